# Optimizing an MI355X kernel written in HIP

```python
import jax, jax.numpy as jnp
from jax import lax
import numpy as np

D_MODEL = 1024
BATCH = 16
SEQ = 4096
DEPTH = 4

MIX_WIDTH = D_MODEL
A_HEADS = 8
A_HEAD_DIM = 64
IDX_HEADS = 8
IDX_DIM = 64
TOPK_MAX = 256
Q_BLOCK = 128
B_HEADS = 4
B_KEY_DIM = 64
B_VAL_DIM = 128
GATE_RANK = 16
GATE_TAU = 16.0
CHUNK = 64
D_FF = 2816
N_EXPERTS = 8
TOP_K_EXPERTS = 2
MOE_BLOCK = 256
N_DENSE = (DEPTH + 1) // 2
N_MOE = DEPTH // 2
DN_ALPHA = (2 * DEPTH) ** 0.25
DN_BETA = (8 * DEPTH) ** -0.25
NORM_EPS = 1e-5

A_Q_W = A_HEADS * A_HEAD_DIM
A_K_W = A_HEAD_DIM
A_V_W = A_HEAD_DIM
I_Q_W = IDX_HEADS * IDX_DIM
I_K_W = IDX_DIM
I_W_W = IDX_HEADS
B_Q_W = B_HEADS * B_KEY_DIM
B_K_W = B_HEADS * B_KEY_DIM
B_V_W = B_HEADS * B_VAL_DIM
B_G_W = B_HEADS * B_VAL_DIM
B_A_W = GATE_RANK
SEG_WIDTHS = (A_Q_W, A_K_W, A_V_W, I_Q_W, I_K_W, I_W_W, B_Q_W, B_K_W, B_V_W, B_G_W, B_A_W)
VALUE_SEGS = (2, 8)
PROJ_WIDTH = A_Q_W + A_K_W + A_V_W + I_Q_W + I_K_W + I_W_W + B_Q_W + B_K_W + B_V_W + B_G_W + B_A_W

kernel_name = 'hybrid_dsa_gla_deepnorm_moe'


def _split_points():
    pts, acc = [], 0
    for w in SEG_WIDTHS[:-1]:
        acc += w
        pts.append(acc)
    return pts


def layer_norm(x, g, b):
    xf = x.astype(jnp.float32)
    mu = jnp.mean(xf, axis=-1, keepdims=True)
    var = jnp.mean(jnp.square(xf - mu), axis=-1, keepdims=True)
    y = (xf - mu) * lax.rsqrt(var + NORM_EPS) * g.astype(jnp.float32) + b.astype(jnp.float32)
    return y.astype(x.dtype)


def rms_norm(x, g):
    xf = x.astype(jnp.float32)
    y = xf * lax.rsqrt(jnp.mean(jnp.square(xf), axis=-1, keepdims=True) + NORM_EPS)
    return (y * g.astype(jnp.float32)).astype(x.dtype)


def alibi_slopes(n):
    return jnp.exp2(-8.0 * jnp.arange(1, n + 1, dtype=jnp.float32) / n)


def dsa_attention(q, k, v, q_idx, k_idx, w_idx):
    bsz, L = q.shape[0], q.shape[1]
    k_top = min(TOPK_MAX, L // 4)
    n_blocks = L // Q_BLOCK
    slopes = alibi_slopes(A_HEADS)
    key_pos = jnp.arange(L)
    scale = A_HEAD_DIM ** -0.5
    idx_scale = IDX_DIM ** -0.5
    k_idx_f = k_idx.astype(jnp.float32)
    gather = jax.vmap(lambda table, ids: table[ids])

    def block(i):
        t0 = i * Q_BLOCK
        qb = lax.dynamic_slice_in_dim(q, t0, Q_BLOCK, axis=1)
        qib = lax.dynamic_slice_in_dim(q_idx, t0, Q_BLOCK, axis=1)
        wib = lax.dynamic_slice_in_dim(w_idx, t0, Q_BLOCK, axis=1)
        qpos = t0 + jnp.arange(Q_BLOCK)
        s_idx = jnp.einsum('bthd,bsd->bths', qib.astype(jnp.float32), k_idx_f) * idx_scale
        scores = jnp.einsum('bth,bths->bts', wib.astype(jnp.float32), jax.nn.relu(s_idx))
        causal = key_pos[None, :] <= qpos[:, None]
        scores = jnp.where(causal[None], scores, -jnp.inf)
        _, sel = lax.top_k(scores, k_top)
        k_sel = gather(k, sel)
        v_sel = gather(v, sel)
        dist = (qpos[None, :, None] - sel).astype(jnp.float32)
        logits = jnp.einsum('bthd,btkd->bthk', qb, k_sel).astype(jnp.float32) * scale
        logits = logits - slopes[None, None, :, None] * dist[:, :, None, :]
        logits = jnp.where((dist >= 0)[:, :, None, :], logits, -jnp.inf)
        p = jax.nn.softmax(logits, axis=-1)
        return jnp.einsum('bthk,btkd->bthd', p.astype(v.dtype), v_sel)

    outs = lax.map(block, jnp.arange(n_blocks))
    return outs.transpose(1, 0, 2, 3, 4).reshape(bsz, L, A_HEADS * A_HEAD_DIM)


def gla(q, k, v, log_a):
    bsz, L = q.shape[0], q.shape[1]
    nc = L // CHUNK

    def to_chunks(z):
        return z.astype(jnp.float32).reshape(bsz, nc, CHUNK, B_HEADS, -1).transpose(1, 0, 3, 2, 4)

    qc = to_chunks(q) * (B_KEY_DIM ** -0.5)
    kc, vc, gc = to_chunks(k), to_chunks(v), to_chunks(log_a)
    tri = jnp.tril(jnp.ones((CHUNK, CHUNK), dtype=bool))

    def step(state, inp):
        qi, ki, vi, gi = inp
        b = jnp.cumsum(gi, axis=2)
        b_last = b[:, :, -1:, :]
        inter = jnp.einsum('bhtd,bhde->bhte', qi * jnp.exp(b), state)
        diff = b[:, :, :, None, :] - b[:, :, None, :, :]
        decay = jnp.exp(jnp.where(tri[None, None, :, :, None], diff, -jnp.inf))
        attn = jnp.einsum('bhtd,bhsd,bhtsd->bhts', qi, ki, decay)
        out = inter + jnp.einsum('bhts,bhse->bhte', attn, vi)
        new_state = jnp.exp(b_last)[:, :, 0, :, None] * state + \
            jnp.einsum('bhsd,bhse->bhde', ki * jnp.exp(b_last - b), vi)
        return new_state, out

    init = jnp.zeros((bsz, B_HEADS, B_KEY_DIM, B_VAL_DIM), jnp.float32)
    _, outs = lax.scan(step, init, (qc, kc, vc, gc))
    return outs.transpose(1, 0, 3, 2, 4).reshape(bsz, L, B_HEADS, B_VAL_DIM).astype(q.dtype)


def hybrid_mixer(h, w_in, w_a2, b_a, gla_g, w_out):
    bsz, L, _ = h.shape
    proj = h @ w_in
    aq, ak, av, iq, ik, iw, bq, bk, bv, bg, ba = jnp.split(proj, _split_points(), axis=-1)
    y_a = dsa_attention(
        aq.reshape(bsz, L, A_HEADS, A_HEAD_DIM), ak, av,
        iq.reshape(bsz, L, IDX_HEADS, IDX_DIM), ik, iw * (IDX_HEADS ** -0.5))
    log_a = jax.nn.log_sigmoid((ba @ w_a2 + b_a).astype(jnp.float32)) / GATE_TAU
    o = gla(bq.reshape(bsz, L, B_HEADS, B_KEY_DIM), bk.reshape(bsz, L, B_HEADS, B_KEY_DIM),
            bv.reshape(bsz, L, B_HEADS, B_VAL_DIM), log_a.reshape(bsz, L, B_HEADS, B_KEY_DIM))
    o = rms_norm(o, gla_g) * jax.nn.silu(bg.reshape(bsz, L, B_HEADS, B_VAL_DIM))
    y = jnp.concatenate([y_a, o.reshape(bsz, L, B_HEADS * B_VAL_DIM)], axis=-1)
    return y @ w_out


def swiglu(h, w_gate, w_up, w_down):
    return (jax.nn.silu(h @ w_gate) * (h @ w_up)) @ w_down


def moe_swiglu(h, w_router, b_router, we_gate, we_up, we_down):
    bsz, L, d = h.shape
    n_tok = bsz * L
    xf = h.reshape(n_tok, d)
    logits = (xf @ w_router + b_router).astype(jnp.float32)
    top_val, top_idx = lax.top_k(logits, TOP_K_EXPERTS)
    gates = jax.nn.softmax(top_val, axis=-1)
    n_assign = n_tok * TOP_K_EXPERTS
    e_flat = top_idx.reshape(-1)
    tok_flat = jnp.repeat(jnp.arange(n_tok, dtype=jnp.int32), TOP_K_EXPERTS)
    g_flat = gates.reshape(-1)
    order = jnp.argsort(e_flat)
    e_sorted = e_flat[order]
    counts = jnp.bincount(e_flat, length=N_EXPERTS)
    padded = ((counts + MOE_BLOCK - 1) // MOE_BLOCK) * MOE_BLOCK
    start = jnp.cumsum(counts) - counts
    pstart = jnp.cumsum(padded) - padded
    pend = pstart + padded
    dest = pstart[e_sorted] + (jnp.arange(n_assign) - start[e_sorted])
    n_blocks = -(-n_assign // MOE_BLOCK) + N_EXPERTS
    n_rows = n_blocks * MOE_BLOCK
    buf_tok = jnp.zeros((n_rows,), jnp.int32).at[dest].set(tok_flat[order])
    buf_gate = jnp.zeros((n_rows,), jnp.float32).at[dest].set(g_flat[order])
    blk_expert = jnp.minimum(
        jnp.searchsorted(pend, jnp.arange(n_blocks) * MOE_BLOCK, side='right'), N_EXPERTS - 1)

    def run_block(args):
        toks, gts, e = args
        y = swiglu(xf[toks], we_gate[e], we_up[e], we_down[e])
        return y * gts[:, None].astype(y.dtype)

    yb = lax.map(run_block, (buf_tok.reshape(n_blocks, MOE_BLOCK),
                             buf_gate.reshape(n_blocks, MOE_BLOCK), blk_expert))
    out = jax.ops.segment_sum(yb.reshape(n_rows, d), buf_tok, num_segments=n_tok)
    return out.reshape(bsz, L, d)


def setup_inputs(seed: int = 0) -> dict:
    key = jax.random.key(seed)
    ks = jax.random.split(key, 20)
    f32 = jnp.float32
    nrm = lambda k, shape: jax.random.normal(k, shape, f32)
    col_scale = jnp.concatenate([
        jnp.full((w,), DN_BETA if i in VALUE_SEGS else 1.0, f32) for i, w in enumerate(SEG_WIDTHS)])
    return {
        'x': nrm(ks[0], (BATCH, SEQ, D_MODEL)),
        'c': nrm(ks[1], (BATCH, D_MODEL)),
        'w_in': nrm(ks[2], (DEPTH, D_MODEL, PROJ_WIDTH)) * (D_MODEL ** -0.5) * col_scale,
        'w_a2': nrm(ks[3], (DEPTH, GATE_RANK, B_HEADS * B_KEY_DIM)) * (GATE_RANK ** -0.5),
        'b_a': 0.1 * nrm(ks[4], (DEPTH, B_HEADS * B_KEY_DIM)),
        'gla_norm_g': 1.0 + 0.1 * nrm(ks[5], (DEPTH, B_VAL_DIM)),
        'w_out': nrm(ks[6], (DEPTH, MIX_WIDTH, D_MODEL)) * (MIX_WIDTH ** -0.5) * DN_BETA,
        'w_mod': nrm(ks[7], (DEPTH, D_MODEL, 6 * D_MODEL)) * (D_MODEL ** -0.5) * 0.1,
        'b_mod': 0.01 * nrm(ks[8], (DEPTH, 6 * D_MODEL)),
        'ln_g': 1.0 + 0.1 * nrm(ks[9], (DEPTH, 2, D_MODEL)),
        'ln_b': 0.02 * nrm(ks[10], (DEPTH, 2, D_MODEL)),
        'ffn_w_gate': nrm(ks[11], (N_DENSE, D_MODEL, D_FF)) * (D_MODEL ** -0.5),
        'ffn_w_up': nrm(ks[12], (N_DENSE, D_MODEL, D_FF)) * (D_MODEL ** -0.5),
        'ffn_w_down': nrm(ks[13], (N_DENSE, D_FF, D_MODEL)) * (D_FF ** -0.5) * DN_BETA,
        'w_router': nrm(ks[14], (N_MOE, D_MODEL, N_EXPERTS)) * (D_MODEL ** -0.5),
        'b_router': 0.01 * nrm(ks[15], (N_MOE, N_EXPERTS)),
        'moe_w_gate': nrm(ks[16], (N_MOE, N_EXPERTS, D_MODEL, D_FF)) * (D_MODEL ** -0.5),
        'moe_w_up': nrm(ks[17], (N_MOE, N_EXPERTS, D_MODEL, D_FF)) * (D_MODEL ** -0.5),
        'moe_w_down': nrm(ks[18], (N_MOE, N_EXPERTS, D_FF, D_MODEL)) * (D_FF ** -0.5) * DN_BETA,
    }


def reference(x, c, w_in, w_a2, b_a, gla_norm_g, w_out, w_mod, b_mod, ln_g, ln_b,
              ffn_w_gate, ffn_w_up, ffn_w_down, w_router, b_router,
              moe_w_gate, moe_w_up, moe_w_down):
    c_act = jax.nn.silu(c)
    for l in range(DEPTH):
        mod = (c_act @ w_mod[l] + b_mod[l])[:, None, :]
        sh1, sc1, g1, sh2, sc2, g2 = jnp.split(mod, 6, axis=-1)
        h = x * (1.0 + sc1) + sh1
        y = hybrid_mixer(h, w_in[l], w_a2[l], b_a[l], gla_norm_g[l], w_out[l])
        x = layer_norm(DN_ALPHA * x + (1.0 + g1) * y, ln_g[l, 0], ln_b[l, 0])
        h = x * (1.0 + sc2) + sh2
        if l % 2 == 0:
            j = l // 2
            y = swiglu(h, ffn_w_gate[j], ffn_w_up[j], ffn_w_down[j])
        else:
            j = l // 2
            y = moe_swiglu(h, w_router[j], b_router[j], moe_w_gate[j], moe_w_up[j], moe_w_down[j])
        x = layer_norm(DN_ALPHA * x + (1.0 + g2) * y, ln_g[l, 1], ln_b[l, 1])
    return x
```

```cpp
#include <hip/hip_runtime.h>
#include <cstdio>
#include <cstdint>

#define GAS __attribute__((address_space(1)))
#define LAS __attribute__((address_space(3)))
typedef unsigned short bf16;
typedef unsigned v4u __attribute__((ext_vector_type(4)));
typedef unsigned v2u __attribute__((ext_vector_type(2)));
typedef float f32x4 __attribute__((ext_vector_type(4)));
typedef float f32x2 __attribute__((ext_vector_type(2)));
typedef float f32x16 __attribute__((ext_vector_type(16)));
typedef short bf16x8 __attribute__((ext_vector_type(8)));

#ifndef MK_MULTI
#define MK_MULTI 0
#endif

constexpr int BATCH = 16, SEQ = 4096, DM = 1024, DEPTH = 4, MTOK = BATCH * SEQ;
constexpr int PW = 2816;
constexpr int PROJ_SRC = 2776;
constexpr int C_AQ = 0, C_IQ = 512, C_BQ = 1024, C_BK = 1280, C_BV = 1536, C_BG = 2048, C_AK = 2560, C_AV = 2624, C_IK = 2688, C_IW = 2752, C_BA = 2760;
constexpr int DFF = 2816, NEXP = 8;
constexpr int PASS_PANELS = 256, NPASS_DENSE = 1, NPASS_MOE = 2;
constexpr float DN_ALPHA = 1.681792830507429f;
constexpr float LN_EPS = 1e-5f;
constexpr float LOG2E = 1.4426950408889634f;

constexpr size_t MiB = 1u << 20;
constexpr size_t WS_CTL = 0, CTL_ZERO_BYTES = 1 * MiB;
constexpr size_t WS_MOD = 1 * MiB;
constexpr size_t WS_TOPE = 3 * MiB;
constexpr size_t WS_TOPG = WS_TOPE + MiB / 2;
constexpr size_t WS_TOKSLOT = WS_TOPG + MiB / 2;
constexpr size_t WS_ROWTOK = 5 * MiB;
constexpr size_t WS_ROWGATE = 6 * MiB;
constexpr size_t WS_WIN = 8 * MiB;
constexpr size_t WS_WOUT = 14 * MiB;
constexpr size_t WS_WGU = 16 * MiB;
constexpr size_t WS_WDN = 104 * MiB;
constexpr size_t WS_H = 148 * MiB;
constexpr size_t WS_P = 276 * MiB;
constexpr size_t WS_Y = 640 * MiB;
constexpr size_t WS_SEL = 900 * MiB;
constexpr size_t WS_END = 1024 * MiB;

constexpr int CW_BAR = 4096;
constexpr int CW_QUEUE = 8192;
constexpr int CW_CNT = 10240;
constexpr int CW_FILL = 10752;

constexpr int LDS_BYTES = 147456;
constexpr int PE_OFF = 131072;
constexpr int MISC_OFF = 139264;

__device__ __forceinline__ float bf2f(unsigned v) { return __uint_as_float(v << 16); }
typedef __bf16 bf16x2_t __attribute__((ext_vector_type(2)));
__device__ __forceinline__ unsigned pk2(float lo, float hi) { const f32x2 v = {lo, hi}; return __builtin_bit_cast(unsigned, __builtin_convertvector(v, bf16x2_t)); }
__device__ __forceinline__ unsigned f2bf(float f) { return pk2(f, 0.f) & 0xffffu; }
__device__ __forceinline__ float wave_sum(float v) {
#pragma unroll
    for (int o = 1; o < 64; o <<= 1) v += __shfl_xor(v, o);
    return v;
}
__device__ __forceinline__ float wave_max(float v) {
#pragma unroll
    for (int o = 1; o < 64; o <<= 1) v = fmaxf(v, __shfl_xor(v, o));
    return v;
}
#define DPP_U32(x, ctrl) ((unsigned)__builtin_amdgcn_update_dpp(0, (int)(x), (ctrl), 0xF, 0xF, true))
__device__ __forceinline__ unsigned wave_sum_u32(unsigned x) {
    x += DPP_U32(x, 0xB1); x += DPP_U32(x, 0x4E); x += DPP_U32(x, 0x124); x += DPP_U32(x, 0x128);
    return (unsigned)__builtin_amdgcn_readlane((int)x, 0) + (unsigned)__builtin_amdgcn_readlane((int)x, 16) + (unsigned)__builtin_amdgcn_readlane((int)x, 32) + (unsigned)__builtin_amdgcn_readlane((int)x, 48);
}
__device__ __forceinline__ float dpp_f32_(float x, int) { return x; }
#define DPP_F32(x, ctrl) (__builtin_bit_cast(float, __builtin_amdgcn_update_dpp(0, __builtin_bit_cast(int, (x)), (ctrl), 0xF, 0xF, true)))
__device__ __forceinline__ float wave_sum_f(float x) {
    x += DPP_F32(x, 0xB1); x += DPP_F32(x, 0x4E); x += DPP_F32(x, 0x124); x += DPP_F32(x, 0x128);
    const float r0 = __builtin_bit_cast(float, __builtin_amdgcn_readlane(__builtin_bit_cast(int, x), 0)), r1 = __builtin_bit_cast(float, __builtin_amdgcn_readlane(__builtin_bit_cast(int, x), 16));
    const float r2 = __builtin_bit_cast(float, __builtin_amdgcn_readlane(__builtin_bit_cast(int, x), 32)), r3 = __builtin_bit_cast(float, __builtin_amdgcn_readlane(__builtin_bit_cast(int, x), 48));
    return (r0 + r1) + (r2 + r3);
}
__device__ __forceinline__ unsigned umax_(unsigned a, unsigned b) { return a > b ? a : b; }
__device__ __forceinline__ unsigned umin_(unsigned a, unsigned b) { return a < b ? a : b; }
__device__ __forceinline__ unsigned wave_max_u32(unsigned x) {
    x = umax_(x, DPP_U32(x, 0xB1)); x = umax_(x, DPP_U32(x, 0x4E)); x = umax_(x, DPP_U32(x, 0x124)); x = umax_(x, DPP_U32(x, 0x128));
    return umax_(umax_((unsigned)__builtin_amdgcn_readlane((int)x, 0), (unsigned)__builtin_amdgcn_readlane((int)x, 16)), umax_((unsigned)__builtin_amdgcn_readlane((int)x, 32), (unsigned)__builtin_amdgcn_readlane((int)x, 48)));
}
__device__ __forceinline__ unsigned wave_min_u32(unsigned x) {
    x = umin_(x, DPP_U32(x, 0xB1)); x = umin_(x, DPP_U32(x, 0x4E)); x = umin_(x, DPP_U32(x, 0x124)); x = umin_(x, DPP_U32(x, 0x128));
    return umin_(umin_((unsigned)__builtin_amdgcn_readlane((int)x, 0), (unsigned)__builtin_amdgcn_readlane((int)x, 16)), umin_((unsigned)__builtin_amdgcn_readlane((int)x, 32), (unsigned)__builtin_amdgcn_readlane((int)x, 48)));
}
#define SHX_F(v, o, lane_) (__builtin_bit_cast(float, __builtin_amdgcn_ds_bpermute((((lane_) ^ (o)) << 2), __builtin_bit_cast(int, (float)(v)))))
#define SHUP_I(v, o, lane_) (__builtin_amdgcn_ds_bpermute((((lane_) - (o)) << 2), (int)(v)))
__device__ __forceinline__ int wave_incl_scan_i(int x, int lane) {
    x += __builtin_amdgcn_update_dpp(0, x, 0x111, 0xF, 0xF, true); x += __builtin_amdgcn_update_dpp(0, x, 0x112, 0xF, 0xF, true);
    x += __builtin_amdgcn_update_dpp(0, x, 0x114, 0xF, 0xF, true); x += __builtin_amdgcn_update_dpp(0, x, 0x118, 0xF, 0xF, true);
    const int t0 = __builtin_amdgcn_readlane(x, 15), t1 = __builtin_amdgcn_readlane(x, 31), t2 = __builtin_amdgcn_readlane(x, 47);
    return x + (lane >= 16 ? t0 : 0) + (lane >= 32 ? t1 : 0) + (lane >= 48 ? t2 : 0);
}
__device__ __forceinline__ float silu_f(float v) { return v / (1.f + expf(-v)); }

#define XB_TMO      128
#define XB_XCNT(j)  (256  + 64 * (j))
#define XB_XSUB(j)  (1280 + 64 * (j))
#define XB_XGEN(j)  (2304 + 64 * (j))
#define XB_TOP      3328
#define XB_TOPGEN   3392
#define XCD_BAR_WORDS 3456
#define XB_SPIN_CAP (1u << 21)

__device__ __forceinline__ unsigned xb_ld(unsigned* p)              { return __hip_atomic_load(p, __ATOMIC_RELAXED, __HIP_MEMORY_SCOPE_AGENT); }
__device__ __forceinline__ unsigned xb_add(unsigned* p, unsigned v) { return __hip_atomic_fetch_add(p, v, __ATOMIC_RELAXED, __HIP_MEMORY_SCOPE_AGENT); }
__device__ __forceinline__ unsigned xb_xcc_id() { return (unsigned)__builtin_amdgcn_s_getreg((3 << 11) | 20) & 0xFu; }
#define XB_SPIN(cond, bar) do { unsigned _sp = 0; while (cond) { __builtin_amdgcn_s_sleep(1); \
    if ((++_sp & 255u) == 0u) { if (xb_ld(&(bar)[XB_TMO])) break; if (_sp > XB_SPIN_CAP) { atomicAdd(&(bar)[XB_TMO], 1u); break; } } } } while (0)

struct XcdBarrier {
    unsigned* bar; unsigned x;
    volatile LAS unsigned* st;
};

__device__ __forceinline__ XcdBarrier xcd_barrier_post(unsigned* bar, volatile LAS unsigned* st) {
    XcdBarrier b; b.bar = bar; b.x = xb_xcc_id(); b.st = st;
    if (threadIdx.x == 0) (void)xb_add(&bar[XB_XCNT(b.x)], 1u);
    return b;
}
__device__ __forceinline__ void xcd_barrier_complete(unsigned* bar, unsigned x, unsigned& nloc, unsigned& nx) {
    const unsigned G = gridDim.x * gridDim.y * gridDim.z;
    unsigned sum, cnt, mine, sp = 0u;
    for (;;) {
        sum = 0u; cnt = 0u; mine = 0u;
#pragma unroll
        for (unsigned j = 0; j < 16; ++j) { const unsigned c = xb_ld(&bar[XB_XCNT(j)]); sum += c; cnt += (c > 0u) ? 1u : 0u; mine = (j == x) ? c : mine; }
        if (sum == G) break;
        __builtin_amdgcn_s_sleep(1);
        if ((++sp & 255u) == 0u) { if (xb_ld(&bar[XB_TMO])) break; if (sp > XB_SPIN_CAP) { atomicAdd(&bar[XB_TMO], 1u); break; } }
    }
    nloc = mine > 0u ? mine : 1u; nx = cnt > 0u ? cnt : 1u;
}

__device__ __forceinline__ void xcd_barrier(const XcdBarrier& b) {
    asm volatile("s_waitcnt vmcnt(0)" ::: "memory");
    __syncthreads();
    if (threadIdx.x == 0) {
        unsigned* bar = b.bar;
        __builtin_amdgcn_s_waitcnt(0);
        unsigned nloc = b.st[0], nx = b.st[1];
        if (nloc == 0u) { xcd_barrier_complete(bar, b.x, nloc, nx); b.st[0] = nloc; b.st[1] = nx; }
        const unsigned old = xb_add(&bar[XB_XSUB(b.x)], 1u);
        const unsigned gen = old / nloc;
        if (old + 1u == (gen + 1u) * nloc) {
            __builtin_amdgcn_fence(__ATOMIC_RELEASE, "agent");
            asm volatile("s_waitcnt vmcnt(0)" ::: "memory");
            const unsigned og = xb_add(&bar[XB_TOP], 1u);
            const unsigned tg = og / nx;
            if (og + 1u == (tg + 1u) * nx) xb_add(&bar[XB_TOPGEN], 1u);
            else XB_SPIN(xb_ld(&bar[XB_TOPGEN]) == tg, bar);
            __builtin_amdgcn_fence(__ATOMIC_ACQUIRE, "agent");
            xb_add(&bar[XB_XGEN(b.x)], 1u);
            asm volatile("s_waitcnt vmcnt(0)" ::: "memory");
        } else {
            XB_SPIN(xb_ld(&bar[XB_XGEN(b.x)]) == gen, bar);
            __builtin_amdgcn_fence(__ATOMIC_ACQUIRE, "agent");
            asm volatile("s_waitcnt vmcnt(0)" ::: "memory");
        }
    }
    __syncthreads();
}


struct Args { const float* in[19]; float* out; unsigned char* ws; int lo, hi; };
typedef const Args __attribute__((address_space(4))) KArgs;
struct Ctx {
    LAS unsigned char* lds;
    volatile LAS unsigned* MISC;
    unsigned* ctl;
    int tid, lane, wave, G, bid;
    int hot;
    KArgs* ka;
    float* out; unsigned char* ws;
    __device__ __forceinline__ const float* in(int i) const { return ka->in[i]; }
};
enum { I_X = 0, I_C, I_WIN, I_WA2, I_BA, I_GLAG, I_WOUT, I_WMOD, I_BMOD, I_LNG, I_LNB, I_FG, I_FU, I_FD, I_WR, I_BR, I_MG, I_MU, I_MD };

__device__ __forceinline__ f32x16 mfma32(bf16x8 a, bf16x8 b, f32x16 c) { return __builtin_amdgcn_mfma_f32_32x32x16_bf16(a, b, c, 0, 0, 0); }

__device__ __forceinline__ void ph_mod(Ctx& C) {
    LAS float* sc = (LAS float*)C.lds;
    LAS float* red = (LAS float*)(C.lds + 65536);
    const float* c = C.in(I_C);
    for (int i = C.tid; i < 16 * 1024; i += 512) sc[i] = silu_f(c[i]);
    __syncthreads();
    const float* wmod = C.in(I_WMOD); const float* bmod = C.in(I_BMOD);
    float* MOD = (float*)(C.ws + WS_MOD);
    for (int u = C.bid; u < 4 * 96; u += C.G) {
        const int l = u / 96, cc = u % 96, col = cc * 64 + C.lane;
        float acc[16];
#pragma unroll
        for (int b = 0; b < 16; ++b) acc[b] = 0.f;
        const float* wp = wmod + ((size_t)l * 1024 + C.wave * 128) * 6144 + col;
        const LAS float* sp = sc + C.wave * 128;
#pragma unroll 16
        for (int kk = 0; kk < 128; ++kk) {
            const float w = wp[(size_t)kk * 6144];
#pragma unroll
            for (int b = 0; b < 16; ++b) acc[b] += sp[b * 1024 + kk] * w;
        }
#pragma unroll
        for (int b = 0; b < 16; ++b) red[(C.wave * 16 + b) * 64 + C.lane] = acc[b];
        __syncthreads();
        for (int o = C.tid; o < 1024; o += 512) {
            const int b = o >> 6, ln = o & 63; float s = 0.f;
#pragma unroll
            for (int w = 0; w < 8; ++w) s += red[(w * 16 + b) * 64 + ln];
            const int cl = cc * 64 + ln;
            MOD[((size_t)l * 16 + b) * 6144 + cl] = s + bmod[l * 6144 + cl];
        }
        __syncthreads();
    }
}

__device__ __forceinline__ void conv_item(const float* colp, int ldn, int K, bf16* WT, LAS float* scr, int kb, int nb, int lane) {
    const int k0 = 64 * kb, n0 = 32 * nb;
    float tv[32];
#pragma unroll
    for (int i = 0; i < 32; ++i) { const int kk = 2 * i + (lane >> 5); tv[i] = colp ? colp[(size_t)(k0 + kk) * ldn] : 0.f; }
#pragma unroll
    for (int i = 0; i < 32; ++i) { const int kk = 2 * i + (lane >> 5); scr[kk * 33 + (lane & 31)] = tv[i]; }
    asm volatile("s_waitcnt lgkmcnt(0)" ::: "memory");
    const int c = lane & 7;
#pragma unroll
    for (int j = 0; j < 4; ++j) {
        const int n = (lane >> 3) + 8 * j; const LAS float* s = scr + (8 * c) * 33 + n;
        v4u o; o.x = pk2(s[0 * 33], s[1 * 33]); o.y = pk2(s[2 * 33], s[3 * 33]); o.z = pk2(s[4 * 33], s[5 * 33]); o.w = pk2(s[6 * 33], s[7 * 33]);
        *(v4u*)(WT + (size_t)(n0 + n) * K + k0 + 8 * c) = o;
    }
    asm volatile("s_waitcnt lgkmcnt(0)" ::: "memory");
}
__device__ __forceinline__ int win_src_col(int n) {
    if (n < C_IQ) return n;
    if (n < C_BQ) return 640 + (n - C_IQ);
    if (n < C_AK) return 1224 + (n - C_BQ);
    if (n < C_AV) return 512 + (n - C_AK);
    if (n < C_IK) return 576 + (n - C_AV);
    if (n < C_IW) return 1152 + (n - C_IK);
    if (n < C_BA) return 1216 + (n - C_IW);
    if (n < PROJ_SRC) return 2760 + (n - C_BA);
    return -1;
}
__device__ __forceinline__ void ph_conv(Ctx& C, int l) {
    LAS float* scr = (LAS float*)(C.lds + C.wave * 8448);
    const int gw = C.bid * 8 + C.wave, NGW = C.G * 8;
    const bool moe = (l & 1) != 0; const int j = l >> 1, ne = moe ? NEXP : 1;
    constexpr int I_IN = 16 * 88, I_OUT = 16 * 32, I_GU = 16 * 176, I_DN = 44 * 32;
    const int nitems = I_IN + I_OUT + ne * (I_GU + I_DN);
    bf16* WIN = (bf16*)(C.ws + WS_WIN); bf16* WOUT = (bf16*)(C.ws + WS_WOUT); bf16* WGU = (bf16*)(C.ws + WS_WGU); bf16* WDN = (bf16*)(C.ws + WS_WDN);
    for (int it = gw; it < nitems; it += NGW) {
        int r = it;
        if (r < I_IN) { const int kb = r / 88, nb = r % 88; const int sc_ = win_src_col(nb * 32 + (C.lane & 31));
            const float* W = C.in(I_WIN) + (size_t)l * 1024 * PROJ_SRC;
            conv_item(sc_ >= 0 ? W + sc_ : nullptr, PROJ_SRC, 1024, WIN, scr, kb, nb, C.lane); continue; }
        r -= I_IN;
        if (r < I_OUT) { const int kb = r / 32, nb = r % 32; const float* W = C.in(I_WOUT) + (size_t)l * 1024 * 1024;
            conv_item(W + nb * 32 + (C.lane & 31), 1024, 1024, WOUT, scr, kb, nb, C.lane); continue; }
        r -= I_OUT;
        const int e = r / (I_GU + I_DN); r -= e * (I_GU + I_DN);
        const size_t eoff = (size_t)(j * ne + e) * 1024 * DFF;
        if (r < I_GU) { const int kb = r / 176, nb = r % 176; const int n = nb * 32 + (C.lane & 31), T = n >> 8, jj = n & 255;
            const float* Wg = (moe ? C.in(I_MG) : C.in(I_FG)) + eoff; const float* Wu = (moe ? C.in(I_MU) : C.in(I_FU)) + eoff;
            const float* colp = (jj < 128) ? Wg + T * 128 + jj : Wu + T * 128 + (jj - 128);
            conv_item(colp, DFF, 1024, WGU + (size_t)e * 5632 * 1024, scr, kb, nb, C.lane); continue; }
        r -= I_GU;
        { const int kb = r / 32, nb = r % 32; const float* Wd = (moe ? C.in(I_MD) : C.in(I_FD)) + eoff;
          conv_item(Wd + nb * 32 + (C.lane & 31), 1024, DFF, WDN + (size_t)e * 1024 * DFF, scr, kb, nb, C.lane); }
    }
}

__device__ __forceinline__ void ph_modulate0(Ctx& C) {
    const int gw = C.bid * 8 + C.wave, NGW = C.G * 8;
    const float* MOD = (const float*)(C.ws + WS_MOD); bf16* H = (bf16*)(C.ws + WS_H); const float* x = C.in(I_X);
    for (int row = gw; row < MTOK; row += NGW) {
        const int b = row >> 12; const float* md = MOD + (size_t)b * 6144;
#pragma unroll
        for (int j = 0; j < 4; ++j) {
            const int col = 4 * C.lane + 256 * j;
            const f32x4 v = *(const f32x4*)(x + (size_t)row * DM + col), sh = *(const f32x4*)(md + col), sc = *(const f32x4*)(md + 1024 + col);
            v2u o; o.x = pk2(v.x * (1.f + sc.x) + sh.x, v.y * (1.f + sc.y) + sh.y); o.y = pk2(v.z * (1.f + sc.z) + sh.z, v.w * (1.f + sc.w) + sh.w);
            *(v2u*)(H + (size_t)row * DM + col) = o;
        }
    }
}

struct GUnit { int arow0; int orow0; int pn; size_t boff; };
template <int MODE, class Epi>
__device__ __forceinline__ void gemm_simple_unit(Ctx& C, const bf16* A, int lda, const int* rowmap, const bf16* Bt, int K, const GUnit& u, const Epi& E) {
    const int rs = C.wave & 3, ch = C.wave >> 2, n = C.lane & 31, h = C.lane >> 5;
    const int r0 = u.arow0 + rs * 64 + n;
    const int ra = rowmap ? rowmap[r0] : r0, rb = rowmap ? rowmap[r0 + 32] : r0 + 32;
    const bf16* a0p = A + (size_t)ra * lda + 8 * h; const bf16* a1p = A + (size_t)rb * lda + 8 * h;
#pragma unroll 1
    for (int sp = 0; sp < 2; ++sp) {
        int br0, br1;
        if (MODE == 1) { const int jj = 2 * ch + sp; br0 = u.pn * 256 + 32 * jj; br1 = br0 + 128; }
        else { br0 = u.pn * 256 + 128 * ch + 64 * sp; br1 = br0 + 32; }
        const bf16* b0p = Bt + u.boff + (size_t)(br0 + n) * K + 8 * h; const bf16* b1p = Bt + u.boff + (size_t)(br1 + n) * K + 8 * h;
        f32x16 c00, c01, c10, c11;
#pragma unroll
        for (int i = 0; i < 16; ++i) { c00[i] = 0.f; c01[i] = 0.f; c10[i] = 0.f; c11[i] = 0.f; }
#pragma unroll 4
        for (int k = 0; k < K; k += 16) {
            const bf16x8 a0 = *(const bf16x8*)(a0p + k), a1 = *(const bf16x8*)(a1p + k), b0 = *(const bf16x8*)(b0p + k), b1 = *(const bf16x8*)(b1p + k);
            c00 = mfma32(a0, b0, c00); c01 = mfma32(a0, b1, c01); c10 = mfma32(a1, b0, c10); c11 = mfma32(a1, b1, c11);
        }
        const int orow = u.orow0 + rs * 64 + 4 * h;
        E(c00, c01, orow, br0, br1, n, u);
        E(c10, c11, orow + 32, br0, br1, n, u);
    }
}
struct EpiStoreS {
    bf16* O; int ldc;
    __device__ __forceinline__ void operator()(const f32x16& c0, const f32x16& c1, int orow, int br0, int br1, int n, const GUnit&) const {
#pragma unroll
        for (int r = 0; r < 16; ++r) { const size_t row = (size_t)(orow + (r & 3) + 8 * (r >> 2));
            O[row * ldc + br0 + n] = (bf16)f2bf(c0[r]); O[row * ldc + br1 + n] = (bf16)f2bf(c1[r]); }
    }
};
struct EpiSwigluS {
    bf16* O;
    __device__ __forceinline__ void operator()(const f32x16& c0, const f32x16& c1, int orow, int br0, int br1, int n, const GUnit& u) const {
        const int col = 128 * u.pn + (br0 - 256 * u.pn) + n;
#pragma unroll
        for (int r = 0; r < 16; ++r) { const size_t row = (size_t)(orow + (r & 3) + 8 * (r >> 2));
            O[row * DFF + col] = (bf16)f2bf(silu_f(c0[r]) * c1[r]); }
    }
};
struct EpiGateS {
    bf16* O; const float* gate;
    __device__ __forceinline__ void operator()(const f32x16& c0, const f32x16& c1, int orow, int br0, int br1, int n, const GUnit&) const {
#pragma unroll
        for (int r = 0; r < 16; ++r) { const size_t row = (size_t)(orow + (r & 3) + 8 * (r >> 2)); const float g = gate[row];
            O[row * DM + br0 + n] = (bf16)f2bf(c0[r] * g); O[row * DM + br1 + n] = (bf16)f2bf(c1[r] * g); }
    }
};

__device__ __forceinline__ void ph_gla_unit(Ctx& C, int l, int b, int hh) {
    LAS float* q_s = (LAS float*)C.lds;
    LAS float* k_s = q_s + 4096;
    LAS float* a_s = k_s + 4096;
    LAS float* v_s = a_s + 4096;
    LAS float* o_s = v_s + 8192;
    const bf16* PROJ = (const bf16*)(C.ws + WS_P); bf16* YM = (bf16*)(C.ws + WS_H);
    const float* w_a2 = C.in(I_WA2) + (size_t)l * 16 * 256; const float* b_a = C.in(I_BA) + l * 256; const float* gg = C.in(I_GLAG) + l * 128;
    const int e = C.tid >> 2, dg = C.tid & 3;
    float S[16];
#pragma unroll
    for (int i = 0; i < 16; ++i) S[i] = 0.f;
    for (int c = 0; c < 64; ++c) {
        const size_t row0 = (size_t)b * SEQ + c * 64;
        {
            const int t = C.tid >> 3, d0 = (C.tid & 7) * 8; const bf16* pr = PROJ + (row0 + t) * PW;
            const v4u qv = *(const v4u*)(pr + C_BQ + hh * 64 + d0), kv = *(const v4u*)(pr + C_BK + hh * 64 + d0);
            const v4u ba0 = *(const v4u*)(pr + C_BA), ba1 = *(const v4u*)(pr + C_BA + 8);
            float baf[16];
            baf[0] = bf2f(ba0.x & 0xffffu); baf[1] = bf2f(ba0.x >> 16); baf[2] = bf2f(ba0.y & 0xffffu); baf[3] = bf2f(ba0.y >> 16);
            baf[4] = bf2f(ba0.z & 0xffffu); baf[5] = bf2f(ba0.z >> 16); baf[6] = bf2f(ba0.w & 0xffffu); baf[7] = bf2f(ba0.w >> 16);
            baf[8] = bf2f(ba1.x & 0xffffu); baf[9] = bf2f(ba1.x >> 16); baf[10] = bf2f(ba1.y & 0xffffu); baf[11] = bf2f(ba1.y >> 16);
            baf[12] = bf2f(ba1.z & 0xffffu); baf[13] = bf2f(ba1.z >> 16); baf[14] = bf2f(ba1.w & 0xffffu); baf[15] = bf2f(ba1.w >> 16);
            const unsigned qw[4] = {qv.x, qv.y, qv.z, qv.w}, kw[4] = {kv.x, kv.y, kv.z, kv.w};
#pragma unroll
            for (int i = 0; i < 8; ++i) {
                const int d = d0 + i; float z = b_a[hh * 64 + d];
#pragma unroll
                for (int r = 0; r < 16; ++r) z += baf[r] * w_a2[r * 256 + hh * 64 + d];
                const float ls = fminf(z, 0.f) - log1pf(expf(-fabsf(z)));
                a_s[t * 64 + d] = expf(ls * (1.f / 16.f));
                const unsigned qq = (i & 1) ? (qw[i >> 1] >> 16) : (qw[i >> 1] & 0xffffu), kk = (i & 1) ? (kw[i >> 1] >> 16) : (kw[i >> 1] & 0xffffu);
                q_s[t * 64 + d] = bf2f(qq) * 0.125f; k_s[t * 64 + d] = bf2f(kk);
            }
            const int e0 = (C.tid & 7) * 16;
            const v4u v0 = *(const v4u*)(pr + C_BV + hh * 128 + e0), v1 = *(const v4u*)(pr + C_BV + hh * 128 + e0 + 8);
            const unsigned vw[8] = {v0.x, v0.y, v0.z, v0.w, v1.x, v1.y, v1.z, v1.w};
#pragma unroll
            for (int i = 0; i < 8; ++i) { v_s[t * 128 + e0 + 2 * i] = bf2f(vw[i] & 0xffffu); v_s[t * 128 + e0 + 2 * i + 1] = bf2f(vw[i] >> 16); }
        }
        __syncthreads();
        for (int tt = 0; tt < 64; ++tt) {
            const float vv = v_s[tt * 128 + e]; float po = 0.f;
#pragma unroll
            for (int i = 0; i < 16; ++i) { const int d = 16 * dg + i; S[i] = a_s[tt * 64 + d] * S[i] + k_s[tt * 64 + d] * vv; po += q_s[tt * 64 + d] * S[i]; }
            po += __shfl_xor(po, 1); po += __shfl_xor(po, 2);
            if (dg == 0) o_s[tt * 128 + e] = po;
        }
        __syncthreads();
#pragma unroll 1
        for (int r = 0; r < 8; ++r) {
            const int tt = C.wave * 8 + r; const float o0 = o_s[tt * 128 + C.lane], o1 = o_s[tt * 128 + 64 + C.lane];
            const float ss = wave_sum(o0 * o0 + o1 * o1); const float rstd = rsqrtf(ss * (1.f / 128.f) + LN_EPS);
            const bf16* pr = PROJ + (row0 + tt) * PW + C_BG + hh * 128; const float g0 = bf2f(pr[C.lane]), g1 = bf2f(pr[64 + C.lane]);
            bf16* yo = YM + (row0 + tt) * DM + 512 + hh * 128;
            yo[C.lane] = (bf16)f2bf(o0 * rstd * gg[C.lane] * silu_f(g0)); yo[64 + C.lane] = (bf16)f2bf(o1 * rstd * gg[64 + C.lane] * silu_f(g1));
        }
        __syncthreads();
    }
}

__device__ __forceinline__ unsigned sortable_u32(float f) { const unsigned u = __float_as_uint(f + 0.0f); return (u & 0x80000000u) ? ~u : (u | 0x80000000u); }
__device__ __forceinline__ void ph_dsa_a_unit(Ctx& C, int b, int t0) {
    LAS unsigned* sc = (LAS unsigned*)C.lds;
    LAS unsigned* cnt = (LAS unsigned*)(C.lds + 131072);
    const bf16* PROJ = (const bf16*)(C.ws + WS_P); unsigned* SEL = (unsigned*)(C.ws + WS_SEL);
    const int lane = C.lane, n = lane & 31, h = lane >> 5, tid = C.tid;
    const int nk = t0 + 8, ntile = (nk + 31) >> 5, nscan = ntile * 32;
    if (tid < 48) cnt[tid] = 0u;
    {
        bf16x8 af[2][4]; float wv[2][4][4];
#pragma unroll
        for (int mt = 0; mt < 2; ++mt) {
            const bf16* p = PROJ + (size_t)(b * SEQ + t0 + 4 * mt + (n >> 3)) * PW + C_IQ + (n & 7) * 64 + 8 * h;
#pragma unroll
            for (int ks = 0; ks < 4; ++ks) af[mt][ks] = *(const bf16x8*)(p + ks * 16);
#pragma unroll
            for (int jq = 0; jq < 4; ++jq)
#pragma unroll
                for (int i = 0; i < 4; ++i) wv[mt][jq][i] = bf2f(PROJ[(size_t)(b * SEQ + t0 + 4 * mt + jq) * PW + C_IW + i + 4 * h]) * (0.35355339059327373f * 0.125f);
        }
        for (int tile = C.wave; tile < ntile; tile += 8) {
            const int s = tile * 32 + n; const bf16* kp = PROJ + (size_t)(b * SEQ + s) * PW + C_IK + 8 * h;
            bf16x8 bfr[4];
#pragma unroll
            for (int ks = 0; ks < 4; ++ks) bfr[ks] = *(const bf16x8*)(kp + ks * 16);
#pragma unroll
            for (int mt = 0; mt < 2; ++mt) {
                f32x16 acc;
#pragma unroll
                for (int i = 0; i < 16; ++i) acc[i] = 0.f;
#pragma unroll
                for (int ks = 0; ks < 4; ++ks) acc = mfma32(af[mt][ks], bfr[ks], acc);
#pragma unroll
                for (int jq = 0; jq < 4; ++jq) {
                    float p = 0.f;
#pragma unroll
                    for (int i = 0; i < 4; ++i) p += wv[mt][jq][i] * fmaxf(acc[4 * jq + i], 0.f);
                    p += __shfl_xor(p, 32);
                    const int t = t0 + 4 * mt + jq; const unsigned u = (s <= t) ? sortable_u32(p) : 0u;
                    if (h == mt) sc[(4 * mt + jq) * 4096 + s] = u;
                }
            }
        }
    }
    __syncthreads();
    unsigned u[8][8];
#pragma unroll
    for (int i = 0; i < 8; ++i) {
        const int s = tid + 512 * i; const bool inr = s < nscan; const int sidx = inr ? s : 0;
#pragma unroll
        for (int q = 0; q < 8; ++q) { const unsigned v = sc[q * 4096 + sidx]; u[i][q] = inr ? v : 0u; }
    }
    unsigned T[8], J[8], need[8];
#pragma unroll
    for (int q = 0; q < 8; ++q) { T[q] = 0u; J[q] = 8192u; need[q] = 0u; }
    int buf = 0;
    for (int bit = 31; bit >= 0; --bit) {
        unsigned cq[8];
#pragma unroll
        for (int q = 0; q < 8; ++q) cq[q] = 0u;
#pragma unroll
        for (int i = 0; i < 8; ++i) if (512 * i < nscan) {
#pragma unroll
            for (int q = 0; q < 8; ++q) cq[q] += (unsigned)__popcll(__ballot(u[i][q] >= (T[q] | (1u << bit))));
        }
        unsigned myc = 0u;
#pragma unroll
        for (int q = 0; q < 8; ++q) myc = (lane == q) ? cq[q] : myc;
        if (lane < 8) __hip_atomic_fetch_add(cnt + buf * 16 + lane, myc, __ATOMIC_RELAXED, __HIP_MEMORY_SCOPE_WORKGROUP);
        const int nb = (buf == 2) ? 0 : buf + 1;
        if (tid >= 64 && tid < 80) cnt[nb * 16 + (tid - 64)] = 0u;
        __syncthreads();
#pragma unroll
        for (int q = 0; q < 8; ++q) if (cnt[buf * 16 + q] >= 256u) T[q] |= (1u << bit);
        buf = nb;
    }
#pragma unroll
    for (int q = 0; q < 8; ++q) T[q] = T[q] < 1u ? 1u : T[q];
    bool extra = false;
    {
        unsigned cg[8], ce[8];
#pragma unroll
        for (int q = 0; q < 8; ++q) { cg[q] = 0u; ce[q] = 0u; }
#pragma unroll
        for (int i = 0; i < 8; ++i) if (512 * i < nscan) {
#pragma unroll
            for (int q = 0; q < 8; ++q) { cg[q] += (unsigned)__popcll(__ballot(u[i][q] > T[q])); ce[q] += (unsigned)__popcll(__ballot(u[i][q] >= T[q])); }
        }
        unsigned myc = 0u;
#pragma unroll
        for (int q = 0; q < 8; ++q) { myc = (lane == q) ? cg[q] : myc; myc = (lane == 8 + q) ? ce[q] : myc; }
        if (lane < 16) __hip_atomic_fetch_add(cnt + buf * 16 + lane, myc, __ATOMIC_RELAXED, __HIP_MEMORY_SCOPE_WORKGROUP);
        const int nb = (buf == 2) ? 0 : buf + 1;
        if (tid >= 64 && tid < 80) cnt[nb * 16 + (tid - 64)] = 0u;
        __syncthreads();
#pragma unroll
        for (int q = 0; q < 8; ++q) { const unsigned g = cnt[buf * 16 + q], ge = cnt[buf * 16 + 8 + q]; need[q] = 256u - (g < 256u ? g : 256u); extra = extra || (ge > 256u); }
        buf = nb;
    }
    if (extra) {
#pragma unroll
        for (int q = 0; q < 8; ++q) J[q] = 0u;
        for (int bit = 12; bit >= 0; --bit) {
            unsigned cq[8];
#pragma unroll
            for (int q = 0; q < 8; ++q) cq[q] = 0u;
#pragma unroll
            for (int i = 0; i < 8; ++i) if (512 * i < nscan) {
                const unsigned s = (unsigned)(tid + 512 * i);
#pragma unroll
                for (int q = 0; q < 8; ++q) cq[q] += (unsigned)__popcll(__ballot(u[i][q] == T[q] && s < (J[q] | (1u << bit))));
            }
            unsigned myc = 0u;
#pragma unroll
            for (int q = 0; q < 8; ++q) myc = (lane == q) ? cq[q] : myc;
            if (lane < 8) __hip_atomic_fetch_add(cnt + buf * 16 + lane, myc, __ATOMIC_RELAXED, __HIP_MEMORY_SCOPE_WORKGROUP);
            const int nb = (buf == 2) ? 0 : buf + 1;
            if (tid >= 64 && tid < 80) cnt[nb * 16 + (tid - 64)] = 0u;
            __syncthreads();
#pragma unroll
            for (int q = 0; q < 8; ++q) if (cnt[buf * 16 + q] <= need[q]) J[q] |= (1u << bit);
            buf = nb;
        }
    }
#pragma unroll
    for (int i = 0; i < 8; ++i) if (512 * i < nscan) {
        const unsigned s = (unsigned)(tid + 512 * i); const int tile0 = 2 * C.wave + 16 * i;
#pragma unroll
        for (int q = 0; q < 8; ++q) {
            const unsigned long long bm = __ballot((u[i][q] > T[q]) || (u[i][q] == T[q] && s < J[q]));
            if (lane == 0) { unsigned* w = SEL + (size_t)(b * SEQ + t0 + q) * 128 + tile0;
                if (tile0 < ntile) w[0] = (unsigned)bm; if (tile0 + 1 < ntile) w[1] = (unsigned)(bm >> 32); }
        }
    }
    __syncthreads();
}

__device__ __forceinline__ void ph_dsa_b_unit(Ctx& C, int b, int t0) {
    LAS float* qs = (LAS float*)C.lds + C.wave * 512;
    LAS int* lst = (LAS int*)(C.lds + 16384) + C.wave * 256;
    LAS float* pl = (LAS float*)(C.lds + 16384 + 8192) + C.wave * 2048;
    const bf16* PROJ = (const bf16*)(C.ws + WS_P); const unsigned* SEL = (const unsigned*)(C.ws + WS_SEL); bf16* YM = (bf16*)(C.ws + WS_H);
    const int lane = C.lane, t = t0 + C.wave; const size_t row = (size_t)b * SEQ + t;
    const int ntile = (t >> 5) + 1;
    int base = 0;
#pragma unroll 1
    for (int rd = 0; rd < 2; ++rd) {
        const int wi = rd * 64 + lane; unsigned w = (wi < ntile) ? SEL[row * 128 + wi] : 0u;
        const int c = __popc(w); int incl = c;
#pragma unroll
        for (int o = 1; o < 64; o <<= 1) { const int v = __shfl_up(incl, o); if (lane >= o) incl += v; }
        int pos = base + incl - c;
        while (w) { const int bit = __ffs(w) - 1; w &= w - 1; if (pos < 256) lst[pos] = wi * 32 + bit; ++pos; }
        base += __shfl(incl, 63);
    }
    const int nsel = base < 256 ? base : 256;
    {
        const v4u qv = *(const v4u*)(PROJ + row * PW + C_AQ + lane * 8); const unsigned qw[4] = {qv.x, qv.y, qv.z, qv.w};
#pragma unroll
        for (int i = 0; i < 4; ++i) { qs[lane * 8 + 2 * i] = bf2f(qw[i] & 0xffffu) * (0.125f * LOG2E); qs[lane * 8 + 2 * i + 1] = bf2f(qw[i] >> 16) * (0.125f * LOG2E); }
    }
    asm volatile("s_waitcnt lgkmcnt(0)" ::: "memory");
    float mx[8];
#pragma unroll
    for (int hd = 0; hd < 8; ++hd) mx[hd] = -3.0e38f;
#pragma unroll 1
    for (int i = 0; i < 4; ++i) {
        const int j = lane + 64 * i;
        asm volatile("" ::: "memory");
        if (j < nsel) {
            const int s = lst[j];
            const bf16* kp = PROJ + ((size_t)b * SEQ + s) * PW + C_AK;
            float kr[64];
#pragma unroll
            for (int c8 = 0; c8 < 8; ++c8) { const v4u kv = *(const v4u*)(kp + 8 * c8); const unsigned kw[4] = {kv.x, kv.y, kv.z, kv.w};
#pragma unroll
                for (int x = 0; x < 4; ++x) { kr[8 * c8 + 2 * x] = bf2f(kw[x] & 0xffffu); kr[8 * c8 + 2 * x + 1] = bf2f(kw[x] >> 16); } }
#pragma unroll
            for (int hd = 0; hd < 8; ++hd) {
                float d = 0.f;
#pragma unroll
                for (int x = 0; x < 64; ++x) d += qs[hd * 64 + x] * kr[x];
                const float slope2 = exp2f(-(float)(hd + 1)) * LOG2E;
                const float lgv = d - slope2 * (float)(t - s);
                pl[j * 8 + hd] = lgv; mx[hd] = fmaxf(mx[hd], lgv);
            }
        }
    }
#pragma unroll
    for (int hd = 0; hd < 8; ++hd) mx[hd] = wave_max(mx[hd]);
    asm volatile("s_waitcnt lgkmcnt(0)" ::: "memory");
    float sm[8];
#pragma unroll
    for (int hd = 0; hd < 8; ++hd) sm[hd] = 0.f;
#pragma unroll 1
    for (int i = 0; i < 4; ++i) {
        const int j = lane + 64 * i;
        if (j < nsel) {
#pragma unroll
            for (int hd = 0; hd < 8; ++hd) { const float p = exp2f(pl[j * 8 + hd] - mx[hd]); pl[j * 8 + hd] = p; sm[hd] += p; }
        }
    }
#pragma unroll
    for (int hd = 0; hd < 8; ++hd) sm[hd] = 1.f / wave_sum(sm[hd]);
    asm volatile("s_waitcnt lgkmcnt(0)" ::: "memory");
    float acc[8];
#pragma unroll
    for (int hd = 0; hd < 8; ++hd) acc[hd] = 0.f;
    const bf16* vb = PROJ + (size_t)b * SEQ * PW + C_AV + lane;
#pragma unroll 4
    for (int j = 0; j < nsel; ++j) {
        const int s = lst[j]; const float v = bf2f(vb[(size_t)s * PW]);
        const f32x4 p0 = *(const LAS f32x4*)(pl + j * 8), p1 = *(const LAS f32x4*)(pl + j * 8 + 4);
        acc[0] += p0.x * v; acc[1] += p0.y * v; acc[2] += p0.z * v; acc[3] += p0.w * v; acc[4] += p1.x * v; acc[5] += p1.y * v; acc[6] += p1.z * v; acc[7] += p1.w * v;
    }
#pragma unroll
    for (int hd = 0; hd < 8; ++hd) acc[hd] *= sm[hd];
#pragma unroll
    for (int hd = 0; hd < 8; ++hd) YM[row * DM + hd * 64 + lane] = (bf16)f2bf(acc[hd]);
}

struct LnRaw { f32x4 x[4]; v2u ya[4]; v2u yb[4]; v2u hx[4]; };
template <bool ROUTE, int YMODE, int XMODE>
__device__ __forceinline__ void ph_ln(Ctx& C, const float* Xin, int l, int which, int mod_g, int mod_l2, int mod_sh, bool write_h, int jmoe, int mod_in, bool write_x) {
    const int gw = C.bid * 8 + C.wave, NGW = C.G * 8, lane = C.lane;
    const float* MOD = (const float*)(C.ws + WS_MOD); bf16* H = (bf16*)(C.ws + WS_H); const bf16* Y = (const bf16*)(C.ws + WS_Y);
    const float* lng = C.in(I_LNG) + (size_t)(l * 2 + which) * DM; const float* lnb = C.in(I_LNB) + (size_t)(l * 2 + which) * DM;
    const int* TOKSLOT = (const int*)(C.ws + WS_TOKSLOT);
    const float* wr = C.in(I_WR) + (size_t)jmoe * DM * NEXP; const float* br = C.in(I_BR) + jmoe * NEXP;
    int* TOPE = (int*)(C.ws + WS_TOPE); float* TOPG = (float*)(C.ws + WS_TOPG);
    unsigned ecnt[8];
#pragma unroll
    for (int e = 0; e < 8; ++e) ecnt[e] = 0u;
    LAS float* wrs = (LAS float*)C.lds;
    if (ROUTE) { for (int i = C.tid; i < DM * NEXP / 4; i += 512) ((LAS f32x4*)wrs)[i] = ((const f32x4*)wr)[i]; __syncthreads(); }
    const int RPW = (MTOK + NGW - 1) / NGW;
    const int r0 = gw * RPW, r1 = (r0 + RPW < MTOK) ? r0 + RPW : MTOK;
    if (r0 < MTOK) {
        const int b = r0 >> 12;
        const bool one_batch = ((r1 - 1) >> 12) == b;
        const float* mg = MOD + ((size_t)l * 16 + b) * 6144 + mod_g;
        const float* mi = MOD + ((size_t)l * 16 + b) * 6144 + mod_in;
        const float* ms = MOD + ((size_t)mod_l2 * 16 + b) * 6144 + mod_sh;
        f32x4 gv[4], shi[4], sci[4];
#pragma unroll
        for (int j = 0; j < 4; ++j) { const int col = 4 * lane + 256 * j; gv[j] = *(const f32x4*)(mg + col);
            if (XMODE == 1) { shi[j] = *(const f32x4*)(mi + col); const f32x4 sc_ = *(const f32x4*)(mi + 1024 + col); sci[j].x = 1.f / (sc_.x + 1.f); sci[j].y = 1.f / (sc_.y + 1.f); sci[j].z = 1.f / (sc_.z + 1.f); sci[j].w = 1.f / (sc_.w + 1.f); } }
        f32x4 Av[4], Bv[4];
#pragma unroll
        for (int j = 0; j < 4; ++j) { const int col = 4 * lane + 256 * j; const f32x4 gn = *(const f32x4*)(lng + col), bn = *(const f32x4*)(lnb + col);
            if (write_h) { const f32x4 sh = *(const f32x4*)(ms + col), sc = *(const f32x4*)(ms + 1024 + col); Av[j] = gn * (sc + 1.f); Bv[j] = bn * (sc + 1.f) + sh; } else { Av[j] = gn; Bv[j] = bn; } }
        int sl0 = 0, sl1 = 0;
        if (YMODE == 1 && r0 + lane < r1) { sl0 = TOKSLOT[2 * (r0 + lane)]; sl1 = TOKSLOT[2 * (r0 + lane) + 1]; }
#define LN_LOAD(R, row_) { const int s0_ = (YMODE == 1) ? (((row_) - r0 < 64) ? __builtin_amdgcn_readlane(sl0, (row_) - r0) : TOKSLOT[2 * (row_)]) : 0, s1_ = (YMODE == 1) ? (((row_) - r0 < 64) ? __builtin_amdgcn_readlane(sl1, (row_) - r0) : TOKSLOT[2 * (row_) + 1]) : 0; \
        const bf16* y0_ = (YMODE == 0) ? Y + (size_t)(row_) * DM : Y + (size_t)s0_ * DM; const bf16* y1_ = Y + (size_t)s1_ * DM; \
        _Pragma("unroll") for (int j = 0; j < 4; ++j) { const int col = 4 * lane + 256 * j; \
            if (XMODE == 0) R.x[j] = *(const f32x4*)(Xin + (size_t)(row_) * DM + col); else R.hx[j] = *(const v2u*)(H + (size_t)(row_) * DM + col); \
            R.ya[j] = *(const v2u*)(y0_ + col); if (YMODE == 1) R.yb[j] = *(const v2u*)(y1_ + col); } }
        LnRaw cur, nx1, nx2;
        LN_LOAD(cur, r0)
        if (r0 + 1 < r1) LN_LOAD(nx1, r0 + 1)
        for (int row = r0; row < r1; ++row) {
            if (ROUTE) asm volatile("" ::: "memory");
            if (row + 2 < r1) LN_LOAD(nx2, row + 2)
            if (!one_batch) {
                const int bb = row >> 12; const float* mg2 = MOD + ((size_t)l * 16 + bb) * 6144 + mod_g; const float* mi2 = MOD + ((size_t)l * 16 + bb) * 6144 + mod_in;
#pragma unroll
                for (int j = 0; j < 4; ++j) { const int col = 4 * lane + 256 * j; gv[j] = *(const f32x4*)(mg2 + col);
                    if (XMODE == 1) { shi[j] = *(const f32x4*)(mi2 + col); const f32x4 sc_ = *(const f32x4*)(mi2 + 1024 + col); sci[j].x = 1.f / (sc_.x + 1.f); sci[j].y = 1.f / (sc_.y + 1.f); sci[j].z = 1.f / (sc_.z + 1.f); sci[j].w = 1.f / (sc_.w + 1.f); } }
            }
            if (!one_batch) {
                const float* msr = MOD + ((size_t)mod_l2 * 16 + (row >> 12)) * 6144 + mod_sh;
#pragma unroll
                for (int j = 0; j < 4; ++j) { const int col = 4 * lane + 256 * j; const f32x4 gn = *(const f32x4*)(lng + col), bn = *(const f32x4*)(lnb + col);
                    if (write_h) { const f32x4 sh = *(const f32x4*)(msr + col), sc = *(const f32x4*)(msr + 1024 + col); Av[j] = gn * (sc + 1.f); Bv[j] = bn * (sc + 1.f) + sh; } else { Av[j] = gn; Bv[j] = bn; } }
            }
            f32x4 v[4]; float s = 0.f;
#pragma unroll
            for (int j = 0; j < 4; ++j) {
                const v2u ya = cur.ya[j];
                f32x4 y; y.x = bf2f(ya.x & 0xffffu); y.y = bf2f(ya.x >> 16); y.z = bf2f(ya.y & 0xffffu); y.w = bf2f(ya.y >> 16);
                if (YMODE == 1) { const v2u yb = cur.yb[j]; y.x += bf2f(yb.x & 0xffffu); y.y += bf2f(yb.x >> 16); y.z += bf2f(yb.y & 0xffffu); y.w += bf2f(yb.y >> 16); }
                f32x4 xr;
                if (XMODE == 0) xr = cur.x[j];
                else { const v2u hh_ = cur.hx[j]; f32x4 hf; hf.x = bf2f(hh_.x & 0xffffu); hf.y = bf2f(hh_.x >> 16); hf.z = bf2f(hh_.y & 0xffffu); hf.w = bf2f(hh_.y >> 16);
                       xr = (hf - shi[j]) * sci[j]; }
                v[j] = xr * DN_ALPHA + (gv[j] + 1.f) * y;
                s += (v[j].x + v[j].y) + (v[j].z + v[j].w);
            }
            const float mean = wave_sum_f(s) * (1.f / DM); float s2 = 0.f;
#pragma unroll
            for (int j = 0; j < 4; ++j) { v[j] = v[j] - mean; s2 += (v[j].x * v[j].x + v[j].y * v[j].y) + (v[j].z * v[j].z + v[j].w * v[j].w); }
            const float rstd = rsqrtf(wave_sum_f(s2) * (1.f / DM) + LN_EPS);
            float lgt[8];
#pragma unroll
            for (int e = 0; e < 8; ++e) lgt[e] = 0.f;
#pragma unroll
            for (int j = 0; j < 4; ++j) {
                const int col = 4 * lane + 256 * j;
                const f32x4 hv = v[j] * rstd * Av[j] + Bv[j];
                if (write_x) *(f32x4*)(C.out + (size_t)row * DM + col) = hv;
                if (write_h) {
                    v2u o; o.x = pk2(hv.x, hv.y); o.y = pk2(hv.z, hv.w);
                    *(v2u*)(H + (size_t)row * DM + col) = o;
                    if (ROUTE) {
                        const float hx[4] = {hv.x, hv.y, hv.z, hv.w};
#pragma unroll
                        for (int c = 0; c < 4; ++c) { const f32x4 w0 = *(const LAS f32x4*)(wrs + (col + c) * NEXP), w1 = *(const LAS f32x4*)(wrs + (col + c) * NEXP + 4);
                            lgt[0] += hx[c] * w0.x; lgt[1] += hx[c] * w0.y; lgt[2] += hx[c] * w0.z; lgt[3] += hx[c] * w0.w;
                            lgt[4] += hx[c] * w1.x; lgt[5] += hx[c] * w1.y; lgt[6] += hx[c] * w1.z; lgt[7] += hx[c] * w1.w; }
                    }
                }
            }
            if (ROUTE) {
#pragma unroll
                for (int e = 0; e < 8; ++e) lgt[e] = wave_sum_f(lgt[e]) + br[e];
                int e0 = 0; float v0 = lgt[0];
#pragma unroll
                for (int e = 1; e < 8; ++e) if (lgt[e] > v0) { v0 = lgt[e]; e0 = e; }
                int e1 = -1; float v1 = -3.0e38f;
#pragma unroll
                for (int e = 0; e < 8; ++e) if (e != e0 && lgt[e] > v1) { v1 = lgt[e]; e1 = e; }
                const float g1 = 1.f / (1.f + expf(v0 - v1)), g0 = 1.f - g1;
                if (lane == 0) { TOPE[2 * row] = e0; TOPE[2 * row + 1] = e1; TOPG[2 * row] = g0; TOPG[2 * row + 1] = g1; }
#pragma unroll
                for (int e = 0; e < 8; ++e) ecnt[e] += (e == e0 ? 1u : 0u) + (e == e1 ? 1u : 0u);
            }
            cur = nx1; nx1 = nx2;
        }
#undef LN_LOAD
    }
    if (ROUTE) {
        unsigned mine = 0u;
#pragma unroll
        for (int e = 0; e < 8; ++e) mine = (lane == e) ? ecnt[e] : mine;
        if (lane < 8 && mine) __hip_atomic_fetch_add(C.ctl + CW_CNT + 64 * jmoe + lane, mine, __ATOMIC_RELAXED, __HIP_MEMORY_SCOPE_AGENT);
    }
}

struct MoeTab { int pend[8]; int npanels; };
__device__ __forceinline__ MoeTab moe_tab(Ctx& C, int jmoe) {
    MoeTab t; int acc = 0;
#pragma unroll
    for (int e = 0; e < 8; ++e) { const int c = (int)__hip_atomic_load(C.ctl + CW_CNT + 64 * jmoe + e, __ATOMIC_RELAXED, __HIP_MEMORY_SCOPE_AGENT); acc += (c + 255) & ~255; t.pend[e] = acc; }
    t.npanels = acc >> 8; return t;
}
__device__ __forceinline__ int panel_expert(const MoeTab& t, int p) {
    int e = 0;
#pragma unroll
    for (int k = 0; k < 7; ++k) e += (p * 256 >= t.pend[k]) ? 1 : 0;
    return e;
}
__device__ __forceinline__ void ph_assign(Ctx& C, int jmoe) {
    const int gw = C.bid * 8 + C.wave, NGW = C.G * 8, lane = C.lane;
    const MoeTab tb = moe_tab(C, jmoe);
    const int* TOPE = (const int*)(C.ws + WS_TOPE); const float* TOPG = (const float*)(C.ws + WS_TOPG);
    int* TOKSLOT = (int*)(C.ws + WS_TOKSLOT); int* ROWTOK = (int*)(C.ws + WS_ROWTOK); float* ROWGATE = (float*)(C.ws + WS_ROWGATE);
    const bf16* H = (const bf16*)(C.ws + WS_H); bf16* HS = (bf16*)(C.ws + WS_Y);
    const unsigned long long ltmask = (lane == 0) ? 0ull : (~0ull >> (64 - lane));
    for (int tk0 = gw * 32; tk0 < MTOK; tk0 += NGW * 32) {
        const int tok = tk0 + (lane & 31); const bool act = lane < 32;
        const int e0 = act ? TOPE[2 * tok] : -1, e1 = act ? TOPE[2 * tok + 1] : -1; const float g0 = TOPG[2 * tok], g1 = TOPG[2 * tok + 1];
        int s0 = 0, s1 = 0;
#pragma unroll
        for (int e = 0; e < 8; ++e) {
            const unsigned long long m0 = __ballot(e0 == e), m1 = __ballot(e1 == e); const int n0 = __popcll(m0), n1 = __popcll(m1);
            int basev = 0;
            if (lane == 0 && (n0 + n1) > 0) basev = (int)__hip_atomic_fetch_add(C.ctl + CW_FILL + 64 * jmoe + e, (unsigned)(n0 + n1), __ATOMIC_RELAXED, __HIP_MEMORY_SCOPE_AGENT);
            basev = __builtin_amdgcn_readfirstlane(basev);
            const int pstart = (e == 0) ? 0 : tb.pend[e > 0 ? e - 1 : 0];
            if (e0 == e) s0 = pstart + basev + __popcll(m0 & ltmask);
            if (e1 == e) s1 = pstart + basev + n0 + __popcll(m1 & ltmask);
        }
        if (act) { TOKSLOT[2 * tok] = s0; TOKSLOT[2 * tok + 1] = s1;
            ROWTOK[s0] = tok; ROWGATE[s0] = g0; ROWTOK[s1] = tok; ROWGATE[s1] = g1; }
#pragma unroll 8
        for (int tt = 0; tt < 32; ++tt) {
            const int d0 = __builtin_amdgcn_readlane(s0, tt), d1 = __builtin_amdgcn_readlane(s1, tt);
            const v4u* src = (const v4u*)(H + (size_t)(tk0 + tt) * DM);
            const v4u a = src[lane], b2 = src[64 + lane];
            v4u* o0 = (v4u*)(HS + (size_t)d0 * DM); v4u* o1 = (v4u*)(HS + (size_t)d1 * DM);
            o0[lane] = a; o0[64 + lane] = b2; o1[lane] = a; o1[64 + lane] = b2;
        }
    }
    for (int idx = gw; idx < 8 * 256; idx += NGW) {
        const int e = idx >> 8, jj = idx & 255;
        const int c = (int)__hip_atomic_load(C.ctl + CW_CNT + 64 * jmoe + e, __ATOMIC_RELAXED, __HIP_MEMORY_SCOPE_AGENT);
        int pstart = 0;
#pragma unroll
        for (int k = 0; k < 7; ++k) if (k < e) pstart = tb.pend[k];
        const int slot = pstart + c + jj;
        if (c + jj < ((c + 255) & ~255)) {
            if (lane == 0) { ROWTOK[slot] = 0; ROWGATE[slot] = 0.f; }
            v4u* o = (v4u*)(HS + (size_t)slot * DM); const v4u z = {0u, 0u, 0u, 0u}; o[lane] = z; o[64 + lane] = z;
        }
    }
}

__device__ __forceinline__ float silu_fast_(float v) { return v * __builtin_amdgcn_rcpf(1.f + __builtin_amdgcn_exp2f(-v * LOG2E)); }
constexpr size_t WS_GLA_LT = WS_Y;
constexpr size_t WS_GLA_SP = WS_Y + 130 * MiB;
constexpr size_t WS_GLA_EB = WS_Y + 128 * MiB;
constexpr int GLA_PITCH = 72;

struct GlaDecay { float b[8]; float Btot; float qv[8]; float kv[8]; };
__device__ __forceinline__ void gla_decay(Ctx& C, int l, int b, int hh, int c, LAS float* segs, GlaDecay& D) {
    const bf16* PROJ = (const bf16*)(C.ws + WS_P);
    const float* w_a2 = C.in(I_WA2) + (size_t)l * 16 * 256 + hh * 64 + C.lane; const float bias = C.in(I_BA)[l * 256 + hh * 64 + C.lane];
    float w[16];
#pragma unroll
    for (int r = 0; r < 16; ++r) w[r] = w_a2[r * 256];
    const size_t row0 = (size_t)b * SEQ + c * 64 + 8 * C.wave;
    LAS unsigned* baS = (LAS unsigned*)(C.lds + 36864) + C.wave * 64;
    baS[C.lane] = *(const unsigned*)(PROJ + (row0 + (C.lane >> 3)) * PW + C_BA + 2 * (C.lane & 7));
    float qraw[8], kraw[8];
#pragma unroll
    for (int i = 0; i < 8; ++i) { const bf16* pr = PROJ + (row0 + i) * PW; qraw[i] = bf2f(pr[C_BQ + hh * 64 + C.lane]); kraw[i] = bf2f(pr[C_BK + hh * 64 + C.lane]); }
    asm volatile("s_waitcnt lgkmcnt(0)" ::: "memory");
    float run = 0.f;
#pragma unroll
    for (int i = 0; i < 8; ++i) {
        const v4u ba0 = *(const LAS v4u*)(baS + 8 * i), ba1 = *(const LAS v4u*)(baS + 8 * i + 4);
        const unsigned bw[8] = {ba0.x, ba0.y, ba0.z, ba0.w, ba1.x, ba1.y, ba1.z, ba1.w};
        float z = bias;
#pragma unroll
        for (int r = 0; r < 8; ++r) { z += bf2f(bw[r] & 0xffffu) * w[2 * r]; z += bf2f(bw[r] >> 16) * w[2 * r + 1]; }
        const float ls = fminf(z, 0.f) - __logf(1.f + __expf(-fabsf(z)));
        run += ls * (1.f / 16.f);
        D.b[i] = run;
        D.qv[i] = qraw[i]; D.kv[i] = kraw[i];
    }
    segs[C.wave * 64 + C.lane] = run;
    __syncthreads();
    float off = 0.f, tot = 0.f;
#pragma unroll
    for (int w8 = 0; w8 < 8; ++w8) { const float sv = segs[w8 * 64 + C.lane]; tot += sv; off += (w8 < C.wave) ? sv : 0.f; }
#pragma unroll
    for (int i = 0; i < 8; ++i) D.b[i] += off;
    D.Btot = tot;
}
__device__ __forceinline__ bf16x8 gla_vt_frag(const bf16* vcol, int ks, int h) {
    unsigned short x[8];
#pragma unroll
    for (int j = 0; j < 8; ++j) x[j] = vcol[(size_t)(16 * ks + 8 * (j >> 2) + 4 * h + (j & 3)) * PW];
    v4u p; p.x = (unsigned)x[0] | ((unsigned)x[1] << 16); p.y = (unsigned)x[2] | ((unsigned)x[3] << 16); p.z = (unsigned)x[4] | ((unsigned)x[5] << 16); p.w = (unsigned)x[6] | ((unsigned)x[7] << 16);
    return __builtin_bit_cast(bf16x8, p);
}

__device__ __forceinline__ void ph_gla1_unit(Ctx& C, int l, int unit) {
    const int c = unit & 63, hh = (unit >> 6) & 3, b = unit >> 8;
    LAS bf16* KDT = (LAS bf16*)C.lds;
    LAS float* segs = (LAS float*)(C.lds + 32768);
    const bf16* PROJ = (const bf16*)(C.ws + WS_P);
    const int mt = C.wave >> 1, nd = C.wave & 1, n = C.lane & 31, h = C.lane >> 5;
    const bf16* vcol = PROJ + ((size_t)b * SEQ + c * 64) * PW + C_BV + hh * 128 + 32 * mt + n;
    bf16x8 vf[4];
#pragma unroll
    for (int ks = 0; ks < 4; ++ks) vf[ks] = gla_vt_frag(vcol, ks, h);
    GlaDecay D; gla_decay(C, l, b, hh, c, segs, D);
    {
        v4u p;
        p.x = pk2(D.kv[0] * __expf(D.Btot - D.b[0]), D.kv[1] * __expf(D.Btot - D.b[1])); p.y = pk2(D.kv[2] * __expf(D.Btot - D.b[2]), D.kv[3] * __expf(D.Btot - D.b[3]));
        p.z = pk2(D.kv[4] * __expf(D.Btot - D.b[4]), D.kv[5] * __expf(D.Btot - D.b[5])); p.w = pk2(D.kv[6] * __expf(D.Btot - D.b[6]), D.kv[7] * __expf(D.Btot - D.b[7]));
        *(LAS v4u*)(KDT + C.lane * GLA_PITCH + 8 * C.wave) = p;
        if (C.wave == 0) ((float*)(C.ws + WS_GLA_EB))[(size_t)unit * 64 + C.lane] = __expf(D.Btot);
    }
    __syncthreads();
    f32x16 acc;
#pragma unroll
    for (int i = 0; i < 16; ++i) acc[i] = 0.f;
#pragma unroll
    for (int ks = 0; ks < 4; ++ks) {
        const LAS bf16* kp = KDT + (32 * nd + n) * GLA_PITCH + 16 * ks + 4 * h;
        const v2u k0 = *(const LAS v2u*)kp, k1 = *(const LAS v2u*)(kp + 8);
        v4u kk; kk.x = k0.x; kk.y = k0.y; kk.z = k1.x; kk.w = k1.y;
        acc = mfma32(vf[ks], __builtin_bit_cast(bf16x8, kk), acc);
    }
    float* LT = (float*)(C.ws + WS_GLA_LT) + (size_t)unit * 8192;
#pragma unroll
    for (int r = 0; r < 16; ++r) LT[(32 * mt + (r & 3) + 8 * (r >> 2) + 4 * h) * 64 + 32 * nd + n] = acc[r];
    __syncthreads();
}

__device__ __forceinline__ void ph_gla2(Ctx& C, size_t probe_off = 0) {
    const f32x4* LT = (const f32x4*)(C.ws + WS_GLA_LT); v2u* SP = (v2u*)(C.ws + WS_GLA_SP + probe_off); const float* EB = (const float*)(C.ws + WS_GLA_EB);
    for (int it = C.bid; it < 64 * 4; it += C.G) {
        const int bh = it >> 2, idx = (it & 3) * 512 + C.tid;
        const f32x4* p = LT + (size_t)bh * 64 * 2048 + idx; v2u* q = SP + (size_t)bh * 64 * 2048 + idx; const float* eb = EB + (size_t)bh * 64 * 64 + ((4 * idx) & 63);
        float S0 = 0.f, S1 = 0.f, S2 = 0.f, S3 = 0.f;
#pragma unroll 16
        for (int c = 0; c < 64; ++c) { const f32x4 lv = p[(size_t)c * 2048]; const f32x4 e = *(const f32x4*)(eb + c * 64);
            v2u o; o.x = pk2(S0, S1); o.y = pk2(S2, S3); q[(size_t)c * 2048] = o;
            S0 = e.x * S0 + lv.x; S1 = e.y * S1 + lv.y; S2 = e.z * S2 + lv.z; S3 = e.w * S3 + lv.w; }
    }
}

__device__ __forceinline__ void ph_gla3_unit(Ctx& C, int l, int unit) {
    const int c = unit & 63, hh = (unit >> 6) & 3, b = unit >> 8;
    LAS bf16* QE = (LAS bf16*)C.lds;
    LAS bf16* KE = QE + 64 * GLA_PITCH;
    LAS float* segs = (LAS float*)(C.lds + 32768);
    LAS float* ssq = (LAS float*)(C.lds + 32768 + 2048);
    const bf16* PROJ = (const bf16*)(C.ws + WS_P); bf16* YM = (bf16*)C.out;
    const int mt = C.wave >> 1, nt = C.wave & 1, n = C.lane & 31, h = C.lane >> 5;
    const size_t row0 = (size_t)b * SEQ + c * 64;
    const bf16* vcol = PROJ + row0 * PW + C_BV + hh * 128 + 32 * mt + n;
    bf16x8 vf[4]; bf16x8 spf[4]; v2u gb[4]; f32x4 gnv[4];
#pragma unroll
    for (int ks = 0; ks < 4; ++ks) vf[ks] = gla_vt_frag(vcol, (ks <= 2 * nt + 1) ? ks : 0, h);
    {
        const bf16* Sp = (const bf16*)(C.ws + WS_GLA_SP) + (size_t)unit * 8192 + (size_t)(32 * mt + n) * 64 + 8 * h;
#pragma unroll
        for (int ks = 0; ks < 4; ++ks) spf[ks] = *(const bf16x8*)(Sp + 16 * ks);
#pragma unroll
        for (int j4 = 0; j4 < 4; ++j4) { gb[j4] = *(const v2u*)(PROJ + (row0 + 32 * nt + n) * PW + C_BG + hh * 128 + 32 * mt + 8 * j4 + 4 * h); gnv[j4] = *(const f32x4*)(C.in(I_GLAG) + l * 128 + 32 * mt + 8 * j4 + 4 * h); }
    }
    GlaDecay D; gla_decay(C, l, b, hh, c, segs, D);
#pragma unroll
    for (int i = 0; i < 8; ++i) {
        QE[(8 * C.wave + i) * GLA_PITCH + C.lane] = (bf16)f2bf(D.qv[i] * 0.125f * __expf(D.b[i]));
        KE[(8 * C.wave + i) * GLA_PITCH + C.lane] = (bf16)f2bf(D.kv[i] * __expf(-D.b[i]));
    }
    __syncthreads();
    bf16x8 qf[4];
#pragma unroll
    for (int ks = 0; ks < 4; ++ks) qf[ks] = *(const LAS bf16x8*)(QE + (32 * nt + n) * GLA_PITCH + 16 * ks + 8 * h);
    f32x16 accO;
#pragma unroll
    for (int i = 0; i < 16; ++i) accO[i] = 0.f;
#pragma unroll
    for (int ms = 0; ms < 2; ++ms) {
        if (ms <= nt) {
            f32x16 aT;
#pragma unroll
            for (int i = 0; i < 16; ++i) aT[i] = 0.f;
#pragma unroll
            for (int ks = 0; ks < 4; ++ks) { const bf16x8 kf = *(const LAS bf16x8*)(KE + (32 * ms + n) * GLA_PITCH + 16 * ks + 8 * h); aT = mfma32(kf, qf[ks], aT); }
            if (ms == nt) {
#pragma unroll
                for (int r = 0; r < 16; ++r) { const int s = (r & 3) + 8 * (r >> 2) + 4 * h; aT[r] = (s <= n) ? aT[r] : 0.f; }
            }
#pragma unroll
            for (int s2 = 0; s2 < 2; ++s2) {
                v4u pa; pa.x = pk2(aT[8 * s2 + 0], aT[8 * s2 + 1]); pa.y = pk2(aT[8 * s2 + 2], aT[8 * s2 + 3]); pa.z = pk2(aT[8 * s2 + 4], aT[8 * s2 + 5]); pa.w = pk2(aT[8 * s2 + 6], aT[8 * s2 + 7]);
                accO = mfma32(vf[2 * ms + s2], __builtin_bit_cast(bf16x8, pa), accO);
            }
        }
    }
    {
#pragma unroll
        for (int ks = 0; ks < 4; ++ks) accO = mfma32(spf[ks], qf[ks], accO);
    }
    float sq = 0.f;
#pragma unroll
    for (int r = 0; r < 16; ++r) sq += accO[r] * accO[r];
    sq += SHX_F(sq, 32, C.lane);
    if (h == 0) ssq[mt * 64 + 32 * nt + n] = sq;
    __syncthreads();
    const float rstd = rsqrtf(((ssq[32 * nt + n] + ssq[64 + 32 * nt + n]) + (ssq[128 + 32 * nt + n] + ssq[192 + 32 * nt + n])) * (1.f / 128.f) + LN_EPS);
    const size_t row = row0 + 32 * nt + n;
#pragma unroll
    for (int j4 = 0; j4 < 4; ++j4) {
        const int e0 = 32 * mt + 8 * j4 + 4 * h;
        const v2u gbv = gb[j4]; const f32x4 gn = gnv[j4];
        const float y0 = accO[4 * j4 + 0] * rstd * gn.x * silu_fast_(bf2f(gbv.x & 0xffffu)), y1 = accO[4 * j4 + 1] * rstd * gn.y * silu_fast_(bf2f(gbv.x >> 16));
        const float y2 = accO[4 * j4 + 2] * rstd * gn.z * silu_fast_(bf2f(gbv.y & 0xffffu)), y3 = accO[4 * j4 + 3] * rstd * gn.w * silu_fast_(bf2f(gbv.y >> 16));
        v2u o; o.x = pk2(y0, y1); o.y = pk2(y2, y3);
        *(v2u*)(YM + row * DM + 512 + hh * 128 + e0) = o;
    }
    __syncthreads();
}

#ifndef A3_VPATH
#define A3_VPATH(i) (true)
#endif
#ifndef REP_S
#define REP_S 1
#endif
constexpr size_t WS_KFI = 932 * MiB, WS_KFA = 940 * MiB, WS_VF = 948 * MiB;

__device__ __forceinline__ void ph_dsa_a2_unit(Ctx& C, int b, int t0) {
    LAS unsigned* cnt = (LAS unsigned*)(C.lds + 131072);
    const bf16* PROJ = (const bf16*)(C.ws + WS_P); unsigned* SEL = (unsigned*)(C.ws + WS_SEL); const bf16* KFI = (const bf16*)(C.ws + WS_KFI);
    const int lane = C.lane, n = lane & 31, h = lane >> 5, tid = C.tid, wave = C.wave;
    const int nk = t0 + 8, ntile = (nk + 31) >> 5;
    if (tid < 48) cnt[tid] = 0u;
    unsigned u[16][4];
    {
        bf16x8 af[2][4]; float wv[2][2][8];
        const int jq = 2 * ((n >> 4) & 1) + ((n >> 2) & 1), hd = 4 * ((n >> 3) & 1) + (n & 3);
#pragma unroll
        for (int mt = 0; mt < 2; ++mt) {
            const bf16* p = PROJ + (size_t)(b * SEQ + t0 + 4 * mt + jq) * PW + C_IQ + hd * 64 + 8 * h;
#pragma unroll
            for (int ks = 0; ks < 4; ++ks) af[mt][ks] = *(const bf16x8*)(p + ks * 16);
#pragma unroll
            for (int g = 0; g < 2; ++g) {
                const v4u w4 = *(const v4u*)(PROJ + (size_t)(b * SEQ + t0 + 4 * mt + 2 * g + h) * PW + C_IW); const unsigned ww[4] = {w4.x, w4.y, w4.z, w4.w};
#pragma unroll
                for (int x = 0; x < 4; ++x) { wv[mt][g][2 * x] = bf2f(ww[x] & 0xffffu) * (0.35355339059327373f * 0.125f); wv[mt][g][2 * x + 1] = bf2f(ww[x] >> 16) * (0.35355339059327373f * 0.125f); }
            }
        }
        const bf16* kbase = KFI + (size_t)(b * 128) * 2048 + lane * 8;
#pragma unroll
        for (int i = 0; i < 16; ++i) {
            const int tile = wave + 8 * i;
#pragma unroll
            for (int k = 0; k < 4; ++k) u[i][k] = 0u;
            if (tile < ntile) {
                bf16x8 bcur[4];
#pragma unroll
                for (int ks = 0; ks < 4; ++ks) bcur[ks] = *(const bf16x8*)(kbase + (size_t)tile * 2048 + ks * 512);
                const int s = tile * 32 + n;
#pragma unroll
                for (int mt = 0; mt < 2; ++mt) {
                    f32x16 acc;
#pragma unroll
                    for (int x = 0; x < 16; ++x) acc[x] = 0.f;
#pragma unroll
                    for (int ks = 0; ks < 4; ++ks) acc = mfma32(af[mt][ks], bcur[ks], acc);
#pragma unroll
                    for (int g = 0; g < 2; ++g) {
                        float p = 0.f;
#pragma unroll
                        for (int x = 0; x < 8; ++x) p += wv[mt][g][x] * fmaxf(acc[8 * g + x], 0.f);
                        const int t = t0 + 4 * mt + 2 * g + h;
                        u[i][2 * mt + g] = (s <= t) ? sortable_u32(p) : 0u;
                    }
                }
            }
            __builtin_amdgcn_sched_barrier(0);
        }
    }
    __syncthreads();
    unsigned Tl[4], Jl[4], needl[4];
#pragma unroll
    for (int k = 0; k < 4; ++k) { Tl[k] = 0u; Jl[k] = 8192u; needl[k] = 0u; }
    int buf = 0;
#define DSA_COUNT(PRED) \
        _Pragma("unroll") for (int i = 0; i < 16; ++i) if (wave + 8 * i < ntile) { const unsigned s = (unsigned)((wave + 8 * i) * 32 + n); (void)s; \
            _Pragma("unroll") for (int k = 0; k < 4; ++k) { const unsigned uu = u[i][k]; const unsigned long long bm = __ballot(PRED); cq[2 * k] += (unsigned)__popc((unsigned)bm); cq[2 * k + 1] += (unsigned)__popc((unsigned)(bm >> 32)); } __builtin_amdgcn_sched_barrier(0); }
#define DSA_PUBLISH(NW) { unsigned myc = 0u; \
        _Pragma("unroll") for (int q = 0; q < NW; ++q) myc = (lane == q) ? cq[q] : myc; \
        if (lane < NW) __hip_atomic_fetch_add(cnt + buf * 16 + lane, myc, __ATOMIC_RELAXED, __HIP_MEMORY_SCOPE_WORKGROUP); \
        nb = (buf == 2) ? 0 : buf + 1; if (tid >= 64 && tid < 80) cnt[nb * 16 + (tid - 64)] = 0u; __syncthreads(); }
#pragma unroll 1
    for (int bit = 31; bit >= 0; --bit) {
        unsigned cq[8]; int nb;
#pragma unroll
        for (int q = 0; q < 8; ++q) cq[q] = 0u;
        unsigned cl[4];
#pragma unroll
        for (int k = 0; k < 4; ++k) cl[k] = Tl[k] | (1u << bit);
        DSA_COUNT(uu >= cl[k])
        DSA_PUBLISH(8)
#pragma unroll
        for (int k = 0; k < 4; ++k) if (cnt[buf * 16 + 2 * k + h] >= 256u) Tl[k] = cl[k];
        buf = nb;
    }
#pragma unroll
    for (int k = 0; k < 4; ++k) Tl[k] = Tl[k] < 1u ? 1u : Tl[k];
    bool extra = false;
    {
        unsigned cq[16]; int nb;
#pragma unroll
        for (int q = 0; q < 16; ++q) cq[q] = 0u;
#pragma unroll
        for (int i = 0; i < 16; ++i) if (wave + 8 * i < ntile) {
#pragma unroll
            for (int k = 0; k < 4; ++k) { const unsigned uu = u[i][k];
                const unsigned long long bg = __ballot(uu > Tl[k]), be = __ballot(uu >= Tl[k]);
                cq[2 * k] += (unsigned)__popc((unsigned)bg); cq[2 * k + 1] += (unsigned)__popc((unsigned)(bg >> 32));
                cq[8 + 2 * k] += (unsigned)__popc((unsigned)be); cq[8 + 2 * k + 1] += (unsigned)__popc((unsigned)(be >> 32)); }
            __builtin_amdgcn_sched_barrier(0);
        }
        DSA_PUBLISH(16)
#pragma unroll
        for (int k = 0; k < 4; ++k) { const unsigned g = cnt[buf * 16 + 2 * k + h]; needl[k] = 256u - (g < 256u ? g : 256u); }
#pragma unroll
        for (int q = 0; q < 8; ++q) extra = extra || (cnt[buf * 16 + 8 + q] > 256u);
        buf = nb;
    }
    if (extra) {
#pragma unroll
        for (int k = 0; k < 4; ++k) Jl[k] = 0u;
#pragma unroll 1
        for (int bit = 12; bit >= 0; --bit) {
            unsigned cq[8]; int nb;
#pragma unroll
            for (int q = 0; q < 8; ++q) cq[q] = 0u;
            unsigned jl[4];
#pragma unroll
            for (int k = 0; k < 4; ++k) jl[k] = Jl[k] | (1u << bit);
            DSA_COUNT(uu == Tl[k] && s < jl[k])
            DSA_PUBLISH(8)
#pragma unroll
            for (int k = 0; k < 4; ++k) if (cnt[buf * 16 + 2 * k + h] <= needl[k]) Jl[k] = jl[k];
            buf = nb;
        }
    }
    {
        unsigned wsel[4];
#pragma unroll
        for (int k = 0; k < 4; ++k) wsel[k] = 0u;
#pragma unroll
        for (int i = 0; i < 16; ++i) if (wave + 8 * i < ntile) {
            const unsigned s = (unsigned)((wave + 8 * i) * 32 + n);
#pragma unroll
            for (int k = 0; k < 4; ++k) {
                const unsigned uu = u[i][k];
                const unsigned long long bm = __ballot((uu > Tl[k]) || (uu == Tl[k] && s < Jl[k]));
                const unsigned wd = h ? (unsigned)(bm >> 32) : (unsigned)bm;
                wsel[k] = (n == i) ? wd : wsel[k];
            }
            __builtin_amdgcn_sched_barrier(0);
        }
        const int tile = wave + 8 * n;
        if (n < 16 && tile < ntile) {
#pragma unroll
            for (int k = 0; k < 4; ++k) SEL[(size_t)(b * SEQ + t0 + 2 * k + h) * 128 + tile] = wsel[k];
        }
    }
#undef DSA_COUNT
#undef DSA_PUBLISH
    __syncthreads();
}


constexpr int A3_QP = 64 * 68;
struct A3Q { bf16x8 af[2][4]; v4u wq; };
__device__ __forceinline__ void a3_load_q(Ctx& C, int b, int t0, A3Q& Q) {
    const bf16* PROJ = (const bf16*)(C.ws + WS_P);
    const int n = C.lane & 31, h = C.lane >> 5;
    const int jq = 2 * ((n >> 4) & 1) + ((n >> 2) & 1), hd = 4 * ((n >> 3) & 1) + (n & 3);
#pragma unroll
    for (int mt = 0; mt < 2; ++mt) {
        const bf16* p = PROJ + (size_t)(b * SEQ + t0 + 4 * mt + jq) * PW + C_IQ + hd * 64 + 8 * h;
#pragma unroll
        for (int ks = 0; ks < 4; ++ks) Q.af[mt][ks] = *(const bf16x8*)(p + ks * 16);
    }
    Q.wq = *(const v4u*)(PROJ + (size_t)(b * SEQ + t0 + (n & 7)) * PW + C_IW);
}
__device__ __forceinline__ void ph_dsa_a3_unit(Ctx& C, int b, int t0, A3Q& Q, bool has_next, int nb, int nt0) {
    LAS unsigned* sc = (LAS unsigned*)C.lds;
    const bf16* PROJ = (const bf16*)(C.ws + WS_P); unsigned* SEL = (unsigned*)(C.ws + WS_SEL); const bf16* KFI = (const bf16*)(C.ws + WS_KFI);
    const int lane = C.lane, n = lane & 31, h = lane >> 5, wave = C.wave;
    const int nk = t0 + 8, ntile = (nk + 31) >> 5;
    {
        typedef _Float16 h8_t __attribute__((ext_vector_type(8)));
        typedef _Float16 h2_t __attribute__((ext_vector_type(2)));
        h8_t wf[2][2];
        {
            const unsigned ww[4] = {Q.wq.x, Q.wq.y, Q.wq.z, Q.wq.w}; unsigned wp[4];
#pragma unroll
            for (int x = 0; x < 4; ++x) wp[x] = __builtin_bit_cast(unsigned, __builtin_amdgcn_cvt_pkrtz(bf2f(ww[x] & 0xffffu) * (0.35355339059327373f * 0.125f), bf2f(ww[x] >> 16) * (0.35355339059327373f * 0.125f)));
#pragma unroll
            for (int mt = 0; mt < 2; ++mt)
#pragma unroll
                for (int ks = 0; ks < 2; ++ks) { const bool on = (n < 8) && ((n >> 2) == mt) && ((n & 3) == 2 * ks + h);
                    v4u f; f.x = on ? wp[0] : 0u; f.y = on ? wp[1] : 0u; f.z = on ? wp[2] : 0u; f.w = on ? wp[3] : 0u; wf[mt][ks] = __builtin_bit_cast(h8_t, f); }
        }
        const bf16* kbase = KFI + (size_t)(b * 128) * 2048 + lane * 8;
        bf16x8 kA[4], kB[4];
        { const int ta = wave < ntile ? wave : 0, tb = wave + 8 < ntile ? wave + 8 : ta;
#pragma unroll
          for (int ks = 0; ks < 4; ++ks) { kA[ks] = *(const bf16x8*)(kbase + (size_t)ta * 2048 + ks * 512); kB[ks] = *(const bf16x8*)(kbase + (size_t)tb * 2048 + ks * 512); } }
#define A3_MMA(A0, A1, KF) { const f32x16 z16_ = {0.f, 0.f, 0.f, 0.f, 0.f, 0.f, 0.f, 0.f, 0.f, 0.f, 0.f, 0.f, 0.f, 0.f, 0.f, 0.f}; \
            A0 = mfma32(Q.af[0][0], KF[0], z16_); A1 = mfma32(Q.af[1][0], KF[0], z16_); \
            _Pragma("unroll") for (int ks = 1; ks < 4; ++ks) { A0 = mfma32(Q.af[0][ks], KF[ks], A0); A1 = mfma32(Q.af[1][ks], KF[ks], A1); } }
#define A3_RELU4(A, r0_) ({ v4u f_; const h2_t z2_ = {(_Float16)0.f, (_Float16)0.f}; \
                f_.x = __builtin_bit_cast(unsigned, __builtin_elementwise_max(__builtin_bit_cast(h2_t, __builtin_amdgcn_cvt_pkrtz(A[(r0_)], A[(r0_) + 1])), z2_)); \
                f_.y = __builtin_bit_cast(unsigned, __builtin_elementwise_max(__builtin_bit_cast(h2_t, __builtin_amdgcn_cvt_pkrtz(A[(r0_) + 2], A[(r0_) + 3])), z2_)); \
                f_.z = __builtin_bit_cast(unsigned, __builtin_elementwise_max(__builtin_bit_cast(h2_t, __builtin_amdgcn_cvt_pkrtz(A[(r0_) + 4], A[(r0_) + 5])), z2_)); \
                f_.w = __builtin_bit_cast(unsigned, __builtin_elementwise_max(__builtin_bit_cast(h2_t, __builtin_amdgcn_cvt_pkrtz(A[(r0_) + 6], A[(r0_) + 7])), z2_)); \
                __builtin_bit_cast(h8_t, f_); })
#define A3_EPI(A0, A1, tile_) { const int s = (tile_) * 32 + n; const f32x16 z16e_ = {0.f, 0.f, 0.f, 0.f, 0.f, 0.f, 0.f, 0.f, 0.f, 0.f, 0.f, 0.f, 0.f, 0.f, 0.f, 0.f}; \
            f32x16 P_ = __builtin_amdgcn_mfma_f32_32x32x16_f16(wf[0][0], A3_RELU4(A0, 0), z16e_, 0, 0, 0); P_ = __builtin_amdgcn_mfma_f32_32x32x16_f16(wf[0][1], A3_RELU4(A0, 8), P_, 0, 0, 0); \
            P_ = __builtin_amdgcn_mfma_f32_32x32x16_f16(wf[1][0], A3_RELU4(A1, 0), P_, 0, 0, 0); P_ = __builtin_amdgcn_mfma_f32_32x32x16_f16(wf[1][1], A3_RELU4(A1, 8), P_, 0, 0, 0); \
              \
            _Pragma("unroll") for (int r = 0; r < 4; ++r) { const int q = r + 4 * h; sc[q * A3_QP + (s >> 6) * 68 + (s & 63)] = (s <= t0 + q) ? sortable_u32(P_[r]) : 0u; } }
#define A3_LOADK(KF, tile_) { const int tl_ = ((tile_) < ntile) ? (tile_) : wave; \
            _Pragma("unroll") for (int ks = 0; ks < 4; ++ks) KF[ks] = *(const bf16x8*)(kbase + (size_t)tl_ * 2048 + ks * 512); }
        f32x16 accA0, accA1, accB0, accB1;
        if (wave < ntile) { A3_MMA(accA0, accA1, kA) A3_LOADK(kA, wave + 16) }
#pragma unroll 1
        for (int tile = wave; tile < ntile; tile += 16) {
            if (tile + 8 < ntile) { A3_MMA(accB0, accB1, kB) A3_LOADK(kB, tile + 24) }
            A3_EPI(accA0, accA1, tile)
            if (tile + 8 < ntile) {
                if (tile + 16 < ntile) { A3_MMA(accA0, accA1, kA) A3_LOADK(kA, tile + 32) }
                A3_EPI(accB0, accB1, tile + 8)
            }
        }
#undef A3_LOADK
#undef A3_RELU4
#undef A3_MMA
#undef A3_EPI
    }
    __syncthreads();
    {
        const int q = wave, t = t0 + q;
        const int nval = t + 1 - 64 * lane;
        const unsigned long long vm = nval >= 64 ? ~0ull : (nval > 0 ? ((1ull << nval) - 1ull) : 0ull);
        unsigned long long selm = vm;
        if (t >= 256) {
            unsigned lo[32], hi[32];
            {
                const LAS v4u* gp = (const LAS v4u*)(sc + q * A3_QP + lane * 68);
#pragma unroll
                for (int i = 0; i < 8; ++i) { const v4u a = gp[i], c = gp[8 + i]; lo[4 * i] = a.x; lo[4 * i + 1] = a.y; lo[4 * i + 2] = a.z; lo[4 * i + 3] = a.w; hi[4 * i] = c.x; hi[4 * i + 1] = c.y; hi[4 * i + 2] = c.z; hi[4 * i + 3] = c.w; }
            }
#define A3_TR(X) { \
            _Pragma("unroll") for (int k = 0; k < 32; ++k) if ((k & 16) == 0) { const unsigned a = X[k], c = X[k + 16]; X[k] = __builtin_amdgcn_perm(c, a, 0x05040100u); X[k + 16] = __builtin_amdgcn_perm(c, a, 0x07060302u); } \
            _Pragma("unroll") for (int k = 0; k < 32; ++k) if ((k & 8) == 0) { const unsigned a = X[k], c = X[k + 8]; X[k] = __builtin_amdgcn_perm(c, a, 0x06020400u); X[k + 8] = __builtin_amdgcn_perm(c, a, 0x07030501u); } \
            _Pragma("unroll") for (int st = 2; st < 5; ++st) { const int j = 16 >> st; const unsigned m = st == 2 ? 0x0f0f0f0fu : st == 3 ? 0x33333333u : 0x55555555u; \
                _Pragma("unroll") for (int k = 0; k < 32; ++k) if ((k & j) == 0) { const unsigned a = X[k], c = X[k + j]; X[k] = (a & m) | ((c << j) & ~m); X[k + j] = ((a >> j) & m) | (c & ~m); } } }
            A3_TR(lo) A3_TR(hi)
#undef A3_TR
            unsigned al = (unsigned)vm, ah = (unsigned)(vm >> 32), gl = 0u, gh = 0u, G = 0u;
            bool done = false;
#pragma unroll
            for (int b = 31; b >= 0; --b) {
                if (!done) {
                    const unsigned ol = al & lo[b], oh = ah & hi[b];
                    const unsigned c = G + wave_sum_u32((unsigned)__popc(ol) + (unsigned)__popc(oh));
                    if (c >= 256u) { al = ol; ah = oh; done = (c == 256u); }
                    else { gl |= ol; gh |= oh; G = c; al ^= ol; ah ^= oh; }
                }
            }
            const unsigned ca = (unsigned)__popc(al) + (unsigned)__popc(ah);
            const unsigned tot = wave_sum_u32(ca);
            unsigned long long alive = ((unsigned long long)ah << 32) | al;
            if (G + tot > 256u) {
                int incl = (int)ca;
#pragma unroll
                for (int o = 1; o < 64; o <<= 1) { const int v = SHUP_I(incl, o, lane); if (lane >= o) incl += v; }
                const int before = incl - (int)ca, room = (int)(256u - G) - before;
                int take = room < 0 ? 0 : (room > (int)ca ? (int)ca : room);
                unsigned long long keep = 0ull;
                while (__any(take > 0)) { if (take > 0) { const unsigned long long low = alive & (0ull - alive); keep |= low; alive ^= low; --take; } }
                alive = keep;
            }
            selm = (((unsigned long long)gh << 32) | gl) | alive;
        }
        if (has_next) a3_load_q(C, nb, nt0, Q);
#ifdef SEL_ALL
        *(unsigned long long*)(SEL + (size_t)(b * SEQ + t) * 128 + 2 * lane) = selm;
#else
        if (64 * lane <= t) *(unsigned long long*)(SEL + (size_t)(b * SEQ + t) * 128 + 2 * lane) = selm;
#endif
    }
    __syncthreads();
}

__device__ __forceinline__ void ph_dsa_b2_wave(Ctx& C, int b, int t4) {
    const bf16* PROJ = (const bf16*)(C.ws + WS_P); const unsigned* SEL = (const unsigned*)(C.ws + WS_SEL); bf16* YM = (bf16*)(C.ws + WS_H);
    const bf16* KFA = (const bf16*)(C.ws + WS_KFA); const bf16* VF = (const bf16*)(C.ws + WS_VF);
    const int lane = C.lane, n = lane & 31, h = lane >> 5, tl = n >> 3, hd = n & 7;
    const int ntile = ((t4 + 3) >> 5) + 1;
    const size_t qrow = (size_t)b * SEQ + t4 + tl;
    bf16x8 qf[5];
    {
        const bf16* qp = PROJ + qrow * PW + C_AQ + hd * 64 + 8 * h;
#pragma unroll
        for (int ks = 0; ks < 4; ++ks) {
            const v4u q4 = *(const v4u*)(qp + 16 * ks); const unsigned qw[4] = {q4.x, q4.y, q4.z, q4.w}; v4u o;
            unsigned ow[4];
#pragma unroll
            for (int x = 0; x < 4; ++x) ow[x] = pk2(bf2f(qw[x] & 0xffffu) * (0.125f * LOG2E), bf2f(qw[x] >> 16) * (0.125f * LOG2E));
            o.x = ow[0]; o.y = ow[1]; o.z = ow[2]; o.w = ow[3]; qf[ks] = __builtin_bit_cast(bf16x8, o);
        }
        const unsigned one = 0x3f80u, sl = f2bf(exp2f(-(float)(hd + 1)));
        v4u e; e.x = (tl == 0 ? one : 0u) | ((tl == 1 ? one : 0u) << 16); e.y = (tl == 2 ? one : 0u) | ((tl == 3 ? one : 0u) << 16); e.z = sl | (sl << 16); e.w = sl;
        if (h) { e.x = 0u; e.y = 0u; e.z = 0u; e.w = 0u; }
        qf[4] = __builtin_bit_cast(bf16x8, e);
    }
    f32x16 O0, O1;
#pragma unroll
    for (int x = 0; x < 16; ++x) { O0[x] = 0.f; O1[x] = 0.f; }
    float m = -3.0e38f, lsum = 0.f;
    const unsigned NEGB = 0xf149u;
    const bf16* kb = KFA + (size_t)(b * 128) * 2048 + lane * 8; const bf16* vb = VF + (size_t)(b * 128) * 2048 + lane * 8;
    const unsigned* selp = SEL + ((size_t)b * SEQ + t4 + (lane & 3)) * 128;
    bf16x8 kc[4], vc[4]; unsigned wc_;
#pragma unroll
    for (int ks = 0; ks < 4; ++ks) { kc[ks] = *(const bf16x8*)(kb + ks * 512); vc[ks] = *(const bf16x8*)(vb + ks * 512); }
    wc_ = selp[0];
    for (int tile = 0; tile < ntile; ++tile) {
        bf16x8 kn[4], vn[4]; unsigned wn = 0u;
        const int tn = (tile + 1 < ntile) ? tile + 1 : tile;
#pragma unroll
        for (int ks = 0; ks < 4; ++ks) { kn[ks] = *(const bf16x8*)(kb + (size_t)tn * 2048 + ks * 512); vn[ks] = *(const bf16x8*)(vb + (size_t)tn * 2048 + ks * 512); }
        wn = selp[tn];
        bf16x8 kx;
        {
            const unsigned w0 = (unsigned)__builtin_amdgcn_readlane((int)wc_, 0), w1 = (unsigned)__builtin_amdgcn_readlane((int)wc_, 1), w2 = (unsigned)__builtin_amdgcn_readlane((int)wc_, 2), w3 = (unsigned)__builtin_amdgcn_readlane((int)wc_, 3);
            const unsigned m0 = ((w0 >> n) & 1u) ? 0u : NEGB, m1 = ((w1 >> n) & 1u) ? 0u : NEGB, m2 = ((w2 >> n) & 1u) ? 0u : NEGB, m3 = ((w3 >> n) & 1u) ? 0u : NEGB;
            const float cs = LOG2E * (float)(tile * 32 + n);
            const unsigned c1 = f2bf(cs); const float r1 = cs - bf2f(c1); const unsigned c2 = f2bf(r1); const float r2 = r1 - bf2f(c2); const unsigned c3 = f2bf(r2);
            v4u e; e.x = m0 | (m1 << 16); e.y = m2 | (m3 << 16); e.z = c1 | (c2 << 16); e.w = c3;
            if (h) { e.x = 0u; e.y = 0u; e.z = 0u; e.w = 0u; }
            kx = __builtin_bit_cast(bf16x8, e);
        }
        f32x16 S;
#pragma unroll
        for (int x = 0; x < 16; ++x) S[x] = 0.f;
#pragma unroll
        for (int ks = 0; ks < 4; ++ks) S = mfma32(kc[ks], qf[ks], S);
        S = mfma32(kx, qf[4], S);
        float mloc = S[0];
#pragma unroll
        for (int x = 1; x < 16; ++x) mloc = fmaxf(mloc, S[x]);
        mloc = fmaxf(mloc, __shfl_xor(mloc, 32));
        const float mnew = fmaxf(m, mloc), alpha = __builtin_amdgcn_exp2f(m - mnew);
        m = mnew;
        float ps = 0.f;
#pragma unroll
        for (int x = 0; x < 16; ++x) { S[x] = __builtin_amdgcn_exp2f(S[x] - mnew); ps += S[x]; }
        lsum = lsum * alpha + ps;
#pragma unroll
        for (int x = 0; x < 16; ++x) { O0[x] *= alpha; O1[x] *= alpha; }
        v4u p0, p1;
        p0.x = pk2(S[0], S[1]); p0.y = pk2(S[2], S[3]); p0.z = pk2(S[4], S[5]); p0.w = pk2(S[6], S[7]);
        p1.x = pk2(S[8], S[9]); p1.y = pk2(S[10], S[11]); p1.z = pk2(S[12], S[13]); p1.w = pk2(S[14], S[15]);
        const bf16x8 pf0 = __builtin_bit_cast(bf16x8, p0), pf1 = __builtin_bit_cast(bf16x8, p1);
        O0 = mfma32(vc[0], pf0, O0); O1 = mfma32(vc[1], pf0, O1);
        O0 = mfma32(vc[2], pf1, O0); O1 = mfma32(vc[3], pf1, O1);
#pragma unroll
        for (int ks = 0; ks < 4; ++ks) { kc[ks] = kn[ks]; vc[ks] = vn[ks]; }
        wc_ = wn;
    }
    const float inv = 1.f / (lsum + __shfl_xor(lsum, 32));
    bf16* yo = YM + qrow * DM + hd * 64 + 4 * h;
#pragma unroll
    for (int j4 = 0; j4 < 4; ++j4) {
        v2u o; o.x = pk2(O0[4 * j4] * inv, O0[4 * j4 + 1] * inv); o.y = pk2(O0[4 * j4 + 2] * inv, O0[4 * j4 + 3] * inv);
        *(v2u*)(yo + 8 * j4) = o;
        v2u o2; o2.x = pk2(O1[4 * j4] * inv, O1[4 * j4 + 1] * inv); o2.y = pk2(O1[4 * j4 + 2] * inv, O1[4 * j4 + 3] * inv);
        *(v2u*)(yo + 32 + 8 * j4) = o2;
    }
}

__device__ __forceinline__ f32x4 mfma16(bf16x8 a, bf16x8 b, f32x4 c) { return __builtin_amdgcn_mfma_f32_16x16x32_bf16(a, b, c, 0, 0, 0); }
constexpr int B3_VS_PITCH = 144;
constexpr int B3_WAVE_LDS = 640 + 32 * B3_VS_PITCH;
#ifdef PROBE_HOT
#define B3_SKIP(bit) ((PROBE_SKIP & (bit)) && C.hot != 0xffff)
#define B3_HOTMASK C.hot
#else
#define B3_SKIP(bit) false
#define B3_HOTMASK 0xffff
#endif
template <bool FULL>
__device__ __forceinline__ void b3_core(Ctx& C, int b, int t, int nsel, const v4u qc0, const v4u qc1, LAS unsigned short* lst, LAS unsigned char* vs) {
    const bf16* PROJ = (const bf16*)(C.ws + WS_P); bf16* YM = (bf16*)C.out;
    const int lane = C.lane, m16 = lane & 15, g = lane >> 4;
    const size_t row = (size_t)b * SEQ + t;
    const int nt16 = FULL ? 16 : (nsel + 15) >> 4, nk32 = FULL ? 8 : (nsel + 31) >> 5;
    const bf16* vbase = PROJ + (size_t)b * SEQ * PW + C_AV + 8 * (lane & 7); const bf16* kbase = PROJ + (size_t)b * SEQ * PW + C_AK + 8 * g;
    v4u vb[3][4];
#pragma unroll
    for (int i = 0; i < 4; ++i) { const int s = (int)lst[8 * i + (lane >> 3)] & B3_HOTMASK; vb[0][i] = *(const v4u*)(vbase + (size_t)s * PW); }
    bf16x8 qf[2];
#pragma unroll
    for (int ks = 0; ks < 2; ++ks) {
        const v4u q4 = ks ? qc1 : qc0; const unsigned qw[4] = {q4.x, q4.y, q4.z, q4.w}; unsigned ow[4];
#pragma unroll
        for (int x = 0; x < 4; ++x) ow[x] = (m16 < 8) ? pk2(bf2f(qw[x] & 0xffffu) * (0.125f * LOG2E), bf2f(qw[x] >> 16) * (0.125f * LOG2E)) : 0u;
        v4u o; o.x = ow[0]; o.y = ow[1]; o.z = ow[2]; o.w = ow[3]; qf[ks] = __builtin_bit_cast(bf16x8, o);
    }
    const float sl2 = exp2f(-(float)((m16 & 7) + 1)) * LOG2E, tf = (float)t;
    f32x4 lg[16];
    bf16x8 a0[2][4], a1[2][4];
#define B3_GATHER(buf, hf_) { _Pragma("unroll") for (int i = 0; i < 4; ++i) { const int sm_k = ((FULL || 4 * (hf_) + i < nt16) ? (int)lst[16 * (4 * (hf_) + i) + m16] : 0) & B3_HOTMASK; \
        const bf16* kp = kbase + (size_t)sm_k * PW; a0[buf][i] = *(const bf16x8*)kp; a1[buf][i] = *(const bf16x8*)(kp + 32); } }
    if (!B3_SKIP(4)) { B3_GATHER(0, 0) B3_GATHER(1, 1) }
#pragma unroll
    for (int kt = 0; kt < 16; ++kt) {
        if (FULL || kt < nt16) {
            const v2u p4 = *(const LAS v2u*)(lst + 16 * kt + 4 * g);
            const float sr[4] = {(float)(p4.x & 0xffffu), (float)(p4.x >> 16), (float)(p4.y & 0xffffu), (float)(p4.y >> 16)};
#pragma unroll
            for (int r = 0; r < 4; ++r) lg[kt][r] = (FULL || 16 * kt + 4 * g + r < nsel) ? sl2 * (sr[r] - tf) : -3.0e38f;
        } else lg[kt] = (f32x4){-3.0e38f, -3.0e38f, -3.0e38f, -3.0e38f};
    }
#pragma unroll
    for (int hf = 0; hf < 4; ++hf) {
        if (!B3_SKIP(2)) {
#pragma unroll
            for (int i = 0; i < 4; ++i) if (FULL || 4 * hf + i < nt16) lg[4 * hf + i] = mfma16(a0[hf & 1][i], qf[0], lg[4 * hf + i]);
#pragma unroll
            for (int i = 0; i < 4; ++i) if (FULL || 4 * hf + i < nt16) lg[4 * hf + i] = mfma16(a1[hf & 1][i], qf[1], lg[4 * hf + i]);
        }
        if (!B3_SKIP(4)) { if (hf == 0) B3_GATHER(0, 2) if (hf == 1) B3_GATHER(1, 3) }
    }
    float mx;
    {
        float m0 = -3.0e38f, m1 = -3.0e38f, m2 = -3.0e38f, m3 = -3.0e38f;
#pragma unroll
        for (int kt = 0; kt < 16; ++kt) { m0 = fmaxf(m0, lg[kt][0]); m1 = fmaxf(m1, lg[kt][1]); m2 = fmaxf(m2, lg[kt][2]); m3 = fmaxf(m3, lg[kt][3]); }
        mx = fmaxf(fmaxf(m0, m1), fmaxf(m2, m3));
    }
#undef B3_GATHER
#pragma unroll
    for (int d = 1; d < 3; ++d) if (FULL || d < nk32) {
#pragma unroll
        for (int i = 0; i < 4; ++i) { const int s = (int)lst[32 * d + 8 * i + (lane >> 3)] & B3_HOTMASK; vb[d][i] = *(const v4u*)(vbase + (size_t)s * PW); }
    }
    mx = fmaxf(mx, SHX_F(mx, 16, lane)); mx = fmaxf(mx, SHX_F(mx, 32, lane));
    float sm_;
    {
        float s0 = 0.f, s1 = 0.f, s2 = 0.f, s3 = 0.f;
#pragma unroll
        for (int kt = 0; kt < 16; ++kt) {
            if (FULL || kt < nt16) {
                const float p0 = __builtin_amdgcn_exp2f(lg[kt][0] - mx), p1 = __builtin_amdgcn_exp2f(lg[kt][1] - mx), p2 = __builtin_amdgcn_exp2f(lg[kt][2] - mx), p3 = __builtin_amdgcn_exp2f(lg[kt][3] - mx);
                lg[kt] = (f32x4){p0, p1, p2, p3}; s0 += p0; s1 += p1; s2 += p2; s3 += p3;
            } else lg[kt] = (f32x4){0.f, 0.f, 0.f, 0.f};
        }
        sm_ = (s0 + s1) + (s2 + s3);
    }
    sm_ += SHX_F(sm_, 16, lane); sm_ += SHX_F(sm_, 32, lane);
    const float inv = 1.f / sm_;
    v4u pbk[8];
#pragma unroll
    for (int kk = 0; kk < 8; ++kk) { pbk[kk].x = pk2(lg[2 * kk][0], lg[2 * kk][1]); pbk[kk].y = pk2(lg[2 * kk][2], lg[2 * kk][3]); pbk[kk].z = pk2(lg[2 * kk + 1][0], lg[2 * kk + 1][1]); pbk[kk].w = pk2(lg[2 * kk + 1][2], lg[2 * kk + 1][3]); }
    f32x4 O[4];
#pragma unroll
    for (int i = 0; i < 4; ++i) O[i] = (f32x4){0.f, 0.f, 0.f, 0.f};
#pragma unroll
    for (int kk = 0; kk < 8; ++kk) if ((FULL || kk < nk32) && !B3_SKIP(1)) {
#pragma unroll
        for (int i = 0; i < 4; ++i) *(LAS v4u*)(vs + (8 * i + (lane >> 3)) * B3_VS_PITCH + (lane & 7) * 16) = vb[kk % 3][i];
        if (kk >= 1 && kk + 2 < 8 && (FULL || kk + 2 < nk32)) {
#pragma unroll
            for (int i = 0; i < 4; ++i) { const int s = (int)lst[32 * (kk + 2) + 8 * i + (lane >> 3)] & B3_HOTMASK; vb[(kk + 2) % 3][i] = *(const v4u*)(vbase + (size_t)s * PW); }
        }
        asm volatile("s_waitcnt lgkmcnt(0)" ::: "memory");
        const bf16x8 pB = __builtin_bit_cast(bf16x8, pbk[kk]);
#pragma unroll
        for (int u = 0; u < 2; ++u) {
            unsigned w[8];
#pragma unroll
            for (int j = 0; j < 8; ++j) { const int sl = (j < 4) ? 4 * g + j : 16 + 4 * g + (j - 4); w[j] = *(const LAS unsigned*)(vs + sl * B3_VS_PITCH + (32 * u + 2 * m16) * 2); }
            v4u ae, ao;
            ae.x = (w[0] & 0xffffu) | (w[1] << 16); ae.y = (w[2] & 0xffffu) | (w[3] << 16); ae.z = (w[4] & 0xffffu) | (w[5] << 16); ae.w = (w[6] & 0xffffu) | (w[7] << 16);
            ao.x = (w[0] >> 16) | (w[1] & 0xffff0000u); ao.y = (w[2] >> 16) | (w[3] & 0xffff0000u); ao.z = (w[4] >> 16) | (w[5] & 0xffff0000u); ao.w = (w[6] >> 16) | (w[7] & 0xffff0000u);
            O[2 * u] = mfma16(__builtin_bit_cast(bf16x8, ae), pB, O[2 * u]); O[2 * u + 1] = mfma16(__builtin_bit_cast(bf16x8, ao), pB, O[2 * u + 1]);
        }
    }
    if (m16 < 8) {
#pragma unroll
        for (int u = 0; u < 2; ++u) {
            v4u o; o.x = pk2(O[2 * u][0] * inv, O[2 * u + 1][0] * inv); o.y = pk2(O[2 * u][1] * inv, O[2 * u + 1][1] * inv); o.z = pk2(O[2 * u][2] * inv, O[2 * u + 1][2] * inv); o.w = pk2(O[2 * u][3] * inv, O[2 * u + 1][3] * inv);
            *(v4u*)(YM + row * DM + m16 * 64 + 32 * u + 8 * g) = o;
        }
    }
}
__device__ __forceinline__ void ph_dsa_b3_wave(Ctx& C, int b, int t4) {
    LAS unsigned short* lst = (LAS unsigned short*)(C.lds + C.wave * B3_WAVE_LDS);
    LAS unsigned char* vs = C.lds + C.wave * B3_WAVE_LDS + 640;
    const bf16* PROJ = (const bf16*)(C.ws + WS_P); const unsigned* SEL = (const unsigned*)(C.ws + WS_SEL);
    const int lane = C.lane, m16 = lane & 15, g = lane >> 4;
    unsigned w0n, w1n; v4u qn0, qn1;
#define B3_PREFETCH(tq) { const size_t r_ = (size_t)b * SEQ + (tq); const int nw_ = ((tq) >> 5) + 1; \
        w0n = (2 * lane < nw_) ? SEL[r_ * 128 + 2 * lane] : 0u; w1n = (2 * lane + 1 < nw_) ? SEL[r_ * 128 + 2 * lane + 1] : 0u; \
        const bf16* qp_ = PROJ + r_ * PW + C_AQ + (m16 & 7) * 64 + 8 * g; qn0 = *(const v4u*)qp_; qn1 = *(const v4u*)(qp_ + 32); }
    B3_PREFETCH(t4)
#pragma unroll 1
    for (int qi = 0; qi < 4; ++qi) {
        const int t = t4 + qi;
        const size_t row = (size_t)b * SEQ + t;
        unsigned w0 = w0n, w1 = w1n;
        const v4u qc0 = qn0, qc1 = qn1;
        if (qi < 3) B3_PREFETCH(t + 1)
        int nsel;
        {
            const int c = __popc(w0) + __popc(w1); const int incl = wave_incl_scan_i(c, lane);
            int pos = incl - c; const int tot = __builtin_amdgcn_readlane(incl, 63);
            if (!B3_SKIP(8)) {
            while (w0) { const int bit = __ffs(w0) - 1; w0 &= w0 - 1; if (pos < 256) lst[pos] = (unsigned short)(64 * lane + bit); ++pos; }
            while (w1) { const int bit = __ffs(w1) - 1; w1 &= w1 - 1; if (pos < 256) lst[pos] = (unsigned short)(64 * lane + 32 + bit); ++pos; }
            }
            nsel = tot < 256 ? tot : 256;
            if (lane < 32 && nsel + lane < 288) lst[nsel + lane] = 0;
        }
        asm volatile("s_waitcnt lgkmcnt(0)" ::: "memory");
        if (nsel == 256) b3_core<true>(C, b, t, nsel, qc0, qc1, lst, vs); else b3_core<false>(C, b, t, nsel, qc0, qc1, lst, vs);
    }
#undef B3_PREFETCH
}

namespace pg8 {
constexpr int BM = 256, BK = 64, HALF = 128, HTB = HALF * BK * 2, STAGE_BYTES = 8 * HTB, NXCD = 8, WGM = 8;
__host__ __device__ __forceinline__ int lds_byte(int r, int c) { const int st = (r >> 4) * 2 + (c >> 5), rr = r & 15, cc = c & 31, ob = rr * 64 + cc * 2; return st * 1024 + (ob ^ (((ob >> 9) & 1) << 5)); }
__host__ __device__ __forceinline__ void stage_rc(int b, int& R, int& C) { const int st = b / 1024, sb = b % 1024, swz = sb ^ (((sb >> 9) & 1) << 5); R = (st >> 1) * 16 + swz / 64; C = (st & 1) * 32 + (swz % 64) / 2; }
__host__ __device__ __forceinline__ int perm32(int rho) { const int n = rho >> 4, i = rho & 15; return 8 * (i >> 2) + 4 * n + (i & 3); }

struct Unit { int pm, pn, po, eb; };
struct Gemm { const bf16* A; const bf16* Bt; int K; size_t ebytes; };

struct Order {
    int nM, nN, nwg, G, c, p_lo, amode; const LAS unsigned char* pe;
    __device__ __forceinline__ void init(int nM_, int nN_, int G_, int c_, int p_lo_, int amode_, const LAS unsigned char* pe_) { nM = nM_; nN = nN_; nwg = nM * nN; G = G_; c = c_; p_lo = p_lo_; amode = amode_; pe = pe_; }
    __device__ __forceinline__ bool next(int i, Unit& u) const {
        const long L = (long)i * G + c; if (L >= nwg) return false;
        int wgid = (int)L; { const int q = nwg / NXCD, r = nwg % NXCD, xcd = wgid % NXCD, off = wgid / NXCD; wgid = (xcd < r ? xcd * (q + 1) : r * (q + 1) + (xcd - r) * q) + off; }
        const int nig = WGM * nN, gid = wgid / nig, fm = gid * WGM, gsz = (nM - fm) < WGM ? (nM - fm) : WGM;
        const int lp = fm + ((wgid % nig) % gsz), gp = p_lo + lp; u.pn = (wgid % nig) / gsz;
        u.pm = amode == 0 ? gp : lp; u.po = amode == 0 ? lp : gp; u.eb = pe ? __builtin_amdgcn_readfirstlane((int)pe[gp]) : 0; return true;
    }
};

__device__ __forceinline__ unsigned cvt_pk_bf16(float lo, float hi) { unsigned r; asm volatile("v_cvt_pk_bf16_f32 %0, %1, %2" : "=v"(r) : "v"(lo), "v"(hi)); return r; }
__device__ __forceinline__ float silu_fast(float g) { return g * __builtin_amdgcn_rcpf(1.f + __builtin_amdgcn_exp2f(-g * LOG2E)); }

struct EpiBf16 {
    static constexpr bool PERM = true;
    bf16* O; int ldc;
    __device__ __forceinline__ void operator()(const f32x4 (&acc)[2][2][4][2], const Unit& u, int wr, int wc, int fr, int fq) const {
        const int row0 = u.po * BM + wr * 64 + fr, col0 = u.pn * BM + wc * 32 + 8 * fq;
#pragma unroll
        for (int ai = 0; ai < 2; ++ai)
#pragma unroll
            for (int m = 0; m < 4; ++m) { bf16* rowp = O + (size_t)(row0 + ai * HALF + m * 16) * ldc + col0;
#pragma unroll
                for (int bj = 0; bj < 2; ++bj) { const f32x4 v0 = acc[ai][bj][m][0], v1 = acc[ai][bj][m][1];
                    v4u w; w.x = cvt_pk_bf16(v0[0], v0[1]); w.y = cvt_pk_bf16(v0[2], v0[3]); w.z = cvt_pk_bf16(v1[0], v1[1]); w.w = cvt_pk_bf16(v1[2], v1[3]);
                    *(v4u*)(rowp + bj * HALF) = w; } }
    }
};
struct EpiProj {
    static constexpr bool PERM = true;
    bf16* O; bf16* KFA; bf16* KFI; bf16* VF;
    __device__ __forceinline__ void operator()(const f32x4 (&acc)[2][2][4][2], const Unit& u, int wr, int wc, int fr, int fq) const {
        const int row0 = u.po * BM + wr * 64 + fr, col0 = u.pn * BM + wc * 32 + 8 * fq;
#pragma unroll
        for (int ai = 0; ai < 2; ++ai)
#pragma unroll
            for (int m = 0; m < 4; ++m) { const int row = row0 + ai * HALF + m * 16; bf16* rowp = O + (size_t)row * PW + col0;
#pragma unroll
                for (int bj = 0; bj < 2; ++bj) { const f32x4 v0 = acc[ai][bj][m][0], v1 = acc[ai][bj][m][1];
                    v4u w; w.x = cvt_pk_bf16(v0[0], v0[1]); w.y = cvt_pk_bf16(v0[2], v0[3]); w.z = cvt_pk_bf16(v1[0], v1[1]); w.w = cvt_pk_bf16(v1[2], v1[3]);
                    *(v4u*)(rowp + bj * HALF) = w;
                    if (u.pn == 10) {
                        if (wc < 2) {
                            const int dc = 4 * wc + fq;
                            bf16* kf = (bj == 0 ? KFA : KFI) + ((size_t)(row >> 5) * 4 + (dc >> 1)) * 512 + (32 * (dc & 1) + (row & 31)) * 8;
                            *(v4u*)kf = w;
                        } else if (bj == 0) {
                            const int kap = row & 31, mf = kap >> 4, k15 = kap & 15, hh = (k15 >> 2) & 1, j = (k15 & 3) + 4 * (k15 >> 3);
                            bf16* vf = VF + ((((size_t)(row >> 5) * 2 + mf) * 2 + (wc - 2)) * 64 + 32 * hh + 8 * fq) * 8 + j;
                            vf[0 * 8] = (bf16)(w.x & 0xffffu); vf[1 * 8] = (bf16)(w.x >> 16); vf[2 * 8] = (bf16)(w.y & 0xffffu); vf[3 * 8] = (bf16)(w.y >> 16);
                            vf[4 * 8] = (bf16)(w.z & 0xffffu); vf[5 * 8] = (bf16)(w.z >> 16); vf[6 * 8] = (bf16)(w.w & 0xffffu); vf[7 * 8] = (bf16)(w.w >> 16);
                        }
                    } } }
    }
};
struct EpiGate {
    static constexpr bool PERM = true;
    bf16* O; const float* gate;
    __device__ __forceinline__ void operator()(const f32x4 (&acc)[2][2][4][2], const Unit& u, int wr, int wc, int fr, int fq) const {
        const int row0 = u.po * BM + wr * 64 + fr, col0 = u.pn * BM + wc * 32 + 8 * fq;
#pragma unroll
        for (int ai = 0; ai < 2; ++ai)
#pragma unroll
            for (int m = 0; m < 4; ++m) { const int row = row0 + ai * HALF + m * 16; const float g = gate ? gate[row] : 1.f; bf16* rowp = O + (size_t)row * DM + col0;
#pragma unroll
                for (int bj = 0; bj < 2; ++bj) { const f32x4 v0 = acc[ai][bj][m][0] * g, v1 = acc[ai][bj][m][1] * g;
                    v4u w; w.x = cvt_pk_bf16(v0[0], v0[1]); w.y = cvt_pk_bf16(v0[2], v0[3]); w.z = cvt_pk_bf16(v1[0], v1[1]); w.w = cvt_pk_bf16(v1[2], v1[3]);
                    *(v4u*)(rowp + bj * HALF) = w; } }
    }
};
struct EpiSwiglu {
    static constexpr bool PERM = true;
    bf16* O;
    __device__ __forceinline__ void operator()(const f32x4 (&acc)[2][2][4][2], const Unit& u, int wr, int wc, int fr, int fq) const {
        const int row0 = u.po * BM + wr * 64 + fr, col0 = u.pn * HALF + wc * 32 + 8 * fq;
#pragma unroll
        for (int ai = 0; ai < 2; ++ai)
#pragma unroll
            for (int m = 0; m < 4; ++m) { bf16* rowp = O + (size_t)(row0 + ai * HALF + m * 16) * DFF + col0;
                const f32x4 g0 = acc[ai][0][m][0], g1 = acc[ai][0][m][1], u0 = acc[ai][1][m][0], u1 = acc[ai][1][m][1];
                v4u w; w.x = cvt_pk_bf16(silu_fast(g0[0]) * u0[0], silu_fast(g0[1]) * u0[1]); w.y = cvt_pk_bf16(silu_fast(g0[2]) * u0[2], silu_fast(g0[3]) * u0[3]);
                w.z = cvt_pk_bf16(silu_fast(g1[0]) * u1[0], silu_fast(g1[1]) * u1[1]); w.w = cvt_pk_bf16(silu_fast(g1[2]) * u1[2], silu_fast(g1[3]) * u1[3]);
                *(v4u*)rowp = w; }
    }
};

template <class Epi, class Sched>
__device__ __forceinline__ void gemm_phase(LAS unsigned char* lds, const int tid, const Gemm g, const Sched& S, const Epi& E) {
    const int wid = __builtin_amdgcn_readfirstlane(tid >> 6), lane = tid & 63, wr = wid >> 2, wc = wid & 3, fr = lane & 15, fq = lane >> 4;
    const int K = g.K, nt = K / BK;
    unsigned voffA[2], voffB[2];
#pragma unroll
    for (int i = 0; i < 2; ++i) { int R, C; stage_rc(tid * 16 + i * 8192, R, C); const int Rb = Epi::PERM ? ((R & ~31) + perm32(R & 31)) : R; voffA[i] = (unsigned)(R * K + C) * 2u; voffB[i] = (unsigned)(Rb * K + C) * 2u; }
    const size_t kstep = (size_t)(BK * 2);
    const size_t hstep = (size_t)HALF * K * 2;
    const size_t tstep = 2 * hstep;
    const unsigned ldsw = (unsigned)wid * 1024u;
    const int aoff = lds_byte(wr * 64 + fr, fq * 8), boff = lds_byte(wc * 32 + fr, fq * 8);
#define PG8_SA(b, h) (((b) * 2 + (h)) * HTB)
#define PG8_SB(b, h) ((4 + (b) * 2 + (h)) * HTB)
#define PG8_STAGE(bufoff, gbase, voff) do { _Pragma("unroll") for (int _i = 0; _i < 2; ++_i) \
        __builtin_amdgcn_global_load_lds((const unsigned*)((const char*)(gbase) + (voff)[_i]), (LAS unsigned*)(lds + (bufoff) + ldsw + _i * 8192), 16, 0, 0); } while (0)
#define PG8_LDA(dst, b, h) do { _Pragma("unroll") for (int m = 0; m < 4; ++m) _Pragma("unroll") for (int k = 0; k < 2; ++k) dst[m][k] = *(const LAS bf16x8*)(lds + PG8_SA(b, h) + aoff + m * 2048 + k * 1024); } while (0)
#define PG8_LDB(dst, b, h) do { _Pragma("unroll") for (int n = 0; n < 2; ++n) _Pragma("unroll") for (int k = 0; k < 2; ++k) dst[n][k] = *(const LAS bf16x8*)(lds + PG8_SB(b, h) + boff + n * 2048 + k * 1024); } while (0)
#define PG8_MMA(ai, bj, At, Bt) do { __builtin_amdgcn_s_setprio(1); _Pragma("unroll") for (int m = 0; m < 4; ++m) _Pragma("unroll") for (int n = 0; n < 2; ++n) _Pragma("unroll") for (int k = 0; k < 2; ++k) \
        acc[ai][bj][m][n] = __builtin_amdgcn_mfma_f32_16x16x32_bf16(Bt[n][k], At[m][k], acc[ai][bj][m][n], 0, 0, 0); __builtin_amdgcn_s_setprio(0); } while (0)
#define PG8_WAIT_V(n) asm volatile("s_waitcnt vmcnt(" #n ")" ::: "memory")
#define PG8_WAIT_L(n) asm volatile("s_waitcnt lgkmcnt(" #n ")" ::: "memory")
#define PG8_BAR __builtin_amdgcn_s_barrier()
#define PG8_SCHED __builtin_amdgcn_sched_barrier(0)
    Unit cur, nxt; int ui = 0;
    if (!S.next(0, cur)) return;
    f32x4 acc[2][2][4][2];
#pragma unroll
    for (int a = 0; a < 2; ++a)
#pragma unroll
        for (int b = 0; b < 2; ++b)
#pragma unroll
            for (int m = 0; m < 4; ++m)
#pragma unroll
                for (int n = 0; n < 2; ++n) acc[a][b][m][n] = (f32x4){0.f, 0.f, 0.f, 0.f};
    bf16x8 At[4][2], B0[2][2], B1[2][2];
    const char* cA = (const char*)g.A + (size_t)cur.pm * tstep;
    const char* cB = (const char*)g.Bt + (size_t)cur.eb * g.ebytes + (size_t)cur.pn * tstep;
    PG8_STAGE(PG8_SB(0, 0), cB, voffB); PG8_STAGE(PG8_SB(0, 1), cB + hstep, voffB); PG8_STAGE(PG8_SA(0, 0), cA, voffA); PG8_STAGE(PG8_SA(0, 1), cA + hstep, voffA);
    if (wr == 1) PG8_BAR;
    PG8_WAIT_V(2); PG8_BAR;
    PG8_STAGE(PG8_SB(1, 0), cB + kstep, voffB); PG8_STAGE(PG8_SA(1, 0), cA + kstep, voffA); PG8_STAGE(PG8_SB(1, 1), cB + hstep + kstep, voffB);
    PG8_WAIT_V(6); PG8_BAR;
    for (;;) {
        const bool has_next = S.next(ui + 1, nxt);
        const char* nA = has_next ? (const char*)g.A + (size_t)nxt.pm * tstep : cA;
        const char* nB = has_next ? (const char*)g.Bt + (size_t)nxt.eb * g.ebytes + (size_t)nxt.pn * tstep : cB;
#define PG8_PAIR(a1, a2, b2, a3, b3) do { \
              \
            PG8_LDB(B0, 0, 0); PG8_LDB(B1, 0, 1); PG8_SCHED; PG8_LDA(At, 0, 0); PG8_STAGE(PG8_SA(1, 1), (a1) + hstep, voffA); \
            PG8_WAIT_V(8); PG8_WAIT_L(0); PG8_BAR; PG8_MMA(0, 0, At, B0); PG8_MMA(0, 1, At, B1); PG8_BAR; PG8_SCHED; \
              \
            PG8_LDA(At, 0, 1); PG8_STAGE(PG8_SB(0, 0), b2, voffB); PG8_STAGE(PG8_SB(0, 1), (b2) + hstep, voffB); PG8_STAGE(PG8_SA(0, 0), a2, voffA); \
            PG8_WAIT_V(8); PG8_WAIT_L(0); PG8_BAR; PG8_MMA(1, 0, At, B0); PG8_MMA(1, 1, At, B1); PG8_BAR; PG8_SCHED; \
              \
            PG8_LDB(B0, 1, 0); PG8_LDB(B1, 1, 1); PG8_SCHED; PG8_LDA(At, 1, 0); PG8_STAGE(PG8_SA(0, 1), (a2) + hstep, voffA); \
            PG8_WAIT_V(8); PG8_WAIT_L(0); PG8_BAR; PG8_MMA(0, 0, At, B0); PG8_MMA(0, 1, At, B1); PG8_BAR; PG8_SCHED; \
              \
            PG8_LDA(At, 1, 1); PG8_STAGE(PG8_SB(1, 0), b3, voffB); PG8_STAGE(PG8_SB(1, 1), (b3) + hstep, voffB); PG8_STAGE(PG8_SA(1, 0), a3, voffA); \
            PG8_WAIT_V(8); PG8_WAIT_L(0); PG8_BAR; PG8_MMA(1, 0, At, B0); PG8_MMA(1, 1, At, B1); PG8_BAR; PG8_SCHED; } while (0)
        for (int t = 0; t < nt; t += 2) {
            const bool last = (t == nt - 2);
            const char* a1 = cA + (size_t)(t + 1) * kstep;
            const char* a2 = last ? nA : cA + (size_t)(t + 2) * kstep; const char* b2 = last ? nB : cB + (size_t)(t + 2) * kstep;
            const char* a3 = a2 + kstep; const char* b3 = b2 + kstep;
            PG8_PAIR(a1, a2, b2, a3, b3);
        }
#undef PG8_PAIR
        if (wr == 0) PG8_BAR;
        E(acc, cur, wr, wc, fr, fq);
        if (!has_next) break;
#pragma unroll
        for (int a = 0; a < 2; ++a)
#pragma unroll
            for (int b = 0; b < 2; ++b)
#pragma unroll
                for (int m = 0; m < 4; ++m)
#pragma unroll
                    for (int n = 0; n < 2; ++n) acc[a][b][m][n] = (f32x4){0.f, 0.f, 0.f, 0.f};
        cur = nxt; cA = nA; cB = nB; ++ui;
        if (wr == 1) PG8_BAR;
    }
    PG8_WAIT_V(0);
    PG8_BAR;
#undef PG8_SA
#undef PG8_SB
#undef PG8_STAGE
#undef PG8_LDA
#undef PG8_LDB
#undef PG8_MMA
#undef PG8_WAIT_V
#undef PG8_WAIT_L
#undef PG8_BAR
#undef PG8_SCHED
}
}

constexpr int N_STEPS = 2 + 2 * (7 + 2 * NPASS_DENSE) + 2 * (8 + 2 * NPASS_MOE);
#ifndef REP_A
#define REP_A 1
#define REP_B 1
#endif
#ifndef PROBE_ID
#define PROBE_ID 0
#endif
#ifndef REP_BAR
#define REP_BAR 1
#endif
#ifndef REP_C
#define REP_C 1
#endif
#ifndef REP_L
#define REP_L 1
#endif
#ifndef REP_G
#define REP_G 1
#endif
#ifndef USE_B3
#define USE_B3 1
#endif
#ifndef USE_B2
#define USE_B2 1
#define USE_A2 1
#endif
#ifndef USE_PG8
#define USE_PG8 1
#endif

__global__ void __launch_bounds__(512, 2) hybrid_fwd(Args args) {
    extern __shared__ __attribute__((aligned(16))) unsigned char lds_raw[];
    Ctx C;
    C.lds = (LAS unsigned char*)lds_raw;
    C.MISC = (volatile LAS unsigned*)(C.lds + MISC_OFF);
    C.tid = threadIdx.x; C.lane = C.tid & 63; C.wave = __builtin_amdgcn_readfirstlane(C.tid >> 6);
    C.G = gridDim.x; C.bid = blockIdx.x; C.hot = 0xffff;
    C.ka = (KArgs*)__builtin_amdgcn_kernarg_segment_ptr();
    C.out = args.out; C.ws = args.ws; C.ctl = (unsigned*)(args.ws + WS_CTL);
    if (C.tid < 32) C.MISC[C.tid] = 0u;
    __syncthreads();
    if (!MK_MULTI) (void)xcd_barrier_post(C.ctl + CW_BAR, C.MISC + 8);
    int step = 0;
    const int wave_s = __builtin_amdgcn_readfirstlane((int)threadIdx.x >> 6);
#define STEP_BEGIN if (step >= C.ka->lo && step < C.ka->hi) { { unsigned m_ = ~0u; asm volatile("" : "+s"(m_)); const int ln_ = (int)__builtin_amdgcn_mbcnt_hi(m_, __builtin_amdgcn_mbcnt_lo(m_, 0u)); \
        int t_ = wave_s * 64 + ln_; asm volatile("" : "+v"(t_)); C.tid = t_; C.lane = t_ & 63; C.wave = wave_s; \
        KArgs* k_ = (KArgs*)__builtin_amdgcn_kernarg_segment_ptr(); asm volatile("" : "+s"(k_)); C.ka = k_; C.ws = k_->ws; C.out = k_->out; C.ctl = (unsigned*)(k_->ws + WS_CTL); C.G = gridDim.x; C.bid = blockIdx.x; }
#define STEP_END } if (!MK_MULTI && step >= C.ka->lo && step + 1 < C.ka->hi) { XcdBarrier b_; b_.bar = (unsigned*)(C.ka->ws + WS_CTL) + CW_BAR; b_.x = xb_xcc_id(); b_.st = C.MISC + 8; xcd_barrier(b_); if (REP_BAR > 1) xcd_barrier(b_); } ++step;
#define WSP(T, off) ((T*)(C.ws + (off)))
#define RELAUNDER { int t_ = C.tid; asm volatile("" : "+v"(t_)); C.tid = t_; C.lane = t_ & 63; C.wave = __builtin_amdgcn_readfirstlane(t_ >> 6); }

    STEP_BEGIN
        ph_mod(C); __syncthreads(); ph_conv(C, 0);
#if REP_C > 1
        __syncthreads(); ph_mod(C); __syncthreads(); ph_conv(C, 0);
#endif
    STEP_END
    STEP_BEGIN
        ph_modulate0(C);
#if PROBE_ID == 8
        RELAUNDER ph_modulate0(C); RELAUNDER ph_modulate0(C); RELAUNDER ph_modulate0(C); RELAUNDER ph_modulate0(C);
#endif
    STEP_END

    for (int l = 0; l < DEPTH; ++l) {
        STEP_BEGIN
#if USE_PG8
            { const pg8::Gemm g{WSP(bf16, WS_H), WSP(bf16, WS_WIN), DM, 0}; pg8::Order S; S.init(256, 11, C.G, C.bid, 0, 0, nullptr);
              pg8::gemm_phase(C.lds, C.tid, g, S, pg8::EpiProj{WSP(bf16, WS_P), WSP(bf16, WS_KFA), WSP(bf16, WS_KFI), WSP(bf16, WS_VF)});
#if PROBE_ID == 5
              RELAUNDER pg8::gemm_phase(C.lds, C.tid, g, S, pg8::EpiProj{WSP(bf16, WS_P), WSP(bf16, WS_KFA), WSP(bf16, WS_KFI), WSP(bf16, WS_VF)});
#endif
            }
#else
            for (int u = C.bid; u < 256 * 11; u += C.G) {
                const int pm = u / 11, pn = u % 11; const GUnit gu{pm * 256, pm * 256, pn, 0};
                gemm_simple_unit<0>(C, WSP(bf16, WS_H), DM, nullptr, WSP(bf16, WS_WIN), DM, gu, EpiStoreS{WSP(bf16, WS_P), PW});
            }
#endif
        STEP_END
        STEP_BEGIN
#pragma unroll 1
            for (int rp_ = 0; rp_ < (PROBE_ID == 1 ? 2 : 1); ++rp_)
            for (int idx = C.bid; idx < 8192; idx += C.G) {
                RELAUNDER
                const int b = idx & 15, r = idx >> 4, j = (r & 15) + 16 * (r >> 5), qb = ((r >> 4) & 1) ? 511 - j : j;
                A3Q qa; a3_load_q(C, b, qb * 8, qa);
                ph_dsa_a3_unit(C, b, qb * 8, qa, false, 0, 0);
            }
#pragma unroll 1
            for (int rp_ = 0; rp_ < (PROBE_ID == 3 ? 2 : 1); ++rp_)
            for (int u = C.bid; u < 4096; u += C.G) { RELAUNDER ph_gla1_unit(C, l, u); }
        STEP_END
        STEP_BEGIN
            ph_gla2(C);
#if PROBE_ID == 9
            RELAUNDER ph_gla2(C, (size_t)66 * MiB); RELAUNDER ph_gla2(C, (size_t)66 * MiB);
#endif
        STEP_END
        STEP_BEGIN
#pragma unroll 1
            for (int rp_ = 0; rp_ < (PROBE_ID == 4 ? 2 : 1); ++rp_)
            for (int u = C.bid; u < 4096; u += C.G) { RELAUNDER ph_gla3_unit(C, l, u); }
#if USE_B2
#pragma unroll 1
            for (int rep = 0; rep < (PROBE_ID == 2 ? 2 : 1); ++rep)
#ifdef PROBE_HOT
            { C.hot = (rep == 0) ? PROBE_HOT : 0xffff;
#else
            {
#endif
            for (int idx = C.bid; idx < 2048; idx += C.G) {
                RELAUNDER
                const int b = idx & 15, r = idx >> 4, j = (r & 15) + 16 * (r >> 5), qb = ((r >> 4) & 1) ? 127 - j : j;
#if USE_B3
                ph_dsa_b3_wave(C, b, qb * 32 + C.wave * 4);
#else
                ph_dsa_b2_wave(C, b, qb * 32 + C.wave * 4);
#endif
            }
            }
#else
            for (int u = C.bid; u < 8192; u += C.G) { RELAUNDER ph_dsa_b_unit(C, u & 15, (u >> 4) * 8); }
#endif
        STEP_END
        STEP_BEGIN
#if USE_PG8
            { const pg8::Gemm g{(const bf16*)C.out, WSP(bf16, WS_WOUT), DM, 0}; pg8::Order S; S.init(256, 4, C.G, C.bid, 0, 0, nullptr);
              pg8::gemm_phase(C.lds, C.tid, g, S, pg8::EpiBf16{WSP(bf16, WS_Y), DM});
#if PROBE_ID == 6
              RELAUNDER pg8::gemm_phase(C.lds, C.tid, g, S, pg8::EpiBf16{WSP(bf16, WS_Y), DM});
#endif
            }
#else
            for (int u = C.bid; u < 256 * 4; u += C.G) {
                const int pm = u >> 2, pn = u & 3; const GUnit gu{pm * 256, pm * 256, pn, 0};
                gemm_simple_unit<0>(C, WSP(bf16, WS_H), DM, nullptr, WSP(bf16, WS_WOUT), DM, gu, EpiStoreS{WSP(bf16, WS_Y), DM});
            }
#endif
        STEP_END
        STEP_BEGIN
            const float* Xin = C.in(I_X);
            if (l == 0) ph_ln<false, 0, 0>(C, Xin, l, 0, 2048, l, 3072, true, 0, 0, false);
            else if (l & 1) ph_ln<true, 0, 1>(C, Xin, l, 0, 2048, l, 3072, true, l >> 1, 0, false);
            else ph_ln<false, 0, 1>(C, Xin, l, 0, 2048, l, 3072, true, l >> 1, 0, false);
        STEP_END
        if (l & 1) {
            STEP_BEGIN
                ph_assign(C, l >> 1);
            STEP_END
        }
        for (int pass = 0; pass < ((l & 1) ? NPASS_MOE : NPASS_DENSE); ++pass) {
            STEP_BEGIN
                const bool moe = (l & 1) != 0;
                MoeTab tb; tb.npanels = 256;
#pragma unroll
                for (int e = 0; e < 8; ++e) tb.pend[e] = 65536;
                if (moe) tb = moe_tab(C, l >> 1);
                const int p_lo = pass * PASS_PANELS, p_hi = moe ? ((pass == NPASS_MOE - 1 || tb.npanels < p_lo + PASS_PANELS) ? tb.npanels : p_lo + PASS_PANELS) : p_lo + PASS_PANELS;
                const int npan = p_hi > p_lo ? p_hi - p_lo : 0;
#if USE_PG8
                LAS unsigned char* pe = C.lds + PE_OFF;
                for (int p = C.tid; p < 528; p += 512) pe[p] = (unsigned char)(moe ? panel_expert(tb, p) : 0);
                __syncthreads();
                { const pg8::Gemm g{moe ? WSP(bf16, WS_Y) : WSP(bf16, WS_H), WSP(bf16, WS_WGU), DM, (size_t)5632 * 1024 * 2}; pg8::Order S; S.init(npan, 22, C.G, C.bid, p_lo, 0, pe);
                  pg8::gemm_phase(C.lds, C.tid, g, S, pg8::EpiSwiglu{WSP(bf16, WS_P)});
#if REP_G > 1
                  RELAUNDER pg8::gemm_phase(C.lds, C.tid, g, S, pg8::EpiSwiglu{WSP(bf16, WS_P)});
#endif
                }
#else
                for (int u = C.bid; u < npan * 22; u += C.G) {
                    const int lp = u / 22, pn = u % 22, gp = p_lo + lp; const int e = moe ? panel_expert(tb, gp) : 0;
                    const GUnit gu{gp * 256, lp * 256, pn, (size_t)e * 5632 * 1024};
                    gemm_simple_unit<1>(C, moe ? WSP(bf16, WS_Y) : WSP(bf16, WS_H), DM, nullptr, WSP(bf16, WS_WGU), DM, gu, EpiSwigluS{WSP(bf16, WS_P)});
                }
#endif
            STEP_END
            STEP_BEGIN
                const bool moe = (l & 1) != 0;
                MoeTab tb; tb.npanels = 256;
#pragma unroll
                for (int e = 0; e < 8; ++e) tb.pend[e] = 65536;
                if (moe) tb = moe_tab(C, l >> 1);
                const int p_lo = pass * PASS_PANELS, p_hi = moe ? ((pass == NPASS_MOE - 1 || tb.npanels < p_lo + PASS_PANELS) ? tb.npanels : p_lo + PASS_PANELS) : p_lo + PASS_PANELS;
                const int npan = p_hi > p_lo ? p_hi - p_lo : 0;
#if USE_PG8
                LAS unsigned char* pe = C.lds + PE_OFF;
                for (int p = C.tid; p < 528; p += 512) pe[p] = (unsigned char)(moe ? panel_expert(tb, p) : 0);
                __syncthreads();
                { const pg8::Gemm g{WSP(bf16, WS_P), WSP(bf16, WS_WDN), DFF, (size_t)1024 * DFF * 2}; pg8::Order S; S.init(npan, 4, C.G, C.bid, p_lo, 1, pe);
                  pg8::gemm_phase(C.lds, C.tid, g, S, pg8::EpiGate{WSP(bf16, WS_Y), moe ? WSP(float, WS_ROWGATE) : nullptr});
#if PROBE_ID == 7
                  RELAUNDER pg8::gemm_phase(C.lds, C.tid, g, S, pg8::EpiGate{WSP(bf16, WS_Y), moe ? WSP(float, WS_ROWGATE) : nullptr});
#endif
                }
#else
                for (int u = C.bid; u < npan * 4; u += C.G) {
                    const int lp = u >> 2, pn = u & 3, gp = p_lo + lp; const int e = moe ? panel_expert(tb, gp) : 0;
                    const GUnit gu{lp * 256, gp * 256, pn, (size_t)e * 1024 * DFF};
                    if (moe) gemm_simple_unit<0>(C, WSP(bf16, WS_P), DFF, nullptr, WSP(bf16, WS_WDN), DFF, gu, EpiGateS{WSP(bf16, WS_Y), WSP(float, WS_ROWGATE)});
                    else gemm_simple_unit<0>(C, WSP(bf16, WS_P), DFF, nullptr, WSP(bf16, WS_WDN), DFF, gu, EpiStoreS{WSP(bf16, WS_Y), DM});
                }
#endif
            STEP_END
        }
        STEP_BEGIN
            const int l2 = l < 3 ? l + 1 : 3;
            if (l & 1) ph_ln<false, 1, 1>(C, nullptr, l, 1, 5120, l2, 0, l < 3, 0, 3072, l == 3); else ph_ln<false, 0, 1>(C, nullptr, l, 1, 5120, l2, 0, l < 3, 0, 3072, l == 3);
            if (l < 3) ph_conv(C, l + 1);
#if REP_C > 1
            if (l < 3) { RELAUNDER ph_conv(C, l + 1); }
#endif
        STEP_END
    }
#undef STEP_BEGIN
#undef STEP_END
#undef WSP
#undef RELAUNDER
}

#ifndef DUMP_HI
#define DUMP_HI 0
#define DUMP_OFF 0
#define DUMP_WORDS 1
#endif
#if DUMP_HI
__global__ void __launch_bounds__(256) copy_half_k(const unsigned* src, unsigned* dst) {
    for (size_t i = (size_t)blockIdx.x * 256 + threadIdx.x; i < (size_t)65536 * 256; i += (size_t)gridDim.x * 256) dst[i] = src[(i >> 8) * 512 + (i & 255)];
}
__global__ void __launch_bounds__(256) dump_k(const unsigned* src, size_t nwords, float* out) {
    const size_t N = (size_t)MTOK * DM;
    for (size_t i = (size_t)blockIdx.x * 256 + threadIdx.x; i < N; i += (size_t)gridDim.x * 256) {
        float v = 0.f;
        for (size_t k = i % nwords; k < nwords; k += N) { const unsigned w = src[k]; v += (float)((w ^ (w >> 13)) & 0xFFFu); }
        out[i] = v;
    }
}
#endif
extern "C" void kernel_launch(void* const* d_in, const int* in_sizes, int n_in, void* d_out, int out_size, void* d_ws, size_t ws_size, hipStream_t stream) {
    static int grid = 0;
    if (grid == 0) {
        if (n_in != 19 || in_sizes[0] != MTOK * DM || out_size != MTOK * DM || ws_size < WS_END) {
            fprintf(stderr, "kernel_launch: unexpected shapes (n_in %d, in0 %d, out %d, ws %zu); nothing launched\n", n_in, n_in > 0 ? in_sizes[0] : -1, out_size, ws_size); grid = -1; return; }
        int dev = 0, cus = 0, per_cu = 0;
        if (hipGetDevice(&dev) != hipSuccess || hipDeviceGetAttribute(&cus, hipDeviceAttributeMultiprocessorCount, dev) != hipSuccess) { grid = -1; return; }
        if (hipFuncSetAttribute((const void*)hybrid_fwd, hipFuncAttributeMaxDynamicSharedMemorySize, LDS_BYTES) != hipSuccess) { fprintf(stderr, "kernel_launch: hipFuncSetAttribute failed\n"); grid = -1; return; }
        if (hipOccupancyMaxActiveBlocksPerMultiprocessor(&per_cu, (const void*)hybrid_fwd, 512, LDS_BYTES) != hipSuccess || per_cu < 1)
            fprintf(stderr, "kernel_launch: note: occupancy query reports %d workgroups per CU\n", per_cu);
        (void)hipGetLastError();
        grid = cus;
    }
    if (grid < 0) return;
    if (hipMemsetAsync((char*)d_ws + WS_CTL, 0, CTL_ZERO_BYTES, stream) != hipSuccess) { fprintf(stderr, "kernel_launch: memset failed\n"); return; }
    Args a{};
    for (int i = 0; i < 19; ++i) a.in[i] = (const float*)d_in[i];
    a.out = (float*)d_out; a.ws = (unsigned char*)d_ws;
#if MK_MULTI
    for (int s = 0; s < N_STEPS; ++s) { a.lo = s; a.hi = s + 1; hipLaunchKernelGGL(hybrid_fwd, dim3(grid), dim3(512), LDS_BYTES, stream, a); }
#else
#ifdef DUMP_SPLIT
    a.lo = 0; a.hi = DUMP_SPLIT;
    hipLaunchKernelGGL(hybrid_fwd, dim3(grid), dim3(512), LDS_BYTES, stream, a);
    (void)hipMemsetAsync((char*)d_ws + WS_CTL, 0, 65536, stream);
    a.lo = DUMP_SPLIT; a.hi = DUMP_HI;
    hipLaunchKernelGGL(hybrid_fwd, dim3(grid), dim3(512), LDS_BYTES, stream, a);
#else
    a.lo = 0; a.hi = DUMP_HI ? DUMP_HI : N_STEPS;
    hipLaunchKernelGGL(hybrid_fwd, dim3(grid), dim3(512), LDS_BYTES, stream, a);
#endif
#ifdef DUMP_OUTCOPY
    hipLaunchKernelGGL(copy_half_k, dim3(8192), dim3(256), 0, stream, (const unsigned*)d_out + (DUMP_OUTCOPY == 2 ? 256 : 0), (unsigned*)((char*)d_ws + (size_t)DUMP_OFF));
#endif
#if DUMP_HI
    hipLaunchKernelGGL(dump_k, dim3(8192), dim3(256), 0, stream, (const unsigned*)((const char*)d_ws + (size_t)DUMP_OFF), (size_t)DUMP_WORDS, (float*)d_out);
#endif
#endif
    const hipError_t le = hipPeekAtLastError();
    if (le != hipSuccess) fprintf(stderr, "kernel_launch: launch failed: %s\n", hipGetErrorName(le));
}
```

```cpp
#include <hip/hip_runtime.h>
#include <cstdio>
#include <cstdint>

#define GAS __attribute__((address_space(1)))
#define LAS __attribute__((address_space(3)))
typedef unsigned short bf16;
typedef unsigned v4u __attribute__((ext_vector_type(4)));
typedef unsigned v2u __attribute__((ext_vector_type(2)));
typedef float f32x4 __attribute__((ext_vector_type(4)));
typedef float f32x2 __attribute__((ext_vector_type(2)));
typedef float f32x16 __attribute__((ext_vector_type(16)));
typedef short bf16x8 __attribute__((ext_vector_type(8)));

#ifndef MK_MULTI
#define MK_MULTI 0
#endif

constexpr int BATCH = 16, SEQ = 4096, DM = 1024, DEPTH = 4, MTOK = BATCH * SEQ;
constexpr int PW = 2816;
constexpr int PROJ_SRC = 2776;
constexpr int C_AQ = 0, C_IQ = 512, C_BQ = 1024, C_BK = 1280, C_BV = 1536, C_BG = 2048, C_AK = 2560, C_AV = 2624, C_IK = 2688, C_IW = 2752, C_BA = 2760;
constexpr int DFF = 2816, NEXP = 8;
constexpr int PASS_PANELS = 256, NPASS_DENSE = 1, NPASS_MOE = 2;
constexpr float DN_ALPHA = 1.681792830507429f;
constexpr float LN_EPS = 1e-5f;
constexpr float LOG2E = 1.4426950408889634f;

constexpr size_t MiB = 1u << 20;
constexpr size_t WS_CTL = 0, CTL_ZERO_BYTES = 1 * MiB;
constexpr size_t WS_MOD = 1 * MiB;
constexpr size_t WS_TOPE = 3 * MiB;
constexpr size_t WS_TOPG = WS_TOPE + MiB / 2;
constexpr size_t WS_TOKSLOT = WS_TOPG + MiB / 2;
constexpr size_t WS_ROWTOK = 5 * MiB;
constexpr size_t WS_ROWGATE = 6 * MiB;
constexpr size_t WS_WIN = 8 * MiB;
constexpr size_t WS_WOUT = 14 * MiB;
constexpr size_t WS_WGU = 16 * MiB;
constexpr size_t WS_WDN = 104 * MiB;
constexpr size_t WS_H = 148 * MiB;
constexpr size_t WS_P = 276 * MiB;
constexpr size_t WS_Y = 640 * MiB;
constexpr size_t WS_SEL = 900 * MiB;
constexpr size_t WS_END = 1024 * MiB;

constexpr int CW_BAR = 4096;
constexpr int CW_QUEUE = 8192;
constexpr int CW_CNT = 10240;
constexpr int CW_FILL = 10752;

constexpr int LDS_BYTES = 147456;
constexpr int PE_OFF = 131072;
constexpr int MISC_OFF = 139264;

__device__ __forceinline__ float bf2f(unsigned v) { return __uint_as_float(v << 16); }
typedef __bf16 bf16x2_t __attribute__((ext_vector_type(2)));
__device__ __forceinline__ unsigned pk2(float lo, float hi) { const f32x2 v = {lo, hi}; return __builtin_bit_cast(unsigned, __builtin_convertvector(v, bf16x2_t)); }
__device__ __forceinline__ unsigned f2bf(float f) { return pk2(f, 0.f) & 0xffffu; }
__device__ __forceinline__ float wave_sum(float v) {
#pragma unroll
    for (int o = 1; o < 64; o <<= 1) v += __shfl_xor(v, o);
    return v;
}
__device__ __forceinline__ float wave_max(float v) {
#pragma unroll
    for (int o = 1; o < 64; o <<= 1) v = fmaxf(v, __shfl_xor(v, o));
    return v;
}
#define DPP_U32(x, ctrl) ((unsigned)__builtin_amdgcn_update_dpp(0, (int)(x), (ctrl), 0xF, 0xF, true))
__device__ __forceinline__ unsigned wave_sum_u32(unsigned x) {
    x += DPP_U32(x, 0xB1); x += DPP_U32(x, 0x4E); x += DPP_U32(x, 0x124); x += DPP_U32(x, 0x128);
    return (unsigned)__builtin_amdgcn_readlane((int)x, 0) + (unsigned)__builtin_amdgcn_readlane((int)x, 16) + (unsigned)__builtin_amdgcn_readlane((int)x, 32) + (unsigned)__builtin_amdgcn_readlane((int)x, 48);
}
__device__ __forceinline__ float dpp_f32_(float x, int) { return x; }
#define DPP_F32(x, ctrl) (__builtin_bit_cast(float, __builtin_amdgcn_update_dpp(0, __builtin_bit_cast(int, (x)), (ctrl), 0xF, 0xF, true)))
__device__ __forceinline__ float wave_sum_f(float x) {
    x += DPP_F32(x, 0xB1); x += DPP_F32(x, 0x4E); x += DPP_F32(x, 0x124); x += DPP_F32(x, 0x128);
    const float r0 = __builtin_bit_cast(float, __builtin_amdgcn_readlane(__builtin_bit_cast(int, x), 0)), r1 = __builtin_bit_cast(float, __builtin_amdgcn_readlane(__builtin_bit_cast(int, x), 16));
    const float r2 = __builtin_bit_cast(float, __builtin_amdgcn_readlane(__builtin_bit_cast(int, x), 32)), r3 = __builtin_bit_cast(float, __builtin_amdgcn_readlane(__builtin_bit_cast(int, x), 48));
    return (r0 + r1) + (r2 + r3);
}
__device__ __forceinline__ unsigned umax_(unsigned a, unsigned b) { return a > b ? a : b; }
__device__ __forceinline__ unsigned umin_(unsigned a, unsigned b) { return a < b ? a : b; }
__device__ __forceinline__ unsigned wave_max_u32(unsigned x) {
    x = umax_(x, DPP_U32(x, 0xB1)); x = umax_(x, DPP_U32(x, 0x4E)); x = umax_(x, DPP_U32(x, 0x124)); x = umax_(x, DPP_U32(x, 0x128));
    return umax_(umax_((unsigned)__builtin_amdgcn_readlane((int)x, 0), (unsigned)__builtin_amdgcn_readlane((int)x, 16)), umax_((unsigned)__builtin_amdgcn_readlane((int)x, 32), (unsigned)__builtin_amdgcn_readlane((int)x, 48)));
}
__device__ __forceinline__ unsigned wave_min_u32(unsigned x) {
    x = umin_(x, DPP_U32(x, 0xB1)); x = umin_(x, DPP_U32(x, 0x4E)); x = umin_(x, DPP_U32(x, 0x124)); x = umin_(x, DPP_U32(x, 0x128));
    return umin_(umin_((unsigned)__builtin_amdgcn_readlane((int)x, 0), (unsigned)__builtin_amdgcn_readlane((int)x, 16)), umin_((unsigned)__builtin_amdgcn_readlane((int)x, 32), (unsigned)__builtin_amdgcn_readlane((int)x, 48)));
}
#define SHX_F(v, o, lane_) (__builtin_bit_cast(float, __builtin_amdgcn_ds_bpermute((((lane_) ^ (o)) << 2), __builtin_bit_cast(int, (float)(v)))))
#define SHUP_I(v, o, lane_) (__builtin_amdgcn_ds_bpermute((((lane_) - (o)) << 2), (int)(v)))
__device__ __forceinline__ int wave_incl_scan_i(int x, int lane) {
    x += __builtin_amdgcn_update_dpp(0, x, 0x111, 0xF, 0xF, true); x += __builtin_amdgcn_update_dpp(0, x, 0x112, 0xF, 0xF, true);
    x += __builtin_amdgcn_update_dpp(0, x, 0x114, 0xF, 0xF, true); x += __builtin_amdgcn_update_dpp(0, x, 0x118, 0xF, 0xF, true);
    const int t0 = __builtin_amdgcn_readlane(x, 15), t1 = __builtin_amdgcn_readlane(x, 31), t2 = __builtin_amdgcn_readlane(x, 47);
    return x + (lane >= 16 ? t0 : 0) + (lane >= 32 ? t1 : 0) + (lane >= 48 ? t2 : 0);
}
__device__ __forceinline__ float silu_f(float v) { return v / (1.f + expf(-v)); }

#define XB_TMO      128
#define XB_XCNT(j)  (256  + 64 * (j))
#define XB_XSUB(j)  (1280 + 64 * (j))
#define XB_XGEN(j)  (2304 + 64 * (j))
#define XB_TOP      3328
#define XB_TOPGEN   3392
#define XCD_BAR_WORDS 3456
#define XB_SPIN_CAP (1u << 21)

__device__ __forceinline__ unsigned xb_ld(unsigned* p)              { return __hip_atomic_load(p, __ATOMIC_RELAXED, __HIP_MEMORY_SCOPE_AGENT); }
__device__ __forceinline__ unsigned xb_add(unsigned* p, unsigned v) { return __hip_atomic_fetch_add(p, v, __ATOMIC_RELAXED, __HIP_MEMORY_SCOPE_AGENT); }
__device__ __forceinline__ unsigned xb_xcc_id() { return (unsigned)__builtin_amdgcn_s_getreg((3 << 11) | 20) & 0xFu; }
#define XB_SPIN(cond, bar) do { unsigned _sp = 0; while (cond) { __builtin_amdgcn_s_sleep(1); \
    if ((++_sp & 255u) == 0u) { if (xb_ld(&(bar)[XB_TMO])) break; if (_sp > XB_SPIN_CAP) { atomicAdd(&(bar)[XB_TMO], 1u); break; } } } } while (0)

struct XcdBarrier {
    unsigned* bar; unsigned x;
    volatile LAS unsigned* st;
};

__device__ __forceinline__ XcdBarrier xcd_barrier_post(unsigned* bar, volatile LAS unsigned* st) {
    XcdBarrier b; b.bar = bar; b.x = xb_xcc_id(); b.st = st;
    if (threadIdx.x == 0) (void)xb_add(&bar[XB_XCNT(b.x)], 1u);
    return b;
}
__device__ __forceinline__ void xcd_barrier_complete(unsigned* bar, unsigned x, unsigned& nloc, unsigned& nx) {
    const unsigned G = gridDim.x * gridDim.y * gridDim.z;
    unsigned sum, cnt, mine, sp = 0u;
    for (;;) {
        sum = 0u; cnt = 0u; mine = 0u;
#pragma unroll
        for (unsigned j = 0; j < 16; ++j) { const unsigned c = xb_ld(&bar[XB_XCNT(j)]); sum += c; cnt += (c > 0u) ? 1u : 0u; mine = (j == x) ? c : mine; }
        if (sum == G) break;
        __builtin_amdgcn_s_sleep(1);
        if ((++sp & 255u) == 0u) { if (xb_ld(&bar[XB_TMO])) break; if (sp > XB_SPIN_CAP) { atomicAdd(&bar[XB_TMO], 1u); break; } }
    }
    nloc = mine > 0u ? mine : 1u; nx = cnt > 0u ? cnt : 1u;
}

__device__ __forceinline__ void xcd_barrier(const XcdBarrier& b) {
    asm volatile("s_waitcnt vmcnt(0)" ::: "memory");
    __syncthreads();
    if (threadIdx.x == 0) {
        unsigned* bar = b.bar;
        __builtin_amdgcn_s_waitcnt(0);
        unsigned nloc = b.st[0], nx = b.st[1];
        if (nloc == 0u) { xcd_barrier_complete(bar, b.x, nloc, nx); b.st[0] = nloc; b.st[1] = nx; }
        const unsigned old = xb_add(&bar[XB_XSUB(b.x)], 1u);
        const unsigned gen = old / nloc;
        if (old + 1u == (gen + 1u) * nloc) {
            __builtin_amdgcn_fence(__ATOMIC_RELEASE, "agent");
            asm volatile("s_waitcnt vmcnt(0)" ::: "memory");
            const unsigned og = xb_add(&bar[XB_TOP], 1u);
            const unsigned tg = og / nx;
            if (og + 1u == (tg + 1u) * nx) xb_add(&bar[XB_TOPGEN], 1u);
            else XB_SPIN(xb_ld(&bar[XB_TOPGEN]) == tg, bar);
            __builtin_amdgcn_fence(__ATOMIC_ACQUIRE, "agent");
            xb_add(&bar[XB_XGEN(b.x)], 1u);
            asm volatile("s_waitcnt vmcnt(0)" ::: "memory");
        } else {
            XB_SPIN(xb_ld(&bar[XB_XGEN(b.x)]) == gen, bar);
            __builtin_amdgcn_fence(__ATOMIC_ACQUIRE, "agent");
            asm volatile("s_waitcnt vmcnt(0)" ::: "memory");
        }
    }
    __syncthreads();
}


struct Args { const float* in[19]; float* out; unsigned char* ws; int lo, hi; };
typedef const Args __attribute__((address_space(4))) KArgs;
struct Ctx {
    LAS unsigned char* lds;
    volatile LAS unsigned* MISC;
    unsigned* ctl;
    int tid, lane, wave, G, bid;
    int hot;
    KArgs* ka;
    float* out; unsigned char* ws;
    __device__ __forceinline__ const float* in(int i) const { return ka->in[i]; }
};
enum { I_X = 0, I_C, I_WIN, I_WA2, I_BA, I_GLAG, I_WOUT, I_WMOD, I_BMOD, I_LNG, I_LNB, I_FG, I_FU, I_FD, I_WR, I_BR, I_MG, I_MU, I_MD };

__device__ __forceinline__ f32x16 mfma32(bf16x8 a, bf16x8 b, f32x16 c) { return __builtin_amdgcn_mfma_f32_32x32x16_bf16(a, b, c, 0, 0, 0); }

__device__ __forceinline__ void ph_mod(Ctx& C) {
    LAS float* sc = (LAS float*)C.lds;
    LAS float* red = (LAS float*)(C.lds + 65536);
    const float* c = C.in(I_C);
    for (int i = C.tid; i < 16 * 1024; i += 512) sc[i] = silu_f(c[i]);
    __syncthreads();
    const float* wmod = C.in(I_WMOD); const float* bmod = C.in(I_BMOD);
    float* MOD = (float*)(C.ws + WS_MOD);
    for (int u = C.bid; u < 4 * 96; u += C.G) {
        const int l = u / 96, cc = u % 96, col = cc * 64 + C.lane;
        float acc[16];
#pragma unroll
        for (int b = 0; b < 16; ++b) acc[b] = 0.f;
        const float* wp = wmod + ((size_t)l * 1024 + C.wave * 128) * 6144 + col;
        const LAS float* sp = sc + C.wave * 128;
#pragma unroll 16
        for (int kk = 0; kk < 128; ++kk) {
            const float w = wp[(size_t)kk * 6144];
#pragma unroll
            for (int b = 0; b < 16; ++b) acc[b] += sp[b * 1024 + kk] * w;
        }
#pragma unroll
        for (int b = 0; b < 16; ++b) red[(C.wave * 16 + b) * 64 + C.lane] = acc[b];
        __syncthreads();
        for (int o = C.tid; o < 1024; o += 512) {
            const int b = o >> 6, ln = o & 63; float s = 0.f;
#pragma unroll
            for (int w = 0; w < 8; ++w) s += red[(w * 16 + b) * 64 + ln];
            const int cl = cc * 64 + ln;
            MOD[((size_t)l * 16 + b) * 6144 + cl] = s + bmod[l * 6144 + cl];
        }
        __syncthreads();
    }
}

__device__ __forceinline__ void conv_item(const float* colp, int ldn, int K, bf16* WT, LAS float* scr, int kb, int nb, int lane) {
    const int k0 = 64 * kb, n0 = 32 * nb;
    float tv[32];
#pragma unroll
    for (int i = 0; i < 32; ++i) { const int kk = 2 * i + (lane >> 5); tv[i] = colp ? colp[(size_t)(k0 + kk) * ldn] : 0.f; }
#pragma unroll
    for (int i = 0; i < 32; ++i) { const int kk = 2 * i + (lane >> 5); scr[kk * 33 + (lane & 31)] = tv[i]; }
    asm volatile("s_waitcnt lgkmcnt(0)" ::: "memory");
    const int c = lane & 7;
#pragma unroll
    for (int j = 0; j < 4; ++j) {
        const int n = (lane >> 3) + 8 * j; const LAS float* s = scr + (8 * c) * 33 + n;
        v4u o; o.x = pk2(s[0 * 33], s[1 * 33]); o.y = pk2(s[2 * 33], s[3 * 33]); o.z = pk2(s[4 * 33], s[5 * 33]); o.w = pk2(s[6 * 33], s[7 * 33]);
        *(v4u*)(WT + (size_t)(n0 + n) * K + k0 + 8 * c) = o;
    }
    asm volatile("s_waitcnt lgkmcnt(0)" ::: "memory");
}
__device__ __forceinline__ int win_src_col(int n) {
    if (n < C_IQ) return n;
    if (n < C_BQ) return 640 + (n - C_IQ);
    if (n < C_AK) return 1224 + (n - C_BQ);
    if (n < C_AV) return 512 + (n - C_AK);
    if (n < C_IK) return 576 + (n - C_AV);
    if (n < C_IW) return 1152 + (n - C_IK);
    if (n < C_BA) return 1216 + (n - C_IW);
    if (n < PROJ_SRC) return 2760 + (n - C_BA);
    return -1;
}
__device__ __forceinline__ void ph_conv(Ctx& C, int l) {
    LAS float* scr = (LAS float*)(C.lds + C.wave * 8448);
    const int gw = C.bid * 8 + C.wave, NGW = C.G * 8;
    const bool moe = (l & 1) != 0; const int j = l >> 1, ne = moe ? NEXP : 1;
    constexpr int I_IN = 16 * 88, I_OUT = 16 * 32, I_GU = 16 * 176, I_DN = 44 * 32;
    const int nitems = I_IN + I_OUT + ne * (I_GU + I_DN);
    bf16* WIN = (bf16*)(C.ws + WS_WIN); bf16* WOUT = (bf16*)(C.ws + WS_WOUT); bf16* WGU = (bf16*)(C.ws + WS_WGU); bf16* WDN = (bf16*)(C.ws + WS_WDN);
    for (int it = gw; it < nitems; it += NGW) {
        int r = it;
        if (r < I_IN) { const int kb = r / 88, nb = r % 88; const int sc_ = win_src_col(nb * 32 + (C.lane & 31));
            const float* W = C.in(I_WIN) + (size_t)l * 1024 * PROJ_SRC;
            conv_item(sc_ >= 0 ? W + sc_ : nullptr, PROJ_SRC, 1024, WIN, scr, kb, nb, C.lane); continue; }
        r -= I_IN;
        if (r < I_OUT) { const int kb = r / 32, nb = r % 32; const float* W = C.in(I_WOUT) + (size_t)l * 1024 * 1024;
            conv_item(W + nb * 32 + (C.lane & 31), 1024, 1024, WOUT, scr, kb, nb, C.lane); continue; }
        r -= I_OUT;
        const int e = r / (I_GU + I_DN); r -= e * (I_GU + I_DN);
        const size_t eoff = (size_t)(j * ne + e) * 1024 * DFF;
        if (r < I_GU) { const int kb = r / 176, nb = r % 176; const int n = nb * 32 + (C.lane & 31), T = n >> 8, jj = n & 255;
            const float* Wg = (moe ? C.in(I_MG) : C.in(I_FG)) + eoff; const float* Wu = (moe ? C.in(I_MU) : C.in(I_FU)) + eoff;
            const float* colp = (jj < 128) ? Wg + T * 128 + jj : Wu + T * 128 + (jj - 128);
            conv_item(colp, DFF, 1024, WGU + (size_t)e * 5632 * 1024, scr, kb, nb, C.lane); continue; }
        r -= I_GU;
        { const int kb = r / 32, nb = r % 32; const float* Wd = (moe ? C.in(I_MD) : C.in(I_FD)) + eoff;
          conv_item(Wd + nb * 32 + (C.lane & 31), 1024, DFF, WDN + (size_t)e * 1024 * DFF, scr, kb, nb, C.lane); }
    }
}

__device__ __forceinline__ void ph_modulate0(Ctx& C) {
    const int gw = C.bid * 8 + C.wave, NGW = C.G * 8;
    const float* MOD = (const float*)(C.ws + WS_MOD); bf16* H = (bf16*)(C.ws + WS_H); const float* x = C.in(I_X);
    for (int row = gw; row < MTOK; row += NGW) {
        const int b = row >> 12; const float* md = MOD + (size_t)b * 6144;
#pragma unroll
        for (int j = 0; j < 4; ++j) {
            const int col = 4 * C.lane + 256 * j;
            const f32x4 v = *(const f32x4*)(x + (size_t)row * DM + col), sh = *(const f32x4*)(md + col), sc = *(const f32x4*)(md + 1024 + col);
            v2u o; o.x = pk2(v.x * (1.f + sc.x) + sh.x, v.y * (1.f + sc.y) + sh.y); o.y = pk2(v.z * (1.f + sc.z) + sh.z, v.w * (1.f + sc.w) + sh.w);
            *(v2u*)(H + (size_t)row * DM + col) = o;
        }
    }
}

struct GUnit { int arow0; int orow0; int pn; size_t boff; };
template <int MODE, class Epi>
__device__ __forceinline__ void gemm_simple_unit(Ctx& C, const bf16* A, int lda, const int* rowmap, const bf16* Bt, int K, const GUnit& u, const Epi& E) {
    const int rs = C.wave & 3, ch = C.wave >> 2, n = C.lane & 31, h = C.lane >> 5;
    const int r0 = u.arow0 + rs * 64 + n;
    const int ra = rowmap ? rowmap[r0] : r0, rb = rowmap ? rowmap[r0 + 32] : r0 + 32;
    const bf16* a0p = A + (size_t)ra * lda + 8 * h; const bf16* a1p = A + (size_t)rb * lda + 8 * h;
#pragma unroll 1
    for (int sp = 0; sp < 2; ++sp) {
        int br0, br1;
        if (MODE == 1) { const int jj = 2 * ch + sp; br0 = u.pn * 256 + 32 * jj; br1 = br0 + 128; }
        else { br0 = u.pn * 256 + 128 * ch + 64 * sp; br1 = br0 + 32; }
        const bf16* b0p = Bt + u.boff + (size_t)(br0 + n) * K + 8 * h; const bf16* b1p = Bt + u.boff + (size_t)(br1 + n) * K + 8 * h;
        f32x16 c00, c01, c10, c11;
#pragma unroll
        for (int i = 0; i < 16; ++i) { c00[i] = 0.f; c01[i] = 0.f; c10[i] = 0.f; c11[i] = 0.f; }
#pragma unroll 4
        for (int k = 0; k < K; k += 16) {
            const bf16x8 a0 = *(const bf16x8*)(a0p + k), a1 = *(const bf16x8*)(a1p + k), b0 = *(const bf16x8*)(b0p + k), b1 = *(const bf16x8*)(b1p + k);
            c00 = mfma32(a0, b0, c00); c01 = mfma32(a0, b1, c01); c10 = mfma32(a1, b0, c10); c11 = mfma32(a1, b1, c11);
        }
        const int orow = u.orow0 + rs * 64 + 4 * h;
        E(c00, c01, orow, br0, br1, n, u);
        E(c10, c11, orow + 32, br0, br1, n, u);
    }
}
struct EpiStoreS {
    bf16* O; int ldc;
    __device__ __forceinline__ void operator()(const f32x16& c0, const f32x16& c1, int orow, int br0, int br1, int n, const GUnit&) const {
#pragma unroll
        for (int r = 0; r < 16; ++r) { const size_t row = (size_t)(orow + (r & 3) + 8 * (r >> 2));
            O[row * ldc + br0 + n] = (bf16)f2bf(c0[r]); O[row * ldc + br1 + n] = (bf16)f2bf(c1[r]); }
    }
};
struct EpiSwigluS {
    bf16* O;
    __device__ __forceinline__ void operator()(const f32x16& c0, const f32x16& c1, int orow, int br0, int br1, int n, const GUnit& u) const {
        const int col = 128 * u.pn + (br0 - 256 * u.pn) + n;
#pragma unroll
        for (int r = 0; r < 16; ++r) { const size_t row = (size_t)(orow + (r & 3) + 8 * (r >> 2));
            O[row * DFF + col] = (bf16)f2bf(silu_f(c0[r]) * c1[r]); }
    }
};
struct EpiGateS {
    bf16* O; const float* gate;
    __device__ __forceinline__ void operator()(const f32x16& c0, const f32x16& c1, int orow, int br0, int br1, int n, const GUnit&) const {
#pragma unroll
        for (int r = 0; r < 16; ++r) { const size_t row = (size_t)(orow + (r & 3) + 8 * (r >> 2)); const float g = gate[row];
            O[row * DM + br0 + n] = (bf16)f2bf(c0[r] * g); O[row * DM + br1 + n] = (bf16)f2bf(c1[r] * g); }
    }
};

__device__ __forceinline__ void ph_gla_unit(Ctx& C, int l, int b, int hh) {
    LAS float* q_s = (LAS float*)C.lds;
    LAS float* k_s = q_s + 4096;
    LAS float* a_s = k_s + 4096;
    LAS float* v_s = a_s + 4096;
    LAS float* o_s = v_s + 8192;
    const bf16* PROJ = (const bf16*)(C.ws + WS_P); bf16* YM = (bf16*)(C.ws + WS_H);
    const float* w_a2 = C.in(I_WA2) + (size_t)l * 16 * 256; const float* b_a = C.in(I_BA) + l * 256; const float* gg = C.in(I_GLAG) + l * 128;
    const int e = C.tid >> 2, dg = C.tid & 3;
    float S[16];
#pragma unroll
    for (int i = 0; i < 16; ++i) S[i] = 0.f;
    for (int c = 0; c < 64; ++c) {
        const size_t row0 = (size_t)b * SEQ + c * 64;
        {
            const int t = C.tid >> 3, d0 = (C.tid & 7) * 8; const bf16* pr = PROJ + (row0 + t) * PW;
            const v4u qv = *(const v4u*)(pr + C_BQ + hh * 64 + d0), kv = *(const v4u*)(pr + C_BK + hh * 64 + d0);
            const v4u ba0 = *(const v4u*)(pr + C_BA), ba1 = *(const v4u*)(pr + C_BA + 8);
            float baf[16];
            baf[0] = bf2f(ba0.x & 0xffffu); baf[1] = bf2f(ba0.x >> 16); baf[2] = bf2f(ba0.y & 0xffffu); baf[3] = bf2f(ba0.y >> 16);
            baf[4] = bf2f(ba0.z & 0xffffu); baf[5] = bf2f(ba0.z >> 16); baf[6] = bf2f(ba0.w & 0xffffu); baf[7] = bf2f(ba0.w >> 16);
            baf[8] = bf2f(ba1.x & 0xffffu); baf[9] = bf2f(ba1.x >> 16); baf[10] = bf2f(ba1.y & 0xffffu); baf[11] = bf2f(ba1.y >> 16);
            baf[12] = bf2f(ba1.z & 0xffffu); baf[13] = bf2f(ba1.z >> 16); baf[14] = bf2f(ba1.w & 0xffffu); baf[15] = bf2f(ba1.w >> 16);
            const unsigned qw[4] = {qv.x, qv.y, qv.z, qv.w}, kw[4] = {kv.x, kv.y, kv.z, kv.w};
#pragma unroll
            for (int i = 0; i < 8; ++i) {
                const int d = d0 + i; float z = b_a[hh * 64 + d];
#pragma unroll
                for (int r = 0; r < 16; ++r) z += baf[r] * w_a2[r * 256 + hh * 64 + d];
                const float ls = fminf(z, 0.f) - log1pf(expf(-fabsf(z)));
                a_s[t * 64 + d] = expf(ls * (1.f / 16.f));
                const unsigned qq = (i & 1) ? (qw[i >> 1] >> 16) : (qw[i >> 1] & 0xffffu), kk = (i & 1) ? (kw[i >> 1] >> 16) : (kw[i >> 1] & 0xffffu);
                q_s[t * 64 + d] = bf2f(qq) * 0.125f; k_s[t * 64 + d] = bf2f(kk);
            }
            const int e0 = (C.tid & 7) * 16;
            const v4u v0 = *(const v4u*)(pr + C_BV + hh * 128 + e0), v1 = *(const v4u*)(pr + C_BV + hh * 128 + e0 + 8);
            const unsigned vw[8] = {v0.x, v0.y, v0.z, v0.w, v1.x, v1.y, v1.z, v1.w};
#pragma unroll
            for (int i = 0; i < 8; ++i) { v_s[t * 128 + e0 + 2 * i] = bf2f(vw[i] & 0xffffu); v_s[t * 128 + e0 + 2 * i + 1] = bf2f(vw[i] >> 16); }
        }
        __syncthreads();
        for (int tt = 0; tt < 64; ++tt) {
            const float vv = v_s[tt * 128 + e]; float po = 0.f;
#pragma unroll
            for (int i = 0; i < 16; ++i) { const int d = 16 * dg + i; S[i] = a_s[tt * 64 + d] * S[i] + k_s[tt * 64 + d] * vv; po += q_s[tt * 64 + d] * S[i]; }
            po += __shfl_xor(po, 1); po += __shfl_xor(po, 2);
            if (dg == 0) o_s[tt * 128 + e] = po;
        }
        __syncthreads();
#pragma unroll 1
        for (int r = 0; r < 8; ++r) {
            const int tt = C.wave * 8 + r; const float o0 = o_s[tt * 128 + C.lane], o1 = o_s[tt * 128 + 64 + C.lane];
            const float ss = wave_sum(o0 * o0 + o1 * o1); const float rstd = rsqrtf(ss * (1.f / 128.f) + LN_EPS);
            const bf16* pr = PROJ + (row0 + tt) * PW + C_BG + hh * 128; const float g0 = bf2f(pr[C.lane]), g1 = bf2f(pr[64 + C.lane]);
            bf16* yo = YM + (row0 + tt) * DM + 512 + hh * 128;
            yo[C.lane] = (bf16)f2bf(o0 * rstd * gg[C.lane] * silu_f(g0)); yo[64 + C.lane] = (bf16)f2bf(o1 * rstd * gg[64 + C.lane] * silu_f(g1));
        }
        __syncthreads();
    }
}

__device__ __forceinline__ unsigned sortable_u32(float f) { const unsigned u = __float_as_uint(f + 0.0f); return (u & 0x80000000u) ? ~u : (u | 0x80000000u); }
__device__ __forceinline__ void ph_dsa_a_unit(Ctx& C, int b, int t0) {
    LAS unsigned* sc = (LAS unsigned*)C.lds;
    LAS unsigned* cnt = (LAS unsigned*)(C.lds + 131072);
    const bf16* PROJ = (const bf16*)(C.ws + WS_P); unsigned* SEL = (unsigned*)(C.ws + WS_SEL);
    const int lane = C.lane, n = lane & 31, h = lane >> 5, tid = C.tid;
    const int nk = t0 + 8, ntile = (nk + 31) >> 5, nscan = ntile * 32;
    if (tid < 48) cnt[tid] = 0u;
    {
        bf16x8 af[2][4]; float wv[2][4][4];
#pragma unroll
        for (int mt = 0; mt < 2; ++mt) {
            const bf16* p = PROJ + (size_t)(b * SEQ + t0 + 4 * mt + (n >> 3)) * PW + C_IQ + (n & 7) * 64 + 8 * h;
#pragma unroll
            for (int ks = 0; ks < 4; ++ks) af[mt][ks] = *(const bf16x8*)(p + ks * 16);
#pragma unroll
            for (int jq = 0; jq < 4; ++jq)
#pragma unroll
                for (int i = 0; i < 4; ++i) wv[mt][jq][i] = bf2f(PROJ[(size_t)(b * SEQ + t0 + 4 * mt + jq) * PW + C_IW + i + 4 * h]) * (0.35355339059327373f * 0.125f);
        }
        for (int tile = C.wave; tile < ntile; tile += 8) {
            const int s = tile * 32 + n; const bf16* kp = PROJ + (size_t)(b * SEQ + s) * PW + C_IK + 8 * h;
            bf16x8 bfr[4];
#pragma unroll
            for (int ks = 0; ks < 4; ++ks) bfr[ks] = *(const bf16x8*)(kp + ks * 16);
#pragma unroll
            for (int mt = 0; mt < 2; ++mt) {
                f32x16 acc;
#pragma unroll
                for (int i = 0; i < 16; ++i) acc[i] = 0.f;
#pragma unroll
                for (int ks = 0; ks < 4; ++ks) acc = mfma32(af[mt][ks], bfr[ks], acc);
#pragma unroll
                for (int jq = 0; jq < 4; ++jq) {
                    float p = 0.f;
#pragma unroll
                    for (int i = 0; i < 4; ++i) p += wv[mt][jq][i] * fmaxf(acc[4 * jq + i], 0.f);
                    p += __shfl_xor(p, 32);
                    const int t = t0 + 4 * mt + jq; const unsigned u = (s <= t) ? sortable_u32(p) : 0u;
                    if (h == mt) sc[(4 * mt + jq) * 4096 + s] = u;
                }
            }
        }
    }
    __syncthreads();
    unsigned u[8][8];
#pragma unroll
    for (int i = 0; i < 8; ++i) {
        const int s = tid + 512 * i; const bool inr = s < nscan; const int sidx = inr ? s : 0;
#pragma unroll
        for (int q = 0; q < 8; ++q) { const unsigned v = sc[q * 4096 + sidx]; u[i][q] = inr ? v : 0u; }
    }
    unsigned T[8], J[8], need[8];
#pragma unroll
    for (int q = 0; q < 8; ++q) { T[q] = 0u; J[q] = 8192u; need[q] = 0u; }
    int buf = 0;
    for (int bit = 31; bit >= 0; --bit) {
        unsigned cq[8];
#pragma unroll
        for (int q = 0; q < 8; ++q) cq[q] = 0u;
#pragma unroll
        for (int i = 0; i < 8; ++i) if (512 * i < nscan) {
#pragma unroll
            for (int q = 0; q < 8; ++q) cq[q] += (unsigned)__popcll(__ballot(u[i][q] >= (T[q] | (1u << bit))));
        }
        unsigned myc = 0u;
#pragma unroll
        for (int q = 0; q < 8; ++q) myc = (lane == q) ? cq[q] : myc;
        if (lane < 8) __hip_atomic_fetch_add(cnt + buf * 16 + lane, myc, __ATOMIC_RELAXED, __HIP_MEMORY_SCOPE_WORKGROUP);
        const int nb = (buf == 2) ? 0 : buf + 1;
        if (tid >= 64 && tid < 80) cnt[nb * 16 + (tid - 64)] = 0u;
        __syncthreads();
#pragma unroll
        for (int q = 0; q < 8; ++q) if (cnt[buf * 16 + q] >= 256u) T[q] |= (1u << bit);
        buf = nb;
    }
#pragma unroll
    for (int q = 0; q < 8; ++q) T[q] = T[q] < 1u ? 1u : T[q];
    bool extra = false;
    {
        unsigned cg[8], ce[8];
#pragma unroll
        for (int q = 0; q < 8; ++q) { cg[q] = 0u; ce[q] = 0u; }
#pragma unroll
        for (int i = 0; i < 8; ++i) if (512 * i < nscan) {
#pragma unroll
            for (int q = 0; q < 8; ++q) { cg[q] += (unsigned)__popcll(__ballot(u[i][q] > T[q])); ce[q] += (unsigned)__popcll(__ballot(u[i][q] >= T[q])); }
        }
        unsigned myc = 0u;
#pragma unroll
        for (int q = 0; q < 8; ++q) { myc = (lane == q) ? cg[q] : myc; myc = (lane == 8 + q) ? ce[q] : myc; }
        if (lane < 16) __hip_atomic_fetch_add(cnt + buf * 16 + lane, myc, __ATOMIC_RELAXED, __HIP_MEMORY_SCOPE_WORKGROUP);
        const int nb = (buf == 2) ? 0 : buf + 1;
        if (tid >= 64 && tid < 80) cnt[nb * 16 + (tid - 64)] = 0u;
        __syncthreads();
#pragma unroll
        for (int q = 0; q < 8; ++q) { const unsigned g = cnt[buf * 16 + q], ge = cnt[buf * 16 + 8 + q]; need[q] = 256u - (g < 256u ? g : 256u); extra = extra || (ge > 256u); }
        buf = nb;
    }
    if (extra) {
#pragma unroll
        for (int q = 0; q < 8; ++q) J[q] = 0u;
        for (int bit = 12; bit >= 0; --bit) {
            unsigned cq[8];
#pragma unroll
            for (int q = 0; q < 8; ++q) cq[q] = 0u;
#pragma unroll
            for (int i = 0; i < 8; ++i) if (512 * i < nscan) {
                const unsigned s = (unsigned)(tid + 512 * i);
#pragma unroll
                for (int q = 0; q < 8; ++q) cq[q] += (unsigned)__popcll(__ballot(u[i][q] == T[q] && s < (J[q] | (1u << bit))));
            }
            unsigned myc = 0u;
#pragma unroll
            for (int q = 0; q < 8; ++q) myc = (lane == q) ? cq[q] : myc;
            if (lane < 8) __hip_atomic_fetch_add(cnt + buf * 16 + lane, myc, __ATOMIC_RELAXED, __HIP_MEMORY_SCOPE_WORKGROUP);
            const int nb = (buf == 2) ? 0 : buf + 1;
            if (tid >= 64 && tid < 80) cnt[nb * 16 + (tid - 64)] = 0u;
            __syncthreads();
#pragma unroll
            for (int q = 0; q < 8; ++q) if (cnt[buf * 16 + q] <= need[q]) J[q] |= (1u << bit);
            buf = nb;
        }
    }
#pragma unroll
    for (int i = 0; i < 8; ++i) if (512 * i < nscan) {
        const unsigned s = (unsigned)(tid + 512 * i); const int tile0 = 2 * C.wave + 16 * i;
#pragma unroll
        for (int q = 0; q < 8; ++q) {
            const unsigned long long bm = __ballot((u[i][q] > T[q]) || (u[i][q] == T[q] && s < J[q]));
            if (lane == 0) { unsigned* w = SEL + (size_t)(b * SEQ + t0 + q) * 128 + tile0;
                if (tile0 < ntile) w[0] = (unsigned)bm; if (tile0 + 1 < ntile) w[1] = (unsigned)(bm >> 32); }
        }
    }
    __syncthreads();
}

__device__ __forceinline__ void ph_dsa_b_unit(Ctx& C, int b, int t0) {
    LAS float* qs = (LAS float*)C.lds + C.wave * 512;
    LAS int* lst = (LAS int*)(C.lds + 16384) + C.wave * 256;
    LAS float* pl = (LAS float*)(C.lds + 16384 + 8192) + C.wave * 2048;
    const bf16* PROJ = (const bf16*)(C.ws + WS_P); const unsigned* SEL = (const unsigned*)(C.ws + WS_SEL); bf16* YM = (bf16*)(C.ws + WS_H);
    const int lane = C.lane, t = t0 + C.wave; const size_t row = (size_t)b * SEQ + t;
    const int ntile = (t >> 5) + 1;
    int base = 0;
#pragma unroll 1
    for (int rd = 0; rd < 2; ++rd) {
        const int wi = rd * 64 + lane; unsigned w = (wi < ntile) ? SEL[row * 128 + wi] : 0u;
        const int c = __popc(w); int incl = c;
#pragma unroll
        for (int o = 1; o < 64; o <<= 1) { const int v = __shfl_up(incl, o); if (lane >= o) incl += v; }
        int pos = base + incl - c;
        while (w) { const int bit = __ffs(w) - 1; w &= w - 1; if (pos < 256) lst[pos] = wi * 32 + bit; ++pos; }
        base += __shfl(incl, 63);
    }
    const int nsel = base < 256 ? base : 256;
    {
        const v4u qv = *(const v4u*)(PROJ + row * PW + C_AQ + lane * 8); const unsigned qw[4] = {qv.x, qv.y, qv.z, qv.w};
#pragma unroll
        for (int i = 0; i < 4; ++i) { qs[lane * 8 + 2 * i] = bf2f(qw[i] & 0xffffu) * (0.125f * LOG2E); qs[lane * 8 + 2 * i + 1] = bf2f(qw[i] >> 16) * (0.125f * LOG2E); }
    }
    asm volatile("s_waitcnt lgkmcnt(0)" ::: "memory");
    float mx[8];
#pragma unroll
    for (int hd = 0; hd < 8; ++hd) mx[hd] = -3.0e38f;
#pragma unroll 1
    for (int i = 0; i < 4; ++i) {
        const int j = lane + 64 * i;
        asm volatile("" ::: "memory");
        if (j < nsel) {
            const int s = lst[j];
            const bf16* kp = PROJ + ((size_t)b * SEQ + s) * PW + C_AK;
            float kr[64];
#pragma unroll
            for (int c8 = 0; c8 < 8; ++c8) { const v4u kv = *(const v4u*)(kp + 8 * c8); const unsigned kw[4] = {kv.x, kv.y, kv.z, kv.w};
#pragma unroll
                for (int x = 0; x < 4; ++x) { kr[8 * c8 + 2 * x] = bf2f(kw[x] & 0xffffu); kr[8 * c8 + 2 * x + 1] = bf2f(kw[x] >> 16); } }
#pragma unroll
            for (int hd = 0; hd < 8; ++hd) {
                float d = 0.f;
#pragma unroll
                for (int x = 0; x < 64; ++x) d += qs[hd * 64 + x] * kr[x];
                const float slope2 = exp2f(-(float)(hd + 1)) * LOG2E;
                const float lgv = d - slope2 * (float)(t - s);
                pl[j * 8 + hd] = lgv; mx[hd] = fmaxf(mx[hd], lgv);
            }
        }
    }
#pragma unroll
    for (int hd = 0; hd < 8; ++hd) mx[hd] = wave_max(mx[hd]);
    asm volatile("s_waitcnt lgkmcnt(0)" ::: "memory");
    float sm[8];
#pragma unroll
    for (int hd = 0; hd < 8; ++hd) sm[hd] = 0.f;
#pragma unroll 1
    for (int i = 0; i < 4; ++i) {
        const int j = lane + 64 * i;
        if (j < nsel) {
#pragma unroll
            for (int hd = 0; hd < 8; ++hd) { const float p = exp2f(pl[j * 8 + hd] - mx[hd]); pl[j * 8 + hd] = p; sm[hd] += p; }
        }
    }
#pragma unroll
    for (int hd = 0; hd < 8; ++hd) sm[hd] = 1.f / wave_sum(sm[hd]);
    asm volatile("s_waitcnt lgkmcnt(0)" ::: "memory");
    float acc[8];
#pragma unroll
    for (int hd = 0; hd < 8; ++hd) acc[hd] = 0.f;
    const bf16* vb = PROJ + (size_t)b * SEQ * PW + C_AV + lane;
#pragma unroll 4
    for (int j = 0; j < nsel; ++j) {
        const int s = lst[j]; const float v = bf2f(vb[(size_t)s * PW]);
        const f32x4 p0 = *(const LAS f32x4*)(pl + j * 8), p1 = *(const LAS f32x4*)(pl + j * 8 + 4);
        acc[0] += p0.x * v; acc[1] += p0.y * v; acc[2] += p0.z * v; acc[3] += p0.w * v; acc[4] += p1.x * v; acc[5] += p1.y * v; acc[6] += p1.z * v; acc[7] += p1.w * v;
    }
#pragma unroll
    for (int hd = 0; hd < 8; ++hd) acc[hd] *= sm[hd];
#pragma unroll
    for (int hd = 0; hd < 8; ++hd) YM[row * DM + hd * 64 + lane] = (bf16)f2bf(acc[hd]);
}

struct LnRaw { f32x4 x[4]; v2u ya[4]; v2u yb[4]; v2u hx[4]; };
template <bool ROUTE, int YMODE, int XMODE>
__device__ __forceinline__ void ph_ln(Ctx& C, const float* Xin, int l, int which, int mod_g, int mod_l2, int mod_sh, bool write_h, int jmoe, int mod_in, bool write_x) {
    const int gw = C.bid * 8 + C.wave, NGW = C.G * 8, lane = C.lane;
    const float* MOD = (const float*)(C.ws + WS_MOD); bf16* H = (bf16*)(C.ws + WS_H); const bf16* Y = (const bf16*)(C.ws + WS_Y);
    const float* lng = C.in(I_LNG) + (size_t)(l * 2 + which) * DM; const float* lnb = C.in(I_LNB) + (size_t)(l * 2 + which) * DM;
    const int* TOKSLOT = (const int*)(C.ws + WS_TOKSLOT);
    const float* wr = C.in(I_WR) + (size_t)jmoe * DM * NEXP; const float* br = C.in(I_BR) + jmoe * NEXP;
    int* TOPE = (int*)(C.ws + WS_TOPE); float* TOPG = (float*)(C.ws + WS_TOPG);
    unsigned ecnt[8];
#pragma unroll
    for (int e = 0; e < 8; ++e) ecnt[e] = 0u;
    LAS float* wrs = (LAS float*)C.lds;
    if (ROUTE) { for (int i = C.tid; i < DM * NEXP / 4; i += 512) ((LAS f32x4*)wrs)[i] = ((const f32x4*)wr)[i]; __syncthreads(); }
    const int RPW = (MTOK + NGW - 1) / NGW;
    const int r0 = gw * RPW, r1 = (r0 + RPW < MTOK) ? r0 + RPW : MTOK;
    if (r0 < MTOK) {
        const int b = r0 >> 12;
        const bool one_batch = ((r1 - 1) >> 12) == b;
        const float* mg = MOD + ((size_t)l * 16 + b) * 6144 + mod_g;
        const float* mi = MOD + ((size_t)l * 16 + b) * 6144 + mod_in;
        const float* ms = MOD + ((size_t)mod_l2 * 16 + b) * 6144 + mod_sh;
        f32x4 gv[4], shi[4], sci[4];
#pragma unroll
        for (int j = 0; j < 4; ++j) { const int col = 4 * lane + 256 * j; gv[j] = *(const f32x4*)(mg + col);
            if (XMODE == 1) { shi[j] = *(const f32x4*)(mi + col); const f32x4 sc_ = *(const f32x4*)(mi + 1024 + col); sci[j].x = 1.f / (sc_.x + 1.f); sci[j].y = 1.f / (sc_.y + 1.f); sci[j].z = 1.f / (sc_.z + 1.f); sci[j].w = 1.f / (sc_.w + 1.f); } }
        f32x4 Av[4], Bv[4];
#pragma unroll
        for (int j = 0; j < 4; ++j) { const int col = 4 * lane + 256 * j; const f32x4 gn = *(const f32x4*)(lng + col), bn = *(const f32x4*)(lnb + col);
            if (write_h) { const f32x4 sh = *(const f32x4*)(ms + col), sc = *(const f32x4*)(ms + 1024 + col); Av[j] = gn * (sc + 1.f); Bv[j] = bn * (sc + 1.f) + sh; } else { Av[j] = gn; Bv[j] = bn; } }
        int sl0 = 0, sl1 = 0;
        if (YMODE == 1 && r0 + lane < r1) { sl0 = TOKSLOT[2 * (r0 + lane)]; sl1 = TOKSLOT[2 * (r0 + lane) + 1]; }
#define LN_LOAD(R, row_) { const int s0_ = (YMODE == 1) ? (((row_) - r0 < 64) ? __builtin_amdgcn_readlane(sl0, (row_) - r0) : TOKSLOT[2 * (row_)]) : 0, s1_ = (YMODE == 1) ? (((row_) - r0 < 64) ? __builtin_amdgcn_readlane(sl1, (row_) - r0) : TOKSLOT[2 * (row_) + 1]) : 0; \
        const bf16* y0_ = (YMODE == 0) ? Y + (size_t)(row_) * DM : Y + (size_t)s0_ * DM; const bf16* y1_ = Y + (size_t)s1_ * DM; \
        _Pragma("unroll") for (int j = 0; j < 4; ++j) { const int col = 4 * lane + 256 * j; \
            if (XMODE == 0) R.x[j] = *(const f32x4*)(Xin + (size_t)(row_) * DM + col); else R.hx[j] = *(const v2u*)(H + (size_t)(row_) * DM + col); \
            R.ya[j] = *(const v2u*)(y0_ + col); if (YMODE == 1) R.yb[j] = *(const v2u*)(y1_ + col); } }
        LnRaw cur, nx1, nx2;
        LN_LOAD(cur, r0)
        if (r0 + 1 < r1) LN_LOAD(nx1, r0 + 1)
        for (int row = r0; row < r1; ++row) {
            if (ROUTE) asm volatile("" ::: "memory");
            if (row + 2 < r1) LN_LOAD(nx2, row + 2)
            if (!one_batch) {
                const int bb = row >> 12; const float* mg2 = MOD + ((size_t)l * 16 + bb) * 6144 + mod_g; const float* mi2 = MOD + ((size_t)l * 16 + bb) * 6144 + mod_in;
#pragma unroll
                for (int j = 0; j < 4; ++j) { const int col = 4 * lane + 256 * j; gv[j] = *(const f32x4*)(mg2 + col);
                    if (XMODE == 1) { shi[j] = *(const f32x4*)(mi2 + col); const f32x4 sc_ = *(const f32x4*)(mi2 + 1024 + col); sci[j].x = 1.f / (sc_.x + 1.f); sci[j].y = 1.f / (sc_.y + 1.f); sci[j].z = 1.f / (sc_.z + 1.f); sci[j].w = 1.f / (sc_.w + 1.f); } }
            }
            if (!one_batch) {
                const float* msr = MOD + ((size_t)mod_l2 * 16 + (row >> 12)) * 6144 + mod_sh;
#pragma unroll
                for (int j = 0; j < 4; ++j) { const int col = 4 * lane + 256 * j; const f32x4 gn = *(const f32x4*)(lng + col), bn = *(const f32x4*)(lnb + col);
                    if (write_h) { const f32x4 sh = *(const f32x4*)(msr + col), sc = *(const f32x4*)(msr + 1024 + col); Av[j] = gn * (sc + 1.f); Bv[j] = bn * (sc + 1.f) + sh; } else { Av[j] = gn; Bv[j] = bn; } }
            }
            f32x4 v[4]; float s = 0.f;
#pragma unroll
            for (int j = 0; j < 4; ++j) {
                const v2u ya = cur.ya[j];
                f32x4 y; y.x = bf2f(ya.x & 0xffffu); y.y = bf2f(ya.x >> 16); y.z = bf2f(ya.y & 0xffffu); y.w = bf2f(ya.y >> 16);
                if (YMODE == 1) { const v2u yb = cur.yb[j]; y.x += bf2f(yb.x & 0xffffu); y.y += bf2f(yb.x >> 16); y.z += bf2f(yb.y & 0xffffu); y.w += bf2f(yb.y >> 16); }
                f32x4 xr;
                if (XMODE == 0) xr = cur.x[j];
                else { const v2u hh_ = cur.hx[j]; f32x4 hf; hf.x = bf2f(hh_.x & 0xffffu); hf.y = bf2f(hh_.x >> 16); hf.z = bf2f(hh_.y & 0xffffu); hf.w = bf2f(hh_.y >> 16);
                       xr = (hf - shi[j]) * sci[j]; }
                v[j] = xr * DN_ALPHA + (gv[j] + 1.f) * y;
                s += (v[j].x + v[j].y) + (v[j].z + v[j].w);
            }
            const float mean = wave_sum_f(s) * (1.f / DM); float s2 = 0.f;
#pragma unroll
            for (int j = 0; j < 4; ++j) { v[j] = v[j] - mean; s2 += (v[j].x * v[j].x + v[j].y * v[j].y) + (v[j].z * v[j].z + v[j].w * v[j].w); }
            const float rstd = rsqrtf(wave_sum_f(s2) * (1.f / DM) + LN_EPS);
            float lgt[8];
#pragma unroll
            for (int e = 0; e < 8; ++e) lgt[e] = 0.f;
#pragma unroll
            for (int j = 0; j < 4; ++j) {
                const int col = 4 * lane + 256 * j;
                const f32x4 hv = v[j] * rstd * Av[j] + Bv[j];
                if (write_x) *(f32x4*)(C.out + (size_t)row * DM + col) = hv;
                if (write_h) {
                    v2u o; o.x = pk2(hv.x, hv.y); o.y = pk2(hv.z, hv.w);
                    *(v2u*)(H + (size_t)row * DM + col) = o;
                    if (ROUTE) {
                        const float hx[4] = {hv.x, hv.y, hv.z, hv.w};
#pragma unroll
                        for (int c = 0; c < 4; ++c) { const f32x4 w0 = *(const LAS f32x4*)(wrs + (col + c) * NEXP), w1 = *(const LAS f32x4*)(wrs + (col + c) * NEXP + 4);
                            lgt[0] += hx[c] * w0.x; lgt[1] += hx[c] * w0.y; lgt[2] += hx[c] * w0.z; lgt[3] += hx[c] * w0.w;
                            lgt[4] += hx[c] * w1.x; lgt[5] += hx[c] * w1.y; lgt[6] += hx[c] * w1.z; lgt[7] += hx[c] * w1.w; }
                    }
                }
            }
            if (ROUTE) {
#pragma unroll
                for (int e = 0; e < 8; ++e) lgt[e] = wave_sum_f(lgt[e]) + br[e];
                int e0 = 0; float v0 = lgt[0];
#pragma unroll
                for (int e = 1; e < 8; ++e) if (lgt[e] > v0) { v0 = lgt[e]; e0 = e; }
                int e1 = -1; float v1 = -3.0e38f;
#pragma unroll
                for (int e = 0; e < 8; ++e) if (e != e0 && lgt[e] > v1) { v1 = lgt[e]; e1 = e; }
                const float g1 = 1.f / (1.f + expf(v0 - v1)), g0 = 1.f - g1;
                if (lane == 0) { TOPE[2 * row] = e0; TOPE[2 * row + 1] = e1; TOPG[2 * row] = g0; TOPG[2 * row + 1] = g1; }
#pragma unroll
                for (int e = 0; e < 8; ++e) ecnt[e] += (e == e0 ? 1u : 0u) + (e == e1 ? 1u : 0u);
            }
            cur = nx1; nx1 = nx2;
        }
#undef LN_LOAD
    }
    if (ROUTE) {
        unsigned mine = 0u;
#pragma unroll
        for (int e = 0; e < 8; ++e) mine = (lane == e) ? ecnt[e] : mine;
        if (lane < 8 && mine) __hip_atomic_fetch_add(C.ctl + CW_CNT + 64 * jmoe + lane, mine, __ATOMIC_RELAXED, __HIP_MEMORY_SCOPE_AGENT);
    }
}

struct MoeTab { int pend[8]; int npanels; };
__device__ __forceinline__ MoeTab moe_tab(Ctx& C, int jmoe) {
    MoeTab t; int acc = 0;
#pragma unroll
    for (int e = 0; e < 8; ++e) { const int c = (int)__hip_atomic_load(C.ctl + CW_CNT + 64 * jmoe + e, __ATOMIC_RELAXED, __HIP_MEMORY_SCOPE_AGENT); acc += (c + 255) & ~255; t.pend[e] = acc; }
    t.npanels = acc >> 8; return t;
}
__device__ __forceinline__ int panel_expert(const MoeTab& t, int p) {
    int e = 0;
#pragma unroll
    for (int k = 0; k < 7; ++k) e += (p * 256 >= t.pend[k]) ? 1 : 0;
    return e;
}
__device__ __forceinline__ void ph_assign(Ctx& C, int jmoe) {
    const int gw = C.bid * 8 + C.wave, NGW = C.G * 8, lane = C.lane;
    const MoeTab tb = moe_tab(C, jmoe);
    const int* TOPE = (const int*)(C.ws + WS_TOPE); const float* TOPG = (const float*)(C.ws + WS_TOPG);
    int* TOKSLOT = (int*)(C.ws + WS_TOKSLOT); int* ROWTOK = (int*)(C.ws + WS_ROWTOK); float* ROWGATE = (float*)(C.ws + WS_ROWGATE);
    const bf16* H = (const bf16*)(C.ws + WS_H); bf16* HS = (bf16*)(C.ws + WS_Y);
    const unsigned long long ltmask = (lane == 0) ? 0ull : (~0ull >> (64 - lane));
    for (int tk0 = gw * 32; tk0 < MTOK; tk0 += NGW * 32) {
        const int tok = tk0 + (lane & 31); const bool act = lane < 32;
        const int e0 = act ? TOPE[2 * tok] : -1, e1 = act ? TOPE[2 * tok + 1] : -1; const float g0 = TOPG[2 * tok], g1 = TOPG[2 * tok + 1];
        int s0 = 0, s1 = 0;
#pragma unroll
        for (int e = 0; e < 8; ++e) {
            const unsigned long long m0 = __ballot(e0 == e), m1 = __ballot(e1 == e); const int n0 = __popcll(m0), n1 = __popcll(m1);
            int basev = 0;
            if (lane == 0 && (n0 + n1) > 0) basev = (int)__hip_atomic_fetch_add(C.ctl + CW_FILL + 64 * jmoe + e, (unsigned)(n0 + n1), __ATOMIC_RELAXED, __HIP_MEMORY_SCOPE_AGENT);
            basev = __builtin_amdgcn_readfirstlane(basev);
            const int pstart = (e == 0) ? 0 : tb.pend[e > 0 ? e - 1 : 0];
            if (e0 == e) s0 = pstart + basev + __popcll(m0 & ltmask);
            if (e1 == e) s1 = pstart + basev + n0 + __popcll(m1 & ltmask);
        }
        if (act) { TOKSLOT[2 * tok] = s0; TOKSLOT[2 * tok + 1] = s1;
            ROWTOK[s0] = tok; ROWGATE[s0] = g0; ROWTOK[s1] = tok; ROWGATE[s1] = g1; }
#pragma unroll 8
        for (int tt = 0; tt < 32; ++tt) {
            const int d0 = __builtin_amdgcn_readlane(s0, tt), d1 = __builtin_amdgcn_readlane(s1, tt);
            const v4u* src = (const v4u*)(H + (size_t)(tk0 + tt) * DM);
            const v4u a = src[lane], b2 = src[64 + lane];
            v4u* o0 = (v4u*)(HS + (size_t)d0 * DM); v4u* o1 = (v4u*)(HS + (size_t)d1 * DM);
            o0[lane] = a; o0[64 + lane] = b2; o1[lane] = a; o1[64 + lane] = b2;
        }
    }
    for (int idx = gw; idx < 8 * 256; idx += NGW) {
        const int e = idx >> 8, jj = idx & 255;
        const int c = (int)__hip_atomic_load(C.ctl + CW_CNT + 64 * jmoe + e, __ATOMIC_RELAXED, __HIP_MEMORY_SCOPE_AGENT);
        int pstart = 0;
#pragma unroll
        for (int k = 0; k < 7; ++k) if (k < e) pstart = tb.pend[k];
        const int slot = pstart + c + jj;
        if (c + jj < ((c + 255) & ~255)) {
            if (lane == 0) { ROWTOK[slot] = 0; ROWGATE[slot] = 0.f; }
            v4u* o = (v4u*)(HS + (size_t)slot * DM); const v4u z = {0u, 0u, 0u, 0u}; o[lane] = z; o[64 + lane] = z;
        }
    }
}

__device__ __forceinline__ float silu_fast_(float v) { return v * __builtin_amdgcn_rcpf(1.f + __builtin_amdgcn_exp2f(-v * LOG2E)); }
constexpr size_t WS_GLA_LT = WS_Y;
constexpr size_t WS_GLA_SP = WS_Y + 130 * MiB;
constexpr size_t WS_GLA_EB = WS_Y + 128 * MiB;
constexpr int GLA_PITCH = 72;

struct GlaDecay { float b[8]; float Btot; float qv[8]; float kv[8]; };
__device__ __forceinline__ void gla_decay(Ctx& C, int l, int b, int hh, int c, LAS float* segs, GlaDecay& D) {
    const bf16* PROJ = (const bf16*)(C.ws + WS_P);
    const float* w_a2 = C.in(I_WA2) + (size_t)l * 16 * 256 + hh * 64 + C.lane; const float bias = C.in(I_BA)[l * 256 + hh * 64 + C.lane];
    float w[16];
#pragma unroll
    for (int r = 0; r < 16; ++r) w[r] = w_a2[r * 256];
    const size_t row0 = (size_t)b * SEQ + c * 64 + 8 * C.wave;
    LAS unsigned* baS = (LAS unsigned*)(C.lds + 36864) + C.wave * 64;
    baS[C.lane] = *(const unsigned*)(PROJ + (row0 + (C.lane >> 3)) * PW + C_BA + 2 * (C.lane & 7));
    float qraw[8], kraw[8];
#pragma unroll
    for (int i = 0; i < 8; ++i) { const bf16* pr = PROJ + (row0 + i) * PW; qraw[i] = bf2f(pr[C_BQ + hh * 64 + C.lane]); kraw[i] = bf2f(pr[C_BK + hh * 64 + C.lane]); }
    asm volatile("s_waitcnt lgkmcnt(0)" ::: "memory");
    float run = 0.f;
#pragma unroll
    for (int i = 0; i < 8; ++i) {
        const v4u ba0 = *(const LAS v4u*)(baS + 8 * i), ba1 = *(const LAS v4u*)(baS + 8 * i + 4);
        const unsigned bw[8] = {ba0.x, ba0.y, ba0.z, ba0.w, ba1.x, ba1.y, ba1.z, ba1.w};
        float z = bias;
#pragma unroll
        for (int r = 0; r < 8; ++r) { z += bf2f(bw[r] & 0xffffu) * w[2 * r]; z += bf2f(bw[r] >> 16) * w[2 * r + 1]; }
        const float ls = fminf(z, 0.f) - __logf(1.f + __expf(-fabsf(z)));
        run += ls * (1.f / 16.f);
        D.b[i] = run;
        D.qv[i] = qraw[i]; D.kv[i] = kraw[i];
    }
    segs[C.wave * 64 + C.lane] = run;
    __syncthreads();
    float off = 0.f, tot = 0.f;
#pragma unroll
    for (int w8 = 0; w8 < 8; ++w8) { const float sv = segs[w8 * 64 + C.lane]; tot += sv; off += (w8 < C.wave) ? sv : 0.f; }
#pragma unroll
    for (int i = 0; i < 8; ++i) D.b[i] += off;
    D.Btot = tot;
}
__device__ __forceinline__ bf16x8 gla_vt_frag(const bf16* vcol, int ks, int h) {
    unsigned short x[8];
#pragma unroll
    for (int j = 0; j < 8; ++j) x[j] = vcol[(size_t)(16 * ks + 8 * (j >> 2) + 4 * h + (j & 3)) * PW];
    v4u p; p.x = (unsigned)x[0] | ((unsigned)x[1] << 16); p.y = (unsigned)x[2] | ((unsigned)x[3] << 16); p.z = (unsigned)x[4] | ((unsigned)x[5] << 16); p.w = (unsigned)x[6] | ((unsigned)x[7] << 16);
    return __builtin_bit_cast(bf16x8, p);
}

__device__ __forceinline__ void ph_gla1_unit(Ctx& C, int l, int unit) {
    const int c = unit & 63, hh = (unit >> 6) & 3, b = unit >> 8;
    LAS bf16* KDT = (LAS bf16*)C.lds;
    LAS float* segs = (LAS float*)(C.lds + 32768);
    const bf16* PROJ = (const bf16*)(C.ws + WS_P);
    const int mt = C.wave >> 1, nd = C.wave & 1, n = C.lane & 31, h = C.lane >> 5;
    const bf16* vcol = PROJ + ((size_t)b * SEQ + c * 64) * PW + C_BV + hh * 128 + 32 * mt + n;
    bf16x8 vf[4];
#pragma unroll
    for (int ks = 0; ks < 4; ++ks) vf[ks] = gla_vt_frag(vcol, ks, h);
    GlaDecay D; gla_decay(C, l, b, hh, c, segs, D);
    {
        v4u p;
        p.x = pk2(D.kv[0] * __expf(D.Btot - D.b[0]), D.kv[1] * __expf(D.Btot - D.b[1])); p.y = pk2(D.kv[2] * __expf(D.Btot - D.b[2]), D.kv[3] * __expf(D.Btot - D.b[3]));
        p.z = pk2(D.kv[4] * __expf(D.Btot - D.b[4]), D.kv[5] * __expf(D.Btot - D.b[5])); p.w = pk2(D.kv[6] * __expf(D.Btot - D.b[6]), D.kv[7] * __expf(D.Btot - D.b[7]));
        *(LAS v4u*)(KDT + C.lane * GLA_PITCH + 8 * C.wave) = p;
        if (C.wave == 0) ((float*)(C.ws + WS_GLA_EB))[(size_t)unit * 64 + C.lane] = __expf(D.Btot);
    }
    __syncthreads();
    f32x16 acc;
#pragma unroll
    for (int i = 0; i < 16; ++i) acc[i] = 0.f;
#pragma unroll
    for (int ks = 0; ks < 4; ++ks) {
        const LAS bf16* kp = KDT + (32 * nd + n) * GLA_PITCH + 16 * ks + 4 * h;
        const v2u k0 = *(const LAS v2u*)kp, k1 = *(const LAS v2u*)(kp + 8);
        v4u kk; kk.x = k0.x; kk.y = k0.y; kk.z = k1.x; kk.w = k1.y;
        acc = mfma32(vf[ks], __builtin_bit_cast(bf16x8, kk), acc);
    }
    float* LT = (float*)(C.ws + WS_GLA_LT) + (size_t)unit * 8192;
#pragma unroll
    for (int r = 0; r < 16; ++r) LT[(32 * mt + (r & 3) + 8 * (r >> 2) + 4 * h) * 64 + 32 * nd + n] = acc[r];
    __syncthreads();
}

__device__ __forceinline__ void ph_gla2(Ctx& C, size_t probe_off = 0) {
    const f32x4* LT = (const f32x4*)(C.ws + WS_GLA_LT); v2u* SP = (v2u*)(C.ws + WS_GLA_SP + probe_off); const float* EB = (const float*)(C.ws + WS_GLA_EB);
    for (int it = C.bid; it < 64 * 4; it += C.G) {
        const int bh = it >> 2, idx = (it & 3) * 512 + C.tid;
        const f32x4* p = LT + (size_t)bh * 64 * 2048 + idx; v2u* q = SP + (size_t)bh * 64 * 2048 + idx; const float* eb = EB + (size_t)bh * 64 * 64 + ((4 * idx) & 63);
        float S0 = 0.f, S1 = 0.f, S2 = 0.f, S3 = 0.f;
#pragma unroll 16
        for (int c = 0; c < 64; ++c) { const f32x4 lv = p[(size_t)c * 2048]; const f32x4 e = *(const f32x4*)(eb + c * 64);
            v2u o; o.x = pk2(S0, S1); o.y = pk2(S2, S3); q[(size_t)c * 2048] = o;
            S0 = e.x * S0 + lv.x; S1 = e.y * S1 + lv.y; S2 = e.z * S2 + lv.z; S3 = e.w * S3 + lv.w; }
    }
}

__device__ __forceinline__ void ph_gla3_unit(Ctx& C, int l, int unit) {
    const int c = unit & 63, hh = (unit >> 6) & 3, b = unit >> 8;
    LAS bf16* QE = (LAS bf16*)C.lds;
    LAS bf16* KE = QE + 64 * GLA_PITCH;
    LAS float* segs = (LAS float*)(C.lds + 32768);
    LAS float* ssq = (LAS float*)(C.lds + 32768 + 2048);
    const bf16* PROJ = (const bf16*)(C.ws + WS_P); bf16* YM = (bf16*)C.out;
    const int mt = C.wave >> 1, nt = C.wave & 1, n = C.lane & 31, h = C.lane >> 5;
    const size_t row0 = (size_t)b * SEQ + c * 64;
    const bf16* vcol = PROJ + row0 * PW + C_BV + hh * 128 + 32 * mt + n;
    bf16x8 vf[4]; bf16x8 spf[4]; v2u gb[4]; f32x4 gnv[4];
#pragma unroll
    for (int ks = 0; ks < 4; ++ks) vf[ks] = gla_vt_frag(vcol, (ks <= 2 * nt + 1) ? ks : 0, h);
    {
        const bf16* Sp = (const bf16*)(C.ws + WS_GLA_SP) + (size_t)unit * 8192 + (size_t)(32 * mt + n) * 64 + 8 * h;
#pragma unroll
        for (int ks = 0; ks < 4; ++ks) spf[ks] = *(const bf16x8*)(Sp + 16 * ks);
#pragma unroll
        for (int j4 = 0; j4 < 4; ++j4) { gb[j4] = *(const v2u*)(PROJ + (row0 + 32 * nt + n) * PW + C_BG + hh * 128 + 32 * mt + 8 * j4 + 4 * h); gnv[j4] = *(const f32x4*)(C.in(I_GLAG) + l * 128 + 32 * mt + 8 * j4 + 4 * h); }
    }
    GlaDecay D; gla_decay(C, l, b, hh, c, segs, D);
#pragma unroll
    for (int i = 0; i < 8; ++i) {
        QE[(8 * C.wave + i) * GLA_PITCH + C.lane] = (bf16)f2bf(D.qv[i] * 0.125f * __expf(D.b[i]));
        KE[(8 * C.wave + i) * GLA_PITCH + C.lane] = (bf16)f2bf(D.kv[i] * __expf(-D.b[i]));
    }
    __syncthreads();
    bf16x8 qf[4];
#pragma unroll
    for (int ks = 0; ks < 4; ++ks) qf[ks] = *(const LAS bf16x8*)(QE + (32 * nt + n) * GLA_PITCH + 16 * ks + 8 * h);
    f32x16 accO;
#pragma unroll
    for (int i = 0; i < 16; ++i) accO[i] = 0.f;
#pragma unroll
    for (int ms = 0; ms < 2; ++ms) {
        if (ms <= nt) {
            f32x16 aT;
#pragma unroll
            for (int i = 0; i < 16; ++i) aT[i] = 0.f;
#pragma unroll
            for (int ks = 0; ks < 4; ++ks) { const bf16x8 kf = *(const LAS bf16x8*)(KE + (32 * ms + n) * GLA_PITCH + 16 * ks + 8 * h); aT = mfma32(kf, qf[ks], aT); }
            if (ms == nt) {
#pragma unroll
                for (int r = 0; r < 16; ++r) { const int s = (r & 3) + 8 * (r >> 2) + 4 * h; aT[r] = (s <= n) ? aT[r] : 0.f; }
            }
#pragma unroll
            for (int s2 = 0; s2 < 2; ++s2) {
                v4u pa; pa.x = pk2(aT[8 * s2 + 0], aT[8 * s2 + 1]); pa.y = pk2(aT[8 * s2 + 2], aT[8 * s2 + 3]); pa.z = pk2(aT[8 * s2 + 4], aT[8 * s2 + 5]); pa.w = pk2(aT[8 * s2 + 6], aT[8 * s2 + 7]);
                accO = mfma32(vf[2 * ms + s2], __builtin_bit_cast(bf16x8, pa), accO);
            }
        }
    }
    {
#pragma unroll
        for (int ks = 0; ks < 4; ++ks) accO = mfma32(spf[ks], qf[ks], accO);
    }
    float sq = 0.f;
#pragma unroll
    for (int r = 0; r < 16; ++r) sq += accO[r] * accO[r];
    sq += SHX_F(sq, 32, C.lane);
    if (h == 0) ssq[mt * 64 + 32 * nt + n] = sq;
    __syncthreads();
    const float rstd = rsqrtf(((ssq[32 * nt + n] + ssq[64 + 32 * nt + n]) + (ssq[128 + 32 * nt + n] + ssq[192 + 32 * nt + n])) * (1.f / 128.f) + LN_EPS);
    const size_t row = row0 + 32 * nt + n;
#pragma unroll
    for (int j4 = 0; j4 < 4; ++j4) {
        const int e0 = 32 * mt + 8 * j4 + 4 * h;
        const v2u gbv = gb[j4]; const f32x4 gn = gnv[j4];
        const float y0 = accO[4 * j4 + 0] * rstd * gn.x * silu_fast_(bf2f(gbv.x & 0xffffu)), y1 = accO[4 * j4 + 1] * rstd * gn.y * silu_fast_(bf2f(gbv.x >> 16));
        const float y2 = accO[4 * j4 + 2] * rstd * gn.z * silu_fast_(bf2f(gbv.y & 0xffffu)), y3 = accO[4 * j4 + 3] * rstd * gn.w * silu_fast_(bf2f(gbv.y >> 16));
        v2u o; o.x = pk2(y0, y1); o.y = pk2(y2, y3);
        *(v2u*)(YM + row * DM + 512 + hh * 128 + e0) = o;
    }
    __syncthreads();
}

#ifndef A3_VPATH
#define A3_VPATH(i) (true)
#endif
#ifndef REP_S
#define REP_S 1
#endif
constexpr size_t WS_KFI = 932 * MiB, WS_KFA = 940 * MiB, WS_VF = 948 * MiB;

__device__ __forceinline__ void ph_dsa_a2_unit(Ctx& C, int b, int t0) {
    LAS unsigned* cnt = (LAS unsigned*)(C.lds + 131072);
    const bf16* PROJ = (const bf16*)(C.ws + WS_P); unsigned* SEL = (unsigned*)(C.ws + WS_SEL); const bf16* KFI = (const bf16*)(C.ws + WS_KFI);
    const int lane = C.lane, n = lane & 31, h = lane >> 5, tid = C.tid, wave = C.wave;
    const int nk = t0 + 8, ntile = (nk + 31) >> 5;
    if (tid < 48) cnt[tid] = 0u;
    unsigned u[16][4];
    {
        bf16x8 af[2][4]; float wv[2][2][8];
        const int jq = 2 * ((n >> 4) & 1) + ((n >> 2) & 1), hd = 4 * ((n >> 3) & 1) + (n & 3);
#pragma unroll
        for (int mt = 0; mt < 2; ++mt) {
            const bf16* p = PROJ + (size_t)(b * SEQ + t0 + 4 * mt + jq) * PW + C_IQ + hd * 64 + 8 * h;
#pragma unroll
            for (int ks = 0; ks < 4; ++ks) af[mt][ks] = *(const bf16x8*)(p + ks * 16);
#pragma unroll
            for (int g = 0; g < 2; ++g) {
                const v4u w4 = *(const v4u*)(PROJ + (size_t)(b * SEQ + t0 + 4 * mt + 2 * g + h) * PW + C_IW); const unsigned ww[4] = {w4.x, w4.y, w4.z, w4.w};
#pragma unroll
                for (int x = 0; x < 4; ++x) { wv[mt][g][2 * x] = bf2f(ww[x] & 0xffffu) * (0.35355339059327373f * 0.125f); wv[mt][g][2 * x + 1] = bf2f(ww[x] >> 16) * (0.35355339059327373f * 0.125f); }
            }
        }
        const bf16* kbase = KFI + (size_t)(b * 128) * 2048 + lane * 8;
#pragma unroll
        for (int i = 0; i < 16; ++i) {
            const int tile = wave + 8 * i;
#pragma unroll
            for (int k = 0; k < 4; ++k) u[i][k] = 0u;
            if (tile < ntile) {
                bf16x8 bcur[4];
#pragma unroll
                for (int ks = 0; ks < 4; ++ks) bcur[ks] = *(const bf16x8*)(kbase + (size_t)tile * 2048 + ks * 512);
                const int s = tile * 32 + n;
#pragma unroll
                for (int mt = 0; mt < 2; ++mt) {
                    f32x16 acc;
#pragma unroll
                    for (int x = 0; x < 16; ++x) acc[x] = 0.f;
#pragma unroll
                    for (int ks = 0; ks < 4; ++ks) acc = mfma32(af[mt][ks], bcur[ks], acc);
#pragma unroll
                    for (int g = 0; g < 2; ++g) {
                        float p = 0.f;
#pragma unroll
                        for (int x = 0; x < 8; ++x) p += wv[mt][g][x] * fmaxf(acc[8 * g + x], 0.f);
                        const int t = t0 + 4 * mt + 2 * g + h;
                        u[i][2 * mt + g] = (s <= t) ? sortable_u32(p) : 0u;
                    }
                }
            }
            __builtin_amdgcn_sched_barrier(0);
        }
    }
    __syncthreads();
    unsigned Tl[4], Jl[4], needl[4];
#pragma unroll
    for (int k = 0; k < 4; ++k) { Tl[k] = 0u; Jl[k] = 8192u; needl[k] = 0u; }
    int buf = 0;
#define DSA_COUNT(PRED) \
        _Pragma("unroll") for (int i = 0; i < 16; ++i) if (wave + 8 * i < ntile) { const unsigned s = (unsigned)((wave + 8 * i) * 32 + n); (void)s; \
            _Pragma("unroll") for (int k = 0; k < 4; ++k) { const unsigned uu = u[i][k]; const unsigned long long bm = __ballot(PRED); cq[2 * k] += (unsigned)__popc((unsigned)bm); cq[2 * k + 1] += (unsigned)__popc((unsigned)(bm >> 32)); } __builtin_amdgcn_sched_barrier(0); }
#define DSA_PUBLISH(NW) { unsigned myc = 0u; \
        _Pragma("unroll") for (int q = 0; q < NW; ++q) myc = (lane == q) ? cq[q] : myc; \
        if (lane < NW) __hip_atomic_fetch_add(cnt + buf * 16 + lane, myc, __ATOMIC_RELAXED, __HIP_MEMORY_SCOPE_WORKGROUP); \
        nb = (buf == 2) ? 0 : buf + 1; if (tid >= 64 && tid < 80) cnt[nb * 16 + (tid - 64)] = 0u; __syncthreads(); }
#pragma unroll 1
    for (int bit = 31; bit >= 0; --bit) {
        unsigned cq[8]; int nb;
#pragma unroll
        for (int q = 0; q < 8; ++q) cq[q] = 0u;
        unsigned cl[4];
#pragma unroll
        for (int k = 0; k < 4; ++k) cl[k] = Tl[k] | (1u << bit);
        DSA_COUNT(uu >= cl[k])
        DSA_PUBLISH(8)
#pragma unroll
        for (int k = 0; k < 4; ++k) if (cnt[buf * 16 + 2 * k + h] >= 256u) Tl[k] = cl[k];
        buf = nb;
    }
#pragma unroll
    for (int k = 0; k < 4; ++k) Tl[k] = Tl[k] < 1u ? 1u : Tl[k];
    bool extra = false;
    {
        unsigned cq[16]; int nb;
#pragma unroll
        for (int q = 0; q < 16; ++q) cq[q] = 0u;
#pragma unroll
        for (int i = 0; i < 16; ++i) if (wave + 8 * i < ntile) {
#pragma unroll
            for (int k = 0; k < 4; ++k) { const unsigned uu = u[i][k];
                const unsigned long long bg = __ballot(uu > Tl[k]), be = __ballot(uu >= Tl[k]);
                cq[2 * k] += (unsigned)__popc((unsigned)bg); cq[2 * k + 1] += (unsigned)__popc((unsigned)(bg >> 32));
                cq[8 + 2 * k] += (unsigned)__popc((unsigned)be); cq[8 + 2 * k + 1] += (unsigned)__popc((unsigned)(be >> 32)); }
            __builtin_amdgcn_sched_barrier(0);
        }
        DSA_PUBLISH(16)
#pragma unroll
        for (int k = 0; k < 4; ++k) { const unsigned g = cnt[buf * 16 + 2 * k + h]; needl[k] = 256u - (g < 256u ? g : 256u); }
#pragma unroll
        for (int q = 0; q < 8; ++q) extra = extra || (cnt[buf * 16 + 8 + q] > 256u);
        buf = nb;
    }
    if (extra) {
#pragma unroll
        for (int k = 0; k < 4; ++k) Jl[k] = 0u;
#pragma unroll 1
        for (int bit = 12; bit >= 0; --bit) {
            unsigned cq[8]; int nb;
#pragma unroll
            for (int q = 0; q < 8; ++q) cq[q] = 0u;
            unsigned jl[4];
#pragma unroll
            for (int k = 0; k < 4; ++k) jl[k] = Jl[k] | (1u << bit);
            DSA_COUNT(uu == Tl[k] && s < jl[k])
            DSA_PUBLISH(8)
#pragma unroll
            for (int k = 0; k < 4; ++k) if (cnt[buf * 16 + 2 * k + h] <= needl[k]) Jl[k] = jl[k];
            buf = nb;
        }
    }
    {
        unsigned wsel[4];
#pragma unroll
        for (int k = 0; k < 4; ++k) wsel[k] = 0u;
#pragma unroll
        for (int i = 0; i < 16; ++i) if (wave + 8 * i < ntile) {
            const unsigned s = (unsigned)((wave + 8 * i) * 32 + n);
#pragma unroll
            for (int k = 0; k < 4; ++k) {
                const unsigned uu = u[i][k];
                const unsigned long long bm = __ballot((uu > Tl[k]) || (uu == Tl[k] && s < Jl[k]));
                const unsigned wd = h ? (unsigned)(bm >> 32) : (unsigned)bm;
                wsel[k] = (n == i) ? wd : wsel[k];
            }
            __builtin_amdgcn_sched_barrier(0);
        }
        const int tile = wave + 8 * n;
        if (n < 16 && tile < ntile) {
#pragma unroll
            for (int k = 0; k < 4; ++k) SEL[(size_t)(b * SEQ + t0 + 2 * k + h) * 128 + tile] = wsel[k];
        }
    }
#undef DSA_COUNT
#undef DSA_PUBLISH
    __syncthreads();
}


constexpr int A3_QP = 64 * 68;
struct A3Q { bf16x8 af[2][4]; v4u wq; };
__device__ __forceinline__ void a3_load_q(Ctx& C, int b, int t0, A3Q& Q) {
    const bf16* PROJ = (const bf16*)(C.ws + WS_P);
    const int n = C.lane & 31, h = C.lane >> 5;
    const int jq = 2 * ((n >> 4) & 1) + ((n >> 2) & 1), hd = 4 * ((n >> 3) & 1) + (n & 3);
#pragma unroll
    for (int mt = 0; mt < 2; ++mt) {
        const bf16* p = PROJ + (size_t)(b * SEQ + t0 + 4 * mt + jq) * PW + C_IQ + hd * 64 + 8 * h;
#pragma unroll
        for (int ks = 0; ks < 4; ++ks) Q.af[mt][ks] = *(const bf16x8*)(p + ks * 16);
    }
    Q.wq = *(const v4u*)(PROJ + (size_t)(b * SEQ + t0 + (n & 7)) * PW + C_IW);
}
__device__ __forceinline__ void ph_dsa_a3_unit(Ctx& C, int b, int t0, A3Q& Q, bool has_next, int nb, int nt0) {
    LAS unsigned* sc = (LAS unsigned*)C.lds;
    const bf16* PROJ = (const bf16*)(C.ws + WS_P); unsigned* SEL = (unsigned*)(C.ws + WS_SEL); const bf16* KFI = (const bf16*)(C.ws + WS_KFI);
    const int lane = C.lane, n = lane & 31, h = lane >> 5, wave = C.wave;
    const int nk = t0 + 8, ntile = (nk + 31) >> 5;
    {
        typedef _Float16 h8_t __attribute__((ext_vector_type(8)));
        typedef _Float16 h2_t __attribute__((ext_vector_type(2)));
        h8_t wf[2][2];
        {
            const unsigned ww[4] = {Q.wq.x, Q.wq.y, Q.wq.z, Q.wq.w}; unsigned wp[4];
#pragma unroll
            for (int x = 0; x < 4; ++x) wp[x] = __builtin_bit_cast(unsigned, __builtin_amdgcn_cvt_pkrtz(bf2f(ww[x] & 0xffffu) * (0.35355339059327373f * 0.125f), bf2f(ww[x] >> 16) * (0.35355339059327373f * 0.125f)));
#pragma unroll
            for (int mt = 0; mt < 2; ++mt)
#pragma unroll
                for (int ks = 0; ks < 2; ++ks) { const bool on = (n < 8) && ((n >> 2) == mt) && ((n & 3) == 2 * ks + h);
                    v4u f; f.x = on ? wp[0] : 0u; f.y = on ? wp[1] : 0u; f.z = on ? wp[2] : 0u; f.w = on ? wp[3] : 0u; wf[mt][ks] = __builtin_bit_cast(h8_t, f); }
        }
        const bf16* kbase = KFI + (size_t)(b * 128) * 2048 + lane * 8;
        bf16x8 kA[4], kB[4];
        { const int ta = wave < ntile ? wave : 0, tb = wave + 8 < ntile ? wave + 8 : ta;
#pragma unroll
          for (int ks = 0; ks < 4; ++ks) { kA[ks] = *(const bf16x8*)(kbase + (size_t)ta * 2048 + ks * 512); kB[ks] = *(const bf16x8*)(kbase + (size_t)tb * 2048 + ks * 512); } }
#define A3_MMA(A0, A1, KF) { const f32x16 z16_ = {0.f, 0.f, 0.f, 0.f, 0.f, 0.f, 0.f, 0.f, 0.f, 0.f, 0.f, 0.f, 0.f, 0.f, 0.f, 0.f}; \
            A0 = mfma32(Q.af[0][0], KF[0], z16_); A1 = mfma32(Q.af[1][0], KF[0], z16_); \
            _Pragma("unroll") for (int ks = 1; ks < 4; ++ks) { A0 = mfma32(Q.af[0][ks], KF[ks], A0); A1 = mfma32(Q.af[1][ks], KF[ks], A1); } }
#define A3_RELU4(A, r0_) ({ v4u f_; const h2_t z2_ = {(_Float16)0.f, (_Float16)0.f}; \
                f_.x = __builtin_bit_cast(unsigned, __builtin_elementwise_max(__builtin_bit_cast(h2_t, __builtin_amdgcn_cvt_pkrtz(A[(r0_)], A[(r0_) + 1])), z2_)); \
                f_.y = __builtin_bit_cast(unsigned, __builtin_elementwise_max(__builtin_bit_cast(h2_t, __builtin_amdgcn_cvt_pkrtz(A[(r0_) + 2], A[(r0_) + 3])), z2_)); \
                f_.z = __builtin_bit_cast(unsigned, __builtin_elementwise_max(__builtin_bit_cast(h2_t, __builtin_amdgcn_cvt_pkrtz(A[(r0_) + 4], A[(r0_) + 5])), z2_)); \
                f_.w = __builtin_bit_cast(unsigned, __builtin_elementwise_max(__builtin_bit_cast(h2_t, __builtin_amdgcn_cvt_pkrtz(A[(r0_) + 6], A[(r0_) + 7])), z2_)); \
                __builtin_bit_cast(h8_t, f_); })
#define A3_EPI(A0, A1, tile_) { const int s = (tile_) * 32 + n; const f32x16 z16e_ = {0.f, 0.f, 0.f, 0.f, 0.f, 0.f, 0.f, 0.f, 0.f, 0.f, 0.f, 0.f, 0.f, 0.f, 0.f, 0.f}; \
            f32x16 P_ = __builtin_amdgcn_mfma_f32_32x32x16_f16(wf[0][0], A3_RELU4(A0, 0), z16e_, 0, 0, 0); P_ = __builtin_amdgcn_mfma_f32_32x32x16_f16(wf[0][1], A3_RELU4(A0, 8), P_, 0, 0, 0); \
            P_ = __builtin_amdgcn_mfma_f32_32x32x16_f16(wf[1][0], A3_RELU4(A1, 0), P_, 0, 0, 0); P_ = __builtin_amdgcn_mfma_f32_32x32x16_f16(wf[1][1], A3_RELU4(A1, 8), P_, 0, 0, 0); \
              \
            _Pragma("unroll") for (int r = 0; r < 4; ++r) { const int q = r + 4 * h; sc[q * A3_QP + (s >> 6) * 68 + (s & 63)] = (s <= t0 + q) ? sortable_u32(P_[r]) : 0u; } }
#define A3_LOADK(KF, tile_) { const int tl_ = ((tile_) < ntile) ? (tile_) : wave; \
            _Pragma("unroll") for (int ks = 0; ks < 4; ++ks) KF[ks] = *(const bf16x8*)(kbase + (size_t)tl_ * 2048 + ks * 512); }
        f32x16 accA0, accA1, accB0, accB1;
        if (wave < ntile) { A3_MMA(accA0, accA1, kA) A3_LOADK(kA, wave + 16) }
#pragma unroll 1
        for (int tile = wave; tile < ntile; tile += 16) {
            if (tile + 8 < ntile) { A3_MMA(accB0, accB1, kB) A3_LOADK(kB, tile + 24) }
            A3_EPI(accA0, accA1, tile)
            if (tile + 8 < ntile) {
                if (tile + 16 < ntile) { A3_MMA(accA0, accA1, kA) A3_LOADK(kA, tile + 32) }
                A3_EPI(accB0, accB1, tile + 8)
            }
        }
#undef A3_LOADK
#undef A3_RELU4
#undef A3_MMA
#undef A3_EPI
    }
    __syncthreads();
    {
        const int q = wave, t = t0 + q;
        const int nval = t + 1 - 64 * lane;
        const unsigned long long vm = nval >= 64 ? ~0ull : (nval > 0 ? ((1ull << nval) - 1ull) : 0ull);
        unsigned long long selm = vm;
        if (t >= 256) {
            unsigned lo[32], hi[32];
            {
                const LAS v4u* gp = (const LAS v4u*)(sc + q * A3_QP + lane * 68);
#pragma unroll
                for (int i = 0; i < 8; ++i) { const v4u a = gp[i], c = gp[8 + i]; lo[4 * i] = a.x; lo[4 * i + 1] = a.y; lo[4 * i + 2] = a.z; lo[4 * i + 3] = a.w; hi[4 * i] = c.x; hi[4 * i + 1] = c.y; hi[4 * i + 2] = c.z; hi[4 * i + 3] = c.w; }
            }
#define A3_TR(X) { \
            _Pragma("unroll") for (int k = 0; k < 32; ++k) if ((k & 16) == 0) { const unsigned a = X[k], c = X[k + 16]; X[k] = __builtin_amdgcn_perm(c, a, 0x05040100u); X[k + 16] = __builtin_amdgcn_perm(c, a, 0x07060302u); } \
            _Pragma("unroll") for (int k = 0; k < 32; ++k) if ((k & 8) == 0) { const unsigned a = X[k], c = X[k + 8]; X[k] = __builtin_amdgcn_perm(c, a, 0x06020400u); X[k + 8] = __builtin_amdgcn_perm(c, a, 0x07030501u); } \
            _Pragma("unroll") for (int st = 2; st < 5; ++st) { const int j = 16 >> st; const unsigned m = st == 2 ? 0x0f0f0f0fu : st == 3 ? 0x33333333u : 0x55555555u; \
                _Pragma("unroll") for (int k = 0; k < 32; ++k) if ((k & j) == 0) { const unsigned a = X[k], c = X[k + j]; X[k] = (a & m) | ((c << j) & ~m); X[k + j] = ((a >> j) & m) | (c & ~m); } } }
            A3_TR(lo) A3_TR(hi)
#undef A3_TR
            unsigned al = (unsigned)vm, ah = (unsigned)(vm >> 32), gl = 0u, gh = 0u, G = 0u;
            bool done = false;
#pragma unroll
            for (int b = 31; b >= 0; --b) {
                if (!done) {
                    const unsigned ol = al & lo[b], oh = ah & hi[b];
                    const unsigned c = G + wave_sum_u32((unsigned)__popc(ol) + (unsigned)__popc(oh));
                    if (c >= 256u) { al = ol; ah = oh; done = (c == 256u); }
                    else { gl |= ol; gh |= oh; G = c; al ^= ol; ah ^= oh; }
                }
            }
            const unsigned ca = (unsigned)__popc(al) + (unsigned)__popc(ah);
            const unsigned tot = wave_sum_u32(ca);
            unsigned long long alive = ((unsigned long long)ah << 32) | al;
            if (G + tot > 256u) {
                int incl = (int)ca;
#pragma unroll
                for (int o = 1; o < 64; o <<= 1) { const int v = SHUP_I(incl, o, lane); if (lane >= o) incl += v; }
                const int before = incl - (int)ca, room = (int)(256u - G) - before;
                int take = room < 0 ? 0 : (room > (int)ca ? (int)ca : room);
                unsigned long long keep = 0ull;
                while (__any(take > 0)) { if (take > 0) { const unsigned long long low = alive & (0ull - alive); keep |= low; alive ^= low; --take; } }
                alive = keep;
            }
            selm = (((unsigned long long)gh << 32) | gl) | alive;
        }
        if (has_next) a3_load_q(C, nb, nt0, Q);
#ifdef SEL_ALL
        *(unsigned long long*)(SEL + (size_t)(b * SEQ + t) * 128 + 2 * lane) = selm;
#else
        if (64 * lane <= t) *(unsigned long long*)(SEL + (size_t)(b * SEQ + t) * 128 + 2 * lane) = selm;
#endif
    }
    __syncthreads();
}

constexpr int A4_BUF = 4 * A3_QP;
constexpr int A4_R = 4;
struct A4S { bf16x8 af[4]; v4u wq; bf16x8 k[A4_R][4]; };
__device__ __forceinline__ int a4_cnt(int t0, int sw) { const int ntile = (t0 + 4 + 31) >> 5; return (t0 + 3 < 256 || sw >= ntile) ? 0 : (ntile - sw + 3) >> 2; }
__device__ __forceinline__ void a4_prefetch(Ctx& C, A4S& S, int b, int t0) {
    const bf16* PROJ = (const bf16*)(C.ws + WS_P); const bf16* KFI = (const bf16*)(C.ws + WS_KFI);
    const int lane = C.lane, n = lane & 31, h = lane >> 5, sw = C.wave;
    const int cnt = a4_cnt(t0, sw);
    {
        const int jq = 2 * ((n >> 4) & 1) + ((n >> 2) & 1), hd = 4 * ((n >> 3) & 1) + (n & 3);
        const bf16* p = PROJ + (size_t)(b * SEQ + t0 + jq) * PW + C_IQ + hd * 64 + 8 * h;
#pragma unroll
        for (int ks = 0; ks < 4; ++ks) S.af[ks] = *(const bf16x8*)(p + ks * 16);
        const int qsel = (n & 1) + 2 * ((n >> 2) & 1);
        S.wq = *(const v4u*)(PROJ + (size_t)(b * SEQ + t0 + qsel) * PW + C_IW);
    }
    const bf16* kbase = KFI + (size_t)(b * 128) * 2048 + lane * 8;
#pragma unroll
    for (int j = 0; j < A4_R; ++j) { const int tl = j < cnt ? sw + 4 * j : 0;
#pragma unroll
        for (int ks = 0; ks < 4; ++ks) S.k[j][ks] = *(const bf16x8*)(kbase + (size_t)tl * 2048 + ks * 512);
    }
}
__device__ __forceinline__ void a4_score(Ctx& C, A4S& S, LAS unsigned* sc, int b, int t0) {
    const bf16* KFI = (const bf16*)(C.ws + WS_KFI);
    const int lane = C.lane, n = lane & 31, h = lane >> 5, sw = C.wave;
    const int cnt = a4_cnt(t0, sw);
    typedef _Float16 h8_t __attribute__((ext_vector_type(8)));
    typedef _Float16 h2_t __attribute__((ext_vector_type(2)));
    h8_t wf[2];
    {
        const unsigned ww[4] = {S.wq.x, S.wq.y, S.wq.z, S.wq.w}; unsigned wp[4];
#pragma unroll
        for (int x = 0; x < 4; ++x) wp[x] = __builtin_bit_cast(unsigned, __builtin_amdgcn_cvt_pkrtz(bf2f(ww[x] & 0xffffu) * (0.35355339059327373f * 0.125f), bf2f(ww[x] >> 16) * (0.35355339059327373f * 0.125f)));
        const bool rowok = (n == 0) || (n == 1) || (n == 4) || (n == 5); const int qrow = (n & 1) + 2 * (n >> 2);
#pragma unroll
        for (int ks = 0; ks < 2; ++ks) { const bool on = rowok && (qrow == 2 * ks + h);
            v4u f; f.x = on ? wp[0] : 0u; f.y = on ? wp[1] : 0u; f.z = on ? wp[2] : 0u; f.w = on ? wp[3] : 0u; wf[ks] = __builtin_bit_cast(h8_t, f); }
    }
    const bf16* kbase = KFI + (size_t)(b * 128) * 2048 + lane * 8;
#define A4_MMA(A, KF) { const f32x16 z16_ = {0.f, 0.f, 0.f, 0.f, 0.f, 0.f, 0.f, 0.f, 0.f, 0.f, 0.f, 0.f, 0.f, 0.f, 0.f, 0.f}; \
        A = mfma32(S.af[0], KF[0], z16_); _Pragma("unroll") for (int ks = 1; ks < 4; ++ks) A = mfma32(S.af[ks], KF[ks], A); }
#define A4_RELU4(A, r0_) ({ v4u f_; const h2_t z2_ = {(_Float16)0.f, (_Float16)0.f}; \
            f_.x = __builtin_bit_cast(unsigned, __builtin_elementwise_max(__builtin_bit_cast(h2_t, __builtin_amdgcn_cvt_pkrtz(A[(r0_)], A[(r0_) + 1])), z2_)); \
            f_.y = __builtin_bit_cast(unsigned, __builtin_elementwise_max(__builtin_bit_cast(h2_t, __builtin_amdgcn_cvt_pkrtz(A[(r0_) + 2], A[(r0_) + 3])), z2_)); \
            f_.z = __builtin_bit_cast(unsigned, __builtin_elementwise_max(__builtin_bit_cast(h2_t, __builtin_amdgcn_cvt_pkrtz(A[(r0_) + 4], A[(r0_) + 5])), z2_)); \
            f_.w = __builtin_bit_cast(unsigned, __builtin_elementwise_max(__builtin_bit_cast(h2_t, __builtin_amdgcn_cvt_pkrtz(A[(r0_) + 6], A[(r0_) + 7])), z2_)); \
            __builtin_bit_cast(h8_t, f_); })
#define A4_EPI(A, i_) { const int s = (sw + 4 * (i_)) * 32 + n; const f32x16 z16e_ = {0.f, 0.f, 0.f, 0.f, 0.f, 0.f, 0.f, 0.f, 0.f, 0.f, 0.f, 0.f, 0.f, 0.f, 0.f, 0.f}; \
        f32x16 P_ = __builtin_amdgcn_mfma_f32_32x32x16_f16(wf[0], A4_RELU4(A, 0), z16e_, 0, 0, 0); P_ = __builtin_amdgcn_mfma_f32_32x32x16_f16(wf[1], A4_RELU4(A, 8), P_, 0, 0, 0); \
          \
        _Pragma("unroll") for (int r = 0; r < 2; ++r) { const int q = 2 * h + r; sc[q * A3_QP + (s >> 6) * 68 + (s & 63)] = (s <= t0 + q) ? sortable_u32(P_[r]) : 0u; } }
#define A4_LOADK(KF, i_) { const int il_ = ((i_) < cnt) ? (i_) : 0; _Pragma("unroll") for (int ks = 0; ks < 4; ++ks) KF[ks] = *(const bf16x8*)(kbase + (size_t)(sw + 4 * il_) * 2048 + ks * 512); }
    f32x16 acc0, acc1;
#pragma unroll 1
    for (int i0 = 0; i0 < cnt; i0 += 4) {
        A4_MMA(acc0, S.k[0]) if (i0 + 4 < cnt) A4_LOADK(S.k[0], i0 + 4)
        if (i0 + 1 < cnt) { A4_MMA(acc1, S.k[1]) if (i0 + 5 < cnt) A4_LOADK(S.k[1], i0 + 5) }
        A4_EPI(acc0, i0)
        if (i0 + 2 < cnt) { A4_MMA(acc0, S.k[2]) if (i0 + 6 < cnt) A4_LOADK(S.k[2], i0 + 6) }
        if (i0 + 1 < cnt) A4_EPI(acc1, i0 + 1)
        if (i0 + 3 < cnt) { A4_MMA(acc1, S.k[3]) if (i0 + 7 < cnt) A4_LOADK(S.k[3], i0 + 7) }
        if (i0 + 2 < cnt) A4_EPI(acc0, i0 + 2)
        if (i0 + 3 < cnt) A4_EPI(acc1, i0 + 3)
    }
#undef A4_LOADK
#undef A4_RELU4
#undef A4_MMA
#undef A4_EPI
}
__device__ __forceinline__ void a4_select(Ctx& C, const LAS unsigned* scq, int b, int t) {
    unsigned* SEL = (unsigned*)(C.ws + WS_SEL);
    const int lane = C.lane;
    const int nval = t + 1 - 64 * lane;
    const unsigned long long vm = nval >= 64 ? ~0ull : (nval > 0 ? ((1ull << nval) - 1ull) : 0ull);
    unsigned long long selm = vm;
    if (t >= 256) {
        unsigned lo[32], hi[32];
        {
            const LAS v4u* gp = (const LAS v4u*)(scq + lane * 68);
#pragma unroll
            for (int i = 0; i < 8; ++i) { const v4u a = gp[i], c = gp[8 + i]; lo[4 * i] = a.x; lo[4 * i + 1] = a.y; lo[4 * i + 2] = a.z; lo[4 * i + 3] = a.w; hi[4 * i] = c.x; hi[4 * i + 1] = c.y; hi[4 * i + 2] = c.z; hi[4 * i + 3] = c.w; }
        }
#define A3_TR(X) { \
        _Pragma("unroll") for (int k = 0; k < 32; ++k) if ((k & 16) == 0) { const unsigned a = X[k], c = X[k + 16]; X[k] = __builtin_amdgcn_perm(c, a, 0x05040100u); X[k + 16] = __builtin_amdgcn_perm(c, a, 0x07060302u); } \
        _Pragma("unroll") for (int k = 0; k < 32; ++k) if ((k & 8) == 0) { const unsigned a = X[k], c = X[k + 8]; X[k] = __builtin_amdgcn_perm(c, a, 0x06020400u); X[k + 8] = __builtin_amdgcn_perm(c, a, 0x07030501u); } \
        _Pragma("unroll") for (int st = 2; st < 5; ++st) { const int j = 16 >> st; const unsigned m = st == 2 ? 0x0f0f0f0fu : st == 3 ? 0x33333333u : 0x55555555u; \
            _Pragma("unroll") for (int k = 0; k < 32; ++k) if ((k & j) == 0) { const unsigned a = X[k], c = X[k + j]; X[k] = (a & m) | ((c << j) & ~m); X[k + j] = ((a >> j) & m) | (c & ~m); } } }
        A3_TR(lo) A3_TR(hi)
#undef A3_TR
        unsigned al = (unsigned)vm, ah = (unsigned)(vm >> 32), gl = 0u, gh = 0u, G = 0u;
        bool done = false;
#pragma unroll
        for (int bb = 31; bb >= 0; --bb) {
            if (!done) {
                const unsigned ol = al & lo[bb], oh = ah & hi[bb];
                const unsigned c = G + wave_sum_u32((unsigned)__popc(ol) + (unsigned)__popc(oh));
                if (c >= 256u) { al = ol; ah = oh; done = (c == 256u); }
                else { gl |= ol; gh |= oh; G = c; al ^= ol; ah ^= oh; }
            }
        }
        const unsigned ca = (unsigned)__popc(al) + (unsigned)__popc(ah);
        const unsigned tot = wave_sum_u32(ca);
        unsigned long long alive = ((unsigned long long)ah << 32) | al;
        if (G + tot > 256u) {
            const int incl = wave_incl_scan_i((int)ca, lane);
            const int before = incl - (int)ca, room = (int)(256u - G) - before;
            int take = room < 0 ? 0 : (room > (int)ca ? (int)ca : room);
            unsigned long long keep = 0ull;
            while (__any(take > 0)) { if (take > 0) { const unsigned long long low = alive & (0ull - alive); keep |= low; alive ^= low; --take; } }
            alive = keep;
        }
        selm = (((unsigned long long)gh << 32) | gl) | alive;
    }
    if (64 * lane <= t) *(unsigned long long*)(SEL + (size_t)(b * SEQ + t) * 128 + 2 * lane) = selm;
}

__device__ __forceinline__ void ph_dsa_b2_wave(Ctx& C, int b, int t4) {
    const bf16* PROJ = (const bf16*)(C.ws + WS_P); const unsigned* SEL = (const unsigned*)(C.ws + WS_SEL); bf16* YM = (bf16*)(C.ws + WS_H);
    const bf16* KFA = (const bf16*)(C.ws + WS_KFA); const bf16* VF = (const bf16*)(C.ws + WS_VF);
    const int lane = C.lane, n = lane & 31, h = lane >> 5, tl = n >> 3, hd = n & 7;
    const int ntile = ((t4 + 3) >> 5) + 1;
    const size_t qrow = (size_t)b * SEQ + t4 + tl;
    bf16x8 qf[5];
    {
        const bf16* qp = PROJ + qrow * PW + C_AQ + hd * 64 + 8 * h;
#pragma unroll
        for (int ks = 0; ks < 4; ++ks) {
            const v4u q4 = *(const v4u*)(qp + 16 * ks); const unsigned qw[4] = {q4.x, q4.y, q4.z, q4.w}; v4u o;
            unsigned ow[4];
#pragma unroll
            for (int x = 0; x < 4; ++x) ow[x] = pk2(bf2f(qw[x] & 0xffffu) * (0.125f * LOG2E), bf2f(qw[x] >> 16) * (0.125f * LOG2E));
            o.x = ow[0]; o.y = ow[1]; o.z = ow[2]; o.w = ow[3]; qf[ks] = __builtin_bit_cast(bf16x8, o);
        }
        const unsigned one = 0x3f80u, sl = f2bf(exp2f(-(float)(hd + 1)));
        v4u e; e.x = (tl == 0 ? one : 0u) | ((tl == 1 ? one : 0u) << 16); e.y = (tl == 2 ? one : 0u) | ((tl == 3 ? one : 0u) << 16); e.z = sl | (sl << 16); e.w = sl;
        if (h) { e.x = 0u; e.y = 0u; e.z = 0u; e.w = 0u; }
        qf[4] = __builtin_bit_cast(bf16x8, e);
    }
    f32x16 O0, O1;
#pragma unroll
    for (int x = 0; x < 16; ++x) { O0[x] = 0.f; O1[x] = 0.f; }
    float m = -3.0e38f, lsum = 0.f;
    const unsigned NEGB = 0xf149u;
    const bf16* kb = KFA + (size_t)(b * 128) * 2048 + lane * 8; const bf16* vb = VF + (size_t)(b * 128) * 2048 + lane * 8;
    const unsigned* selp = SEL + ((size_t)b * SEQ + t4 + (lane & 3)) * 128;
    bf16x8 kc[4], vc[4]; unsigned wc_;
#pragma unroll
    for (int ks = 0; ks < 4; ++ks) { kc[ks] = *(const bf16x8*)(kb + ks * 512); vc[ks] = *(const bf16x8*)(vb + ks * 512); }
    wc_ = selp[0];
    for (int tile = 0; tile < ntile; ++tile) {
        bf16x8 kn[4], vn[4]; unsigned wn = 0u;
        const int tn = (tile + 1 < ntile) ? tile + 1 : tile;
#pragma unroll
        for (int ks = 0; ks < 4; ++ks) { kn[ks] = *(const bf16x8*)(kb + (size_t)tn * 2048 + ks * 512); vn[ks] = *(const bf16x8*)(vb + (size_t)tn * 2048 + ks * 512); }
        wn = selp[tn];
        bf16x8 kx;
        {
            const unsigned w0 = (unsigned)__builtin_amdgcn_readlane((int)wc_, 0), w1 = (unsigned)__builtin_amdgcn_readlane((int)wc_, 1), w2 = (unsigned)__builtin_amdgcn_readlane((int)wc_, 2), w3 = (unsigned)__builtin_amdgcn_readlane((int)wc_, 3);
            const unsigned m0 = ((w0 >> n) & 1u) ? 0u : NEGB, m1 = ((w1 >> n) & 1u) ? 0u : NEGB, m2 = ((w2 >> n) & 1u) ? 0u : NEGB, m3 = ((w3 >> n) & 1u) ? 0u : NEGB;
            const float cs = LOG2E * (float)(tile * 32 + n);
            const unsigned c1 = f2bf(cs); const float r1 = cs - bf2f(c1); const unsigned c2 = f2bf(r1); const float r2 = r1 - bf2f(c2); const unsigned c3 = f2bf(r2);
            v4u e; e.x = m0 | (m1 << 16); e.y = m2 | (m3 << 16); e.z = c1 | (c2 << 16); e.w = c3;
            if (h) { e.x = 0u; e.y = 0u; e.z = 0u; e.w = 0u; }
            kx = __builtin_bit_cast(bf16x8, e);
        }
        f32x16 S;
#pragma unroll
        for (int x = 0; x < 16; ++x) S[x] = 0.f;
#pragma unroll
        for (int ks = 0; ks < 4; ++ks) S = mfma32(kc[ks], qf[ks], S);
        S = mfma32(kx, qf[4], S);
        float mloc = S[0];
#pragma unroll
        for (int x = 1; x < 16; ++x) mloc = fmaxf(mloc, S[x]);
        mloc = fmaxf(mloc, __shfl_xor(mloc, 32));
        const float mnew = fmaxf(m, mloc), alpha = __builtin_amdgcn_exp2f(m - mnew);
        m = mnew;
        float ps = 0.f;
#pragma unroll
        for (int x = 0; x < 16; ++x) { S[x] = __builtin_amdgcn_exp2f(S[x] - mnew); ps += S[x]; }
        lsum = lsum * alpha + ps;
#pragma unroll
        for (int x = 0; x < 16; ++x) { O0[x] *= alpha; O1[x] *= alpha; }
        v4u p0, p1;
        p0.x = pk2(S[0], S[1]); p0.y = pk2(S[2], S[3]); p0.z = pk2(S[4], S[5]); p0.w = pk2(S[6], S[7]);
        p1.x = pk2(S[8], S[9]); p1.y = pk2(S[10], S[11]); p1.z = pk2(S[12], S[13]); p1.w = pk2(S[14], S[15]);
        const bf16x8 pf0 = __builtin_bit_cast(bf16x8, p0), pf1 = __builtin_bit_cast(bf16x8, p1);
        O0 = mfma32(vc[0], pf0, O0); O1 = mfma32(vc[1], pf0, O1);
        O0 = mfma32(vc[2], pf1, O0); O1 = mfma32(vc[3], pf1, O1);
#pragma unroll
        for (int ks = 0; ks < 4; ++ks) { kc[ks] = kn[ks]; vc[ks] = vn[ks]; }
        wc_ = wn;
    }
    const float inv = 1.f / (lsum + __shfl_xor(lsum, 32));
    bf16* yo = YM + qrow * DM + hd * 64 + 4 * h;
#pragma unroll
    for (int j4 = 0; j4 < 4; ++j4) {
        v2u o; o.x = pk2(O0[4 * j4] * inv, O0[4 * j4 + 1] * inv); o.y = pk2(O0[4 * j4 + 2] * inv, O0[4 * j4 + 3] * inv);
        *(v2u*)(yo + 8 * j4) = o;
        v2u o2; o2.x = pk2(O1[4 * j4] * inv, O1[4 * j4 + 1] * inv); o2.y = pk2(O1[4 * j4 + 2] * inv, O1[4 * j4 + 3] * inv);
        *(v2u*)(yo + 32 + 8 * j4) = o2;
    }
}

__device__ __forceinline__ f32x4 mfma16(bf16x8 a, bf16x8 b, f32x4 c) { return __builtin_amdgcn_mfma_f32_16x16x32_bf16(a, b, c, 0, 0, 0); }
constexpr int B3_VS_PITCH = 144;
constexpr int B3_WAVE_LDS = 640 + 32 * B3_VS_PITCH;
#ifdef PROBE_HOT
#define B3_SKIP(bit) ((PROBE_SKIP & (bit)) && C.hot != 0xffff)
#define B3_HOTMASK C.hot
#else
#define B3_SKIP(bit) false
#define B3_HOTMASK 0xffff
#endif
template <bool FULL>
__device__ __forceinline__ void b3_core(Ctx& C, int b, int t, int nsel, const v4u qc0, const v4u qc1, LAS unsigned short* lst, LAS unsigned char* vs) {
    const bf16* PROJ = (const bf16*)(C.ws + WS_P); bf16* YM = (bf16*)C.out;
    const int lane = C.lane, m16 = lane & 15, g = lane >> 4;
    const size_t row = (size_t)b * SEQ + t;
    const int nt16 = FULL ? 16 : (nsel + 15) >> 4, nk32 = FULL ? 8 : (nsel + 31) >> 5;
    const bf16* vbase = PROJ + (size_t)b * SEQ * PW + C_AV + 8 * (lane & 7); const bf16* kbase = PROJ + (size_t)b * SEQ * PW + C_AK + 8 * g;
    v4u vb[3][4];
#pragma unroll
    for (int i = 0; i < 4; ++i) { const int s = (int)lst[8 * i + (lane >> 3)] & B3_HOTMASK; vb[0][i] = *(const v4u*)(vbase + (size_t)s * PW); }
    bf16x8 qf[2];
#pragma unroll
    for (int ks = 0; ks < 2; ++ks) {
        const v4u q4 = ks ? qc1 : qc0; const unsigned qw[4] = {q4.x, q4.y, q4.z, q4.w}; unsigned ow[4];
#pragma unroll
        for (int x = 0; x < 4; ++x) ow[x] = (m16 < 8) ? pk2(bf2f(qw[x] & 0xffffu) * (0.125f * LOG2E), bf2f(qw[x] >> 16) * (0.125f * LOG2E)) : 0u;
        v4u o; o.x = ow[0]; o.y = ow[1]; o.z = ow[2]; o.w = ow[3]; qf[ks] = __builtin_bit_cast(bf16x8, o);
    }
    const float sl2 = exp2f(-(float)((m16 & 7) + 1)) * LOG2E, tf = (float)t;
    f32x4 lg[16];
    bf16x8 a0[2][4], a1[2][4];
#define B3_GATHER(buf, hf_) { _Pragma("unroll") for (int i = 0; i < 4; ++i) { const int sm_k = ((FULL || 4 * (hf_) + i < nt16) ? (int)lst[16 * (4 * (hf_) + i) + m16] : 0) & B3_HOTMASK; \
        const bf16* kp = kbase + (size_t)sm_k * PW; a0[buf][i] = *(const bf16x8*)kp; a1[buf][i] = *(const bf16x8*)(kp + 32); } }
    if (!B3_SKIP(4)) { B3_GATHER(0, 0) B3_GATHER(1, 1) }
#pragma unroll
    for (int kt = 0; kt < 16; ++kt) {
        if (FULL || kt < nt16) {
            const v2u p4 = *(const LAS v2u*)(lst + 16 * kt + 4 * g);
            const float sr[4] = {(float)(p4.x & 0xffffu), (float)(p4.x >> 16), (float)(p4.y & 0xffffu), (float)(p4.y >> 16)};
#pragma unroll
            for (int r = 0; r < 4; ++r) lg[kt][r] = (FULL || 16 * kt + 4 * g + r < nsel) ? sl2 * (sr[r] - tf) : -3.0e38f;
        } else lg[kt] = (f32x4){-3.0e38f, -3.0e38f, -3.0e38f, -3.0e38f};
    }
#pragma unroll
    for (int hf = 0; hf < 4; ++hf) {
        if (!B3_SKIP(2)) {
#pragma unroll
            for (int i = 0; i < 4; ++i) if (FULL || 4 * hf + i < nt16) lg[4 * hf + i] = mfma16(a0[hf & 1][i], qf[0], lg[4 * hf + i]);
#pragma unroll
            for (int i = 0; i < 4; ++i) if (FULL || 4 * hf + i < nt16) lg[4 * hf + i] = mfma16(a1[hf & 1][i], qf[1], lg[4 * hf + i]);
        }
        if (!B3_SKIP(4)) { if (hf == 0) B3_GATHER(0, 2) if (hf == 1) B3_GATHER(1, 3) }
    }
    float mx;
    {
        float m0 = -3.0e38f, m1 = -3.0e38f, m2 = -3.0e38f, m3 = -3.0e38f;
#pragma unroll
        for (int kt = 0; kt < 16; ++kt) { m0 = fmaxf(m0, lg[kt][0]); m1 = fmaxf(m1, lg[kt][1]); m2 = fmaxf(m2, lg[kt][2]); m3 = fmaxf(m3, lg[kt][3]); }
        mx = fmaxf(fmaxf(m0, m1), fmaxf(m2, m3));
    }
#undef B3_GATHER
#pragma unroll
    for (int d = 1; d < 3; ++d) if (FULL || d < nk32) {
#pragma unroll
        for (int i = 0; i < 4; ++i) { const int s = (int)lst[32 * d + 8 * i + (lane >> 3)] & B3_HOTMASK; vb[d][i] = *(const v4u*)(vbase + (size_t)s * PW); }
    }
    mx = fmaxf(mx, SHX_F(mx, 16, lane)); mx = fmaxf(mx, SHX_F(mx, 32, lane));
    float sm_;
    {
        float s0 = 0.f, s1 = 0.f, s2 = 0.f, s3 = 0.f;
#pragma unroll
        for (int kt = 0; kt < 16; ++kt) {
            if (FULL || kt < nt16) {
                const float p0 = __builtin_amdgcn_exp2f(lg[kt][0] - mx), p1 = __builtin_amdgcn_exp2f(lg[kt][1] - mx), p2 = __builtin_amdgcn_exp2f(lg[kt][2] - mx), p3 = __builtin_amdgcn_exp2f(lg[kt][3] - mx);
                lg[kt] = (f32x4){p0, p1, p2, p3}; s0 += p0; s1 += p1; s2 += p2; s3 += p3;
            } else lg[kt] = (f32x4){0.f, 0.f, 0.f, 0.f};
        }
        sm_ = (s0 + s1) + (s2 + s3);
    }
    sm_ += SHX_F(sm_, 16, lane); sm_ += SHX_F(sm_, 32, lane);
    const float inv = 1.f / sm_;
    v4u pbk[8];
#pragma unroll
    for (int kk = 0; kk < 8; ++kk) { pbk[kk].x = pk2(lg[2 * kk][0], lg[2 * kk][1]); pbk[kk].y = pk2(lg[2 * kk][2], lg[2 * kk][3]); pbk[kk].z = pk2(lg[2 * kk + 1][0], lg[2 * kk + 1][1]); pbk[kk].w = pk2(lg[2 * kk + 1][2], lg[2 * kk + 1][3]); }
    f32x4 O[4];
#pragma unroll
    for (int i = 0; i < 4; ++i) O[i] = (f32x4){0.f, 0.f, 0.f, 0.f};
#pragma unroll
    for (int kk = 0; kk < 8; ++kk) if ((FULL || kk < nk32) && !B3_SKIP(1)) {
#pragma unroll
        for (int i = 0; i < 4; ++i) *(LAS v4u*)(vs + (8 * i + (lane >> 3)) * B3_VS_PITCH + (lane & 7) * 16) = vb[kk % 3][i];
        if (kk >= 1 && kk + 2 < 8 && (FULL || kk + 2 < nk32)) {
#pragma unroll
            for (int i = 0; i < 4; ++i) { const int s = (int)lst[32 * (kk + 2) + 8 * i + (lane >> 3)] & B3_HOTMASK; vb[(kk + 2) % 3][i] = *(const v4u*)(vbase + (size_t)s * PW); }
        }
        asm volatile("s_waitcnt lgkmcnt(0)" ::: "memory");
        const bf16x8 pB = __builtin_bit_cast(bf16x8, pbk[kk]);
#pragma unroll
        for (int u = 0; u < 2; ++u) {
            unsigned w[8];
#pragma unroll
            for (int j = 0; j < 8; ++j) { const int sl = (j < 4) ? 4 * g + j : 16 + 4 * g + (j - 4); w[j] = *(const LAS unsigned*)(vs + sl * B3_VS_PITCH + (32 * u + 2 * m16) * 2); }
            v4u ae, ao;
            ae.x = (w[0] & 0xffffu) | (w[1] << 16); ae.y = (w[2] & 0xffffu) | (w[3] << 16); ae.z = (w[4] & 0xffffu) | (w[5] << 16); ae.w = (w[6] & 0xffffu) | (w[7] << 16);
            ao.x = (w[0] >> 16) | (w[1] & 0xffff0000u); ao.y = (w[2] >> 16) | (w[3] & 0xffff0000u); ao.z = (w[4] >> 16) | (w[5] & 0xffff0000u); ao.w = (w[6] >> 16) | (w[7] & 0xffff0000u);
            O[2 * u] = mfma16(__builtin_bit_cast(bf16x8, ae), pB, O[2 * u]); O[2 * u + 1] = mfma16(__builtin_bit_cast(bf16x8, ao), pB, O[2 * u + 1]);
        }
    }
    if (m16 < 8) {
#pragma unroll
        for (int u = 0; u < 2; ++u) {
            v4u o; o.x = pk2(O[2 * u][0] * inv, O[2 * u + 1][0] * inv); o.y = pk2(O[2 * u][1] * inv, O[2 * u + 1][1] * inv); o.z = pk2(O[2 * u][2] * inv, O[2 * u + 1][2] * inv); o.w = pk2(O[2 * u][3] * inv, O[2 * u + 1][3] * inv);
            *(v4u*)(YM + row * DM + m16 * 64 + 32 * u + 8 * g) = o;
        }
    }
}
__device__ __forceinline__ void ph_dsa_b3_wave(Ctx& C, int b, int t4) {
    LAS unsigned short* lst = (LAS unsigned short*)(C.lds + C.wave * B3_WAVE_LDS);
    LAS unsigned char* vs = C.lds + C.wave * B3_WAVE_LDS + 640;
    const bf16* PROJ = (const bf16*)(C.ws + WS_P); const unsigned* SEL = (const unsigned*)(C.ws + WS_SEL);
    const int lane = C.lane, m16 = lane & 15, g = lane >> 4;
    unsigned w0n, w1n; v4u qn0, qn1;
#define B3_PREFETCH(tq) { const size_t r_ = (size_t)b * SEQ + (tq); const int nw_ = ((tq) >> 5) + 1; \
        w0n = (2 * lane < nw_) ? SEL[r_ * 128 + 2 * lane] : 0u; w1n = (2 * lane + 1 < nw_) ? SEL[r_ * 128 + 2 * lane + 1] : 0u; \
        const bf16* qp_ = PROJ + r_ * PW + C_AQ + (m16 & 7) * 64 + 8 * g; qn0 = *(const v4u*)qp_; qn1 = *(const v4u*)(qp_ + 32); }
    B3_PREFETCH(t4)
#pragma unroll 1
    for (int qi = 0; qi < 4; ++qi) {
        const int t = t4 + qi;
        const size_t row = (size_t)b * SEQ + t;
        unsigned w0 = w0n, w1 = w1n;
        const v4u qc0 = qn0, qc1 = qn1;
        if (qi < 3) B3_PREFETCH(t + 1)
        int nsel;
        {
            const int c = __popc(w0) + __popc(w1); const int incl = wave_incl_scan_i(c, lane);
            int pos = incl - c; const int tot = __builtin_amdgcn_readlane(incl, 63);
            if (!B3_SKIP(8)) {
            while (w0) { const int bit = __ffs(w0) - 1; w0 &= w0 - 1; if (pos < 256) lst[pos] = (unsigned short)(64 * lane + bit); ++pos; }
            while (w1) { const int bit = __ffs(w1) - 1; w1 &= w1 - 1; if (pos < 256) lst[pos] = (unsigned short)(64 * lane + 32 + bit); ++pos; }
            }
            nsel = tot < 256 ? tot : 256;
            if (lane < 32 && nsel + lane < 288) lst[nsel + lane] = 0;
        }
        asm volatile("s_waitcnt lgkmcnt(0)" ::: "memory");
        if (nsel == 256) b3_core<true>(C, b, t, nsel, qc0, qc1, lst, vs); else b3_core<false>(C, b, t, nsel, qc0, qc1, lst, vs);
    }
#undef B3_PREFETCH
}

namespace pg8 {
constexpr int BM = 256, BK = 64, HALF = 128, HTB = HALF * BK * 2, STAGE_BYTES = 8 * HTB, NXCD = 8, WGM = 8;
__host__ __device__ __forceinline__ int lds_byte(int r, int c) { const int st = (r >> 4) * 2 + (c >> 5), rr = r & 15, cc = c & 31, ob = rr * 64 + cc * 2; return st * 1024 + (ob ^ (((ob >> 9) & 1) << 5)); }
__host__ __device__ __forceinline__ void stage_rc(int b, int& R, int& C) { const int st = b / 1024, sb = b % 1024, swz = sb ^ (((sb >> 9) & 1) << 5); R = (st >> 1) * 16 + swz / 64; C = (st & 1) * 32 + (swz % 64) / 2; }
__host__ __device__ __forceinline__ int perm32(int rho) { const int n = rho >> 4, i = rho & 15; return 8 * (i >> 2) + 4 * n + (i & 3); }

struct Unit { int pm, pn, po, eb; };
struct Gemm { const bf16* A; const bf16* Bt; int K; size_t ebytes; };

struct Order {
    int nM, nN, nwg, G, c, p_lo, amode; const LAS unsigned char* pe;
    __device__ __forceinline__ void init(int nM_, int nN_, int G_, int c_, int p_lo_, int amode_, const LAS unsigned char* pe_) { nM = nM_; nN = nN_; nwg = nM * nN; G = G_; c = c_; p_lo = p_lo_; amode = amode_; pe = pe_; }
    __device__ __forceinline__ bool next(int i, Unit& u) const {
        const long L = (long)i * G + c; if (L >= nwg) return false;
        int wgid = (int)L; { const int q = nwg / NXCD, r = nwg % NXCD, xcd = wgid % NXCD, off = wgid / NXCD; wgid = (xcd < r ? xcd * (q + 1) : r * (q + 1) + (xcd - r) * q) + off; }
        const int nig = WGM * nN, gid = wgid / nig, fm = gid * WGM, gsz = (nM - fm) < WGM ? (nM - fm) : WGM;
        const int lp = fm + ((wgid % nig) % gsz), gp = p_lo + lp; u.pn = (wgid % nig) / gsz;
        u.pm = amode == 0 ? gp : lp; u.po = amode == 0 ? lp : gp; u.eb = pe ? __builtin_amdgcn_readfirstlane((int)pe[gp]) : 0; return true;
    }
};

__device__ __forceinline__ unsigned cvt_pk_bf16(float lo, float hi) { unsigned r; asm volatile("v_cvt_pk_bf16_f32 %0, %1, %2" : "=v"(r) : "v"(lo), "v"(hi)); return r; }
__device__ __forceinline__ float silu_fast(float g) { return g * __builtin_amdgcn_rcpf(1.f + __builtin_amdgcn_exp2f(-g * LOG2E)); }

struct EpiBf16 {
    static constexpr bool PERM = true;
    bf16* O; int ldc;
    __device__ __forceinline__ void operator()(const f32x4 (&acc)[2][2][4][2], const Unit& u, int wr, int wc, int fr, int fq) const {
        const int row0 = u.po * BM + wr * 64 + fr, col0 = u.pn * BM + wc * 32 + 8 * fq;
#pragma unroll
        for (int ai = 0; ai < 2; ++ai)
#pragma unroll
            for (int m = 0; m < 4; ++m) { bf16* rowp = O + (size_t)(row0 + ai * HALF + m * 16) * ldc + col0;
#pragma unroll
                for (int bj = 0; bj < 2; ++bj) { const f32x4 v0 = acc[ai][bj][m][0], v1 = acc[ai][bj][m][1];
                    v4u w; w.x = cvt_pk_bf16(v0[0], v0[1]); w.y = cvt_pk_bf16(v0[2], v0[3]); w.z = cvt_pk_bf16(v1[0], v1[1]); w.w = cvt_pk_bf16(v1[2], v1[3]);
                    *(v4u*)(rowp + bj * HALF) = w; } }
    }
};
struct EpiProj {
    static constexpr bool PERM = true;
    bf16* O; bf16* KFA; bf16* KFI; bf16* VF;
    __device__ __forceinline__ void operator()(const f32x4 (&acc)[2][2][4][2], const Unit& u, int wr, int wc, int fr, int fq) const {
        const int row0 = u.po * BM + wr * 64 + fr, col0 = u.pn * BM + wc * 32 + 8 * fq;
#pragma unroll
        for (int ai = 0; ai < 2; ++ai)
#pragma unroll
            for (int m = 0; m < 4; ++m) { const int row = row0 + ai * HALF + m * 16; bf16* rowp = O + (size_t)row * PW + col0;
#pragma unroll
                for (int bj = 0; bj < 2; ++bj) { const f32x4 v0 = acc[ai][bj][m][0], v1 = acc[ai][bj][m][1];
                    v4u w; w.x = cvt_pk_bf16(v0[0], v0[1]); w.y = cvt_pk_bf16(v0[2], v0[3]); w.z = cvt_pk_bf16(v1[0], v1[1]); w.w = cvt_pk_bf16(v1[2], v1[3]);
                    *(v4u*)(rowp + bj * HALF) = w;
                    if (u.pn == 10) {
                        if (wc < 2) {
                            const int dc = 4 * wc + fq;
                            bf16* kf = (bj == 0 ? KFA : KFI) + ((size_t)(row >> 5) * 4 + (dc >> 1)) * 512 + (32 * (dc & 1) + (row & 31)) * 8;
                            *(v4u*)kf = w;
                        } else if (bj == 0) {
                            const int kap = row & 31, mf = kap >> 4, k15 = kap & 15, hh = (k15 >> 2) & 1, j = (k15 & 3) + 4 * (k15 >> 3);
                            bf16* vf = VF + ((((size_t)(row >> 5) * 2 + mf) * 2 + (wc - 2)) * 64 + 32 * hh + 8 * fq) * 8 + j;
                            vf[0 * 8] = (bf16)(w.x & 0xffffu); vf[1 * 8] = (bf16)(w.x >> 16); vf[2 * 8] = (bf16)(w.y & 0xffffu); vf[3 * 8] = (bf16)(w.y >> 16);
                            vf[4 * 8] = (bf16)(w.z & 0xffffu); vf[5 * 8] = (bf16)(w.z >> 16); vf[6 * 8] = (bf16)(w.w & 0xffffu); vf[7 * 8] = (bf16)(w.w >> 16);
                        }
                    } } }
    }
};
struct EpiGate {
    static constexpr bool PERM = true;
    bf16* O; const float* gate;
    __device__ __forceinline__ void operator()(const f32x4 (&acc)[2][2][4][2], const Unit& u, int wr, int wc, int fr, int fq) const {
        const int row0 = u.po * BM + wr * 64 + fr, col0 = u.pn * BM + wc * 32 + 8 * fq;
#pragma unroll
        for (int ai = 0; ai < 2; ++ai)
#pragma unroll
            for (int m = 0; m < 4; ++m) { const int row = row0 + ai * HALF + m * 16; const float g = gate ? gate[row] : 1.f; bf16* rowp = O + (size_t)row * DM + col0;
#pragma unroll
                for (int bj = 0; bj < 2; ++bj) { const f32x4 v0 = acc[ai][bj][m][0] * g, v1 = acc[ai][bj][m][1] * g;
                    v4u w; w.x = cvt_pk_bf16(v0[0], v0[1]); w.y = cvt_pk_bf16(v0[2], v0[3]); w.z = cvt_pk_bf16(v1[0], v1[1]); w.w = cvt_pk_bf16(v1[2], v1[3]);
                    *(v4u*)(rowp + bj * HALF) = w; } }
    }
};
struct EpiSwiglu {
    static constexpr bool PERM = true;
    bf16* O;
    __device__ __forceinline__ void operator()(const f32x4 (&acc)[2][2][4][2], const Unit& u, int wr, int wc, int fr, int fq) const {
        const int row0 = u.po * BM + wr * 64 + fr, col0 = u.pn * HALF + wc * 32 + 8 * fq;
#pragma unroll
        for (int ai = 0; ai < 2; ++ai)
#pragma unroll
            for (int m = 0; m < 4; ++m) { bf16* rowp = O + (size_t)(row0 + ai * HALF + m * 16) * DFF + col0;
                const f32x4 g0 = acc[ai][0][m][0], g1 = acc[ai][0][m][1], u0 = acc[ai][1][m][0], u1 = acc[ai][1][m][1];
                v4u w; w.x = cvt_pk_bf16(silu_fast(g0[0]) * u0[0], silu_fast(g0[1]) * u0[1]); w.y = cvt_pk_bf16(silu_fast(g0[2]) * u0[2], silu_fast(g0[3]) * u0[3]);
                w.z = cvt_pk_bf16(silu_fast(g1[0]) * u1[0], silu_fast(g1[1]) * u1[1]); w.w = cvt_pk_bf16(silu_fast(g1[2]) * u1[2], silu_fast(g1[3]) * u1[3]);
                *(v4u*)rowp = w; }
    }
};

template <class Epi, class Sched>
__device__ __forceinline__ void gemm_phase(LAS unsigned char* lds, const int tid, const Gemm g, const Sched& S, const Epi& E) {
    const int wid = __builtin_amdgcn_readfirstlane(tid >> 6), lane = tid & 63, wr = wid >> 2, wc = wid & 3, fr = lane & 15, fq = lane >> 4;
    const int K = g.K, nt = K / BK;
    unsigned voffA[2], voffB[2];
#pragma unroll
    for (int i = 0; i < 2; ++i) { int R, C; stage_rc(tid * 16 + i * 8192, R, C); const int Rb = Epi::PERM ? ((R & ~31) + perm32(R & 31)) : R; voffA[i] = (unsigned)(R * K + C) * 2u; voffB[i] = (unsigned)(Rb * K + C) * 2u; }
    const size_t kstep = (size_t)(BK * 2);
    const size_t hstep = (size_t)HALF * K * 2;
    const size_t tstep = 2 * hstep;
    const unsigned ldsw = (unsigned)wid * 1024u;
    const int aoff = lds_byte(wr * 64 + fr, fq * 8), boff = lds_byte(wc * 32 + fr, fq * 8);
#define PG8_SA(b, h) (((b) * 2 + (h)) * HTB)
#define PG8_SB(b, h) ((4 + (b) * 2 + (h)) * HTB)
#define PG8_STAGE(bufoff, gbase, voff) do { _Pragma("unroll") for (int _i = 0; _i < 2; ++_i) \
        __builtin_amdgcn_global_load_lds((const unsigned*)((const char*)(gbase) + (voff)[_i]), (LAS unsigned*)(lds + (bufoff) + ldsw + _i * 8192), 16, 0, 0); } while (0)
#define PG8_LDA(dst, b, h) do { _Pragma("unroll") for (int m = 0; m < 4; ++m) _Pragma("unroll") for (int k = 0; k < 2; ++k) dst[m][k] = *(const LAS bf16x8*)(lds + PG8_SA(b, h) + aoff + m * 2048 + k * 1024); } while (0)
#define PG8_LDB(dst, b, h) do { _Pragma("unroll") for (int n = 0; n < 2; ++n) _Pragma("unroll") for (int k = 0; k < 2; ++k) dst[n][k] = *(const LAS bf16x8*)(lds + PG8_SB(b, h) + boff + n * 2048 + k * 1024); } while (0)
#define PG8_MMA(ai, bj, At, Bt) do { __builtin_amdgcn_s_setprio(1); _Pragma("unroll") for (int m = 0; m < 4; ++m) _Pragma("unroll") for (int n = 0; n < 2; ++n) _Pragma("unroll") for (int k = 0; k < 2; ++k) \
        acc[ai][bj][m][n] = __builtin_amdgcn_mfma_f32_16x16x32_bf16(Bt[n][k], At[m][k], acc[ai][bj][m][n], 0, 0, 0); __builtin_amdgcn_s_setprio(0); } while (0)
#define PG8_WAIT_V(n) asm volatile("s_waitcnt vmcnt(" #n ")" ::: "memory")
#define PG8_WAIT_L(n) asm volatile("s_waitcnt lgkmcnt(" #n ")" ::: "memory")
#define PG8_BAR __builtin_amdgcn_s_barrier()
#define PG8_SCHED __builtin_amdgcn_sched_barrier(0)
    Unit cur, nxt; int ui = 0;
    if (!S.next(0, cur)) return;
    f32x4 acc[2][2][4][2];
#pragma unroll
    for (int a = 0; a < 2; ++a)
#pragma unroll
        for (int b = 0; b < 2; ++b)
#pragma unroll
            for (int m = 0; m < 4; ++m)
#pragma unroll
                for (int n = 0; n < 2; ++n) acc[a][b][m][n] = (f32x4){0.f, 0.f, 0.f, 0.f};
    bf16x8 At[4][2], B0[2][2], B1[2][2];
    const char* cA = (const char*)g.A + (size_t)cur.pm * tstep;
    const char* cB = (const char*)g.Bt + (size_t)cur.eb * g.ebytes + (size_t)cur.pn * tstep;
    PG8_STAGE(PG8_SB(0, 0), cB, voffB); PG8_STAGE(PG8_SB(0, 1), cB + hstep, voffB); PG8_STAGE(PG8_SA(0, 0), cA, voffA); PG8_STAGE(PG8_SA(0, 1), cA + hstep, voffA);
    if (wr == 1) PG8_BAR;
    PG8_WAIT_V(2); PG8_BAR;
    PG8_STAGE(PG8_SB(1, 0), cB + kstep, voffB); PG8_STAGE(PG8_SA(1, 0), cA + kstep, voffA); PG8_STAGE(PG8_SB(1, 1), cB + hstep + kstep, voffB);
    PG8_WAIT_V(6); PG8_BAR;
    for (;;) {
        const bool has_next = S.next(ui + 1, nxt);
        const char* nA = has_next ? (const char*)g.A + (size_t)nxt.pm * tstep : cA;
        const char* nB = has_next ? (const char*)g.Bt + (size_t)nxt.eb * g.ebytes + (size_t)nxt.pn * tstep : cB;
#define PG8_PAIR(a1, a2, b2, a3, b3) do { \
              \
            PG8_LDB(B0, 0, 0); PG8_LDB(B1, 0, 1); PG8_SCHED; PG8_LDA(At, 0, 0); PG8_STAGE(PG8_SA(1, 1), (a1) + hstep, voffA); \
            PG8_WAIT_V(8); PG8_WAIT_L(0); PG8_BAR; PG8_MMA(0, 0, At, B0); PG8_MMA(0, 1, At, B1); PG8_BAR; PG8_SCHED; \
              \
            PG8_LDA(At, 0, 1); PG8_STAGE(PG8_SB(0, 0), b2, voffB); PG8_STAGE(PG8_SB(0, 1), (b2) + hstep, voffB); PG8_STAGE(PG8_SA(0, 0), a2, voffA); \
            PG8_WAIT_V(8); PG8_WAIT_L(0); PG8_BAR; PG8_MMA(1, 0, At, B0); PG8_MMA(1, 1, At, B1); PG8_BAR; PG8_SCHED; \
              \
            PG8_LDB(B0, 1, 0); PG8_LDB(B1, 1, 1); PG8_SCHED; PG8_LDA(At, 1, 0); PG8_STAGE(PG8_SA(0, 1), (a2) + hstep, voffA); \
            PG8_WAIT_V(8); PG8_WAIT_L(0); PG8_BAR; PG8_MMA(0, 0, At, B0); PG8_MMA(0, 1, At, B1); PG8_BAR; PG8_SCHED; \
              \
            PG8_LDA(At, 1, 1); PG8_STAGE(PG8_SB(1, 0), b3, voffB); PG8_STAGE(PG8_SB(1, 1), (b3) + hstep, voffB); PG8_STAGE(PG8_SA(1, 0), a3, voffA); \
            PG8_WAIT_V(8); PG8_WAIT_L(0); PG8_BAR; PG8_MMA(1, 0, At, B0); PG8_MMA(1, 1, At, B1); PG8_BAR; PG8_SCHED; } while (0)
        for (int t = 0; t < nt; t += 2) {
            const bool last = (t == nt - 2);
            const char* a1 = cA + (size_t)(t + 1) * kstep;
            const char* a2 = last ? nA : cA + (size_t)(t + 2) * kstep; const char* b2 = last ? nB : cB + (size_t)(t + 2) * kstep;
            const char* a3 = a2 + kstep; const char* b3 = b2 + kstep;
            PG8_PAIR(a1, a2, b2, a3, b3);
        }
#undef PG8_PAIR
        if (wr == 0) PG8_BAR;
        E(acc, cur, wr, wc, fr, fq);
        if (!has_next) break;
#pragma unroll
        for (int a = 0; a < 2; ++a)
#pragma unroll
            for (int b = 0; b < 2; ++b)
#pragma unroll
                for (int m = 0; m < 4; ++m)
#pragma unroll
                    for (int n = 0; n < 2; ++n) acc[a][b][m][n] = (f32x4){0.f, 0.f, 0.f, 0.f};
        cur = nxt; cA = nA; cB = nB; ++ui;
        if (wr == 1) PG8_BAR;
    }
    PG8_WAIT_V(0);
    PG8_BAR;
#undef PG8_SA
#undef PG8_SB
#undef PG8_STAGE
#undef PG8_LDA
#undef PG8_LDB
#undef PG8_MMA
#undef PG8_WAIT_V
#undef PG8_WAIT_L
#undef PG8_BAR
#undef PG8_SCHED
}
}

constexpr int N_STEPS = 2 + 2 * (7 + 2 * NPASS_DENSE) + 2 * (8 + 2 * NPASS_MOE);
#ifndef REP_A
#define REP_A 1
#define REP_B 1
#endif
#ifndef PROBE_ID
#define PROBE_ID 0
#endif
#ifndef REP_BAR
#define REP_BAR 1
#endif
#ifndef REP_C
#define REP_C 1
#endif
#ifndef REP_L
#define REP_L 1
#endif
#ifndef REP_G
#define REP_G 1
#endif
#ifndef USE_B3
#define USE_B3 1
#endif
#ifndef USE_B2
#define USE_B2 1
#define USE_A2 1
#endif
#ifndef USE_PG8
#define USE_PG8 1
#endif
#ifndef USE_A4
#define USE_A4 1
#endif

__global__ void __launch_bounds__(512, 2) hybrid_fwd(Args args) {
    extern __shared__ __attribute__((aligned(16))) unsigned char lds_raw[];
    Ctx C;
    C.lds = (LAS unsigned char*)lds_raw;
    C.MISC = (volatile LAS unsigned*)(C.lds + MISC_OFF);
    C.tid = threadIdx.x; C.lane = C.tid & 63; C.wave = __builtin_amdgcn_readfirstlane(C.tid >> 6);
    C.G = gridDim.x; C.bid = blockIdx.x; C.hot = 0xffff;
    C.ka = (KArgs*)__builtin_amdgcn_kernarg_segment_ptr();
    C.out = args.out; C.ws = args.ws; C.ctl = (unsigned*)(args.ws + WS_CTL);
    if (C.tid < 32) C.MISC[C.tid] = 0u;
    __syncthreads();
    if (!MK_MULTI) (void)xcd_barrier_post(C.ctl + CW_BAR, C.MISC + 8);
    int step = 0;
    const int wave_s = __builtin_amdgcn_readfirstlane((int)threadIdx.x >> 6);
#define STEP_BEGIN if (step >= C.ka->lo && step < C.ka->hi) { { unsigned m_ = ~0u; asm volatile("" : "+s"(m_)); const int ln_ = (int)__builtin_amdgcn_mbcnt_hi(m_, __builtin_amdgcn_mbcnt_lo(m_, 0u)); \
        int t_ = wave_s * 64 + ln_; asm volatile("" : "+v"(t_)); C.tid = t_; C.lane = t_ & 63; C.wave = wave_s; \
        KArgs* k_ = (KArgs*)__builtin_amdgcn_kernarg_segment_ptr(); asm volatile("" : "+s"(k_)); C.ka = k_; C.ws = k_->ws; C.out = k_->out; C.ctl = (unsigned*)(k_->ws + WS_CTL); C.G = gridDim.x; C.bid = blockIdx.x; }
#define STEP_END } if (!MK_MULTI && step >= C.ka->lo && step + 1 < C.ka->hi) { XcdBarrier b_; b_.bar = (unsigned*)(C.ka->ws + WS_CTL) + CW_BAR; b_.x = xb_xcc_id(); b_.st = C.MISC + 8; xcd_barrier(b_); if (REP_BAR > 1) xcd_barrier(b_); } ++step;
#define WSP(T, off) ((T*)(C.ws + (off)))
#define RELAUNDER { int t_ = C.tid; asm volatile("" : "+v"(t_)); C.tid = t_; C.lane = t_ & 63; C.wave = __builtin_amdgcn_readfirstlane(t_ >> 6); }

    STEP_BEGIN
        ph_mod(C); __syncthreads(); ph_conv(C, 0);
#if REP_C > 1
        __syncthreads(); ph_mod(C); __syncthreads(); ph_conv(C, 0);
#endif
    STEP_END
    STEP_BEGIN
        ph_modulate0(C);
#if PROBE_ID == 8
        RELAUNDER ph_modulate0(C); RELAUNDER ph_modulate0(C); RELAUNDER ph_modulate0(C); RELAUNDER ph_modulate0(C);
#endif
    STEP_END

    for (int l = 0; l < DEPTH; ++l) {
        STEP_BEGIN
#if USE_PG8
            { const pg8::Gemm g{WSP(bf16, WS_H), WSP(bf16, WS_WIN), DM, 0}; pg8::Order S; S.init(256, 11, C.G, C.bid, 0, 0, nullptr);
              pg8::gemm_phase(C.lds, C.tid, g, S, pg8::EpiProj{WSP(bf16, WS_P), WSP(bf16, WS_KFA), WSP(bf16, WS_KFI), WSP(bf16, WS_VF)});
#if PROBE_ID == 5
              RELAUNDER pg8::gemm_phase(C.lds, C.tid, g, S, pg8::EpiProj{WSP(bf16, WS_P), WSP(bf16, WS_KFA), WSP(bf16, WS_KFI), WSP(bf16, WS_VF)});
#endif
            }
#else
            for (int u = C.bid; u < 256 * 11; u += C.G) {
                const int pm = u / 11, pn = u % 11; const GUnit gu{pm * 256, pm * 256, pn, 0};
                gemm_simple_unit<0>(C, WSP(bf16, WS_H), DM, nullptr, WSP(bf16, WS_WIN), DM, gu, EpiStoreS{WSP(bf16, WS_P), PW});
            }
#endif
        STEP_END
        STEP_BEGIN
#pragma unroll 1
#if USE_A4
            for (int rp_ = 0; rp_ < (PROBE_ID == 1 ? 2 : 1); ++rp_) {
#define A4_MAP(idx_) const int b = (idx_) & 15, r_ = (idx_) >> 4, j_ = (r_ & 15) + 16 * (r_ >> 5), t0 = 4 * (((r_ >> 4) & 1) ? 1023 - j_ : j_);
                LAS unsigned* img = (LAS unsigned*)C.lds;
                const int nun = (C.bid < 16384) ? (16384 - C.bid + C.G - 1) / C.G : 0;
                if (C.wave < 4) {
                    A4S S;
                    { A4_MAP(C.bid < 16384 ? C.bid : 0) a4_prefetch(C, S, b, t0); }
#pragma unroll 1
                    for (int k = 0; k < nun; ++k) { RELAUNDER
                        { A4_MAP(C.bid + k * C.G) a4_score(C, S, img + (k & 1) * A4_BUF, b, t0); }
                        { const int nidx = (k + 1 < nun) ? C.bid + (k + 1) * C.G : C.bid; A4_MAP(nidx) a4_prefetch(C, S, b, t0); }
                        __syncthreads(); }
                } else {
#pragma unroll 1
                    for (int k = 0; k < nun; ++k) { __syncthreads(); RELAUNDER A4_MAP(C.bid + k * C.G) const int q = C.wave - 4; a4_select(C, img + (k & 1) * A4_BUF + q * A3_QP, b, t0 + q); }
                }
                __syncthreads();
#undef A4_MAP
            }
#else
            for (int rp_ = 0; rp_ < (PROBE_ID == 1 ? 2 : 1); ++rp_)
            for (int idx = C.bid; idx < 8192; idx += C.G) {
                RELAUNDER
                const int b = idx & 15, r = idx >> 4, j = (r & 15) + 16 * (r >> 5), qb = ((r >> 4) & 1) ? 511 - j : j;
                A3Q qa; a3_load_q(C, b, qb * 8, qa);
                ph_dsa_a3_unit(C, b, qb * 8, qa, false, 0, 0);
            }
#endif
#pragma unroll 1
            for (int rp_ = 0; rp_ < (PROBE_ID == 3 ? 2 : 1); ++rp_)
            for (int u = C.bid; u < 4096; u += C.G) { RELAUNDER ph_gla1_unit(C, l, u); }
        STEP_END
        STEP_BEGIN
            ph_gla2(C);
#if PROBE_ID == 9
            RELAUNDER ph_gla2(C, (size_t)66 * MiB); RELAUNDER ph_gla2(C, (size_t)66 * MiB);
#endif
        STEP_END
        STEP_BEGIN
#pragma unroll 1
            for (int rp_ = 0; rp_ < (PROBE_ID == 4 ? 2 : 1); ++rp_)
            for (int u = C.bid; u < 4096; u += C.G) { RELAUNDER ph_gla3_unit(C, l, u); }
#if USE_B2
#pragma unroll 1
            for (int rep = 0; rep < (PROBE_ID == 2 ? 2 : 1); ++rep)
#ifdef PROBE_HOT
            { C.hot = (rep == 0) ? PROBE_HOT : 0xffff;
#else
            {
#endif
            for (int idx = C.bid; idx < 2048; idx += C.G) {
                RELAUNDER
                const int b = idx & 15, r = idx >> 4, j = (r & 15) + 16 * (r >> 5), qb = ((r >> 4) & 1) ? 127 - j : j;
#if USE_B3
                ph_dsa_b3_wave(C, b, qb * 32 + C.wave * 4);
#else
                ph_dsa_b2_wave(C, b, qb * 32 + C.wave * 4);
#endif
            }
            }
#else
            for (int u = C.bid; u < 8192; u += C.G) { RELAUNDER ph_dsa_b_unit(C, u & 15, (u >> 4) * 8); }
#endif
        STEP_END
        STEP_BEGIN
#if USE_PG8
            { const pg8::Gemm g{(const bf16*)C.out, WSP(bf16, WS_WOUT), DM, 0}; pg8::Order S; S.init(256, 4, C.G, C.bid, 0, 0, nullptr);
              pg8::gemm_phase(C.lds, C.tid, g, S, pg8::EpiBf16{WSP(bf16, WS_Y), DM});
#if PROBE_ID == 6
              RELAUNDER pg8::gemm_phase(C.lds, C.tid, g, S, pg8::EpiBf16{WSP(bf16, WS_Y), DM});
#endif
            }
#else
            for (int u = C.bid; u < 256 * 4; u += C.G) {
                const int pm = u >> 2, pn = u & 3; const GUnit gu{pm * 256, pm * 256, pn, 0};
                gemm_simple_unit<0>(C, WSP(bf16, WS_H), DM, nullptr, WSP(bf16, WS_WOUT), DM, gu, EpiStoreS{WSP(bf16, WS_Y), DM});
            }
#endif
        STEP_END
        STEP_BEGIN
            const float* Xin = C.in(I_X);
            if (l == 0) ph_ln<false, 0, 0>(C, Xin, l, 0, 2048, l, 3072, true, 0, 0, false);
            else if (l & 1) ph_ln<true, 0, 1>(C, Xin, l, 0, 2048, l, 3072, true, l >> 1, 0, false);
            else ph_ln<false, 0, 1>(C, Xin, l, 0, 2048, l, 3072, true, l >> 1, 0, false);
        STEP_END
        if (l & 1) {
            STEP_BEGIN
                ph_assign(C, l >> 1);
            STEP_END
        }
        for (int pass = 0; pass < ((l & 1) ? NPASS_MOE : NPASS_DENSE); ++pass) {
            STEP_BEGIN
                const bool moe = (l & 1) != 0;
                MoeTab tb; tb.npanels = 256;
#pragma unroll
                for (int e = 0; e < 8; ++e) tb.pend[e] = 65536;
                if (moe) tb = moe_tab(C, l >> 1);
                const int p_lo = pass * PASS_PANELS, p_hi = moe ? ((pass == NPASS_MOE - 1 || tb.npanels < p_lo + PASS_PANELS) ? tb.npanels : p_lo + PASS_PANELS) : p_lo + PASS_PANELS;
                const int npan = p_hi > p_lo ? p_hi - p_lo : 0;
#if USE_PG8
                LAS unsigned char* pe = C.lds + PE_OFF;
                for (int p = C.tid; p < 528; p += 512) pe[p] = (unsigned char)(moe ? panel_expert(tb, p) : 0);
                __syncthreads();
                { const pg8::Gemm g{moe ? WSP(bf16, WS_Y) : WSP(bf16, WS_H), WSP(bf16, WS_WGU), DM, (size_t)5632 * 1024 * 2}; pg8::Order S; S.init(npan, 22, C.G, C.bid, p_lo, 0, pe);
                  pg8::gemm_phase(C.lds, C.tid, g, S, pg8::EpiSwiglu{WSP(bf16, WS_P)});
#if REP_G > 1
                  RELAUNDER pg8::gemm_phase(C.lds, C.tid, g, S, pg8::EpiSwiglu{WSP(bf16, WS_P)});
#endif
                }
#else
                for (int u = C.bid; u < npan * 22; u += C.G) {
                    const int lp = u / 22, pn = u % 22, gp = p_lo + lp; const int e = moe ? panel_expert(tb, gp) : 0;
                    const GUnit gu{gp * 256, lp * 256, pn, (size_t)e * 5632 * 1024};
                    gemm_simple_unit<1>(C, moe ? WSP(bf16, WS_Y) : WSP(bf16, WS_H), DM, nullptr, WSP(bf16, WS_WGU), DM, gu, EpiSwigluS{WSP(bf16, WS_P)});
                }
#endif
            STEP_END
            STEP_BEGIN
                const bool moe = (l & 1) != 0;
                MoeTab tb; tb.npanels = 256;
#pragma unroll
                for (int e = 0; e < 8; ++e) tb.pend[e] = 65536;
                if (moe) tb = moe_tab(C, l >> 1);
                const int p_lo = pass * PASS_PANELS, p_hi = moe ? ((pass == NPASS_MOE - 1 || tb.npanels < p_lo + PASS_PANELS) ? tb.npanels : p_lo + PASS_PANELS) : p_lo + PASS_PANELS;
                const int npan = p_hi > p_lo ? p_hi - p_lo : 0;
#if USE_PG8
                LAS unsigned char* pe = C.lds + PE_OFF;
                for (int p = C.tid; p < 528; p += 512) pe[p] = (unsigned char)(moe ? panel_expert(tb, p) : 0);
                __syncthreads();
                { const pg8::Gemm g{WSP(bf16, WS_P), WSP(bf16, WS_WDN), DFF, (size_t)1024 * DFF * 2}; pg8::Order S; S.init(npan, 4, C.G, C.bid, p_lo, 1, pe);
                  pg8::gemm_phase(C.lds, C.tid, g, S, pg8::EpiGate{WSP(bf16, WS_Y), moe ? WSP(float, WS_ROWGATE) : nullptr});
#if PROBE_ID == 7
                  RELAUNDER pg8::gemm_phase(C.lds, C.tid, g, S, pg8::EpiGate{WSP(bf16, WS_Y), moe ? WSP(float, WS_ROWGATE) : nullptr});
#endif
                }
#else
                for (int u = C.bid; u < npan * 4; u += C.G) {
                    const int lp = u >> 2, pn = u & 3, gp = p_lo + lp; const int e = moe ? panel_expert(tb, gp) : 0;
                    const GUnit gu{lp * 256, gp * 256, pn, (size_t)e * 1024 * DFF};
                    if (moe) gemm_simple_unit<0>(C, WSP(bf16, WS_P), DFF, nullptr, WSP(bf16, WS_WDN), DFF, gu, EpiGateS{WSP(bf16, WS_Y), WSP(float, WS_ROWGATE)});
                    else gemm_simple_unit<0>(C, WSP(bf16, WS_P), DFF, nullptr, WSP(bf16, WS_WDN), DFF, gu, EpiStoreS{WSP(bf16, WS_Y), DM});
                }
#endif
            STEP_END
        }
        STEP_BEGIN
            const int l2 = l < 3 ? l + 1 : 3;
            if (l & 1) ph_ln<false, 1, 1>(C, nullptr, l, 1, 5120, l2, 0, l < 3, 0, 3072, l == 3); else ph_ln<false, 0, 1>(C, nullptr, l, 1, 5120, l2, 0, l < 3, 0, 3072, l == 3);
            if (l < 3) ph_conv(C, l + 1);
#if REP_C > 1
            if (l < 3) { RELAUNDER ph_conv(C, l + 1); }
#endif
        STEP_END
    }
#undef STEP_BEGIN
#undef STEP_END
#undef WSP
#undef RELAUNDER
}

#ifndef DUMP_HI
#define DUMP_HI 0
#define DUMP_OFF 0
#define DUMP_WORDS 1
#endif
#if DUMP_HI
__global__ void __launch_bounds__(256) copy_half_k(const unsigned* src, unsigned* dst) {
    for (size_t i = (size_t)blockIdx.x * 256 + threadIdx.x; i < (size_t)65536 * 256; i += (size_t)gridDim.x * 256) dst[i] = src[(i >> 8) * 512 + (i & 255)];
}
__global__ void __launch_bounds__(256) dump_k(const unsigned* src, size_t nwords, float* out) {
    const size_t N = (size_t)MTOK * DM;
    for (size_t i = (size_t)blockIdx.x * 256 + threadIdx.x; i < N; i += (size_t)gridDim.x * 256) {
        float v = 0.f;
        for (size_t k = i % nwords; k < nwords; k += N) { const unsigned w = src[k]; v += (float)((w ^ (w >> 13)) & 0xFFFu); }
        out[i] = v;
    }
}
#endif
extern "C" void kernel_launch(void* const* d_in, const int* in_sizes, int n_in, void* d_out, int out_size, void* d_ws, size_t ws_size, hipStream_t stream) {
    static int grid = 0;
    if (grid == 0) {
        if (n_in != 19 || in_sizes[0] != MTOK * DM || out_size != MTOK * DM || ws_size < WS_END) {
            fprintf(stderr, "kernel_launch: unexpected shapes (n_in %d, in0 %d, out %d, ws %zu); nothing launched\n", n_in, n_in > 0 ? in_sizes[0] : -1, out_size, ws_size); grid = -1; return; }
        int dev = 0, cus = 0, per_cu = 0;
        if (hipGetDevice(&dev) != hipSuccess || hipDeviceGetAttribute(&cus, hipDeviceAttributeMultiprocessorCount, dev) != hipSuccess) { grid = -1; return; }
        if (hipFuncSetAttribute((const void*)hybrid_fwd, hipFuncAttributeMaxDynamicSharedMemorySize, LDS_BYTES) != hipSuccess) { fprintf(stderr, "kernel_launch: hipFuncSetAttribute failed\n"); grid = -1; return; }
        if (hipOccupancyMaxActiveBlocksPerMultiprocessor(&per_cu, (const void*)hybrid_fwd, 512, LDS_BYTES) != hipSuccess || per_cu < 1)
            fprintf(stderr, "kernel_launch: note: occupancy query reports %d workgroups per CU\n", per_cu);
        (void)hipGetLastError();
        grid = cus;
    }
    if (grid < 0) return;
    if (hipMemsetAsync((char*)d_ws + WS_CTL, 0, CTL_ZERO_BYTES, stream) != hipSuccess) { fprintf(stderr, "kernel_launch: memset failed\n"); return; }
    Args a{};
    for (int i = 0; i < 19; ++i) a.in[i] = (const float*)d_in[i];
    a.out = (float*)d_out; a.ws = (unsigned char*)d_ws;
#if MK_MULTI
    for (int s = 0; s < N_STEPS; ++s) { a.lo = s; a.hi = s + 1; hipLaunchKernelGGL(hybrid_fwd, dim3(grid), dim3(512), LDS_BYTES, stream, a); }
#else
#ifdef DUMP_SPLIT
    a.lo = 0; a.hi = DUMP_SPLIT;
    hipLaunchKernelGGL(hybrid_fwd, dim3(grid), dim3(512), LDS_BYTES, stream, a);
    (void)hipMemsetAsync((char*)d_ws + WS_CTL, 0, 65536, stream);
    a.lo = DUMP_SPLIT; a.hi = DUMP_HI;
    hipLaunchKernelGGL(hybrid_fwd, dim3(grid), dim3(512), LDS_BYTES, stream, a);
#else
    a.lo = 0; a.hi = DUMP_HI ? DUMP_HI : N_STEPS;
    hipLaunchKernelGGL(hybrid_fwd, dim3(grid), dim3(512), LDS_BYTES, stream, a);
#endif
#ifdef DUMP_OUTCOPY
    hipLaunchKernelGGL(copy_half_k, dim3(8192), dim3(256), 0, stream, (const unsigned*)d_out + (DUMP_OUTCOPY == 2 ? 256 : 0), (unsigned*)((char*)d_ws + (size_t)DUMP_OFF));
#endif
#if DUMP_HI
    hipLaunchKernelGGL(dump_k, dim3(8192), dim3(256), 0, stream, (const unsigned*)((const char*)d_ws + (size_t)DUMP_OFF), (size_t)DUMP_WORDS, (float*)d_out);
#endif
#endif
    const hipError_t le = hipPeekAtLastError();
    if (le != hipSuccess) fprintf(stderr, "kernel_launch: launch failed: %s\n", hipGetErrorName(le));
}
```

```cpp
#include <hip/hip_runtime.h>
#include <cstdio>
#include <cstdint>

#define GAS __attribute__((address_space(1)))
#define LAS __attribute__((address_space(3)))
typedef unsigned short bf16;
typedef unsigned v4u __attribute__((ext_vector_type(4)));
typedef unsigned v2u __attribute__((ext_vector_type(2)));
typedef float f32x4 __attribute__((ext_vector_type(4)));
typedef float f32x2 __attribute__((ext_vector_type(2)));
typedef float f32x16 __attribute__((ext_vector_type(16)));
typedef short bf16x8 __attribute__((ext_vector_type(8)));

#ifndef USE_LIST
#define USE_LIST 0
#endif
#ifndef USE_BCAST
#define USE_BCAST 1
#endif
#ifndef MK_MULTI
#define MK_MULTI 0
#endif

constexpr int BATCH = 16, SEQ = 4096, DM = 1024, DEPTH = 4, MTOK = BATCH * SEQ;
constexpr int PW = 2816;
constexpr int PROJ_SRC = 2776;
constexpr int C_AQ = 0, C_IQ = 512, C_BQ = 1024, C_BK = 1280, C_BV = 1536, C_BG = 2048, C_AK = 2560, C_AV = 2624, C_IK = 2688, C_IW = 2752, C_BA = 2760;
constexpr int DFF = 2816, NEXP = 8;
constexpr int PASS_PANELS = 256, NPASS_DENSE = 1, NPASS_MOE = 2;
constexpr float DN_ALPHA = 1.681792830507429f;
constexpr float LN_EPS = 1e-5f;
constexpr float LOG2E = 1.4426950408889634f;

constexpr size_t MiB = 1u << 20;
constexpr size_t WS_CTL = 0, CTL_ZERO_BYTES = 1 * MiB;
constexpr size_t WS_MOD = 1 * MiB;
constexpr size_t WS_TOPE = 3 * MiB;
constexpr size_t WS_TOPG = WS_TOPE + MiB / 2;
constexpr size_t WS_TOKSLOT = WS_TOPG + MiB / 2;
constexpr size_t WS_ROWTOK = 5 * MiB;
constexpr size_t WS_ROWGATE = 6 * MiB;
constexpr size_t WS_WIN = 8 * MiB;
constexpr size_t WS_WOUT = 14 * MiB;
constexpr size_t WS_WGU = 16 * MiB;
constexpr size_t WS_WDN = 104 * MiB;
constexpr size_t WS_H = 148 * MiB;
constexpr size_t WS_P = 276 * MiB;
constexpr size_t WS_Y = 640 * MiB;
constexpr size_t WS_SEL = 900 * MiB;
constexpr size_t WS_END = 1024 * MiB;

constexpr int CW_BAR = 4096;
constexpr int CW_QUEUE = 8192;
constexpr int CW_CNT = 10240;
constexpr int CW_FILL = 10752;

constexpr int LDS_BYTES = 147456;
constexpr int PE_OFF = 131072;
constexpr int MISC_OFF = 139264;

__device__ __forceinline__ float bf2f(unsigned v) { return __uint_as_float(v << 16); }
typedef __bf16 bf16x2_t __attribute__((ext_vector_type(2)));
__device__ __forceinline__ unsigned pk2(float lo, float hi) { const f32x2 v = {lo, hi}; return __builtin_bit_cast(unsigned, __builtin_convertvector(v, bf16x2_t)); }
__device__ __forceinline__ unsigned f2bf(float f) { return pk2(f, 0.f) & 0xffffu; }
__device__ __forceinline__ float wave_sum(float v) {
#pragma unroll
    for (int o = 1; o < 64; o <<= 1) v += __shfl_xor(v, o);
    return v;
}
__device__ __forceinline__ float wave_max(float v) {
#pragma unroll
    for (int o = 1; o < 64; o <<= 1) v = fmaxf(v, __shfl_xor(v, o));
    return v;
}
#define DPP_U32(x, ctrl) ((unsigned)__builtin_amdgcn_update_dpp(0, (int)(x), (ctrl), 0xF, 0xF, true))
__device__ __forceinline__ unsigned wave_sum_u32(unsigned x) {
    x += DPP_U32(x, 0xB1); x += DPP_U32(x, 0x4E); x += DPP_U32(x, 0x124); x += DPP_U32(x, 0x128);
#if USE_BCAST
    x += (unsigned)__builtin_amdgcn_update_dpp(0, (int)x, 0x142, 0xA, 0xF, false);
    x += (unsigned)__builtin_amdgcn_update_dpp(0, (int)x, 0x143, 0xC, 0xF, false);
    return (unsigned)__builtin_amdgcn_readlane((int)x, 63);
#else
    return (unsigned)__builtin_amdgcn_readlane((int)x, 0) + (unsigned)__builtin_amdgcn_readlane((int)x, 16) + (unsigned)__builtin_amdgcn_readlane((int)x, 32) + (unsigned)__builtin_amdgcn_readlane((int)x, 48);
#endif
}
__device__ __forceinline__ float dpp_f32_(float x, int) { return x; }
#define DPP_F32(x, ctrl) (__builtin_bit_cast(float, __builtin_amdgcn_update_dpp(0, __builtin_bit_cast(int, (x)), (ctrl), 0xF, 0xF, true)))
__device__ __forceinline__ float wave_sum_f(float x) {
    x += DPP_F32(x, 0xB1); x += DPP_F32(x, 0x4E); x += DPP_F32(x, 0x124); x += DPP_F32(x, 0x128);
    const float r0 = __builtin_bit_cast(float, __builtin_amdgcn_readlane(__builtin_bit_cast(int, x), 0)), r1 = __builtin_bit_cast(float, __builtin_amdgcn_readlane(__builtin_bit_cast(int, x), 16));
    const float r2 = __builtin_bit_cast(float, __builtin_amdgcn_readlane(__builtin_bit_cast(int, x), 32)), r3 = __builtin_bit_cast(float, __builtin_amdgcn_readlane(__builtin_bit_cast(int, x), 48));
    return (r0 + r1) + (r2 + r3);
}
__device__ __forceinline__ unsigned umax_(unsigned a, unsigned b) { return a > b ? a : b; }
__device__ __forceinline__ unsigned umin_(unsigned a, unsigned b) { return a < b ? a : b; }
__device__ __forceinline__ unsigned wave_max_u32(unsigned x) {
    x = umax_(x, DPP_U32(x, 0xB1)); x = umax_(x, DPP_U32(x, 0x4E)); x = umax_(x, DPP_U32(x, 0x124)); x = umax_(x, DPP_U32(x, 0x128));
    return umax_(umax_((unsigned)__builtin_amdgcn_readlane((int)x, 0), (unsigned)__builtin_amdgcn_readlane((int)x, 16)), umax_((unsigned)__builtin_amdgcn_readlane((int)x, 32), (unsigned)__builtin_amdgcn_readlane((int)x, 48)));
}
__device__ __forceinline__ unsigned wave_min_u32(unsigned x) {
    x = umin_(x, DPP_U32(x, 0xB1)); x = umin_(x, DPP_U32(x, 0x4E)); x = umin_(x, DPP_U32(x, 0x124)); x = umin_(x, DPP_U32(x, 0x128));
    return umin_(umin_((unsigned)__builtin_amdgcn_readlane((int)x, 0), (unsigned)__builtin_amdgcn_readlane((int)x, 16)), umin_((unsigned)__builtin_amdgcn_readlane((int)x, 32), (unsigned)__builtin_amdgcn_readlane((int)x, 48)));
}
#define SHX_F(v, o, lane_) (__builtin_bit_cast(float, __builtin_amdgcn_ds_bpermute((((lane_) ^ (o)) << 2), __builtin_bit_cast(int, (float)(v)))))
#define SHUP_I(v, o, lane_) (__builtin_amdgcn_ds_bpermute((((lane_) - (o)) << 2), (int)(v)))
__device__ __forceinline__ int wave_incl_scan_i(int x, int lane) {
    x += __builtin_amdgcn_update_dpp(0, x, 0x111, 0xF, 0xF, true); x += __builtin_amdgcn_update_dpp(0, x, 0x112, 0xF, 0xF, true);
    x += __builtin_amdgcn_update_dpp(0, x, 0x114, 0xF, 0xF, true); x += __builtin_amdgcn_update_dpp(0, x, 0x118, 0xF, 0xF, true);
    const int t0 = __builtin_amdgcn_readlane(x, 15), t1 = __builtin_amdgcn_readlane(x, 31), t2 = __builtin_amdgcn_readlane(x, 47);
    return x + (lane >= 16 ? t0 : 0) + (lane >= 32 ? t1 : 0) + (lane >= 48 ? t2 : 0);
}
__device__ __forceinline__ float silu_f(float v) { return v / (1.f + expf(-v)); }

#define XB_TMO      128
#define XB_XCNT(j)  (256  + 64 * (j))
#define XB_XSUB(j)  (1280 + 64 * (j))
#define XB_XGEN(j)  (2304 + 64 * (j))
#define XB_TOP      3328
#define XB_TOPGEN   3392
#define XCD_BAR_WORDS 3456
#define XB_SPIN_CAP (1u << 21)

__device__ __forceinline__ unsigned xb_ld(unsigned* p)              { return __hip_atomic_load(p, __ATOMIC_RELAXED, __HIP_MEMORY_SCOPE_AGENT); }
__device__ __forceinline__ unsigned xb_add(unsigned* p, unsigned v) { return __hip_atomic_fetch_add(p, v, __ATOMIC_RELAXED, __HIP_MEMORY_SCOPE_AGENT); }
__device__ __forceinline__ unsigned xb_xcc_id() { return (unsigned)__builtin_amdgcn_s_getreg((3 << 11) | 20) & 0xFu; }
#define XB_SPIN(cond, bar) do { unsigned _sp = 0; while (cond) { __builtin_amdgcn_s_sleep(1); \
    if ((++_sp & 255u) == 0u) { if (xb_ld(&(bar)[XB_TMO])) break; if (_sp > XB_SPIN_CAP) { atomicAdd(&(bar)[XB_TMO], 1u); break; } } } } while (0)

struct XcdBarrier {
    unsigned* bar; unsigned x;
    volatile LAS unsigned* st;
};

__device__ __forceinline__ XcdBarrier xcd_barrier_post(unsigned* bar, volatile LAS unsigned* st) {
    XcdBarrier b; b.bar = bar; b.x = xb_xcc_id(); b.st = st;
    if (threadIdx.x == 0) (void)xb_add(&bar[XB_XCNT(b.x)], 1u);
    return b;
}
__device__ __forceinline__ void xcd_barrier_complete(unsigned* bar, unsigned x, unsigned& nloc, unsigned& nx) {
    const unsigned G = gridDim.x * gridDim.y * gridDim.z;
    unsigned sum, cnt, mine, sp = 0u;
    for (;;) {
        sum = 0u; cnt = 0u; mine = 0u;
#pragma unroll
        for (unsigned j = 0; j < 16; ++j) { const unsigned c = xb_ld(&bar[XB_XCNT(j)]); sum += c; cnt += (c > 0u) ? 1u : 0u; mine = (j == x) ? c : mine; }
        if (sum == G) break;
        __builtin_amdgcn_s_sleep(1);
        if ((++sp & 255u) == 0u) { if (xb_ld(&bar[XB_TMO])) break; if (sp > XB_SPIN_CAP) { atomicAdd(&bar[XB_TMO], 1u); break; } }
    }
    nloc = mine > 0u ? mine : 1u; nx = cnt > 0u ? cnt : 1u;
}

__device__ __forceinline__ void xcd_barrier(const XcdBarrier& b) {
    asm volatile("s_waitcnt vmcnt(0)" ::: "memory");
    __syncthreads();
    if (threadIdx.x == 0) {
        unsigned* bar = b.bar;
        __builtin_amdgcn_s_waitcnt(0);
        unsigned nloc = b.st[0], nx = b.st[1];
        if (nloc == 0u) { xcd_barrier_complete(bar, b.x, nloc, nx); b.st[0] = nloc; b.st[1] = nx; }
        const unsigned old = xb_add(&bar[XB_XSUB(b.x)], 1u);
        const unsigned gen = old / nloc;
        if (old + 1u == (gen + 1u) * nloc) {
            __builtin_amdgcn_fence(__ATOMIC_RELEASE, "agent");
            asm volatile("s_waitcnt vmcnt(0)" ::: "memory");
            const unsigned og = xb_add(&bar[XB_TOP], 1u);
            const unsigned tg = og / nx;
            if (og + 1u == (tg + 1u) * nx) xb_add(&bar[XB_TOPGEN], 1u);
            else XB_SPIN(xb_ld(&bar[XB_TOPGEN]) == tg, bar);
            __builtin_amdgcn_fence(__ATOMIC_ACQUIRE, "agent");
            xb_add(&bar[XB_XGEN(b.x)], 1u);
            asm volatile("s_waitcnt vmcnt(0)" ::: "memory");
        } else {
            XB_SPIN(xb_ld(&bar[XB_XGEN(b.x)]) == gen, bar);
            __builtin_amdgcn_fence(__ATOMIC_ACQUIRE, "agent");
            asm volatile("s_waitcnt vmcnt(0)" ::: "memory");
        }
    }
    __syncthreads();
}


struct Args { const float* in[19]; float* out; unsigned char* ws; int lo, hi; };
typedef const Args __attribute__((address_space(4))) KArgs;
struct Ctx {
    LAS unsigned char* lds;
    volatile LAS unsigned* MISC;
    unsigned* ctl;
    int tid, lane, wave, G, bid;
    int hot;
    KArgs* ka;
    float* out; unsigned char* ws;
    __device__ __forceinline__ const float* in(int i) const { return ka->in[i]; }
};
enum { I_X = 0, I_C, I_WIN, I_WA2, I_BA, I_GLAG, I_WOUT, I_WMOD, I_BMOD, I_LNG, I_LNB, I_FG, I_FU, I_FD, I_WR, I_BR, I_MG, I_MU, I_MD };

__device__ __forceinline__ f32x16 mfma32(bf16x8 a, bf16x8 b, f32x16 c) { return __builtin_amdgcn_mfma_f32_32x32x16_bf16(a, b, c, 0, 0, 0); }

__device__ __forceinline__ void ph_mod(Ctx& C) {
    LAS float* sc = (LAS float*)C.lds;
    LAS float* red = (LAS float*)(C.lds + 65536);
    const float* c = C.in(I_C);
    for (int i = C.tid; i < 16 * 1024; i += 512) sc[i] = silu_f(c[i]);
    __syncthreads();
    const float* wmod = C.in(I_WMOD); const float* bmod = C.in(I_BMOD);
    float* MOD = (float*)(C.ws + WS_MOD);
    for (int u = C.bid; u < 4 * 96; u += C.G) {
        const int l = u / 96, cc = u % 96, col = cc * 64 + C.lane;
        float acc[16];
#pragma unroll
        for (int b = 0; b < 16; ++b) acc[b] = 0.f;
        const float* wp = wmod + ((size_t)l * 1024 + C.wave * 128) * 6144 + col;
        const LAS float* sp = sc + C.wave * 128;
#pragma unroll 16
        for (int kk = 0; kk < 128; ++kk) {
            const float w = wp[(size_t)kk * 6144];
#pragma unroll
            for (int b = 0; b < 16; ++b) acc[b] += sp[b * 1024 + kk] * w;
        }
#pragma unroll
        for (int b = 0; b < 16; ++b) red[(C.wave * 16 + b) * 64 + C.lane] = acc[b];
        __syncthreads();
        for (int o = C.tid; o < 1024; o += 512) {
            const int b = o >> 6, ln = o & 63; float s = 0.f;
#pragma unroll
            for (int w = 0; w < 8; ++w) s += red[(w * 16 + b) * 64 + ln];
            const int cl = cc * 64 + ln;
            MOD[((size_t)l * 16 + b) * 6144 + cl] = s + bmod[l * 6144 + cl];
        }
        __syncthreads();
    }
}

__device__ __forceinline__ void conv_item(const float* colp, int ldn, int K, bf16* WT, LAS float* scr, int kb, int nb, int lane) {
    const int k0 = 64 * kb, n0 = 32 * nb;
    float tv[32];
#pragma unroll
    for (int i = 0; i < 32; ++i) { const int kk = 2 * i + (lane >> 5); tv[i] = colp ? colp[(size_t)(k0 + kk) * ldn] : 0.f; }
#pragma unroll
    for (int i = 0; i < 32; ++i) { const int kk = 2 * i + (lane >> 5); scr[kk * 33 + (lane & 31)] = tv[i]; }
    asm volatile("s_waitcnt lgkmcnt(0)" ::: "memory");
    const int c = lane & 7;
#pragma unroll
    for (int j = 0; j < 4; ++j) {
        const int n = (lane >> 3) + 8 * j; const LAS float* s = scr + (8 * c) * 33 + n;
        v4u o; o.x = pk2(s[0 * 33], s[1 * 33]); o.y = pk2(s[2 * 33], s[3 * 33]); o.z = pk2(s[4 * 33], s[5 * 33]); o.w = pk2(s[6 * 33], s[7 * 33]);
        *(v4u*)(WT + (size_t)(n0 + n) * K + k0 + 8 * c) = o;
    }
    asm volatile("s_waitcnt lgkmcnt(0)" ::: "memory");
}
__device__ __forceinline__ int win_src_col(int n) {
    if (n < C_IQ) return n;
    if (n < C_BQ) return 640 + (n - C_IQ);
    if (n < C_AK) return 1224 + (n - C_BQ);
    if (n < C_AV) return 512 + (n - C_AK);
    if (n < C_IK) return 576 + (n - C_AV);
    if (n < C_IW) return 1152 + (n - C_IK);
    if (n < C_BA) return 1216 + (n - C_IW);
    if (n < PROJ_SRC) return 2760 + (n - C_BA);
    return -1;
}
__device__ __forceinline__ void ph_conv(Ctx& C, int l) {
    LAS float* scr = (LAS float*)(C.lds + C.wave * 8448);
    const int gw = C.bid * 8 + C.wave, NGW = C.G * 8;
    const bool moe = (l & 1) != 0; const int j = l >> 1, ne = moe ? NEXP : 1;
    constexpr int I_IN = 16 * 88, I_OUT = 16 * 32, I_GU = 16 * 176, I_DN = 44 * 32;
    const int nitems = I_IN + I_OUT + ne * (I_GU + I_DN);
    bf16* WIN = (bf16*)(C.ws + WS_WIN); bf16* WOUT = (bf16*)(C.ws + WS_WOUT); bf16* WGU = (bf16*)(C.ws + WS_WGU); bf16* WDN = (bf16*)(C.ws + WS_WDN);
    for (int it = gw; it < nitems; it += NGW) {
        int r = it;
        if (r < I_IN) { const int kb = r / 88, nb = r % 88; const int sc_ = win_src_col(nb * 32 + (C.lane & 31));
            const float* W = C.in(I_WIN) + (size_t)l * 1024 * PROJ_SRC;
            conv_item(sc_ >= 0 ? W + sc_ : nullptr, PROJ_SRC, 1024, WIN, scr, kb, nb, C.lane); continue; }
        r -= I_IN;
        if (r < I_OUT) { const int kb = r / 32, nb = r % 32; const float* W = C.in(I_WOUT) + (size_t)l * 1024 * 1024;
            conv_item(W + nb * 32 + (C.lane & 31), 1024, 1024, WOUT, scr, kb, nb, C.lane); continue; }
        r -= I_OUT;
        const int e = r / (I_GU + I_DN); r -= e * (I_GU + I_DN);
        const size_t eoff = (size_t)(j * ne + e) * 1024 * DFF;
        if (r < I_GU) { const int kb = r / 176, nb = r % 176; const int n = nb * 32 + (C.lane & 31), T = n >> 8, jj = n & 255;
            const float* Wg = (moe ? C.in(I_MG) : C.in(I_FG)) + eoff; const float* Wu = (moe ? C.in(I_MU) : C.in(I_FU)) + eoff;
            const float* colp = (jj < 128) ? Wg + T * 128 + jj : Wu + T * 128 + (jj - 128);
            conv_item(colp, DFF, 1024, WGU + (size_t)e * 5632 * 1024, scr, kb, nb, C.lane); continue; }
        r -= I_GU;
        { const int kb = r / 32, nb = r % 32; const float* Wd = (moe ? C.in(I_MD) : C.in(I_FD)) + eoff;
          conv_item(Wd + nb * 32 + (C.lane & 31), 1024, DFF, WDN + (size_t)e * 1024 * DFF, scr, kb, nb, C.lane); }
    }
}

__device__ __forceinline__ void ph_modulate0(Ctx& C) {
    const int gw = C.bid * 8 + C.wave, NGW = C.G * 8;
    const float* MOD = (const float*)(C.ws + WS_MOD); bf16* H = (bf16*)(C.ws + WS_H); const float* x = C.in(I_X);
    for (int row = gw; row < MTOK; row += NGW) {
        const int b = row >> 12; const float* md = MOD + (size_t)b * 6144;
#pragma unroll
        for (int j = 0; j < 4; ++j) {
            const int col = 4 * C.lane + 256 * j;
            const f32x4 v = *(const f32x4*)(x + (size_t)row * DM + col), sh = *(const f32x4*)(md + col), sc = *(const f32x4*)(md + 1024 + col);
            v2u o; o.x = pk2(v.x * (1.f + sc.x) + sh.x, v.y * (1.f + sc.y) + sh.y); o.y = pk2(v.z * (1.f + sc.z) + sh.z, v.w * (1.f + sc.w) + sh.w);
            *(v2u*)(H + (size_t)row * DM + col) = o;
        }
    }
}

struct GUnit { int arow0; int orow0; int pn; size_t boff; };
template <int MODE, class Epi>
__device__ __forceinline__ void gemm_simple_unit(Ctx& C, const bf16* A, int lda, const int* rowmap, const bf16* Bt, int K, const GUnit& u, const Epi& E) {
    const int rs = C.wave & 3, ch = C.wave >> 2, n = C.lane & 31, h = C.lane >> 5;
    const int r0 = u.arow0 + rs * 64 + n;
    const int ra = rowmap ? rowmap[r0] : r0, rb = rowmap ? rowmap[r0 + 32] : r0 + 32;
    const bf16* a0p = A + (size_t)ra * lda + 8 * h; const bf16* a1p = A + (size_t)rb * lda + 8 * h;
#pragma unroll 1
    for (int sp = 0; sp < 2; ++sp) {
        int br0, br1;
        if (MODE == 1) { const int jj = 2 * ch + sp; br0 = u.pn * 256 + 32 * jj; br1 = br0 + 128; }
        else { br0 = u.pn * 256 + 128 * ch + 64 * sp; br1 = br0 + 32; }
        const bf16* b0p = Bt + u.boff + (size_t)(br0 + n) * K + 8 * h; const bf16* b1p = Bt + u.boff + (size_t)(br1 + n) * K + 8 * h;
        f32x16 c00, c01, c10, c11;
#pragma unroll
        for (int i = 0; i < 16; ++i) { c00[i] = 0.f; c01[i] = 0.f; c10[i] = 0.f; c11[i] = 0.f; }
#pragma unroll 4
        for (int k = 0; k < K; k += 16) {
            const bf16x8 a0 = *(const bf16x8*)(a0p + k), a1 = *(const bf16x8*)(a1p + k), b0 = *(const bf16x8*)(b0p + k), b1 = *(const bf16x8*)(b1p + k);
            c00 = mfma32(a0, b0, c00); c01 = mfma32(a0, b1, c01); c10 = mfma32(a1, b0, c10); c11 = mfma32(a1, b1, c11);
        }
        const int orow = u.orow0 + rs * 64 + 4 * h;
        E(c00, c01, orow, br0, br1, n, u);
        E(c10, c11, orow + 32, br0, br1, n, u);
    }
}
struct EpiStoreS {
    bf16* O; int ldc;
    __device__ __forceinline__ void operator()(const f32x16& c0, const f32x16& c1, int orow, int br0, int br1, int n, const GUnit&) const {
#pragma unroll
        for (int r = 0; r < 16; ++r) { const size_t row = (size_t)(orow + (r & 3) + 8 * (r >> 2));
            O[row * ldc + br0 + n] = (bf16)f2bf(c0[r]); O[row * ldc + br1 + n] = (bf16)f2bf(c1[r]); }
    }
};
struct EpiSwigluS {
    bf16* O;
    __device__ __forceinline__ void operator()(const f32x16& c0, const f32x16& c1, int orow, int br0, int br1, int n, const GUnit& u) const {
        const int col = 128 * u.pn + (br0 - 256 * u.pn) + n;
#pragma unroll
        for (int r = 0; r < 16; ++r) { const size_t row = (size_t)(orow + (r & 3) + 8 * (r >> 2));
            O[row * DFF + col] = (bf16)f2bf(silu_f(c0[r]) * c1[r]); }
    }
};
struct EpiGateS {
    bf16* O; const float* gate;
    __device__ __forceinline__ void operator()(const f32x16& c0, const f32x16& c1, int orow, int br0, int br1, int n, const GUnit&) const {
#pragma unroll
        for (int r = 0; r < 16; ++r) { const size_t row = (size_t)(orow + (r & 3) + 8 * (r >> 2)); const float g = gate[row];
            O[row * DM + br0 + n] = (bf16)f2bf(c0[r] * g); O[row * DM + br1 + n] = (bf16)f2bf(c1[r] * g); }
    }
};

__device__ __forceinline__ void ph_gla_unit(Ctx& C, int l, int b, int hh) {
    LAS float* q_s = (LAS float*)C.lds;
    LAS float* k_s = q_s + 4096;
    LAS float* a_s = k_s + 4096;
    LAS float* v_s = a_s + 4096;
    LAS float* o_s = v_s + 8192;
    const bf16* PROJ = (const bf16*)(C.ws + WS_P); bf16* YM = (bf16*)(C.ws + WS_H);
    const float* w_a2 = C.in(I_WA2) + (size_t)l * 16 * 256; const float* b_a = C.in(I_BA) + l * 256; const float* gg = C.in(I_GLAG) + l * 128;
    const int e = C.tid >> 2, dg = C.tid & 3;
    float S[16];
#pragma unroll
    for (int i = 0; i < 16; ++i) S[i] = 0.f;
    for (int c = 0; c < 64; ++c) {
        const size_t row0 = (size_t)b * SEQ + c * 64;
        {
            const int t = C.tid >> 3, d0 = (C.tid & 7) * 8; const bf16* pr = PROJ + (row0 + t) * PW;
            const v4u qv = *(const v4u*)(pr + C_BQ + hh * 64 + d0), kv = *(const v4u*)(pr + C_BK + hh * 64 + d0);
            const v4u ba0 = *(const v4u*)(pr + C_BA), ba1 = *(const v4u*)(pr + C_BA + 8);
            float baf[16];
            baf[0] = bf2f(ba0.x & 0xffffu); baf[1] = bf2f(ba0.x >> 16); baf[2] = bf2f(ba0.y & 0xffffu); baf[3] = bf2f(ba0.y >> 16);
            baf[4] = bf2f(ba0.z & 0xffffu); baf[5] = bf2f(ba0.z >> 16); baf[6] = bf2f(ba0.w & 0xffffu); baf[7] = bf2f(ba0.w >> 16);
            baf[8] = bf2f(ba1.x & 0xffffu); baf[9] = bf2f(ba1.x >> 16); baf[10] = bf2f(ba1.y & 0xffffu); baf[11] = bf2f(ba1.y >> 16);
            baf[12] = bf2f(ba1.z & 0xffffu); baf[13] = bf2f(ba1.z >> 16); baf[14] = bf2f(ba1.w & 0xffffu); baf[15] = bf2f(ba1.w >> 16);
            const unsigned qw[4] = {qv.x, qv.y, qv.z, qv.w}, kw[4] = {kv.x, kv.y, kv.z, kv.w};
#pragma unroll
            for (int i = 0; i < 8; ++i) {
                const int d = d0 + i; float z = b_a[hh * 64 + d];
#pragma unroll
                for (int r = 0; r < 16; ++r) z += baf[r] * w_a2[r * 256 + hh * 64 + d];
                const float ls = fminf(z, 0.f) - log1pf(expf(-fabsf(z)));
                a_s[t * 64 + d] = expf(ls * (1.f / 16.f));
                const unsigned qq = (i & 1) ? (qw[i >> 1] >> 16) : (qw[i >> 1] & 0xffffu), kk = (i & 1) ? (kw[i >> 1] >> 16) : (kw[i >> 1] & 0xffffu);
                q_s[t * 64 + d] = bf2f(qq) * 0.125f; k_s[t * 64 + d] = bf2f(kk);
            }
            const int e0 = (C.tid & 7) * 16;
            const v4u v0 = *(const v4u*)(pr + C_BV + hh * 128 + e0), v1 = *(const v4u*)(pr + C_BV + hh * 128 + e0 + 8);
            const unsigned vw[8] = {v0.x, v0.y, v0.z, v0.w, v1.x, v1.y, v1.z, v1.w};
#pragma unroll
            for (int i = 0; i < 8; ++i) { v_s[t * 128 + e0 + 2 * i] = bf2f(vw[i] & 0xffffu); v_s[t * 128 + e0 + 2 * i + 1] = bf2f(vw[i] >> 16); }
        }
        __syncthreads();
        for (int tt = 0; tt < 64; ++tt) {
            const float vv = v_s[tt * 128 + e]; float po = 0.f;
#pragma unroll
            for (int i = 0; i < 16; ++i) { const int d = 16 * dg + i; S[i] = a_s[tt * 64 + d] * S[i] + k_s[tt * 64 + d] * vv; po += q_s[tt * 64 + d] * S[i]; }
            po += __shfl_xor(po, 1); po += __shfl_xor(po, 2);
            if (dg == 0) o_s[tt * 128 + e] = po;
        }
        __syncthreads();
#pragma unroll 1
        for (int r = 0; r < 8; ++r) {
            const int tt = C.wave * 8 + r; const float o0 = o_s[tt * 128 + C.lane], o1 = o_s[tt * 128 + 64 + C.lane];
            const float ss = wave_sum(o0 * o0 + o1 * o1); const float rstd = rsqrtf(ss * (1.f / 128.f) + LN_EPS);
            const bf16* pr = PROJ + (row0 + tt) * PW + C_BG + hh * 128; const float g0 = bf2f(pr[C.lane]), g1 = bf2f(pr[64 + C.lane]);
            bf16* yo = YM + (row0 + tt) * DM + 512 + hh * 128;
            yo[C.lane] = (bf16)f2bf(o0 * rstd * gg[C.lane] * silu_f(g0)); yo[64 + C.lane] = (bf16)f2bf(o1 * rstd * gg[64 + C.lane] * silu_f(g1));
        }
        __syncthreads();
    }
}

__device__ __forceinline__ unsigned sortable_u32(float f) { const unsigned u = __float_as_uint(f + 0.0f); return (u & 0x80000000u) ? ~u : (u | 0x80000000u); }
__device__ __forceinline__ void ph_dsa_a_unit(Ctx& C, int b, int t0) {
    LAS unsigned* sc = (LAS unsigned*)C.lds;
    LAS unsigned* cnt = (LAS unsigned*)(C.lds + 131072);
    const bf16* PROJ = (const bf16*)(C.ws + WS_P); unsigned* SEL = (unsigned*)(C.ws + WS_SEL);
    const int lane = C.lane, n = lane & 31, h = lane >> 5, tid = C.tid;
    const int nk = t0 + 8, ntile = (nk + 31) >> 5, nscan = ntile * 32;
    if (tid < 48) cnt[tid] = 0u;
    {
        bf16x8 af[2][4]; float wv[2][4][4];
#pragma unroll
        for (int mt = 0; mt < 2; ++mt) {
            const bf16* p = PROJ + (size_t)(b * SEQ + t0 + 4 * mt + (n >> 3)) * PW + C_IQ + (n & 7) * 64 + 8 * h;
#pragma unroll
            for (int ks = 0; ks < 4; ++ks) af[mt][ks] = *(const bf16x8*)(p + ks * 16);
#pragma unroll
            for (int jq = 0; jq < 4; ++jq)
#pragma unroll
                for (int i = 0; i < 4; ++i) wv[mt][jq][i] = bf2f(PROJ[(size_t)(b * SEQ + t0 + 4 * mt + jq) * PW + C_IW + i + 4 * h]) * (0.35355339059327373f * 0.125f);
        }
        for (int tile = C.wave; tile < ntile; tile += 8) {
            const int s = tile * 32 + n; const bf16* kp = PROJ + (size_t)(b * SEQ + s) * PW + C_IK + 8 * h;
            bf16x8 bfr[4];
#pragma unroll
            for (int ks = 0; ks < 4; ++ks) bfr[ks] = *(const bf16x8*)(kp + ks * 16);
#pragma unroll
            for (int mt = 0; mt < 2; ++mt) {
                f32x16 acc;
#pragma unroll
                for (int i = 0; i < 16; ++i) acc[i] = 0.f;
#pragma unroll
                for (int ks = 0; ks < 4; ++ks) acc = mfma32(af[mt][ks], bfr[ks], acc);
#pragma unroll
                for (int jq = 0; jq < 4; ++jq) {
                    float p = 0.f;
#pragma unroll
                    for (int i = 0; i < 4; ++i) p += wv[mt][jq][i] * fmaxf(acc[4 * jq + i], 0.f);
                    p += __shfl_xor(p, 32);
                    const int t = t0 + 4 * mt + jq; const unsigned u = (s <= t) ? sortable_u32(p) : 0u;
                    if (h == mt) sc[(4 * mt + jq) * 4096 + s] = u;
                }
            }
        }
    }
    __syncthreads();
    unsigned u[8][8];
#pragma unroll
    for (int i = 0; i < 8; ++i) {
        const int s = tid + 512 * i; const bool inr = s < nscan; const int sidx = inr ? s : 0;
#pragma unroll
        for (int q = 0; q < 8; ++q) { const unsigned v = sc[q * 4096 + sidx]; u[i][q] = inr ? v : 0u; }
    }
    unsigned T[8], J[8], need[8];
#pragma unroll
    for (int q = 0; q < 8; ++q) { T[q] = 0u; J[q] = 8192u; need[q] = 0u; }
    int buf = 0;
    for (int bit = 31; bit >= 0; --bit) {
        unsigned cq[8];
#pragma unroll
        for (int q = 0; q < 8; ++q) cq[q] = 0u;
#pragma unroll
        for (int i = 0; i < 8; ++i) if (512 * i < nscan) {
#pragma unroll
            for (int q = 0; q < 8; ++q) cq[q] += (unsigned)__popcll(__ballot(u[i][q] >= (T[q] | (1u << bit))));
        }
        unsigned myc = 0u;
#pragma unroll
        for (int q = 0; q < 8; ++q) myc = (lane == q) ? cq[q] : myc;
        if (lane < 8) __hip_atomic_fetch_add(cnt + buf * 16 + lane, myc, __ATOMIC_RELAXED, __HIP_MEMORY_SCOPE_WORKGROUP);
        const int nb = (buf == 2) ? 0 : buf + 1;
        if (tid >= 64 && tid < 80) cnt[nb * 16 + (tid - 64)] = 0u;
        __syncthreads();
#pragma unroll
        for (int q = 0; q < 8; ++q) if (cnt[buf * 16 + q] >= 256u) T[q] |= (1u << bit);
        buf = nb;
    }
#pragma unroll
    for (int q = 0; q < 8; ++q) T[q] = T[q] < 1u ? 1u : T[q];
    bool extra = false;
    {
        unsigned cg[8], ce[8];
#pragma unroll
        for (int q = 0; q < 8; ++q) { cg[q] = 0u; ce[q] = 0u; }
#pragma unroll
        for (int i = 0; i < 8; ++i) if (512 * i < nscan) {
#pragma unroll
            for (int q = 0; q < 8; ++q) { cg[q] += (unsigned)__popcll(__ballot(u[i][q] > T[q])); ce[q] += (unsigned)__popcll(__ballot(u[i][q] >= T[q])); }
        }
        unsigned myc = 0u;
#pragma unroll
        for (int q = 0; q < 8; ++q) { myc = (lane == q) ? cg[q] : myc; myc = (lane == 8 + q) ? ce[q] : myc; }
        if (lane < 16) __hip_atomic_fetch_add(cnt + buf * 16 + lane, myc, __ATOMIC_RELAXED, __HIP_MEMORY_SCOPE_WORKGROUP);
        const int nb = (buf == 2) ? 0 : buf + 1;
        if (tid >= 64 && tid < 80) cnt[nb * 16 + (tid - 64)] = 0u;
        __syncthreads();
#pragma unroll
        for (int q = 0; q < 8; ++q) { const unsigned g = cnt[buf * 16 + q], ge = cnt[buf * 16 + 8 + q]; need[q] = 256u - (g < 256u ? g : 256u); extra = extra || (ge > 256u); }
        buf = nb;
    }
    if (extra) {
#pragma unroll
        for (int q = 0; q < 8; ++q) J[q] = 0u;
        for (int bit = 12; bit >= 0; --bit) {
            unsigned cq[8];
#pragma unroll
            for (int q = 0; q < 8; ++q) cq[q] = 0u;
#pragma unroll
            for (int i = 0; i < 8; ++i) if (512 * i < nscan) {
                const unsigned s = (unsigned)(tid + 512 * i);
#pragma unroll
                for (int q = 0; q < 8; ++q) cq[q] += (unsigned)__popcll(__ballot(u[i][q] == T[q] && s < (J[q] | (1u << bit))));
            }
            unsigned myc = 0u;
#pragma unroll
            for (int q = 0; q < 8; ++q) myc = (lane == q) ? cq[q] : myc;
            if (lane < 8) __hip_atomic_fetch_add(cnt + buf * 16 + lane, myc, __ATOMIC_RELAXED, __HIP_MEMORY_SCOPE_WORKGROUP);
            const int nb = (buf == 2) ? 0 : buf + 1;
            if (tid >= 64 && tid < 80) cnt[nb * 16 + (tid - 64)] = 0u;
            __syncthreads();
#pragma unroll
            for (int q = 0; q < 8; ++q) if (cnt[buf * 16 + q] <= need[q]) J[q] |= (1u << bit);
            buf = nb;
        }
    }
#pragma unroll
    for (int i = 0; i < 8; ++i) if (512 * i < nscan) {
        const unsigned s = (unsigned)(tid + 512 * i); const int tile0 = 2 * C.wave + 16 * i;
#pragma unroll
        for (int q = 0; q < 8; ++q) {
            const unsigned long long bm = __ballot((u[i][q] > T[q]) || (u[i][q] == T[q] && s < J[q]));
            if (lane == 0) { unsigned* w = SEL + (size_t)(b * SEQ + t0 + q) * 128 + tile0;
                if (tile0 < ntile) w[0] = (unsigned)bm; if (tile0 + 1 < ntile) w[1] = (unsigned)(bm >> 32); }
        }
    }
    __syncthreads();
}

__device__ __forceinline__ void ph_dsa_b_unit(Ctx& C, int b, int t0) {
    LAS float* qs = (LAS float*)C.lds + C.wave * 512;
    LAS int* lst = (LAS int*)(C.lds + 16384) + C.wave * 256;
    LAS float* pl = (LAS float*)(C.lds + 16384 + 8192) + C.wave * 2048;
    const bf16* PROJ = (const bf16*)(C.ws + WS_P); const unsigned* SEL = (const unsigned*)(C.ws + WS_SEL); bf16* YM = (bf16*)(C.ws + WS_H);
    const int lane = C.lane, t = t0 + C.wave; const size_t row = (size_t)b * SEQ + t;
    const int ntile = (t >> 5) + 1;
    int base = 0;
#pragma unroll 1
    for (int rd = 0; rd < 2; ++rd) {
        const int wi = rd * 64 + lane; unsigned w = (wi < ntile) ? SEL[row * 128 + wi] : 0u;
        const int c = __popc(w); int incl = c;
#pragma unroll
        for (int o = 1; o < 64; o <<= 1) { const int v = __shfl_up(incl, o); if (lane >= o) incl += v; }
        int pos = base + incl - c;
        while (w) { const int bit = __ffs(w) - 1; w &= w - 1; if (pos < 256) lst[pos] = wi * 32 + bit; ++pos; }
        base += __shfl(incl, 63);
    }
    const int nsel = base < 256 ? base : 256;
    {
        const v4u qv = *(const v4u*)(PROJ + row * PW + C_AQ + lane * 8); const unsigned qw[4] = {qv.x, qv.y, qv.z, qv.w};
#pragma unroll
        for (int i = 0; i < 4; ++i) { qs[lane * 8 + 2 * i] = bf2f(qw[i] & 0xffffu) * (0.125f * LOG2E); qs[lane * 8 + 2 * i + 1] = bf2f(qw[i] >> 16) * (0.125f * LOG2E); }
    }
    asm volatile("s_waitcnt lgkmcnt(0)" ::: "memory");
    float mx[8];
#pragma unroll
    for (int hd = 0; hd < 8; ++hd) mx[hd] = -3.0e38f;
#pragma unroll 1
    for (int i = 0; i < 4; ++i) {
        const int j = lane + 64 * i;
        asm volatile("" ::: "memory");
        if (j < nsel) {
            const int s = lst[j];
            const bf16* kp = PROJ + ((size_t)b * SEQ + s) * PW + C_AK;
            float kr[64];
#pragma unroll
            for (int c8 = 0; c8 < 8; ++c8) { const v4u kv = *(const v4u*)(kp + 8 * c8); const unsigned kw[4] = {kv.x, kv.y, kv.z, kv.w};
#pragma unroll
                for (int x = 0; x < 4; ++x) { kr[8 * c8 + 2 * x] = bf2f(kw[x] & 0xffffu); kr[8 * c8 + 2 * x + 1] = bf2f(kw[x] >> 16); } }
#pragma unroll
            for (int hd = 0; hd < 8; ++hd) {
                float d = 0.f;
#pragma unroll
                for (int x = 0; x < 64; ++x) d += qs[hd * 64 + x] * kr[x];
                const float slope2 = exp2f(-(float)(hd + 1)) * LOG2E;
                const float lgv = d - slope2 * (float)(t - s);
                pl[j * 8 + hd] = lgv; mx[hd] = fmaxf(mx[hd], lgv);
            }
        }
    }
#pragma unroll
    for (int hd = 0; hd < 8; ++hd) mx[hd] = wave_max(mx[hd]);
    asm volatile("s_waitcnt lgkmcnt(0)" ::: "memory");
    float sm[8];
#pragma unroll
    for (int hd = 0; hd < 8; ++hd) sm[hd] = 0.f;
#pragma unroll 1
    for (int i = 0; i < 4; ++i) {
        const int j = lane + 64 * i;
        if (j < nsel) {
#pragma unroll
            for (int hd = 0; hd < 8; ++hd) { const float p = exp2f(pl[j * 8 + hd] - mx[hd]); pl[j * 8 + hd] = p; sm[hd] += p; }
        }
    }
#pragma unroll
    for (int hd = 0; hd < 8; ++hd) sm[hd] = 1.f / wave_sum(sm[hd]);
    asm volatile("s_waitcnt lgkmcnt(0)" ::: "memory");
    float acc[8];
#pragma unroll
    for (int hd = 0; hd < 8; ++hd) acc[hd] = 0.f;
    const bf16* vb = PROJ + (size_t)b * SEQ * PW + C_AV + lane;
#pragma unroll 4
    for (int j = 0; j < nsel; ++j) {
        const int s = lst[j]; const float v = bf2f(vb[(size_t)s * PW]);
        const f32x4 p0 = *(const LAS f32x4*)(pl + j * 8), p1 = *(const LAS f32x4*)(pl + j * 8 + 4);
        acc[0] += p0.x * v; acc[1] += p0.y * v; acc[2] += p0.z * v; acc[3] += p0.w * v; acc[4] += p1.x * v; acc[5] += p1.y * v; acc[6] += p1.z * v; acc[7] += p1.w * v;
    }
#pragma unroll
    for (int hd = 0; hd < 8; ++hd) acc[hd] *= sm[hd];
#pragma unroll
    for (int hd = 0; hd < 8; ++hd) YM[row * DM + hd * 64 + lane] = (bf16)f2bf(acc[hd]);
}

struct LnRaw { f32x4 x[4]; v2u ya[4]; v2u yb[4]; v2u hx[4]; };
template <bool ROUTE, int YMODE, int XMODE>
__device__ __forceinline__ void ph_ln(Ctx& C, const float* Xin, int l, int which, int mod_g, int mod_l2, int mod_sh, bool write_h, int jmoe, int mod_in, bool write_x) {
    const int gw = C.bid * 8 + C.wave, NGW = C.G * 8, lane = C.lane;
    const float* MOD = (const float*)(C.ws + WS_MOD); bf16* H = (bf16*)(C.ws + WS_H); const bf16* Y = (const bf16*)(C.ws + WS_Y);
    const float* lng = C.in(I_LNG) + (size_t)(l * 2 + which) * DM; const float* lnb = C.in(I_LNB) + (size_t)(l * 2 + which) * DM;
    const int* TOKSLOT = (const int*)(C.ws + WS_TOKSLOT);
    const float* wr = C.in(I_WR) + (size_t)jmoe * DM * NEXP; const float* br = C.in(I_BR) + jmoe * NEXP;
    int* TOPE = (int*)(C.ws + WS_TOPE); float* TOPG = (float*)(C.ws + WS_TOPG);
    unsigned ecnt[8];
#pragma unroll
    for (int e = 0; e < 8; ++e) ecnt[e] = 0u;
    LAS float* wrs = (LAS float*)C.lds;
    if (ROUTE) { for (int i = C.tid; i < DM * NEXP / 4; i += 512) ((LAS f32x4*)wrs)[i] = ((const f32x4*)wr)[i]; __syncthreads(); }
    const int RPW = (MTOK + NGW - 1) / NGW;
    const int r0 = gw * RPW, r1 = (r0 + RPW < MTOK) ? r0 + RPW : MTOK;
    if (r0 < MTOK) {
        const int b = r0 >> 12;
        const bool one_batch = ((r1 - 1) >> 12) == b;
        const float* mg = MOD + ((size_t)l * 16 + b) * 6144 + mod_g;
        const float* mi = MOD + ((size_t)l * 16 + b) * 6144 + mod_in;
        const float* ms = MOD + ((size_t)mod_l2 * 16 + b) * 6144 + mod_sh;
        f32x4 gv[4], shi[4], sci[4];
#pragma unroll
        for (int j = 0; j < 4; ++j) { const int col = 4 * lane + 256 * j; gv[j] = *(const f32x4*)(mg + col);
            if (XMODE == 1) { shi[j] = *(const f32x4*)(mi + col); const f32x4 sc_ = *(const f32x4*)(mi + 1024 + col); sci[j].x = 1.f / (sc_.x + 1.f); sci[j].y = 1.f / (sc_.y + 1.f); sci[j].z = 1.f / (sc_.z + 1.f); sci[j].w = 1.f / (sc_.w + 1.f); } }
        f32x4 Av[4], Bv[4];
#pragma unroll
        for (int j = 0; j < 4; ++j) { const int col = 4 * lane + 256 * j; const f32x4 gn = *(const f32x4*)(lng + col), bn = *(const f32x4*)(lnb + col);
            if (write_h) { const f32x4 sh = *(const f32x4*)(ms + col), sc = *(const f32x4*)(ms + 1024 + col); Av[j] = gn * (sc + 1.f); Bv[j] = bn * (sc + 1.f) + sh; } else { Av[j] = gn; Bv[j] = bn; } }
        int sl0 = 0, sl1 = 0;
        if (YMODE == 1 && r0 + lane < r1) { sl0 = TOKSLOT[2 * (r0 + lane)]; sl1 = TOKSLOT[2 * (r0 + lane) + 1]; }
#define LN_LOAD(R, row_) { const int s0_ = (YMODE == 1) ? (((row_) - r0 < 64) ? __builtin_amdgcn_readlane(sl0, (row_) - r0) : TOKSLOT[2 * (row_)]) : 0, s1_ = (YMODE == 1) ? (((row_) - r0 < 64) ? __builtin_amdgcn_readlane(sl1, (row_) - r0) : TOKSLOT[2 * (row_) + 1]) : 0; \
        const bf16* y0_ = (YMODE == 0) ? Y + (size_t)(row_) * DM : Y + (size_t)s0_ * DM; const bf16* y1_ = Y + (size_t)s1_ * DM; \
        _Pragma("unroll") for (int j = 0; j < 4; ++j) { const int col = 4 * lane + 256 * j; \
            if (XMODE == 0) R.x[j] = *(const f32x4*)(Xin + (size_t)(row_) * DM + col); else R.hx[j] = *(const v2u*)(H + (size_t)(row_) * DM + col); \
            R.ya[j] = *(const v2u*)(y0_ + col); if (YMODE == 1) R.yb[j] = *(const v2u*)(y1_ + col); } }
        LnRaw cur, nx1, nx2;
        LN_LOAD(cur, r0)
        if (r0 + 1 < r1) LN_LOAD(nx1, r0 + 1)
        for (int row = r0; row < r1; ++row) {
            if (ROUTE) asm volatile("" ::: "memory");
            if (row + 2 < r1) LN_LOAD(nx2, row + 2)
            if (!one_batch) {
                const int bb = row >> 12; const float* mg2 = MOD + ((size_t)l * 16 + bb) * 6144 + mod_g; const float* mi2 = MOD + ((size_t)l * 16 + bb) * 6144 + mod_in;
#pragma unroll
                for (int j = 0; j < 4; ++j) { const int col = 4 * lane + 256 * j; gv[j] = *(const f32x4*)(mg2 + col);
                    if (XMODE == 1) { shi[j] = *(const f32x4*)(mi2 + col); const f32x4 sc_ = *(const f32x4*)(mi2 + 1024 + col); sci[j].x = 1.f / (sc_.x + 1.f); sci[j].y = 1.f / (sc_.y + 1.f); sci[j].z = 1.f / (sc_.z + 1.f); sci[j].w = 1.f / (sc_.w + 1.f); } }
            }
            if (!one_batch) {
                const float* msr = MOD + ((size_t)mod_l2 * 16 + (row >> 12)) * 6144 + mod_sh;
#pragma unroll
                for (int j = 0; j < 4; ++j) { const int col = 4 * lane + 256 * j; const f32x4 gn = *(const f32x4*)(lng + col), bn = *(const f32x4*)(lnb + col);
                    if (write_h) { const f32x4 sh = *(const f32x4*)(msr + col), sc = *(const f32x4*)(msr + 1024 + col); Av[j] = gn * (sc + 1.f); Bv[j] = bn * (sc + 1.f) + sh; } else { Av[j] = gn; Bv[j] = bn; } }
            }
            f32x4 v[4]; float s = 0.f;
#pragma unroll
            for (int j = 0; j < 4; ++j) {
                const v2u ya = cur.ya[j];
                f32x4 y; y.x = bf2f(ya.x & 0xffffu); y.y = bf2f(ya.x >> 16); y.z = bf2f(ya.y & 0xffffu); y.w = bf2f(ya.y >> 16);
                if (YMODE == 1) { const v2u yb = cur.yb[j]; y.x += bf2f(yb.x & 0xffffu); y.y += bf2f(yb.x >> 16); y.z += bf2f(yb.y & 0xffffu); y.w += bf2f(yb.y >> 16); }
                f32x4 xr;
                if (XMODE == 0) xr = cur.x[j];
                else { const v2u hh_ = cur.hx[j]; f32x4 hf; hf.x = bf2f(hh_.x & 0xffffu); hf.y = bf2f(hh_.x >> 16); hf.z = bf2f(hh_.y & 0xffffu); hf.w = bf2f(hh_.y >> 16);
                       xr = (hf - shi[j]) * sci[j]; }
                v[j] = xr * DN_ALPHA + (gv[j] + 1.f) * y;
                s += (v[j].x + v[j].y) + (v[j].z + v[j].w);
            }
            const float mean = wave_sum_f(s) * (1.f / DM); float s2 = 0.f;
#pragma unroll
            for (int j = 0; j < 4; ++j) { v[j] = v[j] - mean; s2 += (v[j].x * v[j].x + v[j].y * v[j].y) + (v[j].z * v[j].z + v[j].w * v[j].w); }
            const float rstd = rsqrtf(wave_sum_f(s2) * (1.f / DM) + LN_EPS);
            float lgt[8];
#pragma unroll
            for (int e = 0; e < 8; ++e) lgt[e] = 0.f;
#pragma unroll
            for (int j = 0; j < 4; ++j) {
                const int col = 4 * lane + 256 * j;
                const f32x4 hv = v[j] * rstd * Av[j] + Bv[j];
                if (write_x) *(f32x4*)(C.out + (size_t)row * DM + col) = hv;
                if (write_h) {
                    v2u o; o.x = pk2(hv.x, hv.y); o.y = pk2(hv.z, hv.w);
                    *(v2u*)(H + (size_t)row * DM + col) = o;
                    if (ROUTE) {
                        const float hx[4] = {hv.x, hv.y, hv.z, hv.w};
#pragma unroll
                        for (int c = 0; c < 4; ++c) { const f32x4 w0 = *(const LAS f32x4*)(wrs + (col + c) * NEXP), w1 = *(const LAS f32x4*)(wrs + (col + c) * NEXP + 4);
                            lgt[0] += hx[c] * w0.x; lgt[1] += hx[c] * w0.y; lgt[2] += hx[c] * w0.z; lgt[3] += hx[c] * w0.w;
                            lgt[4] += hx[c] * w1.x; lgt[5] += hx[c] * w1.y; lgt[6] += hx[c] * w1.z; lgt[7] += hx[c] * w1.w; }
                    }
                }
            }
            if (ROUTE) {
#pragma unroll
                for (int e = 0; e < 8; ++e) lgt[e] = wave_sum_f(lgt[e]) + br[e];
                int e0 = 0; float v0 = lgt[0];
#pragma unroll
                for (int e = 1; e < 8; ++e) if (lgt[e] > v0) { v0 = lgt[e]; e0 = e; }
                int e1 = -1; float v1 = -3.0e38f;
#pragma unroll
                for (int e = 0; e < 8; ++e) if (e != e0 && lgt[e] > v1) { v1 = lgt[e]; e1 = e; }
                const float g1 = 1.f / (1.f + expf(v0 - v1)), g0 = 1.f - g1;
                if (lane == 0) { TOPE[2 * row] = e0; TOPE[2 * row + 1] = e1; TOPG[2 * row] = g0; TOPG[2 * row + 1] = g1; }
#pragma unroll
                for (int e = 0; e < 8; ++e) ecnt[e] += (e == e0 ? 1u : 0u) + (e == e1 ? 1u : 0u);
            }
            cur = nx1; nx1 = nx2;
        }
#undef LN_LOAD
    }
    if (ROUTE) {
        unsigned mine = 0u;
#pragma unroll
        for (int e = 0; e < 8; ++e) mine = (lane == e) ? ecnt[e] : mine;
        if (lane < 8 && mine) __hip_atomic_fetch_add(C.ctl + CW_CNT + 64 * jmoe + lane, mine, __ATOMIC_RELAXED, __HIP_MEMORY_SCOPE_AGENT);
    }
}

struct MoeTab { int pend[8]; int npanels; };
__device__ __forceinline__ MoeTab moe_tab(Ctx& C, int jmoe) {
    MoeTab t; int acc = 0;
#pragma unroll
    for (int e = 0; e < 8; ++e) { const int c = (int)__hip_atomic_load(C.ctl + CW_CNT + 64 * jmoe + e, __ATOMIC_RELAXED, __HIP_MEMORY_SCOPE_AGENT); acc += (c + 255) & ~255; t.pend[e] = acc; }
    t.npanels = acc >> 8; return t;
}
__device__ __forceinline__ int panel_expert(const MoeTab& t, int p) {
    int e = 0;
#pragma unroll
    for (int k = 0; k < 7; ++k) e += (p * 256 >= t.pend[k]) ? 1 : 0;
    return e;
}
__device__ __forceinline__ void ph_assign(Ctx& C, int jmoe) {
    const int gw = C.bid * 8 + C.wave, NGW = C.G * 8, lane = C.lane;
    const MoeTab tb = moe_tab(C, jmoe);
    const int* TOPE = (const int*)(C.ws + WS_TOPE); const float* TOPG = (const float*)(C.ws + WS_TOPG);
    int* TOKSLOT = (int*)(C.ws + WS_TOKSLOT); int* ROWTOK = (int*)(C.ws + WS_ROWTOK); float* ROWGATE = (float*)(C.ws + WS_ROWGATE);
    const bf16* H = (const bf16*)(C.ws + WS_H); bf16* HS = (bf16*)(C.ws + WS_Y);
    const unsigned long long ltmask = (lane == 0) ? 0ull : (~0ull >> (64 - lane));
    for (int tk0 = gw * 32; tk0 < MTOK; tk0 += NGW * 32) {
        const int tok = tk0 + (lane & 31); const bool act = lane < 32;
        const int e0 = act ? TOPE[2 * tok] : -1, e1 = act ? TOPE[2 * tok + 1] : -1; const float g0 = TOPG[2 * tok], g1 = TOPG[2 * tok + 1];
        int s0 = 0, s1 = 0;
#pragma unroll
        for (int e = 0; e < 8; ++e) {
            const unsigned long long m0 = __ballot(e0 == e), m1 = __ballot(e1 == e); const int n0 = __popcll(m0), n1 = __popcll(m1);
            int basev = 0;
            if (lane == 0 && (n0 + n1) > 0) basev = (int)__hip_atomic_fetch_add(C.ctl + CW_FILL + 64 * jmoe + e, (unsigned)(n0 + n1), __ATOMIC_RELAXED, __HIP_MEMORY_SCOPE_AGENT);
            basev = __builtin_amdgcn_readfirstlane(basev);
            const int pstart = (e == 0) ? 0 : tb.pend[e > 0 ? e - 1 : 0];
            if (e0 == e) s0 = pstart + basev + __popcll(m0 & ltmask);
            if (e1 == e) s1 = pstart + basev + n0 + __popcll(m1 & ltmask);
        }
        if (act) { TOKSLOT[2 * tok] = s0; TOKSLOT[2 * tok + 1] = s1;
            ROWTOK[s0] = tok; ROWGATE[s0] = g0; ROWTOK[s1] = tok; ROWGATE[s1] = g1; }
#pragma unroll 8
        for (int tt = 0; tt < 32; ++tt) {
            const int d0 = __builtin_amdgcn_readlane(s0, tt), d1 = __builtin_amdgcn_readlane(s1, tt);
            const v4u* src = (const v4u*)(H + (size_t)(tk0 + tt) * DM);
            const v4u a = src[lane], b2 = src[64 + lane];
            v4u* o0 = (v4u*)(HS + (size_t)d0 * DM); v4u* o1 = (v4u*)(HS + (size_t)d1 * DM);
            o0[lane] = a; o0[64 + lane] = b2; o1[lane] = a; o1[64 + lane] = b2;
        }
    }
    for (int idx = gw; idx < 8 * 256; idx += NGW) {
        const int e = idx >> 8, jj = idx & 255;
        const int c = (int)__hip_atomic_load(C.ctl + CW_CNT + 64 * jmoe + e, __ATOMIC_RELAXED, __HIP_MEMORY_SCOPE_AGENT);
        int pstart = 0;
#pragma unroll
        for (int k = 0; k < 7; ++k) if (k < e) pstart = tb.pend[k];
        const int slot = pstart + c + jj;
        if (c + jj < ((c + 255) & ~255)) {
            if (lane == 0) { ROWTOK[slot] = 0; ROWGATE[slot] = 0.f; }
            v4u* o = (v4u*)(HS + (size_t)slot * DM); const v4u z = {0u, 0u, 0u, 0u}; o[lane] = z; o[64 + lane] = z;
        }
    }
}

__device__ __forceinline__ float silu_fast_(float v) { return v * __builtin_amdgcn_rcpf(1.f + __builtin_amdgcn_exp2f(-v * LOG2E)); }
constexpr size_t WS_GLA_LT = WS_Y;
constexpr size_t WS_GLA_SP = WS_Y + 130 * MiB;
constexpr size_t WS_GLA_EB = WS_Y + 128 * MiB;
constexpr int GLA_PITCH = 72;

struct GlaDecay { float b[8]; float Btot; float qv[8]; float kv[8]; };
__device__ __forceinline__ void gla_decay(Ctx& C, int l, int b, int hh, int c, LAS float* segs, GlaDecay& D) {
    const bf16* PROJ = (const bf16*)(C.ws + WS_P);
    const float* w_a2 = C.in(I_WA2) + (size_t)l * 16 * 256 + hh * 64 + C.lane; const float bias = C.in(I_BA)[l * 256 + hh * 64 + C.lane];
    float w[16];
#pragma unroll
    for (int r = 0; r < 16; ++r) w[r] = w_a2[r * 256];
    const size_t row0 = (size_t)b * SEQ + c * 64 + 8 * C.wave;
    LAS unsigned* baS = (LAS unsigned*)(C.lds + 36864) + C.wave * 64;
    baS[C.lane] = *(const unsigned*)(PROJ + (row0 + (C.lane >> 3)) * PW + C_BA + 2 * (C.lane & 7));
    float qraw[8], kraw[8];
#pragma unroll
    for (int i = 0; i < 8; ++i) { const bf16* pr = PROJ + (row0 + i) * PW; qraw[i] = bf2f(pr[C_BQ + hh * 64 + C.lane]); kraw[i] = bf2f(pr[C_BK + hh * 64 + C.lane]); }
    asm volatile("s_waitcnt lgkmcnt(0)" ::: "memory");
    float run = 0.f;
#pragma unroll
    for (int i = 0; i < 8; ++i) {
        const v4u ba0 = *(const LAS v4u*)(baS + 8 * i), ba1 = *(const LAS v4u*)(baS + 8 * i + 4);
        const unsigned bw[8] = {ba0.x, ba0.y, ba0.z, ba0.w, ba1.x, ba1.y, ba1.z, ba1.w};
        float z = bias;
#pragma unroll
        for (int r = 0; r < 8; ++r) { z += bf2f(bw[r] & 0xffffu) * w[2 * r]; z += bf2f(bw[r] >> 16) * w[2 * r + 1]; }
        const float ls = fminf(z, 0.f) - __logf(1.f + __expf(-fabsf(z)));
        run += ls * (1.f / 16.f);
        D.b[i] = run;
        D.qv[i] = qraw[i]; D.kv[i] = kraw[i];
    }
    segs[C.wave * 64 + C.lane] = run;
    __syncthreads();
    float off = 0.f, tot = 0.f;
#pragma unroll
    for (int w8 = 0; w8 < 8; ++w8) { const float sv = segs[w8 * 64 + C.lane]; tot += sv; off += (w8 < C.wave) ? sv : 0.f; }
#pragma unroll
    for (int i = 0; i < 8; ++i) D.b[i] += off;
    D.Btot = tot;
}
__device__ __forceinline__ bf16x8 gla_vt_frag(const bf16* vcol, int ks, int h) {
    unsigned short x[8];
#pragma unroll
    for (int j = 0; j < 8; ++j) x[j] = vcol[(size_t)(16 * ks + 8 * (j >> 2) + 4 * h + (j & 3)) * PW];
    v4u p; p.x = (unsigned)x[0] | ((unsigned)x[1] << 16); p.y = (unsigned)x[2] | ((unsigned)x[3] << 16); p.z = (unsigned)x[4] | ((unsigned)x[5] << 16); p.w = (unsigned)x[6] | ((unsigned)x[7] << 16);
    return __builtin_bit_cast(bf16x8, p);
}

__device__ __forceinline__ void ph_gla1_unit(Ctx& C, int l, int unit) {
    const int c = unit & 63, hh = (unit >> 6) & 3, b = unit >> 8;
    LAS bf16* KDT = (LAS bf16*)C.lds;
    LAS float* segs = (LAS float*)(C.lds + 32768);
    const bf16* PROJ = (const bf16*)(C.ws + WS_P);
    const int mt = C.wave >> 1, nd = C.wave & 1, n = C.lane & 31, h = C.lane >> 5;
    const bf16* vcol = PROJ + ((size_t)b * SEQ + c * 64) * PW + C_BV + hh * 128 + 32 * mt + n;
    bf16x8 vf[4];
#pragma unroll
    for (int ks = 0; ks < 4; ++ks) vf[ks] = gla_vt_frag(vcol, ks, h);
    GlaDecay D; gla_decay(C, l, b, hh, c, segs, D);
    {
        v4u p;
        p.x = pk2(D.kv[0] * __expf(D.Btot - D.b[0]), D.kv[1] * __expf(D.Btot - D.b[1])); p.y = pk2(D.kv[2] * __expf(D.Btot - D.b[2]), D.kv[3] * __expf(D.Btot - D.b[3]));
        p.z = pk2(D.kv[4] * __expf(D.Btot - D.b[4]), D.kv[5] * __expf(D.Btot - D.b[5])); p.w = pk2(D.kv[6] * __expf(D.Btot - D.b[6]), D.kv[7] * __expf(D.Btot - D.b[7]));
        *(LAS v4u*)(KDT + C.lane * GLA_PITCH + 8 * C.wave) = p;
        if (C.wave == 0) ((float*)(C.ws + WS_GLA_EB))[(size_t)unit * 64 + C.lane] = __expf(D.Btot);
    }
    __syncthreads();
    f32x16 acc;
#pragma unroll
    for (int i = 0; i < 16; ++i) acc[i] = 0.f;
#pragma unroll
    for (int ks = 0; ks < 4; ++ks) {
        const LAS bf16* kp = KDT + (32 * nd + n) * GLA_PITCH + 16 * ks + 4 * h;
        const v2u k0 = *(const LAS v2u*)kp, k1 = *(const LAS v2u*)(kp + 8);
        v4u kk; kk.x = k0.x; kk.y = k0.y; kk.z = k1.x; kk.w = k1.y;
        acc = mfma32(vf[ks], __builtin_bit_cast(bf16x8, kk), acc);
    }
    float* LT = (float*)(C.ws + WS_GLA_LT) + (size_t)unit * 8192;
#pragma unroll
    for (int r = 0; r < 16; ++r) LT[(32 * mt + (r & 3) + 8 * (r >> 2) + 4 * h) * 64 + 32 * nd + n] = acc[r];
    __syncthreads();
}

__device__ __forceinline__ void ph_gla2(Ctx& C, size_t probe_off = 0) {
    const f32x4* LT = (const f32x4*)(C.ws + WS_GLA_LT); v2u* SP = (v2u*)(C.ws + WS_GLA_SP + probe_off); const float* EB = (const float*)(C.ws + WS_GLA_EB);
    for (int it = C.bid; it < 64 * 4; it += C.G) {
        const int bh = it >> 2, idx = (it & 3) * 512 + C.tid;
        const f32x4* p = LT + (size_t)bh * 64 * 2048 + idx; v2u* q = SP + (size_t)bh * 64 * 2048 + idx; const float* eb = EB + (size_t)bh * 64 * 64 + ((4 * idx) & 63);
        float S0 = 0.f, S1 = 0.f, S2 = 0.f, S3 = 0.f;
#pragma unroll 16
        for (int c = 0; c < 64; ++c) { const f32x4 lv = p[(size_t)c * 2048]; const f32x4 e = *(const f32x4*)(eb + c * 64);
            v2u o; o.x = pk2(S0, S1); o.y = pk2(S2, S3); q[(size_t)c * 2048] = o;
            S0 = e.x * S0 + lv.x; S1 = e.y * S1 + lv.y; S2 = e.z * S2 + lv.z; S3 = e.w * S3 + lv.w; }
    }
}

__device__ __forceinline__ void ph_gla3_unit(Ctx& C, int l, int unit) {
    const int c = unit & 63, hh = (unit >> 6) & 3, b = unit >> 8;
    LAS bf16* QE = (LAS bf16*)C.lds;
    LAS bf16* KE = QE + 64 * GLA_PITCH;
    LAS float* segs = (LAS float*)(C.lds + 32768);
    LAS float* ssq = (LAS float*)(C.lds + 32768 + 2048);
    const bf16* PROJ = (const bf16*)(C.ws + WS_P); bf16* YM = (bf16*)C.out;
    const int mt = C.wave >> 1, nt = C.wave & 1, n = C.lane & 31, h = C.lane >> 5;
    const size_t row0 = (size_t)b * SEQ + c * 64;
    const bf16* vcol = PROJ + row0 * PW + C_BV + hh * 128 + 32 * mt + n;
    bf16x8 vf[4]; bf16x8 spf[4]; v2u gb[4]; f32x4 gnv[4];
#pragma unroll
    for (int ks = 0; ks < 4; ++ks) vf[ks] = gla_vt_frag(vcol, (ks <= 2 * nt + 1) ? ks : 0, h);
    {
        const bf16* Sp = (const bf16*)(C.ws + WS_GLA_SP) + (size_t)unit * 8192 + (size_t)(32 * mt + n) * 64 + 8 * h;
#pragma unroll
        for (int ks = 0; ks < 4; ++ks) spf[ks] = *(const bf16x8*)(Sp + 16 * ks);
#pragma unroll
        for (int j4 = 0; j4 < 4; ++j4) { gb[j4] = *(const v2u*)(PROJ + (row0 + 32 * nt + n) * PW + C_BG + hh * 128 + 32 * mt + 8 * j4 + 4 * h); gnv[j4] = *(const f32x4*)(C.in(I_GLAG) + l * 128 + 32 * mt + 8 * j4 + 4 * h); }
    }
    GlaDecay D; gla_decay(C, l, b, hh, c, segs, D);
#pragma unroll
    for (int i = 0; i < 8; ++i) {
        QE[(8 * C.wave + i) * GLA_PITCH + C.lane] = (bf16)f2bf(D.qv[i] * 0.125f * __expf(D.b[i]));
        KE[(8 * C.wave + i) * GLA_PITCH + C.lane] = (bf16)f2bf(D.kv[i] * __expf(-D.b[i]));
    }
    __syncthreads();
    bf16x8 qf[4];
#pragma unroll
    for (int ks = 0; ks < 4; ++ks) qf[ks] = *(const LAS bf16x8*)(QE + (32 * nt + n) * GLA_PITCH + 16 * ks + 8 * h);
    f32x16 accO;
#pragma unroll
    for (int i = 0; i < 16; ++i) accO[i] = 0.f;
#pragma unroll
    for (int ms = 0; ms < 2; ++ms) {
        if (ms <= nt) {
            f32x16 aT;
#pragma unroll
            for (int i = 0; i < 16; ++i) aT[i] = 0.f;
#pragma unroll
            for (int ks = 0; ks < 4; ++ks) { const bf16x8 kf = *(const LAS bf16x8*)(KE + (32 * ms + n) * GLA_PITCH + 16 * ks + 8 * h); aT = mfma32(kf, qf[ks], aT); }
            if (ms == nt) {
#pragma unroll
                for (int r = 0; r < 16; ++r) { const int s = (r & 3) + 8 * (r >> 2) + 4 * h; aT[r] = (s <= n) ? aT[r] : 0.f; }
            }
#pragma unroll
            for (int s2 = 0; s2 < 2; ++s2) {
                v4u pa; pa.x = pk2(aT[8 * s2 + 0], aT[8 * s2 + 1]); pa.y = pk2(aT[8 * s2 + 2], aT[8 * s2 + 3]); pa.z = pk2(aT[8 * s2 + 4], aT[8 * s2 + 5]); pa.w = pk2(aT[8 * s2 + 6], aT[8 * s2 + 7]);
                accO = mfma32(vf[2 * ms + s2], __builtin_bit_cast(bf16x8, pa), accO);
            }
        }
    }
    {
#pragma unroll
        for (int ks = 0; ks < 4; ++ks) accO = mfma32(spf[ks], qf[ks], accO);
    }
    float sq = 0.f;
#pragma unroll
    for (int r = 0; r < 16; ++r) sq += accO[r] * accO[r];
    sq += SHX_F(sq, 32, C.lane);
    if (h == 0) ssq[mt * 64 + 32 * nt + n] = sq;
    __syncthreads();
    const float rstd = rsqrtf(((ssq[32 * nt + n] + ssq[64 + 32 * nt + n]) + (ssq[128 + 32 * nt + n] + ssq[192 + 32 * nt + n])) * (1.f / 128.f) + LN_EPS);
    const size_t row = row0 + 32 * nt + n;
#pragma unroll
    for (int j4 = 0; j4 < 4; ++j4) {
        const int e0 = 32 * mt + 8 * j4 + 4 * h;
        const v2u gbv = gb[j4]; const f32x4 gn = gnv[j4];
        const float y0 = accO[4 * j4 + 0] * rstd * gn.x * silu_fast_(bf2f(gbv.x & 0xffffu)), y1 = accO[4 * j4 + 1] * rstd * gn.y * silu_fast_(bf2f(gbv.x >> 16));
        const float y2 = accO[4 * j4 + 2] * rstd * gn.z * silu_fast_(bf2f(gbv.y & 0xffffu)), y3 = accO[4 * j4 + 3] * rstd * gn.w * silu_fast_(bf2f(gbv.y >> 16));
        v2u o; o.x = pk2(y0, y1); o.y = pk2(y2, y3);
        *(v2u*)(YM + row * DM + 512 + hh * 128 + e0) = o;
    }
    __syncthreads();
}

#ifndef A3_VPATH
#define A3_VPATH(i) (true)
#endif
#ifndef REP_S
#define REP_S 1
#endif
constexpr size_t WS_KFI = 932 * MiB, WS_KFA = 940 * MiB, WS_VF = 948 * MiB;

__device__ __forceinline__ void ph_dsa_a2_unit(Ctx& C, int b, int t0) {
    LAS unsigned* cnt = (LAS unsigned*)(C.lds + 131072);
    const bf16* PROJ = (const bf16*)(C.ws + WS_P); unsigned* SEL = (unsigned*)(C.ws + WS_SEL); const bf16* KFI = (const bf16*)(C.ws + WS_KFI);
    const int lane = C.lane, n = lane & 31, h = lane >> 5, tid = C.tid, wave = C.wave;
    const int nk = t0 + 8, ntile = (nk + 31) >> 5;
    if (tid < 48) cnt[tid] = 0u;
    unsigned u[16][4];
    {
        bf16x8 af[2][4]; float wv[2][2][8];
        const int jq = 2 * ((n >> 4) & 1) + ((n >> 2) & 1), hd = 4 * ((n >> 3) & 1) + (n & 3);
#pragma unroll
        for (int mt = 0; mt < 2; ++mt) {
            const bf16* p = PROJ + (size_t)(b * SEQ + t0 + 4 * mt + jq) * PW + C_IQ + hd * 64 + 8 * h;
#pragma unroll
            for (int ks = 0; ks < 4; ++ks) af[mt][ks] = *(const bf16x8*)(p + ks * 16);
#pragma unroll
            for (int g = 0; g < 2; ++g) {
                const v4u w4 = *(const v4u*)(PROJ + (size_t)(b * SEQ + t0 + 4 * mt + 2 * g + h) * PW + C_IW); const unsigned ww[4] = {w4.x, w4.y, w4.z, w4.w};
#pragma unroll
                for (int x = 0; x < 4; ++x) { wv[mt][g][2 * x] = bf2f(ww[x] & 0xffffu) * (0.35355339059327373f * 0.125f); wv[mt][g][2 * x + 1] = bf2f(ww[x] >> 16) * (0.35355339059327373f * 0.125f); }
            }
        }
        const bf16* kbase = KFI + (size_t)(b * 128) * 2048 + lane * 8;
#pragma unroll
        for (int i = 0; i < 16; ++i) {
            const int tile = wave + 8 * i;
#pragma unroll
            for (int k = 0; k < 4; ++k) u[i][k] = 0u;
            if (tile < ntile) {
                bf16x8 bcur[4];
#pragma unroll
                for (int ks = 0; ks < 4; ++ks) bcur[ks] = *(const bf16x8*)(kbase + (size_t)tile * 2048 + ks * 512);
                const int s = tile * 32 + n;
#pragma unroll
                for (int mt = 0; mt < 2; ++mt) {
                    f32x16 acc;
#pragma unroll
                    for (int x = 0; x < 16; ++x) acc[x] = 0.f;
#pragma unroll
                    for (int ks = 0; ks < 4; ++ks) acc = mfma32(af[mt][ks], bcur[ks], acc);
#pragma unroll
                    for (int g = 0; g < 2; ++g) {
                        float p = 0.f;
#pragma unroll
                        for (int x = 0; x < 8; ++x) p += wv[mt][g][x] * fmaxf(acc[8 * g + x], 0.f);
                        const int t = t0 + 4 * mt + 2 * g + h;
                        u[i][2 * mt + g] = (s <= t) ? sortable_u32(p) : 0u;
                    }
                }
            }
            __builtin_amdgcn_sched_barrier(0);
        }
    }
    __syncthreads();
    unsigned Tl[4], Jl[4], needl[4];
#pragma unroll
    for (int k = 0; k < 4; ++k) { Tl[k] = 0u; Jl[k] = 8192u; needl[k] = 0u; }
    int buf = 0;
#define DSA_COUNT(PRED) \
        _Pragma("unroll") for (int i = 0; i < 16; ++i) if (wave + 8 * i < ntile) { const unsigned s = (unsigned)((wave + 8 * i) * 32 + n); (void)s; \
            _Pragma("unroll") for (int k = 0; k < 4; ++k) { const unsigned uu = u[i][k]; const unsigned long long bm = __ballot(PRED); cq[2 * k] += (unsigned)__popc((unsigned)bm); cq[2 * k + 1] += (unsigned)__popc((unsigned)(bm >> 32)); } __builtin_amdgcn_sched_barrier(0); }
#define DSA_PUBLISH(NW) { unsigned myc = 0u; \
        _Pragma("unroll") for (int q = 0; q < NW; ++q) myc = (lane == q) ? cq[q] : myc; \
        if (lane < NW) __hip_atomic_fetch_add(cnt + buf * 16 + lane, myc, __ATOMIC_RELAXED, __HIP_MEMORY_SCOPE_WORKGROUP); \
        nb = (buf == 2) ? 0 : buf + 1; if (tid >= 64 && tid < 80) cnt[nb * 16 + (tid - 64)] = 0u; __syncthreads(); }
#pragma unroll 1
    for (int bit = 31; bit >= 0; --bit) {
        unsigned cq[8]; int nb;
#pragma unroll
        for (int q = 0; q < 8; ++q) cq[q] = 0u;
        unsigned cl[4];
#pragma unroll
        for (int k = 0; k < 4; ++k) cl[k] = Tl[k] | (1u << bit);
        DSA_COUNT(uu >= cl[k])
        DSA_PUBLISH(8)
#pragma unroll
        for (int k = 0; k < 4; ++k) if (cnt[buf * 16 + 2 * k + h] >= 256u) Tl[k] = cl[k];
        buf = nb;
    }
#pragma unroll
    for (int k = 0; k < 4; ++k) Tl[k] = Tl[k] < 1u ? 1u : Tl[k];
    bool extra = false;
    {
        unsigned cq[16]; int nb;
#pragma unroll
        for (int q = 0; q < 16; ++q) cq[q] = 0u;
#pragma unroll
        for (int i = 0; i < 16; ++i) if (wave + 8 * i < ntile) {
#pragma unroll
            for (int k = 0; k < 4; ++k) { const unsigned uu = u[i][k];
                const unsigned long long bg = __ballot(uu > Tl[k]), be = __ballot(uu >= Tl[k]);
                cq[2 * k] += (unsigned)__popc((unsigned)bg); cq[2 * k + 1] += (unsigned)__popc((unsigned)(bg >> 32));
                cq[8 + 2 * k] += (unsigned)__popc((unsigned)be); cq[8 + 2 * k + 1] += (unsigned)__popc((unsigned)(be >> 32)); }
            __builtin_amdgcn_sched_barrier(0);
        }
        DSA_PUBLISH(16)
#pragma unroll
        for (int k = 0; k < 4; ++k) { const unsigned g = cnt[buf * 16 + 2 * k + h]; needl[k] = 256u - (g < 256u ? g : 256u); }
#pragma unroll
        for (int q = 0; q < 8; ++q) extra = extra || (cnt[buf * 16 + 8 + q] > 256u);
        buf = nb;
    }
    if (extra) {
#pragma unroll
        for (int k = 0; k < 4; ++k) Jl[k] = 0u;
#pragma unroll 1
        for (int bit = 12; bit >= 0; --bit) {
            unsigned cq[8]; int nb;
#pragma unroll
            for (int q = 0; q < 8; ++q) cq[q] = 0u;
            unsigned jl[4];
#pragma unroll
            for (int k = 0; k < 4; ++k) jl[k] = Jl[k] | (1u << bit);
            DSA_COUNT(uu == Tl[k] && s < jl[k])
            DSA_PUBLISH(8)
#pragma unroll
            for (int k = 0; k < 4; ++k) if (cnt[buf * 16 + 2 * k + h] <= needl[k]) Jl[k] = jl[k];
            buf = nb;
        }
    }
    {
        unsigned wsel[4];
#pragma unroll
        for (int k = 0; k < 4; ++k) wsel[k] = 0u;
#pragma unroll
        for (int i = 0; i < 16; ++i) if (wave + 8 * i < ntile) {
            const unsigned s = (unsigned)((wave + 8 * i) * 32 + n);
#pragma unroll
            for (int k = 0; k < 4; ++k) {
                const unsigned uu = u[i][k];
                const unsigned long long bm = __ballot((uu > Tl[k]) || (uu == Tl[k] && s < Jl[k]));
                const unsigned wd = h ? (unsigned)(bm >> 32) : (unsigned)bm;
                wsel[k] = (n == i) ? wd : wsel[k];
            }
            __builtin_amdgcn_sched_barrier(0);
        }
        const int tile = wave + 8 * n;
        if (n < 16 && tile < ntile) {
#pragma unroll
            for (int k = 0; k < 4; ++k) SEL[(size_t)(b * SEQ + t0 + 2 * k + h) * 128 + tile] = wsel[k];
        }
    }
#undef DSA_COUNT
#undef DSA_PUBLISH
    __syncthreads();
}


constexpr int A3_QP = 64 * 68;
struct A3Q { bf16x8 af[2][4]; v4u wq; };
__device__ __forceinline__ void a3_load_q(Ctx& C, int b, int t0, A3Q& Q) {
    const bf16* PROJ = (const bf16*)(C.ws + WS_P);
    const int n = C.lane & 31, h = C.lane >> 5;
    const int jq = 2 * ((n >> 4) & 1) + ((n >> 2) & 1), hd = 4 * ((n >> 3) & 1) + (n & 3);
#pragma unroll
    for (int mt = 0; mt < 2; ++mt) {
        const bf16* p = PROJ + (size_t)(b * SEQ + t0 + 4 * mt + jq) * PW + C_IQ + hd * 64 + 8 * h;
#pragma unroll
        for (int ks = 0; ks < 4; ++ks) Q.af[mt][ks] = *(const bf16x8*)(p + ks * 16);
    }
    Q.wq = *(const v4u*)(PROJ + (size_t)(b * SEQ + t0 + (n & 7)) * PW + C_IW);
}
__device__ __forceinline__ void ph_dsa_a3_unit(Ctx& C, int b, int t0, A3Q& Q, bool has_next, int nb, int nt0) {
    LAS unsigned* sc = (LAS unsigned*)C.lds;
    const bf16* PROJ = (const bf16*)(C.ws + WS_P); unsigned* SEL = (unsigned*)(C.ws + WS_SEL); const bf16* KFI = (const bf16*)(C.ws + WS_KFI);
    const int lane = C.lane, n = lane & 31, h = lane >> 5, wave = C.wave;
    const int nk = t0 + 8, ntile = (nk + 31) >> 5;
    {
        typedef _Float16 h8_t __attribute__((ext_vector_type(8)));
        typedef _Float16 h2_t __attribute__((ext_vector_type(2)));
        h8_t wf[2][2];
        {
            const unsigned ww[4] = {Q.wq.x, Q.wq.y, Q.wq.z, Q.wq.w}; unsigned wp[4];
#pragma unroll
            for (int x = 0; x < 4; ++x) wp[x] = __builtin_bit_cast(unsigned, __builtin_amdgcn_cvt_pkrtz(bf2f(ww[x] & 0xffffu) * (0.35355339059327373f * 0.125f), bf2f(ww[x] >> 16) * (0.35355339059327373f * 0.125f)));
#pragma unroll
            for (int mt = 0; mt < 2; ++mt)
#pragma unroll
                for (int ks = 0; ks < 2; ++ks) { const bool on = (n < 8) && ((n >> 2) == mt) && ((n & 3) == 2 * ks + h);
                    v4u f; f.x = on ? wp[0] : 0u; f.y = on ? wp[1] : 0u; f.z = on ? wp[2] : 0u; f.w = on ? wp[3] : 0u; wf[mt][ks] = __builtin_bit_cast(h8_t, f); }
        }
        const bf16* kbase = KFI + (size_t)(b * 128) * 2048 + lane * 8;
        bf16x8 kA[4], kB[4];
        { const int ta = wave < ntile ? wave : 0, tb = wave + 8 < ntile ? wave + 8 : ta;
#pragma unroll
          for (int ks = 0; ks < 4; ++ks) { kA[ks] = *(const bf16x8*)(kbase + (size_t)ta * 2048 + ks * 512); kB[ks] = *(const bf16x8*)(kbase + (size_t)tb * 2048 + ks * 512); } }
#define A3_MMA(A0, A1, KF) { const f32x16 z16_ = {0.f, 0.f, 0.f, 0.f, 0.f, 0.f, 0.f, 0.f, 0.f, 0.f, 0.f, 0.f, 0.f, 0.f, 0.f, 0.f}; \
            A0 = mfma32(Q.af[0][0], KF[0], z16_); A1 = mfma32(Q.af[1][0], KF[0], z16_); \
            _Pragma("unroll") for (int ks = 1; ks < 4; ++ks) { A0 = mfma32(Q.af[0][ks], KF[ks], A0); A1 = mfma32(Q.af[1][ks], KF[ks], A1); } }
#define A3_RELU4(A, r0_) ({ v4u f_; const h2_t z2_ = {(_Float16)0.f, (_Float16)0.f}; \
                f_.x = __builtin_bit_cast(unsigned, __builtin_elementwise_max(__builtin_bit_cast(h2_t, __builtin_amdgcn_cvt_pkrtz(A[(r0_)], A[(r0_) + 1])), z2_)); \
                f_.y = __builtin_bit_cast(unsigned, __builtin_elementwise_max(__builtin_bit_cast(h2_t, __builtin_amdgcn_cvt_pkrtz(A[(r0_) + 2], A[(r0_) + 3])), z2_)); \
                f_.z = __builtin_bit_cast(unsigned, __builtin_elementwise_max(__builtin_bit_cast(h2_t, __builtin_amdgcn_cvt_pkrtz(A[(r0_) + 4], A[(r0_) + 5])), z2_)); \
                f_.w = __builtin_bit_cast(unsigned, __builtin_elementwise_max(__builtin_bit_cast(h2_t, __builtin_amdgcn_cvt_pkrtz(A[(r0_) + 6], A[(r0_) + 7])), z2_)); \
                __builtin_bit_cast(h8_t, f_); })
#define A3_EPI(A0, A1, tile_) { const int s = (tile_) * 32 + n; const f32x16 z16e_ = {0.f, 0.f, 0.f, 0.f, 0.f, 0.f, 0.f, 0.f, 0.f, 0.f, 0.f, 0.f, 0.f, 0.f, 0.f, 0.f}; \
            f32x16 P_ = __builtin_amdgcn_mfma_f32_32x32x16_f16(wf[0][0], A3_RELU4(A0, 0), z16e_, 0, 0, 0); P_ = __builtin_amdgcn_mfma_f32_32x32x16_f16(wf[0][1], A3_RELU4(A0, 8), P_, 0, 0, 0); \
            P_ = __builtin_amdgcn_mfma_f32_32x32x16_f16(wf[1][0], A3_RELU4(A1, 0), P_, 0, 0, 0); P_ = __builtin_amdgcn_mfma_f32_32x32x16_f16(wf[1][1], A3_RELU4(A1, 8), P_, 0, 0, 0); \
              \
            _Pragma("unroll") for (int r = 0; r < 4; ++r) { const int q = r + 4 * h; sc[q * A3_QP + (s >> 6) * 68 + (s & 63)] = (s <= t0 + q) ? sortable_u32(P_[r]) : 0u; } }
#define A3_LOADK(KF, tile_) { const int tl_ = ((tile_) < ntile) ? (tile_) : wave; \
            _Pragma("unroll") for (int ks = 0; ks < 4; ++ks) KF[ks] = *(const bf16x8*)(kbase + (size_t)tl_ * 2048 + ks * 512); }
        f32x16 accA0, accA1, accB0, accB1;
        if (wave < ntile) { A3_MMA(accA0, accA1, kA) A3_LOADK(kA, wave + 16) }
#pragma unroll 1
        for (int tile = wave; tile < ntile; tile += 16) {
            if (tile + 8 < ntile) { A3_MMA(accB0, accB1, kB) A3_LOADK(kB, tile + 24) }
            A3_EPI(accA0, accA1, tile)
            if (tile + 8 < ntile) {
                if (tile + 16 < ntile) { A3_MMA(accA0, accA1, kA) A3_LOADK(kA, tile + 32) }
                A3_EPI(accB0, accB1, tile + 8)
            }
        }
#undef A3_LOADK
#undef A3_RELU4
#undef A3_MMA
#undef A3_EPI
    }
    __syncthreads();
    {
        const int q = wave, t = t0 + q;
        const int nval = t + 1 - 64 * lane;
        const unsigned long long vm = nval >= 64 ? ~0ull : (nval > 0 ? ((1ull << nval) - 1ull) : 0ull);
        unsigned long long selm = vm;
        if (t >= 256) {
            unsigned lo[32], hi[32];
            {
                const LAS v4u* gp = (const LAS v4u*)(sc + q * A3_QP + lane * 68);
#pragma unroll
                for (int i = 0; i < 8; ++i) { const v4u a = gp[i], c = gp[8 + i]; lo[4 * i] = a.x; lo[4 * i + 1] = a.y; lo[4 * i + 2] = a.z; lo[4 * i + 3] = a.w; hi[4 * i] = c.x; hi[4 * i + 1] = c.y; hi[4 * i + 2] = c.z; hi[4 * i + 3] = c.w; }
            }
#define A3_TR(X) { \
            _Pragma("unroll") for (int k = 0; k < 32; ++k) if ((k & 16) == 0) { const unsigned a = X[k], c = X[k + 16]; X[k] = __builtin_amdgcn_perm(c, a, 0x05040100u); X[k + 16] = __builtin_amdgcn_perm(c, a, 0x07060302u); } \
            _Pragma("unroll") for (int k = 0; k < 32; ++k) if ((k & 8) == 0) { const unsigned a = X[k], c = X[k + 8]; X[k] = __builtin_amdgcn_perm(c, a, 0x06020400u); X[k + 8] = __builtin_amdgcn_perm(c, a, 0x07030501u); } \
            _Pragma("unroll") for (int st = 2; st < 5; ++st) { const int j = 16 >> st; const unsigned m = st == 2 ? 0x0f0f0f0fu : st == 3 ? 0x33333333u : 0x55555555u; \
                _Pragma("unroll") for (int k = 0; k < 32; ++k) if ((k & j) == 0) { const unsigned a = X[k], c = X[k + j]; X[k] = (a & m) | ((c << j) & ~m); X[k + j] = ((a >> j) & m) | (c & ~m); } } }
            A3_TR(lo) A3_TR(hi)
#undef A3_TR
            unsigned al = (unsigned)vm, ah = (unsigned)(vm >> 32), gl = 0u, gh = 0u, G = 0u;
            bool done = false;
#pragma unroll
            for (int b = 31; b >= 0; --b) {
                if (!done) {
                    const unsigned ol = al & lo[b], oh = ah & hi[b];
                    const unsigned c = G + wave_sum_u32((unsigned)__popc(ol) + (unsigned)__popc(oh));
                    if (c >= 256u) { al = ol; ah = oh; done = (c == 256u); }
                    else { gl |= ol; gh |= oh; G = c; al ^= ol; ah ^= oh; }
                }
            }
            const unsigned ca = (unsigned)__popc(al) + (unsigned)__popc(ah);
            const unsigned tot = wave_sum_u32(ca);
            unsigned long long alive = ((unsigned long long)ah << 32) | al;
            if (G + tot > 256u) {
                int incl = (int)ca;
#pragma unroll
                for (int o = 1; o < 64; o <<= 1) { const int v = SHUP_I(incl, o, lane); if (lane >= o) incl += v; }
                const int before = incl - (int)ca, room = (int)(256u - G) - before;
                int take = room < 0 ? 0 : (room > (int)ca ? (int)ca : room);
                unsigned long long keep = 0ull;
                while (__any(take > 0)) { if (take > 0) { const unsigned long long low = alive & (0ull - alive); keep |= low; alive ^= low; --take; } }
                alive = keep;
            }
            selm = (((unsigned long long)gh << 32) | gl) | alive;
        }
        if (has_next) a3_load_q(C, nb, nt0, Q);
#ifdef SEL_ALL
        *(unsigned long long*)(SEL + (size_t)(b * SEQ + t) * 128 + 2 * lane) = selm;
#else
        if (64 * lane <= t) *(unsigned long long*)(SEL + (size_t)(b * SEQ + t) * 128 + 2 * lane) = selm;
#endif
    }
    __syncthreads();
}

constexpr int A4_BUF = 4 * A3_QP;
#ifdef PROBE_HOT
#define A4_TMASK(x) ((x) & C.hot)
#else
#define A4_TMASK(x) (x)
#endif
constexpr int A4_R = 4;
struct A4S { bf16x8 af[4]; v4u wq; bf16x8 k[A4_R][4]; };
__device__ __forceinline__ int a4_cnt(int t0, int sw) { const int ntile = (t0 + 4 + 31) >> 5; return (t0 + 3 < 256 || sw >= ntile) ? 0 : (ntile - sw + 3) >> 2; }
__device__ __forceinline__ void a4_prefetch(Ctx& C, A4S& S, int b, int t0) {
    const bf16* PROJ = (const bf16*)(C.ws + WS_P); const bf16* KFI = (const bf16*)(C.ws + WS_KFI);
    const int lane = C.lane, n = lane & 31, h = lane >> 5, sw = C.wave;
    const int cnt = a4_cnt(t0, sw);
    {
        const int jq = 2 * ((n >> 4) & 1) + ((n >> 2) & 1), hd = 4 * ((n >> 3) & 1) + (n & 3);
        const bf16* p = PROJ + (size_t)(b * SEQ + t0 + jq) * PW + C_IQ + hd * 64 + 8 * h;
#pragma unroll
        for (int ks = 0; ks < 4; ++ks) S.af[ks] = *(const bf16x8*)(p + ks * 16);
        const int qsel = (n & 1) + 2 * ((n >> 2) & 1);
        S.wq = *(const v4u*)(PROJ + (size_t)(b * SEQ + t0 + qsel) * PW + C_IW);
    }
    const bf16* kbase = KFI + (size_t)(b * 128) * 2048 + lane * 8;
#pragma unroll
    for (int j = 0; j < A4_R; ++j) { const int tl = j < cnt ? sw + 4 * j : 0;
#pragma unroll
        for (int ks = 0; ks < 4; ++ks) S.k[j][ks] = *(const bf16x8*)(kbase + (size_t)A4_TMASK(tl) * 2048 + ks * 512);
    }
}
__device__ __forceinline__ void a4_score(Ctx& C, A4S& S, LAS unsigned* sc, int b, int t0, int nb, int nt0) {
    const bf16* KFI = (const bf16*)(C.ws + WS_KFI); const bf16* PROJ = (const bf16*)(C.ws + WS_P);
    const int lane = C.lane, n = lane & 31, h = lane >> 5, sw = C.wave;
    const int cnt = a4_cnt(t0, sw);
    bf16x8 naf[4]; v4u nwq;
    {
        const int jq = 2 * ((n >> 4) & 1) + ((n >> 2) & 1), hd = 4 * ((n >> 3) & 1) + (n & 3);
        const bf16* p = PROJ + (size_t)(nb * SEQ + nt0 + jq) * PW + C_IQ + hd * 64 + 8 * h;
#pragma unroll
        for (int ks = 0; ks < 4; ++ks) naf[ks] = *(const bf16x8*)(p + ks * 16);
        const int qsel = (n & 1) + 2 * ((n >> 2) & 1);
        nwq = *(const v4u*)(PROJ + (size_t)(nb * SEQ + nt0 + qsel) * PW + C_IW);
    }
    const int ncnt = a4_cnt(nt0, sw);
    const bf16* nkbase = KFI + (size_t)(nb * 128) * 2048 + lane * 8;
    typedef _Float16 h8_t __attribute__((ext_vector_type(8)));
    typedef _Float16 h2_t __attribute__((ext_vector_type(2)));
    h8_t wf[2];
    {
        const unsigned ww[4] = {S.wq.x, S.wq.y, S.wq.z, S.wq.w}; unsigned wp[4];
#pragma unroll
        for (int x = 0; x < 4; ++x) wp[x] = __builtin_bit_cast(unsigned, __builtin_amdgcn_cvt_pkrtz(bf2f(ww[x] & 0xffffu) * (0.35355339059327373f * 0.125f), bf2f(ww[x] >> 16) * (0.35355339059327373f * 0.125f)));
        const bool rowok = (n == 0) || (n == 1) || (n == 4) || (n == 5); const int qrow = (n & 1) + 2 * (n >> 2);
#pragma unroll
        for (int ks = 0; ks < 2; ++ks) { const bool on = rowok && (qrow == 2 * ks + h);
            v4u f; f.x = on ? wp[0] : 0u; f.y = on ? wp[1] : 0u; f.z = on ? wp[2] : 0u; f.w = on ? wp[3] : 0u; wf[ks] = __builtin_bit_cast(h8_t, f); }
    }
    const bf16* kbase = KFI + (size_t)(b * 128) * 2048 + lane * 8;
#define A4_MMA(A, KF) { const f32x16 z16_ = {0.f, 0.f, 0.f, 0.f, 0.f, 0.f, 0.f, 0.f, 0.f, 0.f, 0.f, 0.f, 0.f, 0.f, 0.f, 0.f}; \
        A = mfma32(S.af[0], KF[0], z16_); _Pragma("unroll") for (int ks = 1; ks < 4; ++ks) A = mfma32(S.af[ks], KF[ks], A); }
#define A4_RELU4(A, r0_) ({ v4u f_; const h2_t z2_ = {(_Float16)0.f, (_Float16)0.f}; \
            f_.x = __builtin_bit_cast(unsigned, __builtin_elementwise_max(__builtin_bit_cast(h2_t, __builtin_amdgcn_cvt_pkrtz(A[(r0_)], A[(r0_) + 1])), z2_)); \
            f_.y = __builtin_bit_cast(unsigned, __builtin_elementwise_max(__builtin_bit_cast(h2_t, __builtin_amdgcn_cvt_pkrtz(A[(r0_) + 2], A[(r0_) + 3])), z2_)); \
            f_.z = __builtin_bit_cast(unsigned, __builtin_elementwise_max(__builtin_bit_cast(h2_t, __builtin_amdgcn_cvt_pkrtz(A[(r0_) + 4], A[(r0_) + 5])), z2_)); \
            f_.w = __builtin_bit_cast(unsigned, __builtin_elementwise_max(__builtin_bit_cast(h2_t, __builtin_amdgcn_cvt_pkrtz(A[(r0_) + 6], A[(r0_) + 7])), z2_)); \
            __builtin_bit_cast(h8_t, f_); })
#define A4_EPI(A, i_) { const int s = (sw + 4 * (i_)) * 32 + n; const f32x16 z16e_ = {0.f, 0.f, 0.f, 0.f, 0.f, 0.f, 0.f, 0.f, 0.f, 0.f, 0.f, 0.f, 0.f, 0.f, 0.f, 0.f}; \
        f32x16 P_ = __builtin_amdgcn_mfma_f32_32x32x16_f16(wf[0], A4_RELU4(A, 0), z16e_, 0, 0, 0); P_ = __builtin_amdgcn_mfma_f32_32x32x16_f16(wf[1], A4_RELU4(A, 8), P_, 0, 0, 0); \
          \
          \
        _Pragma("unroll") for (int r = 0; r < 2; ++r) { const int q = 2 * h + r; const unsigned u_ = __float_as_uint(P_[r]); sc[q * A3_QP + (s >> 6) * 68 + (s & 63)] = u_ ^ ((unsigned)((int)u_ >> 31) | 0x80000000u); } }
#define A4_LOADK(KF, i_) { const int il_ = ((i_) < cnt) ? (i_) : 0; _Pragma("unroll") for (int ks = 0; ks < 4; ++ks) KF[ks] = *(const bf16x8*)(kbase + (size_t)A4_TMASK(sw + 4 * il_) * 2048 + ks * 512); }
    f32x16 acc0, acc1;
    int i0 = 0;
#pragma unroll 1
    for (; i0 + 4 < cnt; i0 += 4) {
        A4_MMA(acc0, S.k[0]) A4_LOADK(S.k[0], i0 + 4)
        A4_MMA(acc1, S.k[1]) A4_LOADK(S.k[1], i0 + 5)
        A4_EPI(acc0, i0)
        A4_MMA(acc0, S.k[2]) A4_LOADK(S.k[2], i0 + 6)
        A4_EPI(acc1, i0 + 1)
        A4_MMA(acc1, S.k[3]) A4_LOADK(S.k[3], i0 + 7)
        A4_EPI(acc0, i0 + 2)
        A4_EPI(acc1, i0 + 3)
    }
#define A4_LOADN(KF, j_) { const int tl_ = ((j_) < ncnt) ? sw + 4 * (j_) : 0; _Pragma("unroll") for (int ks = 0; ks < 4; ++ks) KF[ks] = *(const bf16x8*)(nkbase + (size_t)A4_TMASK(tl_) * 2048 + ks * 512); }
    if (i0 < cnt) { A4_MMA(acc0, S.k[0]) }
    A4_LOADN(S.k[0], 0)
    if (i0 + 1 < cnt) { A4_MMA(acc1, S.k[1]) }
    A4_LOADN(S.k[1], 1)
    if (i0 < cnt) A4_EPI(acc0, i0)
    if (i0 + 2 < cnt) { A4_MMA(acc0, S.k[2]) }
    A4_LOADN(S.k[2], 2)
    if (i0 + 1 < cnt) A4_EPI(acc1, i0 + 1)
    if (i0 + 3 < cnt) { A4_MMA(acc1, S.k[3]) }
    A4_LOADN(S.k[3], 3)
    if (i0 + 2 < cnt) A4_EPI(acc0, i0 + 2)
    if (i0 + 3 < cnt) A4_EPI(acc1, i0 + 3)
#undef A4_LOADN
#pragma unroll
    for (int ks = 0; ks < 4; ++ks) S.af[ks] = naf[ks];
    S.wq = nwq;
#undef A4_LOADK
#undef A4_RELU4
#undef A4_MMA
#undef A4_EPI
}
__device__ __forceinline__ void a4_select(Ctx& C, const LAS unsigned* scq, int b, int t) {
    unsigned* SEL = (unsigned*)(C.ws + WS_SEL);
    const int lane = C.lane;
    const int nval = t + 1 - 64 * lane;
    const unsigned long long vm = nval >= 64 ? ~0ull : (nval > 0 ? ((1ull << nval) - 1ull) : 0ull);
    unsigned long long selm = vm;
    if (t >= 256) {
        unsigned lo[32], hi[32];
        {
            const LAS v4u* gp = (const LAS v4u*)(scq + lane * 68);
#pragma unroll
            for (int i = 0; i < 8; ++i) { const v4u a = gp[i], c = gp[8 + i]; lo[4 * i] = a.x; lo[4 * i + 1] = a.y; lo[4 * i + 2] = a.z; lo[4 * i + 3] = a.w; hi[4 * i] = c.x; hi[4 * i + 1] = c.y; hi[4 * i + 2] = c.z; hi[4 * i + 3] = c.w; }
        }
#define A3_TR(X) { \
        _Pragma("unroll") for (int k = 0; k < 32; ++k) if ((k & 16) == 0) { const unsigned a = X[k], c = X[k + 16]; X[k] = __builtin_amdgcn_perm(c, a, 0x05040100u); X[k + 16] = __builtin_amdgcn_perm(c, a, 0x07060302u); } \
        _Pragma("unroll") for (int k = 0; k < 32; ++k) if ((k & 8) == 0) { const unsigned a = X[k], c = X[k + 8]; X[k] = __builtin_amdgcn_perm(c, a, 0x06020400u); X[k + 8] = __builtin_amdgcn_perm(c, a, 0x07030501u); } \
        _Pragma("unroll") for (int st = 2; st < 5; ++st) { const int j = 16 >> st; const unsigned m = st == 2 ? 0x0f0f0f0fu : st == 3 ? 0x33333333u : 0x55555555u; \
            _Pragma("unroll") for (int k = 0; k < 32; ++k) if ((k & j) == 0) { const unsigned a = X[k], c = X[k + j]; X[k] = (a & m) | ((c << j) & ~m); X[k + j] = ((a >> j) & m) | (c & ~m); } } }
        A3_TR(lo) A3_TR(hi)
#undef A3_TR
        unsigned al = (unsigned)vm, ah = (unsigned)(vm >> 32), gl = 0u, gh = 0u, G = 0u;
        bool done = false;
#pragma unroll
        for (int bb = 31; bb >= 1; bb -= 2) {
            if (!done) {
                const unsigned o1l = al & lo[bb], o1h = ah & hi[bb];
                const unsigned o11l = o1l & lo[bb - 1], o11h = o1h & hi[bb - 1];
                const unsigned o01l = (al ^ o1l) & lo[bb - 1], o01h = (ah ^ o1h) & hi[bb - 1];
                unsigned x1 = (unsigned)__popc(o1l) + (unsigned)__popc(o1h), x11 = (unsigned)__popc(o11l) + (unsigned)__popc(o11h), x01 = (unsigned)__popc(o01l) + (unsigned)__popc(o01h);
                x1 += DPP_U32(x1, 0xB1); x11 += DPP_U32(x11, 0xB1); x01 += DPP_U32(x01, 0xB1);
                x1 += DPP_U32(x1, 0x4E); x11 += DPP_U32(x11, 0x4E); x01 += DPP_U32(x01, 0x4E);
                x1 += DPP_U32(x1, 0x124); x11 += DPP_U32(x11, 0x124); x01 += DPP_U32(x01, 0x124);
                x1 += DPP_U32(x1, 0x128); x11 += DPP_U32(x11, 0x128); x01 += DPP_U32(x01, 0x128);
                x1 += (unsigned)__builtin_amdgcn_update_dpp(0, (int)x1, 0x142, 0xA, 0xF, false); x11 += (unsigned)__builtin_amdgcn_update_dpp(0, (int)x11, 0x142, 0xA, 0xF, false); x01 += (unsigned)__builtin_amdgcn_update_dpp(0, (int)x01, 0x142, 0xA, 0xF, false);
                x1 += (unsigned)__builtin_amdgcn_update_dpp(0, (int)x1, 0x143, 0xC, 0xF, false); x11 += (unsigned)__builtin_amdgcn_update_dpp(0, (int)x11, 0x143, 0xC, 0xF, false); x01 += (unsigned)__builtin_amdgcn_update_dpp(0, (int)x01, 0x143, 0xC, 0xF, false);
                const unsigned c1 = G + (unsigned)__builtin_amdgcn_readlane((int)x1, 63), n11 = (unsigned)__builtin_amdgcn_readlane((int)x11, 63), n01 = (unsigned)__builtin_amdgcn_readlane((int)x01, 63);
                if (c1 >= 256u) {
                    al = o1l; ah = o1h;
                    if (c1 == 256u) done = true;
                    else {
                        const unsigned c = G + n11;
                        if (c >= 256u) { al = o11l; ah = o11h; done = (c == 256u); }
                        else { gl |= o11l; gh |= o11h; G = c; al ^= o11l; ah ^= o11h; }
                    }
                } else {
                    gl |= o1l; gh |= o1h; G = c1; al ^= o1l; ah ^= o1h;
                    const unsigned c = G + n01;
                    if (c >= 256u) { al = o01l; ah = o01h; done = (c == 256u); }
                    else { gl |= o01l; gh |= o01h; G = c; al ^= o01l; ah ^= o01h; }
                }
            }
        }
        const unsigned ca = (unsigned)__popc(al) + (unsigned)__popc(ah);
        const unsigned tot = wave_sum_u32(ca);
        unsigned long long alive = ((unsigned long long)ah << 32) | al;
        if (G + tot > 256u) {
            const int incl = wave_incl_scan_i((int)ca, lane);
            const int before = incl - (int)ca, room = (int)(256u - G) - before;
            int take = room < 0 ? 0 : (room > (int)ca ? (int)ca : room);
            unsigned long long keep = 0ull;
            while (__any(take > 0)) { if (take > 0) { const unsigned long long low = alive & (0ull - alive); keep |= low; alive ^= low; --take; } }
            alive = keep;
        }
        selm = (((unsigned long long)gh << 32) | gl) | alive;
    }
#if USE_LIST
    if (t >= 256) {
        LAS unsigned short* lb = (LAS unsigned short*)(C.lds + MISC_OFF + 1024) + (C.wave & 3) * 256;
        unsigned w0 = (unsigned)selm, w1 = (unsigned)(selm >> 32);
        const int c = __popc(w0) + __popc(w1); const int incl = wave_incl_scan_i(c, lane); int pos = incl - c;
        while (w0) { const int bit = __ffs(w0) - 1; w0 &= w0 - 1; if (pos < 256) lb[pos] = (unsigned short)(64 * lane + bit); ++pos; }
        while (w1) { const int bit = __ffs(w1) - 1; w1 &= w1 - 1; if (pos < 256) lb[pos] = (unsigned short)(64 * lane + 32 + bit); ++pos; }
        asm volatile("" ::: "memory");
        const v2u e = *(const LAS v2u*)(lb + 4 * lane);
        *(v2u*)((unsigned short*)SEL + (size_t)(b * SEQ + t) * 256 + 4 * lane) = e;
        asm volatile("" ::: "memory");
    }
#else
    if (64 * lane <= t) *(unsigned long long*)(SEL + (size_t)(b * SEQ + t) * 128 + 2 * lane) = selm;
#endif
}

__device__ __forceinline__ void ph_dsa_b2_wave(Ctx& C, int b, int t4) {
    const bf16* PROJ = (const bf16*)(C.ws + WS_P); const unsigned* SEL = (const unsigned*)(C.ws + WS_SEL); bf16* YM = (bf16*)(C.ws + WS_H);
    const bf16* KFA = (const bf16*)(C.ws + WS_KFA); const bf16* VF = (const bf16*)(C.ws + WS_VF);
    const int lane = C.lane, n = lane & 31, h = lane >> 5, tl = n >> 3, hd = n & 7;
    const int ntile = ((t4 + 3) >> 5) + 1;
    const size_t qrow = (size_t)b * SEQ + t4 + tl;
    bf16x8 qf[5];
    {
        const bf16* qp = PROJ + qrow * PW + C_AQ + hd * 64 + 8 * h;
#pragma unroll
        for (int ks = 0; ks < 4; ++ks) {
            const v4u q4 = *(const v4u*)(qp + 16 * ks); const unsigned qw[4] = {q4.x, q4.y, q4.z, q4.w}; v4u o;
            unsigned ow[4];
#pragma unroll
            for (int x = 0; x < 4; ++x) ow[x] = pk2(bf2f(qw[x] & 0xffffu) * (0.125f * LOG2E), bf2f(qw[x] >> 16) * (0.125f * LOG2E));
            o.x = ow[0]; o.y = ow[1]; o.z = ow[2]; o.w = ow[3]; qf[ks] = __builtin_bit_cast(bf16x8, o);
        }
        const unsigned one = 0x3f80u, sl = f2bf(exp2f(-(float)(hd + 1)));
        v4u e; e.x = (tl == 0 ? one : 0u) | ((tl == 1 ? one : 0u) << 16); e.y = (tl == 2 ? one : 0u) | ((tl == 3 ? one : 0u) << 16); e.z = sl | (sl << 16); e.w = sl;
        if (h) { e.x = 0u; e.y = 0u; e.z = 0u; e.w = 0u; }
        qf[4] = __builtin_bit_cast(bf16x8, e);
    }
    f32x16 O0, O1;
#pragma unroll
    for (int x = 0; x < 16; ++x) { O0[x] = 0.f; O1[x] = 0.f; }
    float m = -3.0e38f, lsum = 0.f;
    const unsigned NEGB = 0xf149u;
    const bf16* kb = KFA + (size_t)(b * 128) * 2048 + lane * 8; const bf16* vb = VF + (size_t)(b * 128) * 2048 + lane * 8;
    const unsigned* selp = SEL + ((size_t)b * SEQ + t4 + (lane & 3)) * 128;
    bf16x8 kc[4], vc[4]; unsigned wc_;
#pragma unroll
    for (int ks = 0; ks < 4; ++ks) { kc[ks] = *(const bf16x8*)(kb + ks * 512); vc[ks] = *(const bf16x8*)(vb + ks * 512); }
    wc_ = selp[0];
    for (int tile = 0; tile < ntile; ++tile) {
        bf16x8 kn[4], vn[4]; unsigned wn = 0u;
        const int tn = (tile + 1 < ntile) ? tile + 1 : tile;
#pragma unroll
        for (int ks = 0; ks < 4; ++ks) { kn[ks] = *(const bf16x8*)(kb + (size_t)tn * 2048 + ks * 512); vn[ks] = *(const bf16x8*)(vb + (size_t)tn * 2048 + ks * 512); }
        wn = selp[tn];
        bf16x8 kx;
        {
            const unsigned w0 = (unsigned)__builtin_amdgcn_readlane((int)wc_, 0), w1 = (unsigned)__builtin_amdgcn_readlane((int)wc_, 1), w2 = (unsigned)__builtin_amdgcn_readlane((int)wc_, 2), w3 = (unsigned)__builtin_amdgcn_readlane((int)wc_, 3);
            const unsigned m0 = ((w0 >> n) & 1u) ? 0u : NEGB, m1 = ((w1 >> n) & 1u) ? 0u : NEGB, m2 = ((w2 >> n) & 1u) ? 0u : NEGB, m3 = ((w3 >> n) & 1u) ? 0u : NEGB;
            const float cs = LOG2E * (float)(tile * 32 + n);
            const unsigned c1 = f2bf(cs); const float r1 = cs - bf2f(c1); const unsigned c2 = f2bf(r1); const float r2 = r1 - bf2f(c2); const unsigned c3 = f2bf(r2);
            v4u e; e.x = m0 | (m1 << 16); e.y = m2 | (m3 << 16); e.z = c1 | (c2 << 16); e.w = c3;
            if (h) { e.x = 0u; e.y = 0u; e.z = 0u; e.w = 0u; }
            kx = __builtin_bit_cast(bf16x8, e);
        }
        f32x16 S;
#pragma unroll
        for (int x = 0; x < 16; ++x) S[x] = 0.f;
#pragma unroll
        for (int ks = 0; ks < 4; ++ks) S = mfma32(kc[ks], qf[ks], S);
        S = mfma32(kx, qf[4], S);
        float mloc = S[0];
#pragma unroll
        for (int x = 1; x < 16; ++x) mloc = fmaxf(mloc, S[x]);
        mloc = fmaxf(mloc, __shfl_xor(mloc, 32));
        const float mnew = fmaxf(m, mloc), alpha = __builtin_amdgcn_exp2f(m - mnew);
        m = mnew;
        float ps = 0.f;
#pragma unroll
        for (int x = 0; x < 16; ++x) { S[x] = __builtin_amdgcn_exp2f(S[x] - mnew); ps += S[x]; }
        lsum = lsum * alpha + ps;
#pragma unroll
        for (int x = 0; x < 16; ++x) { O0[x] *= alpha; O1[x] *= alpha; }
        v4u p0, p1;
        p0.x = pk2(S[0], S[1]); p0.y = pk2(S[2], S[3]); p0.z = pk2(S[4], S[5]); p0.w = pk2(S[6], S[7]);
        p1.x = pk2(S[8], S[9]); p1.y = pk2(S[10], S[11]); p1.z = pk2(S[12], S[13]); p1.w = pk2(S[14], S[15]);
        const bf16x8 pf0 = __builtin_bit_cast(bf16x8, p0), pf1 = __builtin_bit_cast(bf16x8, p1);
        O0 = mfma32(vc[0], pf0, O0); O1 = mfma32(vc[1], pf0, O1);
        O0 = mfma32(vc[2], pf1, O0); O1 = mfma32(vc[3], pf1, O1);
#pragma unroll
        for (int ks = 0; ks < 4; ++ks) { kc[ks] = kn[ks]; vc[ks] = vn[ks]; }
        wc_ = wn;
    }
    const float inv = 1.f / (lsum + __shfl_xor(lsum, 32));
    bf16* yo = YM + qrow * DM + hd * 64 + 4 * h;
#pragma unroll
    for (int j4 = 0; j4 < 4; ++j4) {
        v2u o; o.x = pk2(O0[4 * j4] * inv, O0[4 * j4 + 1] * inv); o.y = pk2(O0[4 * j4 + 2] * inv, O0[4 * j4 + 3] * inv);
        *(v2u*)(yo + 8 * j4) = o;
        v2u o2; o2.x = pk2(O1[4 * j4] * inv, O1[4 * j4 + 1] * inv); o2.y = pk2(O1[4 * j4 + 2] * inv, O1[4 * j4 + 3] * inv);
        *(v2u*)(yo + 32 + 8 * j4) = o2;
    }
}

__device__ __forceinline__ f32x4 mfma16(bf16x8 a, bf16x8 b, f32x4 c) { return __builtin_amdgcn_mfma_f32_16x16x32_bf16(a, b, c, 0, 0, 0); }
constexpr int B3_VS_PITCH = 144;
constexpr int B3_WAVE_LDS = 640 + 32 * B3_VS_PITCH;
#ifdef PROBE_HOT
#define B3_SKIP(bit) ((PROBE_SKIP & (bit)) && C.hot != 0xffff)
#define B3_HOTMASK C.hot
#else
#define B3_SKIP(bit) false
#define B3_HOTMASK 0xffff
#endif
template <bool FULL>
__device__ __forceinline__ void b3_core(Ctx& C, int b, int t, int nsel, const v4u qc0, const v4u qc1, LAS unsigned short* lst, LAS unsigned char* vs) {
    const bf16* PROJ = (const bf16*)(C.ws + WS_P); bf16* YM = (bf16*)C.out;
    const int lane = C.lane, m16 = lane & 15, g = lane >> 4;
    const size_t row = (size_t)b * SEQ + t;
    const int nt16 = FULL ? 16 : (nsel + 15) >> 4, nk32 = FULL ? 8 : (nsel + 31) >> 5;
    const bf16* vbase = PROJ + (size_t)b * SEQ * PW + C_AV + 8 * (lane & 7); const bf16* kbase = PROJ + (size_t)b * SEQ * PW + C_AK + 8 * g;
    v4u vb[3][4];
#pragma unroll
    for (int i = 0; i < 4; ++i) { const int s = (int)lst[8 * i + (lane >> 3)] & B3_HOTMASK; vb[0][i] = *(const v4u*)(vbase + (size_t)s * PW); }
    bf16x8 qf[2];
#pragma unroll
    for (int ks = 0; ks < 2; ++ks) {
        const v4u q4 = ks ? qc1 : qc0; const unsigned qw[4] = {q4.x, q4.y, q4.z, q4.w}; unsigned ow[4];
#pragma unroll
        for (int x = 0; x < 4; ++x) ow[x] = (m16 < 8) ? pk2(bf2f(qw[x] & 0xffffu) * (0.125f * LOG2E), bf2f(qw[x] >> 16) * (0.125f * LOG2E)) : 0u;
        v4u o; o.x = ow[0]; o.y = ow[1]; o.z = ow[2]; o.w = ow[3]; qf[ks] = __builtin_bit_cast(bf16x8, o);
    }
    const float sl2 = exp2f(-(float)((m16 & 7) + 1)) * LOG2E, tf = (float)t;
    f32x4 lg[16];
    bf16x8 a0[2][4], a1[2][4];
#define B3_GATHER(buf, hf_) { _Pragma("unroll") for (int i = 0; i < 4; ++i) { const int sm_k = ((FULL || 4 * (hf_) + i < nt16) ? (int)lst[16 * (4 * (hf_) + i) + m16] : 0) & B3_HOTMASK; \
        const bf16* kp = kbase + (size_t)sm_k * PW; a0[buf][i] = *(const bf16x8*)kp; a1[buf][i] = *(const bf16x8*)(kp + 32); } }
    if (!B3_SKIP(4)) { B3_GATHER(0, 0) B3_GATHER(1, 1) }
#pragma unroll
    for (int kt = 0; kt < 16; ++kt) {
        if (FULL || kt < nt16) {
            const v2u p4 = *(const LAS v2u*)(lst + 16 * kt + 4 * g);
            const float sr[4] = {(float)(p4.x & 0xffffu), (float)(p4.x >> 16), (float)(p4.y & 0xffffu), (float)(p4.y >> 16)};
#pragma unroll
            for (int r = 0; r < 4; ++r) lg[kt][r] = (FULL || 16 * kt + 4 * g + r < nsel) ? sl2 * (sr[r] - tf) : -3.0e38f;
        } else lg[kt] = (f32x4){-3.0e38f, -3.0e38f, -3.0e38f, -3.0e38f};
    }
#pragma unroll
    for (int hf = 0; hf < 4; ++hf) {
        if (!B3_SKIP(2)) {
#pragma unroll
            for (int i = 0; i < 4; ++i) if (FULL || 4 * hf + i < nt16) lg[4 * hf + i] = mfma16(a0[hf & 1][i], qf[0], lg[4 * hf + i]);
#pragma unroll
            for (int i = 0; i < 4; ++i) if (FULL || 4 * hf + i < nt16) lg[4 * hf + i] = mfma16(a1[hf & 1][i], qf[1], lg[4 * hf + i]);
        }
        if (!B3_SKIP(4)) { if (hf == 0) B3_GATHER(0, 2) if (hf == 1) B3_GATHER(1, 3) }
    }
    float mx;
    {
        float m0 = -3.0e38f, m1 = -3.0e38f, m2 = -3.0e38f, m3 = -3.0e38f;
#pragma unroll
        for (int kt = 0; kt < 16; ++kt) { m0 = fmaxf(m0, lg[kt][0]); m1 = fmaxf(m1, lg[kt][1]); m2 = fmaxf(m2, lg[kt][2]); m3 = fmaxf(m3, lg[kt][3]); }
        mx = fmaxf(fmaxf(m0, m1), fmaxf(m2, m3));
    }
#undef B3_GATHER
#pragma unroll
    for (int d = 1; d < 3; ++d) if (FULL || d < nk32) {
#pragma unroll
        for (int i = 0; i < 4; ++i) { const int s = (int)lst[32 * d + 8 * i + (lane >> 3)] & B3_HOTMASK; vb[d][i] = *(const v4u*)(vbase + (size_t)s * PW); }
    }
    mx = fmaxf(mx, SHX_F(mx, 16, lane)); mx = fmaxf(mx, SHX_F(mx, 32, lane));
    float sm_;
    {
        float s0 = 0.f, s1 = 0.f, s2 = 0.f, s3 = 0.f;
#pragma unroll
        for (int kt = 0; kt < 16; ++kt) {
            if (FULL || kt < nt16) {
                const float p0 = __builtin_amdgcn_exp2f(lg[kt][0] - mx), p1 = __builtin_amdgcn_exp2f(lg[kt][1] - mx), p2 = __builtin_amdgcn_exp2f(lg[kt][2] - mx), p3 = __builtin_amdgcn_exp2f(lg[kt][3] - mx);
                lg[kt] = (f32x4){p0, p1, p2, p3}; s0 += p0; s1 += p1; s2 += p2; s3 += p3;
            } else lg[kt] = (f32x4){0.f, 0.f, 0.f, 0.f};
        }
        sm_ = (s0 + s1) + (s2 + s3);
    }
    sm_ += SHX_F(sm_, 16, lane); sm_ += SHX_F(sm_, 32, lane);
    const float inv = 1.f / sm_;
    v4u pbk[8];
#pragma unroll
    for (int kk = 0; kk < 8; ++kk) { pbk[kk].x = pk2(lg[2 * kk][0], lg[2 * kk][1]); pbk[kk].y = pk2(lg[2 * kk][2], lg[2 * kk][3]); pbk[kk].z = pk2(lg[2 * kk + 1][0], lg[2 * kk + 1][1]); pbk[kk].w = pk2(lg[2 * kk + 1][2], lg[2 * kk + 1][3]); }
    f32x4 O[4];
#pragma unroll
    for (int i = 0; i < 4; ++i) O[i] = (f32x4){0.f, 0.f, 0.f, 0.f};
#pragma unroll
    for (int kk = 0; kk < 8; ++kk) if ((FULL || kk < nk32) && !B3_SKIP(1)) {
#pragma unroll
        for (int i = 0; i < 4; ++i) *(LAS v4u*)(vs + (8 * i + (lane >> 3)) * B3_VS_PITCH + (lane & 7) * 16) = vb[kk % 3][i];
        if (kk >= 1 && kk + 2 < 8 && (FULL || kk + 2 < nk32)) {
#pragma unroll
            for (int i = 0; i < 4; ++i) { const int s = (int)lst[32 * (kk + 2) + 8 * i + (lane >> 3)] & B3_HOTMASK; vb[(kk + 2) % 3][i] = *(const v4u*)(vbase + (size_t)s * PW); }
        }
        asm volatile("s_waitcnt lgkmcnt(0)" ::: "memory");
        const bf16x8 pB = __builtin_bit_cast(bf16x8, pbk[kk]);
#pragma unroll
        for (int u = 0; u < 2; ++u) {
            unsigned w[8];
#pragma unroll
            for (int j = 0; j < 8; ++j) { const int sl = (j < 4) ? 4 * g + j : 16 + 4 * g + (j - 4); w[j] = *(const LAS unsigned*)(vs + sl * B3_VS_PITCH + (32 * u + 2 * m16) * 2); }
            v4u ae, ao;
            ae.x = (w[0] & 0xffffu) | (w[1] << 16); ae.y = (w[2] & 0xffffu) | (w[3] << 16); ae.z = (w[4] & 0xffffu) | (w[5] << 16); ae.w = (w[6] & 0xffffu) | (w[7] << 16);
            ao.x = (w[0] >> 16) | (w[1] & 0xffff0000u); ao.y = (w[2] >> 16) | (w[3] & 0xffff0000u); ao.z = (w[4] >> 16) | (w[5] & 0xffff0000u); ao.w = (w[6] >> 16) | (w[7] & 0xffff0000u);
            O[2 * u] = mfma16(__builtin_bit_cast(bf16x8, ae), pB, O[2 * u]); O[2 * u + 1] = mfma16(__builtin_bit_cast(bf16x8, ao), pB, O[2 * u + 1]);
        }
    }
    if (m16 < 8) {
#pragma unroll
        for (int u = 0; u < 2; ++u) {
            v4u o; o.x = pk2(O[2 * u][0] * inv, O[2 * u + 1][0] * inv); o.y = pk2(O[2 * u][1] * inv, O[2 * u + 1][1] * inv); o.z = pk2(O[2 * u][2] * inv, O[2 * u + 1][2] * inv); o.w = pk2(O[2 * u][3] * inv, O[2 * u + 1][3] * inv);
            *(v4u*)(YM + row * DM + m16 * 64 + 32 * u + 8 * g) = o;
        }
    }
}
__device__ __forceinline__ void ph_dsa_b3_wave(Ctx& C, int b, int t4) {
    LAS unsigned short* lst = (LAS unsigned short*)(C.lds + C.wave * B3_WAVE_LDS);
    LAS unsigned char* vs = C.lds + C.wave * B3_WAVE_LDS + 640;
    const bf16* PROJ = (const bf16*)(C.ws + WS_P); const unsigned* SEL = (const unsigned*)(C.ws + WS_SEL);
    const int lane = C.lane, m16 = lane & 15, g = lane >> 4;
#if USE_LIST
    v2u lqn; v4u qn0, qn1;
#define B3_PREFETCH(tq) { const size_t r_ = (size_t)b * SEQ + (tq); \
        lqn = ((tq) >= 256) ? *(const v2u*)((const unsigned short*)SEL + r_ * 256 + 4 * lane) : (v2u){0u, 0u}; \
        const bf16* qp_ = PROJ + r_ * PW + C_AQ + (m16 & 7) * 64 + 8 * g; qn0 = *(const v4u*)qp_; qn1 = *(const v4u*)(qp_ + 32); }
    B3_PREFETCH(t4)
#pragma unroll 1
    for (int qi = 0; qi < 4; ++qi) {
        const int t = t4 + qi;
        v2u lq = lqn;
        const v4u qc0 = qn0, qc1 = qn1;
        if (qi < 3) B3_PREFETCH(t + 1)
        const int nsel = t < 256 ? t + 1 : 256;
        if (t < 256) { const int i0 = 4 * lane; lq.x = (unsigned)(i0 <= t ? i0 : 0) | ((unsigned)(i0 + 1 <= t ? i0 + 1 : 0) << 16); lq.y = (unsigned)(i0 + 2 <= t ? i0 + 2 : 0) | ((unsigned)(i0 + 3 <= t ? i0 + 3 : 0) << 16); }
        *(LAS v2u*)(lst + 4 * lane) = lq;
        if (lane < 16) *(LAS unsigned*)(lst + 256 + 2 * lane) = 0u;
        asm volatile("s_waitcnt lgkmcnt(0)" ::: "memory");
        if (nsel == 256) b3_core<true>(C, b, t, nsel, qc0, qc1, lst, vs); else b3_core<false>(C, b, t, nsel, qc0, qc1, lst, vs);
    }
#undef B3_PREFETCH
#else
    unsigned w0n, w1n; v4u qn0, qn1;
#define B3_PREFETCH(tq) { const size_t r_ = (size_t)b * SEQ + (tq); const int nw_ = ((tq) >> 5) + 1; \
        w0n = (2 * lane < nw_) ? SEL[r_ * 128 + 2 * lane] : 0u; w1n = (2 * lane + 1 < nw_) ? SEL[r_ * 128 + 2 * lane + 1] : 0u; \
        const bf16* qp_ = PROJ + r_ * PW + C_AQ + (m16 & 7) * 64 + 8 * g; qn0 = *(const v4u*)qp_; qn1 = *(const v4u*)(qp_ + 32); }
    B3_PREFETCH(t4)
#pragma unroll 1
    for (int qi = 0; qi < 4; ++qi) {
        const int t = t4 + qi;
        unsigned w0 = w0n, w1 = w1n;
        const v4u qc0 = qn0, qc1 = qn1;
        if (qi < 3) B3_PREFETCH(t + 1)
        int nsel;
        {
            const int c = __popc(w0) + __popc(w1); const int incl = wave_incl_scan_i(c, lane);
            int pos = incl - c; const int tot = __builtin_amdgcn_readlane(incl, 63);
            while (w0) { const int bit = __ffs(w0) - 1; w0 &= w0 - 1; if (pos < 256) lst[pos] = (unsigned short)(64 * lane + bit); ++pos; }
            while (w1) { const int bit = __ffs(w1) - 1; w1 &= w1 - 1; if (pos < 256) lst[pos] = (unsigned short)(64 * lane + 32 + bit); ++pos; }
            nsel = tot < 256 ? tot : 256;
            if (lane < 32 && nsel + lane < 288) lst[nsel + lane] = 0;
        }
        asm volatile("s_waitcnt lgkmcnt(0)" ::: "memory");
        if (nsel == 256) b3_core<true>(C, b, t, nsel, qc0, qc1, lst, vs); else b3_core<false>(C, b, t, nsel, qc0, qc1, lst, vs);
    }
#undef B3_PREFETCH
#endif
}

namespace pg8 {
constexpr int BM = 256, BK = 64, HALF = 128, HTB = HALF * BK * 2, STAGE_BYTES = 8 * HTB, NXCD = 8, WGM = 8;
__host__ __device__ __forceinline__ int lds_byte(int r, int c) { const int st = (r >> 4) * 2 + (c >> 5), rr = r & 15, cc = c & 31, ob = rr * 64 + cc * 2; return st * 1024 + (ob ^ (((ob >> 9) & 1) << 5)); }
__host__ __device__ __forceinline__ void stage_rc(int b, int& R, int& C) { const int st = b / 1024, sb = b % 1024, swz = sb ^ (((sb >> 9) & 1) << 5); R = (st >> 1) * 16 + swz / 64; C = (st & 1) * 32 + (swz % 64) / 2; }
__host__ __device__ __forceinline__ int perm32(int rho) { const int n = rho >> 4, i = rho & 15; return 8 * (i >> 2) + 4 * n + (i & 3); }

struct Unit { int pm, pn, po, eb; };
struct Gemm { const bf16* A; const bf16* Bt; int K; size_t ebytes; };

struct Order {
    int nM, nN, nwg, G, c, p_lo, amode; const LAS unsigned char* pe;
    __device__ __forceinline__ void init(int nM_, int nN_, int G_, int c_, int p_lo_, int amode_, const LAS unsigned char* pe_) { nM = nM_; nN = nN_; nwg = nM * nN; G = G_; c = c_; p_lo = p_lo_; amode = amode_; pe = pe_; }
    __device__ __forceinline__ bool next(int i, Unit& u) const {
        const long L = (long)i * G + c; if (L >= nwg) return false;
        int wgid = (int)L; { const int q = nwg / NXCD, r = nwg % NXCD, xcd = wgid % NXCD, off = wgid / NXCD; wgid = (xcd < r ? xcd * (q + 1) : r * (q + 1) + (xcd - r) * q) + off; }
        const int nig = WGM * nN, gid = wgid / nig, fm = gid * WGM, gsz = (nM - fm) < WGM ? (nM - fm) : WGM;
        const int lp = fm + ((wgid % nig) % gsz), gp = p_lo + lp; u.pn = (wgid % nig) / gsz;
        u.pm = amode == 0 ? gp : lp; u.po = amode == 0 ? lp : gp; u.eb = pe ? __builtin_amdgcn_readfirstlane((int)pe[gp]) : 0; return true;
    }
};

__device__ __forceinline__ unsigned cvt_pk_bf16(float lo, float hi) { unsigned r; asm volatile("v_cvt_pk_bf16_f32 %0, %1, %2" : "=v"(r) : "v"(lo), "v"(hi)); return r; }
__device__ __forceinline__ float silu_fast(float g) { return g * __builtin_amdgcn_rcpf(1.f + __builtin_amdgcn_exp2f(-g * LOG2E)); }

struct EpiBf16 {
    static constexpr bool PERM = true;
    bf16* O; int ldc;
    __device__ __forceinline__ void operator()(const f32x4 (&acc)[2][2][4][2], const Unit& u, int wr, int wc, int fr, int fq) const {
        const int row0 = u.po * BM + wr * 64 + fr, col0 = u.pn * BM + wc * 32 + 8 * fq;
#pragma unroll
        for (int ai = 0; ai < 2; ++ai)
#pragma unroll
            for (int m = 0; m < 4; ++m) { bf16* rowp = O + (size_t)(row0 + ai * HALF + m * 16) * ldc + col0;
#pragma unroll
                for (int bj = 0; bj < 2; ++bj) { const f32x4 v0 = acc[ai][bj][m][0], v1 = acc[ai][bj][m][1];
                    v4u w; w.x = cvt_pk_bf16(v0[0], v0[1]); w.y = cvt_pk_bf16(v0[2], v0[3]); w.z = cvt_pk_bf16(v1[0], v1[1]); w.w = cvt_pk_bf16(v1[2], v1[3]);
                    *(v4u*)(rowp + bj * HALF) = w; } }
    }
};
struct EpiProj {
    static constexpr bool PERM = true;
    bf16* O; bf16* KFA; bf16* KFI; bf16* VF;
    __device__ __forceinline__ void operator()(const f32x4 (&acc)[2][2][4][2], const Unit& u, int wr, int wc, int fr, int fq) const {
        const int row0 = u.po * BM + wr * 64 + fr, col0 = u.pn * BM + wc * 32 + 8 * fq;
#pragma unroll
        for (int ai = 0; ai < 2; ++ai)
#pragma unroll
            for (int m = 0; m < 4; ++m) { const int row = row0 + ai * HALF + m * 16; bf16* rowp = O + (size_t)row * PW + col0;
#pragma unroll
                for (int bj = 0; bj < 2; ++bj) { const f32x4 v0 = acc[ai][bj][m][0], v1 = acc[ai][bj][m][1];
                    v4u w; w.x = cvt_pk_bf16(v0[0], v0[1]); w.y = cvt_pk_bf16(v0[2], v0[3]); w.z = cvt_pk_bf16(v1[0], v1[1]); w.w = cvt_pk_bf16(v1[2], v1[3]);
                    *(v4u*)(rowp + bj * HALF) = w;
                    if (u.pn == 10) {
                        if (wc < 2) {
                            const int dc = 4 * wc + fq;
                            bf16* kf = (bj == 0 ? KFA : KFI) + ((size_t)(row >> 5) * 4 + (dc >> 1)) * 512 + (32 * (dc & 1) + (row & 31)) * 8;
                            *(v4u*)kf = w;
                        } else if (bj == 0) {
                            const int kap = row & 31, mf = kap >> 4, k15 = kap & 15, hh = (k15 >> 2) & 1, j = (k15 & 3) + 4 * (k15 >> 3);
                            bf16* vf = VF + ((((size_t)(row >> 5) * 2 + mf) * 2 + (wc - 2)) * 64 + 32 * hh + 8 * fq) * 8 + j;
                            vf[0 * 8] = (bf16)(w.x & 0xffffu); vf[1 * 8] = (bf16)(w.x >> 16); vf[2 * 8] = (bf16)(w.y & 0xffffu); vf[3 * 8] = (bf16)(w.y >> 16);
                            vf[4 * 8] = (bf16)(w.z & 0xffffu); vf[5 * 8] = (bf16)(w.z >> 16); vf[6 * 8] = (bf16)(w.w & 0xffffu); vf[7 * 8] = (bf16)(w.w >> 16);
                        }
                    } } }
    }
};
struct EpiGate {
    static constexpr bool PERM = true;
    bf16* O; const float* gate;
    __device__ __forceinline__ void operator()(const f32x4 (&acc)[2][2][4][2], const Unit& u, int wr, int wc, int fr, int fq) const {
        const int row0 = u.po * BM + wr * 64 + fr, col0 = u.pn * BM + wc * 32 + 8 * fq;
#pragma unroll
        for (int ai = 0; ai < 2; ++ai)
#pragma unroll
            for (int m = 0; m < 4; ++m) { const int row = row0 + ai * HALF + m * 16; const float g = gate ? gate[row] : 1.f; bf16* rowp = O + (size_t)row * DM + col0;
#pragma unroll
                for (int bj = 0; bj < 2; ++bj) { const f32x4 v0 = acc[ai][bj][m][0] * g, v1 = acc[ai][bj][m][1] * g;
                    v4u w; w.x = cvt_pk_bf16(v0[0], v0[1]); w.y = cvt_pk_bf16(v0[2], v0[3]); w.z = cvt_pk_bf16(v1[0], v1[1]); w.w = cvt_pk_bf16(v1[2], v1[3]);
                    *(v4u*)(rowp + bj * HALF) = w; } }
    }
};
struct EpiSwiglu {
    static constexpr bool PERM = true;
    bf16* O;
    __device__ __forceinline__ void operator()(const f32x4 (&acc)[2][2][4][2], const Unit& u, int wr, int wc, int fr, int fq) const {
        const int row0 = u.po * BM + wr * 64 + fr, col0 = u.pn * HALF + wc * 32 + 8 * fq;
#pragma unroll
        for (int ai = 0; ai < 2; ++ai)
#pragma unroll
            for (int m = 0; m < 4; ++m) { bf16* rowp = O + (size_t)(row0 + ai * HALF + m * 16) * DFF + col0;
                const f32x4 g0 = acc[ai][0][m][0], g1 = acc[ai][0][m][1], u0 = acc[ai][1][m][0], u1 = acc[ai][1][m][1];
                v4u w; w.x = cvt_pk_bf16(silu_fast(g0[0]) * u0[0], silu_fast(g0[1]) * u0[1]); w.y = cvt_pk_bf16(silu_fast(g0[2]) * u0[2], silu_fast(g0[3]) * u0[3]);
                w.z = cvt_pk_bf16(silu_fast(g1[0]) * u1[0], silu_fast(g1[1]) * u1[1]); w.w = cvt_pk_bf16(silu_fast(g1[2]) * u1[2], silu_fast(g1[3]) * u1[3]);
                *(v4u*)rowp = w; }
    }
};

template <class Epi, class Sched>
__device__ __forceinline__ void gemm_phase(LAS unsigned char* lds, const int tid, const Gemm g, const Sched& S, const Epi& E) {
    const int wid = __builtin_amdgcn_readfirstlane(tid >> 6), lane = tid & 63, wr = wid >> 2, wc = wid & 3, fr = lane & 15, fq = lane >> 4;
    const int K = g.K, nt = K / BK;
    unsigned voffA[2], voffB[2];
#pragma unroll
    for (int i = 0; i < 2; ++i) { int R, C; stage_rc(tid * 16 + i * 8192, R, C); const int Rb = Epi::PERM ? ((R & ~31) + perm32(R & 31)) : R; voffA[i] = (unsigned)(R * K + C) * 2u; voffB[i] = (unsigned)(Rb * K + C) * 2u; }
    const size_t kstep = (size_t)(BK * 2);
    const size_t hstep = (size_t)HALF * K * 2;
    const size_t tstep = 2 * hstep;
    const unsigned ldsw = (unsigned)wid * 1024u;
    const int aoff = lds_byte(wr * 64 + fr, fq * 8), boff = lds_byte(wc * 32 + fr, fq * 8);
#define PG8_SA(b, h) (((b) * 2 + (h)) * HTB)
#define PG8_SB(b, h) ((4 + (b) * 2 + (h)) * HTB)
#define PG8_STAGE(bufoff, gbase, voff) do { _Pragma("unroll") for (int _i = 0; _i < 2; ++_i) \
        __builtin_amdgcn_global_load_lds((const unsigned*)((const char*)(gbase) + (voff)[_i]), (LAS unsigned*)(lds + (bufoff) + ldsw + _i * 8192), 16, 0, 0); } while (0)
#define PG8_LDA(dst, b, h) do { _Pragma("unroll") for (int m = 0; m < 4; ++m) _Pragma("unroll") for (int k = 0; k < 2; ++k) dst[m][k] = *(const LAS bf16x8*)(lds + PG8_SA(b, h) + aoff + m * 2048 + k * 1024); } while (0)
#define PG8_LDB(dst, b, h) do { _Pragma("unroll") for (int n = 0; n < 2; ++n) _Pragma("unroll") for (int k = 0; k < 2; ++k) dst[n][k] = *(const LAS bf16x8*)(lds + PG8_SB(b, h) + boff + n * 2048 + k * 1024); } while (0)
#define PG8_MMA(ai, bj, At, Bt) do { __builtin_amdgcn_s_setprio(1); _Pragma("unroll") for (int m = 0; m < 4; ++m) _Pragma("unroll") for (int n = 0; n < 2; ++n) _Pragma("unroll") for (int k = 0; k < 2; ++k) \
        acc[ai][bj][m][n] = __builtin_amdgcn_mfma_f32_16x16x32_bf16(Bt[n][k], At[m][k], acc[ai][bj][m][n], 0, 0, 0); __builtin_amdgcn_s_setprio(0); } while (0)
#define PG8_WAIT_V(n) asm volatile("s_waitcnt vmcnt(" #n ")" ::: "memory")
#define PG8_WAIT_L(n) asm volatile("s_waitcnt lgkmcnt(" #n ")" ::: "memory")
#define PG8_BAR __builtin_amdgcn_s_barrier()
#define PG8_SCHED __builtin_amdgcn_sched_barrier(0)
    Unit cur, nxt; int ui = 0;
    if (!S.next(0, cur)) return;
    f32x4 acc[2][2][4][2];
#pragma unroll
    for (int a = 0; a < 2; ++a)
#pragma unroll
        for (int b = 0; b < 2; ++b)
#pragma unroll
            for (int m = 0; m < 4; ++m)
#pragma unroll
                for (int n = 0; n < 2; ++n) acc[a][b][m][n] = (f32x4){0.f, 0.f, 0.f, 0.f};
    bf16x8 At[4][2], B0[2][2], B1[2][2];
    const char* cA = (const char*)g.A + (size_t)cur.pm * tstep;
    const char* cB = (const char*)g.Bt + (size_t)cur.eb * g.ebytes + (size_t)cur.pn * tstep;
    PG8_STAGE(PG8_SB(0, 0), cB, voffB); PG8_STAGE(PG8_SB(0, 1), cB + hstep, voffB); PG8_STAGE(PG8_SA(0, 0), cA, voffA); PG8_STAGE(PG8_SA(0, 1), cA + hstep, voffA);
    if (wr == 1) PG8_BAR;
    PG8_WAIT_V(2); PG8_BAR;
    PG8_STAGE(PG8_SB(1, 0), cB + kstep, voffB); PG8_STAGE(PG8_SA(1, 0), cA + kstep, voffA); PG8_STAGE(PG8_SB(1, 1), cB + hstep + kstep, voffB);
    PG8_WAIT_V(6); PG8_BAR;
    for (;;) {
        const bool has_next = S.next(ui + 1, nxt);
        const char* nA = has_next ? (const char*)g.A + (size_t)nxt.pm * tstep : cA;
        const char* nB = has_next ? (const char*)g.Bt + (size_t)nxt.eb * g.ebytes + (size_t)nxt.pn * tstep : cB;
#define PG8_PAIR(a1, a2, b2, a3, b3) do { \
              \
            PG8_LDB(B0, 0, 0); PG8_LDB(B1, 0, 1); PG8_SCHED; PG8_LDA(At, 0, 0); PG8_STAGE(PG8_SA(1, 1), (a1) + hstep, voffA); \
            PG8_WAIT_V(8); PG8_WAIT_L(0); PG8_BAR; PG8_MMA(0, 0, At, B0); PG8_MMA(0, 1, At, B1); PG8_BAR; PG8_SCHED; \
              \
            PG8_LDA(At, 0, 1); PG8_STAGE(PG8_SB(0, 0), b2, voffB); PG8_STAGE(PG8_SB(0, 1), (b2) + hstep, voffB); PG8_STAGE(PG8_SA(0, 0), a2, voffA); \
            PG8_WAIT_V(8); PG8_WAIT_L(0); PG8_BAR; PG8_MMA(1, 0, At, B0); PG8_MMA(1, 1, At, B1); PG8_BAR; PG8_SCHED; \
              \
            PG8_LDB(B0, 1, 0); PG8_LDB(B1, 1, 1); PG8_SCHED; PG8_LDA(At, 1, 0); PG8_STAGE(PG8_SA(0, 1), (a2) + hstep, voffA); \
            PG8_WAIT_V(8); PG8_WAIT_L(0); PG8_BAR; PG8_MMA(0, 0, At, B0); PG8_MMA(0, 1, At, B1); PG8_BAR; PG8_SCHED; \
              \
            PG8_LDA(At, 1, 1); PG8_STAGE(PG8_SB(1, 0), b3, voffB); PG8_STAGE(PG8_SB(1, 1), (b3) + hstep, voffB); PG8_STAGE(PG8_SA(1, 0), a3, voffA); \
            PG8_WAIT_V(8); PG8_WAIT_L(0); PG8_BAR; PG8_MMA(1, 0, At, B0); PG8_MMA(1, 1, At, B1); PG8_BAR; PG8_SCHED; } while (0)
        for (int t = 0; t < nt; t += 2) {
            const bool last = (t == nt - 2);
            const char* a1 = cA + (size_t)(t + 1) * kstep;
            const char* a2 = last ? nA : cA + (size_t)(t + 2) * kstep; const char* b2 = last ? nB : cB + (size_t)(t + 2) * kstep;
            const char* a3 = a2 + kstep; const char* b3 = b2 + kstep;
            PG8_PAIR(a1, a2, b2, a3, b3);
        }
#undef PG8_PAIR
        if (wr == 0) PG8_BAR;
        E(acc, cur, wr, wc, fr, fq);
        if (!has_next) break;
#pragma unroll
        for (int a = 0; a < 2; ++a)
#pragma unroll
            for (int b = 0; b < 2; ++b)
#pragma unroll
                for (int m = 0; m < 4; ++m)
#pragma unroll
                    for (int n = 0; n < 2; ++n) acc[a][b][m][n] = (f32x4){0.f, 0.f, 0.f, 0.f};
        cur = nxt; cA = nA; cB = nB; ++ui;
        if (wr == 1) PG8_BAR;
    }
    PG8_WAIT_V(0);
    PG8_BAR;
#undef PG8_SA
#undef PG8_SB
#undef PG8_STAGE
#undef PG8_LDA
#undef PG8_LDB
#undef PG8_MMA
#undef PG8_WAIT_V
#undef PG8_WAIT_L
#undef PG8_BAR
#undef PG8_SCHED
}
}

constexpr int N_STEPS = 2 + 2 * (7 + 2 * NPASS_DENSE) + 2 * (8 + 2 * NPASS_MOE);
#ifndef REP_A
#define REP_A 1
#define REP_B 1
#endif
#ifndef PROBE_ID
#define PROBE_ID 0
#endif
#ifndef REP_BAR
#define REP_BAR 1
#endif
#ifndef REP_C
#define REP_C 1
#endif
#ifndef REP_L
#define REP_L 1
#endif
#ifndef REP_G
#define REP_G 1
#endif
#ifndef USE_B3
#define USE_B3 1
#endif
#ifndef USE_B2
#define USE_B2 1
#define USE_A2 1
#endif
#ifndef USE_PG8
#define USE_PG8 1
#endif
#ifndef USE_A4
#define USE_A4 1
#endif

__global__ void __launch_bounds__(512, 2) hybrid_fwd(Args args) {
    extern __shared__ __attribute__((aligned(16))) unsigned char lds_raw[];
    Ctx C;
    C.lds = (LAS unsigned char*)lds_raw;
    C.MISC = (volatile LAS unsigned*)(C.lds + MISC_OFF);
    C.tid = threadIdx.x; C.lane = C.tid & 63; C.wave = __builtin_amdgcn_readfirstlane(C.tid >> 6);
    C.G = gridDim.x; C.bid = blockIdx.x; C.hot = 0xffff;
    C.ka = (KArgs*)__builtin_amdgcn_kernarg_segment_ptr();
    C.out = args.out; C.ws = args.ws; C.ctl = (unsigned*)(args.ws + WS_CTL);
    if (C.tid < 32) C.MISC[C.tid] = 0u;
    __syncthreads();
    if (!MK_MULTI) (void)xcd_barrier_post(C.ctl + CW_BAR, C.MISC + 8);
    int step = 0;
    const int wave_s = __builtin_amdgcn_readfirstlane((int)threadIdx.x >> 6);
#define STEP_BEGIN if (step >= C.ka->lo && step < C.ka->hi) { { unsigned m_ = ~0u; asm volatile("" : "+s"(m_)); const int ln_ = (int)__builtin_amdgcn_mbcnt_hi(m_, __builtin_amdgcn_mbcnt_lo(m_, 0u)); \
        int t_ = wave_s * 64 + ln_; asm volatile("" : "+v"(t_)); C.tid = t_; C.lane = t_ & 63; C.wave = wave_s; \
        KArgs* k_ = (KArgs*)__builtin_amdgcn_kernarg_segment_ptr(); asm volatile("" : "+s"(k_)); C.ka = k_; C.ws = k_->ws; C.out = k_->out; C.ctl = (unsigned*)(k_->ws + WS_CTL); C.G = gridDim.x; C.bid = blockIdx.x; }
#define STEP_END } if (!MK_MULTI && step >= C.ka->lo && step + 1 < C.ka->hi) { XcdBarrier b_; b_.bar = (unsigned*)(C.ka->ws + WS_CTL) + CW_BAR; b_.x = xb_xcc_id(); b_.st = C.MISC + 8; xcd_barrier(b_); if (REP_BAR > 1) xcd_barrier(b_); } ++step;
#define WSP(T, off) ((T*)(C.ws + (off)))
#define RELAUNDER { int t_ = C.tid; asm volatile("" : "+v"(t_)); C.tid = t_; C.lane = t_ & 63; C.wave = __builtin_amdgcn_readfirstlane(t_ >> 6); }

    STEP_BEGIN
        ph_mod(C); __syncthreads(); ph_conv(C, 0);
#if REP_C > 1
        __syncthreads(); ph_mod(C); __syncthreads(); ph_conv(C, 0);
#endif
    STEP_END
    STEP_BEGIN
        ph_modulate0(C);
#if PROBE_ID == 8
        RELAUNDER ph_modulate0(C); RELAUNDER ph_modulate0(C); RELAUNDER ph_modulate0(C); RELAUNDER ph_modulate0(C);
#endif
    STEP_END

    for (int l = 0; l < DEPTH; ++l) {
        STEP_BEGIN
#if USE_PG8
            { const pg8::Gemm g{WSP(bf16, WS_H), WSP(bf16, WS_WIN), DM, 0}; pg8::Order S; S.init(256, 11, C.G, C.bid, 0, 0, nullptr);
              pg8::gemm_phase(C.lds, C.tid, g, S, pg8::EpiProj{WSP(bf16, WS_P), WSP(bf16, WS_KFA), WSP(bf16, WS_KFI), WSP(bf16, WS_VF)});
#if PROBE_ID == 5
              RELAUNDER pg8::gemm_phase(C.lds, C.tid, g, S, pg8::EpiProj{WSP(bf16, WS_P), WSP(bf16, WS_KFA), WSP(bf16, WS_KFI), WSP(bf16, WS_VF)});
#endif
            }
#else
            for (int u = C.bid; u < 256 * 11; u += C.G) {
                const int pm = u / 11, pn = u % 11; const GUnit gu{pm * 256, pm * 256, pn, 0};
                gemm_simple_unit<0>(C, WSP(bf16, WS_H), DM, nullptr, WSP(bf16, WS_WIN), DM, gu, EpiStoreS{WSP(bf16, WS_P), PW});
            }
#endif
        STEP_END
        STEP_BEGIN
#pragma unroll 1
#if USE_A4
            for (int rp_ = 0; rp_ < (PROBE_ID == 1 ? 2 : 1); ++rp_) {
#ifdef PROBE_HOT
                C.hot = (PROBE_ID == 1 && rp_ == 0) ? PROBE_HOT : 0xffff;
#endif
#ifdef PROBE_SKIP
#define A4_SKIPM ((PROBE_ID == 1 && rp_ == 0) ? PROBE_SKIP : 0)
#else
#define A4_SKIPM 0
#endif
#define A4_MAP(idx_) const int b = (idx_) & 15, r_ = (idx_) >> 4, j_ = (r_ & 15) + 16 * (r_ >> 5), t0 = 4 * (((r_ >> 4) & 1) ? 1023 - j_ : j_);
                LAS unsigned* img = (LAS unsigned*)C.lds;
                const int nun = (C.bid < 16384) ? (16384 - C.bid + C.G - 1) / C.G : 0;
                if (C.wave < 4) {
                    A4S S;
                    { A4_MAP(C.bid < 16384 ? C.bid : 0) a4_prefetch(C, S, b, t0); }
#pragma unroll 1
                    for (int k = 0; k < nun; ++k) { RELAUNDER
                        { const int nidx = (k + 1 < nun) ? C.bid + (k + 1) * C.G : C.bid; const int nb = nidx & 15, nr_ = nidx >> 4, nj_ = (nr_ & 15) + 16 * (nr_ >> 5), nt0 = 4 * (((nr_ >> 4) & 1) ? 1023 - nj_ : nj_);
                          A4_MAP(C.bid + k * C.G) a4_score(C, S, img + (k & 1) * A4_BUF, b, t0, nb, nt0); }
                        __syncthreads(); }
                } else {
#pragma unroll 1
                    for (int k = 0; k < nun; ++k) { __syncthreads(); RELAUNDER A4_MAP(C.bid + k * C.G) const int q = C.wave - 4; if (!(A4_SKIPM & 32)) a4_select(C, img + (k & 1) * A4_BUF + q * A3_QP, b, t0 + q); }
                }
                __syncthreads();
#undef A4_MAP
            }
#else
            for (int rp_ = 0; rp_ < (PROBE_ID == 1 ? 2 : 1); ++rp_)
            for (int idx = C.bid; idx < 8192; idx += C.G) {
                RELAUNDER
                const int b = idx & 15, r = idx >> 4, j = (r & 15) + 16 * (r >> 5), qb = ((r >> 4) & 1) ? 511 - j : j;
                A3Q qa; a3_load_q(C, b, qb * 8, qa);
                ph_dsa_a3_unit(C, b, qb * 8, qa, false, 0, 0);
            }
#endif
#pragma unroll 1
            for (int rp_ = 0; rp_ < (PROBE_ID == 3 ? 2 : 1); ++rp_)
            for (int u = C.bid; u < 4096; u += C.G) { RELAUNDER ph_gla1_unit(C, l, u); }
        STEP_END
        STEP_BEGIN
            ph_gla2(C);
#if PROBE_ID == 9
            RELAUNDER ph_gla2(C, (size_t)66 * MiB); RELAUNDER ph_gla2(C, (size_t)66 * MiB);
#endif
        STEP_END
        STEP_BEGIN
#pragma unroll 1
            for (int rp_ = 0; rp_ < (PROBE_ID == 4 ? 2 : 1); ++rp_)
            for (int u = C.bid; u < 4096; u += C.G) { RELAUNDER ph_gla3_unit(C, l, u); }
#if USE_B2
#pragma unroll 1
            for (int rep = 0; rep < (PROBE_ID == 2 ? 2 : 1); ++rep)
#ifdef PROBE_HOT
            { C.hot = (PROBE_ID == 2 && rep == 0) ? PROBE_HOT : 0xffff;
#else
            {
#endif
            for (int idx = C.bid; idx < 2048; idx += C.G) {
                RELAUNDER
                const int b = idx & 15, r = idx >> 4, j = (r & 15) + 16 * (r >> 5), qb = ((r >> 4) & 1) ? 127 - j : j;
#if USE_B3
                ph_dsa_b3_wave(C, b, qb * 32 + C.wave * 4);
#else
                ph_dsa_b2_wave(C, b, qb * 32 + C.wave * 4);
#endif
            }
            }
#else
            for (int u = C.bid; u < 8192; u += C.G) { RELAUNDER ph_dsa_b_unit(C, u & 15, (u >> 4) * 8); }
#endif
        STEP_END
        STEP_BEGIN
#if USE_PG8
            { const pg8::Gemm g{(const bf16*)C.out, WSP(bf16, WS_WOUT), DM, 0}; pg8::Order S; S.init(256, 4, C.G, C.bid, 0, 0, nullptr);
              pg8::gemm_phase(C.lds, C.tid, g, S, pg8::EpiBf16{WSP(bf16, WS_Y), DM});
#if PROBE_ID == 6
              RELAUNDER pg8::gemm_phase(C.lds, C.tid, g, S, pg8::EpiBf16{WSP(bf16, WS_Y), DM});
#endif
            }
#else
            for (int u = C.bid; u < 256 * 4; u += C.G) {
                const int pm = u >> 2, pn = u & 3; const GUnit gu{pm * 256, pm * 256, pn, 0};
                gemm_simple_unit<0>(C, WSP(bf16, WS_H), DM, nullptr, WSP(bf16, WS_WOUT), DM, gu, EpiStoreS{WSP(bf16, WS_Y), DM});
            }
#endif
        STEP_END
        STEP_BEGIN
            const float* Xin = C.in(I_X);
            if (l == 0) ph_ln<false, 0, 0>(C, Xin, l, 0, 2048, l, 3072, true, 0, 0, false);
            else if (l & 1) ph_ln<true, 0, 1>(C, Xin, l, 0, 2048, l, 3072, true, l >> 1, 0, false);
            else ph_ln<false, 0, 1>(C, Xin, l, 0, 2048, l, 3072, true, l >> 1, 0, false);
        STEP_END
        if (l & 1) {
            STEP_BEGIN
                ph_assign(C, l >> 1);
            STEP_END
        }
        for (int pass = 0; pass < ((l & 1) ? NPASS_MOE : NPASS_DENSE); ++pass) {
            STEP_BEGIN
                const bool moe = (l & 1) != 0;
                MoeTab tb; tb.npanels = 256;
#pragma unroll
                for (int e = 0; e < 8; ++e) tb.pend[e] = 65536;
                if (moe) tb = moe_tab(C, l >> 1);
                const int p_lo = pass * PASS_PANELS, p_hi = moe ? ((pass == NPASS_MOE - 1 || tb.npanels < p_lo + PASS_PANELS) ? tb.npanels : p_lo + PASS_PANELS) : p_lo + PASS_PANELS;
                const int npan = p_hi > p_lo ? p_hi - p_lo : 0;
#if USE_PG8
                LAS unsigned char* pe = C.lds + PE_OFF;
                for (int p = C.tid; p < 528; p += 512) pe[p] = (unsigned char)(moe ? panel_expert(tb, p) : 0);
                __syncthreads();
                { const pg8::Gemm g{moe ? WSP(bf16, WS_Y) : WSP(bf16, WS_H), WSP(bf16, WS_WGU), DM, (size_t)5632 * 1024 * 2}; pg8::Order S; S.init(npan, 22, C.G, C.bid, p_lo, 0, pe);
                  pg8::gemm_phase(C.lds, C.tid, g, S, pg8::EpiSwiglu{WSP(bf16, WS_P)});
#if REP_G > 1
                  RELAUNDER pg8::gemm_phase(C.lds, C.tid, g, S, pg8::EpiSwiglu{WSP(bf16, WS_P)});
#endif
                }
#else
                for (int u = C.bid; u < npan * 22; u += C.G) {
                    const int lp = u / 22, pn = u % 22, gp = p_lo + lp; const int e = moe ? panel_expert(tb, gp) : 0;
                    const GUnit gu{gp * 256, lp * 256, pn, (size_t)e * 5632 * 1024};
                    gemm_simple_unit<1>(C, moe ? WSP(bf16, WS_Y) : WSP(bf16, WS_H), DM, nullptr, WSP(bf16, WS_WGU), DM, gu, EpiSwigluS{WSP(bf16, WS_P)});
                }
#endif
            STEP_END
            STEP_BEGIN
                const bool moe = (l & 1) != 0;
                MoeTab tb; tb.npanels = 256;
#pragma unroll
                for (int e = 0; e < 8; ++e) tb.pend[e] = 65536;
                if (moe) tb = moe_tab(C, l >> 1);
                const int p_lo = pass * PASS_PANELS, p_hi = moe ? ((pass == NPASS_MOE - 1 || tb.npanels < p_lo + PASS_PANELS) ? tb.npanels : p_lo + PASS_PANELS) : p_lo + PASS_PANELS;
                const int npan = p_hi > p_lo ? p_hi - p_lo : 0;
#if USE_PG8
                LAS unsigned char* pe = C.lds + PE_OFF;
                for (int p = C.tid; p < 528; p += 512) pe[p] = (unsigned char)(moe ? panel_expert(tb, p) : 0);
                __syncthreads();
                { const pg8::Gemm g{WSP(bf16, WS_P), WSP(bf16, WS_WDN), DFF, (size_t)1024 * DFF * 2}; pg8::Order S; S.init(npan, 4, C.G, C.bid, p_lo, 1, pe);
                  pg8::gemm_phase(C.lds, C.tid, g, S, pg8::EpiGate{WSP(bf16, WS_Y), moe ? WSP(float, WS_ROWGATE) : nullptr});
#if PROBE_ID == 7
                  RELAUNDER pg8::gemm_phase(C.lds, C.tid, g, S, pg8::EpiGate{WSP(bf16, WS_Y), moe ? WSP(float, WS_ROWGATE) : nullptr});
#endif
                }
#else
                for (int u = C.bid; u < npan * 4; u += C.G) {
                    const int lp = u >> 2, pn = u & 3, gp = p_lo + lp; const int e = moe ? panel_expert(tb, gp) : 0;
                    const GUnit gu{lp * 256, gp * 256, pn, (size_t)e * 1024 * DFF};
                    if (moe) gemm_simple_unit<0>(C, WSP(bf16, WS_P), DFF, nullptr, WSP(bf16, WS_WDN), DFF, gu, EpiGateS{WSP(bf16, WS_Y), WSP(float, WS_ROWGATE)});
                    else gemm_simple_unit<0>(C, WSP(bf16, WS_P), DFF, nullptr, WSP(bf16, WS_WDN), DFF, gu, EpiStoreS{WSP(bf16, WS_Y), DM});
                }
#endif
            STEP_END
        }
        STEP_BEGIN
            const int l2 = l < 3 ? l + 1 : 3;
            if (l & 1) ph_ln<false, 1, 1>(C, nullptr, l, 1, 5120, l2, 0, l < 3, 0, 3072, l == 3); else ph_ln<false, 0, 1>(C, nullptr, l, 1, 5120, l2, 0, l < 3, 0, 3072, l == 3);
            if (l < 3) ph_conv(C, l + 1);
#if REP_C > 1
            if (l < 3) { RELAUNDER ph_conv(C, l + 1); }
#endif
        STEP_END
    }
#undef STEP_BEGIN
#undef STEP_END
#undef WSP
#undef RELAUNDER
}

#ifndef DUMP_HI
#define DUMP_HI 0
#define DUMP_OFF 0
#define DUMP_WORDS 1
#endif
#if DUMP_HI
__global__ void __launch_bounds__(256) copy_half_k(const unsigned* src, unsigned* dst) {
    for (size_t i = (size_t)blockIdx.x * 256 + threadIdx.x; i < (size_t)65536 * 256; i += (size_t)gridDim.x * 256) dst[i] = src[(i >> 8) * 512 + (i & 255)];
}
__global__ void __launch_bounds__(256) dump_k(const unsigned* src, size_t nwords, float* out) {
    const size_t N = (size_t)MTOK * DM;
    for (size_t i = (size_t)blockIdx.x * 256 + threadIdx.x; i < N; i += (size_t)gridDim.x * 256) {
        float v = 0.f;
        for (size_t k = i % nwords; k < nwords; k += N) { const unsigned w = src[k]; v += (float)((w ^ (w >> 13)) & 0xFFFu); }
        out[i] = v;
    }
}
#endif
extern "C" void kernel_launch(void* const* d_in, const int* in_sizes, int n_in, void* d_out, int out_size, void* d_ws, size_t ws_size, hipStream_t stream) {
    static int grid = 0;
    if (grid == 0) {
        if (n_in != 19 || in_sizes[0] != MTOK * DM || out_size != MTOK * DM || ws_size < WS_END) {
            fprintf(stderr, "kernel_launch: unexpected shapes (n_in %d, in0 %d, out %d, ws %zu); nothing launched\n", n_in, n_in > 0 ? in_sizes[0] : -1, out_size, ws_size); grid = -1; return; }
        int dev = 0, cus = 0, per_cu = 0;
        if (hipGetDevice(&dev) != hipSuccess || hipDeviceGetAttribute(&cus, hipDeviceAttributeMultiprocessorCount, dev) != hipSuccess) { grid = -1; return; }
        if (hipFuncSetAttribute((const void*)hybrid_fwd, hipFuncAttributeMaxDynamicSharedMemorySize, LDS_BYTES) != hipSuccess) { fprintf(stderr, "kernel_launch: hipFuncSetAttribute failed\n"); grid = -1; return; }
        if (hipOccupancyMaxActiveBlocksPerMultiprocessor(&per_cu, (const void*)hybrid_fwd, 512, LDS_BYTES) != hipSuccess || per_cu < 1)
            fprintf(stderr, "kernel_launch: note: occupancy query reports %d workgroups per CU\n", per_cu);
        (void)hipGetLastError();
        grid = cus;
    }
    if (grid < 0) return;
    if (hipMemsetAsync((char*)d_ws + WS_CTL, 0, CTL_ZERO_BYTES, stream) != hipSuccess) { fprintf(stderr, "kernel_launch: memset failed\n"); return; }
    Args a{};
    for (int i = 0; i < 19; ++i) a.in[i] = (const float*)d_in[i];
    a.out = (float*)d_out; a.ws = (unsigned char*)d_ws;
#if MK_MULTI
    for (int s = 0; s < N_STEPS; ++s) { a.lo = s; a.hi = s + 1; hipLaunchKernelGGL(hybrid_fwd, dim3(grid), dim3(512), LDS_BYTES, stream, a); }
#else
#ifdef DUMP_SPLIT
    a.lo = 0; a.hi = DUMP_SPLIT;
    hipLaunchKernelGGL(hybrid_fwd, dim3(grid), dim3(512), LDS_BYTES, stream, a);
    (void)hipMemsetAsync((char*)d_ws + WS_CTL, 0, 65536, stream);
    a.lo = DUMP_SPLIT; a.hi = DUMP_HI;
    hipLaunchKernelGGL(hybrid_fwd, dim3(grid), dim3(512), LDS_BYTES, stream, a);
#else
    a.lo = 0; a.hi = DUMP_HI ? DUMP_HI : N_STEPS;
    hipLaunchKernelGGL(hybrid_fwd, dim3(grid), dim3(512), LDS_BYTES, stream, a);
#endif
#ifdef DUMP_OUTCOPY
    hipLaunchKernelGGL(copy_half_k, dim3(8192), dim3(256), 0, stream, (const unsigned*)d_out + (DUMP_OUTCOPY == 2 ? 256 : 0), (unsigned*)((char*)d_ws + (size_t)DUMP_OFF));
#endif
#if DUMP_HI
    hipLaunchKernelGGL(dump_k, dim3(8192), dim3(256), 0, stream, (const unsigned*)((const char*)d_ws + (size_t)DUMP_OFF), (size_t)DUMP_WORDS, (float*)d_out);
#endif
#endif
    const hipError_t le = hipPeekAtLastError();
    if (le != hipSuccess) fprintf(stderr, "kernel_launch: launch failed: %s\n", hipGetErrorName(le));
}
```

```cpp
#include <hip/hip_runtime.h>
#include <cstdio>
#include <cstdint>

#define GAS __attribute__((address_space(1)))
#define LAS __attribute__((address_space(3)))
typedef unsigned short bf16;
typedef unsigned v4u __attribute__((ext_vector_type(4)));
typedef unsigned v2u __attribute__((ext_vector_type(2)));
typedef float f32x4 __attribute__((ext_vector_type(4)));
typedef float f32x2 __attribute__((ext_vector_type(2)));
typedef float f32x16 __attribute__((ext_vector_type(16)));
typedef short bf16x8 __attribute__((ext_vector_type(8)));

#ifndef USE_LIST
#define USE_LIST 0
#endif
#ifndef USE_BCAST
#define USE_BCAST 1
#endif
#ifndef USE_GSEQ
#define USE_GSEQ 1
#endif
#ifndef MK_MULTI
#define MK_MULTI 0
#endif

constexpr int BATCH = 16, SEQ = 4096, DM = 1024, DEPTH = 4, MTOK = BATCH * SEQ;
constexpr int PW = 2816;
constexpr int PROJ_SRC = 2776;
constexpr int C_AQ = 0, C_IQ = 512, C_BQ = 1024, C_BK = 1280, C_BV = 1536, C_BG = 2048, C_AK = 2560, C_AV = 2624, C_IK = 2688, C_IW = 2752, C_BA = 2760;
constexpr int DFF = 2816, NEXP = 8;
constexpr int PASS_PANELS = 256, NPASS_DENSE = 1, NPASS_MOE = 2;
constexpr float DN_ALPHA = 1.681792830507429f;
constexpr float LN_EPS = 1e-5f;
constexpr float LOG2E = 1.4426950408889634f;

constexpr size_t MiB = 1u << 20;
constexpr size_t WS_CTL = 0, CTL_ZERO_BYTES = 1 * MiB;
constexpr size_t WS_MOD = 1 * MiB;
constexpr size_t WS_TOPE = 3 * MiB;
constexpr size_t WS_TOPG = WS_TOPE + MiB / 2;
constexpr size_t WS_TOKSLOT = WS_TOPG + MiB / 2;
constexpr size_t WS_ROWTOK = 5 * MiB;
constexpr size_t WS_ROWGATE = 6 * MiB;
constexpr size_t WS_WIN = 8 * MiB;
constexpr size_t WS_WOUT = 14 * MiB;
constexpr size_t WS_WGU = 16 * MiB;
constexpr size_t WS_WDN = 104 * MiB;
constexpr size_t WS_H = 148 * MiB;
constexpr size_t WS_P = 276 * MiB;
constexpr size_t WS_Y = 640 * MiB;
constexpr size_t WS_SEL = 900 * MiB;
constexpr size_t WS_END = 1024 * MiB;

constexpr int CW_BAR = 4096;
constexpr int CW_QUEUE = 8192;
constexpr int CW_CNT = 10240;
constexpr int CW_FILL = 10752;

constexpr int LDS_BYTES = 147456;
constexpr int PE_OFF = 131072;
constexpr int MISC_OFF = 139264;

__device__ __forceinline__ float bf2f(unsigned v) { return __uint_as_float(v << 16); }
typedef __bf16 bf16x2_t __attribute__((ext_vector_type(2)));
__device__ __forceinline__ unsigned pk2(float lo, float hi) { const f32x2 v = {lo, hi}; return __builtin_bit_cast(unsigned, __builtin_convertvector(v, bf16x2_t)); }
__device__ __forceinline__ unsigned f2bf(float f) { return pk2(f, 0.f) & 0xffffu; }
__device__ __forceinline__ float wave_sum(float v) {
#pragma unroll
    for (int o = 1; o < 64; o <<= 1) v += __shfl_xor(v, o);
    return v;
}
__device__ __forceinline__ float wave_max(float v) {
#pragma unroll
    for (int o = 1; o < 64; o <<= 1) v = fmaxf(v, __shfl_xor(v, o));
    return v;
}
#define DPP_U32(x, ctrl) ((unsigned)__builtin_amdgcn_update_dpp(0, (int)(x), (ctrl), 0xF, 0xF, true))
__device__ __forceinline__ unsigned wave_sum_u32(unsigned x) {
    x += DPP_U32(x, 0xB1); x += DPP_U32(x, 0x4E); x += DPP_U32(x, 0x124); x += DPP_U32(x, 0x128);
#if USE_BCAST
    x += (unsigned)__builtin_amdgcn_update_dpp(0, (int)x, 0x142, 0xA, 0xF, false);
    x += (unsigned)__builtin_amdgcn_update_dpp(0, (int)x, 0x143, 0xC, 0xF, false);
    return (unsigned)__builtin_amdgcn_readlane((int)x, 63);
#else
    return (unsigned)__builtin_amdgcn_readlane((int)x, 0) + (unsigned)__builtin_amdgcn_readlane((int)x, 16) + (unsigned)__builtin_amdgcn_readlane((int)x, 32) + (unsigned)__builtin_amdgcn_readlane((int)x, 48);
#endif
}
__device__ __forceinline__ float dpp_f32_(float x, int) { return x; }
#define DPP_F32(x, ctrl) (__builtin_bit_cast(float, __builtin_amdgcn_update_dpp(0, __builtin_bit_cast(int, (x)), (ctrl), 0xF, 0xF, true)))
__device__ __forceinline__ float wave_sum_f(float x) {
    x += DPP_F32(x, 0xB1); x += DPP_F32(x, 0x4E); x += DPP_F32(x, 0x124); x += DPP_F32(x, 0x128);
    const float r0 = __builtin_bit_cast(float, __builtin_amdgcn_readlane(__builtin_bit_cast(int, x), 0)), r1 = __builtin_bit_cast(float, __builtin_amdgcn_readlane(__builtin_bit_cast(int, x), 16));
    const float r2 = __builtin_bit_cast(float, __builtin_amdgcn_readlane(__builtin_bit_cast(int, x), 32)), r3 = __builtin_bit_cast(float, __builtin_amdgcn_readlane(__builtin_bit_cast(int, x), 48));
    return (r0 + r1) + (r2 + r3);
}
__device__ __forceinline__ unsigned umax_(unsigned a, unsigned b) { return a > b ? a : b; }
__device__ __forceinline__ unsigned umin_(unsigned a, unsigned b) { return a < b ? a : b; }
__device__ __forceinline__ unsigned wave_max_u32(unsigned x) {
    x = umax_(x, DPP_U32(x, 0xB1)); x = umax_(x, DPP_U32(x, 0x4E)); x = umax_(x, DPP_U32(x, 0x124)); x = umax_(x, DPP_U32(x, 0x128));
    return umax_(umax_((unsigned)__builtin_amdgcn_readlane((int)x, 0), (unsigned)__builtin_amdgcn_readlane((int)x, 16)), umax_((unsigned)__builtin_amdgcn_readlane((int)x, 32), (unsigned)__builtin_amdgcn_readlane((int)x, 48)));
}
__device__ __forceinline__ unsigned wave_min_u32(unsigned x) {
    x = umin_(x, DPP_U32(x, 0xB1)); x = umin_(x, DPP_U32(x, 0x4E)); x = umin_(x, DPP_U32(x, 0x124)); x = umin_(x, DPP_U32(x, 0x128));
    return umin_(umin_((unsigned)__builtin_amdgcn_readlane((int)x, 0), (unsigned)__builtin_amdgcn_readlane((int)x, 16)), umin_((unsigned)__builtin_amdgcn_readlane((int)x, 32), (unsigned)__builtin_amdgcn_readlane((int)x, 48)));
}
#define SHX_F(v, o, lane_) (__builtin_bit_cast(float, __builtin_amdgcn_ds_bpermute((((lane_) ^ (o)) << 2), __builtin_bit_cast(int, (float)(v)))))
#define SHUP_I(v, o, lane_) (__builtin_amdgcn_ds_bpermute((((lane_) - (o)) << 2), (int)(v)))
__device__ __forceinline__ int wave_incl_scan_i(int x, int lane) {
    x += __builtin_amdgcn_update_dpp(0, x, 0x111, 0xF, 0xF, true); x += __builtin_amdgcn_update_dpp(0, x, 0x112, 0xF, 0xF, true);
    x += __builtin_amdgcn_update_dpp(0, x, 0x114, 0xF, 0xF, true); x += __builtin_amdgcn_update_dpp(0, x, 0x118, 0xF, 0xF, true);
    const int t0 = __builtin_amdgcn_readlane(x, 15), t1 = __builtin_amdgcn_readlane(x, 31), t2 = __builtin_amdgcn_readlane(x, 47);
    return x + (lane >= 16 ? t0 : 0) + (lane >= 32 ? t1 : 0) + (lane >= 48 ? t2 : 0);
}
__device__ __forceinline__ float silu_f(float v) { return v / (1.f + expf(-v)); }

#define XB_TMO      128
#define XB_XCNT(j)  (256  + 64 * (j))
#define XB_XSUB(j)  (1280 + 64 * (j))
#define XB_XGEN(j)  (2304 + 64 * (j))
#define XB_TOP      3328
#define XB_TOPGEN   3392
#define XCD_BAR_WORDS 3456
#define XB_SPIN_CAP (1u << 21)

__device__ __forceinline__ unsigned xb_ld(unsigned* p)              { return __hip_atomic_load(p, __ATOMIC_RELAXED, __HIP_MEMORY_SCOPE_AGENT); }
__device__ __forceinline__ unsigned xb_add(unsigned* p, unsigned v) { return __hip_atomic_fetch_add(p, v, __ATOMIC_RELAXED, __HIP_MEMORY_SCOPE_AGENT); }
__device__ __forceinline__ unsigned xb_xcc_id() { return (unsigned)__builtin_amdgcn_s_getreg((3 << 11) | 20) & 0xFu; }
#define XB_SPIN(cond, bar) do { unsigned _sp = 0; while (cond) { __builtin_amdgcn_s_sleep(1); \
    if ((++_sp & 255u) == 0u) { if (xb_ld(&(bar)[XB_TMO])) break; if (_sp > XB_SPIN_CAP) { atomicAdd(&(bar)[XB_TMO], 1u); break; } } } } while (0)

struct XcdBarrier {
    unsigned* bar; unsigned x;
    volatile LAS unsigned* st;
};

__device__ __forceinline__ XcdBarrier xcd_barrier_post(unsigned* bar, volatile LAS unsigned* st) {
    XcdBarrier b; b.bar = bar; b.x = xb_xcc_id(); b.st = st;
    if (threadIdx.x == 0) (void)xb_add(&bar[XB_XCNT(b.x)], 1u);
    return b;
}
__device__ __forceinline__ void xcd_barrier_complete(unsigned* bar, unsigned x, unsigned& nloc, unsigned& nx) {
    const unsigned G = gridDim.x * gridDim.y * gridDim.z;
    unsigned sum, cnt, mine, sp = 0u;
    for (;;) {
        sum = 0u; cnt = 0u; mine = 0u;
#pragma unroll
        for (unsigned j = 0; j < 16; ++j) { const unsigned c = xb_ld(&bar[XB_XCNT(j)]); sum += c; cnt += (c > 0u) ? 1u : 0u; mine = (j == x) ? c : mine; }
        if (sum == G) break;
        __builtin_amdgcn_s_sleep(1);
        if ((++sp & 255u) == 0u) { if (xb_ld(&bar[XB_TMO])) break; if (sp > XB_SPIN_CAP) { atomicAdd(&bar[XB_TMO], 1u); break; } }
    }
    nloc = mine > 0u ? mine : 1u; nx = cnt > 0u ? cnt : 1u;
}

__device__ __forceinline__ void xcd_barrier(const XcdBarrier& b) {
    asm volatile("s_waitcnt vmcnt(0)" ::: "memory");
    __syncthreads();
    if (threadIdx.x == 0) {
        unsigned* bar = b.bar;
        __builtin_amdgcn_s_waitcnt(0);
        unsigned nloc = b.st[0], nx = b.st[1];
        if (nloc == 0u) { xcd_barrier_complete(bar, b.x, nloc, nx); b.st[0] = nloc; b.st[1] = nx; }
        const unsigned old = xb_add(&bar[XB_XSUB(b.x)], 1u);
        const unsigned gen = old / nloc;
        if (old + 1u == (gen + 1u) * nloc) {
            __builtin_amdgcn_fence(__ATOMIC_RELEASE, "agent");
            asm volatile("s_waitcnt vmcnt(0)" ::: "memory");
            const unsigned og = xb_add(&bar[XB_TOP], 1u);
            const unsigned tg = og / nx;
            if (og + 1u == (tg + 1u) * nx) xb_add(&bar[XB_TOPGEN], 1u);
            else XB_SPIN(xb_ld(&bar[XB_TOPGEN]) == tg, bar);
            __builtin_amdgcn_fence(__ATOMIC_ACQUIRE, "agent");
            xb_add(&bar[XB_XGEN(b.x)], 1u);
            asm volatile("s_waitcnt vmcnt(0)" ::: "memory");
        } else {
            XB_SPIN(xb_ld(&bar[XB_XGEN(b.x)]) == gen, bar);
            __builtin_amdgcn_fence(__ATOMIC_ACQUIRE, "agent");
            asm volatile("s_waitcnt vmcnt(0)" ::: "memory");
        }
    }
    __syncthreads();
}


struct Args { const float* in[19]; float* out; unsigned char* ws; int lo, hi; };
typedef const Args __attribute__((address_space(4))) KArgs;
struct Ctx {
    LAS unsigned char* lds;
    volatile LAS unsigned* MISC;
    unsigned* ctl;
    int tid, lane, wave, G, bid;
    int hot;
    KArgs* ka;
    float* out; unsigned char* ws;
    __device__ __forceinline__ const float* in(int i) const { return ka->in[i]; }
};
enum { I_X = 0, I_C, I_WIN, I_WA2, I_BA, I_GLAG, I_WOUT, I_WMOD, I_BMOD, I_LNG, I_LNB, I_FG, I_FU, I_FD, I_WR, I_BR, I_MG, I_MU, I_MD };

__device__ __forceinline__ f32x16 mfma32(bf16x8 a, bf16x8 b, f32x16 c) { return __builtin_amdgcn_mfma_f32_32x32x16_bf16(a, b, c, 0, 0, 0); }

__device__ __forceinline__ void ph_mod(Ctx& C) {
    LAS float* sc = (LAS float*)C.lds;
    LAS float* red = (LAS float*)(C.lds + 65536);
    const float* c = C.in(I_C);
    for (int i = C.tid; i < 16 * 1024; i += 512) sc[i] = silu_f(c[i]);
    __syncthreads();
    const float* wmod = C.in(I_WMOD); const float* bmod = C.in(I_BMOD);
    float* MOD = (float*)(C.ws + WS_MOD);
    for (int u = C.bid; u < 4 * 96; u += C.G) {
        const int l = u / 96, cc = u % 96, col = cc * 64 + C.lane;
        float acc[16];
#pragma unroll
        for (int b = 0; b < 16; ++b) acc[b] = 0.f;
        const float* wp = wmod + ((size_t)l * 1024 + C.wave * 128) * 6144 + col;
        const LAS float* sp = sc + C.wave * 128;
#pragma unroll 16
        for (int kk = 0; kk < 128; ++kk) {
            const float w = wp[(size_t)kk * 6144];
#pragma unroll
            for (int b = 0; b < 16; ++b) acc[b] += sp[b * 1024 + kk] * w;
        }
#pragma unroll
        for (int b = 0; b < 16; ++b) red[(C.wave * 16 + b) * 64 + C.lane] = acc[b];
        __syncthreads();
        for (int o = C.tid; o < 1024; o += 512) {
            const int b = o >> 6, ln = o & 63; float s = 0.f;
#pragma unroll
            for (int w = 0; w < 8; ++w) s += red[(w * 16 + b) * 64 + ln];
            const int cl = cc * 64 + ln;
            MOD[((size_t)l * 16 + b) * 6144 + cl] = s + bmod[l * 6144 + cl];
        }
        __syncthreads();
    }
}

__device__ __forceinline__ void conv_item(const float* colp, int ldn, int K, bf16* WT, LAS float* scr, int kb, int nb, int lane) {
    const int k0 = 64 * kb, n0 = 32 * nb;
    float tv[32];
#pragma unroll
    for (int i = 0; i < 32; ++i) { const int kk = 2 * i + (lane >> 5); tv[i] = colp ? colp[(size_t)(k0 + kk) * ldn] : 0.f; }
#pragma unroll
    for (int i = 0; i < 32; ++i) { const int kk = 2 * i + (lane >> 5); scr[kk * 33 + (lane & 31)] = tv[i]; }
    asm volatile("s_waitcnt lgkmcnt(0)" ::: "memory");
    const int c = lane & 7;
#pragma unroll
    for (int j = 0; j < 4; ++j) {
        const int n = (lane >> 3) + 8 * j; const LAS float* s = scr + (8 * c) * 33 + n;
        v4u o; o.x = pk2(s[0 * 33], s[1 * 33]); o.y = pk2(s[2 * 33], s[3 * 33]); o.z = pk2(s[4 * 33], s[5 * 33]); o.w = pk2(s[6 * 33], s[7 * 33]);
        *(v4u*)(WT + (size_t)(n0 + n) * K + k0 + 8 * c) = o;
    }
    asm volatile("s_waitcnt lgkmcnt(0)" ::: "memory");
}
__device__ __forceinline__ int win_src_col(int n) {
    if (n < C_IQ) return n;
    if (n < C_BQ) return 640 + (n - C_IQ);
    if (n < C_AK) return 1224 + (n - C_BQ);
    if (n < C_AV) return 512 + (n - C_AK);
    if (n < C_IK) return 576 + (n - C_AV);
    if (n < C_IW) return 1152 + (n - C_IK);
    if (n < C_BA) return 1216 + (n - C_IW);
    if (n < PROJ_SRC) return 2760 + (n - C_BA);
    return -1;
}
__device__ __forceinline__ void ph_conv(Ctx& C, int l) {
    LAS float* scr = (LAS float*)(C.lds + C.wave * 8448);
    const int gw = C.bid * 8 + C.wave, NGW = C.G * 8;
    const bool moe = (l & 1) != 0; const int j = l >> 1, ne = moe ? NEXP : 1;
    constexpr int I_IN = 16 * 88, I_OUT = 16 * 32, I_GU = 16 * 176, I_DN = 44 * 32;
    const int nitems = I_IN + I_OUT + ne * (I_GU + I_DN);
    bf16* WIN = (bf16*)(C.ws + WS_WIN); bf16* WOUT = (bf16*)(C.ws + WS_WOUT); bf16* WGU = (bf16*)(C.ws + WS_WGU); bf16* WDN = (bf16*)(C.ws + WS_WDN);
    for (int it = gw; it < nitems; it += NGW) {
        int r = it;
        if (r < I_IN) { const int kb = r / 88, nb = r % 88; const int sc_ = win_src_col(nb * 32 + (C.lane & 31));
            const float* W = C.in(I_WIN) + (size_t)l * 1024 * PROJ_SRC;
            conv_item(sc_ >= 0 ? W + sc_ : nullptr, PROJ_SRC, 1024, WIN, scr, kb, nb, C.lane); continue; }
        r -= I_IN;
        if (r < I_OUT) { const int kb = r / 32, nb = r % 32; const float* W = C.in(I_WOUT) + (size_t)l * 1024 * 1024;
            conv_item(W + nb * 32 + (C.lane & 31), 1024, 1024, WOUT, scr, kb, nb, C.lane); continue; }
        r -= I_OUT;
        const int e = r / (I_GU + I_DN); r -= e * (I_GU + I_DN);
        const size_t eoff = (size_t)(j * ne + e) * 1024 * DFF;
        if (r < I_GU) { const int kb = r / 176, nb = r % 176; const int n = nb * 32 + (C.lane & 31), T = n >> 8, jj = n & 255;
            const float* Wg = (moe ? C.in(I_MG) : C.in(I_FG)) + eoff; const float* Wu = (moe ? C.in(I_MU) : C.in(I_FU)) + eoff;
            const float* colp = (jj < 128) ? Wg + T * 128 + jj : Wu + T * 128 + (jj - 128);
            conv_item(colp, DFF, 1024, WGU + (size_t)e * 5632 * 1024, scr, kb, nb, C.lane); continue; }
        r -= I_GU;
        { const int kb = r / 32, nb = r % 32; const float* Wd = (moe ? C.in(I_MD) : C.in(I_FD)) + eoff;
          conv_item(Wd + nb * 32 + (C.lane & 31), 1024, DFF, WDN + (size_t)e * 1024 * DFF, scr, kb, nb, C.lane); }
    }
}

__device__ __forceinline__ void ph_modulate0(Ctx& C) {
    const int gw = C.bid * 8 + C.wave, NGW = C.G * 8;
    const float* MOD = (const float*)(C.ws + WS_MOD); bf16* H = (bf16*)(C.ws + WS_H); const float* x = C.in(I_X);
    for (int row = gw; row < MTOK; row += NGW) {
        const int b = row >> 12; const float* md = MOD + (size_t)b * 6144;
#pragma unroll
        for (int j = 0; j < 4; ++j) {
            const int col = 4 * C.lane + 256 * j;
            const f32x4 v = *(const f32x4*)(x + (size_t)row * DM + col), sh = *(const f32x4*)(md + col), sc = *(const f32x4*)(md + 1024 + col);
            v2u o; o.x = pk2(v.x * (1.f + sc.x) + sh.x, v.y * (1.f + sc.y) + sh.y); o.y = pk2(v.z * (1.f + sc.z) + sh.z, v.w * (1.f + sc.w) + sh.w);
            *(v2u*)(H + (size_t)row * DM + col) = o;
        }
    }
}

struct GUnit { int arow0; int orow0; int pn; size_t boff; };
template <int MODE, class Epi>
__device__ __forceinline__ void gemm_simple_unit(Ctx& C, const bf16* A, int lda, const int* rowmap, const bf16* Bt, int K, const GUnit& u, const Epi& E) {
    const int rs = C.wave & 3, ch = C.wave >> 2, n = C.lane & 31, h = C.lane >> 5;
    const int r0 = u.arow0 + rs * 64 + n;
    const int ra = rowmap ? rowmap[r0] : r0, rb = rowmap ? rowmap[r0 + 32] : r0 + 32;
    const bf16* a0p = A + (size_t)ra * lda + 8 * h; const bf16* a1p = A + (size_t)rb * lda + 8 * h;
#pragma unroll 1
    for (int sp = 0; sp < 2; ++sp) {
        int br0, br1;
        if (MODE == 1) { const int jj = 2 * ch + sp; br0 = u.pn * 256 + 32 * jj; br1 = br0 + 128; }
        else { br0 = u.pn * 256 + 128 * ch + 64 * sp; br1 = br0 + 32; }
        const bf16* b0p = Bt + u.boff + (size_t)(br0 + n) * K + 8 * h; const bf16* b1p = Bt + u.boff + (size_t)(br1 + n) * K + 8 * h;
        f32x16 c00, c01, c10, c11;
#pragma unroll
        for (int i = 0; i < 16; ++i) { c00[i] = 0.f; c01[i] = 0.f; c10[i] = 0.f; c11[i] = 0.f; }
#pragma unroll 4
        for (int k = 0; k < K; k += 16) {
            const bf16x8 a0 = *(const bf16x8*)(a0p + k), a1 = *(const bf16x8*)(a1p + k), b0 = *(const bf16x8*)(b0p + k), b1 = *(const bf16x8*)(b1p + k);
            c00 = mfma32(a0, b0, c00); c01 = mfma32(a0, b1, c01); c10 = mfma32(a1, b0, c10); c11 = mfma32(a1, b1, c11);
        }
        const int orow = u.orow0 + rs * 64 + 4 * h;
        E(c00, c01, orow, br0, br1, n, u);
        E(c10, c11, orow + 32, br0, br1, n, u);
    }
}
struct EpiStoreS {
    bf16* O; int ldc;
    __device__ __forceinline__ void operator()(const f32x16& c0, const f32x16& c1, int orow, int br0, int br1, int n, const GUnit&) const {
#pragma unroll
        for (int r = 0; r < 16; ++r) { const size_t row = (size_t)(orow + (r & 3) + 8 * (r >> 2));
            O[row * ldc + br0 + n] = (bf16)f2bf(c0[r]); O[row * ldc + br1 + n] = (bf16)f2bf(c1[r]); }
    }
};
struct EpiSwigluS {
    bf16* O;
    __device__ __forceinline__ void operator()(const f32x16& c0, const f32x16& c1, int orow, int br0, int br1, int n, const GUnit& u) const {
        const int col = 128 * u.pn + (br0 - 256 * u.pn) + n;
#pragma unroll
        for (int r = 0; r < 16; ++r) { const size_t row = (size_t)(orow + (r & 3) + 8 * (r >> 2));
            O[row * DFF + col] = (bf16)f2bf(silu_f(c0[r]) * c1[r]); }
    }
};
struct EpiGateS {
    bf16* O; const float* gate;
    __device__ __forceinline__ void operator()(const f32x16& c0, const f32x16& c1, int orow, int br0, int br1, int n, const GUnit&) const {
#pragma unroll
        for (int r = 0; r < 16; ++r) { const size_t row = (size_t)(orow + (r & 3) + 8 * (r >> 2)); const float g = gate[row];
            O[row * DM + br0 + n] = (bf16)f2bf(c0[r] * g); O[row * DM + br1 + n] = (bf16)f2bf(c1[r] * g); }
    }
};

__device__ __forceinline__ void ph_gla_unit(Ctx& C, int l, int b, int hh) {
    LAS float* q_s = (LAS float*)C.lds;
    LAS float* k_s = q_s + 4096;
    LAS float* a_s = k_s + 4096;
    LAS float* v_s = a_s + 4096;
    LAS float* o_s = v_s + 8192;
    const bf16* PROJ = (const bf16*)(C.ws + WS_P); bf16* YM = (bf16*)(C.ws + WS_H);
    const float* w_a2 = C.in(I_WA2) + (size_t)l * 16 * 256; const float* b_a = C.in(I_BA) + l * 256; const float* gg = C.in(I_GLAG) + l * 128;
    const int e = C.tid >> 2, dg = C.tid & 3;
    float S[16];
#pragma unroll
    for (int i = 0; i < 16; ++i) S[i] = 0.f;
    for (int c = 0; c < 64; ++c) {
        const size_t row0 = (size_t)b * SEQ + c * 64;
        {
            const int t = C.tid >> 3, d0 = (C.tid & 7) * 8; const bf16* pr = PROJ + (row0 + t) * PW;
            const v4u qv = *(const v4u*)(pr + C_BQ + hh * 64 + d0), kv = *(const v4u*)(pr + C_BK + hh * 64 + d0);
            const v4u ba0 = *(const v4u*)(pr + C_BA), ba1 = *(const v4u*)(pr + C_BA + 8);
            float baf[16];
            baf[0] = bf2f(ba0.x & 0xffffu); baf[1] = bf2f(ba0.x >> 16); baf[2] = bf2f(ba0.y & 0xffffu); baf[3] = bf2f(ba0.y >> 16);
            baf[4] = bf2f(ba0.z & 0xffffu); baf[5] = bf2f(ba0.z >> 16); baf[6] = bf2f(ba0.w & 0xffffu); baf[7] = bf2f(ba0.w >> 16);
            baf[8] = bf2f(ba1.x & 0xffffu); baf[9] = bf2f(ba1.x >> 16); baf[10] = bf2f(ba1.y & 0xffffu); baf[11] = bf2f(ba1.y >> 16);
            baf[12] = bf2f(ba1.z & 0xffffu); baf[13] = bf2f(ba1.z >> 16); baf[14] = bf2f(ba1.w & 0xffffu); baf[15] = bf2f(ba1.w >> 16);
            const unsigned qw[4] = {qv.x, qv.y, qv.z, qv.w}, kw[4] = {kv.x, kv.y, kv.z, kv.w};
#pragma unroll
            for (int i = 0; i < 8; ++i) {
                const int d = d0 + i; float z = b_a[hh * 64 + d];
#pragma unroll
                for (int r = 0; r < 16; ++r) z += baf[r] * w_a2[r * 256 + hh * 64 + d];
                const float ls = fminf(z, 0.f) - log1pf(expf(-fabsf(z)));
                a_s[t * 64 + d] = expf(ls * (1.f / 16.f));
                const unsigned qq = (i & 1) ? (qw[i >> 1] >> 16) : (qw[i >> 1] & 0xffffu), kk = (i & 1) ? (kw[i >> 1] >> 16) : (kw[i >> 1] & 0xffffu);
                q_s[t * 64 + d] = bf2f(qq) * 0.125f; k_s[t * 64 + d] = bf2f(kk);
            }
            const int e0 = (C.tid & 7) * 16;
            const v4u v0 = *(const v4u*)(pr + C_BV + hh * 128 + e0), v1 = *(const v4u*)(pr + C_BV + hh * 128 + e0 + 8);
            const unsigned vw[8] = {v0.x, v0.y, v0.z, v0.w, v1.x, v1.y, v1.z, v1.w};
#pragma unroll
            for (int i = 0; i < 8; ++i) { v_s[t * 128 + e0 + 2 * i] = bf2f(vw[i] & 0xffffu); v_s[t * 128 + e0 + 2 * i + 1] = bf2f(vw[i] >> 16); }
        }
        __syncthreads();
        for (int tt = 0; tt < 64; ++tt) {
            const float vv = v_s[tt * 128 + e]; float po = 0.f;
#pragma unroll
            for (int i = 0; i < 16; ++i) { const int d = 16 * dg + i; S[i] = a_s[tt * 64 + d] * S[i] + k_s[tt * 64 + d] * vv; po += q_s[tt * 64 + d] * S[i]; }
            po += __shfl_xor(po, 1); po += __shfl_xor(po, 2);
            if (dg == 0) o_s[tt * 128 + e] = po;
        }
        __syncthreads();
#pragma unroll 1
        for (int r = 0; r < 8; ++r) {
            const int tt = C.wave * 8 + r; const float o0 = o_s[tt * 128 + C.lane], o1 = o_s[tt * 128 + 64 + C.lane];
            const float ss = wave_sum(o0 * o0 + o1 * o1); const float rstd = rsqrtf(ss * (1.f / 128.f) + LN_EPS);
            const bf16* pr = PROJ + (row0 + tt) * PW + C_BG + hh * 128; const float g0 = bf2f(pr[C.lane]), g1 = bf2f(pr[64 + C.lane]);
            bf16* yo = YM + (row0 + tt) * DM + 512 + hh * 128;
            yo[C.lane] = (bf16)f2bf(o0 * rstd * gg[C.lane] * silu_f(g0)); yo[64 + C.lane] = (bf16)f2bf(o1 * rstd * gg[64 + C.lane] * silu_f(g1));
        }
        __syncthreads();
    }
}

__device__ __forceinline__ unsigned sortable_u32(float f) { const unsigned u = __float_as_uint(f + 0.0f); return (u & 0x80000000u) ? ~u : (u | 0x80000000u); }
__device__ __forceinline__ void ph_dsa_a_unit(Ctx& C, int b, int t0) {
    LAS unsigned* sc = (LAS unsigned*)C.lds;
    LAS unsigned* cnt = (LAS unsigned*)(C.lds + 131072);
    const bf16* PROJ = (const bf16*)(C.ws + WS_P); unsigned* SEL = (unsigned*)(C.ws + WS_SEL);
    const int lane = C.lane, n = lane & 31, h = lane >> 5, tid = C.tid;
    const int nk = t0 + 8, ntile = (nk + 31) >> 5, nscan = ntile * 32;
    if (tid < 48) cnt[tid] = 0u;
    {
        bf16x8 af[2][4]; float wv[2][4][4];
#pragma unroll
        for (int mt = 0; mt < 2; ++mt) {
            const bf16* p = PROJ + (size_t)(b * SEQ + t0 + 4 * mt + (n >> 3)) * PW + C_IQ + (n & 7) * 64 + 8 * h;
#pragma unroll
            for (int ks = 0; ks < 4; ++ks) af[mt][ks] = *(const bf16x8*)(p + ks * 16);
#pragma unroll
            for (int jq = 0; jq < 4; ++jq)
#pragma unroll
                for (int i = 0; i < 4; ++i) wv[mt][jq][i] = bf2f(PROJ[(size_t)(b * SEQ + t0 + 4 * mt + jq) * PW + C_IW + i + 4 * h]) * (0.35355339059327373f * 0.125f);
        }
        for (int tile = C.wave; tile < ntile; tile += 8) {
            const int s = tile * 32 + n; const bf16* kp = PROJ + (size_t)(b * SEQ + s) * PW + C_IK + 8 * h;
            bf16x8 bfr[4];
#pragma unroll
            for (int ks = 0; ks < 4; ++ks) bfr[ks] = *(const bf16x8*)(kp + ks * 16);
#pragma unroll
            for (int mt = 0; mt < 2; ++mt) {
                f32x16 acc;
#pragma unroll
                for (int i = 0; i < 16; ++i) acc[i] = 0.f;
#pragma unroll
                for (int ks = 0; ks < 4; ++ks) acc = mfma32(af[mt][ks], bfr[ks], acc);
#pragma unroll
                for (int jq = 0; jq < 4; ++jq) {
                    float p = 0.f;
#pragma unroll
                    for (int i = 0; i < 4; ++i) p += wv[mt][jq][i] * fmaxf(acc[4 * jq + i], 0.f);
                    p += __shfl_xor(p, 32);
                    const int t = t0 + 4 * mt + jq; const unsigned u = (s <= t) ? sortable_u32(p) : 0u;
                    if (h == mt) sc[(4 * mt + jq) * 4096 + s] = u;
                }
            }
        }
    }
    __syncthreads();
    unsigned u[8][8];
#pragma unroll
    for (int i = 0; i < 8; ++i) {
        const int s = tid + 512 * i; const bool inr = s < nscan; const int sidx = inr ? s : 0;
#pragma unroll
        for (int q = 0; q < 8; ++q) { const unsigned v = sc[q * 4096 + sidx]; u[i][q] = inr ? v : 0u; }
    }
    unsigned T[8], J[8], need[8];
#pragma unroll
    for (int q = 0; q < 8; ++q) { T[q] = 0u; J[q] = 8192u; need[q] = 0u; }
    int buf = 0;
    for (int bit = 31; bit >= 0; --bit) {
        unsigned cq[8];
#pragma unroll
        for (int q = 0; q < 8; ++q) cq[q] = 0u;
#pragma unroll
        for (int i = 0; i < 8; ++i) if (512 * i < nscan) {
#pragma unroll
            for (int q = 0; q < 8; ++q) cq[q] += (unsigned)__popcll(__ballot(u[i][q] >= (T[q] | (1u << bit))));
        }
        unsigned myc = 0u;
#pragma unroll
        for (int q = 0; q < 8; ++q) myc = (lane == q) ? cq[q] : myc;
        if (lane < 8) __hip_atomic_fetch_add(cnt + buf * 16 + lane, myc, __ATOMIC_RELAXED, __HIP_MEMORY_SCOPE_WORKGROUP);
        const int nb = (buf == 2) ? 0 : buf + 1;
        if (tid >= 64 && tid < 80) cnt[nb * 16 + (tid - 64)] = 0u;
        __syncthreads();
#pragma unroll
        for (int q = 0; q < 8; ++q) if (cnt[buf * 16 + q] >= 256u) T[q] |= (1u << bit);
        buf = nb;
    }
#pragma unroll
    for (int q = 0; q < 8; ++q) T[q] = T[q] < 1u ? 1u : T[q];
    bool extra = false;
    {
        unsigned cg[8], ce[8];
#pragma unroll
        for (int q = 0; q < 8; ++q) { cg[q] = 0u; ce[q] = 0u; }
#pragma unroll
        for (int i = 0; i < 8; ++i) if (512 * i < nscan) {
#pragma unroll
            for (int q = 0; q < 8; ++q) { cg[q] += (unsigned)__popcll(__ballot(u[i][q] > T[q])); ce[q] += (unsigned)__popcll(__ballot(u[i][q] >= T[q])); }
        }
        unsigned myc = 0u;
#pragma unroll
        for (int q = 0; q < 8; ++q) { myc = (lane == q) ? cg[q] : myc; myc = (lane == 8 + q) ? ce[q] : myc; }
        if (lane < 16) __hip_atomic_fetch_add(cnt + buf * 16 + lane, myc, __ATOMIC_RELAXED, __HIP_MEMORY_SCOPE_WORKGROUP);
        const int nb = (buf == 2) ? 0 : buf + 1;
        if (tid >= 64 && tid < 80) cnt[nb * 16 + (tid - 64)] = 0u;
        __syncthreads();
#pragma unroll
        for (int q = 0; q < 8; ++q) { const unsigned g = cnt[buf * 16 + q], ge = cnt[buf * 16 + 8 + q]; need[q] = 256u - (g < 256u ? g : 256u); extra = extra || (ge > 256u); }
        buf = nb;
    }
    if (extra) {
#pragma unroll
        for (int q = 0; q < 8; ++q) J[q] = 0u;
        for (int bit = 12; bit >= 0; --bit) {
            unsigned cq[8];
#pragma unroll
            for (int q = 0; q < 8; ++q) cq[q] = 0u;
#pragma unroll
            for (int i = 0; i < 8; ++i) if (512 * i < nscan) {
                const unsigned s = (unsigned)(tid + 512 * i);
#pragma unroll
                for (int q = 0; q < 8; ++q) cq[q] += (unsigned)__popcll(__ballot(u[i][q] == T[q] && s < (J[q] | (1u << bit))));
            }
            unsigned myc = 0u;
#pragma unroll
            for (int q = 0; q < 8; ++q) myc = (lane == q) ? cq[q] : myc;
            if (lane < 8) __hip_atomic_fetch_add(cnt + buf * 16 + lane, myc, __ATOMIC_RELAXED, __HIP_MEMORY_SCOPE_WORKGROUP);
            const int nb = (buf == 2) ? 0 : buf + 1;
            if (tid >= 64 && tid < 80) cnt[nb * 16 + (tid - 64)] = 0u;
            __syncthreads();
#pragma unroll
            for (int q = 0; q < 8; ++q) if (cnt[buf * 16 + q] <= need[q]) J[q] |= (1u << bit);
            buf = nb;
        }
    }
#pragma unroll
    for (int i = 0; i < 8; ++i) if (512 * i < nscan) {
        const unsigned s = (unsigned)(tid + 512 * i); const int tile0 = 2 * C.wave + 16 * i;
#pragma unroll
        for (int q = 0; q < 8; ++q) {
            const unsigned long long bm = __ballot((u[i][q] > T[q]) || (u[i][q] == T[q] && s < J[q]));
            if (lane == 0) { unsigned* w = SEL + (size_t)(b * SEQ + t0 + q) * 128 + tile0;
                if (tile0 < ntile) w[0] = (unsigned)bm; if (tile0 + 1 < ntile) w[1] = (unsigned)(bm >> 32); }
        }
    }
    __syncthreads();
}

__device__ __forceinline__ void ph_dsa_b_unit(Ctx& C, int b, int t0) {
    LAS float* qs = (LAS float*)C.lds + C.wave * 512;
    LAS int* lst = (LAS int*)(C.lds + 16384) + C.wave * 256;
    LAS float* pl = (LAS float*)(C.lds + 16384 + 8192) + C.wave * 2048;
    const bf16* PROJ = (const bf16*)(C.ws + WS_P); const unsigned* SEL = (const unsigned*)(C.ws + WS_SEL); bf16* YM = (bf16*)(C.ws + WS_H);
    const int lane = C.lane, t = t0 + C.wave; const size_t row = (size_t)b * SEQ + t;
    const int ntile = (t >> 5) + 1;
    int base = 0;
#pragma unroll 1
    for (int rd = 0; rd < 2; ++rd) {
        const int wi = rd * 64 + lane; unsigned w = (wi < ntile) ? SEL[row * 128 + wi] : 0u;
        const int c = __popc(w); int incl = c;
#pragma unroll
        for (int o = 1; o < 64; o <<= 1) { const int v = __shfl_up(incl, o); if (lane >= o) incl += v; }
        int pos = base + incl - c;
        while (w) { const int bit = __ffs(w) - 1; w &= w - 1; if (pos < 256) lst[pos] = wi * 32 + bit; ++pos; }
        base += __shfl(incl, 63);
    }
    const int nsel = base < 256 ? base : 256;
    {
        const v4u qv = *(const v4u*)(PROJ + row * PW + C_AQ + lane * 8); const unsigned qw[4] = {qv.x, qv.y, qv.z, qv.w};
#pragma unroll
        for (int i = 0; i < 4; ++i) { qs[lane * 8 + 2 * i] = bf2f(qw[i] & 0xffffu) * (0.125f * LOG2E); qs[lane * 8 + 2 * i + 1] = bf2f(qw[i] >> 16) * (0.125f * LOG2E); }
    }
    asm volatile("s_waitcnt lgkmcnt(0)" ::: "memory");
    float mx[8];
#pragma unroll
    for (int hd = 0; hd < 8; ++hd) mx[hd] = -3.0e38f;
#pragma unroll 1
    for (int i = 0; i < 4; ++i) {
        const int j = lane + 64 * i;
        asm volatile("" ::: "memory");
        if (j < nsel) {
            const int s = lst[j];
            const bf16* kp = PROJ + ((size_t)b * SEQ + s) * PW + C_AK;
            float kr[64];
#pragma unroll
            for (int c8 = 0; c8 < 8; ++c8) { const v4u kv = *(const v4u*)(kp + 8 * c8); const unsigned kw[4] = {kv.x, kv.y, kv.z, kv.w};
#pragma unroll
                for (int x = 0; x < 4; ++x) { kr[8 * c8 + 2 * x] = bf2f(kw[x] & 0xffffu); kr[8 * c8 + 2 * x + 1] = bf2f(kw[x] >> 16); } }
#pragma unroll
            for (int hd = 0; hd < 8; ++hd) {
                float d = 0.f;
#pragma unroll
                for (int x = 0; x < 64; ++x) d += qs[hd * 64 + x] * kr[x];
                const float slope2 = exp2f(-(float)(hd + 1)) * LOG2E;
                const float lgv = d - slope2 * (float)(t - s);
                pl[j * 8 + hd] = lgv; mx[hd] = fmaxf(mx[hd], lgv);
            }
        }
    }
#pragma unroll
    for (int hd = 0; hd < 8; ++hd) mx[hd] = wave_max(mx[hd]);
    asm volatile("s_waitcnt lgkmcnt(0)" ::: "memory");
    float sm[8];
#pragma unroll
    for (int hd = 0; hd < 8; ++hd) sm[hd] = 0.f;
#pragma unroll 1
    for (int i = 0; i < 4; ++i) {
        const int j = lane + 64 * i;
        if (j < nsel) {
#pragma unroll
            for (int hd = 0; hd < 8; ++hd) { const float p = exp2f(pl[j * 8 + hd] - mx[hd]); pl[j * 8 + hd] = p; sm[hd] += p; }
        }
    }
#pragma unroll
    for (int hd = 0; hd < 8; ++hd) sm[hd] = 1.f / wave_sum(sm[hd]);
    asm volatile("s_waitcnt lgkmcnt(0)" ::: "memory");
    float acc[8];
#pragma unroll
    for (int hd = 0; hd < 8; ++hd) acc[hd] = 0.f;
    const bf16* vb = PROJ + (size_t)b * SEQ * PW + C_AV + lane;
#pragma unroll 4
    for (int j = 0; j < nsel; ++j) {
        const int s = lst[j]; const float v = bf2f(vb[(size_t)s * PW]);
        const f32x4 p0 = *(const LAS f32x4*)(pl + j * 8), p1 = *(const LAS f32x4*)(pl + j * 8 + 4);
        acc[0] += p0.x * v; acc[1] += p0.y * v; acc[2] += p0.z * v; acc[3] += p0.w * v; acc[4] += p1.x * v; acc[5] += p1.y * v; acc[6] += p1.z * v; acc[7] += p1.w * v;
    }
#pragma unroll
    for (int hd = 0; hd < 8; ++hd) acc[hd] *= sm[hd];
#pragma unroll
    for (int hd = 0; hd < 8; ++hd) YM[row * DM + hd * 64 + lane] = (bf16)f2bf(acc[hd]);
}

struct LnRaw { f32x4 x[4]; v2u ya[4]; v2u yb[4]; v2u hx[4]; };
template <bool ROUTE, int YMODE, int XMODE>
__device__ __forceinline__ void ph_ln(Ctx& C, const float* Xin, int l, int which, int mod_g, int mod_l2, int mod_sh, bool write_h, int jmoe, int mod_in, bool write_x) {
    const int gw = C.bid * 8 + C.wave, NGW = C.G * 8, lane = C.lane;
    const float* MOD = (const float*)(C.ws + WS_MOD); bf16* H = (bf16*)(C.ws + WS_H); const bf16* Y = (const bf16*)(C.ws + WS_Y);
    const float* lng = C.in(I_LNG) + (size_t)(l * 2 + which) * DM; const float* lnb = C.in(I_LNB) + (size_t)(l * 2 + which) * DM;
    const int* TOKSLOT = (const int*)(C.ws + WS_TOKSLOT);
    const float* wr = C.in(I_WR) + (size_t)jmoe * DM * NEXP; const float* br = C.in(I_BR) + jmoe * NEXP;
    int* TOPE = (int*)(C.ws + WS_TOPE); float* TOPG = (float*)(C.ws + WS_TOPG);
    unsigned ecnt[8];
#pragma unroll
    for (int e = 0; e < 8; ++e) ecnt[e] = 0u;
    LAS float* wrs = (LAS float*)C.lds;
    if (ROUTE) { for (int i = C.tid; i < DM * NEXP / 4; i += 512) ((LAS f32x4*)wrs)[i] = ((const f32x4*)wr)[i]; __syncthreads(); }
    const int RPW = (MTOK + NGW - 1) / NGW;
    const int r0 = gw * RPW, r1 = (r0 + RPW < MTOK) ? r0 + RPW : MTOK;
    if (r0 < MTOK) {
        const int b = r0 >> 12;
        const bool one_batch = ((r1 - 1) >> 12) == b;
        const float* mg = MOD + ((size_t)l * 16 + b) * 6144 + mod_g;
        const float* mi = MOD + ((size_t)l * 16 + b) * 6144 + mod_in;
        const float* ms = MOD + ((size_t)mod_l2 * 16 + b) * 6144 + mod_sh;
        f32x4 gv[4], shi[4], sci[4];
#pragma unroll
        for (int j = 0; j < 4; ++j) { const int col = 4 * lane + 256 * j; gv[j] = *(const f32x4*)(mg + col);
            if (XMODE == 1) { shi[j] = *(const f32x4*)(mi + col); const f32x4 sc_ = *(const f32x4*)(mi + 1024 + col); sci[j].x = 1.f / (sc_.x + 1.f); sci[j].y = 1.f / (sc_.y + 1.f); sci[j].z = 1.f / (sc_.z + 1.f); sci[j].w = 1.f / (sc_.w + 1.f); } }
        f32x4 Av[4], Bv[4];
#pragma unroll
        for (int j = 0; j < 4; ++j) { const int col = 4 * lane + 256 * j; const f32x4 gn = *(const f32x4*)(lng + col), bn = *(const f32x4*)(lnb + col);
            if (write_h) { const f32x4 sh = *(const f32x4*)(ms + col), sc = *(const f32x4*)(ms + 1024 + col); Av[j] = gn * (sc + 1.f); Bv[j] = bn * (sc + 1.f) + sh; } else { Av[j] = gn; Bv[j] = bn; } }
        int sl0 = 0, sl1 = 0;
        if (YMODE == 1 && r0 + lane < r1) { sl0 = TOKSLOT[2 * (r0 + lane)]; sl1 = TOKSLOT[2 * (r0 + lane) + 1]; }
#define LN_LOAD(R, row_) { const int s0_ = (YMODE == 1) ? (((row_) - r0 < 64) ? __builtin_amdgcn_readlane(sl0, (row_) - r0) : TOKSLOT[2 * (row_)]) : 0, s1_ = (YMODE == 1) ? (((row_) - r0 < 64) ? __builtin_amdgcn_readlane(sl1, (row_) - r0) : TOKSLOT[2 * (row_) + 1]) : 0; \
        const bf16* y0_ = (YMODE == 0) ? Y + (size_t)(row_) * DM : Y + (size_t)s0_ * DM; const bf16* y1_ = Y + (size_t)s1_ * DM; \
        _Pragma("unroll") for (int j = 0; j < 4; ++j) { const int col = 4 * lane + 256 * j; \
            if (XMODE == 0) R.x[j] = *(const f32x4*)(Xin + (size_t)(row_) * DM + col); else R.hx[j] = *(const v2u*)(H + (size_t)(row_) * DM + col); \
            R.ya[j] = *(const v2u*)(y0_ + col); if (YMODE == 1) R.yb[j] = *(const v2u*)(y1_ + col); } }
        LnRaw cur, nx1, nx2;
        LN_LOAD(cur, r0)
        if (r0 + 1 < r1) LN_LOAD(nx1, r0 + 1)
        for (int row = r0; row < r1; ++row) {
            if (ROUTE) asm volatile("" ::: "memory");
            if (row + 2 < r1) LN_LOAD(nx2, row + 2)
            if (!one_batch) {
                const int bb = row >> 12; const float* mg2 = MOD + ((size_t)l * 16 + bb) * 6144 + mod_g; const float* mi2 = MOD + ((size_t)l * 16 + bb) * 6144 + mod_in;
#pragma unroll
                for (int j = 0; j < 4; ++j) { const int col = 4 * lane + 256 * j; gv[j] = *(const f32x4*)(mg2 + col);
                    if (XMODE == 1) { shi[j] = *(const f32x4*)(mi2 + col); const f32x4 sc_ = *(const f32x4*)(mi2 + 1024 + col); sci[j].x = 1.f / (sc_.x + 1.f); sci[j].y = 1.f / (sc_.y + 1.f); sci[j].z = 1.f / (sc_.z + 1.f); sci[j].w = 1.f / (sc_.w + 1.f); } }
            }
            if (!one_batch) {
                const float* msr = MOD + ((size_t)mod_l2 * 16 + (row >> 12)) * 6144 + mod_sh;
#pragma unroll
                for (int j = 0; j < 4; ++j) { const int col = 4 * lane + 256 * j; const f32x4 gn = *(const f32x4*)(lng + col), bn = *(const f32x4*)(lnb + col);
                    if (write_h) { const f32x4 sh = *(const f32x4*)(msr + col), sc = *(const f32x4*)(msr + 1024 + col); Av[j] = gn * (sc + 1.f); Bv[j] = bn * (sc + 1.f) + sh; } else { Av[j] = gn; Bv[j] = bn; } }
            }
            f32x4 v[4]; float s = 0.f;
#pragma unroll
            for (int j = 0; j < 4; ++j) {
                const v2u ya = cur.ya[j];
                f32x4 y; y.x = bf2f(ya.x & 0xffffu); y.y = bf2f(ya.x >> 16); y.z = bf2f(ya.y & 0xffffu); y.w = bf2f(ya.y >> 16);
                if (YMODE == 1) { const v2u yb = cur.yb[j]; y.x += bf2f(yb.x & 0xffffu); y.y += bf2f(yb.x >> 16); y.z += bf2f(yb.y & 0xffffu); y.w += bf2f(yb.y >> 16); }
                f32x4 xr;
                if (XMODE == 0) xr = cur.x[j];
                else { const v2u hh_ = cur.hx[j]; f32x4 hf; hf.x = bf2f(hh_.x & 0xffffu); hf.y = bf2f(hh_.x >> 16); hf.z = bf2f(hh_.y & 0xffffu); hf.w = bf2f(hh_.y >> 16);
                       xr = (hf - shi[j]) * sci[j]; }
                v[j] = xr * DN_ALPHA + (gv[j] + 1.f) * y;
                s += (v[j].x + v[j].y) + (v[j].z + v[j].w);
            }
            const float mean = wave_sum_f(s) * (1.f / DM); float s2 = 0.f;
#pragma unroll
            for (int j = 0; j < 4; ++j) { v[j] = v[j] - mean; s2 += (v[j].x * v[j].x + v[j].y * v[j].y) + (v[j].z * v[j].z + v[j].w * v[j].w); }
            const float rstd = rsqrtf(wave_sum_f(s2) * (1.f / DM) + LN_EPS);
            float lgt[8];
#pragma unroll
            for (int e = 0; e < 8; ++e) lgt[e] = 0.f;
#pragma unroll
            for (int j = 0; j < 4; ++j) {
                const int col = 4 * lane + 256 * j;
                const f32x4 hv = v[j] * rstd * Av[j] + Bv[j];
                if (write_x) *(f32x4*)(C.out + (size_t)row * DM + col) = hv;
                if (write_h) {
                    v2u o; o.x = pk2(hv.x, hv.y); o.y = pk2(hv.z, hv.w);
                    *(v2u*)(H + (size_t)row * DM + col) = o;
                    if (ROUTE) {
                        const float hx[4] = {hv.x, hv.y, hv.z, hv.w};
#pragma unroll
                        for (int c = 0; c < 4; ++c) { const f32x4 w0 = *(const LAS f32x4*)(wrs + (col + c) * NEXP), w1 = *(const LAS f32x4*)(wrs + (col + c) * NEXP + 4);
                            lgt[0] += hx[c] * w0.x; lgt[1] += hx[c] * w0.y; lgt[2] += hx[c] * w0.z; lgt[3] += hx[c] * w0.w;
                            lgt[4] += hx[c] * w1.x; lgt[5] += hx[c] * w1.y; lgt[6] += hx[c] * w1.z; lgt[7] += hx[c] * w1.w; }
                    }
                }
            }
            if (ROUTE) {
#pragma unroll
                for (int e = 0; e < 8; ++e) lgt[e] = wave_sum_f(lgt[e]) + br[e];
                int e0 = 0; float v0 = lgt[0];
#pragma unroll
                for (int e = 1; e < 8; ++e) if (lgt[e] > v0) { v0 = lgt[e]; e0 = e; }
                int e1 = -1; float v1 = -3.0e38f;
#pragma unroll
                for (int e = 0; e < 8; ++e) if (e != e0 && lgt[e] > v1) { v1 = lgt[e]; e1 = e; }
                const float g1 = 1.f / (1.f + expf(v0 - v1)), g0 = 1.f - g1;
                if (lane == 0) { TOPE[2 * row] = e0; TOPE[2 * row + 1] = e1; TOPG[2 * row] = g0; TOPG[2 * row + 1] = g1; }
#pragma unroll
                for (int e = 0; e < 8; ++e) ecnt[e] += (e == e0 ? 1u : 0u) + (e == e1 ? 1u : 0u);
            }
            cur = nx1; nx1 = nx2;
        }
#undef LN_LOAD
    }
    if (ROUTE) {
        unsigned mine = 0u;
#pragma unroll
        for (int e = 0; e < 8; ++e) mine = (lane == e) ? ecnt[e] : mine;
        if (lane < 8 && mine) __hip_atomic_fetch_add(C.ctl + CW_CNT + 64 * jmoe + lane, mine, __ATOMIC_RELAXED, __HIP_MEMORY_SCOPE_AGENT);
    }
}

struct MoeTab { int pend[8]; int npanels; };
__device__ __forceinline__ MoeTab moe_tab(Ctx& C, int jmoe) {
    MoeTab t; int acc = 0;
#pragma unroll
    for (int e = 0; e < 8; ++e) { const int c = (int)__hip_atomic_load(C.ctl + CW_CNT + 64 * jmoe + e, __ATOMIC_RELAXED, __HIP_MEMORY_SCOPE_AGENT); acc += (c + 255) & ~255; t.pend[e] = acc; }
    t.npanels = acc >> 8; return t;
}
__device__ __forceinline__ int panel_expert(const MoeTab& t, int p) {
    int e = 0;
#pragma unroll
    for (int k = 0; k < 7; ++k) e += (p * 256 >= t.pend[k]) ? 1 : 0;
    return e;
}
__device__ __forceinline__ void ph_assign(Ctx& C, int jmoe) {
    const int gw = C.bid * 8 + C.wave, NGW = C.G * 8, lane = C.lane;
    const MoeTab tb = moe_tab(C, jmoe);
    const int* TOPE = (const int*)(C.ws + WS_TOPE); const float* TOPG = (const float*)(C.ws + WS_TOPG);
    int* TOKSLOT = (int*)(C.ws + WS_TOKSLOT); int* ROWTOK = (int*)(C.ws + WS_ROWTOK); float* ROWGATE = (float*)(C.ws + WS_ROWGATE);
    const bf16* H = (const bf16*)(C.ws + WS_H); bf16* HS = (bf16*)(C.ws + WS_Y);
    const unsigned long long ltmask = (lane == 0) ? 0ull : (~0ull >> (64 - lane));
    for (int tk0 = gw * 32; tk0 < MTOK; tk0 += NGW * 32) {
        const int tok = tk0 + (lane & 31); const bool act = lane < 32;
        const int e0 = act ? TOPE[2 * tok] : -1, e1 = act ? TOPE[2 * tok + 1] : -1; const float g0 = TOPG[2 * tok], g1 = TOPG[2 * tok + 1];
        int s0 = 0, s1 = 0;
#pragma unroll
        for (int e = 0; e < 8; ++e) {
            const unsigned long long m0 = __ballot(e0 == e), m1 = __ballot(e1 == e); const int n0 = __popcll(m0), n1 = __popcll(m1);
            int basev = 0;
            if (lane == 0 && (n0 + n1) > 0) basev = (int)__hip_atomic_fetch_add(C.ctl + CW_FILL + 64 * jmoe + e, (unsigned)(n0 + n1), __ATOMIC_RELAXED, __HIP_MEMORY_SCOPE_AGENT);
            basev = __builtin_amdgcn_readfirstlane(basev);
            const int pstart = (e == 0) ? 0 : tb.pend[e > 0 ? e - 1 : 0];
            if (e0 == e) s0 = pstart + basev + __popcll(m0 & ltmask);
            if (e1 == e) s1 = pstart + basev + n0 + __popcll(m1 & ltmask);
        }
        if (act) { TOKSLOT[2 * tok] = s0; TOKSLOT[2 * tok + 1] = s1;
            ROWTOK[s0] = tok; ROWGATE[s0] = g0; ROWTOK[s1] = tok; ROWGATE[s1] = g1; }
#pragma unroll 8
        for (int tt = 0; tt < 32; ++tt) {
            const int d0 = __builtin_amdgcn_readlane(s0, tt), d1 = __builtin_amdgcn_readlane(s1, tt);
            const v4u* src = (const v4u*)(H + (size_t)(tk0 + tt) * DM);
            const v4u a = src[lane], b2 = src[64 + lane];
            v4u* o0 = (v4u*)(HS + (size_t)d0 * DM); v4u* o1 = (v4u*)(HS + (size_t)d1 * DM);
            o0[lane] = a; o0[64 + lane] = b2; o1[lane] = a; o1[64 + lane] = b2;
        }
    }
    for (int idx = gw; idx < 8 * 256; idx += NGW) {
        const int e = idx >> 8, jj = idx & 255;
        const int c = (int)__hip_atomic_load(C.ctl + CW_CNT + 64 * jmoe + e, __ATOMIC_RELAXED, __HIP_MEMORY_SCOPE_AGENT);
        int pstart = 0;
#pragma unroll
        for (int k = 0; k < 7; ++k) if (k < e) pstart = tb.pend[k];
        const int slot = pstart + c + jj;
        if (c + jj < ((c + 255) & ~255)) {
            if (lane == 0) { ROWTOK[slot] = 0; ROWGATE[slot] = 0.f; }
            v4u* o = (v4u*)(HS + (size_t)slot * DM); const v4u z = {0u, 0u, 0u, 0u}; o[lane] = z; o[64 + lane] = z;
        }
    }
}

__device__ __forceinline__ float silu_fast_(float v) { return v * __builtin_amdgcn_rcpf(1.f + __builtin_amdgcn_exp2f(-v * LOG2E)); }
constexpr size_t WS_GLA_LT = WS_Y;
constexpr size_t WS_GLA_SP = WS_Y + 130 * MiB;
constexpr size_t WS_GLA_EB = WS_Y + 128 * MiB;
constexpr int GLA_PITCH = 72;

struct GlaDecay { float b[8]; float Btot; float qv[8]; float kv[8]; };
__device__ __forceinline__ void gla_decay(Ctx& C, int l, int b, int hh, int c, LAS float* segs, GlaDecay& D, int bas_off = 36864) {
    const bf16* PROJ = (const bf16*)(C.ws + WS_P);
    const float* w_a2 = C.in(I_WA2) + (size_t)l * 16 * 256 + hh * 64 + C.lane; const float bias = C.in(I_BA)[l * 256 + hh * 64 + C.lane];
    float w[16];
#pragma unroll
    for (int r = 0; r < 16; ++r) w[r] = w_a2[r * 256];
    const size_t row0 = (size_t)b * SEQ + c * 64 + 8 * C.wave;
    LAS unsigned* baS = (LAS unsigned*)(C.lds + bas_off) + C.wave * 64;
    baS[C.lane] = *(const unsigned*)(PROJ + (row0 + (C.lane >> 3)) * PW + C_BA + 2 * (C.lane & 7));
    float qraw[8], kraw[8];
#pragma unroll
    for (int i = 0; i < 8; ++i) { const bf16* pr = PROJ + (row0 + i) * PW; qraw[i] = bf2f(pr[C_BQ + hh * 64 + C.lane]); kraw[i] = bf2f(pr[C_BK + hh * 64 + C.lane]); }
    asm volatile("s_waitcnt lgkmcnt(0)" ::: "memory");
    float run = 0.f;
#pragma unroll
    for (int i = 0; i < 8; ++i) {
        const v4u ba0 = *(const LAS v4u*)(baS + 8 * i), ba1 = *(const LAS v4u*)(baS + 8 * i + 4);
        const unsigned bw[8] = {ba0.x, ba0.y, ba0.z, ba0.w, ba1.x, ba1.y, ba1.z, ba1.w};
        float z = bias;
#pragma unroll
        for (int r = 0; r < 8; ++r) { z += bf2f(bw[r] & 0xffffu) * w[2 * r]; z += bf2f(bw[r] >> 16) * w[2 * r + 1]; }
        const float ls = fminf(z, 0.f) - __logf(1.f + __expf(-fabsf(z)));
        run += ls * (1.f / 16.f);
        D.b[i] = run;
        D.qv[i] = qraw[i]; D.kv[i] = kraw[i];
    }
    segs[C.wave * 64 + C.lane] = run;
    __syncthreads();
    float off = 0.f, tot = 0.f;
#pragma unroll
    for (int w8 = 0; w8 < 8; ++w8) { const float sv = segs[w8 * 64 + C.lane]; tot += sv; off += (w8 < C.wave) ? sv : 0.f; }
#pragma unroll
    for (int i = 0; i < 8; ++i) D.b[i] += off;
    D.Btot = tot;
}
__device__ __forceinline__ bf16x8 gla_vt_frag(const bf16* vcol, int ks, int h) {
    unsigned short x[8];
#pragma unroll
    for (int j = 0; j < 8; ++j) x[j] = vcol[(size_t)(16 * ks + 8 * (j >> 2) + 4 * h + (j & 3)) * PW];
    v4u p; p.x = (unsigned)x[0] | ((unsigned)x[1] << 16); p.y = (unsigned)x[2] | ((unsigned)x[3] << 16); p.z = (unsigned)x[4] | ((unsigned)x[5] << 16); p.w = (unsigned)x[6] | ((unsigned)x[7] << 16);
    return __builtin_bit_cast(bf16x8, p);
}

__device__ __forceinline__ void ph_gla1_unit(Ctx& C, int l, int unit) {
    const int c = unit & 63, hh = (unit >> 6) & 3, b = unit >> 8;
    LAS bf16* KDT = (LAS bf16*)C.lds;
    LAS float* segs = (LAS float*)(C.lds + 32768);
    const bf16* PROJ = (const bf16*)(C.ws + WS_P);
    const int mt = C.wave >> 1, nd = C.wave & 1, n = C.lane & 31, h = C.lane >> 5;
    const bf16* vcol = PROJ + ((size_t)b * SEQ + c * 64) * PW + C_BV + hh * 128 + 32 * mt + n;
    bf16x8 vf[4];
#pragma unroll
    for (int ks = 0; ks < 4; ++ks) vf[ks] = gla_vt_frag(vcol, ks, h);
    GlaDecay D; gla_decay(C, l, b, hh, c, segs, D);
    {
        v4u p;
        p.x = pk2(D.kv[0] * __expf(D.Btot - D.b[0]), D.kv[1] * __expf(D.Btot - D.b[1])); p.y = pk2(D.kv[2] * __expf(D.Btot - D.b[2]), D.kv[3] * __expf(D.Btot - D.b[3]));
        p.z = pk2(D.kv[4] * __expf(D.Btot - D.b[4]), D.kv[5] * __expf(D.Btot - D.b[5])); p.w = pk2(D.kv[6] * __expf(D.Btot - D.b[6]), D.kv[7] * __expf(D.Btot - D.b[7]));
        *(LAS v4u*)(KDT + C.lane * GLA_PITCH + 8 * C.wave) = p;
        if (C.wave == 0) ((float*)(C.ws + WS_GLA_EB))[(size_t)unit * 64 + C.lane] = __expf(D.Btot);
    }
    __syncthreads();
    f32x16 acc;
#pragma unroll
    for (int i = 0; i < 16; ++i) acc[i] = 0.f;
#pragma unroll
    for (int ks = 0; ks < 4; ++ks) {
        const LAS bf16* kp = KDT + (32 * nd + n) * GLA_PITCH + 16 * ks + 4 * h;
        const v2u k0 = *(const LAS v2u*)kp, k1 = *(const LAS v2u*)(kp + 8);
        v4u kk; kk.x = k0.x; kk.y = k0.y; kk.z = k1.x; kk.w = k1.y;
        acc = mfma32(vf[ks], __builtin_bit_cast(bf16x8, kk), acc);
    }
    float* LT = (float*)(C.ws + WS_GLA_LT) + (size_t)unit * 8192;
#pragma unroll
    for (int r = 0; r < 16; ++r) LT[(32 * mt + (r & 3) + 8 * (r >> 2) + 4 * h) * 64 + 32 * nd + n] = acc[r];
    __syncthreads();
}

__device__ __forceinline__ void ph_gla2(Ctx& C, size_t probe_off = 0) {
    const f32x4* LT = (const f32x4*)(C.ws + WS_GLA_LT); v2u* SP = (v2u*)(C.ws + WS_GLA_SP + probe_off); const float* EB = (const float*)(C.ws + WS_GLA_EB);
    for (int it = C.bid; it < 64 * 4; it += C.G) {
        const int bh = it >> 2, idx = (it & 3) * 512 + C.tid;
        const f32x4* p = LT + (size_t)bh * 64 * 2048 + idx; v2u* q = SP + (size_t)bh * 64 * 2048 + idx; const float* eb = EB + (size_t)bh * 64 * 64 + ((4 * idx) & 63);
        float S0 = 0.f, S1 = 0.f, S2 = 0.f, S3 = 0.f;
#pragma unroll 16
        for (int c = 0; c < 64; ++c) { const f32x4 lv = p[(size_t)c * 2048]; const f32x4 e = *(const f32x4*)(eb + c * 64);
            v2u o; o.x = pk2(S0, S1); o.y = pk2(S2, S3); q[(size_t)c * 2048] = o;
            S0 = e.x * S0 + lv.x; S1 = e.y * S1 + lv.y; S2 = e.z * S2 + lv.z; S3 = e.w * S3 + lv.w; }
    }
}

__device__ __forceinline__ void ph_gla3_unit(Ctx& C, int l, int unit) {
    const int c = unit & 63, hh = (unit >> 6) & 3, b = unit >> 8;
    LAS bf16* QE = (LAS bf16*)C.lds;
    LAS bf16* KE = QE + 64 * GLA_PITCH;
    LAS float* segs = (LAS float*)(C.lds + 32768);
    LAS float* ssq = (LAS float*)(C.lds + 32768 + 2048);
    const bf16* PROJ = (const bf16*)(C.ws + WS_P); bf16* YM = (bf16*)C.out;
    const int mt = C.wave >> 1, nt = C.wave & 1, n = C.lane & 31, h = C.lane >> 5;
    const size_t row0 = (size_t)b * SEQ + c * 64;
    const bf16* vcol = PROJ + row0 * PW + C_BV + hh * 128 + 32 * mt + n;
    bf16x8 vf[4]; bf16x8 spf[4]; v2u gb[4]; f32x4 gnv[4];
#pragma unroll
    for (int ks = 0; ks < 4; ++ks) vf[ks] = gla_vt_frag(vcol, (ks <= 2 * nt + 1) ? ks : 0, h);
    {
        const bf16* Sp = (const bf16*)(C.ws + WS_GLA_SP) + (size_t)unit * 8192 + (size_t)(32 * mt + n) * 64 + 8 * h;
#pragma unroll
        for (int ks = 0; ks < 4; ++ks) spf[ks] = *(const bf16x8*)(Sp + 16 * ks);
#pragma unroll
        for (int j4 = 0; j4 < 4; ++j4) { gb[j4] = *(const v2u*)(PROJ + (row0 + 32 * nt + n) * PW + C_BG + hh * 128 + 32 * mt + 8 * j4 + 4 * h); gnv[j4] = *(const f32x4*)(C.in(I_GLAG) + l * 128 + 32 * mt + 8 * j4 + 4 * h); }
    }
    GlaDecay D; gla_decay(C, l, b, hh, c, segs, D);
#pragma unroll
    for (int i = 0; i < 8; ++i) {
        QE[(8 * C.wave + i) * GLA_PITCH + C.lane] = (bf16)f2bf(D.qv[i] * 0.125f * __expf(D.b[i]));
        KE[(8 * C.wave + i) * GLA_PITCH + C.lane] = (bf16)f2bf(D.kv[i] * __expf(-D.b[i]));
    }
    __syncthreads();
    bf16x8 qf[4];
#pragma unroll
    for (int ks = 0; ks < 4; ++ks) qf[ks] = *(const LAS bf16x8*)(QE + (32 * nt + n) * GLA_PITCH + 16 * ks + 8 * h);
    f32x16 accO;
#pragma unroll
    for (int i = 0; i < 16; ++i) accO[i] = 0.f;
#pragma unroll
    for (int ms = 0; ms < 2; ++ms) {
        if (ms <= nt) {
            f32x16 aT;
#pragma unroll
            for (int i = 0; i < 16; ++i) aT[i] = 0.f;
#pragma unroll
            for (int ks = 0; ks < 4; ++ks) { const bf16x8 kf = *(const LAS bf16x8*)(KE + (32 * ms + n) * GLA_PITCH + 16 * ks + 8 * h); aT = mfma32(kf, qf[ks], aT); }
            if (ms == nt) {
#pragma unroll
                for (int r = 0; r < 16; ++r) { const int s = (r & 3) + 8 * (r >> 2) + 4 * h; aT[r] = (s <= n) ? aT[r] : 0.f; }
            }
#pragma unroll
            for (int s2 = 0; s2 < 2; ++s2) {
                v4u pa; pa.x = pk2(aT[8 * s2 + 0], aT[8 * s2 + 1]); pa.y = pk2(aT[8 * s2 + 2], aT[8 * s2 + 3]); pa.z = pk2(aT[8 * s2 + 4], aT[8 * s2 + 5]); pa.w = pk2(aT[8 * s2 + 6], aT[8 * s2 + 7]);
                accO = mfma32(vf[2 * ms + s2], __builtin_bit_cast(bf16x8, pa), accO);
            }
        }
    }
    {
#pragma unroll
        for (int ks = 0; ks < 4; ++ks) accO = mfma32(spf[ks], qf[ks], accO);
    }
    float sq = 0.f;
#pragma unroll
    for (int r = 0; r < 16; ++r) sq += accO[r] * accO[r];
    sq += SHX_F(sq, 32, C.lane);
    if (h == 0) ssq[mt * 64 + 32 * nt + n] = sq;
    __syncthreads();
    const float rstd = rsqrtf(((ssq[32 * nt + n] + ssq[64 + 32 * nt + n]) + (ssq[128 + 32 * nt + n] + ssq[192 + 32 * nt + n])) * (1.f / 128.f) + LN_EPS);
    const size_t row = row0 + 32 * nt + n;
#pragma unroll
    for (int j4 = 0; j4 < 4; ++j4) {
        const int e0 = 32 * mt + 8 * j4 + 4 * h;
        const v2u gbv = gb[j4]; const f32x4 gn = gnv[j4];
        const float y0 = accO[4 * j4 + 0] * rstd * gn.x * silu_fast_(bf2f(gbv.x & 0xffffu)), y1 = accO[4 * j4 + 1] * rstd * gn.y * silu_fast_(bf2f(gbv.x >> 16));
        const float y2 = accO[4 * j4 + 2] * rstd * gn.z * silu_fast_(bf2f(gbv.y & 0xffffu)), y3 = accO[4 * j4 + 3] * rstd * gn.w * silu_fast_(bf2f(gbv.y >> 16));
        v2u o; o.x = pk2(y0, y1); o.y = pk2(y2, y3);
        *(v2u*)(YM + row * DM + 512 + hh * 128 + e0) = o;
    }
    __syncthreads();
}

constexpr int GS_QE = 0, GS_KE = 9216, GS_KDT = 18432, GS_SB = 27648, GS_SEGS = 46080, GS_SSQ = 48128, GS_EB = 49152, GS_BAS = 49408;
struct GlaIn { bf16x8 vf[4]; v2u gb[4]; unsigned ba; float q[8], k[8]; };
__device__ __forceinline__ void gla_seq_load(Ctx& C, int b, int hh, int c, GlaIn& I) {
    const bf16* PROJ = (const bf16*)(C.ws + WS_P);
    const int mt = C.wave >> 1, x = C.wave & 1, n = C.lane & 31, h = C.lane >> 5;
    const size_t row0 = (size_t)b * SEQ + c * 64;
    const bf16* vcol = PROJ + row0 * PW + C_BV + hh * 128 + 32 * mt + n;
#pragma unroll
    for (int ks = 0; ks < 4; ++ks) I.vf[ks] = gla_vt_frag(vcol, ks, h);
#pragma unroll
    for (int j4 = 0; j4 < 4; ++j4) I.gb[j4] = *(const v2u*)(PROJ + (row0 + 32 * x + n) * PW + C_BG + hh * 128 + 32 * mt + 8 * j4 + 4 * h);
    const size_t rw = row0 + 8 * C.wave;
    I.ba = *(const unsigned*)(PROJ + (rw + (C.lane >> 3)) * PW + C_BA + 2 * (C.lane & 7));
#pragma unroll
    for (int i = 0; i < 8; ++i) { const bf16* pr = PROJ + (rw + i) * PW; I.q[i] = bf2f(pr[C_BQ + hh * 64 + C.lane]); I.k[i] = bf2f(pr[C_BK + hh * 64 + C.lane]); }
}
__device__ __forceinline__ void ph_gla_seq(Ctx& C, int l, int seq) {
    const int hh = seq & 3, b = seq >> 2;
    LAS bf16* QE = (LAS bf16*)(C.lds + GS_QE); LAS bf16* KE = (LAS bf16*)(C.lds + GS_KE); LAS bf16* KDT = (LAS bf16*)(C.lds + GS_KDT); LAS bf16* SB = (LAS bf16*)(C.lds + GS_SB);
    LAS float* segs = (LAS float*)(C.lds + GS_SEGS); LAS float* ssq = (LAS float*)(C.lds + GS_SSQ); LAS float* ebS = (LAS float*)(C.lds + GS_EB);
    LAS unsigned* baS = (LAS unsigned*)(C.lds + GS_BAS) + C.wave * 64;
    bf16* YM = (bf16*)C.out;
    const int mt = C.wave >> 1, x = C.wave & 1, n = C.lane & 31, h = C.lane >> 5;
    f32x16 st;
#pragma unroll
    for (int i = 0; i < 16; ++i) st[i] = 0.f;
    for (int i = C.tid; i < 128 * GLA_PITCH / 2; i += 512) ((LAS unsigned*)SB)[i] = 0u;
    f32x4 gnv[4];
#pragma unroll
    for (int j4 = 0; j4 < 4; ++j4) gnv[j4] = *(const f32x4*)(C.in(I_GLAG) + l * 128 + 32 * mt + 8 * j4 + 4 * h);
    float w[16];
    { const float* w_a2 = C.in(I_WA2) + (size_t)l * 16 * 256 + hh * 64 + C.lane;
#pragma unroll
      for (int r = 0; r < 16; ++r) w[r] = w_a2[r * 256]; }
    const float bias = C.in(I_BA)[l * 256 + hh * 64 + C.lane];
    GlaIn I; gla_seq_load(C, b, hh, 0, I);
    __syncthreads();
#pragma unroll 1
    for (int c = 0; c < 64; ++c) {
        const size_t row0 = (size_t)b * SEQ + c * 64;
        bf16x8 vf[4]; v2u gb[4]; GlaDecay D;
#pragma unroll
        for (int ks = 0; ks < 4; ++ks) vf[ks] = I.vf[ks];
#pragma unroll
        for (int j4 = 0; j4 < 4; ++j4) gb[j4] = I.gb[j4];
        baS[C.lane] = I.ba;
#pragma unroll
        for (int i = 0; i < 8; ++i) { D.qv[i] = I.q[i]; D.kv[i] = I.k[i]; }
        gla_seq_load(C, b, hh, c < 63 ? c + 1 : 63, I);
        {
            asm volatile("" ::: "memory");
            float run = 0.f;
#pragma unroll
            for (int i = 0; i < 8; ++i) {
                const v4u ba0 = *(const LAS v4u*)(baS + 8 * i), ba1 = *(const LAS v4u*)(baS + 8 * i + 4);
                const unsigned bw[8] = {ba0.x, ba0.y, ba0.z, ba0.w, ba1.x, ba1.y, ba1.z, ba1.w};
                float z = bias;
#pragma unroll
                for (int r = 0; r < 8; ++r) { z += bf2f(bw[r] & 0xffffu) * w[2 * r]; z += bf2f(bw[r] >> 16) * w[2 * r + 1]; }
                const float ls = fminf(z, 0.f) - __logf(1.f + __expf(-fabsf(z)));
                run += ls * (1.f / 16.f);
                D.b[i] = run;
            }
            segs[C.wave * 64 + C.lane] = run;
            __syncthreads();
            float off = 0.f, tot = 0.f;
#pragma unroll
            for (int w8 = 0; w8 < 8; ++w8) { const float sv = segs[w8 * 64 + C.lane]; tot += sv; off += (w8 < C.wave) ? sv : 0.f; }
#pragma unroll
            for (int i = 0; i < 8; ++i) D.b[i] += off;
            D.Btot = tot;
        }
#pragma unroll
        for (int i = 0; i < 8; ++i) {
            QE[(8 * C.wave + i) * GLA_PITCH + C.lane] = (bf16)f2bf(D.qv[i] * 0.125f * __expf(D.b[i]));
            KE[(8 * C.wave + i) * GLA_PITCH + C.lane] = (bf16)f2bf(D.kv[i] * __expf(-D.b[i]));
        }
        {
            v4u p;
            p.x = pk2(D.kv[0] * __expf(D.Btot - D.b[0]), D.kv[1] * __expf(D.Btot - D.b[1])); p.y = pk2(D.kv[2] * __expf(D.Btot - D.b[2]), D.kv[3] * __expf(D.Btot - D.b[3]));
            p.z = pk2(D.kv[4] * __expf(D.Btot - D.b[4]), D.kv[5] * __expf(D.Btot - D.b[5])); p.w = pk2(D.kv[6] * __expf(D.Btot - D.b[6]), D.kv[7] * __expf(D.Btot - D.b[7]));
            *(LAS v4u*)(KDT + C.lane * GLA_PITCH + 8 * C.wave) = p;
            if (C.wave == 0) ebS[C.lane] = __expf(D.Btot);
        }
        __syncthreads();
        bf16x8 qf[4];
#pragma unroll
        for (int ks = 0; ks < 4; ++ks) qf[ks] = *(const LAS bf16x8*)(QE + (32 * x + n) * GLA_PITCH + 16 * ks + 8 * h);
        f32x16 accO;
#pragma unroll
        for (int i = 0; i < 16; ++i) accO[i] = 0.f;
#pragma unroll
        for (int ms = 0; ms < 2; ++ms) {
            if (ms <= x) {
                f32x16 aT;
#pragma unroll
                for (int i = 0; i < 16; ++i) aT[i] = 0.f;
#pragma unroll
                for (int ks = 0; ks < 4; ++ks) { const bf16x8 kf = *(const LAS bf16x8*)(KE + (32 * ms + n) * GLA_PITCH + 16 * ks + 8 * h); aT = mfma32(kf, qf[ks], aT); }
                if (ms == x) {
#pragma unroll
                    for (int r = 0; r < 16; ++r) { const int sx = (r & 3) + 8 * (r >> 2) + 4 * h; aT[r] = (sx <= n) ? aT[r] : 0.f; }
                }
#pragma unroll
                for (int s2 = 0; s2 < 2; ++s2) {
                    v4u pa; pa.x = pk2(aT[8 * s2 + 0], aT[8 * s2 + 1]); pa.y = pk2(aT[8 * s2 + 2], aT[8 * s2 + 3]); pa.z = pk2(aT[8 * s2 + 4], aT[8 * s2 + 5]); pa.w = pk2(aT[8 * s2 + 6], aT[8 * s2 + 7]);
                    accO = mfma32(vf[2 * ms + s2], __builtin_bit_cast(bf16x8, pa), accO);
                }
            }
        }
#pragma unroll
        for (int ks = 0; ks < 4; ++ks) { const bf16x8 spf = *(const LAS bf16x8*)(SB + (32 * mt + n) * GLA_PITCH + 16 * ks + 8 * h); accO = mfma32(spf, qf[ks], accO); }
        {
            f32x16 accL;
#pragma unroll
            for (int i = 0; i < 16; ++i) accL[i] = 0.f;
#pragma unroll
            for (int ks = 0; ks < 4; ++ks) {
                const LAS bf16* kp = KDT + (32 * x + n) * GLA_PITCH + 16 * ks + 4 * h;
                const v2u k0 = *(const LAS v2u*)kp, k1 = *(const LAS v2u*)(kp + 8);
                v4u kk; kk.x = k0.x; kk.y = k0.y; kk.z = k1.x; kk.w = k1.y;
                accL = mfma32(vf[ks], __builtin_bit_cast(bf16x8, kk), accL);
            }
            const float eb = ebS[32 * x + n];
#pragma unroll
            for (int i = 0; i < 16; ++i) st[i] = st[i] * eb + accL[i];
        }
        float sq = 0.f;
#pragma unroll
        for (int r = 0; r < 16; ++r) sq += accO[r] * accO[r];
        sq += SHX_F(sq, 32, C.lane);
        if (h == 0) ssq[mt * 64 + 32 * x + n] = sq;
        __syncthreads();
#pragma unroll
        for (int r = 0; r < 16; ++r) SB[(32 * mt + (r & 3) + 8 * (r >> 2) + 4 * h) * GLA_PITCH + 32 * x + n] = (bf16)f2bf(st[r]);
        const float rstd = rsqrtf(((ssq[32 * x + n] + ssq[64 + 32 * x + n]) + (ssq[128 + 32 * x + n] + ssq[192 + 32 * x + n])) * (1.f / 128.f) + LN_EPS);
        const size_t row = row0 + 32 * x + n;
#pragma unroll
        for (int j4 = 0; j4 < 4; ++j4) {
            const int e0 = 32 * mt + 8 * j4 + 4 * h;
            const v2u gbv = gb[j4]; const f32x4 gn = gnv[j4];
            const float y0 = accO[4 * j4 + 0] * rstd * gn.x * silu_fast_(bf2f(gbv.x & 0xffffu)), y1 = accO[4 * j4 + 1] * rstd * gn.y * silu_fast_(bf2f(gbv.x >> 16));
            const float y2 = accO[4 * j4 + 2] * rstd * gn.z * silu_fast_(bf2f(gbv.y & 0xffffu)), y3 = accO[4 * j4 + 3] * rstd * gn.w * silu_fast_(bf2f(gbv.y >> 16));
            v2u o; o.x = pk2(y0, y1); o.y = pk2(y2, y3);
            *(v2u*)(YM + row * DM + 512 + hh * 128 + e0) = o;
        }
    }
    __syncthreads();
}

#ifndef A3_VPATH
#define A3_VPATH(i) (true)
#endif
#ifndef REP_S
#define REP_S 1
#endif
constexpr size_t WS_KFI = 932 * MiB, WS_KFA = 940 * MiB, WS_VF = 948 * MiB;

__device__ __forceinline__ void ph_dsa_a2_unit(Ctx& C, int b, int t0) {
    LAS unsigned* cnt = (LAS unsigned*)(C.lds + 131072);
    const bf16* PROJ = (const bf16*)(C.ws + WS_P); unsigned* SEL = (unsigned*)(C.ws + WS_SEL); const bf16* KFI = (const bf16*)(C.ws + WS_KFI);
    const int lane = C.lane, n = lane & 31, h = lane >> 5, tid = C.tid, wave = C.wave;
    const int nk = t0 + 8, ntile = (nk + 31) >> 5;
    if (tid < 48) cnt[tid] = 0u;
    unsigned u[16][4];
    {
        bf16x8 af[2][4]; float wv[2][2][8];
        const int jq = 2 * ((n >> 4) & 1) + ((n >> 2) & 1), hd = 4 * ((n >> 3) & 1) + (n & 3);
#pragma unroll
        for (int mt = 0; mt < 2; ++mt) {
            const bf16* p = PROJ + (size_t)(b * SEQ + t0 + 4 * mt + jq) * PW + C_IQ + hd * 64 + 8 * h;
#pragma unroll
            for (int ks = 0; ks < 4; ++ks) af[mt][ks] = *(const bf16x8*)(p + ks * 16);
#pragma unroll
            for (int g = 0; g < 2; ++g) {
                const v4u w4 = *(const v4u*)(PROJ + (size_t)(b * SEQ + t0 + 4 * mt + 2 * g + h) * PW + C_IW); const unsigned ww[4] = {w4.x, w4.y, w4.z, w4.w};
#pragma unroll
                for (int x = 0; x < 4; ++x) { wv[mt][g][2 * x] = bf2f(ww[x] & 0xffffu) * (0.35355339059327373f * 0.125f); wv[mt][g][2 * x + 1] = bf2f(ww[x] >> 16) * (0.35355339059327373f * 0.125f); }
            }
        }
        const bf16* kbase = KFI + (size_t)(b * 128) * 2048 + lane * 8;
#pragma unroll
        for (int i = 0; i < 16; ++i) {
            const int tile = wave + 8 * i;
#pragma unroll
            for (int k = 0; k < 4; ++k) u[i][k] = 0u;
            if (tile < ntile) {
                bf16x8 bcur[4];
#pragma unroll
                for (int ks = 0; ks < 4; ++ks) bcur[ks] = *(const bf16x8*)(kbase + (size_t)tile * 2048 + ks * 512);
                const int s = tile * 32 + n;
#pragma unroll
                for (int mt = 0; mt < 2; ++mt) {
                    f32x16 acc;
#pragma unroll
                    for (int x = 0; x < 16; ++x) acc[x] = 0.f;
#pragma unroll
                    for (int ks = 0; ks < 4; ++ks) acc = mfma32(af[mt][ks], bcur[ks], acc);
#pragma unroll
                    for (int g = 0; g < 2; ++g) {
                        float p = 0.f;
#pragma unroll
                        for (int x = 0; x < 8; ++x) p += wv[mt][g][x] * fmaxf(acc[8 * g + x], 0.f);
                        const int t = t0 + 4 * mt + 2 * g + h;
                        u[i][2 * mt + g] = (s <= t) ? sortable_u32(p) : 0u;
                    }
                }
            }
            __builtin_amdgcn_sched_barrier(0);
        }
    }
    __syncthreads();
    unsigned Tl[4], Jl[4], needl[4];
#pragma unroll
    for (int k = 0; k < 4; ++k) { Tl[k] = 0u; Jl[k] = 8192u; needl[k] = 0u; }
    int buf = 0;
#define DSA_COUNT(PRED) \
        _Pragma("unroll") for (int i = 0; i < 16; ++i) if (wave + 8 * i < ntile) { const unsigned s = (unsigned)((wave + 8 * i) * 32 + n); (void)s; \
            _Pragma("unroll") for (int k = 0; k < 4; ++k) { const unsigned uu = u[i][k]; const unsigned long long bm = __ballot(PRED); cq[2 * k] += (unsigned)__popc((unsigned)bm); cq[2 * k + 1] += (unsigned)__popc((unsigned)(bm >> 32)); } __builtin_amdgcn_sched_barrier(0); }
#define DSA_PUBLISH(NW) { unsigned myc = 0u; \
        _Pragma("unroll") for (int q = 0; q < NW; ++q) myc = (lane == q) ? cq[q] : myc; \
        if (lane < NW) __hip_atomic_fetch_add(cnt + buf * 16 + lane, myc, __ATOMIC_RELAXED, __HIP_MEMORY_SCOPE_WORKGROUP); \
        nb = (buf == 2) ? 0 : buf + 1; if (tid >= 64 && tid < 80) cnt[nb * 16 + (tid - 64)] = 0u; __syncthreads(); }
#pragma unroll 1
    for (int bit = 31; bit >= 0; --bit) {
        unsigned cq[8]; int nb;
#pragma unroll
        for (int q = 0; q < 8; ++q) cq[q] = 0u;
        unsigned cl[4];
#pragma unroll
        for (int k = 0; k < 4; ++k) cl[k] = Tl[k] | (1u << bit);
        DSA_COUNT(uu >= cl[k])
        DSA_PUBLISH(8)
#pragma unroll
        for (int k = 0; k < 4; ++k) if (cnt[buf * 16 + 2 * k + h] >= 256u) Tl[k] = cl[k];
        buf = nb;
    }
#pragma unroll
    for (int k = 0; k < 4; ++k) Tl[k] = Tl[k] < 1u ? 1u : Tl[k];
    bool extra = false;
    {
        unsigned cq[16]; int nb;
#pragma unroll
        for (int q = 0; q < 16; ++q) cq[q] = 0u;
#pragma unroll
        for (int i = 0; i < 16; ++i) if (wave + 8 * i < ntile) {
#pragma unroll
            for (int k = 0; k < 4; ++k) { const unsigned uu = u[i][k];
                const unsigned long long bg = __ballot(uu > Tl[k]), be = __ballot(uu >= Tl[k]);
                cq[2 * k] += (unsigned)__popc((unsigned)bg); cq[2 * k + 1] += (unsigned)__popc((unsigned)(bg >> 32));
                cq[8 + 2 * k] += (unsigned)__popc((unsigned)be); cq[8 + 2 * k + 1] += (unsigned)__popc((unsigned)(be >> 32)); }
            __builtin_amdgcn_sched_barrier(0);
        }
        DSA_PUBLISH(16)
#pragma unroll
        for (int k = 0; k < 4; ++k) { const unsigned g = cnt[buf * 16 + 2 * k + h]; needl[k] = 256u - (g < 256u ? g : 256u); }
#pragma unroll
        for (int q = 0; q < 8; ++q) extra = extra || (cnt[buf * 16 + 8 + q] > 256u);
        buf = nb;
    }
    if (extra) {
#pragma unroll
        for (int k = 0; k < 4; ++k) Jl[k] = 0u;
#pragma unroll 1
        for (int bit = 12; bit >= 0; --bit) {
            unsigned cq[8]; int nb;
#pragma unroll
            for (int q = 0; q < 8; ++q) cq[q] = 0u;
            unsigned jl[4];
#pragma unroll
            for (int k = 0; k < 4; ++k) jl[k] = Jl[k] | (1u << bit);
            DSA_COUNT(uu == Tl[k] && s < jl[k])
            DSA_PUBLISH(8)
#pragma unroll
            for (int k = 0; k < 4; ++k) if (cnt[buf * 16 + 2 * k + h] <= needl[k]) Jl[k] = jl[k];
            buf = nb;
        }
    }
    {
        unsigned wsel[4];
#pragma unroll
        for (int k = 0; k < 4; ++k) wsel[k] = 0u;
#pragma unroll
        for (int i = 0; i < 16; ++i) if (wave + 8 * i < ntile) {
            const unsigned s = (unsigned)((wave + 8 * i) * 32 + n);
#pragma unroll
            for (int k = 0; k < 4; ++k) {
                const unsigned uu = u[i][k];
                const unsigned long long bm = __ballot((uu > Tl[k]) || (uu == Tl[k] && s < Jl[k]));
                const unsigned wd = h ? (unsigned)(bm >> 32) : (unsigned)bm;
                wsel[k] = (n == i) ? wd : wsel[k];
            }
            __builtin_amdgcn_sched_barrier(0);
        }
        const int tile = wave + 8 * n;
        if (n < 16 && tile < ntile) {
#pragma unroll
            for (int k = 0; k < 4; ++k) SEL[(size_t)(b * SEQ + t0 + 2 * k + h) * 128 + tile] = wsel[k];
        }
    }
#undef DSA_COUNT
#undef DSA_PUBLISH
    __syncthreads();
}


constexpr int A3_QP = 64 * 68;
struct A3Q { bf16x8 af[2][4]; v4u wq; };
__device__ __forceinline__ void a3_load_q(Ctx& C, int b, int t0, A3Q& Q) {
    const bf16* PROJ = (const bf16*)(C.ws + WS_P);
    const int n = C.lane & 31, h = C.lane >> 5;
    const int jq = 2 * ((n >> 4) & 1) + ((n >> 2) & 1), hd = 4 * ((n >> 3) & 1) + (n & 3);
#pragma unroll
    for (int mt = 0; mt < 2; ++mt) {
        const bf16* p = PROJ + (size_t)(b * SEQ + t0 + 4 * mt + jq) * PW + C_IQ + hd * 64 + 8 * h;
#pragma unroll
        for (int ks = 0; ks < 4; ++ks) Q.af[mt][ks] = *(const bf16x8*)(p + ks * 16);
    }
    Q.wq = *(const v4u*)(PROJ + (size_t)(b * SEQ + t0 + (n & 7)) * PW + C_IW);
}
__device__ __forceinline__ void ph_dsa_a3_unit(Ctx& C, int b, int t0, A3Q& Q, bool has_next, int nb, int nt0) {
    LAS unsigned* sc = (LAS unsigned*)C.lds;
    const bf16* PROJ = (const bf16*)(C.ws + WS_P); unsigned* SEL = (unsigned*)(C.ws + WS_SEL); const bf16* KFI = (const bf16*)(C.ws + WS_KFI);
    const int lane = C.lane, n = lane & 31, h = lane >> 5, wave = C.wave;
    const int nk = t0 + 8, ntile = (nk + 31) >> 5;
    {
        typedef _Float16 h8_t __attribute__((ext_vector_type(8)));
        typedef _Float16 h2_t __attribute__((ext_vector_type(2)));
        h8_t wf[2][2];
        {
            const unsigned ww[4] = {Q.wq.x, Q.wq.y, Q.wq.z, Q.wq.w}; unsigned wp[4];
#pragma unroll
            for (int x = 0; x < 4; ++x) wp[x] = __builtin_bit_cast(unsigned, __builtin_amdgcn_cvt_pkrtz(bf2f(ww[x] & 0xffffu) * (0.35355339059327373f * 0.125f), bf2f(ww[x] >> 16) * (0.35355339059327373f * 0.125f)));
#pragma unroll
            for (int mt = 0; mt < 2; ++mt)
#pragma unroll
                for (int ks = 0; ks < 2; ++ks) { const bool on = (n < 8) && ((n >> 2) == mt) && ((n & 3) == 2 * ks + h);
                    v4u f; f.x = on ? wp[0] : 0u; f.y = on ? wp[1] : 0u; f.z = on ? wp[2] : 0u; f.w = on ? wp[3] : 0u; wf[mt][ks] = __builtin_bit_cast(h8_t, f); }
        }
        const bf16* kbase = KFI + (size_t)(b * 128) * 2048 + lane * 8;
        bf16x8 kA[4], kB[4];
        { const int ta = wave < ntile ? wave : 0, tb = wave + 8 < ntile ? wave + 8 : ta;
#pragma unroll
          for (int ks = 0; ks < 4; ++ks) { kA[ks] = *(const bf16x8*)(kbase + (size_t)ta * 2048 + ks * 512); kB[ks] = *(const bf16x8*)(kbase + (size_t)tb * 2048 + ks * 512); } }
#define A3_MMA(A0, A1, KF) { const f32x16 z16_ = {0.f, 0.f, 0.f, 0.f, 0.f, 0.f, 0.f, 0.f, 0.f, 0.f, 0.f, 0.f, 0.f, 0.f, 0.f, 0.f}; \
            A0 = mfma32(Q.af[0][0], KF[0], z16_); A1 = mfma32(Q.af[1][0], KF[0], z16_); \
            _Pragma("unroll") for (int ks = 1; ks < 4; ++ks) { A0 = mfma32(Q.af[0][ks], KF[ks], A0); A1 = mfma32(Q.af[1][ks], KF[ks], A1); } }
#define A3_RELU4(A, r0_) ({ v4u f_; const h2_t z2_ = {(_Float16)0.f, (_Float16)0.f}; \
                f_.x = __builtin_bit_cast(unsigned, __builtin_elementwise_max(__builtin_bit_cast(h2_t, __builtin_amdgcn_cvt_pkrtz(A[(r0_)], A[(r0_) + 1])), z2_)); \
                f_.y = __builtin_bit_cast(unsigned, __builtin_elementwise_max(__builtin_bit_cast(h2_t, __builtin_amdgcn_cvt_pkrtz(A[(r0_) + 2], A[(r0_) + 3])), z2_)); \
                f_.z = __builtin_bit_cast(unsigned, __builtin_elementwise_max(__builtin_bit_cast(h2_t, __builtin_amdgcn_cvt_pkrtz(A[(r0_) + 4], A[(r0_) + 5])), z2_)); \
                f_.w = __builtin_bit_cast(unsigned, __builtin_elementwise_max(__builtin_bit_cast(h2_t, __builtin_amdgcn_cvt_pkrtz(A[(r0_) + 6], A[(r0_) + 7])), z2_)); \
                __builtin_bit_cast(h8_t, f_); })
#define A3_EPI(A0, A1, tile_) { const int s = (tile_) * 32 + n; const f32x16 z16e_ = {0.f, 0.f, 0.f, 0.f, 0.f, 0.f, 0.f, 0.f, 0.f, 0.f, 0.f, 0.f, 0.f, 0.f, 0.f, 0.f}; \
            f32x16 P_ = __builtin_amdgcn_mfma_f32_32x32x16_f16(wf[0][0], A3_RELU4(A0, 0), z16e_, 0, 0, 0); P_ = __builtin_amdgcn_mfma_f32_32x32x16_f16(wf[0][1], A3_RELU4(A0, 8), P_, 0, 0, 0); \
            P_ = __builtin_amdgcn_mfma_f32_32x32x16_f16(wf[1][0], A3_RELU4(A1, 0), P_, 0, 0, 0); P_ = __builtin_amdgcn_mfma_f32_32x32x16_f16(wf[1][1], A3_RELU4(A1, 8), P_, 0, 0, 0); \
              \
            _Pragma("unroll") for (int r = 0; r < 4; ++r) { const int q = r + 4 * h; sc[q * A3_QP + (s >> 6) * 68 + (s & 63)] = (s <= t0 + q) ? sortable_u32(P_[r]) : 0u; } }
#define A3_LOADK(KF, tile_) { const int tl_ = ((tile_) < ntile) ? (tile_) : wave; \
            _Pragma("unroll") for (int ks = 0; ks < 4; ++ks) KF[ks] = *(const bf16x8*)(kbase + (size_t)tl_ * 2048 + ks * 512); }
        f32x16 accA0, accA1, accB0, accB1;
        if (wave < ntile) { A3_MMA(accA0, accA1, kA) A3_LOADK(kA, wave + 16) }
#pragma unroll 1
        for (int tile = wave; tile < ntile; tile += 16) {
            if (tile + 8 < ntile) { A3_MMA(accB0, accB1, kB) A3_LOADK(kB, tile + 24) }
            A3_EPI(accA0, accA1, tile)
            if (tile + 8 < ntile) {
                if (tile + 16 < ntile) { A3_MMA(accA0, accA1, kA) A3_LOADK(kA, tile + 32) }
                A3_EPI(accB0, accB1, tile + 8)
            }
        }
#undef A3_LOADK
#undef A3_RELU4
#undef A3_MMA
#undef A3_EPI
    }
    __syncthreads();
    {
        const int q = wave, t = t0 + q;
        const int nval = t + 1 - 64 * lane;
        const unsigned long long vm = nval >= 64 ? ~0ull : (nval > 0 ? ((1ull << nval) - 1ull) : 0ull);
        unsigned long long selm = vm;
        if (t >= 256) {
            unsigned lo[32], hi[32];
            {
                const LAS v4u* gp = (const LAS v4u*)(sc + q * A3_QP + lane * 68);
#pragma unroll
                for (int i = 0; i < 8; ++i) { const v4u a = gp[i], c = gp[8 + i]; lo[4 * i] = a.x; lo[4 * i + 1] = a.y; lo[4 * i + 2] = a.z; lo[4 * i + 3] = a.w; hi[4 * i] = c.x; hi[4 * i + 1] = c.y; hi[4 * i + 2] = c.z; hi[4 * i + 3] = c.w; }
            }
#define A3_TR(X) { \
            _Pragma("unroll") for (int k = 0; k < 32; ++k) if ((k & 16) == 0) { const unsigned a = X[k], c = X[k + 16]; X[k] = __builtin_amdgcn_perm(c, a, 0x05040100u); X[k + 16] = __builtin_amdgcn_perm(c, a, 0x07060302u); } \
            _Pragma("unroll") for (int k = 0; k < 32; ++k) if ((k & 8) == 0) { const unsigned a = X[k], c = X[k + 8]; X[k] = __builtin_amdgcn_perm(c, a, 0x06020400u); X[k + 8] = __builtin_amdgcn_perm(c, a, 0x07030501u); } \
            _Pragma("unroll") for (int st = 2; st < 5; ++st) { const int j = 16 >> st; const unsigned m = st == 2 ? 0x0f0f0f0fu : st == 3 ? 0x33333333u : 0x55555555u; \
                _Pragma("unroll") for (int k = 0; k < 32; ++k) if ((k & j) == 0) { const unsigned a = X[k], c = X[k + j]; X[k] = (a & m) | ((c << j) & ~m); X[k + j] = ((a >> j) & m) | (c & ~m); } } }
            A3_TR(lo) A3_TR(hi)
#undef A3_TR
            unsigned al = (unsigned)vm, ah = (unsigned)(vm >> 32), gl = 0u, gh = 0u, G = 0u;
            bool done = false;
#pragma unroll
            for (int b = 31; b >= 0; --b) {
                if (!done) {
                    const unsigned ol = al & lo[b], oh = ah & hi[b];
                    const unsigned c = G + wave_sum_u32((unsigned)__popc(ol) + (unsigned)__popc(oh));
                    if (c >= 256u) { al = ol; ah = oh; done = (c == 256u); }
                    else { gl |= ol; gh |= oh; G = c; al ^= ol; ah ^= oh; }
                }
            }
            const unsigned ca = (unsigned)__popc(al) + (unsigned)__popc(ah);
            const unsigned tot = wave_sum_u32(ca);
            unsigned long long alive = ((unsigned long long)ah << 32) | al;
            if (G + tot > 256u) {
                int incl = (int)ca;
#pragma unroll
                for (int o = 1; o < 64; o <<= 1) { const int v = SHUP_I(incl, o, lane); if (lane >= o) incl += v; }
                const int before = incl - (int)ca, room = (int)(256u - G) - before;
                int take = room < 0 ? 0 : (room > (int)ca ? (int)ca : room);
                unsigned long long keep = 0ull;
                while (__any(take > 0)) { if (take > 0) { const unsigned long long low = alive & (0ull - alive); keep |= low; alive ^= low; --take; } }
                alive = keep;
            }
            selm = (((unsigned long long)gh << 32) | gl) | alive;
        }
        if (has_next) a3_load_q(C, nb, nt0, Q);
#ifdef SEL_ALL
        *(unsigned long long*)(SEL + (size_t)(b * SEQ + t) * 128 + 2 * lane) = selm;
#else
        if (64 * lane <= t) *(unsigned long long*)(SEL + (size_t)(b * SEQ + t) * 128 + 2 * lane) = selm;
#endif
    }
    __syncthreads();
}

constexpr int A4_BUF = 4 * A3_QP;
#ifdef PROBE_HOT
#define A4_TMASK(x) ((x) & C.hot)
#else
#define A4_TMASK(x) (x)
#endif
constexpr int A4_R = 4;
struct A4S { bf16x8 af[4]; v4u wq; bf16x8 k[A4_R][4]; };
__device__ __forceinline__ int a4_cnt(int t0, int sw) { const int ntile = (t0 + 4 + 31) >> 5; return (t0 + 3 < 256 || sw >= ntile) ? 0 : (ntile - sw + 3) >> 2; }
__device__ __forceinline__ void a4_prefetch(Ctx& C, A4S& S, int b, int t0) {
    const bf16* PROJ = (const bf16*)(C.ws + WS_P); const bf16* KFI = (const bf16*)(C.ws + WS_KFI);
    const int lane = C.lane, n = lane & 31, h = lane >> 5, sw = C.wave;
    const int cnt = a4_cnt(t0, sw);
    {
        const int jq = 2 * ((n >> 4) & 1) + ((n >> 2) & 1), hd = 4 * ((n >> 3) & 1) + (n & 3);
        const bf16* p = PROJ + (size_t)(b * SEQ + t0 + jq) * PW + C_IQ + hd * 64 + 8 * h;
#pragma unroll
        for (int ks = 0; ks < 4; ++ks) S.af[ks] = *(const bf16x8*)(p + ks * 16);
        const int qsel = (n & 1) + 2 * ((n >> 2) & 1);
        S.wq = *(const v4u*)(PROJ + (size_t)(b * SEQ + t0 + qsel) * PW + C_IW);
    }
    const bf16* kbase = KFI + (size_t)(b * 128) * 2048 + lane * 8;
#pragma unroll
    for (int j = 0; j < A4_R; ++j) { const int tl = j < cnt ? sw + 4 * j : 0;
#pragma unroll
        for (int ks = 0; ks < 4; ++ks) S.k[j][ks] = *(const bf16x8*)(kbase + (size_t)A4_TMASK(tl) * 2048 + ks * 512);
    }
}
__device__ __forceinline__ void a4_score(Ctx& C, A4S& S, LAS unsigned* sc, int b, int t0, int nb, int nt0) {
    const bf16* KFI = (const bf16*)(C.ws + WS_KFI); const bf16* PROJ = (const bf16*)(C.ws + WS_P);
    const int lane = C.lane, n = lane & 31, h = lane >> 5, sw = C.wave;
    const int cnt = a4_cnt(t0, sw);
    bf16x8 naf[4]; v4u nwq;
    {
        const int jq = 2 * ((n >> 4) & 1) + ((n >> 2) & 1), hd = 4 * ((n >> 3) & 1) + (n & 3);
        const bf16* p = PROJ + (size_t)(nb * SEQ + nt0 + jq) * PW + C_IQ + hd * 64 + 8 * h;
#pragma unroll
        for (int ks = 0; ks < 4; ++ks) naf[ks] = *(const bf16x8*)(p + ks * 16);
        const int qsel = (n & 1) + 2 * ((n >> 2) & 1);
        nwq = *(const v4u*)(PROJ + (size_t)(nb * SEQ + nt0 + qsel) * PW + C_IW);
    }
    const int ncnt = a4_cnt(nt0, sw);
    const bf16* nkbase = KFI + (size_t)(nb * 128) * 2048 + lane * 8;
    typedef _Float16 h8_t __attribute__((ext_vector_type(8)));
    typedef _Float16 h2_t __attribute__((ext_vector_type(2)));
    h8_t wf[2];
    {
        const unsigned ww[4] = {S.wq.x, S.wq.y, S.wq.z, S.wq.w}; unsigned wp[4];
#pragma unroll
        for (int x = 0; x < 4; ++x) wp[x] = __builtin_bit_cast(unsigned, __builtin_amdgcn_cvt_pkrtz(bf2f(ww[x] & 0xffffu) * (0.35355339059327373f * 0.125f), bf2f(ww[x] >> 16) * (0.35355339059327373f * 0.125f)));
        const bool rowok = (n == 0) || (n == 1) || (n == 4) || (n == 5); const int qrow = (n & 1) + 2 * (n >> 2);
#pragma unroll
        for (int ks = 0; ks < 2; ++ks) { const bool on = rowok && (qrow == 2 * ks + h);
            v4u f; f.x = on ? wp[0] : 0u; f.y = on ? wp[1] : 0u; f.z = on ? wp[2] : 0u; f.w = on ? wp[3] : 0u; wf[ks] = __builtin_bit_cast(h8_t, f); }
    }
    const bf16* kbase = KFI + (size_t)(b * 128) * 2048 + lane * 8;
#define A4_MMA(A, KF) { const f32x16 z16_ = {0.f, 0.f, 0.f, 0.f, 0.f, 0.f, 0.f, 0.f, 0.f, 0.f, 0.f, 0.f, 0.f, 0.f, 0.f, 0.f}; \
        A = mfma32(S.af[0], KF[0], z16_); _Pragma("unroll") for (int ks = 1; ks < 4; ++ks) A = mfma32(S.af[ks], KF[ks], A); }
#define A4_RELU4(A, r0_) ({ v4u f_; const h2_t z2_ = {(_Float16)0.f, (_Float16)0.f}; \
            f_.x = __builtin_bit_cast(unsigned, __builtin_elementwise_max(__builtin_bit_cast(h2_t, __builtin_amdgcn_cvt_pkrtz(A[(r0_)], A[(r0_) + 1])), z2_)); \
            f_.y = __builtin_bit_cast(unsigned, __builtin_elementwise_max(__builtin_bit_cast(h2_t, __builtin_amdgcn_cvt_pkrtz(A[(r0_) + 2], A[(r0_) + 3])), z2_)); \
            f_.z = __builtin_bit_cast(unsigned, __builtin_elementwise_max(__builtin_bit_cast(h2_t, __builtin_amdgcn_cvt_pkrtz(A[(r0_) + 4], A[(r0_) + 5])), z2_)); \
            f_.w = __builtin_bit_cast(unsigned, __builtin_elementwise_max(__builtin_bit_cast(h2_t, __builtin_amdgcn_cvt_pkrtz(A[(r0_) + 6], A[(r0_) + 7])), z2_)); \
            __builtin_bit_cast(h8_t, f_); })
#define A4_EPI(A, i_) { const int s = (sw + 4 * (i_)) * 32 + n; const f32x16 z16e_ = {0.f, 0.f, 0.f, 0.f, 0.f, 0.f, 0.f, 0.f, 0.f, 0.f, 0.f, 0.f, 0.f, 0.f, 0.f, 0.f}; \
        f32x16 P_ = __builtin_amdgcn_mfma_f32_32x32x16_f16(wf[0], A4_RELU4(A, 0), z16e_, 0, 0, 0); P_ = __builtin_amdgcn_mfma_f32_32x32x16_f16(wf[1], A4_RELU4(A, 8), P_, 0, 0, 0); \
          \
          \
        _Pragma("unroll") for (int r = 0; r < 2; ++r) { const int q = 2 * h + r; const unsigned u_ = __float_as_uint(P_[r]); sc[q * A3_QP + (s >> 6) * 68 + (s & 63)] = u_ ^ ((unsigned)((int)u_ >> 31) | 0x80000000u); } }
#define A4_LOADK(KF, i_) { const int il_ = ((i_) < cnt) ? (i_) : 0; _Pragma("unroll") for (int ks = 0; ks < 4; ++ks) KF[ks] = *(const bf16x8*)(kbase + (size_t)A4_TMASK(sw + 4 * il_) * 2048 + ks * 512); }
    f32x16 acc0, acc1;
    int i0 = 0;
#pragma unroll 1
    for (; i0 + 4 < cnt; i0 += 4) {
        A4_MMA(acc0, S.k[0]) A4_LOADK(S.k[0], i0 + 4)
        A4_MMA(acc1, S.k[1]) A4_LOADK(S.k[1], i0 + 5)
        A4_EPI(acc0, i0)
        A4_MMA(acc0, S.k[2]) A4_LOADK(S.k[2], i0 + 6)
        A4_EPI(acc1, i0 + 1)
        A4_MMA(acc1, S.k[3]) A4_LOADK(S.k[3], i0 + 7)
        A4_EPI(acc0, i0 + 2)
        A4_EPI(acc1, i0 + 3)
    }
#define A4_LOADN(KF, j_) { const int tl_ = ((j_) < ncnt) ? sw + 4 * (j_) : 0; _Pragma("unroll") for (int ks = 0; ks < 4; ++ks) KF[ks] = *(const bf16x8*)(nkbase + (size_t)A4_TMASK(tl_) * 2048 + ks * 512); }
    if (i0 < cnt) { A4_MMA(acc0, S.k[0]) }
    A4_LOADN(S.k[0], 0)
    if (i0 + 1 < cnt) { A4_MMA(acc1, S.k[1]) }
    A4_LOADN(S.k[1], 1)
    if (i0 < cnt) A4_EPI(acc0, i0)
    if (i0 + 2 < cnt) { A4_MMA(acc0, S.k[2]) }
    A4_LOADN(S.k[2], 2)
    if (i0 + 1 < cnt) A4_EPI(acc1, i0 + 1)
    if (i0 + 3 < cnt) { A4_MMA(acc1, S.k[3]) }
    A4_LOADN(S.k[3], 3)
    if (i0 + 2 < cnt) A4_EPI(acc0, i0 + 2)
    if (i0 + 3 < cnt) A4_EPI(acc1, i0 + 3)
#undef A4_LOADN
#pragma unroll
    for (int ks = 0; ks < 4; ++ks) S.af[ks] = naf[ks];
    S.wq = nwq;
#undef A4_LOADK
#undef A4_RELU4
#undef A4_MMA
#undef A4_EPI
}
__device__ __forceinline__ void a4_select(Ctx& C, const LAS unsigned* scq, int b, int t) {
    unsigned* SEL = (unsigned*)(C.ws + WS_SEL);
    const int lane = C.lane;
    const int nval = t + 1 - 64 * lane;
    const unsigned long long vm = nval >= 64 ? ~0ull : (nval > 0 ? ((1ull << nval) - 1ull) : 0ull);
    unsigned long long selm = vm;
    if (t >= 256) {
        unsigned lo[32], hi[32];
        {
            const LAS v4u* gp = (const LAS v4u*)(scq + lane * 68);
#pragma unroll
            for (int i = 0; i < 8; ++i) { const v4u a = gp[i], c = gp[8 + i]; lo[4 * i] = a.x; lo[4 * i + 1] = a.y; lo[4 * i + 2] = a.z; lo[4 * i + 3] = a.w; hi[4 * i] = c.x; hi[4 * i + 1] = c.y; hi[4 * i + 2] = c.z; hi[4 * i + 3] = c.w; }
        }
#define A3_TR(X) { \
        _Pragma("unroll") for (int k = 0; k < 32; ++k) if ((k & 16) == 0) { const unsigned a = X[k], c = X[k + 16]; X[k] = __builtin_amdgcn_perm(c, a, 0x05040100u); X[k + 16] = __builtin_amdgcn_perm(c, a, 0x07060302u); } \
        _Pragma("unroll") for (int k = 0; k < 32; ++k) if ((k & 8) == 0) { const unsigned a = X[k], c = X[k + 8]; X[k] = __builtin_amdgcn_perm(c, a, 0x06020400u); X[k + 8] = __builtin_amdgcn_perm(c, a, 0x07030501u); } \
        _Pragma("unroll") for (int st = 2; st < 5; ++st) { const int j = 16 >> st; const unsigned m = st == 2 ? 0x0f0f0f0fu : st == 3 ? 0x33333333u : 0x55555555u; \
            _Pragma("unroll") for (int k = 0; k < 32; ++k) if ((k & j) == 0) { const unsigned a = X[k], c = X[k + j]; X[k] = (a & m) | ((c << j) & ~m); X[k + j] = ((a >> j) & m) | (c & ~m); } } }
        A3_TR(lo) A3_TR(hi)
#undef A3_TR
        unsigned al = (unsigned)vm, ah = (unsigned)(vm >> 32), gl = 0u, gh = 0u, G = 0u;
        bool done = false;
#pragma unroll
        for (int bb = 31; bb >= 1; bb -= 2) {
            if (!done) {
                const unsigned o1l = al & lo[bb], o1h = ah & hi[bb];
                const unsigned o11l = o1l & lo[bb - 1], o11h = o1h & hi[bb - 1];
                const unsigned o01l = (al ^ o1l) & lo[bb - 1], o01h = (ah ^ o1h) & hi[bb - 1];
                unsigned x1 = (unsigned)__popc(o1l) + (unsigned)__popc(o1h), x11 = (unsigned)__popc(o11l) + (unsigned)__popc(o11h), x01 = (unsigned)__popc(o01l) + (unsigned)__popc(o01h);
                x1 += DPP_U32(x1, 0xB1); x11 += DPP_U32(x11, 0xB1); x01 += DPP_U32(x01, 0xB1);
                x1 += DPP_U32(x1, 0x4E); x11 += DPP_U32(x11, 0x4E); x01 += DPP_U32(x01, 0x4E);
                x1 += DPP_U32(x1, 0x124); x11 += DPP_U32(x11, 0x124); x01 += DPP_U32(x01, 0x124);
                x1 += DPP_U32(x1, 0x128); x11 += DPP_U32(x11, 0x128); x01 += DPP_U32(x01, 0x128);
                x1 += (unsigned)__builtin_amdgcn_update_dpp(0, (int)x1, 0x142, 0xA, 0xF, false); x11 += (unsigned)__builtin_amdgcn_update_dpp(0, (int)x11, 0x142, 0xA, 0xF, false); x01 += (unsigned)__builtin_amdgcn_update_dpp(0, (int)x01, 0x142, 0xA, 0xF, false);
                x1 += (unsigned)__builtin_amdgcn_update_dpp(0, (int)x1, 0x143, 0xC, 0xF, false); x11 += (unsigned)__builtin_amdgcn_update_dpp(0, (int)x11, 0x143, 0xC, 0xF, false); x01 += (unsigned)__builtin_amdgcn_update_dpp(0, (int)x01, 0x143, 0xC, 0xF, false);
                const unsigned c1 = G + (unsigned)__builtin_amdgcn_readlane((int)x1, 63), n11 = (unsigned)__builtin_amdgcn_readlane((int)x11, 63), n01 = (unsigned)__builtin_amdgcn_readlane((int)x01, 63);
                if (c1 >= 256u) {
                    al = o1l; ah = o1h;
                    if (c1 == 256u) done = true;
                    else {
                        const unsigned c = G + n11;
                        if (c >= 256u) { al = o11l; ah = o11h; done = (c == 256u); }
                        else { gl |= o11l; gh |= o11h; G = c; al ^= o11l; ah ^= o11h; }
                    }
                } else {
                    gl |= o1l; gh |= o1h; G = c1; al ^= o1l; ah ^= o1h;
                    const unsigned c = G + n01;
                    if (c >= 256u) { al = o01l; ah = o01h; done = (c == 256u); }
                    else { gl |= o01l; gh |= o01h; G = c; al ^= o01l; ah ^= o01h; }
                }
            }
        }
        const unsigned ca = (unsigned)__popc(al) + (unsigned)__popc(ah);
        const unsigned tot = wave_sum_u32(ca);
        unsigned long long alive = ((unsigned long long)ah << 32) | al;
        if (G + tot > 256u) {
            const int incl = wave_incl_scan_i((int)ca, lane);
            const int before = incl - (int)ca, room = (int)(256u - G) - before;
            int take = room < 0 ? 0 : (room > (int)ca ? (int)ca : room);
            unsigned long long keep = 0ull;
            while (__any(take > 0)) { if (take > 0) { const unsigned long long low = alive & (0ull - alive); keep |= low; alive ^= low; --take; } }
            alive = keep;
        }
        selm = (((unsigned long long)gh << 32) | gl) | alive;
    }
#if USE_LIST
    if (t >= 256) {
        LAS unsigned short* lb = (LAS unsigned short*)(C.lds + MISC_OFF + 1024) + (C.wave & 3) * 256;
        unsigned w0 = (unsigned)selm, w1 = (unsigned)(selm >> 32);
        const int c = __popc(w0) + __popc(w1); const int incl = wave_incl_scan_i(c, lane); int pos = incl - c;
        while (w0) { const int bit = __ffs(w0) - 1; w0 &= w0 - 1; if (pos < 256) lb[pos] = (unsigned short)(64 * lane + bit); ++pos; }
        while (w1) { const int bit = __ffs(w1) - 1; w1 &= w1 - 1; if (pos < 256) lb[pos] = (unsigned short)(64 * lane + 32 + bit); ++pos; }
        asm volatile("" ::: "memory");
        const v2u e = *(const LAS v2u*)(lb + 4 * lane);
        *(v2u*)((unsigned short*)SEL + (size_t)(b * SEQ + t) * 256 + 4 * lane) = e;
        asm volatile("" ::: "memory");
    }
#else
    if (64 * lane <= t) *(unsigned long long*)(SEL + (size_t)(b * SEQ + t) * 128 + 2 * lane) = selm;
#endif
}

__device__ __forceinline__ void ph_dsa_b2_wave(Ctx& C, int b, int t4) {
    const bf16* PROJ = (const bf16*)(C.ws + WS_P); const unsigned* SEL = (const unsigned*)(C.ws + WS_SEL); bf16* YM = (bf16*)(C.ws + WS_H);
    const bf16* KFA = (const bf16*)(C.ws + WS_KFA); const bf16* VF = (const bf16*)(C.ws + WS_VF);
    const int lane = C.lane, n = lane & 31, h = lane >> 5, tl = n >> 3, hd = n & 7;
    const int ntile = ((t4 + 3) >> 5) + 1;
    const size_t qrow = (size_t)b * SEQ + t4 + tl;
    bf16x8 qf[5];
    {
        const bf16* qp = PROJ + qrow * PW + C_AQ + hd * 64 + 8 * h;
#pragma unroll
        for (int ks = 0; ks < 4; ++ks) {
            const v4u q4 = *(const v4u*)(qp + 16 * ks); const unsigned qw[4] = {q4.x, q4.y, q4.z, q4.w}; v4u o;
            unsigned ow[4];
#pragma unroll
            for (int x = 0; x < 4; ++x) ow[x] = pk2(bf2f(qw[x] & 0xffffu) * (0.125f * LOG2E), bf2f(qw[x] >> 16) * (0.125f * LOG2E));
            o.x = ow[0]; o.y = ow[1]; o.z = ow[2]; o.w = ow[3]; qf[ks] = __builtin_bit_cast(bf16x8, o);
        }
        const unsigned one = 0x3f80u, sl = f2bf(exp2f(-(float)(hd + 1)));
        v4u e; e.x = (tl == 0 ? one : 0u) | ((tl == 1 ? one : 0u) << 16); e.y = (tl == 2 ? one : 0u) | ((tl == 3 ? one : 0u) << 16); e.z = sl | (sl << 16); e.w = sl;
        if (h) { e.x = 0u; e.y = 0u; e.z = 0u; e.w = 0u; }
        qf[4] = __builtin_bit_cast(bf16x8, e);
    }
    f32x16 O0, O1;
#pragma unroll
    for (int x = 0; x < 16; ++x) { O0[x] = 0.f; O1[x] = 0.f; }
    float m = -3.0e38f, lsum = 0.f;
    const unsigned NEGB = 0xf149u;
    const bf16* kb = KFA + (size_t)(b * 128) * 2048 + lane * 8; const bf16* vb = VF + (size_t)(b * 128) * 2048 + lane * 8;
    const unsigned* selp = SEL + ((size_t)b * SEQ + t4 + (lane & 3)) * 128;
    bf16x8 kc[4], vc[4]; unsigned wc_;
#pragma unroll
    for (int ks = 0; ks < 4; ++ks) { kc[ks] = *(const bf16x8*)(kb + ks * 512); vc[ks] = *(const bf16x8*)(vb + ks * 512); }
    wc_ = selp[0];
    for (int tile = 0; tile < ntile; ++tile) {
        bf16x8 kn[4], vn[4]; unsigned wn = 0u;
        const int tn = (tile + 1 < ntile) ? tile + 1 : tile;
#pragma unroll
        for (int ks = 0; ks < 4; ++ks) { kn[ks] = *(const bf16x8*)(kb + (size_t)tn * 2048 + ks * 512); vn[ks] = *(const bf16x8*)(vb + (size_t)tn * 2048 + ks * 512); }
        wn = selp[tn];
        bf16x8 kx;
        {
            const unsigned w0 = (unsigned)__builtin_amdgcn_readlane((int)wc_, 0), w1 = (unsigned)__builtin_amdgcn_readlane((int)wc_, 1), w2 = (unsigned)__builtin_amdgcn_readlane((int)wc_, 2), w3 = (unsigned)__builtin_amdgcn_readlane((int)wc_, 3);
            const unsigned m0 = ((w0 >> n) & 1u) ? 0u : NEGB, m1 = ((w1 >> n) & 1u) ? 0u : NEGB, m2 = ((w2 >> n) & 1u) ? 0u : NEGB, m3 = ((w3 >> n) & 1u) ? 0u : NEGB;
            const float cs = LOG2E * (float)(tile * 32 + n);
            const unsigned c1 = f2bf(cs); const float r1 = cs - bf2f(c1); const unsigned c2 = f2bf(r1); const float r2 = r1 - bf2f(c2); const unsigned c3 = f2bf(r2);
            v4u e; e.x = m0 | (m1 << 16); e.y = m2 | (m3 << 16); e.z = c1 | (c2 << 16); e.w = c3;
            if (h) { e.x = 0u; e.y = 0u; e.z = 0u; e.w = 0u; }
            kx = __builtin_bit_cast(bf16x8, e);
        }
        f32x16 S;
#pragma unroll
        for (int x = 0; x < 16; ++x) S[x] = 0.f;
#pragma unroll
        for (int ks = 0; ks < 4; ++ks) S = mfma32(kc[ks], qf[ks], S);
        S = mfma32(kx, qf[4], S);
        float mloc = S[0];
#pragma unroll
        for (int x = 1; x < 16; ++x) mloc = fmaxf(mloc, S[x]);
        mloc = fmaxf(mloc, __shfl_xor(mloc, 32));
        const float mnew = fmaxf(m, mloc), alpha = __builtin_amdgcn_exp2f(m - mnew);
        m = mnew;
        float ps = 0.f;
#pragma unroll
        for (int x = 0; x < 16; ++x) { S[x] = __builtin_amdgcn_exp2f(S[x] - mnew); ps += S[x]; }
        lsum = lsum * alpha + ps;
#pragma unroll
        for (int x = 0; x < 16; ++x) { O0[x] *= alpha; O1[x] *= alpha; }
        v4u p0, p1;
        p0.x = pk2(S[0], S[1]); p0.y = pk2(S[2], S[3]); p0.z = pk2(S[4], S[5]); p0.w = pk2(S[6], S[7]);
        p1.x = pk2(S[8], S[9]); p1.y = pk2(S[10], S[11]); p1.z = pk2(S[12], S[13]); p1.w = pk2(S[14], S[15]);
        const bf16x8 pf0 = __builtin_bit_cast(bf16x8, p0), pf1 = __builtin_bit_cast(bf16x8, p1);
        O0 = mfma32(vc[0], pf0, O0); O1 = mfma32(vc[1], pf0, O1);
        O0 = mfma32(vc[2], pf1, O0); O1 = mfma32(vc[3], pf1, O1);
#pragma unroll
        for (int ks = 0; ks < 4; ++ks) { kc[ks] = kn[ks]; vc[ks] = vn[ks]; }
        wc_ = wn;
    }
    const float inv = 1.f / (lsum + __shfl_xor(lsum, 32));
    bf16* yo = YM + qrow * DM + hd * 64 + 4 * h;
#pragma unroll
    for (int j4 = 0; j4 < 4; ++j4) {
        v2u o; o.x = pk2(O0[4 * j4] * inv, O0[4 * j4 + 1] * inv); o.y = pk2(O0[4 * j4 + 2] * inv, O0[4 * j4 + 3] * inv);
        *(v2u*)(yo + 8 * j4) = o;
        v2u o2; o2.x = pk2(O1[4 * j4] * inv, O1[4 * j4 + 1] * inv); o2.y = pk2(O1[4 * j4 + 2] * inv, O1[4 * j4 + 3] * inv);
        *(v2u*)(yo + 32 + 8 * j4) = o2;
    }
}

__device__ __forceinline__ f32x4 mfma16(bf16x8 a, bf16x8 b, f32x4 c) { return __builtin_amdgcn_mfma_f32_16x16x32_bf16(a, b, c, 0, 0, 0); }
constexpr int B3_VS_PITCH = 144;
constexpr int B3_WAVE_LDS = 640 + 32 * B3_VS_PITCH;
#ifdef PROBE_HOT
#define B3_SKIP(bit) ((PROBE_SKIP & (bit)) && C.hot != 0xffff)
#define B3_HOTMASK C.hot
#else
#define B3_SKIP(bit) false
#define B3_HOTMASK 0xffff
#endif
template <bool FULL>
__device__ __forceinline__ void b3_core(Ctx& C, int b, int t, int nsel, const v4u qc0, const v4u qc1, LAS unsigned short* lst, LAS unsigned char* vs) {
    const bf16* PROJ = (const bf16*)(C.ws + WS_P); bf16* YM = (bf16*)C.out;
    const int lane = C.lane, m16 = lane & 15, g = lane >> 4;
    const size_t row = (size_t)b * SEQ + t;
    const int nt16 = FULL ? 16 : (nsel + 15) >> 4, nk32 = FULL ? 8 : (nsel + 31) >> 5;
    const bf16* vbase = PROJ + (size_t)b * SEQ * PW + C_AV + 8 * (lane & 7); const bf16* kbase = PROJ + (size_t)b * SEQ * PW + C_AK + 8 * g;
    v4u vb[3][4];
#pragma unroll
    for (int i = 0; i < 4; ++i) { const int s = (int)lst[8 * i + (lane >> 3)] & B3_HOTMASK; vb[0][i] = *(const v4u*)(vbase + (size_t)s * PW); }
    bf16x8 qf[2];
#pragma unroll
    for (int ks = 0; ks < 2; ++ks) {
        const v4u q4 = ks ? qc1 : qc0; const unsigned qw[4] = {q4.x, q4.y, q4.z, q4.w}; unsigned ow[4];
#pragma unroll
        for (int x = 0; x < 4; ++x) ow[x] = (m16 < 8) ? pk2(bf2f(qw[x] & 0xffffu) * (0.125f * LOG2E), bf2f(qw[x] >> 16) * (0.125f * LOG2E)) : 0u;
        v4u o; o.x = ow[0]; o.y = ow[1]; o.z = ow[2]; o.w = ow[3]; qf[ks] = __builtin_bit_cast(bf16x8, o);
    }
    const float sl2 = exp2f(-(float)((m16 & 7) + 1)) * LOG2E, tf = (float)t;
    f32x4 lg[16];
    bf16x8 a0[2][4], a1[2][4];
#define B3_GATHER(buf, hf_) { _Pragma("unroll") for (int i = 0; i < 4; ++i) { const int sm_k = ((FULL || 4 * (hf_) + i < nt16) ? (int)lst[16 * (4 * (hf_) + i) + m16] : 0) & B3_HOTMASK; \
        const bf16* kp = kbase + (size_t)sm_k * PW; a0[buf][i] = *(const bf16x8*)kp; a1[buf][i] = *(const bf16x8*)(kp + 32); } }
    if (!B3_SKIP(4)) { B3_GATHER(0, 0) B3_GATHER(1, 1) }
#pragma unroll
    for (int kt = 0; kt < 16; ++kt) {
        if (FULL || kt < nt16) {
            const v2u p4 = *(const LAS v2u*)(lst + 16 * kt + 4 * g);
            const float sr[4] = {(float)(p4.x & 0xffffu), (float)(p4.x >> 16), (float)(p4.y & 0xffffu), (float)(p4.y >> 16)};
#pragma unroll
            for (int r = 0; r < 4; ++r) lg[kt][r] = (FULL || 16 * kt + 4 * g + r < nsel) ? sl2 * (sr[r] - tf) : -3.0e38f;
        } else lg[kt] = (f32x4){-3.0e38f, -3.0e38f, -3.0e38f, -3.0e38f};
    }
#pragma unroll
    for (int hf = 0; hf < 4; ++hf) {
        if (!B3_SKIP(2)) {
#pragma unroll
            for (int i = 0; i < 4; ++i) if (FULL || 4 * hf + i < nt16) lg[4 * hf + i] = mfma16(a0[hf & 1][i], qf[0], lg[4 * hf + i]);
#pragma unroll
            for (int i = 0; i < 4; ++i) if (FULL || 4 * hf + i < nt16) lg[4 * hf + i] = mfma16(a1[hf & 1][i], qf[1], lg[4 * hf + i]);
        }
        if (!B3_SKIP(4)) { if (hf == 0) B3_GATHER(0, 2) if (hf == 1) B3_GATHER(1, 3) }
    }
    float mx;
    {
        float m0 = -3.0e38f, m1 = -3.0e38f, m2 = -3.0e38f, m3 = -3.0e38f;
#pragma unroll
        for (int kt = 0; kt < 16; ++kt) { m0 = fmaxf(m0, lg[kt][0]); m1 = fmaxf(m1, lg[kt][1]); m2 = fmaxf(m2, lg[kt][2]); m3 = fmaxf(m3, lg[kt][3]); }
        mx = fmaxf(fmaxf(m0, m1), fmaxf(m2, m3));
    }
#undef B3_GATHER
#pragma unroll
    for (int d = 1; d < 3; ++d) if (FULL || d < nk32) {
#pragma unroll
        for (int i = 0; i < 4; ++i) { const int s = (int)lst[32 * d + 8 * i + (lane >> 3)] & B3_HOTMASK; vb[d][i] = *(const v4u*)(vbase + (size_t)s * PW); }
    }
    mx = fmaxf(mx, SHX_F(mx, 16, lane)); mx = fmaxf(mx, SHX_F(mx, 32, lane));
    float sm_;
    {
        float s0 = 0.f, s1 = 0.f, s2 = 0.f, s3 = 0.f;
#pragma unroll
        for (int kt = 0; kt < 16; ++kt) {
            if (FULL || kt < nt16) {
                const float p0 = __builtin_amdgcn_exp2f(lg[kt][0] - mx), p1 = __builtin_amdgcn_exp2f(lg[kt][1] - mx), p2 = __builtin_amdgcn_exp2f(lg[kt][2] - mx), p3 = __builtin_amdgcn_exp2f(lg[kt][3] - mx);
                lg[kt] = (f32x4){p0, p1, p2, p3}; s0 += p0; s1 += p1; s2 += p2; s3 += p3;
            } else lg[kt] = (f32x4){0.f, 0.f, 0.f, 0.f};
        }
        sm_ = (s0 + s1) + (s2 + s3);
    }
    sm_ += SHX_F(sm_, 16, lane); sm_ += SHX_F(sm_, 32, lane);
    const float inv = 1.f / sm_;
    v4u pbk[8];
#pragma unroll
    for (int kk = 0; kk < 8; ++kk) { pbk[kk].x = pk2(lg[2 * kk][0], lg[2 * kk][1]); pbk[kk].y = pk2(lg[2 * kk][2], lg[2 * kk][3]); pbk[kk].z = pk2(lg[2 * kk + 1][0], lg[2 * kk + 1][1]); pbk[kk].w = pk2(lg[2 * kk + 1][2], lg[2 * kk + 1][3]); }
    f32x4 O[4];
#pragma unroll
    for (int i = 0; i < 4; ++i) O[i] = (f32x4){0.f, 0.f, 0.f, 0.f};
#pragma unroll
    for (int kk = 0; kk < 8; ++kk) if ((FULL || kk < nk32) && !B3_SKIP(1)) {
#pragma unroll
        for (int i = 0; i < 4; ++i) *(LAS v4u*)(vs + (8 * i + (lane >> 3)) * B3_VS_PITCH + (lane & 7) * 16) = vb[kk % 3][i];
        if (kk >= 1 && kk + 2 < 8 && (FULL || kk + 2 < nk32)) {
#pragma unroll
            for (int i = 0; i < 4; ++i) { const int s = (int)lst[32 * (kk + 2) + 8 * i + (lane >> 3)] & B3_HOTMASK; vb[(kk + 2) % 3][i] = *(const v4u*)(vbase + (size_t)s * PW); }
        }
        asm volatile("s_waitcnt lgkmcnt(0)" ::: "memory");
        const bf16x8 pB = __builtin_bit_cast(bf16x8, pbk[kk]);
#pragma unroll
        for (int u = 0; u < 2; ++u) {
            unsigned w[8];
#pragma unroll
            for (int j = 0; j < 8; ++j) { const int sl = (j < 4) ? 4 * g + j : 16 + 4 * g + (j - 4); w[j] = *(const LAS unsigned*)(vs + sl * B3_VS_PITCH + (32 * u + 2 * m16) * 2); }
            v4u ae, ao;
            ae.x = (w[0] & 0xffffu) | (w[1] << 16); ae.y = (w[2] & 0xffffu) | (w[3] << 16); ae.z = (w[4] & 0xffffu) | (w[5] << 16); ae.w = (w[6] & 0xffffu) | (w[7] << 16);
            ao.x = (w[0] >> 16) | (w[1] & 0xffff0000u); ao.y = (w[2] >> 16) | (w[3] & 0xffff0000u); ao.z = (w[4] >> 16) | (w[5] & 0xffff0000u); ao.w = (w[6] >> 16) | (w[7] & 0xffff0000u);
            O[2 * u] = mfma16(__builtin_bit_cast(bf16x8, ae), pB, O[2 * u]); O[2 * u + 1] = mfma16(__builtin_bit_cast(bf16x8, ao), pB, O[2 * u + 1]);
        }
    }
    if (m16 < 8) {
#pragma unroll
        for (int u = 0; u < 2; ++u) {
            v4u o; o.x = pk2(O[2 * u][0] * inv, O[2 * u + 1][0] * inv); o.y = pk2(O[2 * u][1] * inv, O[2 * u + 1][1] * inv); o.z = pk2(O[2 * u][2] * inv, O[2 * u + 1][2] * inv); o.w = pk2(O[2 * u][3] * inv, O[2 * u + 1][3] * inv);
            *(v4u*)(YM + row * DM + m16 * 64 + 32 * u + 8 * g) = o;
        }
    }
}
__device__ __forceinline__ void ph_dsa_b3_wave(Ctx& C, int b, int t4) {
    LAS unsigned short* lst = (LAS unsigned short*)(C.lds + C.wave * B3_WAVE_LDS);
    LAS unsigned char* vs = C.lds + C.wave * B3_WAVE_LDS + 640;
    const bf16* PROJ = (const bf16*)(C.ws + WS_P); const unsigned* SEL = (const unsigned*)(C.ws + WS_SEL);
    const int lane = C.lane, m16 = lane & 15, g = lane >> 4;
#if USE_LIST
    v2u lqn; v4u qn0, qn1;
#define B3_PREFETCH(tq) { const size_t r_ = (size_t)b * SEQ + (tq); \
        lqn = ((tq) >= 256) ? *(const v2u*)((const unsigned short*)SEL + r_ * 256 + 4 * lane) : (v2u){0u, 0u}; \
        const bf16* qp_ = PROJ + r_ * PW + C_AQ + (m16 & 7) * 64 + 8 * g; qn0 = *(const v4u*)qp_; qn1 = *(const v4u*)(qp_ + 32); }
    B3_PREFETCH(t4)
#pragma unroll 1
    for (int qi = 0; qi < 4; ++qi) {
        const int t = t4 + qi;
        v2u lq = lqn;
        const v4u qc0 = qn0, qc1 = qn1;
        if (qi < 3) B3_PREFETCH(t + 1)
        const int nsel = t < 256 ? t + 1 : 256;
        if (t < 256) { const int i0 = 4 * lane; lq.x = (unsigned)(i0 <= t ? i0 : 0) | ((unsigned)(i0 + 1 <= t ? i0 + 1 : 0) << 16); lq.y = (unsigned)(i0 + 2 <= t ? i0 + 2 : 0) | ((unsigned)(i0 + 3 <= t ? i0 + 3 : 0) << 16); }
        *(LAS v2u*)(lst + 4 * lane) = lq;
        if (lane < 16) *(LAS unsigned*)(lst + 256 + 2 * lane) = 0u;
        asm volatile("s_waitcnt lgkmcnt(0)" ::: "memory");
        if (nsel == 256) b3_core<true>(C, b, t, nsel, qc0, qc1, lst, vs); else b3_core<false>(C, b, t, nsel, qc0, qc1, lst, vs);
    }
#undef B3_PREFETCH
#else
    unsigned w0n, w1n; v4u qn0, qn1;
#define B3_PREFETCH(tq) { const size_t r_ = (size_t)b * SEQ + (tq); const int nw_ = ((tq) >> 5) + 1; \
        w0n = (2 * lane < nw_) ? SEL[r_ * 128 + 2 * lane] : 0u; w1n = (2 * lane + 1 < nw_) ? SEL[r_ * 128 + 2 * lane + 1] : 0u; \
        const bf16* qp_ = PROJ + r_ * PW + C_AQ + (m16 & 7) * 64 + 8 * g; qn0 = *(const v4u*)qp_; qn1 = *(const v4u*)(qp_ + 32); }
    B3_PREFETCH(t4)
#pragma unroll 1
    for (int qi = 0; qi < 4; ++qi) {
        const int t = t4 + qi;
        unsigned w0 = w0n, w1 = w1n;
        const v4u qc0 = qn0, qc1 = qn1;
        if (qi < 3) B3_PREFETCH(t + 1)
        int nsel;
        {
            const int c = __popc(w0) + __popc(w1); const int incl = wave_incl_scan_i(c, lane);
            int pos = incl - c; const int tot = __builtin_amdgcn_readlane(incl, 63);
            while (w0) { const int bit = __ffs(w0) - 1; w0 &= w0 - 1; if (pos < 256) lst[pos] = (unsigned short)(64 * lane + bit); ++pos; }
            while (w1) { const int bit = __ffs(w1) - 1; w1 &= w1 - 1; if (pos < 256) lst[pos] = (unsigned short)(64 * lane + 32 + bit); ++pos; }
            nsel = tot < 256 ? tot : 256;
            if (lane < 32 && nsel + lane < 288) lst[nsel + lane] = 0;
        }
        asm volatile("s_waitcnt lgkmcnt(0)" ::: "memory");
        if (nsel == 256) b3_core<true>(C, b, t, nsel, qc0, qc1, lst, vs); else b3_core<false>(C, b, t, nsel, qc0, qc1, lst, vs);
    }
#undef B3_PREFETCH
#endif
}

namespace pg8 {
constexpr int BM = 256, BK = 64, HALF = 128, HTB = HALF * BK * 2, STAGE_BYTES = 8 * HTB, NXCD = 8, WGM = 8;
__host__ __device__ __forceinline__ int lds_byte(int r, int c) { const int st = (r >> 4) * 2 + (c >> 5), rr = r & 15, cc = c & 31, ob = rr * 64 + cc * 2; return st * 1024 + (ob ^ (((ob >> 9) & 1) << 5)); }
__host__ __device__ __forceinline__ void stage_rc(int b, int& R, int& C) { const int st = b / 1024, sb = b % 1024, swz = sb ^ (((sb >> 9) & 1) << 5); R = (st >> 1) * 16 + swz / 64; C = (st & 1) * 32 + (swz % 64) / 2; }
__host__ __device__ __forceinline__ int perm32(int rho) { const int n = rho >> 4, i = rho & 15; return 8 * (i >> 2) + 4 * n + (i & 3); }

struct Unit { int pm, pn, po, eb; };
struct Gemm { const bf16* A; const bf16* Bt; int K; size_t ebytes; };

struct Order {
    int nM, nN, nwg, G, c, p_lo, amode; const LAS unsigned char* pe;
    __device__ __forceinline__ void init(int nM_, int nN_, int G_, int c_, int p_lo_, int amode_, const LAS unsigned char* pe_) { nM = nM_; nN = nN_; nwg = nM * nN; G = G_; c = c_; p_lo = p_lo_; amode = amode_; pe = pe_; }
    __device__ __forceinline__ bool next(int i, Unit& u) const {
        const long L = (long)i * G + c; if (L >= nwg) return false;
        int wgid = (int)L; { const int q = nwg / NXCD, r = nwg % NXCD, xcd = wgid % NXCD, off = wgid / NXCD; wgid = (xcd < r ? xcd * (q + 1) : r * (q + 1) + (xcd - r) * q) + off; }
        const int nig = WGM * nN, gid = wgid / nig, fm = gid * WGM, gsz = (nM - fm) < WGM ? (nM - fm) : WGM;
        const int lp = fm + ((wgid % nig) % gsz), gp = p_lo + lp; u.pn = (wgid % nig) / gsz;
        u.pm = amode == 0 ? gp : lp; u.po = amode == 0 ? lp : gp; u.eb = pe ? __builtin_amdgcn_readfirstlane((int)pe[gp]) : 0; return true;
    }
};

__device__ __forceinline__ unsigned cvt_pk_bf16(float lo, float hi) { unsigned r; asm volatile("v_cvt_pk_bf16_f32 %0, %1, %2" : "=v"(r) : "v"(lo), "v"(hi)); return r; }
__device__ __forceinline__ float silu_fast(float g) { return g * __builtin_amdgcn_rcpf(1.f + __builtin_amdgcn_exp2f(-g * LOG2E)); }

struct EpiBf16 {
    static constexpr bool PERM = true;
    bf16* O; int ldc;
    __device__ __forceinline__ void operator()(const f32x4 (&acc)[2][2][4][2], const Unit& u, int wr, int wc, int fr, int fq) const {
        const int row0 = u.po * BM + wr * 64 + fr, col0 = u.pn * BM + wc * 32 + 8 * fq;
#pragma unroll
        for (int ai = 0; ai < 2; ++ai)
#pragma unroll
            for (int m = 0; m < 4; ++m) { bf16* rowp = O + (size_t)(row0 + ai * HALF + m * 16) * ldc + col0;
#pragma unroll
                for (int bj = 0; bj < 2; ++bj) { const f32x4 v0 = acc[ai][bj][m][0], v1 = acc[ai][bj][m][1];
                    v4u w; w.x = cvt_pk_bf16(v0[0], v0[1]); w.y = cvt_pk_bf16(v0[2], v0[3]); w.z = cvt_pk_bf16(v1[0], v1[1]); w.w = cvt_pk_bf16(v1[2], v1[3]);
                    *(v4u*)(rowp + bj * HALF) = w; } }
    }
};
struct EpiProj {
    static constexpr bool PERM = true;
    bf16* O; bf16* KFA; bf16* KFI; bf16* VF;
    __device__ __forceinline__ void operator()(const f32x4 (&acc)[2][2][4][2], const Unit& u, int wr, int wc, int fr, int fq) const {
        const int row0 = u.po * BM + wr * 64 + fr, col0 = u.pn * BM + wc * 32 + 8 * fq;
#pragma unroll
        for (int ai = 0; ai < 2; ++ai)
#pragma unroll
            for (int m = 0; m < 4; ++m) { const int row = row0 + ai * HALF + m * 16; bf16* rowp = O + (size_t)row * PW + col0;
#pragma unroll
                for (int bj = 0; bj < 2; ++bj) { const f32x4 v0 = acc[ai][bj][m][0], v1 = acc[ai][bj][m][1];
                    v4u w; w.x = cvt_pk_bf16(v0[0], v0[1]); w.y = cvt_pk_bf16(v0[2], v0[3]); w.z = cvt_pk_bf16(v1[0], v1[1]); w.w = cvt_pk_bf16(v1[2], v1[3]);
                    *(v4u*)(rowp + bj * HALF) = w;
                    if (u.pn == 10) {
                        if (wc < 2) {
                            const int dc = 4 * wc + fq;
                            bf16* kf = (bj == 0 ? KFA : KFI) + ((size_t)(row >> 5) * 4 + (dc >> 1)) * 512 + (32 * (dc & 1) + (row & 31)) * 8;
                            *(v4u*)kf = w;
                        } else if (bj == 0) {
                            const int kap = row & 31, mf = kap >> 4, k15 = kap & 15, hh = (k15 >> 2) & 1, j = (k15 & 3) + 4 * (k15 >> 3);
                            bf16* vf = VF + ((((size_t)(row >> 5) * 2 + mf) * 2 + (wc - 2)) * 64 + 32 * hh + 8 * fq) * 8 + j;
                            vf[0 * 8] = (bf16)(w.x & 0xffffu); vf[1 * 8] = (bf16)(w.x >> 16); vf[2 * 8] = (bf16)(w.y & 0xffffu); vf[3 * 8] = (bf16)(w.y >> 16);
                            vf[4 * 8] = (bf16)(w.z & 0xffffu); vf[5 * 8] = (bf16)(w.z >> 16); vf[6 * 8] = (bf16)(w.w & 0xffffu); vf[7 * 8] = (bf16)(w.w >> 16);
                        }
                    } } }
    }
};
struct EpiGate {
    static constexpr bool PERM = true;
    bf16* O; const float* gate;
    __device__ __forceinline__ void operator()(const f32x4 (&acc)[2][2][4][2], const Unit& u, int wr, int wc, int fr, int fq) const {
        const int row0 = u.po * BM + wr * 64 + fr, col0 = u.pn * BM + wc * 32 + 8 * fq;
#pragma unroll
        for (int ai = 0; ai < 2; ++ai)
#pragma unroll
            for (int m = 0; m < 4; ++m) { const int row = row0 + ai * HALF + m * 16; const float g = gate ? gate[row] : 1.f; bf16* rowp = O + (size_t)row * DM + col0;
#pragma unroll
                for (int bj = 0; bj < 2; ++bj) { const f32x4 v0 = acc[ai][bj][m][0] * g, v1 = acc[ai][bj][m][1] * g;
                    v4u w; w.x = cvt_pk_bf16(v0[0], v0[1]); w.y = cvt_pk_bf16(v0[2], v0[3]); w.z = cvt_pk_bf16(v1[0], v1[1]); w.w = cvt_pk_bf16(v1[2], v1[3]);
                    *(v4u*)(rowp + bj * HALF) = w; } }
    }
};
struct EpiSwiglu {
    static constexpr bool PERM = true;
    bf16* O;
    __device__ __forceinline__ void operator()(const f32x4 (&acc)[2][2][4][2], const Unit& u, int wr, int wc, int fr, int fq) const {
        const int row0 = u.po * BM + wr * 64 + fr, col0 = u.pn * HALF + wc * 32 + 8 * fq;
#pragma unroll
        for (int ai = 0; ai < 2; ++ai)
#pragma unroll
            for (int m = 0; m < 4; ++m) { bf16* rowp = O + (size_t)(row0 + ai * HALF + m * 16) * DFF + col0;
                const f32x4 g0 = acc[ai][0][m][0], g1 = acc[ai][0][m][1], u0 = acc[ai][1][m][0], u1 = acc[ai][1][m][1];
                v4u w; w.x = cvt_pk_bf16(silu_fast(g0[0]) * u0[0], silu_fast(g0[1]) * u0[1]); w.y = cvt_pk_bf16(silu_fast(g0[2]) * u0[2], silu_fast(g0[3]) * u0[3]);
                w.z = cvt_pk_bf16(silu_fast(g1[0]) * u1[0], silu_fast(g1[1]) * u1[1]); w.w = cvt_pk_bf16(silu_fast(g1[2]) * u1[2], silu_fast(g1[3]) * u1[3]);
                *(v4u*)rowp = w; }
    }
};

template <class Epi, class Sched>
__device__ __forceinline__ void gemm_phase(LAS unsigned char* lds, const int tid, const Gemm g, const Sched& S, const Epi& E) {
    const int wid = __builtin_amdgcn_readfirstlane(tid >> 6), lane = tid & 63, wr = wid >> 2, wc = wid & 3, fr = lane & 15, fq = lane >> 4;
    const int K = g.K, nt = K / BK;
    unsigned voffA[2], voffB[2];
#pragma unroll
    for (int i = 0; i < 2; ++i) { int R, C; stage_rc(tid * 16 + i * 8192, R, C); const int Rb = Epi::PERM ? ((R & ~31) + perm32(R & 31)) : R; voffA[i] = (unsigned)(R * K + C) * 2u; voffB[i] = (unsigned)(Rb * K + C) * 2u; }
    const size_t kstep = (size_t)(BK * 2);
    const size_t hstep = (size_t)HALF * K * 2;
    const size_t tstep = 2 * hstep;
    const unsigned ldsw = (unsigned)wid * 1024u;
    const int aoff = lds_byte(wr * 64 + fr, fq * 8), boff = lds_byte(wc * 32 + fr, fq * 8);
#define PG8_SA(b, h) (((b) * 2 + (h)) * HTB)
#define PG8_SB(b, h) ((4 + (b) * 2 + (h)) * HTB)
#define PG8_STAGE(bufoff, gbase, voff) do { _Pragma("unroll") for (int _i = 0; _i < 2; ++_i) \
        __builtin_amdgcn_global_load_lds((const unsigned*)((const char*)(gbase) + (voff)[_i]), (LAS unsigned*)(lds + (bufoff) + ldsw + _i * 8192), 16, 0, 0); } while (0)
#define PG8_LDA(dst, b, h) do { _Pragma("unroll") for (int m = 0; m < 4; ++m) _Pragma("unroll") for (int k = 0; k < 2; ++k) dst[m][k] = *(const LAS bf16x8*)(lds + PG8_SA(b, h) + aoff + m * 2048 + k * 1024); } while (0)
#define PG8_LDB(dst, b, h) do { _Pragma("unroll") for (int n = 0; n < 2; ++n) _Pragma("unroll") for (int k = 0; k < 2; ++k) dst[n][k] = *(const LAS bf16x8*)(lds + PG8_SB(b, h) + boff + n * 2048 + k * 1024); } while (0)
#define PG8_MMA(ai, bj, At, Bt) do { __builtin_amdgcn_s_setprio(1); _Pragma("unroll") for (int m = 0; m < 4; ++m) _Pragma("unroll") for (int n = 0; n < 2; ++n) _Pragma("unroll") for (int k = 0; k < 2; ++k) \
        acc[ai][bj][m][n] = __builtin_amdgcn_mfma_f32_16x16x32_bf16(Bt[n][k], At[m][k], acc[ai][bj][m][n], 0, 0, 0); __builtin_amdgcn_s_setprio(0); } while (0)
#define PG8_WAIT_V(n) asm volatile("s_waitcnt vmcnt(" #n ")" ::: "memory")
#define PG8_WAIT_L(n) asm volatile("s_waitcnt lgkmcnt(" #n ")" ::: "memory")
#define PG8_BAR __builtin_amdgcn_s_barrier()
#define PG8_SCHED __builtin_amdgcn_sched_barrier(0)
    Unit cur, nxt; int ui = 0;
    if (!S.next(0, cur)) return;
    f32x4 acc[2][2][4][2];
#pragma unroll
    for (int a = 0; a < 2; ++a)
#pragma unroll
        for (int b = 0; b < 2; ++b)
#pragma unroll
            for (int m = 0; m < 4; ++m)
#pragma unroll
                for (int n = 0; n < 2; ++n) acc[a][b][m][n] = (f32x4){0.f, 0.f, 0.f, 0.f};
    bf16x8 At[4][2], B0[2][2], B1[2][2];
    const char* cA = (const char*)g.A + (size_t)cur.pm * tstep;
    const char* cB = (const char*)g.Bt + (size_t)cur.eb * g.ebytes + (size_t)cur.pn * tstep;
    PG8_STAGE(PG8_SB(0, 0), cB, voffB); PG8_STAGE(PG8_SB(0, 1), cB + hstep, voffB); PG8_STAGE(PG8_SA(0, 0), cA, voffA); PG8_STAGE(PG8_SA(0, 1), cA + hstep, voffA);
    if (wr == 1) PG8_BAR;
    PG8_WAIT_V(2); PG8_BAR;
    PG8_STAGE(PG8_SB(1, 0), cB + kstep, voffB); PG8_STAGE(PG8_SA(1, 0), cA + kstep, voffA); PG8_STAGE(PG8_SB(1, 1), cB + hstep + kstep, voffB);
    PG8_WAIT_V(6); PG8_BAR;
    for (;;) {
        const bool has_next = S.next(ui + 1, nxt);
        const char* nA = has_next ? (const char*)g.A + (size_t)nxt.pm * tstep : cA;
        const char* nB = has_next ? (const char*)g.Bt + (size_t)nxt.eb * g.ebytes + (size_t)nxt.pn * tstep : cB;
#define PG8_PAIR(a1, a2, b2, a3, b3) do { \
              \
            PG8_LDB(B0, 0, 0); PG8_LDB(B1, 0, 1); PG8_SCHED; PG8_LDA(At, 0, 0); PG8_STAGE(PG8_SA(1, 1), (a1) + hstep, voffA); \
            PG8_WAIT_V(8); PG8_WAIT_L(0); PG8_BAR; PG8_MMA(0, 0, At, B0); PG8_MMA(0, 1, At, B1); PG8_BAR; PG8_SCHED; \
              \
            PG8_LDA(At, 0, 1); PG8_STAGE(PG8_SB(0, 0), b2, voffB); PG8_STAGE(PG8_SB(0, 1), (b2) + hstep, voffB); PG8_STAGE(PG8_SA(0, 0), a2, voffA); \
            PG8_WAIT_V(8); PG8_WAIT_L(0); PG8_BAR; PG8_MMA(1, 0, At, B0); PG8_MMA(1, 1, At, B1); PG8_BAR; PG8_SCHED; \
              \
            PG8_LDB(B0, 1, 0); PG8_LDB(B1, 1, 1); PG8_SCHED; PG8_LDA(At, 1, 0); PG8_STAGE(PG8_SA(0, 1), (a2) + hstep, voffA); \
            PG8_WAIT_V(8); PG8_WAIT_L(0); PG8_BAR; PG8_MMA(0, 0, At, B0); PG8_MMA(0, 1, At, B1); PG8_BAR; PG8_SCHED; \
              \
            PG8_LDA(At, 1, 1); PG8_STAGE(PG8_SB(1, 0), b3, voffB); PG8_STAGE(PG8_SB(1, 1), (b3) + hstep, voffB); PG8_STAGE(PG8_SA(1, 0), a3, voffA); \
            PG8_WAIT_V(8); PG8_WAIT_L(0); PG8_BAR; PG8_MMA(1, 0, At, B0); PG8_MMA(1, 1, At, B1); PG8_BAR; PG8_SCHED; } while (0)
        for (int t = 0; t < nt; t += 2) {
            const bool last = (t == nt - 2);
            const char* a1 = cA + (size_t)(t + 1) * kstep;
            const char* a2 = last ? nA : cA + (size_t)(t + 2) * kstep; const char* b2 = last ? nB : cB + (size_t)(t + 2) * kstep;
            const char* a3 = a2 + kstep; const char* b3 = b2 + kstep;
            PG8_PAIR(a1, a2, b2, a3, b3);
        }
#undef PG8_PAIR
        if (wr == 0) PG8_BAR;
        E(acc, cur, wr, wc, fr, fq);
        if (!has_next) break;
#pragma unroll
        for (int a = 0; a < 2; ++a)
#pragma unroll
            for (int b = 0; b < 2; ++b)
#pragma unroll
                for (int m = 0; m < 4; ++m)
#pragma unroll
                    for (int n = 0; n < 2; ++n) acc[a][b][m][n] = (f32x4){0.f, 0.f, 0.f, 0.f};
        cur = nxt; cA = nA; cB = nB; ++ui;
        if (wr == 1) PG8_BAR;
    }
    PG8_WAIT_V(0);
    PG8_BAR;
#undef PG8_SA
#undef PG8_SB
#undef PG8_STAGE
#undef PG8_LDA
#undef PG8_LDB
#undef PG8_MMA
#undef PG8_WAIT_V
#undef PG8_WAIT_L
#undef PG8_BAR
#undef PG8_SCHED
}
}

constexpr int N_STEPS = 2 + 2 * (7 - USE_GSEQ + 2 * NPASS_DENSE) + 2 * (8 - USE_GSEQ + 2 * NPASS_MOE);
#ifndef REP_A
#define REP_A 1
#define REP_B 1
#endif
#ifndef PROBE_ID
#define PROBE_ID 0
#endif
#ifndef REP_BAR
#define REP_BAR 1
#endif
#ifndef REP_C
#define REP_C 1
#endif
#ifndef REP_L
#define REP_L 1
#endif
#ifndef REP_G
#define REP_G 1
#endif
#ifndef USE_B3
#define USE_B3 1
#endif
#ifndef USE_B2
#define USE_B2 1
#define USE_A2 1
#endif
#ifndef USE_PG8
#define USE_PG8 1
#endif
#ifndef USE_A4
#define USE_A4 1
#endif

__global__ void __launch_bounds__(512, 2) hybrid_fwd(Args args) {
    extern __shared__ __attribute__((aligned(16))) unsigned char lds_raw[];
    Ctx C;
    C.lds = (LAS unsigned char*)lds_raw;
    C.MISC = (volatile LAS unsigned*)(C.lds + MISC_OFF);
    C.tid = threadIdx.x; C.lane = C.tid & 63; C.wave = __builtin_amdgcn_readfirstlane(C.tid >> 6);
    C.G = gridDim.x; C.bid = blockIdx.x; C.hot = 0xffff;
    C.ka = (KArgs*)__builtin_amdgcn_kernarg_segment_ptr();
    C.out = args.out; C.ws = args.ws; C.ctl = (unsigned*)(args.ws + WS_CTL);
    if (C.tid < 32) C.MISC[C.tid] = 0u;
    __syncthreads();
    if (!MK_MULTI) (void)xcd_barrier_post(C.ctl + CW_BAR, C.MISC + 8);
    int step = 0;
    const int wave_s = __builtin_amdgcn_readfirstlane((int)threadIdx.x >> 6);
#define STEP_BEGIN if (step >= C.ka->lo && step < C.ka->hi) { { unsigned m_ = ~0u; asm volatile("" : "+s"(m_)); const int ln_ = (int)__builtin_amdgcn_mbcnt_hi(m_, __builtin_amdgcn_mbcnt_lo(m_, 0u)); \
        int t_ = wave_s * 64 + ln_; asm volatile("" : "+v"(t_)); C.tid = t_; C.lane = t_ & 63; C.wave = wave_s; \
        KArgs* k_ = (KArgs*)__builtin_amdgcn_kernarg_segment_ptr(); asm volatile("" : "+s"(k_)); C.ka = k_; C.ws = k_->ws; C.out = k_->out; C.ctl = (unsigned*)(k_->ws + WS_CTL); C.G = gridDim.x; C.bid = blockIdx.x; }
#define STEP_END } if (!MK_MULTI && step >= C.ka->lo && step + 1 < C.ka->hi) { XcdBarrier b_; b_.bar = (unsigned*)(C.ka->ws + WS_CTL) + CW_BAR; b_.x = xb_xcc_id(); b_.st = C.MISC + 8; xcd_barrier(b_); if (REP_BAR > 1) xcd_barrier(b_); } ++step;
#define WSP(T, off) ((T*)(C.ws + (off)))
#define RELAUNDER { int t_ = C.tid; asm volatile("" : "+v"(t_)); C.tid = t_; C.lane = t_ & 63; C.wave = __builtin_amdgcn_readfirstlane(t_ >> 6); }

    STEP_BEGIN
        ph_mod(C); __syncthreads(); ph_conv(C, 0);
#if REP_C > 1
        __syncthreads(); ph_mod(C); __syncthreads(); ph_conv(C, 0);
#endif
    STEP_END
    STEP_BEGIN
        ph_modulate0(C);
#if PROBE_ID == 8
        RELAUNDER ph_modulate0(C); RELAUNDER ph_modulate0(C); RELAUNDER ph_modulate0(C); RELAUNDER ph_modulate0(C);
#endif
    STEP_END

    for (int l = 0; l < DEPTH; ++l) {
        STEP_BEGIN
#if USE_PG8
            { const pg8::Gemm g{WSP(bf16, WS_H), WSP(bf16, WS_WIN), DM, 0}; pg8::Order S; S.init(256, 11, C.G, C.bid, 0, 0, nullptr);
              pg8::gemm_phase(C.lds, C.tid, g, S, pg8::EpiProj{WSP(bf16, WS_P), WSP(bf16, WS_KFA), WSP(bf16, WS_KFI), WSP(bf16, WS_VF)});
#if PROBE_ID == 5
              RELAUNDER pg8::gemm_phase(C.lds, C.tid, g, S, pg8::EpiProj{WSP(bf16, WS_P), WSP(bf16, WS_KFA), WSP(bf16, WS_KFI), WSP(bf16, WS_VF)});
#endif
            }
#else
            for (int u = C.bid; u < 256 * 11; u += C.G) {
                const int pm = u / 11, pn = u % 11; const GUnit gu{pm * 256, pm * 256, pn, 0};
                gemm_simple_unit<0>(C, WSP(bf16, WS_H), DM, nullptr, WSP(bf16, WS_WIN), DM, gu, EpiStoreS{WSP(bf16, WS_P), PW});
            }
#endif
        STEP_END
        STEP_BEGIN
#pragma unroll 1
#if USE_A4
            for (int rp_ = 0; rp_ < (PROBE_ID == 1 ? 2 : 1); ++rp_) {
#ifdef PROBE_HOT
                C.hot = (PROBE_ID == 1 && rp_ == 0) ? PROBE_HOT : 0xffff;
#endif
#ifdef PROBE_SKIP
#define A4_SKIPM ((PROBE_ID == 1 && rp_ == 0) ? PROBE_SKIP : 0)
#else
#define A4_SKIPM 0
#endif
#define A4_MAP(idx_) const int b = (idx_) & 15, r_ = (idx_) >> 4, j_ = (r_ & 15) + 16 * (r_ >> 5), t0 = 4 * (((r_ >> 4) & 1) ? 1023 - j_ : j_);
                LAS unsigned* img = (LAS unsigned*)C.lds;
#if USE_GSEQ
                const int NGW = C.G >= 128 ? 64 : C.G / 2, NW = C.G - NGW, wid = C.bid - NGW;
                const int nun = (wid >= 0 && wid < 16384) ? (16384 - wid + NW - 1) / NW : 0;
                if (wid < 0) {
#pragma unroll 1
                    for (int sq_ = C.bid; sq_ < 64; sq_ += NGW) { RELAUNDER ph_gla_seq(C, l, sq_); }
                } else
#else
                const int NW = C.G, wid = C.bid;
                const int nun = (C.bid < 16384) ? (16384 - C.bid + C.G - 1) / C.G : 0;
#endif
                if (C.wave < 4) {
                    A4S S;
                    { A4_MAP(nun > 0 ? wid : 0) a4_prefetch(C, S, b, t0); }
#pragma unroll 1
                    for (int k = 0; k < nun; ++k) { RELAUNDER
                        { const int nidx = (k + 1 < nun) ? wid + (k + 1) * NW : wid; const int nb = nidx & 15, nr_ = nidx >> 4, nj_ = (nr_ & 15) + 16 * (nr_ >> 5), nt0 = 4 * (((nr_ >> 4) & 1) ? 1023 - nj_ : nj_);
                          A4_MAP(wid + k * NW) a4_score(C, S, img + (k & 1) * A4_BUF, b, t0, nb, nt0); }
                        __syncthreads(); }
                } else {
#pragma unroll 1
                    for (int k = 0; k < nun; ++k) { __syncthreads(); RELAUNDER A4_MAP(wid + k * NW) const int q = C.wave - 4; if (!(A4_SKIPM & 32)) a4_select(C, img + (k & 1) * A4_BUF + q * A3_QP, b, t0 + q); }
                }
                __syncthreads();
#undef A4_MAP
            }
#else
            for (int rp_ = 0; rp_ < (PROBE_ID == 1 ? 2 : 1); ++rp_)
            for (int idx = C.bid; idx < 8192; idx += C.G) {
                RELAUNDER
                const int b = idx & 15, r = idx >> 4, j = (r & 15) + 16 * (r >> 5), qb = ((r >> 4) & 1) ? 511 - j : j;
                A3Q qa; a3_load_q(C, b, qb * 8, qa);
                ph_dsa_a3_unit(C, b, qb * 8, qa, false, 0, 0);
            }
#endif
#if !USE_GSEQ
#pragma unroll 1
            for (int rp_ = 0; rp_ < (PROBE_ID == 3 ? 2 : 1); ++rp_)
            for (int u = C.bid; u < 4096; u += C.G) { RELAUNDER ph_gla1_unit(C, l, u); }
#endif
        STEP_END
#if !USE_GSEQ
        STEP_BEGIN
            ph_gla2(C);
#if PROBE_ID == 9
            RELAUNDER ph_gla2(C, (size_t)66 * MiB); RELAUNDER ph_gla2(C, (size_t)66 * MiB);
#endif
        STEP_END
#endif
        STEP_BEGIN
#if !USE_GSEQ
#pragma unroll 1
            for (int rp_ = 0; rp_ < (PROBE_ID == 4 ? 2 : 1); ++rp_)
            for (int u = C.bid; u < 4096; u += C.G) { RELAUNDER ph_gla3_unit(C, l, u); }
#endif
#if USE_B2
#pragma unroll 1
            for (int rep = 0; rep < (PROBE_ID == 2 ? 2 : 1); ++rep)
#ifdef PROBE_HOT
            { C.hot = (PROBE_ID == 2 && rep == 0) ? PROBE_HOT : 0xffff;
#else
            {
#endif
            for (int idx = C.bid; idx < 2048; idx += C.G) {
                RELAUNDER
                const int b = idx & 15, r = idx >> 4, j = (r & 15) + 16 * (r >> 5), qb = ((r >> 4) & 1) ? 127 - j : j;
#if USE_B3
                ph_dsa_b3_wave(C, b, qb * 32 + C.wave * 4);
#else
                ph_dsa_b2_wave(C, b, qb * 32 + C.wave * 4);
#endif
            }
            }
#else
            for (int u = C.bid; u < 8192; u += C.G) { RELAUNDER ph_dsa_b_unit(C, u & 15, (u >> 4) * 8); }
#endif
        STEP_END
        STEP_BEGIN
#if USE_PG8
            { const pg8::Gemm g{(const bf16*)C.out, WSP(bf16, WS_WOUT), DM, 0}; pg8::Order S; S.init(256, 4, C.G, C.bid, 0, 0, nullptr);
              pg8::gemm_phase(C.lds, C.tid, g, S, pg8::EpiBf16{WSP(bf16, WS_Y), DM});
#if PROBE_ID == 6
              RELAUNDER pg8::gemm_phase(C.lds, C.tid, g, S, pg8::EpiBf16{WSP(bf16, WS_Y), DM});
#endif
            }
#else
            for (int u = C.bid; u < 256 * 4; u += C.G) {
                const int pm = u >> 2, pn = u & 3; const GUnit gu{pm * 256, pm * 256, pn, 0};
                gemm_simple_unit<0>(C, WSP(bf16, WS_H), DM, nullptr, WSP(bf16, WS_WOUT), DM, gu, EpiStoreS{WSP(bf16, WS_Y), DM});
            }
#endif
        STEP_END
        STEP_BEGIN
            const float* Xin = C.in(I_X);
            if (l == 0) ph_ln<false, 0, 0>(C, Xin, l, 0, 2048, l, 3072, true, 0, 0, false);
            else if (l & 1) ph_ln<true, 0, 1>(C, Xin, l, 0, 2048, l, 3072, true, l >> 1, 0, false);
            else ph_ln<false, 0, 1>(C, Xin, l, 0, 2048, l, 3072, true, l >> 1, 0, false);
        STEP_END
        if (l & 1) {
            STEP_BEGIN
                ph_assign(C, l >> 1);
            STEP_END
        }
        for (int pass = 0; pass < ((l & 1) ? NPASS_MOE : NPASS_DENSE); ++pass) {
            STEP_BEGIN
                const bool moe = (l & 1) != 0;
                MoeTab tb; tb.npanels = 256;
#pragma unroll
                for (int e = 0; e < 8; ++e) tb.pend[e] = 65536;
                if (moe) tb = moe_tab(C, l >> 1);
                const int p_lo = pass * PASS_PANELS, p_hi = moe ? ((pass == NPASS_MOE - 1 || tb.npanels < p_lo + PASS_PANELS) ? tb.npanels : p_lo + PASS_PANELS) : p_lo + PASS_PANELS;
                const int npan = p_hi > p_lo ? p_hi - p_lo : 0;
#if USE_PG8
                LAS unsigned char* pe = C.lds + PE_OFF;
                for (int p = C.tid; p < 528; p += 512) pe[p] = (unsigned char)(moe ? panel_expert(tb, p) : 0);
                __syncthreads();
                { const pg8::Gemm g{moe ? WSP(bf16, WS_Y) : WSP(bf16, WS_H), WSP(bf16, WS_WGU), DM, (size_t)5632 * 1024 * 2}; pg8::Order S; S.init(npan, 22, C.G, C.bid, p_lo, 0, pe);
                  pg8::gemm_phase(C.lds, C.tid, g, S, pg8::EpiSwiglu{WSP(bf16, WS_P)});
#if REP_G > 1
                  RELAUNDER pg8::gemm_phase(C.lds, C.tid, g, S, pg8::EpiSwiglu{WSP(bf16, WS_P)});
#endif
                }
#else
                for (int u = C.bid; u < npan * 22; u += C.G) {
                    const int lp = u / 22, pn = u % 22, gp = p_lo + lp; const int e = moe ? panel_expert(tb, gp) : 0;
                    const GUnit gu{gp * 256, lp * 256, pn, (size_t)e * 5632 * 1024};
                    gemm_simple_unit<1>(C, moe ? WSP(bf16, WS_Y) : WSP(bf16, WS_H), DM, nullptr, WSP(bf16, WS_WGU), DM, gu, EpiSwigluS{WSP(bf16, WS_P)});
                }
#endif
            STEP_END
            STEP_BEGIN
                const bool moe = (l & 1) != 0;
                MoeTab tb; tb.npanels = 256;
#pragma unroll
                for (int e = 0; e < 8; ++e) tb.pend[e] = 65536;
                if (moe) tb = moe_tab(C, l >> 1);
                const int p_lo = pass * PASS_PANELS, p_hi = moe ? ((pass == NPASS_MOE - 1 || tb.npanels < p_lo + PASS_PANELS) ? tb.npanels : p_lo + PASS_PANELS) : p_lo + PASS_PANELS;
                const int npan = p_hi > p_lo ? p_hi - p_lo : 0;
#if USE_PG8
                LAS unsigned char* pe = C.lds + PE_OFF;
                for (int p = C.tid; p < 528; p += 512) pe[p] = (unsigned char)(moe ? panel_expert(tb, p) : 0);
                __syncthreads();
                { const pg8::Gemm g{WSP(bf16, WS_P), WSP(bf16, WS_WDN), DFF, (size_t)1024 * DFF * 2}; pg8::Order S; S.init(npan, 4, C.G, C.bid, p_lo, 1, pe);
                  pg8::gemm_phase(C.lds, C.tid, g, S, pg8::EpiGate{WSP(bf16, WS_Y), moe ? WSP(float, WS_ROWGATE) : nullptr});
#if PROBE_ID == 7
                  RELAUNDER pg8::gemm_phase(C.lds, C.tid, g, S, pg8::EpiGate{WSP(bf16, WS_Y), moe ? WSP(float, WS_ROWGATE) : nullptr});
#endif
                }
#else
                for (int u = C.bid; u < npan * 4; u += C.G) {
                    const int lp = u >> 2, pn = u & 3, gp = p_lo + lp; const int e = moe ? panel_expert(tb, gp) : 0;
                    const GUnit gu{lp * 256, gp * 256, pn, (size_t)e * 1024 * DFF};
                    if (moe) gemm_simple_unit<0>(C, WSP(bf16, WS_P), DFF, nullptr, WSP(bf16, WS_WDN), DFF, gu, EpiGateS{WSP(bf16, WS_Y), WSP(float, WS_ROWGATE)});
                    else gemm_simple_unit<0>(C, WSP(bf16, WS_P), DFF, nullptr, WSP(bf16, WS_WDN), DFF, gu, EpiStoreS{WSP(bf16, WS_Y), DM});
                }
#endif
            STEP_END
        }
        STEP_BEGIN
            const int l2 = l < 3 ? l + 1 : 3;
            if (l & 1) ph_ln<false, 1, 1>(C, nullptr, l, 1, 5120, l2, 0, l < 3, 0, 3072, l == 3); else ph_ln<false, 0, 1>(C, nullptr, l, 1, 5120, l2, 0, l < 3, 0, 3072, l == 3);
            if (l < 3) ph_conv(C, l + 1);
#if REP_C > 1
            if (l < 3) { RELAUNDER ph_conv(C, l + 1); }
#endif
        STEP_END
    }
#undef STEP_BEGIN
#undef STEP_END
#undef WSP
#undef RELAUNDER
}

#ifndef DUMP_HI
#define DUMP_HI 0
#define DUMP_OFF 0
#define DUMP_WORDS 1
#endif
#if DUMP_HI
__global__ void __launch_bounds__(256) copy_half_k(const unsigned* src, unsigned* dst) {
    for (size_t i = (size_t)blockIdx.x * 256 + threadIdx.x; i < (size_t)65536 * 256; i += (size_t)gridDim.x * 256) dst[i] = src[(i >> 8) * 512 + (i & 255)];
}
__global__ void __launch_bounds__(256) dump_k(const unsigned* src, size_t nwords, float* out) {
    const size_t N = (size_t)MTOK * DM;
    for (size_t i = (size_t)blockIdx.x * 256 + threadIdx.x; i < N; i += (size_t)gridDim.x * 256) {
        float v = 0.f;
        for (size_t k = i % nwords; k < nwords; k += N) { const unsigned w = src[k]; v += (float)((w ^ (w >> 13)) & 0xFFFu); }
        out[i] = v;
    }
}
#endif
extern "C" void kernel_launch(void* const* d_in, const int* in_sizes, int n_in, void* d_out, int out_size, void* d_ws, size_t ws_size, hipStream_t stream) {
    static int grid = 0;
    if (grid == 0) {
        if (n_in != 19 || in_sizes[0] != MTOK * DM || out_size != MTOK * DM || ws_size < WS_END) {
            fprintf(stderr, "kernel_launch: unexpected shapes (n_in %d, in0 %d, out %d, ws %zu); nothing launched\n", n_in, n_in > 0 ? in_sizes[0] : -1, out_size, ws_size); grid = -1; return; }
        int dev = 0, cus = 0, per_cu = 0;
        if (hipGetDevice(&dev) != hipSuccess || hipDeviceGetAttribute(&cus, hipDeviceAttributeMultiprocessorCount, dev) != hipSuccess) { grid = -1; return; }
        if (hipFuncSetAttribute((const void*)hybrid_fwd, hipFuncAttributeMaxDynamicSharedMemorySize, LDS_BYTES) != hipSuccess) { fprintf(stderr, "kernel_launch: hipFuncSetAttribute failed\n"); grid = -1; return; }
        if (hipOccupancyMaxActiveBlocksPerMultiprocessor(&per_cu, (const void*)hybrid_fwd, 512, LDS_BYTES) != hipSuccess || per_cu < 1)
            fprintf(stderr, "kernel_launch: note: occupancy query reports %d workgroups per CU\n", per_cu);
        (void)hipGetLastError();
        grid = cus;
    }
    if (grid < 0) return;
    if (hipMemsetAsync((char*)d_ws + WS_CTL, 0, CTL_ZERO_BYTES, stream) != hipSuccess) { fprintf(stderr, "kernel_launch: memset failed\n"); return; }
    Args a{};
    for (int i = 0; i < 19; ++i) a.in[i] = (const float*)d_in[i];
    a.out = (float*)d_out; a.ws = (unsigned char*)d_ws;
#if MK_MULTI
    for (int s = 0; s < N_STEPS; ++s) { a.lo = s; a.hi = s + 1; hipLaunchKernelGGL(hybrid_fwd, dim3(grid), dim3(512), LDS_BYTES, stream, a); }
#else
#ifdef DUMP_SPLIT
    a.lo = 0; a.hi = DUMP_SPLIT;
    hipLaunchKernelGGL(hybrid_fwd, dim3(grid), dim3(512), LDS_BYTES, stream, a);
    (void)hipMemsetAsync((char*)d_ws + WS_CTL, 0, 65536, stream);
    a.lo = DUMP_SPLIT; a.hi = DUMP_HI;
    hipLaunchKernelGGL(hybrid_fwd, dim3(grid), dim3(512), LDS_BYTES, stream, a);
#else
    a.lo = 0; a.hi = DUMP_HI ? DUMP_HI : N_STEPS;
    hipLaunchKernelGGL(hybrid_fwd, dim3(grid), dim3(512), LDS_BYTES, stream, a);
#endif
#ifdef DUMP_OUTCOPY
    hipLaunchKernelGGL(copy_half_k, dim3(8192), dim3(256), 0, stream, (const unsigned*)d_out + (DUMP_OUTCOPY == 2 ? 256 : 0), (unsigned*)((char*)d_ws + (size_t)DUMP_OFF));
#endif
#if DUMP_HI
    hipLaunchKernelGGL(dump_k, dim3(8192), dim3(256), 0, stream, (const unsigned*)((const char*)d_ws + (size_t)DUMP_OFF), (size_t)DUMP_WORDS, (float*)d_out);
#endif
#endif
    const hipError_t le = hipPeekAtLastError();
    if (le != hipSuccess) fprintf(stderr, "kernel_launch: launch failed: %s\n", hipGetErrorName(le));
}
```

```cpp
#include <hip/hip_runtime.h>
#include <cstdio>
#include <cstdint>

#define GAS __attribute__((address_space(1)))
#define LAS __attribute__((address_space(3)))
typedef unsigned short bf16;
typedef unsigned v4u __attribute__((ext_vector_type(4)));
typedef unsigned v2u __attribute__((ext_vector_type(2)));
typedef float f32x4 __attribute__((ext_vector_type(4)));
typedef float f32x2 __attribute__((ext_vector_type(2)));
typedef float f32x16 __attribute__((ext_vector_type(16)));
typedef short bf16x8 __attribute__((ext_vector_type(8)));

#ifndef USE_LIST
#define USE_LIST 0
#endif
#ifndef USE_BCAST
#define USE_BCAST 1
#endif
#ifndef USE_GSEQ
#define USE_GSEQ 1
#endif
#ifndef MK_MULTI
#define MK_MULTI 0
#endif

constexpr int BATCH = 16, SEQ = 4096, DM = 1024, DEPTH = 4, MTOK = BATCH * SEQ;
constexpr int PW = 2816;
constexpr int PROJ_SRC = 2776;
constexpr int C_AQ = 0, C_IQ = 512, C_BQ = 1024, C_BK = 1280, C_BV = 1536, C_BG = 2048, C_AK = 2560, C_AV = 2624, C_IK = 2688, C_IW = 2752, C_BA = 2760;
constexpr int DFF = 2816, NEXP = 8;
constexpr int PASS_PANELS = 256, NPASS_DENSE = 1, NPASS_MOE = 2;
constexpr float DN_ALPHA = 1.681792830507429f;
constexpr float LN_EPS = 1e-5f;
constexpr float LOG2E = 1.4426950408889634f;

constexpr size_t MiB = 1u << 20;
constexpr size_t WS_CTL = 0, CTL_ZERO_BYTES = 1 * MiB;
constexpr size_t WS_MOD = 1 * MiB;
constexpr size_t WS_TOPE = 3 * MiB;
constexpr size_t WS_TOPG = WS_TOPE + MiB / 2;
constexpr size_t WS_TOKSLOT = WS_TOPG + MiB / 2;
constexpr size_t WS_ROWTOK = 5 * MiB;
constexpr size_t WS_ROWGATE = 6 * MiB;
constexpr size_t WS_WIN = 8 * MiB;
constexpr size_t WS_WOUT = 14 * MiB;
constexpr size_t WS_WGU = 16 * MiB;
constexpr size_t WS_WDN = 104 * MiB;
constexpr size_t WS_H = 148 * MiB;
constexpr size_t WS_P = 276 * MiB;
constexpr size_t WS_Y = 640 * MiB;
constexpr size_t WS_SEL = 900 * MiB;
constexpr size_t WS_END = 1024 * MiB;

constexpr int CW_BAR = 4096;
constexpr int CW_QUEUE = 8192;
constexpr int CW_CNT = 10240;
constexpr int CW_FILL = 10752;

constexpr int LDS_BYTES = 147456;
constexpr int PE_OFF = 131072;
constexpr int MISC_OFF = 139264;

__device__ __forceinline__ float bf2f(unsigned v) { return __uint_as_float(v << 16); }
typedef __bf16 bf16x2_t __attribute__((ext_vector_type(2)));
__device__ __forceinline__ unsigned pk2(float lo, float hi) { const f32x2 v = {lo, hi}; return __builtin_bit_cast(unsigned, __builtin_convertvector(v, bf16x2_t)); }
__device__ __forceinline__ unsigned f2bf(float f) { return pk2(f, 0.f) & 0xffffu; }
__device__ __forceinline__ float wave_sum(float v) {
#pragma unroll
    for (int o = 1; o < 64; o <<= 1) v += __shfl_xor(v, o);
    return v;
}
__device__ __forceinline__ float wave_max(float v) {
#pragma unroll
    for (int o = 1; o < 64; o <<= 1) v = fmaxf(v, __shfl_xor(v, o));
    return v;
}
#define DPP_U32(x, ctrl) ((unsigned)__builtin_amdgcn_update_dpp(0, (int)(x), (ctrl), 0xF, 0xF, true))
__device__ __forceinline__ unsigned wave_sum_u32(unsigned x) {
    x += DPP_U32(x, 0xB1); x += DPP_U32(x, 0x4E); x += DPP_U32(x, 0x124); x += DPP_U32(x, 0x128);
#if USE_BCAST
    x += (unsigned)__builtin_amdgcn_update_dpp(0, (int)x, 0x142, 0xA, 0xF, false);
    x += (unsigned)__builtin_amdgcn_update_dpp(0, (int)x, 0x143, 0xC, 0xF, false);
    return (unsigned)__builtin_amdgcn_readlane((int)x, 63);
#else
    return (unsigned)__builtin_amdgcn_readlane((int)x, 0) + (unsigned)__builtin_amdgcn_readlane((int)x, 16) + (unsigned)__builtin_amdgcn_readlane((int)x, 32) + (unsigned)__builtin_amdgcn_readlane((int)x, 48);
#endif
}
__device__ __forceinline__ float dpp_f32_(float x, int) { return x; }
#define DPP_F32(x, ctrl) (__builtin_bit_cast(float, __builtin_amdgcn_update_dpp(0, __builtin_bit_cast(int, (x)), (ctrl), 0xF, 0xF, true)))
__device__ __forceinline__ float wave_sum_f(float x) {
    x += DPP_F32(x, 0xB1); x += DPP_F32(x, 0x4E); x += DPP_F32(x, 0x124); x += DPP_F32(x, 0x128);
    const float r0 = __builtin_bit_cast(float, __builtin_amdgcn_readlane(__builtin_bit_cast(int, x), 0)), r1 = __builtin_bit_cast(float, __builtin_amdgcn_readlane(__builtin_bit_cast(int, x), 16));
    const float r2 = __builtin_bit_cast(float, __builtin_amdgcn_readlane(__builtin_bit_cast(int, x), 32)), r3 = __builtin_bit_cast(float, __builtin_amdgcn_readlane(__builtin_bit_cast(int, x), 48));
    return (r0 + r1) + (r2 + r3);
}
__device__ __forceinline__ unsigned umax_(unsigned a, unsigned b) { return a > b ? a : b; }
__device__ __forceinline__ unsigned umin_(unsigned a, unsigned b) { return a < b ? a : b; }
__device__ __forceinline__ unsigned wave_max_u32(unsigned x) {
    x = umax_(x, DPP_U32(x, 0xB1)); x = umax_(x, DPP_U32(x, 0x4E)); x = umax_(x, DPP_U32(x, 0x124)); x = umax_(x, DPP_U32(x, 0x128));
    return umax_(umax_((unsigned)__builtin_amdgcn_readlane((int)x, 0), (unsigned)__builtin_amdgcn_readlane((int)x, 16)), umax_((unsigned)__builtin_amdgcn_readlane((int)x, 32), (unsigned)__builtin_amdgcn_readlane((int)x, 48)));
}
__device__ __forceinline__ unsigned wave_min_u32(unsigned x) {
    x = umin_(x, DPP_U32(x, 0xB1)); x = umin_(x, DPP_U32(x, 0x4E)); x = umin_(x, DPP_U32(x, 0x124)); x = umin_(x, DPP_U32(x, 0x128));
    return umin_(umin_((unsigned)__builtin_amdgcn_readlane((int)x, 0), (unsigned)__builtin_amdgcn_readlane((int)x, 16)), umin_((unsigned)__builtin_amdgcn_readlane((int)x, 32), (unsigned)__builtin_amdgcn_readlane((int)x, 48)));
}
#define SHX_F(v, o, lane_) (__builtin_bit_cast(float, __builtin_amdgcn_ds_bpermute((((lane_) ^ (o)) << 2), __builtin_bit_cast(int, (float)(v)))))
#define SHUP_I(v, o, lane_) (__builtin_amdgcn_ds_bpermute((((lane_) - (o)) << 2), (int)(v)))
__device__ __forceinline__ int wave_incl_scan_i(int x, int lane) {
    x += __builtin_amdgcn_update_dpp(0, x, 0x111, 0xF, 0xF, true); x += __builtin_amdgcn_update_dpp(0, x, 0x112, 0xF, 0xF, true);
    x += __builtin_amdgcn_update_dpp(0, x, 0x114, 0xF, 0xF, true); x += __builtin_amdgcn_update_dpp(0, x, 0x118, 0xF, 0xF, true);
    const int t0 = __builtin_amdgcn_readlane(x, 15), t1 = __builtin_amdgcn_readlane(x, 31), t2 = __builtin_amdgcn_readlane(x, 47);
    return x + (lane >= 16 ? t0 : 0) + (lane >= 32 ? t1 : 0) + (lane >= 48 ? t2 : 0);
}
__device__ __forceinline__ float silu_f(float v) { return v / (1.f + expf(-v)); }

#define XB_TMO      128
#define XB_XCNT(j)  (256  + 64 * (j))
#define XB_XSUB(j)  (1280 + 64 * (j))
#define XB_XGEN(j)  (2304 + 64 * (j))
#define XB_TOP      3328
#define XB_TOPGEN   3392
#define XCD_BAR_WORDS 3456
#define XB_SPIN_CAP (1u << 21)

__device__ __forceinline__ unsigned xb_ld(unsigned* p)              { return __hip_atomic_load(p, __ATOMIC_RELAXED, __HIP_MEMORY_SCOPE_AGENT); }
__device__ __forceinline__ unsigned xb_add(unsigned* p, unsigned v) { return __hip_atomic_fetch_add(p, v, __ATOMIC_RELAXED, __HIP_MEMORY_SCOPE_AGENT); }
__device__ __forceinline__ unsigned xb_xcc_id() { return (unsigned)__builtin_amdgcn_s_getreg((3 << 11) | 20) & 0xFu; }
#define XB_SPIN(cond, bar) do { unsigned _sp = 0; while (cond) { __builtin_amdgcn_s_sleep(1); \
    if ((++_sp & 255u) == 0u) { if (xb_ld(&(bar)[XB_TMO])) break; if (_sp > XB_SPIN_CAP) { atomicAdd(&(bar)[XB_TMO], 1u); break; } } } } while (0)

struct XcdBarrier {
    unsigned* bar; unsigned x;
    volatile LAS unsigned* st;
};

__device__ __forceinline__ XcdBarrier xcd_barrier_post(unsigned* bar, volatile LAS unsigned* st) {
    XcdBarrier b; b.bar = bar; b.x = xb_xcc_id(); b.st = st;
    if (threadIdx.x == 0) (void)xb_add(&bar[XB_XCNT(b.x)], 1u);
    return b;
}
__device__ __forceinline__ void xcd_barrier_complete(unsigned* bar, unsigned x, unsigned& nloc, unsigned& nx) {
    const unsigned G = gridDim.x * gridDim.y * gridDim.z;
    unsigned sum, cnt, mine, sp = 0u;
    for (;;) {
        sum = 0u; cnt = 0u; mine = 0u;
#pragma unroll
        for (unsigned j = 0; j < 16; ++j) { const unsigned c = xb_ld(&bar[XB_XCNT(j)]); sum += c; cnt += (c > 0u) ? 1u : 0u; mine = (j == x) ? c : mine; }
        if (sum == G) break;
        __builtin_amdgcn_s_sleep(1);
        if ((++sp & 255u) == 0u) { if (xb_ld(&bar[XB_TMO])) break; if (sp > XB_SPIN_CAP) { atomicAdd(&bar[XB_TMO], 1u); break; } }
    }
    nloc = mine > 0u ? mine : 1u; nx = cnt > 0u ? cnt : 1u;
}

__device__ __forceinline__ void xcd_barrier(const XcdBarrier& b) {
    asm volatile("s_waitcnt vmcnt(0)" ::: "memory");
    __syncthreads();
    if (threadIdx.x == 0) {
        unsigned* bar = b.bar;
        __builtin_amdgcn_s_waitcnt(0);
        unsigned nloc = b.st[0], nx = b.st[1];
        if (nloc == 0u) { xcd_barrier_complete(bar, b.x, nloc, nx); b.st[0] = nloc; b.st[1] = nx; }
        const unsigned old = xb_add(&bar[XB_XSUB(b.x)], 1u);
        const unsigned gen = old / nloc;
        if (old + 1u == (gen + 1u) * nloc) {
            __builtin_amdgcn_fence(__ATOMIC_RELEASE, "agent");
            asm volatile("s_waitcnt vmcnt(0)" ::: "memory");
            const unsigned og = xb_add(&bar[XB_TOP], 1u);
            const unsigned tg = og / nx;
            if (og + 1u == (tg + 1u) * nx) xb_add(&bar[XB_TOPGEN], 1u);
            else XB_SPIN(xb_ld(&bar[XB_TOPGEN]) == tg, bar);
            __builtin_amdgcn_fence(__ATOMIC_ACQUIRE, "agent");
            xb_add(&bar[XB_XGEN(b.x)], 1u);
            asm volatile("s_waitcnt vmcnt(0)" ::: "memory");
        } else {
            XB_SPIN(xb_ld(&bar[XB_XGEN(b.x)]) == gen, bar);
            __builtin_amdgcn_fence(__ATOMIC_ACQUIRE, "agent");
            asm volatile("s_waitcnt vmcnt(0)" ::: "memory");
        }
    }
    __syncthreads();
}


struct Args { const float* in[19]; float* out; unsigned char* ws; int lo, hi; };
typedef const Args __attribute__((address_space(4))) KArgs;
struct Ctx {
    LAS unsigned char* lds;
    volatile LAS unsigned* MISC;
    unsigned* ctl;
    int tid, lane, wave, G, bid;
    int hot;
    KArgs* ka;
    float* out; unsigned char* ws;
    __device__ __forceinline__ const float* in(int i) const { return ka->in[i]; }
};
enum { I_X = 0, I_C, I_WIN, I_WA2, I_BA, I_GLAG, I_WOUT, I_WMOD, I_BMOD, I_LNG, I_LNB, I_FG, I_FU, I_FD, I_WR, I_BR, I_MG, I_MU, I_MD };

__device__ __forceinline__ f32x16 mfma32(bf16x8 a, bf16x8 b, f32x16 c) { return __builtin_amdgcn_mfma_f32_32x32x16_bf16(a, b, c, 0, 0, 0); }

__device__ __forceinline__ void ph_mod(Ctx& C) {
    LAS float* sc = (LAS float*)C.lds;
    LAS float* red = (LAS float*)(C.lds + 65536);
    const float* c = C.in(I_C);
    for (int i = C.tid; i < 16 * 1024; i += 512) sc[i] = silu_f(c[i]);
    __syncthreads();
    const float* wmod = C.in(I_WMOD); const float* bmod = C.in(I_BMOD);
    float* MOD = (float*)(C.ws + WS_MOD);
    for (int u = C.bid; u < 4 * 96; u += C.G) {
        const int l = u / 96, cc = u % 96, col = cc * 64 + C.lane;
        float acc[16];
#pragma unroll
        for (int b = 0; b < 16; ++b) acc[b] = 0.f;
        const float* wp = wmod + ((size_t)l * 1024 + C.wave * 128) * 6144 + col;
        const LAS float* sp = sc + C.wave * 128;
#pragma unroll 16
        for (int kk = 0; kk < 128; ++kk) {
            const float w = wp[(size_t)kk * 6144];
#pragma unroll
            for (int b = 0; b < 16; ++b) acc[b] += sp[b * 1024 + kk] * w;
        }
#pragma unroll
        for (int b = 0; b < 16; ++b) red[(C.wave * 16 + b) * 64 + C.lane] = acc[b];
        __syncthreads();
        for (int o = C.tid; o < 1024; o += 512) {
            const int b = o >> 6, ln = o & 63; float s = 0.f;
#pragma unroll
            for (int w = 0; w < 8; ++w) s += red[(w * 16 + b) * 64 + ln];
            const int cl = cc * 64 + ln;
            MOD[((size_t)l * 16 + b) * 6144 + cl] = s + bmod[l * 6144 + cl];
        }
        __syncthreads();
    }
}

__device__ __forceinline__ void conv_item(const float* colp, int ldn, int K, bf16* WT, LAS float* scr, int kb, int nb, int lane) {
    const int k0 = 64 * kb, n0 = 32 * nb;
    float tv[32];
#pragma unroll
    for (int i = 0; i < 32; ++i) { const int kk = 2 * i + (lane >> 5); tv[i] = colp ? colp[(size_t)(k0 + kk) * ldn] : 0.f; }
#pragma unroll
    for (int i = 0; i < 32; ++i) { const int kk = 2 * i + (lane >> 5); scr[kk * 33 + (lane & 31)] = tv[i]; }
    asm volatile("s_waitcnt lgkmcnt(0)" ::: "memory");
    const int c = lane & 7;
#pragma unroll
    for (int j = 0; j < 4; ++j) {
        const int n = (lane >> 3) + 8 * j; const LAS float* s = scr + (8 * c) * 33 + n;
        v4u o; o.x = pk2(s[0 * 33], s[1 * 33]); o.y = pk2(s[2 * 33], s[3 * 33]); o.z = pk2(s[4 * 33], s[5 * 33]); o.w = pk2(s[6 * 33], s[7 * 33]);
        *(v4u*)(WT + (size_t)(n0 + n) * K + k0 + 8 * c) = o;
    }
    asm volatile("s_waitcnt lgkmcnt(0)" ::: "memory");
}
__device__ __forceinline__ int win_src_col(int n) {
    if (n < C_IQ) return n;
    if (n < C_BQ) return 640 + (n - C_IQ);
    if (n < C_AK) return 1224 + (n - C_BQ);
    if (n < C_AV) return 512 + (n - C_AK);
    if (n < C_IK) return 576 + (n - C_AV);
    if (n < C_IW) return 1152 + (n - C_IK);
    if (n < C_BA) return 1216 + (n - C_IW);
    if (n < PROJ_SRC) return 2760 + (n - C_BA);
    return -1;
}
__device__ __forceinline__ void ph_conv(Ctx& C, int l) {
    LAS float* scr = (LAS float*)(C.lds + C.wave * 8448);
    const int gw = C.bid * 8 + C.wave, NGW = C.G * 8;
    const bool moe = (l & 1) != 0; const int j = l >> 1, ne = moe ? NEXP : 1;
    constexpr int I_IN = 16 * 88, I_OUT = 16 * 32, I_GU = 16 * 176, I_DN = 44 * 32;
    const int nitems = I_IN + I_OUT + ne * (I_GU + I_DN);
    bf16* WIN = (bf16*)(C.ws + WS_WIN); bf16* WOUT = (bf16*)(C.ws + WS_WOUT); bf16* WGU = (bf16*)(C.ws + WS_WGU); bf16* WDN = (bf16*)(C.ws + WS_WDN);
    for (int it = gw; it < nitems; it += NGW) {
        int r = it;
        if (r < I_IN) { const int kb = r / 88, nb = r % 88; const int sc_ = win_src_col(nb * 32 + (C.lane & 31));
            const float* W = C.in(I_WIN) + (size_t)l * 1024 * PROJ_SRC;
            conv_item(sc_ >= 0 ? W + sc_ : nullptr, PROJ_SRC, 1024, WIN, scr, kb, nb, C.lane); continue; }
        r -= I_IN;
        if (r < I_OUT) { const int kb = r / 32, nb = r % 32; const float* W = C.in(I_WOUT) + (size_t)l * 1024 * 1024;
            conv_item(W + nb * 32 + (C.lane & 31), 1024, 1024, WOUT, scr, kb, nb, C.lane); continue; }
        r -= I_OUT;
        const int e = r / (I_GU + I_DN); r -= e * (I_GU + I_DN);
        const size_t eoff = (size_t)(j * ne + e) * 1024 * DFF;
        if (r < I_GU) { const int kb = r / 176, nb = r % 176; const int n = nb * 32 + (C.lane & 31), T = n >> 8, jj = n & 255;
            const float* Wg = (moe ? C.in(I_MG) : C.in(I_FG)) + eoff; const float* Wu = (moe ? C.in(I_MU) : C.in(I_FU)) + eoff;
            const float* colp = (jj < 128) ? Wg + T * 128 + jj : Wu + T * 128 + (jj - 128);
            conv_item(colp, DFF, 1024, WGU + (size_t)e * 5632 * 1024, scr, kb, nb, C.lane); continue; }
        r -= I_GU;
        { const int kb = r / 32, nb = r % 32; const float* Wd = (moe ? C.in(I_MD) : C.in(I_FD)) + eoff;
          conv_item(Wd + nb * 32 + (C.lane & 31), 1024, DFF, WDN + (size_t)e * 1024 * DFF, scr, kb, nb, C.lane); }
    }
}

__device__ __forceinline__ void ph_modulate0(Ctx& C) {
    const int gw = C.bid * 8 + C.wave, NGW = C.G * 8;
    const float* MOD = (const float*)(C.ws + WS_MOD); bf16* H = (bf16*)(C.ws + WS_H); const float* x = C.in(I_X);
    for (int row = gw; row < MTOK; row += NGW) {
        const int b = row >> 12; const float* md = MOD + (size_t)b * 6144;
#pragma unroll
        for (int j = 0; j < 4; ++j) {
            const int col = 4 * C.lane + 256 * j;
            const f32x4 v = *(const f32x4*)(x + (size_t)row * DM + col), sh = *(const f32x4*)(md + col), sc = *(const f32x4*)(md + 1024 + col);
            v2u o; o.x = pk2(v.x * (1.f + sc.x) + sh.x, v.y * (1.f + sc.y) + sh.y); o.y = pk2(v.z * (1.f + sc.z) + sh.z, v.w * (1.f + sc.w) + sh.w);
            *(v2u*)(H + (size_t)row * DM + col) = o;
        }
    }
}

struct GUnit { int arow0; int orow0; int pn; size_t boff; };
template <int MODE, class Epi>
__device__ __forceinline__ void gemm_simple_unit(Ctx& C, const bf16* A, int lda, const int* rowmap, const bf16* Bt, int K, const GUnit& u, const Epi& E) {
    const int rs = C.wave & 3, ch = C.wave >> 2, n = C.lane & 31, h = C.lane >> 5;
    const int r0 = u.arow0 + rs * 64 + n;
    const int ra = rowmap ? rowmap[r0] : r0, rb = rowmap ? rowmap[r0 + 32] : r0 + 32;
    const bf16* a0p = A + (size_t)ra * lda + 8 * h; const bf16* a1p = A + (size_t)rb * lda + 8 * h;
#pragma unroll 1
    for (int sp = 0; sp < 2; ++sp) {
        int br0, br1;
        if (MODE == 1) { const int jj = 2 * ch + sp; br0 = u.pn * 256 + 32 * jj; br1 = br0 + 128; }
        else { br0 = u.pn * 256 + 128 * ch + 64 * sp; br1 = br0 + 32; }
        const bf16* b0p = Bt + u.boff + (size_t)(br0 + n) * K + 8 * h; const bf16* b1p = Bt + u.boff + (size_t)(br1 + n) * K + 8 * h;
        f32x16 c00, c01, c10, c11;
#pragma unroll
        for (int i = 0; i < 16; ++i) { c00[i] = 0.f; c01[i] = 0.f; c10[i] = 0.f; c11[i] = 0.f; }
#pragma unroll 4
        for (int k = 0; k < K; k += 16) {
            const bf16x8 a0 = *(const bf16x8*)(a0p + k), a1 = *(const bf16x8*)(a1p + k), b0 = *(const bf16x8*)(b0p + k), b1 = *(const bf16x8*)(b1p + k);
            c00 = mfma32(a0, b0, c00); c01 = mfma32(a0, b1, c01); c10 = mfma32(a1, b0, c10); c11 = mfma32(a1, b1, c11);
        }
        const int orow = u.orow0 + rs * 64 + 4 * h;
        E(c00, c01, orow, br0, br1, n, u);
        E(c10, c11, orow + 32, br0, br1, n, u);
    }
}
struct EpiStoreS {
    bf16* O; int ldc;
    __device__ __forceinline__ void operator()(const f32x16& c0, const f32x16& c1, int orow, int br0, int br1, int n, const GUnit&) const {
#pragma unroll
        for (int r = 0; r < 16; ++r) { const size_t row = (size_t)(orow + (r & 3) + 8 * (r >> 2));
            O[row * ldc + br0 + n] = (bf16)f2bf(c0[r]); O[row * ldc + br1 + n] = (bf16)f2bf(c1[r]); }
    }
};
struct EpiSwigluS {
    bf16* O;
    __device__ __forceinline__ void operator()(const f32x16& c0, const f32x16& c1, int orow, int br0, int br1, int n, const GUnit& u) const {
        const int col = 128 * u.pn + (br0 - 256 * u.pn) + n;
#pragma unroll
        for (int r = 0; r < 16; ++r) { const size_t row = (size_t)(orow + (r & 3) + 8 * (r >> 2));
            O[row * DFF + col] = (bf16)f2bf(silu_f(c0[r]) * c1[r]); }
    }
};
struct EpiGateS {
    bf16* O; const float* gate;
    __device__ __forceinline__ void operator()(const f32x16& c0, const f32x16& c1, int orow, int br0, int br1, int n, const GUnit&) const {
#pragma unroll
        for (int r = 0; r < 16; ++r) { const size_t row = (size_t)(orow + (r & 3) + 8 * (r >> 2)); const float g = gate[row];
            O[row * DM + br0 + n] = (bf16)f2bf(c0[r] * g); O[row * DM + br1 + n] = (bf16)f2bf(c1[r] * g); }
    }
};

__device__ __forceinline__ void ph_gla_unit(Ctx& C, int l, int b, int hh) {
    LAS float* q_s = (LAS float*)C.lds;
    LAS float* k_s = q_s + 4096;
    LAS float* a_s = k_s + 4096;
    LAS float* v_s = a_s + 4096;
    LAS float* o_s = v_s + 8192;
    const bf16* PROJ = (const bf16*)(C.ws + WS_P); bf16* YM = (bf16*)(C.ws + WS_H);
    const float* w_a2 = C.in(I_WA2) + (size_t)l * 16 * 256; const float* b_a = C.in(I_BA) + l * 256; const float* gg = C.in(I_GLAG) + l * 128;
    const int e = C.tid >> 2, dg = C.tid & 3;
    float S[16];
#pragma unroll
    for (int i = 0; i < 16; ++i) S[i] = 0.f;
    for (int c = 0; c < 64; ++c) {
        const size_t row0 = (size_t)b * SEQ + c * 64;
        {
            const int t = C.tid >> 3, d0 = (C.tid & 7) * 8; const bf16* pr = PROJ + (row0 + t) * PW;
            const v4u qv = *(const v4u*)(pr + C_BQ + hh * 64 + d0), kv = *(const v4u*)(pr + C_BK + hh * 64 + d0);
            const v4u ba0 = *(const v4u*)(pr + C_BA), ba1 = *(const v4u*)(pr + C_BA + 8);
            float baf[16];
            baf[0] = bf2f(ba0.x & 0xffffu); baf[1] = bf2f(ba0.x >> 16); baf[2] = bf2f(ba0.y & 0xffffu); baf[3] = bf2f(ba0.y >> 16);
            baf[4] = bf2f(ba0.z & 0xffffu); baf[5] = bf2f(ba0.z >> 16); baf[6] = bf2f(ba0.w & 0xffffu); baf[7] = bf2f(ba0.w >> 16);
            baf[8] = bf2f(ba1.x & 0xffffu); baf[9] = bf2f(ba1.x >> 16); baf[10] = bf2f(ba1.y & 0xffffu); baf[11] = bf2f(ba1.y >> 16);
            baf[12] = bf2f(ba1.z & 0xffffu); baf[13] = bf2f(ba1.z >> 16); baf[14] = bf2f(ba1.w & 0xffffu); baf[15] = bf2f(ba1.w >> 16);
            const unsigned qw[4] = {qv.x, qv.y, qv.z, qv.w}, kw[4] = {kv.x, kv.y, kv.z, kv.w};
#pragma unroll
            for (int i = 0; i < 8; ++i) {
                const int d = d0 + i; float z = b_a[hh * 64 + d];
#pragma unroll
                for (int r = 0; r < 16; ++r) z += baf[r] * w_a2[r * 256 + hh * 64 + d];
                const float ls = fminf(z, 0.f) - log1pf(expf(-fabsf(z)));
                a_s[t * 64 + d] = expf(ls * (1.f / 16.f));
                const unsigned qq = (i & 1) ? (qw[i >> 1] >> 16) : (qw[i >> 1] & 0xffffu), kk = (i & 1) ? (kw[i >> 1] >> 16) : (kw[i >> 1] & 0xffffu);
                q_s[t * 64 + d] = bf2f(qq) * 0.125f; k_s[t * 64 + d] = bf2f(kk);
            }
            const int e0 = (C.tid & 7) * 16;
            const v4u v0 = *(const v4u*)(pr + C_BV + hh * 128 + e0), v1 = *(const v4u*)(pr + C_BV + hh * 128 + e0 + 8);
            const unsigned vw[8] = {v0.x, v0.y, v0.z, v0.w, v1.x, v1.y, v1.z, v1.w};
#pragma unroll
            for (int i = 0; i < 8; ++i) { v_s[t * 128 + e0 + 2 * i] = bf2f(vw[i] & 0xffffu); v_s[t * 128 + e0 + 2 * i + 1] = bf2f(vw[i] >> 16); }
        }
        __syncthreads();
        for (int tt = 0; tt < 64; ++tt) {
            const float vv = v_s[tt * 128 + e]; float po = 0.f;
#pragma unroll
            for (int i = 0; i < 16; ++i) { const int d = 16 * dg + i; S[i] = a_s[tt * 64 + d] * S[i] + k_s[tt * 64 + d] * vv; po += q_s[tt * 64 + d] * S[i]; }
            po += __shfl_xor(po, 1); po += __shfl_xor(po, 2);
            if (dg == 0) o_s[tt * 128 + e] = po;
        }
        __syncthreads();
#pragma unroll 1
        for (int r = 0; r < 8; ++r) {
            const int tt = C.wave * 8 + r; const float o0 = o_s[tt * 128 + C.lane], o1 = o_s[tt * 128 + 64 + C.lane];
            const float ss = wave_sum(o0 * o0 + o1 * o1); const float rstd = rsqrtf(ss * (1.f / 128.f) + LN_EPS);
            const bf16* pr = PROJ + (row0 + tt) * PW + C_BG + hh * 128; const float g0 = bf2f(pr[C.lane]), g1 = bf2f(pr[64 + C.lane]);
            bf16* yo = YM + (row0 + tt) * DM + 512 + hh * 128;
            yo[C.lane] = (bf16)f2bf(o0 * rstd * gg[C.lane] * silu_f(g0)); yo[64 + C.lane] = (bf16)f2bf(o1 * rstd * gg[64 + C.lane] * silu_f(g1));
        }
        __syncthreads();
    }
}

__device__ __forceinline__ unsigned sortable_u32(float f) { const unsigned u = __float_as_uint(f + 0.0f); return (u & 0x80000000u) ? ~u : (u | 0x80000000u); }
__device__ __forceinline__ void ph_dsa_a_unit(Ctx& C, int b, int t0) {
    LAS unsigned* sc = (LAS unsigned*)C.lds;
    LAS unsigned* cnt = (LAS unsigned*)(C.lds + 131072);
    const bf16* PROJ = (const bf16*)(C.ws + WS_P); unsigned* SEL = (unsigned*)(C.ws + WS_SEL);
    const int lane = C.lane, n = lane & 31, h = lane >> 5, tid = C.tid;
    const int nk = t0 + 8, ntile = (nk + 31) >> 5, nscan = ntile * 32;
    if (tid < 48) cnt[tid] = 0u;
    {
        bf16x8 af[2][4]; float wv[2][4][4];
#pragma unroll
        for (int mt = 0; mt < 2; ++mt) {
            const bf16* p = PROJ + (size_t)(b * SEQ + t0 + 4 * mt + (n >> 3)) * PW + C_IQ + (n & 7) * 64 + 8 * h;
#pragma unroll
            for (int ks = 0; ks < 4; ++ks) af[mt][ks] = *(const bf16x8*)(p + ks * 16);
#pragma unroll
            for (int jq = 0; jq < 4; ++jq)
#pragma unroll
                for (int i = 0; i < 4; ++i) wv[mt][jq][i] = bf2f(PROJ[(size_t)(b * SEQ + t0 + 4 * mt + jq) * PW + C_IW + i + 4 * h]) * (0.35355339059327373f * 0.125f);
        }
        for (int tile = C.wave; tile < ntile; tile += 8) {
            const int s = tile * 32 + n; const bf16* kp = PROJ + (size_t)(b * SEQ + s) * PW + C_IK + 8 * h;
            bf16x8 bfr[4];
#pragma unroll
            for (int ks = 0; ks < 4; ++ks) bfr[ks] = *(const bf16x8*)(kp + ks * 16);
#pragma unroll
            for (int mt = 0; mt < 2; ++mt) {
                f32x16 acc;
#pragma unroll
                for (int i = 0; i < 16; ++i) acc[i] = 0.f;
#pragma unroll
                for (int ks = 0; ks < 4; ++ks) acc = mfma32(af[mt][ks], bfr[ks], acc);
#pragma unroll
                for (int jq = 0; jq < 4; ++jq) {
                    float p = 0.f;
#pragma unroll
                    for (int i = 0; i < 4; ++i) p += wv[mt][jq][i] * fmaxf(acc[4 * jq + i], 0.f);
                    p += __shfl_xor(p, 32);
                    const int t = t0 + 4 * mt + jq; const unsigned u = (s <= t) ? sortable_u32(p) : 0u;
                    if (h == mt) sc[(4 * mt + jq) * 4096 + s] = u;
                }
            }
        }
    }
    __syncthreads();
    unsigned u[8][8];
#pragma unroll
    for (int i = 0; i < 8; ++i) {
        const int s = tid + 512 * i; const bool inr = s < nscan; const int sidx = inr ? s : 0;
#pragma unroll
        for (int q = 0; q < 8; ++q) { const unsigned v = sc[q * 4096 + sidx]; u[i][q] = inr ? v : 0u; }
    }
    unsigned T[8], J[8], need[8];
#pragma unroll
    for (int q = 0; q < 8; ++q) { T[q] = 0u; J[q] = 8192u; need[q] = 0u; }
    int buf = 0;
    for (int bit = 31; bit >= 0; --bit) {
        unsigned cq[8];
#pragma unroll
        for (int q = 0; q < 8; ++q) cq[q] = 0u;
#pragma unroll
        for (int i = 0; i < 8; ++i) if (512 * i < nscan) {
#pragma unroll
            for (int q = 0; q < 8; ++q) cq[q] += (unsigned)__popcll(__ballot(u[i][q] >= (T[q] | (1u << bit))));
        }
        unsigned myc = 0u;
#pragma unroll
        for (int q = 0; q < 8; ++q) myc = (lane == q) ? cq[q] : myc;
        if (lane < 8) __hip_atomic_fetch_add(cnt + buf * 16 + lane, myc, __ATOMIC_RELAXED, __HIP_MEMORY_SCOPE_WORKGROUP);
        const int nb = (buf == 2) ? 0 : buf + 1;
        if (tid >= 64 && tid < 80) cnt[nb * 16 + (tid - 64)] = 0u;
        __syncthreads();
#pragma unroll
        for (int q = 0; q < 8; ++q) if (cnt[buf * 16 + q] >= 256u) T[q] |= (1u << bit);
        buf = nb;
    }
#pragma unroll
    for (int q = 0; q < 8; ++q) T[q] = T[q] < 1u ? 1u : T[q];
    bool extra = false;
    {
        unsigned cg[8], ce[8];
#pragma unroll
        for (int q = 0; q < 8; ++q) { cg[q] = 0u; ce[q] = 0u; }
#pragma unroll
        for (int i = 0; i < 8; ++i) if (512 * i < nscan) {
#pragma unroll
            for (int q = 0; q < 8; ++q) { cg[q] += (unsigned)__popcll(__ballot(u[i][q] > T[q])); ce[q] += (unsigned)__popcll(__ballot(u[i][q] >= T[q])); }
        }
        unsigned myc = 0u;
#pragma unroll
        for (int q = 0; q < 8; ++q) { myc = (lane == q) ? cg[q] : myc; myc = (lane == 8 + q) ? ce[q] : myc; }
        if (lane < 16) __hip_atomic_fetch_add(cnt + buf * 16 + lane, myc, __ATOMIC_RELAXED, __HIP_MEMORY_SCOPE_WORKGROUP);
        const int nb = (buf == 2) ? 0 : buf + 1;
        if (tid >= 64 && tid < 80) cnt[nb * 16 + (tid - 64)] = 0u;
        __syncthreads();
#pragma unroll
        for (int q = 0; q < 8; ++q) { const unsigned g = cnt[buf * 16 + q], ge = cnt[buf * 16 + 8 + q]; need[q] = 256u - (g < 256u ? g : 256u); extra = extra || (ge > 256u); }
        buf = nb;
    }
    if (extra) {
#pragma unroll
        for (int q = 0; q < 8; ++q) J[q] = 0u;
        for (int bit = 12; bit >= 0; --bit) {
            unsigned cq[8];
#pragma unroll
            for (int q = 0; q < 8; ++q) cq[q] = 0u;
#pragma unroll
            for (int i = 0; i < 8; ++i) if (512 * i < nscan) {
                const unsigned s = (unsigned)(tid + 512 * i);
#pragma unroll
                for (int q = 0; q < 8; ++q) cq[q] += (unsigned)__popcll(__ballot(u[i][q] == T[q] && s < (J[q] | (1u << bit))));
            }
            unsigned myc = 0u;
#pragma unroll
            for (int q = 0; q < 8; ++q) myc = (lane == q) ? cq[q] : myc;
            if (lane < 8) __hip_atomic_fetch_add(cnt + buf * 16 + lane, myc, __ATOMIC_RELAXED, __HIP_MEMORY_SCOPE_WORKGROUP);
            const int nb = (buf == 2) ? 0 : buf + 1;
            if (tid >= 64 && tid < 80) cnt[nb * 16 + (tid - 64)] = 0u;
            __syncthreads();
#pragma unroll
            for (int q = 0; q < 8; ++q) if (cnt[buf * 16 + q] <= need[q]) J[q] |= (1u << bit);
            buf = nb;
        }
    }
#pragma unroll
    for (int i = 0; i < 8; ++i) if (512 * i < nscan) {
        const unsigned s = (unsigned)(tid + 512 * i); const int tile0 = 2 * C.wave + 16 * i;
#pragma unroll
        for (int q = 0; q < 8; ++q) {
            const unsigned long long bm = __ballot((u[i][q] > T[q]) || (u[i][q] == T[q] && s < J[q]));
            if (lane == 0) { unsigned* w = SEL + (size_t)(b * SEQ + t0 + q) * 128 + tile0;
                if (tile0 < ntile) w[0] = (unsigned)bm; if (tile0 + 1 < ntile) w[1] = (unsigned)(bm >> 32); }
        }
    }
    __syncthreads();
}

__device__ __forceinline__ void ph_dsa_b_unit(Ctx& C, int b, int t0) {
    LAS float* qs = (LAS float*)C.lds + C.wave * 512;
    LAS int* lst = (LAS int*)(C.lds + 16384) + C.wave * 256;
    LAS float* pl = (LAS float*)(C.lds + 16384 + 8192) + C.wave * 2048;
    const bf16* PROJ = (const bf16*)(C.ws + WS_P); const unsigned* SEL = (const unsigned*)(C.ws + WS_SEL); bf16* YM = (bf16*)(C.ws + WS_H);
    const int lane = C.lane, t = t0 + C.wave; const size_t row = (size_t)b * SEQ + t;
    const int ntile = (t >> 5) + 1;
    int base = 0;
#pragma unroll 1
    for (int rd = 0; rd < 2; ++rd) {
        const int wi = rd * 64 + lane; unsigned w = (wi < ntile) ? SEL[row * 128 + wi] : 0u;
        const int c = __popc(w); int incl = c;
#pragma unroll
        for (int o = 1; o < 64; o <<= 1) { const int v = __shfl_up(incl, o); if (lane >= o) incl += v; }
        int pos = base + incl - c;
        while (w) { const int bit = __ffs(w) - 1; w &= w - 1; if (pos < 256) lst[pos] = wi * 32 + bit; ++pos; }
        base += __shfl(incl, 63);
    }
    const int nsel = base < 256 ? base : 256;
    {
        const v4u qv = *(const v4u*)(PROJ + row * PW + C_AQ + lane * 8); const unsigned qw[4] = {qv.x, qv.y, qv.z, qv.w};
#pragma unroll
        for (int i = 0; i < 4; ++i) { qs[lane * 8 + 2 * i] = bf2f(qw[i] & 0xffffu) * (0.125f * LOG2E); qs[lane * 8 + 2 * i + 1] = bf2f(qw[i] >> 16) * (0.125f * LOG2E); }
    }
    asm volatile("s_waitcnt lgkmcnt(0)" ::: "memory");
    float mx[8];
#pragma unroll
    for (int hd = 0; hd < 8; ++hd) mx[hd] = -3.0e38f;
#pragma unroll 1
    for (int i = 0; i < 4; ++i) {
        const int j = lane + 64 * i;
        asm volatile("" ::: "memory");
        if (j < nsel) {
            const int s = lst[j];
            const bf16* kp = PROJ + ((size_t)b * SEQ + s) * PW + C_AK;
            float kr[64];
#pragma unroll
            for (int c8 = 0; c8 < 8; ++c8) { const v4u kv = *(const v4u*)(kp + 8 * c8); const unsigned kw[4] = {kv.x, kv.y, kv.z, kv.w};
#pragma unroll
                for (int x = 0; x < 4; ++x) { kr[8 * c8 + 2 * x] = bf2f(kw[x] & 0xffffu); kr[8 * c8 + 2 * x + 1] = bf2f(kw[x] >> 16); } }
#pragma unroll
            for (int hd = 0; hd < 8; ++hd) {
                float d = 0.f;
#pragma unroll
                for (int x = 0; x < 64; ++x) d += qs[hd * 64 + x] * kr[x];
                const float slope2 = exp2f(-(float)(hd + 1)) * LOG2E;
                const float lgv = d - slope2 * (float)(t - s);
                pl[j * 8 + hd] = lgv; mx[hd] = fmaxf(mx[hd], lgv);
            }
        }
    }
#pragma unroll
    for (int hd = 0; hd < 8; ++hd) mx[hd] = wave_max(mx[hd]);
    asm volatile("s_waitcnt lgkmcnt(0)" ::: "memory");
    float sm[8];
#pragma unroll
    for (int hd = 0; hd < 8; ++hd) sm[hd] = 0.f;
#pragma unroll 1
    for (int i = 0; i < 4; ++i) {
        const int j = lane + 64 * i;
        if (j < nsel) {
#pragma unroll
            for (int hd = 0; hd < 8; ++hd) { const float p = exp2f(pl[j * 8 + hd] - mx[hd]); pl[j * 8 + hd] = p; sm[hd] += p; }
        }
    }
#pragma unroll
    for (int hd = 0; hd < 8; ++hd) sm[hd] = 1.f / wave_sum(sm[hd]);
    asm volatile("s_waitcnt lgkmcnt(0)" ::: "memory");
    float acc[8];
#pragma unroll
    for (int hd = 0; hd < 8; ++hd) acc[hd] = 0.f;
    const bf16* vb = PROJ + (size_t)b * SEQ * PW + C_AV + lane;
#pragma unroll 4
    for (int j = 0; j < nsel; ++j) {
        const int s = lst[j]; const float v = bf2f(vb[(size_t)s * PW]);
        const f32x4 p0 = *(const LAS f32x4*)(pl + j * 8), p1 = *(const LAS f32x4*)(pl + j * 8 + 4);
        acc[0] += p0.x * v; acc[1] += p0.y * v; acc[2] += p0.z * v; acc[3] += p0.w * v; acc[4] += p1.x * v; acc[5] += p1.y * v; acc[6] += p1.z * v; acc[7] += p1.w * v;
    }
#pragma unroll
    for (int hd = 0; hd < 8; ++hd) acc[hd] *= sm[hd];
#pragma unroll
    for (int hd = 0; hd < 8; ++hd) YM[row * DM + hd * 64 + lane] = (bf16)f2bf(acc[hd]);
}

struct LnRaw { f32x4 x[4]; v2u ya[4]; v2u yb[4]; v2u hx[4]; };
template <bool ROUTE, int YMODE, int XMODE>
__device__ __forceinline__ void ph_ln(Ctx& C, const float* Xin, int l, int which, int mod_g, int mod_l2, int mod_sh, bool write_h, int jmoe, int mod_in, bool write_x) {
    const int gw = C.bid * 8 + C.wave, NGW = C.G * 8, lane = C.lane;
    const float* MOD = (const float*)(C.ws + WS_MOD); bf16* H = (bf16*)(C.ws + WS_H); const bf16* Y = (const bf16*)(C.ws + WS_Y);
    const float* lng = C.in(I_LNG) + (size_t)(l * 2 + which) * DM; const float* lnb = C.in(I_LNB) + (size_t)(l * 2 + which) * DM;
    const int* TOKSLOT = (const int*)(C.ws + WS_TOKSLOT);
    const float* wr = C.in(I_WR) + (size_t)jmoe * DM * NEXP; const float* br = C.in(I_BR) + jmoe * NEXP;
    int* TOPE = (int*)(C.ws + WS_TOPE); float* TOPG = (float*)(C.ws + WS_TOPG);
    unsigned ecnt[8];
#pragma unroll
    for (int e = 0; e < 8; ++e) ecnt[e] = 0u;
    LAS float* wrs = (LAS float*)C.lds;
    if (ROUTE) { for (int i = C.tid; i < DM * NEXP / 4; i += 512) ((LAS f32x4*)wrs)[i] = ((const f32x4*)wr)[i]; __syncthreads(); }
    const int RPW = (MTOK + NGW - 1) / NGW;
    const int r0 = gw * RPW, r1 = (r0 + RPW < MTOK) ? r0 + RPW : MTOK;
    if (r0 < MTOK) {
        const int b = r0 >> 12;
        const bool one_batch = ((r1 - 1) >> 12) == b;
        const float* mg = MOD + ((size_t)l * 16 + b) * 6144 + mod_g;
        const float* mi = MOD + ((size_t)l * 16 + b) * 6144 + mod_in;
        const float* ms = MOD + ((size_t)mod_l2 * 16 + b) * 6144 + mod_sh;
        f32x4 gv[4], shi[4], sci[4];
#pragma unroll
        for (int j = 0; j < 4; ++j) { const int col = 4 * lane + 256 * j; gv[j] = *(const f32x4*)(mg + col);
            if (XMODE == 1) { shi[j] = *(const f32x4*)(mi + col); const f32x4 sc_ = *(const f32x4*)(mi + 1024 + col); sci[j].x = 1.f / (sc_.x + 1.f); sci[j].y = 1.f / (sc_.y + 1.f); sci[j].z = 1.f / (sc_.z + 1.f); sci[j].w = 1.f / (sc_.w + 1.f); } }
        f32x4 Av[4], Bv[4];
#pragma unroll
        for (int j = 0; j < 4; ++j) { const int col = 4 * lane + 256 * j; const f32x4 gn = *(const f32x4*)(lng + col), bn = *(const f32x4*)(lnb + col);
            if (write_h) { const f32x4 sh = *(const f32x4*)(ms + col), sc = *(const f32x4*)(ms + 1024 + col); Av[j] = gn * (sc + 1.f); Bv[j] = bn * (sc + 1.f) + sh; } else { Av[j] = gn; Bv[j] = bn; } }
        int sl0 = 0, sl1 = 0;
        if (YMODE == 1 && r0 + lane < r1) { sl0 = TOKSLOT[2 * (r0 + lane)]; sl1 = TOKSLOT[2 * (r0 + lane) + 1]; }
#define LN_LOAD(R, row_) { const int s0_ = (YMODE == 1) ? (((row_) - r0 < 64) ? __builtin_amdgcn_readlane(sl0, (row_) - r0) : TOKSLOT[2 * (row_)]) : 0, s1_ = (YMODE == 1) ? (((row_) - r0 < 64) ? __builtin_amdgcn_readlane(sl1, (row_) - r0) : TOKSLOT[2 * (row_) + 1]) : 0; \
        const bf16* y0_ = (YMODE == 0) ? Y + (size_t)(row_) * DM : Y + (size_t)s0_ * DM; const bf16* y1_ = Y + (size_t)s1_ * DM; \
        _Pragma("unroll") for (int j = 0; j < 4; ++j) { const int col = 4 * lane + 256 * j; \
            if (XMODE == 0) R.x[j] = *(const f32x4*)(Xin + (size_t)(row_) * DM + col); else R.hx[j] = *(const v2u*)(H + (size_t)(row_) * DM + col); \
            R.ya[j] = *(const v2u*)(y0_ + col); if (YMODE == 1) R.yb[j] = *(const v2u*)(y1_ + col); } }
        LnRaw cur, nx1, nx2;
        LN_LOAD(cur, r0)
        if (r0 + 1 < r1) LN_LOAD(nx1, r0 + 1)
        for (int row = r0; row < r1; ++row) {
            if (ROUTE) asm volatile("" ::: "memory");
            if (row + 2 < r1) LN_LOAD(nx2, row + 2)
            if (!one_batch) {
                const int bb = row >> 12; const float* mg2 = MOD + ((size_t)l * 16 + bb) * 6144 + mod_g; const float* mi2 = MOD + ((size_t)l * 16 + bb) * 6144 + mod_in;
#pragma unroll
                for (int j = 0; j < 4; ++j) { const int col = 4 * lane + 256 * j; gv[j] = *(const f32x4*)(mg2 + col);
                    if (XMODE == 1) { shi[j] = *(const f32x4*)(mi2 + col); const f32x4 sc_ = *(const f32x4*)(mi2 + 1024 + col); sci[j].x = 1.f / (sc_.x + 1.f); sci[j].y = 1.f / (sc_.y + 1.f); sci[j].z = 1.f / (sc_.z + 1.f); sci[j].w = 1.f / (sc_.w + 1.f); } }
            }
            if (!one_batch) {
                const float* msr = MOD + ((size_t)mod_l2 * 16 + (row >> 12)) * 6144 + mod_sh;
#pragma unroll
                for (int j = 0; j < 4; ++j) { const int col = 4 * lane + 256 * j; const f32x4 gn = *(const f32x4*)(lng + col), bn = *(const f32x4*)(lnb + col);
                    if (write_h) { const f32x4 sh = *(const f32x4*)(msr + col), sc = *(const f32x4*)(msr + 1024 + col); Av[j] = gn * (sc + 1.f); Bv[j] = bn * (sc + 1.f) + sh; } else { Av[j] = gn; Bv[j] = bn; } }
            }
            f32x4 v[4]; float s = 0.f;
#pragma unroll
            for (int j = 0; j < 4; ++j) {
                const v2u ya = cur.ya[j];
                f32x4 y; y.x = bf2f(ya.x & 0xffffu); y.y = bf2f(ya.x >> 16); y.z = bf2f(ya.y & 0xffffu); y.w = bf2f(ya.y >> 16);
                if (YMODE == 1) { const v2u yb = cur.yb[j]; y.x += bf2f(yb.x & 0xffffu); y.y += bf2f(yb.x >> 16); y.z += bf2f(yb.y & 0xffffu); y.w += bf2f(yb.y >> 16); }
                f32x4 xr;
                if (XMODE == 0) xr = cur.x[j];
                else { const v2u hh_ = cur.hx[j]; f32x4 hf; hf.x = bf2f(hh_.x & 0xffffu); hf.y = bf2f(hh_.x >> 16); hf.z = bf2f(hh_.y & 0xffffu); hf.w = bf2f(hh_.y >> 16);
                       xr = (hf - shi[j]) * sci[j]; }
                v[j] = xr * DN_ALPHA + (gv[j] + 1.f) * y;
                s += (v[j].x + v[j].y) + (v[j].z + v[j].w);
            }
            const float mean = wave_sum_f(s) * (1.f / DM); float s2 = 0.f;
#pragma unroll
            for (int j = 0; j < 4; ++j) { v[j] = v[j] - mean; s2 += (v[j].x * v[j].x + v[j].y * v[j].y) + (v[j].z * v[j].z + v[j].w * v[j].w); }
            const float rstd = rsqrtf(wave_sum_f(s2) * (1.f / DM) + LN_EPS);
            float lgt[8];
#pragma unroll
            for (int e = 0; e < 8; ++e) lgt[e] = 0.f;
#pragma unroll
            for (int j = 0; j < 4; ++j) {
                const int col = 4 * lane + 256 * j;
                const f32x4 hv = v[j] * rstd * Av[j] + Bv[j];
                if (write_x) *(f32x4*)(C.out + (size_t)row * DM + col) = hv;
                if (write_h) {
                    v2u o; o.x = pk2(hv.x, hv.y); o.y = pk2(hv.z, hv.w);
                    *(v2u*)(H + (size_t)row * DM + col) = o;
                    if (ROUTE) {
                        const float hx[4] = {hv.x, hv.y, hv.z, hv.w};
#pragma unroll
                        for (int c = 0; c < 4; ++c) { const f32x4 w0 = *(const LAS f32x4*)(wrs + (col + c) * NEXP), w1 = *(const LAS f32x4*)(wrs + (col + c) * NEXP + 4);
                            lgt[0] += hx[c] * w0.x; lgt[1] += hx[c] * w0.y; lgt[2] += hx[c] * w0.z; lgt[3] += hx[c] * w0.w;
                            lgt[4] += hx[c] * w1.x; lgt[5] += hx[c] * w1.y; lgt[6] += hx[c] * w1.z; lgt[7] += hx[c] * w1.w; }
                    }
                }
            }
            if (ROUTE) {
#pragma unroll
                for (int e = 0; e < 8; ++e) lgt[e] = wave_sum_f(lgt[e]) + br[e];
                int e0 = 0; float v0 = lgt[0];
#pragma unroll
                for (int e = 1; e < 8; ++e) if (lgt[e] > v0) { v0 = lgt[e]; e0 = e; }
                int e1 = -1; float v1 = -3.0e38f;
#pragma unroll
                for (int e = 0; e < 8; ++e) if (e != e0 && lgt[e] > v1) { v1 = lgt[e]; e1 = e; }
                const float g1 = 1.f / (1.f + expf(v0 - v1)), g0 = 1.f - g1;
                if (lane == 0) { TOPE[2 * row] = e0; TOPE[2 * row + 1] = e1; TOPG[2 * row] = g0; TOPG[2 * row + 1] = g1; }
#pragma unroll
                for (int e = 0; e < 8; ++e) ecnt[e] += (e == e0 ? 1u : 0u) + (e == e1 ? 1u : 0u);
            }
            cur = nx1; nx1 = nx2;
        }
#undef LN_LOAD
    }
    if (ROUTE) {
        unsigned mine = 0u;
#pragma unroll
        for (int e = 0; e < 8; ++e) mine = (lane == e) ? ecnt[e] : mine;
        if (lane < 8 && mine) __hip_atomic_fetch_add(C.ctl + CW_CNT + 64 * jmoe + lane, mine, __ATOMIC_RELAXED, __HIP_MEMORY_SCOPE_AGENT);
    }
}

struct MoeTab { int pend[8]; int npanels; };
__device__ __forceinline__ MoeTab moe_tab(Ctx& C, int jmoe) {
    MoeTab t; int acc = 0;
#pragma unroll
    for (int e = 0; e < 8; ++e) { const int c = (int)__hip_atomic_load(C.ctl + CW_CNT + 64 * jmoe + e, __ATOMIC_RELAXED, __HIP_MEMORY_SCOPE_AGENT); acc += (c + 255) & ~255; t.pend[e] = acc; }
    t.npanels = acc >> 8; return t;
}
__device__ __forceinline__ int panel_expert(const MoeTab& t, int p) {
    int e = 0;
#pragma unroll
    for (int k = 0; k < 7; ++k) e += (p * 256 >= t.pend[k]) ? 1 : 0;
    return e;
}
__device__ __forceinline__ void ph_assign(Ctx& C, int jmoe) {
    const int gw = C.bid * 8 + C.wave, NGW = C.G * 8, lane = C.lane;
    const MoeTab tb = moe_tab(C, jmoe);
    const int* TOPE = (const int*)(C.ws + WS_TOPE); const float* TOPG = (const float*)(C.ws + WS_TOPG);
    int* TOKSLOT = (int*)(C.ws + WS_TOKSLOT); int* ROWTOK = (int*)(C.ws + WS_ROWTOK); float* ROWGATE = (float*)(C.ws + WS_ROWGATE);
    const bf16* H = (const bf16*)(C.ws + WS_H); bf16* HS = (bf16*)(C.ws + WS_Y);
    const unsigned long long ltmask = (lane == 0) ? 0ull : (~0ull >> (64 - lane));
    for (int tk0 = gw * 32; tk0 < MTOK; tk0 += NGW * 32) {
        const int tok = tk0 + (lane & 31); const bool act = lane < 32;
        const int e0 = act ? TOPE[2 * tok] : -1, e1 = act ? TOPE[2 * tok + 1] : -1; const float g0 = TOPG[2 * tok], g1 = TOPG[2 * tok + 1];
        int s0 = 0, s1 = 0;
#pragma unroll
        for (int e = 0; e < 8; ++e) {
            const unsigned long long m0 = __ballot(e0 == e), m1 = __ballot(e1 == e); const int n0 = __popcll(m0), n1 = __popcll(m1);
            int basev = 0;
            if (lane == 0 && (n0 + n1) > 0) basev = (int)__hip_atomic_fetch_add(C.ctl + CW_FILL + 64 * jmoe + e, (unsigned)(n0 + n1), __ATOMIC_RELAXED, __HIP_MEMORY_SCOPE_AGENT);
            basev = __builtin_amdgcn_readfirstlane(basev);
            const int pstart = (e == 0) ? 0 : tb.pend[e > 0 ? e - 1 : 0];
            if (e0 == e) s0 = pstart + basev + __popcll(m0 & ltmask);
            if (e1 == e) s1 = pstart + basev + n0 + __popcll(m1 & ltmask);
        }
        if (act) { TOKSLOT[2 * tok] = s0; TOKSLOT[2 * tok + 1] = s1;
            ROWTOK[s0] = tok; ROWGATE[s0] = g0; ROWTOK[s1] = tok; ROWGATE[s1] = g1; }
    }
    for (int idx = gw; idx < 8 * 256; idx += NGW) {
        const int e = idx >> 8, jj = idx & 255;
        const int c = (int)__hip_atomic_load(C.ctl + CW_CNT + 64 * jmoe + e, __ATOMIC_RELAXED, __HIP_MEMORY_SCOPE_AGENT);
        int pstart = 0;
#pragma unroll
        for (int k = 0; k < 7; ++k) if (k < e) pstart = tb.pend[k];
        const int slot = pstart + c + jj;
        if (c + jj < ((c + 255) & ~255)) {
            if (lane == 0) { ROWTOK[slot] = 0; ROWGATE[slot] = 0.f; }
        }
    }
}

__device__ __forceinline__ float silu_fast_(float v) { return v * __builtin_amdgcn_rcpf(1.f + __builtin_amdgcn_exp2f(-v * LOG2E)); }
constexpr size_t WS_GLA_LT = WS_Y;
constexpr size_t WS_GLA_SP = WS_Y + 130 * MiB;
constexpr size_t WS_GLA_EB = WS_Y + 128 * MiB;
constexpr int GLA_PITCH = 72;

struct GlaDecay { float b[8]; float Btot; float qv[8]; float kv[8]; };
__device__ __forceinline__ void gla_decay(Ctx& C, int l, int b, int hh, int c, LAS float* segs, GlaDecay& D, int bas_off = 36864) {
    const bf16* PROJ = (const bf16*)(C.ws + WS_P);
    const float* w_a2 = C.in(I_WA2) + (size_t)l * 16 * 256 + hh * 64 + C.lane; const float bias = C.in(I_BA)[l * 256 + hh * 64 + C.lane];
    float w[16];
#pragma unroll
    for (int r = 0; r < 16; ++r) w[r] = w_a2[r * 256];
    const size_t row0 = (size_t)b * SEQ + c * 64 + 8 * C.wave;
    LAS unsigned* baS = (LAS unsigned*)(C.lds + bas_off) + C.wave * 64;
    baS[C.lane] = *(const unsigned*)(PROJ + (row0 + (C.lane >> 3)) * PW + C_BA + 2 * (C.lane & 7));
    float qraw[8], kraw[8];
#pragma unroll
    for (int i = 0; i < 8; ++i) { const bf16* pr = PROJ + (row0 + i) * PW; qraw[i] = bf2f(pr[C_BQ + hh * 64 + C.lane]); kraw[i] = bf2f(pr[C_BK + hh * 64 + C.lane]); }
    asm volatile("s_waitcnt lgkmcnt(0)" ::: "memory");
    float run = 0.f;
#pragma unroll
    for (int i = 0; i < 8; ++i) {
        const v4u ba0 = *(const LAS v4u*)(baS + 8 * i), ba1 = *(const LAS v4u*)(baS + 8 * i + 4);
        const unsigned bw[8] = {ba0.x, ba0.y, ba0.z, ba0.w, ba1.x, ba1.y, ba1.z, ba1.w};
        float z = bias;
#pragma unroll
        for (int r = 0; r < 8; ++r) { z += bf2f(bw[r] & 0xffffu) * w[2 * r]; z += bf2f(bw[r] >> 16) * w[2 * r + 1]; }
        const float ls = fminf(z, 0.f) - __logf(1.f + __expf(-fabsf(z)));
        run += ls * (1.f / 16.f);
        D.b[i] = run;
        D.qv[i] = qraw[i]; D.kv[i] = kraw[i];
    }
    segs[C.wave * 64 + C.lane] = run;
    __syncthreads();
    float off = 0.f, tot = 0.f;
#pragma unroll
    for (int w8 = 0; w8 < 8; ++w8) { const float sv = segs[w8 * 64 + C.lane]; tot += sv; off += (w8 < C.wave) ? sv : 0.f; }
#pragma unroll
    for (int i = 0; i < 8; ++i) D.b[i] += off;
    D.Btot = tot;
}
__device__ __forceinline__ bf16x8 gla_vt_frag(const bf16* vcol, int ks, int h) {
    unsigned short x[8];
#pragma unroll
    for (int j = 0; j < 8; ++j) x[j] = vcol[(size_t)(16 * ks + 8 * (j >> 2) + 4 * h + (j & 3)) * PW];
    v4u p; p.x = (unsigned)x[0] | ((unsigned)x[1] << 16); p.y = (unsigned)x[2] | ((unsigned)x[3] << 16); p.z = (unsigned)x[4] | ((unsigned)x[5] << 16); p.w = (unsigned)x[6] | ((unsigned)x[7] << 16);
    return __builtin_bit_cast(bf16x8, p);
}

__device__ __forceinline__ void ph_gla1_unit(Ctx& C, int l, int unit) {
    const int c = unit & 63, hh = (unit >> 6) & 3, b = unit >> 8;
    LAS bf16* KDT = (LAS bf16*)C.lds;
    LAS float* segs = (LAS float*)(C.lds + 32768);
    const bf16* PROJ = (const bf16*)(C.ws + WS_P);
    const int mt = C.wave >> 1, nd = C.wave & 1, n = C.lane & 31, h = C.lane >> 5;
    const bf16* vcol = PROJ + ((size_t)b * SEQ + c * 64) * PW + C_BV + hh * 128 + 32 * mt + n;
    bf16x8 vf[4];
#pragma unroll
    for (int ks = 0; ks < 4; ++ks) vf[ks] = gla_vt_frag(vcol, ks, h);
    GlaDecay D; gla_decay(C, l, b, hh, c, segs, D);
    {
        v4u p;
        p.x = pk2(D.kv[0] * __expf(D.Btot - D.b[0]), D.kv[1] * __expf(D.Btot - D.b[1])); p.y = pk2(D.kv[2] * __expf(D.Btot - D.b[2]), D.kv[3] * __expf(D.Btot - D.b[3]));
        p.z = pk2(D.kv[4] * __expf(D.Btot - D.b[4]), D.kv[5] * __expf(D.Btot - D.b[5])); p.w = pk2(D.kv[6] * __expf(D.Btot - D.b[6]), D.kv[7] * __expf(D.Btot - D.b[7]));
        *(LAS v4u*)(KDT + C.lane * GLA_PITCH + 8 * C.wave) = p;
        if (C.wave == 0) ((float*)(C.ws + WS_GLA_EB))[(size_t)unit * 64 + C.lane] = __expf(D.Btot);
    }
    __syncthreads();
    f32x16 acc;
#pragma unroll
    for (int i = 0; i < 16; ++i) acc[i] = 0.f;
#pragma unroll
    for (int ks = 0; ks < 4; ++ks) {
        const LAS bf16* kp = KDT + (32 * nd + n) * GLA_PITCH + 16 * ks + 4 * h;
        const v2u k0 = *(const LAS v2u*)kp, k1 = *(const LAS v2u*)(kp + 8);
        v4u kk; kk.x = k0.x; kk.y = k0.y; kk.z = k1.x; kk.w = k1.y;
        acc = mfma32(vf[ks], __builtin_bit_cast(bf16x8, kk), acc);
    }
    float* LT = (float*)(C.ws + WS_GLA_LT) + (size_t)unit * 8192;
#pragma unroll
    for (int r = 0; r < 16; ++r) LT[(32 * mt + (r & 3) + 8 * (r >> 2) + 4 * h) * 64 + 32 * nd + n] = acc[r];
    __syncthreads();
}

__device__ __forceinline__ void ph_gla2(Ctx& C, size_t probe_off = 0) {
    const f32x4* LT = (const f32x4*)(C.ws + WS_GLA_LT); v2u* SP = (v2u*)(C.ws + WS_GLA_SP + probe_off); const float* EB = (const float*)(C.ws + WS_GLA_EB);
    for (int it = C.bid; it < 64 * 4; it += C.G) {
        const int bh = it >> 2, idx = (it & 3) * 512 + C.tid;
        const f32x4* p = LT + (size_t)bh * 64 * 2048 + idx; v2u* q = SP + (size_t)bh * 64 * 2048 + idx; const float* eb = EB + (size_t)bh * 64 * 64 + ((4 * idx) & 63);
        float S0 = 0.f, S1 = 0.f, S2 = 0.f, S3 = 0.f;
#pragma unroll 16
        for (int c = 0; c < 64; ++c) { const f32x4 lv = p[(size_t)c * 2048]; const f32x4 e = *(const f32x4*)(eb + c * 64);
            v2u o; o.x = pk2(S0, S1); o.y = pk2(S2, S3); q[(size_t)c * 2048] = o;
            S0 = e.x * S0 + lv.x; S1 = e.y * S1 + lv.y; S2 = e.z * S2 + lv.z; S3 = e.w * S3 + lv.w; }
    }
}

__device__ __forceinline__ void ph_gla3_unit(Ctx& C, int l, int unit) {
    const int c = unit & 63, hh = (unit >> 6) & 3, b = unit >> 8;
    LAS bf16* QE = (LAS bf16*)C.lds;
    LAS bf16* KE = QE + 64 * GLA_PITCH;
    LAS float* segs = (LAS float*)(C.lds + 32768);
    LAS float* ssq = (LAS float*)(C.lds + 32768 + 2048);
    const bf16* PROJ = (const bf16*)(C.ws + WS_P); bf16* YM = (bf16*)C.out;
    const int mt = C.wave >> 1, nt = C.wave & 1, n = C.lane & 31, h = C.lane >> 5;
    const size_t row0 = (size_t)b * SEQ + c * 64;
    const bf16* vcol = PROJ + row0 * PW + C_BV + hh * 128 + 32 * mt + n;
    bf16x8 vf[4]; bf16x8 spf[4]; v2u gb[4]; f32x4 gnv[4];
#pragma unroll
    for (int ks = 0; ks < 4; ++ks) vf[ks] = gla_vt_frag(vcol, (ks <= 2 * nt + 1) ? ks : 0, h);
    {
        const bf16* Sp = (const bf16*)(C.ws + WS_GLA_SP) + (size_t)unit * 8192 + (size_t)(32 * mt + n) * 64 + 8 * h;
#pragma unroll
        for (int ks = 0; ks < 4; ++ks) spf[ks] = *(const bf16x8*)(Sp + 16 * ks);
#pragma unroll
        for (int j4 = 0; j4 < 4; ++j4) { gb[j4] = *(const v2u*)(PROJ + (row0 + 32 * nt + n) * PW + C_BG + hh * 128 + 32 * mt + 8 * j4 + 4 * h); gnv[j4] = *(const f32x4*)(C.in(I_GLAG) + l * 128 + 32 * mt + 8 * j4 + 4 * h); }
    }
    GlaDecay D; gla_decay(C, l, b, hh, c, segs, D);
#pragma unroll
    for (int i = 0; i < 8; ++i) {
        QE[(8 * C.wave + i) * GLA_PITCH + C.lane] = (bf16)f2bf(D.qv[i] * 0.125f * __expf(D.b[i]));
        KE[(8 * C.wave + i) * GLA_PITCH + C.lane] = (bf16)f2bf(D.kv[i] * __expf(-D.b[i]));
    }
    __syncthreads();
    bf16x8 qf[4];
#pragma unroll
    for (int ks = 0; ks < 4; ++ks) qf[ks] = *(const LAS bf16x8*)(QE + (32 * nt + n) * GLA_PITCH + 16 * ks + 8 * h);
    f32x16 accO;
#pragma unroll
    for (int i = 0; i < 16; ++i) accO[i] = 0.f;
#pragma unroll
    for (int ms = 0; ms < 2; ++ms) {
        if (ms <= nt) {
            f32x16 aT;
#pragma unroll
            for (int i = 0; i < 16; ++i) aT[i] = 0.f;
#pragma unroll
            for (int ks = 0; ks < 4; ++ks) { const bf16x8 kf = *(const LAS bf16x8*)(KE + (32 * ms + n) * GLA_PITCH + 16 * ks + 8 * h); aT = mfma32(kf, qf[ks], aT); }
            if (ms == nt) {
#pragma unroll
                for (int r = 0; r < 16; ++r) { const int s = (r & 3) + 8 * (r >> 2) + 4 * h; aT[r] = (s <= n) ? aT[r] : 0.f; }
            }
#pragma unroll
            for (int s2 = 0; s2 < 2; ++s2) {
                v4u pa; pa.x = pk2(aT[8 * s2 + 0], aT[8 * s2 + 1]); pa.y = pk2(aT[8 * s2 + 2], aT[8 * s2 + 3]); pa.z = pk2(aT[8 * s2 + 4], aT[8 * s2 + 5]); pa.w = pk2(aT[8 * s2 + 6], aT[8 * s2 + 7]);
                accO = mfma32(vf[2 * ms + s2], __builtin_bit_cast(bf16x8, pa), accO);
            }
        }
    }
    {
#pragma unroll
        for (int ks = 0; ks < 4; ++ks) accO = mfma32(spf[ks], qf[ks], accO);
    }
    float sq = 0.f;
#pragma unroll
    for (int r = 0; r < 16; ++r) sq += accO[r] * accO[r];
    sq += SHX_F(sq, 32, C.lane);
    if (h == 0) ssq[mt * 64 + 32 * nt + n] = sq;
    __syncthreads();
    const float rstd = rsqrtf(((ssq[32 * nt + n] + ssq[64 + 32 * nt + n]) + (ssq[128 + 32 * nt + n] + ssq[192 + 32 * nt + n])) * (1.f / 128.f) + LN_EPS);
    const size_t row = row0 + 32 * nt + n;
#pragma unroll
    for (int j4 = 0; j4 < 4; ++j4) {
        const int e0 = 32 * mt + 8 * j4 + 4 * h;
        const v2u gbv = gb[j4]; const f32x4 gn = gnv[j4];
        const float y0 = accO[4 * j4 + 0] * rstd * gn.x * silu_fast_(bf2f(gbv.x & 0xffffu)), y1 = accO[4 * j4 + 1] * rstd * gn.y * silu_fast_(bf2f(gbv.x >> 16));
        const float y2 = accO[4 * j4 + 2] * rstd * gn.z * silu_fast_(bf2f(gbv.y & 0xffffu)), y3 = accO[4 * j4 + 3] * rstd * gn.w * silu_fast_(bf2f(gbv.y >> 16));
        v2u o; o.x = pk2(y0, y1); o.y = pk2(y2, y3);
        *(v2u*)(YM + row * DM + 512 + hh * 128 + e0) = o;
    }
    __syncthreads();
}

constexpr int GS_QE = 0, GS_KE = 9216, GS_KDT = 18432, GS_SB = 27648, GS_SEGS = 46080, GS_SSQ = 48128, GS_EB = 49152, GS_BAS = 49408;
struct GlaIn { bf16x8 vf[4]; v2u gb[4]; unsigned ba; float q[8], k[8]; };
__device__ __forceinline__ void gla_seq_load(Ctx& C, int b, int hh, int c, GlaIn& I) {
    const bf16* PROJ = (const bf16*)(C.ws + WS_P);
    const int mt = C.wave >> 1, x = C.wave & 1, n = C.lane & 31, h = C.lane >> 5;
    const size_t row0 = (size_t)b * SEQ + c * 64;
    const bf16* vcol = PROJ + row0 * PW + C_BV + hh * 128 + 32 * mt + n;
#pragma unroll
    for (int ks = 0; ks < 4; ++ks) I.vf[ks] = gla_vt_frag(vcol, ks, h);
#pragma unroll
    for (int j4 = 0; j4 < 4; ++j4) I.gb[j4] = *(const v2u*)(PROJ + (row0 + 32 * x + n) * PW + C_BG + hh * 128 + 32 * mt + 8 * j4 + 4 * h);
    const size_t rw = row0 + 8 * C.wave;
    I.ba = *(const unsigned*)(PROJ + (rw + (C.lane >> 3)) * PW + C_BA + 2 * (C.lane & 7));
#pragma unroll
    for (int i = 0; i < 8; ++i) { const bf16* pr = PROJ + (rw + i) * PW; I.q[i] = bf2f(pr[C_BQ + hh * 64 + C.lane]); I.k[i] = bf2f(pr[C_BK + hh * 64 + C.lane]); }
}
__device__ __forceinline__ void ph_gla_seq(Ctx& C, int l, int seq) {
    const int hh = seq & 3, b = seq >> 2;
    LAS bf16* QE = (LAS bf16*)(C.lds + GS_QE); LAS bf16* KE = (LAS bf16*)(C.lds + GS_KE); LAS bf16* KDT = (LAS bf16*)(C.lds + GS_KDT); LAS bf16* SB = (LAS bf16*)(C.lds + GS_SB);
    LAS float* segs = (LAS float*)(C.lds + GS_SEGS); LAS float* ssq = (LAS float*)(C.lds + GS_SSQ); LAS float* ebS = (LAS float*)(C.lds + GS_EB);
    LAS unsigned* baS = (LAS unsigned*)(C.lds + GS_BAS) + C.wave * 64;
    bf16* YM = (bf16*)C.out;
    const int mt = C.wave >> 1, x = C.wave & 1, n = C.lane & 31, h = C.lane >> 5;
    f32x16 st;
#pragma unroll
    for (int i = 0; i < 16; ++i) st[i] = 0.f;
    for (int i = C.tid; i < 128 * GLA_PITCH / 2; i += 512) ((LAS unsigned*)SB)[i] = 0u;
    f32x4 gnv[4];
#pragma unroll
    for (int j4 = 0; j4 < 4; ++j4) gnv[j4] = *(const f32x4*)(C.in(I_GLAG) + l * 128 + 32 * mt + 8 * j4 + 4 * h);
    float w[16];
    { const float* w_a2 = C.in(I_WA2) + (size_t)l * 16 * 256 + hh * 64 + C.lane;
#pragma unroll
      for (int r = 0; r < 16; ++r) w[r] = w_a2[r * 256]; }
    const float bias = C.in(I_BA)[l * 256 + hh * 64 + C.lane];
    GlaIn I; gla_seq_load(C, b, hh, 0, I);
    __syncthreads();
#pragma unroll 1
    for (int c = 0; c < 64; ++c) {
        const size_t row0 = (size_t)b * SEQ + c * 64;
        bf16x8 vf[4]; v2u gb[4]; GlaDecay D;
#pragma unroll
        for (int ks = 0; ks < 4; ++ks) vf[ks] = I.vf[ks];
#pragma unroll
        for (int j4 = 0; j4 < 4; ++j4) gb[j4] = I.gb[j4];
        baS[C.lane] = I.ba;
#pragma unroll
        for (int i = 0; i < 8; ++i) { D.qv[i] = I.q[i]; D.kv[i] = I.k[i]; }
        gla_seq_load(C, b, hh, c < 63 ? c + 1 : 63, I);
        {
            asm volatile("" ::: "memory");
            float run = 0.f;
#pragma unroll
            for (int i = 0; i < 8; ++i) {
                const v4u ba0 = *(const LAS v4u*)(baS + 8 * i), ba1 = *(const LAS v4u*)(baS + 8 * i + 4);
                const unsigned bw[8] = {ba0.x, ba0.y, ba0.z, ba0.w, ba1.x, ba1.y, ba1.z, ba1.w};
                float z = bias;
#pragma unroll
                for (int r = 0; r < 8; ++r) { z += bf2f(bw[r] & 0xffffu) * w[2 * r]; z += bf2f(bw[r] >> 16) * w[2 * r + 1]; }
                const float ls = fminf(z, 0.f) - __logf(1.f + __expf(-fabsf(z)));
                run += ls * (1.f / 16.f);
                D.b[i] = run;
            }
            segs[C.wave * 64 + C.lane] = run;
            __syncthreads();
            float off = 0.f, tot = 0.f;
#pragma unroll
            for (int w8 = 0; w8 < 8; ++w8) { const float sv = segs[w8 * 64 + C.lane]; tot += sv; off += (w8 < C.wave) ? sv : 0.f; }
#pragma unroll
            for (int i = 0; i < 8; ++i) D.b[i] += off;
            D.Btot = tot;
        }
#pragma unroll
        for (int i = 0; i < 8; ++i) {
            QE[(8 * C.wave + i) * GLA_PITCH + C.lane] = (bf16)f2bf(D.qv[i] * 0.125f * __expf(D.b[i]));
            KE[(8 * C.wave + i) * GLA_PITCH + C.lane] = (bf16)f2bf(D.kv[i] * __expf(-D.b[i]));
        }
        {
            v4u p;
            p.x = pk2(D.kv[0] * __expf(D.Btot - D.b[0]), D.kv[1] * __expf(D.Btot - D.b[1])); p.y = pk2(D.kv[2] * __expf(D.Btot - D.b[2]), D.kv[3] * __expf(D.Btot - D.b[3]));
            p.z = pk2(D.kv[4] * __expf(D.Btot - D.b[4]), D.kv[5] * __expf(D.Btot - D.b[5])); p.w = pk2(D.kv[6] * __expf(D.Btot - D.b[6]), D.kv[7] * __expf(D.Btot - D.b[7]));
            *(LAS v4u*)(KDT + C.lane * GLA_PITCH + 8 * C.wave) = p;
            if (C.wave == 0) ebS[C.lane] = __expf(D.Btot);
        }
        __syncthreads();
        bf16x8 qf[4];
#pragma unroll
        for (int ks = 0; ks < 4; ++ks) qf[ks] = *(const LAS bf16x8*)(QE + (32 * x + n) * GLA_PITCH + 16 * ks + 8 * h);
        f32x16 accO;
#pragma unroll
        for (int i = 0; i < 16; ++i) accO[i] = 0.f;
#pragma unroll
        for (int ms = 0; ms < 2; ++ms) {
            if (ms <= x) {
                f32x16 aT;
#pragma unroll
                for (int i = 0; i < 16; ++i) aT[i] = 0.f;
#pragma unroll
                for (int ks = 0; ks < 4; ++ks) { const bf16x8 kf = *(const LAS bf16x8*)(KE + (32 * ms + n) * GLA_PITCH + 16 * ks + 8 * h); aT = mfma32(kf, qf[ks], aT); }
                if (ms == x) {
#pragma unroll
                    for (int r = 0; r < 16; ++r) { const int sx = (r & 3) + 8 * (r >> 2) + 4 * h; aT[r] = (sx <= n) ? aT[r] : 0.f; }
                }
#pragma unroll
                for (int s2 = 0; s2 < 2; ++s2) {
                    v4u pa; pa.x = pk2(aT[8 * s2 + 0], aT[8 * s2 + 1]); pa.y = pk2(aT[8 * s2 + 2], aT[8 * s2 + 3]); pa.z = pk2(aT[8 * s2 + 4], aT[8 * s2 + 5]); pa.w = pk2(aT[8 * s2 + 6], aT[8 * s2 + 7]);
                    accO = mfma32(vf[2 * ms + s2], __builtin_bit_cast(bf16x8, pa), accO);
                }
            }
        }
#pragma unroll
        for (int ks = 0; ks < 4; ++ks) { const bf16x8 spf = *(const LAS bf16x8*)(SB + (32 * mt + n) * GLA_PITCH + 16 * ks + 8 * h); accO = mfma32(spf, qf[ks], accO); }
        {
            f32x16 accL;
#pragma unroll
            for (int i = 0; i < 16; ++i) accL[i] = 0.f;
#pragma unroll
            for (int ks = 0; ks < 4; ++ks) {
                const LAS bf16* kp = KDT + (32 * x + n) * GLA_PITCH + 16 * ks + 4 * h;
                const v2u k0 = *(const LAS v2u*)kp, k1 = *(const LAS v2u*)(kp + 8);
                v4u kk; kk.x = k0.x; kk.y = k0.y; kk.z = k1.x; kk.w = k1.y;
                accL = mfma32(vf[ks], __builtin_bit_cast(bf16x8, kk), accL);
            }
            const float eb = ebS[32 * x + n];
#pragma unroll
            for (int i = 0; i < 16; ++i) st[i] = st[i] * eb + accL[i];
        }
        float sq = 0.f;
#pragma unroll
        for (int r = 0; r < 16; ++r) sq += accO[r] * accO[r];
        sq += SHX_F(sq, 32, C.lane);
        if (h == 0) ssq[mt * 64 + 32 * x + n] = sq;
        __syncthreads();
#pragma unroll
        for (int r = 0; r < 16; ++r) SB[(32 * mt + (r & 3) + 8 * (r >> 2) + 4 * h) * GLA_PITCH + 32 * x + n] = (bf16)f2bf(st[r]);
        const float rstd = rsqrtf(((ssq[32 * x + n] + ssq[64 + 32 * x + n]) + (ssq[128 + 32 * x + n] + ssq[192 + 32 * x + n])) * (1.f / 128.f) + LN_EPS);
        const size_t row = row0 + 32 * x + n;
#pragma unroll
        for (int j4 = 0; j4 < 4; ++j4) {
            const int e0 = 32 * mt + 8 * j4 + 4 * h;
            const v2u gbv = gb[j4]; const f32x4 gn = gnv[j4];
            const float y0 = accO[4 * j4 + 0] * rstd * gn.x * silu_fast_(bf2f(gbv.x & 0xffffu)), y1 = accO[4 * j4 + 1] * rstd * gn.y * silu_fast_(bf2f(gbv.x >> 16));
            const float y2 = accO[4 * j4 + 2] * rstd * gn.z * silu_fast_(bf2f(gbv.y & 0xffffu)), y3 = accO[4 * j4 + 3] * rstd * gn.w * silu_fast_(bf2f(gbv.y >> 16));
            v2u o; o.x = pk2(y0, y1); o.y = pk2(y2, y3);
            *(v2u*)(YM + row * DM + 512 + hh * 128 + e0) = o;
        }
    }
    __syncthreads();
}

#ifndef A3_VPATH
#define A3_VPATH(i) (true)
#endif
#ifndef REP_S
#define REP_S 1
#endif
constexpr size_t WS_KFI = 932 * MiB, WS_KFA = 940 * MiB, WS_VF = 948 * MiB;

__device__ __forceinline__ void ph_dsa_a2_unit(Ctx& C, int b, int t0) {
    LAS unsigned* cnt = (LAS unsigned*)(C.lds + 131072);
    const bf16* PROJ = (const bf16*)(C.ws + WS_P); unsigned* SEL = (unsigned*)(C.ws + WS_SEL); const bf16* KFI = (const bf16*)(C.ws + WS_KFI);
    const int lane = C.lane, n = lane & 31, h = lane >> 5, tid = C.tid, wave = C.wave;
    const int nk = t0 + 8, ntile = (nk + 31) >> 5;
    if (tid < 48) cnt[tid] = 0u;
    unsigned u[16][4];
    {
        bf16x8 af[2][4]; float wv[2][2][8];
        const int jq = 2 * ((n >> 4) & 1) + ((n >> 2) & 1), hd = 4 * ((n >> 3) & 1) + (n & 3);
#pragma unroll
        for (int mt = 0; mt < 2; ++mt) {
            const bf16* p = PROJ + (size_t)(b * SEQ + t0 + 4 * mt + jq) * PW + C_IQ + hd * 64 + 8 * h;
#pragma unroll
            for (int ks = 0; ks < 4; ++ks) af[mt][ks] = *(const bf16x8*)(p + ks * 16);
#pragma unroll
            for (int g = 0; g < 2; ++g) {
                const v4u w4 = *(const v4u*)(PROJ + (size_t)(b * SEQ + t0 + 4 * mt + 2 * g + h) * PW + C_IW); const unsigned ww[4] = {w4.x, w4.y, w4.z, w4.w};
#pragma unroll
                for (int x = 0; x < 4; ++x) { wv[mt][g][2 * x] = bf2f(ww[x] & 0xffffu) * (0.35355339059327373f * 0.125f); wv[mt][g][2 * x + 1] = bf2f(ww[x] >> 16) * (0.35355339059327373f * 0.125f); }
            }
        }
        const bf16* kbase = KFI + (size_t)(b * 128) * 2048 + lane * 8;
#pragma unroll
        for (int i = 0; i < 16; ++i) {
            const int tile = wave + 8 * i;
#pragma unroll
            for (int k = 0; k < 4; ++k) u[i][k] = 0u;
            if (tile < ntile) {
                bf16x8 bcur[4];
#pragma unroll
                for (int ks = 0; ks < 4; ++ks) bcur[ks] = *(const bf16x8*)(kbase + (size_t)tile * 2048 + ks * 512);
                const int s = tile * 32 + n;
#pragma unroll
                for (int mt = 0; mt < 2; ++mt) {
                    f32x16 acc;
#pragma unroll
                    for (int x = 0; x < 16; ++x) acc[x] = 0.f;
#pragma unroll
                    for (int ks = 0; ks < 4; ++ks) acc = mfma32(af[mt][ks], bcur[ks], acc);
#pragma unroll
                    for (int g = 0; g < 2; ++g) {
                        float p = 0.f;
#pragma unroll
                        for (int x = 0; x < 8; ++x) p += wv[mt][g][x] * fmaxf(acc[8 * g + x], 0.f);
                        const int t = t0 + 4 * mt + 2 * g + h;
                        u[i][2 * mt + g] = (s <= t) ? sortable_u32(p) : 0u;
                    }
                }
            }
            __builtin_amdgcn_sched_barrier(0);
        }
    }
    __syncthreads();
    unsigned Tl[4], Jl[4], needl[4];
#pragma unroll
    for (int k = 0; k < 4; ++k) { Tl[k] = 0u; Jl[k] = 8192u; needl[k] = 0u; }
    int buf = 0;
#define DSA_COUNT(PRED) \
        _Pragma("unroll") for (int i = 0; i < 16; ++i) if (wave + 8 * i < ntile) { const unsigned s = (unsigned)((wave + 8 * i) * 32 + n); (void)s; \
            _Pragma("unroll") for (int k = 0; k < 4; ++k) { const unsigned uu = u[i][k]; const unsigned long long bm = __ballot(PRED); cq[2 * k] += (unsigned)__popc((unsigned)bm); cq[2 * k + 1] += (unsigned)__popc((unsigned)(bm >> 32)); } __builtin_amdgcn_sched_barrier(0); }
#define DSA_PUBLISH(NW) { unsigned myc = 0u; \
        _Pragma("unroll") for (int q = 0; q < NW; ++q) myc = (lane == q) ? cq[q] : myc; \
        if (lane < NW) __hip_atomic_fetch_add(cnt + buf * 16 + lane, myc, __ATOMIC_RELAXED, __HIP_MEMORY_SCOPE_WORKGROUP); \
        nb = (buf == 2) ? 0 : buf + 1; if (tid >= 64 && tid < 80) cnt[nb * 16 + (tid - 64)] = 0u; __syncthreads(); }
#pragma unroll 1
    for (int bit = 31; bit >= 0; --bit) {
        unsigned cq[8]; int nb;
#pragma unroll
        for (int q = 0; q < 8; ++q) cq[q] = 0u;
        unsigned cl[4];
#pragma unroll
        for (int k = 0; k < 4; ++k) cl[k] = Tl[k] | (1u << bit);
        DSA_COUNT(uu >= cl[k])
        DSA_PUBLISH(8)
#pragma unroll
        for (int k = 0; k < 4; ++k) if (cnt[buf * 16 + 2 * k + h] >= 256u) Tl[k] = cl[k];
        buf = nb;
    }
#pragma unroll
    for (int k = 0; k < 4; ++k) Tl[k] = Tl[k] < 1u ? 1u : Tl[k];
    bool extra = false;
    {
        unsigned cq[16]; int nb;
#pragma unroll
        for (int q = 0; q < 16; ++q) cq[q] = 0u;
#pragma unroll
        for (int i = 0; i < 16; ++i) if (wave + 8 * i < ntile) {
#pragma unroll
            for (int k = 0; k < 4; ++k) { const unsigned uu = u[i][k];
                const unsigned long long bg = __ballot(uu > Tl[k]), be = __ballot(uu >= Tl[k]);
                cq[2 * k] += (unsigned)__popc((unsigned)bg); cq[2 * k + 1] += (unsigned)__popc((unsigned)(bg >> 32));
                cq[8 + 2 * k] += (unsigned)__popc((unsigned)be); cq[8 + 2 * k + 1] += (unsigned)__popc((unsigned)(be >> 32)); }
            __builtin_amdgcn_sched_barrier(0);
        }
        DSA_PUBLISH(16)
#pragma unroll
        for (int k = 0; k < 4; ++k) { const unsigned g = cnt[buf * 16 + 2 * k + h]; needl[k] = 256u - (g < 256u ? g : 256u); }
#pragma unroll
        for (int q = 0; q < 8; ++q) extra = extra || (cnt[buf * 16 + 8 + q] > 256u);
        buf = nb;
    }
    if (extra) {
#pragma unroll
        for (int k = 0; k < 4; ++k) Jl[k] = 0u;
#pragma unroll 1
        for (int bit = 12; bit >= 0; --bit) {
            unsigned cq[8]; int nb;
#pragma unroll
            for (int q = 0; q < 8; ++q) cq[q] = 0u;
            unsigned jl[4];
#pragma unroll
            for (int k = 0; k < 4; ++k) jl[k] = Jl[k] | (1u << bit);
            DSA_COUNT(uu == Tl[k] && s < jl[k])
            DSA_PUBLISH(8)
#pragma unroll
            for (int k = 0; k < 4; ++k) if (cnt[buf * 16 + 2 * k + h] <= needl[k]) Jl[k] = jl[k];
            buf = nb;
        }
    }
    {
        unsigned wsel[4];
#pragma unroll
        for (int k = 0; k < 4; ++k) wsel[k] = 0u;
#pragma unroll
        for (int i = 0; i < 16; ++i) if (wave + 8 * i < ntile) {
            const unsigned s = (unsigned)((wave + 8 * i) * 32 + n);
#pragma unroll
            for (int k = 0; k < 4; ++k) {
                const unsigned uu = u[i][k];
                const unsigned long long bm = __ballot((uu > Tl[k]) || (uu == Tl[k] && s < Jl[k]));
                const unsigned wd = h ? (unsigned)(bm >> 32) : (unsigned)bm;
                wsel[k] = (n == i) ? wd : wsel[k];
            }
            __builtin_amdgcn_sched_barrier(0);
        }
        const int tile = wave + 8 * n;
        if (n < 16 && tile < ntile) {
#pragma unroll
            for (int k = 0; k < 4; ++k) SEL[(size_t)(b * SEQ + t0 + 2 * k + h) * 128 + tile] = wsel[k];
        }
    }
#undef DSA_COUNT
#undef DSA_PUBLISH
    __syncthreads();
}


constexpr int A3_QP = 64 * 68;
struct A3Q { bf16x8 af[2][4]; v4u wq; };
__device__ __forceinline__ void a3_load_q(Ctx& C, int b, int t0, A3Q& Q) {
    const bf16* PROJ = (const bf16*)(C.ws + WS_P);
    const int n = C.lane & 31, h = C.lane >> 5;
    const int jq = 2 * ((n >> 4) & 1) + ((n >> 2) & 1), hd = 4 * ((n >> 3) & 1) + (n & 3);
#pragma unroll
    for (int mt = 0; mt < 2; ++mt) {
        const bf16* p = PROJ + (size_t)(b * SEQ + t0 + 4 * mt + jq) * PW + C_IQ + hd * 64 + 8 * h;
#pragma unroll
        for (int ks = 0; ks < 4; ++ks) Q.af[mt][ks] = *(const bf16x8*)(p + ks * 16);
    }
    Q.wq = *(const v4u*)(PROJ + (size_t)(b * SEQ + t0 + (n & 7)) * PW + C_IW);
}
__device__ __forceinline__ void ph_dsa_a3_unit(Ctx& C, int b, int t0, A3Q& Q, bool has_next, int nb, int nt0) {
    LAS unsigned* sc = (LAS unsigned*)C.lds;
    const bf16* PROJ = (const bf16*)(C.ws + WS_P); unsigned* SEL = (unsigned*)(C.ws + WS_SEL); const bf16* KFI = (const bf16*)(C.ws + WS_KFI);
    const int lane = C.lane, n = lane & 31, h = lane >> 5, wave = C.wave;
    const int nk = t0 + 8, ntile = (nk + 31) >> 5;
    {
        typedef _Float16 h8_t __attribute__((ext_vector_type(8)));
        typedef _Float16 h2_t __attribute__((ext_vector_type(2)));
        h8_t wf[2][2];
        {
            const unsigned ww[4] = {Q.wq.x, Q.wq.y, Q.wq.z, Q.wq.w}; unsigned wp[4];
#pragma unroll
            for (int x = 0; x < 4; ++x) wp[x] = __builtin_bit_cast(unsigned, __builtin_amdgcn_cvt_pkrtz(bf2f(ww[x] & 0xffffu) * (0.35355339059327373f * 0.125f), bf2f(ww[x] >> 16) * (0.35355339059327373f * 0.125f)));
#pragma unroll
            for (int mt = 0; mt < 2; ++mt)
#pragma unroll
                for (int ks = 0; ks < 2; ++ks) { const bool on = (n < 8) && ((n >> 2) == mt) && ((n & 3) == 2 * ks + h);
                    v4u f; f.x = on ? wp[0] : 0u; f.y = on ? wp[1] : 0u; f.z = on ? wp[2] : 0u; f.w = on ? wp[3] : 0u; wf[mt][ks] = __builtin_bit_cast(h8_t, f); }
        }
        const bf16* kbase = KFI + (size_t)(b * 128) * 2048 + lane * 8;
        bf16x8 kA[4], kB[4];
        { const int ta = wave < ntile ? wave : 0, tb = wave + 8 < ntile ? wave + 8 : ta;
#pragma unroll
          for (int ks = 0; ks < 4; ++ks) { kA[ks] = *(const bf16x8*)(kbase + (size_t)ta * 2048 + ks * 512); kB[ks] = *(const bf16x8*)(kbase + (size_t)tb * 2048 + ks * 512); } }
#define A3_MMA(A0, A1, KF) { const f32x16 z16_ = {0.f, 0.f, 0.f, 0.f, 0.f, 0.f, 0.f, 0.f, 0.f, 0.f, 0.f, 0.f, 0.f, 0.f, 0.f, 0.f}; \
            A0 = mfma32(Q.af[0][0], KF[0], z16_); A1 = mfma32(Q.af[1][0], KF[0], z16_); \
            _Pragma("unroll") for (int ks = 1; ks < 4; ++ks) { A0 = mfma32(Q.af[0][ks], KF[ks], A0); A1 = mfma32(Q.af[1][ks], KF[ks], A1); } }
#define A3_RELU4(A, r0_) ({ v4u f_; const h2_t z2_ = {(_Float16)0.f, (_Float16)0.f}; \
                f_.x = __builtin_bit_cast(unsigned, __builtin_elementwise_max(__builtin_bit_cast(h2_t, __builtin_amdgcn_cvt_pkrtz(A[(r0_)], A[(r0_) + 1])), z2_)); \
                f_.y = __builtin_bit_cast(unsigned, __builtin_elementwise_max(__builtin_bit_cast(h2_t, __builtin_amdgcn_cvt_pkrtz(A[(r0_) + 2], A[(r0_) + 3])), z2_)); \
                f_.z = __builtin_bit_cast(unsigned, __builtin_elementwise_max(__builtin_bit_cast(h2_t, __builtin_amdgcn_cvt_pkrtz(A[(r0_) + 4], A[(r0_) + 5])), z2_)); \
                f_.w = __builtin_bit_cast(unsigned, __builtin_elementwise_max(__builtin_bit_cast(h2_t, __builtin_amdgcn_cvt_pkrtz(A[(r0_) + 6], A[(r0_) + 7])), z2_)); \
                __builtin_bit_cast(h8_t, f_); })
#define A3_EPI(A0, A1, tile_) { const int s = (tile_) * 32 + n; const f32x16 z16e_ = {0.f, 0.f, 0.f, 0.f, 0.f, 0.f, 0.f, 0.f, 0.f, 0.f, 0.f, 0.f, 0.f, 0.f, 0.f, 0.f}; \
            f32x16 P_ = __builtin_amdgcn_mfma_f32_32x32x16_f16(wf[0][0], A3_RELU4(A0, 0), z16e_, 0, 0, 0); P_ = __builtin_amdgcn_mfma_f32_32x32x16_f16(wf[0][1], A3_RELU4(A0, 8), P_, 0, 0, 0); \
            P_ = __builtin_amdgcn_mfma_f32_32x32x16_f16(wf[1][0], A3_RELU4(A1, 0), P_, 0, 0, 0); P_ = __builtin_amdgcn_mfma_f32_32x32x16_f16(wf[1][1], A3_RELU4(A1, 8), P_, 0, 0, 0); \
              \
            _Pragma("unroll") for (int r = 0; r < 4; ++r) { const int q = r + 4 * h; sc[q * A3_QP + (s >> 6) * 68 + (s & 63)] = (s <= t0 + q) ? sortable_u32(P_[r]) : 0u; } }
#define A3_LOADK(KF, tile_) { const int tl_ = ((tile_) < ntile) ? (tile_) : wave; \
            _Pragma("unroll") for (int ks = 0; ks < 4; ++ks) KF[ks] = *(const bf16x8*)(kbase + (size_t)tl_ * 2048 + ks * 512); }
        f32x16 accA0, accA1, accB0, accB1;
        if (wave < ntile) { A3_MMA(accA0, accA1, kA) A3_LOADK(kA, wave + 16) }
#pragma unroll 1
        for (int tile = wave; tile < ntile; tile += 16) {
            if (tile + 8 < ntile) { A3_MMA(accB0, accB1, kB) A3_LOADK(kB, tile + 24) }
            A3_EPI(accA0, accA1, tile)
            if (tile + 8 < ntile) {
                if (tile + 16 < ntile) { A3_MMA(accA0, accA1, kA) A3_LOADK(kA, tile + 32) }
                A3_EPI(accB0, accB1, tile + 8)
            }
        }
#undef A3_LOADK
#undef A3_RELU4
#undef A3_MMA
#undef A3_EPI
    }
    __syncthreads();
    {
        const int q = wave, t = t0 + q;
        const int nval = t + 1 - 64 * lane;
        const unsigned long long vm = nval >= 64 ? ~0ull : (nval > 0 ? ((1ull << nval) - 1ull) : 0ull);
        unsigned long long selm = vm;
        if (t >= 256) {
            unsigned lo[32], hi[32];
            {
                const LAS v4u* gp = (const LAS v4u*)(sc + q * A3_QP + lane * 68);
#pragma unroll
                for (int i = 0; i < 8; ++i) { const v4u a = gp[i], c = gp[8 + i]; lo[4 * i] = a.x; lo[4 * i + 1] = a.y; lo[4 * i + 2] = a.z; lo[4 * i + 3] = a.w; hi[4 * i] = c.x; hi[4 * i + 1] = c.y; hi[4 * i + 2] = c.z; hi[4 * i + 3] = c.w; }
            }
#define A3_TR(X) { \
            _Pragma("unroll") for (int k = 0; k < 32; ++k) if ((k & 16) == 0) { const unsigned a = X[k], c = X[k + 16]; X[k] = __builtin_amdgcn_perm(c, a, 0x05040100u); X[k + 16] = __builtin_amdgcn_perm(c, a, 0x07060302u); } \
            _Pragma("unroll") for (int k = 0; k < 32; ++k) if ((k & 8) == 0) { const unsigned a = X[k], c = X[k + 8]; X[k] = __builtin_amdgcn_perm(c, a, 0x06020400u); X[k + 8] = __builtin_amdgcn_perm(c, a, 0x07030501u); } \
            _Pragma("unroll") for (int st = 2; st < 5; ++st) { const int j = 16 >> st; const unsigned m = st == 2 ? 0x0f0f0f0fu : st == 3 ? 0x33333333u : 0x55555555u; \
                _Pragma("unroll") for (int k = 0; k < 32; ++k) if ((k & j) == 0) { const unsigned a = X[k], c = X[k + j]; X[k] = (a & m) | ((c << j) & ~m); X[k + j] = ((a >> j) & m) | (c & ~m); } } }
            A3_TR(lo) A3_TR(hi)
#undef A3_TR
            unsigned al = (unsigned)vm, ah = (unsigned)(vm >> 32), gl = 0u, gh = 0u, G = 0u;
            bool done = false;
#pragma unroll
            for (int b = 31; b >= 0; --b) {
                if (!done) {
                    const unsigned ol = al & lo[b], oh = ah & hi[b];
                    const unsigned c = G + wave_sum_u32((unsigned)__popc(ol) + (unsigned)__popc(oh));
                    if (c >= 256u) { al = ol; ah = oh; done = (c == 256u); }
                    else { gl |= ol; gh |= oh; G = c; al ^= ol; ah ^= oh; }
                }
            }
            const unsigned ca = (unsigned)__popc(al) + (unsigned)__popc(ah);
            const unsigned tot = wave_sum_u32(ca);
            unsigned long long alive = ((unsigned long long)ah << 32) | al;
            if (G + tot > 256u) {
                int incl = (int)ca;
#pragma unroll
                for (int o = 1; o < 64; o <<= 1) { const int v = SHUP_I(incl, o, lane); if (lane >= o) incl += v; }
                const int before = incl - (int)ca, room = (int)(256u - G) - before;
                int take = room < 0 ? 0 : (room > (int)ca ? (int)ca : room);
                unsigned long long keep = 0ull;
                while (__any(take > 0)) { if (take > 0) { const unsigned long long low = alive & (0ull - alive); keep |= low; alive ^= low; --take; } }
                alive = keep;
            }
            selm = (((unsigned long long)gh << 32) | gl) | alive;
        }
        if (has_next) a3_load_q(C, nb, nt0, Q);
#ifdef SEL_ALL
        *(unsigned long long*)(SEL + (size_t)(b * SEQ + t) * 128 + 2 * lane) = selm;
#else
        if (64 * lane <= t) *(unsigned long long*)(SEL + (size_t)(b * SEQ + t) * 128 + 2 * lane) = selm;
#endif
    }
    __syncthreads();
}

constexpr int A4_BUF = 4 * A3_QP;
#ifdef PROBE_HOT
#define A4_TMASK(x) ((x) & C.hot)
#else
#define A4_TMASK(x) (x)
#endif
constexpr int A4_R = 4;
struct A4S { bf16x8 af[4]; v4u wq; bf16x8 k[A4_R][4]; };
__device__ __forceinline__ int a4_cnt(int t0, int sw) { const int ntile = (t0 + 4 + 31) >> 5; return (t0 + 3 < 256 || sw >= ntile) ? 0 : (ntile - sw + 3) >> 2; }
__device__ __forceinline__ void a4_prefetch(Ctx& C, A4S& S, int b, int t0) {
    const bf16* PROJ = (const bf16*)(C.ws + WS_P); const bf16* KFI = (const bf16*)(C.ws + WS_KFI);
    const int lane = C.lane, n = lane & 31, h = lane >> 5, sw = C.wave;
    const int cnt = a4_cnt(t0, sw);
    {
        const int jq = 2 * ((n >> 4) & 1) + ((n >> 2) & 1), hd = 4 * ((n >> 3) & 1) + (n & 3);
        const bf16* p = PROJ + (size_t)(b * SEQ + t0 + jq) * PW + C_IQ + hd * 64 + 8 * h;
#pragma unroll
        for (int ks = 0; ks < 4; ++ks) S.af[ks] = *(const bf16x8*)(p + ks * 16);
        const int qsel = (n & 1) + 2 * ((n >> 2) & 1);
        S.wq = *(const v4u*)(PROJ + (size_t)(b * SEQ + t0 + qsel) * PW + C_IW);
    }
    const bf16* kbase = KFI + (size_t)(b * 128) * 2048 + lane * 8;
#pragma unroll
    for (int j = 0; j < A4_R; ++j) { const int tl = j < cnt ? sw + 4 * j : 0;
#pragma unroll
        for (int ks = 0; ks < 4; ++ks) S.k[j][ks] = *(const bf16x8*)(kbase + (size_t)A4_TMASK(tl) * 2048 + ks * 512);
    }
}
__device__ __forceinline__ void a4_score(Ctx& C, A4S& S, LAS unsigned* sc, int b, int t0, int nb, int nt0) {
    const bf16* KFI = (const bf16*)(C.ws + WS_KFI); const bf16* PROJ = (const bf16*)(C.ws + WS_P);
    const int lane = C.lane, n = lane & 31, h = lane >> 5, sw = C.wave;
    const int cnt = a4_cnt(t0, sw);
    bf16x8 naf[4]; v4u nwq;
    {
        const int jq = 2 * ((n >> 4) & 1) + ((n >> 2) & 1), hd = 4 * ((n >> 3) & 1) + (n & 3);
        const bf16* p = PROJ + (size_t)(nb * SEQ + nt0 + jq) * PW + C_IQ + hd * 64 + 8 * h;
#pragma unroll
        for (int ks = 0; ks < 4; ++ks) naf[ks] = *(const bf16x8*)(p + ks * 16);
        const int qsel = (n & 1) + 2 * ((n >> 2) & 1);
        nwq = *(const v4u*)(PROJ + (size_t)(nb * SEQ + nt0 + qsel) * PW + C_IW);
    }
    const int ncnt = a4_cnt(nt0, sw);
    const bf16* nkbase = KFI + (size_t)(nb * 128) * 2048 + lane * 8;
    typedef _Float16 h8_t __attribute__((ext_vector_type(8)));
    typedef _Float16 h2_t __attribute__((ext_vector_type(2)));
    h8_t wf[2];
    {
        const unsigned ww[4] = {S.wq.x, S.wq.y, S.wq.z, S.wq.w}; unsigned wp[4];
#pragma unroll
        for (int x = 0; x < 4; ++x) wp[x] = __builtin_bit_cast(unsigned, __builtin_amdgcn_cvt_pkrtz(bf2f(ww[x] & 0xffffu) * (0.35355339059327373f * 0.125f), bf2f(ww[x] >> 16) * (0.35355339059327373f * 0.125f)));
        const bool rowok = (n == 0) || (n == 1) || (n == 4) || (n == 5); const int qrow = (n & 1) + 2 * (n >> 2);
#pragma unroll
        for (int ks = 0; ks < 2; ++ks) { const bool on = rowok && (qrow == 2 * ks + h);
            v4u f; f.x = on ? wp[0] : 0u; f.y = on ? wp[1] : 0u; f.z = on ? wp[2] : 0u; f.w = on ? wp[3] : 0u; wf[ks] = __builtin_bit_cast(h8_t, f); }
    }
    const bf16* kbase = KFI + (size_t)(b * 128) * 2048 + lane * 8;
#define A4_MMA(A, KF) { const f32x16 z16_ = {0.f, 0.f, 0.f, 0.f, 0.f, 0.f, 0.f, 0.f, 0.f, 0.f, 0.f, 0.f, 0.f, 0.f, 0.f, 0.f}; \
        A = mfma32(S.af[0], KF[0], z16_); _Pragma("unroll") for (int ks = 1; ks < 4; ++ks) A = mfma32(S.af[ks], KF[ks], A); }
#define A4_RELU4(A, r0_) ({ v4u f_; const h2_t z2_ = {(_Float16)0.f, (_Float16)0.f}; \
            f_.x = __builtin_bit_cast(unsigned, __builtin_elementwise_max(__builtin_bit_cast(h2_t, __builtin_amdgcn_cvt_pkrtz(A[(r0_)], A[(r0_) + 1])), z2_)); \
            f_.y = __builtin_bit_cast(unsigned, __builtin_elementwise_max(__builtin_bit_cast(h2_t, __builtin_amdgcn_cvt_pkrtz(A[(r0_) + 2], A[(r0_) + 3])), z2_)); \
            f_.z = __builtin_bit_cast(unsigned, __builtin_elementwise_max(__builtin_bit_cast(h2_t, __builtin_amdgcn_cvt_pkrtz(A[(r0_) + 4], A[(r0_) + 5])), z2_)); \
            f_.w = __builtin_bit_cast(unsigned, __builtin_elementwise_max(__builtin_bit_cast(h2_t, __builtin_amdgcn_cvt_pkrtz(A[(r0_) + 6], A[(r0_) + 7])), z2_)); \
            __builtin_bit_cast(h8_t, f_); })
#define A4_EPI(A, i_) { const int s = (sw + 4 * (i_)) * 32 + n; const f32x16 z16e_ = {0.f, 0.f, 0.f, 0.f, 0.f, 0.f, 0.f, 0.f, 0.f, 0.f, 0.f, 0.f, 0.f, 0.f, 0.f, 0.f}; \
        f32x16 P_ = __builtin_amdgcn_mfma_f32_32x32x16_f16(wf[0], A4_RELU4(A, 0), z16e_, 0, 0, 0); P_ = __builtin_amdgcn_mfma_f32_32x32x16_f16(wf[1], A4_RELU4(A, 8), P_, 0, 0, 0); \
          \
          \
        _Pragma("unroll") for (int r = 0; r < 2; ++r) { const int q = 2 * h + r; const unsigned u_ = __float_as_uint(P_[r]); sc[q * A3_QP + (s >> 6) * 68 + (s & 63)] = u_ ^ ((unsigned)((int)u_ >> 31) | 0x80000000u); } }
#define A4_LOADK(KF, i_) { const int il_ = ((i_) < cnt) ? (i_) : 0; _Pragma("unroll") for (int ks = 0; ks < 4; ++ks) KF[ks] = *(const bf16x8*)(kbase + (size_t)A4_TMASK(sw + 4 * il_) * 2048 + ks * 512); }
    f32x16 acc0, acc1;
    int i0 = 0;
#pragma unroll 1
    for (; i0 + 4 < cnt; i0 += 4) {
        A4_MMA(acc0, S.k[0]) A4_LOADK(S.k[0], i0 + 4)
        A4_MMA(acc1, S.k[1]) A4_LOADK(S.k[1], i0 + 5)
        A4_EPI(acc0, i0)
        A4_MMA(acc0, S.k[2]) A4_LOADK(S.k[2], i0 + 6)
        A4_EPI(acc1, i0 + 1)
        A4_MMA(acc1, S.k[3]) A4_LOADK(S.k[3], i0 + 7)
        A4_EPI(acc0, i0 + 2)
        A4_EPI(acc1, i0 + 3)
    }
#define A4_LOADN(KF, j_) { const int tl_ = ((j_) < ncnt) ? sw + 4 * (j_) : 0; _Pragma("unroll") for (int ks = 0; ks < 4; ++ks) KF[ks] = *(const bf16x8*)(nkbase + (size_t)A4_TMASK(tl_) * 2048 + ks * 512); }
    if (i0 < cnt) { A4_MMA(acc0, S.k[0]) }
    A4_LOADN(S.k[0], 0)
    if (i0 + 1 < cnt) { A4_MMA(acc1, S.k[1]) }
    A4_LOADN(S.k[1], 1)
    if (i0 < cnt) A4_EPI(acc0, i0)
    if (i0 + 2 < cnt) { A4_MMA(acc0, S.k[2]) }
    A4_LOADN(S.k[2], 2)
    if (i0 + 1 < cnt) A4_EPI(acc1, i0 + 1)
    if (i0 + 3 < cnt) { A4_MMA(acc1, S.k[3]) }
    A4_LOADN(S.k[3], 3)
    if (i0 + 2 < cnt) A4_EPI(acc0, i0 + 2)
    if (i0 + 3 < cnt) A4_EPI(acc1, i0 + 3)
#undef A4_LOADN
#pragma unroll
    for (int ks = 0; ks < 4; ++ks) S.af[ks] = naf[ks];
    S.wq = nwq;
#undef A4_LOADK
#undef A4_RELU4
#undef A4_MMA
#undef A4_EPI
}
__device__ __forceinline__ void a4_select(Ctx& C, const LAS unsigned* scq, int b, int t) {
    unsigned* SEL = (unsigned*)(C.ws + WS_SEL);
    const int lane = C.lane;
    const int nval = t + 1 - 64 * lane;
    const unsigned long long vm = nval >= 64 ? ~0ull : (nval > 0 ? ((1ull << nval) - 1ull) : 0ull);
    unsigned long long selm = vm;
    if (t >= 256) {
        unsigned lo[32], hi[32];
        {
            const LAS v4u* gp = (const LAS v4u*)(scq + lane * 68);
#pragma unroll
            for (int i = 0; i < 8; ++i) { const v4u a = gp[i], c = gp[8 + i]; lo[4 * i] = a.x; lo[4 * i + 1] = a.y; lo[4 * i + 2] = a.z; lo[4 * i + 3] = a.w; hi[4 * i] = c.x; hi[4 * i + 1] = c.y; hi[4 * i + 2] = c.z; hi[4 * i + 3] = c.w; }
        }
#define A3_TR(X) { \
        _Pragma("unroll") for (int k = 0; k < 32; ++k) if ((k & 16) == 0) { const unsigned a = X[k], c = X[k + 16]; X[k] = __builtin_amdgcn_perm(c, a, 0x05040100u); X[k + 16] = __builtin_amdgcn_perm(c, a, 0x07060302u); } \
        _Pragma("unroll") for (int k = 0; k < 32; ++k) if ((k & 8) == 0) { const unsigned a = X[k], c = X[k + 8]; X[k] = __builtin_amdgcn_perm(c, a, 0x06020400u); X[k + 8] = __builtin_amdgcn_perm(c, a, 0x07030501u); } \
        _Pragma("unroll") for (int st = 2; st < 5; ++st) { const int j = 16 >> st; const unsigned m = st == 2 ? 0x0f0f0f0fu : st == 3 ? 0x33333333u : 0x55555555u; \
            _Pragma("unroll") for (int k = 0; k < 32; ++k) if ((k & j) == 0) { const unsigned a = X[k], c = X[k + j]; X[k] = (a & m) | ((c << j) & ~m); X[k + j] = ((a >> j) & m) | (c & ~m); } } }
        A3_TR(lo) A3_TR(hi)
#undef A3_TR
        unsigned al = (unsigned)vm, ah = (unsigned)(vm >> 32), gl = 0u, gh = 0u, G = 0u;
        bool done = false;
#pragma unroll
        for (int bb = 31; bb >= 1; bb -= 2) {
            if (!done) {
                const unsigned o1l = al & lo[bb], o1h = ah & hi[bb];
                const unsigned o11l = o1l & lo[bb - 1], o11h = o1h & hi[bb - 1];
                const unsigned o01l = (al ^ o1l) & lo[bb - 1], o01h = (ah ^ o1h) & hi[bb - 1];
                unsigned x1 = (unsigned)__popc(o1l) + (unsigned)__popc(o1h), x11 = (unsigned)__popc(o11l) + (unsigned)__popc(o11h), x01 = (unsigned)__popc(o01l) + (unsigned)__popc(o01h);
                x1 += DPP_U32(x1, 0xB1); x11 += DPP_U32(x11, 0xB1); x01 += DPP_U32(x01, 0xB1);
                x1 += DPP_U32(x1, 0x4E); x11 += DPP_U32(x11, 0x4E); x01 += DPP_U32(x01, 0x4E);
                x1 += DPP_U32(x1, 0x124); x11 += DPP_U32(x11, 0x124); x01 += DPP_U32(x01, 0x124);
                x1 += DPP_U32(x1, 0x128); x11 += DPP_U32(x11, 0x128); x01 += DPP_U32(x01, 0x128);
                x1 += (unsigned)__builtin_amdgcn_update_dpp(0, (int)x1, 0x142, 0xA, 0xF, false); x11 += (unsigned)__builtin_amdgcn_update_dpp(0, (int)x11, 0x142, 0xA, 0xF, false); x01 += (unsigned)__builtin_amdgcn_update_dpp(0, (int)x01, 0x142, 0xA, 0xF, false);
                x1 += (unsigned)__builtin_amdgcn_update_dpp(0, (int)x1, 0x143, 0xC, 0xF, false); x11 += (unsigned)__builtin_amdgcn_update_dpp(0, (int)x11, 0x143, 0xC, 0xF, false); x01 += (unsigned)__builtin_amdgcn_update_dpp(0, (int)x01, 0x143, 0xC, 0xF, false);
                const unsigned c1 = G + (unsigned)__builtin_amdgcn_readlane((int)x1, 63), n11 = (unsigned)__builtin_amdgcn_readlane((int)x11, 63), n01 = (unsigned)__builtin_amdgcn_readlane((int)x01, 63);
                if (c1 >= 256u) {
                    al = o1l; ah = o1h;
                    if (c1 == 256u) done = true;
                    else {
                        const unsigned c = G + n11;
                        if (c >= 256u) { al = o11l; ah = o11h; done = (c == 256u); }
                        else { gl |= o11l; gh |= o11h; G = c; al ^= o11l; ah ^= o11h; }
                    }
                } else {
                    gl |= o1l; gh |= o1h; G = c1; al ^= o1l; ah ^= o1h;
                    const unsigned c = G + n01;
                    if (c >= 256u) { al = o01l; ah = o01h; done = (c == 256u); }
                    else { gl |= o01l; gh |= o01h; G = c; al ^= o01l; ah ^= o01h; }
                }
            }
        }
        const unsigned ca = (unsigned)__popc(al) + (unsigned)__popc(ah);
        const unsigned tot = wave_sum_u32(ca);
        unsigned long long alive = ((unsigned long long)ah << 32) | al;
        if (G + tot > 256u) {
            const int incl = wave_incl_scan_i((int)ca, lane);
            const int before = incl - (int)ca, room = (int)(256u - G) - before;
            int take = room < 0 ? 0 : (room > (int)ca ? (int)ca : room);
            unsigned long long keep = 0ull;
            while (__any(take > 0)) { if (take > 0) { const unsigned long long low = alive & (0ull - alive); keep |= low; alive ^= low; --take; } }
            alive = keep;
        }
        selm = (((unsigned long long)gh << 32) | gl) | alive;
    }
#if USE_LIST
    if (t >= 256) {
        LAS unsigned short* lb = (LAS unsigned short*)(C.lds + MISC_OFF + 1024) + (C.wave & 3) * 256;
        unsigned w0 = (unsigned)selm, w1 = (unsigned)(selm >> 32);
        const int c = __popc(w0) + __popc(w1); const int incl = wave_incl_scan_i(c, lane); int pos = incl - c;
        while (w0) { const int bit = __ffs(w0) - 1; w0 &= w0 - 1; if (pos < 256) lb[pos] = (unsigned short)(64 * lane + bit); ++pos; }
        while (w1) { const int bit = __ffs(w1) - 1; w1 &= w1 - 1; if (pos < 256) lb[pos] = (unsigned short)(64 * lane + 32 + bit); ++pos; }
        asm volatile("" ::: "memory");
        const v2u e = *(const LAS v2u*)(lb + 4 * lane);
        *(v2u*)((unsigned short*)SEL + (size_t)(b * SEQ + t) * 256 + 4 * lane) = e;
        asm volatile("" ::: "memory");
    }
#else
    if (64 * lane <= t) *(unsigned long long*)(SEL + (size_t)(b * SEQ + t) * 128 + 2 * lane) = selm;
#endif
}

__device__ __forceinline__ void ph_dsa_b2_wave(Ctx& C, int b, int t4) {
    const bf16* PROJ = (const bf16*)(C.ws + WS_P); const unsigned* SEL = (const unsigned*)(C.ws + WS_SEL); bf16* YM = (bf16*)(C.ws + WS_H);
    const bf16* KFA = (const bf16*)(C.ws + WS_KFA); const bf16* VF = (const bf16*)(C.ws + WS_VF);
    const int lane = C.lane, n = lane & 31, h = lane >> 5, tl = n >> 3, hd = n & 7;
    const int ntile = ((t4 + 3) >> 5) + 1;
    const size_t qrow = (size_t)b * SEQ + t4 + tl;
    bf16x8 qf[5];
    {
        const bf16* qp = PROJ + qrow * PW + C_AQ + hd * 64 + 8 * h;
#pragma unroll
        for (int ks = 0; ks < 4; ++ks) {
            const v4u q4 = *(const v4u*)(qp + 16 * ks); const unsigned qw[4] = {q4.x, q4.y, q4.z, q4.w}; v4u o;
            unsigned ow[4];
#pragma unroll
            for (int x = 0; x < 4; ++x) ow[x] = pk2(bf2f(qw[x] & 0xffffu) * (0.125f * LOG2E), bf2f(qw[x] >> 16) * (0.125f * LOG2E));
            o.x = ow[0]; o.y = ow[1]; o.z = ow[2]; o.w = ow[3]; qf[ks] = __builtin_bit_cast(bf16x8, o);
        }
        const unsigned one = 0x3f80u, sl = f2bf(exp2f(-(float)(hd + 1)));
        v4u e; e.x = (tl == 0 ? one : 0u) | ((tl == 1 ? one : 0u) << 16); e.y = (tl == 2 ? one : 0u) | ((tl == 3 ? one : 0u) << 16); e.z = sl | (sl << 16); e.w = sl;
        if (h) { e.x = 0u; e.y = 0u; e.z = 0u; e.w = 0u; }
        qf[4] = __builtin_bit_cast(bf16x8, e);
    }
    f32x16 O0, O1;
#pragma unroll
    for (int x = 0; x < 16; ++x) { O0[x] = 0.f; O1[x] = 0.f; }
    float m = -3.0e38f, lsum = 0.f;
    const unsigned NEGB = 0xf149u;
    const bf16* kb = KFA + (size_t)(b * 128) * 2048 + lane * 8; const bf16* vb = VF + (size_t)(b * 128) * 2048 + lane * 8;
    const unsigned* selp = SEL + ((size_t)b * SEQ + t4 + (lane & 3)) * 128;
    bf16x8 kc[4], vc[4]; unsigned wc_;
#pragma unroll
    for (int ks = 0; ks < 4; ++ks) { kc[ks] = *(const bf16x8*)(kb + ks * 512); vc[ks] = *(const bf16x8*)(vb + ks * 512); }
    wc_ = selp[0];
    for (int tile = 0; tile < ntile; ++tile) {
        bf16x8 kn[4], vn[4]; unsigned wn = 0u;
        const int tn = (tile + 1 < ntile) ? tile + 1 : tile;
#pragma unroll
        for (int ks = 0; ks < 4; ++ks) { kn[ks] = *(const bf16x8*)(kb + (size_t)tn * 2048 + ks * 512); vn[ks] = *(const bf16x8*)(vb + (size_t)tn * 2048 + ks * 512); }
        wn = selp[tn];
        bf16x8 kx;
        {
            const unsigned w0 = (unsigned)__builtin_amdgcn_readlane((int)wc_, 0), w1 = (unsigned)__builtin_amdgcn_readlane((int)wc_, 1), w2 = (unsigned)__builtin_amdgcn_readlane((int)wc_, 2), w3 = (unsigned)__builtin_amdgcn_readlane((int)wc_, 3);
            const unsigned m0 = ((w0 >> n) & 1u) ? 0u : NEGB, m1 = ((w1 >> n) & 1u) ? 0u : NEGB, m2 = ((w2 >> n) & 1u) ? 0u : NEGB, m3 = ((w3 >> n) & 1u) ? 0u : NEGB;
            const float cs = LOG2E * (float)(tile * 32 + n);
            const unsigned c1 = f2bf(cs); const float r1 = cs - bf2f(c1); const unsigned c2 = f2bf(r1); const float r2 = r1 - bf2f(c2); const unsigned c3 = f2bf(r2);
            v4u e; e.x = m0 | (m1 << 16); e.y = m2 | (m3 << 16); e.z = c1 | (c2 << 16); e.w = c3;
            if (h) { e.x = 0u; e.y = 0u; e.z = 0u; e.w = 0u; }
            kx = __builtin_bit_cast(bf16x8, e);
        }
        f32x16 S;
#pragma unroll
        for (int x = 0; x < 16; ++x) S[x] = 0.f;
#pragma unroll
        for (int ks = 0; ks < 4; ++ks) S = mfma32(kc[ks], qf[ks], S);
        S = mfma32(kx, qf[4], S);
        float mloc = S[0];
#pragma unroll
        for (int x = 1; x < 16; ++x) mloc = fmaxf(mloc, S[x]);
        mloc = fmaxf(mloc, __shfl_xor(mloc, 32));
        const float mnew = fmaxf(m, mloc), alpha = __builtin_amdgcn_exp2f(m - mnew);
        m = mnew;
        float ps = 0.f;
#pragma unroll
        for (int x = 0; x < 16; ++x) { S[x] = __builtin_amdgcn_exp2f(S[x] - mnew); ps += S[x]; }
        lsum = lsum * alpha + ps;
#pragma unroll
        for (int x = 0; x < 16; ++x) { O0[x] *= alpha; O1[x] *= alpha; }
        v4u p0, p1;
        p0.x = pk2(S[0], S[1]); p0.y = pk2(S[2], S[3]); p0.z = pk2(S[4], S[5]); p0.w = pk2(S[6], S[7]);
        p1.x = pk2(S[8], S[9]); p1.y = pk2(S[10], S[11]); p1.z = pk2(S[12], S[13]); p1.w = pk2(S[14], S[15]);
        const bf16x8 pf0 = __builtin_bit_cast(bf16x8, p0), pf1 = __builtin_bit_cast(bf16x8, p1);
        O0 = mfma32(vc[0], pf0, O0); O1 = mfma32(vc[1], pf0, O1);
        O0 = mfma32(vc[2], pf1, O0); O1 = mfma32(vc[3], pf1, O1);
#pragma unroll
        for (int ks = 0; ks < 4; ++ks) { kc[ks] = kn[ks]; vc[ks] = vn[ks]; }
        wc_ = wn;
    }
    const float inv = 1.f / (lsum + __shfl_xor(lsum, 32));
    bf16* yo = YM + qrow * DM + hd * 64 + 4 * h;
#pragma unroll
    for (int j4 = 0; j4 < 4; ++j4) {
        v2u o; o.x = pk2(O0[4 * j4] * inv, O0[4 * j4 + 1] * inv); o.y = pk2(O0[4 * j4 + 2] * inv, O0[4 * j4 + 3] * inv);
        *(v2u*)(yo + 8 * j4) = o;
        v2u o2; o2.x = pk2(O1[4 * j4] * inv, O1[4 * j4 + 1] * inv); o2.y = pk2(O1[4 * j4 + 2] * inv, O1[4 * j4 + 3] * inv);
        *(v2u*)(yo + 32 + 8 * j4) = o2;
    }
}

__device__ __forceinline__ f32x4 mfma16(bf16x8 a, bf16x8 b, f32x4 c) { return __builtin_amdgcn_mfma_f32_16x16x32_bf16(a, b, c, 0, 0, 0); }
constexpr int B3_VS_PITCH = 144;
constexpr int B3_WAVE_LDS = 640 + 32 * B3_VS_PITCH;
#ifdef PROBE_HOT
#define B3_SKIP(bit) ((PROBE_SKIP & (bit)) && C.hot != 0xffff)
#define B3_HOTMASK C.hot
#else
#define B3_SKIP(bit) false
#define B3_HOTMASK 0xffff
#endif
template <bool FULL>
__device__ __forceinline__ void b3_core(Ctx& C, int b, int t, int nsel, const v4u qc0, const v4u qc1, LAS unsigned short* lst, LAS unsigned char* vs) {
    const bf16* PROJ = (const bf16*)(C.ws + WS_P); bf16* YM = (bf16*)C.out;
    const int lane = C.lane, m16 = lane & 15, g = lane >> 4;
    const size_t row = (size_t)b * SEQ + t;
    const int nt16 = FULL ? 16 : (nsel + 15) >> 4, nk32 = FULL ? 8 : (nsel + 31) >> 5;
    const bf16* vbase = PROJ + (size_t)b * SEQ * PW + C_AV + 8 * (lane & 7); const bf16* kbase = PROJ + (size_t)b * SEQ * PW + C_AK + 8 * g;
    v4u vb[3][4];
#pragma unroll
    for (int i = 0; i < 4; ++i) { const int s = (int)lst[8 * i + (lane >> 3)] & B3_HOTMASK; vb[0][i] = *(const v4u*)(vbase + (size_t)s * PW); }
    bf16x8 qf[2];
#pragma unroll
    for (int ks = 0; ks < 2; ++ks) {
        const v4u q4 = ks ? qc1 : qc0; const unsigned qw[4] = {q4.x, q4.y, q4.z, q4.w}; unsigned ow[4];
#pragma unroll
        for (int x = 0; x < 4; ++x) ow[x] = (m16 < 8) ? pk2(bf2f(qw[x] & 0xffffu) * (0.125f * LOG2E), bf2f(qw[x] >> 16) * (0.125f * LOG2E)) : 0u;
        v4u o; o.x = ow[0]; o.y = ow[1]; o.z = ow[2]; o.w = ow[3]; qf[ks] = __builtin_bit_cast(bf16x8, o);
    }
    const float sl2 = exp2f(-(float)((m16 & 7) + 1)) * LOG2E, tf = (float)t;
    f32x4 lg[16];
    bf16x8 a0[2][4], a1[2][4];
#define B3_GATHER(buf, hf_) { _Pragma("unroll") for (int i = 0; i < 4; ++i) { const int sm_k = ((FULL || 4 * (hf_) + i < nt16) ? (int)lst[16 * (4 * (hf_) + i) + m16] : 0) & B3_HOTMASK; \
        const bf16* kp = kbase + (size_t)sm_k * PW; a0[buf][i] = *(const bf16x8*)kp; a1[buf][i] = *(const bf16x8*)(kp + 32); } }
    if (!B3_SKIP(4)) { B3_GATHER(0, 0) B3_GATHER(1, 1) }
#pragma unroll
    for (int kt = 0; kt < 16; ++kt) {
        if (FULL || kt < nt16) {
            const v2u p4 = *(const LAS v2u*)(lst + 16 * kt + 4 * g);
            const float sr[4] = {(float)(p4.x & 0xffffu), (float)(p4.x >> 16), (float)(p4.y & 0xffffu), (float)(p4.y >> 16)};
#pragma unroll
            for (int r = 0; r < 4; ++r) lg[kt][r] = (FULL || 16 * kt + 4 * g + r < nsel) ? sl2 * (sr[r] - tf) : -3.0e38f;
        } else lg[kt] = (f32x4){-3.0e38f, -3.0e38f, -3.0e38f, -3.0e38f};
    }
#pragma unroll
    for (int hf = 0; hf < 4; ++hf) {
        if (!B3_SKIP(2)) {
#pragma unroll
            for (int i = 0; i < 4; ++i) if (FULL || 4 * hf + i < nt16) lg[4 * hf + i] = mfma16(a0[hf & 1][i], qf[0], lg[4 * hf + i]);
#pragma unroll
            for (int i = 0; i < 4; ++i) if (FULL || 4 * hf + i < nt16) lg[4 * hf + i] = mfma16(a1[hf & 1][i], qf[1], lg[4 * hf + i]);
        }
        if (!B3_SKIP(4)) { if (hf == 0) B3_GATHER(0, 2) if (hf == 1) B3_GATHER(1, 3) }
    }
    float mx;
    {
        float m0 = -3.0e38f, m1 = -3.0e38f, m2 = -3.0e38f, m3 = -3.0e38f;
#pragma unroll
        for (int kt = 0; kt < 16; ++kt) { m0 = fmaxf(m0, lg[kt][0]); m1 = fmaxf(m1, lg[kt][1]); m2 = fmaxf(m2, lg[kt][2]); m3 = fmaxf(m3, lg[kt][3]); }
        mx = fmaxf(fmaxf(m0, m1), fmaxf(m2, m3));
    }
#undef B3_GATHER
#pragma unroll
    for (int d = 1; d < 3; ++d) if (FULL || d < nk32) {
#pragma unroll
        for (int i = 0; i < 4; ++i) { const int s = (int)lst[32 * d + 8 * i + (lane >> 3)] & B3_HOTMASK; vb[d][i] = *(const v4u*)(vbase + (size_t)s * PW); }
    }
    mx = fmaxf(mx, SHX_F(mx, 16, lane)); mx = fmaxf(mx, SHX_F(mx, 32, lane));
    float sm_;
    {
        float s0 = 0.f, s1 = 0.f, s2 = 0.f, s3 = 0.f;
#pragma unroll
        for (int kt = 0; kt < 16; ++kt) {
            if (FULL || kt < nt16) {
                const float p0 = __builtin_amdgcn_exp2f(lg[kt][0] - mx), p1 = __builtin_amdgcn_exp2f(lg[kt][1] - mx), p2 = __builtin_amdgcn_exp2f(lg[kt][2] - mx), p3 = __builtin_amdgcn_exp2f(lg[kt][3] - mx);
                lg[kt] = (f32x4){p0, p1, p2, p3}; s0 += p0; s1 += p1; s2 += p2; s3 += p3;
            } else lg[kt] = (f32x4){0.f, 0.f, 0.f, 0.f};
        }
        sm_ = (s0 + s1) + (s2 + s3);
    }
    sm_ += SHX_F(sm_, 16, lane); sm_ += SHX_F(sm_, 32, lane);
    const float inv = 1.f / sm_;
    v4u pbk[8];
#pragma unroll
    for (int kk = 0; kk < 8; ++kk) { pbk[kk].x = pk2(lg[2 * kk][0], lg[2 * kk][1]); pbk[kk].y = pk2(lg[2 * kk][2], lg[2 * kk][3]); pbk[kk].z = pk2(lg[2 * kk + 1][0], lg[2 * kk + 1][1]); pbk[kk].w = pk2(lg[2 * kk + 1][2], lg[2 * kk + 1][3]); }
    f32x4 O[4];
#pragma unroll
    for (int i = 0; i < 4; ++i) O[i] = (f32x4){0.f, 0.f, 0.f, 0.f};
#pragma unroll
    for (int kk = 0; kk < 8; ++kk) if ((FULL || kk < nk32) && !B3_SKIP(1)) {
#pragma unroll
        for (int i = 0; i < 4; ++i) *(LAS v4u*)(vs + (8 * i + (lane >> 3)) * B3_VS_PITCH + (lane & 7) * 16) = vb[kk % 3][i];
        if (kk >= 1 && kk + 2 < 8 && (FULL || kk + 2 < nk32)) {
#pragma unroll
            for (int i = 0; i < 4; ++i) { const int s = (int)lst[32 * (kk + 2) + 8 * i + (lane >> 3)] & B3_HOTMASK; vb[(kk + 2) % 3][i] = *(const v4u*)(vbase + (size_t)s * PW); }
        }
        asm volatile("s_waitcnt lgkmcnt(0)" ::: "memory");
        const bf16x8 pB = __builtin_bit_cast(bf16x8, pbk[kk]);
#pragma unroll
        for (int u = 0; u < 2; ++u) {
            unsigned w[8];
#pragma unroll
            for (int j = 0; j < 8; ++j) { const int sl = (j < 4) ? 4 * g + j : 16 + 4 * g + (j - 4); w[j] = *(const LAS unsigned*)(vs + sl * B3_VS_PITCH + (32 * u + 2 * m16) * 2); }
            v4u ae, ao;
            ae.x = (w[0] & 0xffffu) | (w[1] << 16); ae.y = (w[2] & 0xffffu) | (w[3] << 16); ae.z = (w[4] & 0xffffu) | (w[5] << 16); ae.w = (w[6] & 0xffffu) | (w[7] << 16);
            ao.x = (w[0] >> 16) | (w[1] & 0xffff0000u); ao.y = (w[2] >> 16) | (w[3] & 0xffff0000u); ao.z = (w[4] >> 16) | (w[5] & 0xffff0000u); ao.w = (w[6] >> 16) | (w[7] & 0xffff0000u);
            O[2 * u] = mfma16(__builtin_bit_cast(bf16x8, ae), pB, O[2 * u]); O[2 * u + 1] = mfma16(__builtin_bit_cast(bf16x8, ao), pB, O[2 * u + 1]);
        }
    }
    if (m16 < 8) {
#pragma unroll
        for (int u = 0; u < 2; ++u) {
            v4u o; o.x = pk2(O[2 * u][0] * inv, O[2 * u + 1][0] * inv); o.y = pk2(O[2 * u][1] * inv, O[2 * u + 1][1] * inv); o.z = pk2(O[2 * u][2] * inv, O[2 * u + 1][2] * inv); o.w = pk2(O[2 * u][3] * inv, O[2 * u + 1][3] * inv);
            *(v4u*)(YM + row * DM + m16 * 64 + 32 * u + 8 * g) = o;
        }
    }
}
__device__ __forceinline__ void ph_dsa_b3_wave(Ctx& C, int b, int t4) {
    LAS unsigned short* lst = (LAS unsigned short*)(C.lds + C.wave * B3_WAVE_LDS);
    LAS unsigned char* vs = C.lds + C.wave * B3_WAVE_LDS + 640;
    const bf16* PROJ = (const bf16*)(C.ws + WS_P); const unsigned* SEL = (const unsigned*)(C.ws + WS_SEL);
    const int lane = C.lane, m16 = lane & 15, g = lane >> 4;
#if USE_LIST
    v2u lqn; v4u qn0, qn1;
#define B3_PREFETCH(tq) { const size_t r_ = (size_t)b * SEQ + (tq); \
        lqn = ((tq) >= 256) ? *(const v2u*)((const unsigned short*)SEL + r_ * 256 + 4 * lane) : (v2u){0u, 0u}; \
        const bf16* qp_ = PROJ + r_ * PW + C_AQ + (m16 & 7) * 64 + 8 * g; qn0 = *(const v4u*)qp_; qn1 = *(const v4u*)(qp_ + 32); }
    B3_PREFETCH(t4)
#pragma unroll 1
    for (int qi = 0; qi < 4; ++qi) {
        const int t = t4 + qi;
        v2u lq = lqn;
        const v4u qc0 = qn0, qc1 = qn1;
        if (qi < 3) B3_PREFETCH(t + 1)
        const int nsel = t < 256 ? t + 1 : 256;
        if (t < 256) { const int i0 = 4 * lane; lq.x = (unsigned)(i0 <= t ? i0 : 0) | ((unsigned)(i0 + 1 <= t ? i0 + 1 : 0) << 16); lq.y = (unsigned)(i0 + 2 <= t ? i0 + 2 : 0) | ((unsigned)(i0 + 3 <= t ? i0 + 3 : 0) << 16); }
        *(LAS v2u*)(lst + 4 * lane) = lq;
        if (lane < 16) *(LAS unsigned*)(lst + 256 + 2 * lane) = 0u;
        asm volatile("s_waitcnt lgkmcnt(0)" ::: "memory");
        if (nsel == 256) b3_core<true>(C, b, t, nsel, qc0, qc1, lst, vs); else b3_core<false>(C, b, t, nsel, qc0, qc1, lst, vs);
    }
#undef B3_PREFETCH
#else
    unsigned w0n, w1n; v4u qn0, qn1;
#define B3_PREFETCH(tq) { const size_t r_ = (size_t)b * SEQ + (tq); const int nw_ = ((tq) >> 5) + 1; \
        w0n = (2 * lane < nw_) ? SEL[r_ * 128 + 2 * lane] : 0u; w1n = (2 * lane + 1 < nw_) ? SEL[r_ * 128 + 2 * lane + 1] : 0u; \
        const bf16* qp_ = PROJ + r_ * PW + C_AQ + (m16 & 7) * 64 + 8 * g; qn0 = *(const v4u*)qp_; qn1 = *(const v4u*)(qp_ + 32); }
    B3_PREFETCH(t4)
#pragma unroll 1
    for (int qi = 0; qi < 4; ++qi) {
        const int t = t4 + qi;
        unsigned w0 = w0n, w1 = w1n;
        const v4u qc0 = qn0, qc1 = qn1;
        if (qi < 3) B3_PREFETCH(t + 1)
        int nsel;
        {
            const int c = __popc(w0) + __popc(w1); const int incl = wave_incl_scan_i(c, lane);
            int pos = incl - c; const int tot = __builtin_amdgcn_readlane(incl, 63);
            while (w0) { const int bit = __ffs(w0) - 1; w0 &= w0 - 1; if (pos < 256) lst[pos] = (unsigned short)(64 * lane + bit); ++pos; }
            while (w1) { const int bit = __ffs(w1) - 1; w1 &= w1 - 1; if (pos < 256) lst[pos] = (unsigned short)(64 * lane + 32 + bit); ++pos; }
            nsel = tot < 256 ? tot : 256;
            if (lane < 32 && nsel + lane < 288) lst[nsel + lane] = 0;
        }
        asm volatile("s_waitcnt lgkmcnt(0)" ::: "memory");
        if (nsel == 256) b3_core<true>(C, b, t, nsel, qc0, qc1, lst, vs); else b3_core<false>(C, b, t, nsel, qc0, qc1, lst, vs);
    }
#undef B3_PREFETCH
#endif
}

namespace pg8 {
constexpr int BM = 256, BK = 64, HALF = 128, HTB = HALF * BK * 2, STAGE_BYTES = 8 * HTB, NXCD = 8, WGM = 8;
__host__ __device__ __forceinline__ int lds_byte(int r, int c) { const int st = (r >> 4) * 2 + (c >> 5), rr = r & 15, cc = c & 31, ob = rr * 64 + cc * 2; return st * 1024 + (ob ^ (((ob >> 9) & 1) << 5)); }
__host__ __device__ __forceinline__ void stage_rc(int b, int& R, int& C) { const int st = b / 1024, sb = b % 1024, swz = sb ^ (((sb >> 9) & 1) << 5); R = (st >> 1) * 16 + swz / 64; C = (st & 1) * 32 + (swz % 64) / 2; }
__host__ __device__ __forceinline__ int perm32(int rho) { const int n = rho >> 4, i = rho & 15; return 8 * (i >> 2) + 4 * n + (i & 3); }

struct Unit { int pm, pn, po, eb; };
struct Gemm { const bf16* A; const bf16* Bt; int K; size_t ebytes; const int* rowsrc = nullptr; };

struct Order {
    int nM, nN, nwg, G, c, p_lo, amode; const LAS unsigned char* pe;
    __device__ __forceinline__ void init(int nM_, int nN_, int G_, int c_, int p_lo_, int amode_, const LAS unsigned char* pe_) { nM = nM_; nN = nN_; nwg = nM * nN; G = G_; c = c_; p_lo = p_lo_; amode = amode_; pe = pe_; }
    __device__ __forceinline__ bool next(int i, Unit& u) const {
        const long L = (long)i * G + c; if (L >= nwg) return false;
        int wgid = (int)L; { const int q = nwg / NXCD, r = nwg % NXCD, xcd = wgid % NXCD, off = wgid / NXCD; wgid = (xcd < r ? xcd * (q + 1) : r * (q + 1) + (xcd - r) * q) + off; }
        const int nig = WGM * nN, gid = wgid / nig, fm = gid * WGM, gsz = (nM - fm) < WGM ? (nM - fm) : WGM;
        const int lp = fm + ((wgid % nig) % gsz), gp = p_lo + lp; u.pn = (wgid % nig) / gsz;
        u.pm = amode == 0 ? gp : lp; u.po = amode == 0 ? lp : gp; u.eb = pe ? __builtin_amdgcn_readfirstlane((int)pe[gp]) : 0; return true;
    }
};

__device__ __forceinline__ unsigned cvt_pk_bf16(float lo, float hi) { unsigned r; asm volatile("v_cvt_pk_bf16_f32 %0, %1, %2" : "=v"(r) : "v"(lo), "v"(hi)); return r; }
__device__ __forceinline__ float silu_fast(float g) { return g * __builtin_amdgcn_rcpf(1.f + __builtin_amdgcn_exp2f(-g * LOG2E)); }

struct EpiBf16 {
    static constexpr bool PERM = true;
    bf16* O; int ldc;
    __device__ __forceinline__ void operator()(const f32x4 (&acc)[2][2][4][2], const Unit& u, int wr, int wc, int fr, int fq) const {
        const int row0 = u.po * BM + wr * 64 + fr, col0 = u.pn * BM + wc * 32 + 8 * fq;
#pragma unroll
        for (int ai = 0; ai < 2; ++ai)
#pragma unroll
            for (int m = 0; m < 4; ++m) { bf16* rowp = O + (size_t)(row0 + ai * HALF + m * 16) * ldc + col0;
#pragma unroll
                for (int bj = 0; bj < 2; ++bj) { const f32x4 v0 = acc[ai][bj][m][0], v1 = acc[ai][bj][m][1];
                    v4u w; w.x = cvt_pk_bf16(v0[0], v0[1]); w.y = cvt_pk_bf16(v0[2], v0[3]); w.z = cvt_pk_bf16(v1[0], v1[1]); w.w = cvt_pk_bf16(v1[2], v1[3]);
                    *(v4u*)(rowp + bj * HALF) = w; } }
    }
};
struct EpiProj {
    static constexpr bool PERM = true;
    bf16* O; bf16* KFA; bf16* KFI; bf16* VF;
    __device__ __forceinline__ void operator()(const f32x4 (&acc)[2][2][4][2], const Unit& u, int wr, int wc, int fr, int fq) const {
        const int row0 = u.po * BM + wr * 64 + fr, col0 = u.pn * BM + wc * 32 + 8 * fq;
#pragma unroll
        for (int ai = 0; ai < 2; ++ai)
#pragma unroll
            for (int m = 0; m < 4; ++m) { const int row = row0 + ai * HALF + m * 16; bf16* rowp = O + (size_t)row * PW + col0;
#pragma unroll
                for (int bj = 0; bj < 2; ++bj) { const f32x4 v0 = acc[ai][bj][m][0], v1 = acc[ai][bj][m][1];
                    v4u w; w.x = cvt_pk_bf16(v0[0], v0[1]); w.y = cvt_pk_bf16(v0[2], v0[3]); w.z = cvt_pk_bf16(v1[0], v1[1]); w.w = cvt_pk_bf16(v1[2], v1[3]);
                    *(v4u*)(rowp + bj * HALF) = w;
                    if (u.pn == 10) {
                        if (wc < 2) {
                            const int dc = 4 * wc + fq;
                            bf16* kf = (bj == 0 ? KFA : KFI) + ((size_t)(row >> 5) * 4 + (dc >> 1)) * 512 + (32 * (dc & 1) + (row & 31)) * 8;
                            *(v4u*)kf = w;
                        } else if (bj == 0) {
                            const int kap = row & 31, mf = kap >> 4, k15 = kap & 15, hh = (k15 >> 2) & 1, j = (k15 & 3) + 4 * (k15 >> 3);
                            bf16* vf = VF + ((((size_t)(row >> 5) * 2 + mf) * 2 + (wc - 2)) * 64 + 32 * hh + 8 * fq) * 8 + j;
                            vf[0 * 8] = (bf16)(w.x & 0xffffu); vf[1 * 8] = (bf16)(w.x >> 16); vf[2 * 8] = (bf16)(w.y & 0xffffu); vf[3 * 8] = (bf16)(w.y >> 16);
                            vf[4 * 8] = (bf16)(w.z & 0xffffu); vf[5 * 8] = (bf16)(w.z >> 16); vf[6 * 8] = (bf16)(w.w & 0xffffu); vf[7 * 8] = (bf16)(w.w >> 16);
                        }
                    } } }
    }
};
struct EpiGate {
    static constexpr bool PERM = true;
    bf16* O; const float* gate;
    __device__ __forceinline__ void operator()(const f32x4 (&acc)[2][2][4][2], const Unit& u, int wr, int wc, int fr, int fq) const {
        const int row0 = u.po * BM + wr * 64 + fr, col0 = u.pn * BM + wc * 32 + 8 * fq;
#pragma unroll
        for (int ai = 0; ai < 2; ++ai)
#pragma unroll
            for (int m = 0; m < 4; ++m) { const int row = row0 + ai * HALF + m * 16; const float g = gate ? gate[row] : 1.f; bf16* rowp = O + (size_t)row * DM + col0;
#pragma unroll
                for (int bj = 0; bj < 2; ++bj) { const f32x4 v0 = acc[ai][bj][m][0] * g, v1 = acc[ai][bj][m][1] * g;
                    v4u w; w.x = cvt_pk_bf16(v0[0], v0[1]); w.y = cvt_pk_bf16(v0[2], v0[3]); w.z = cvt_pk_bf16(v1[0], v1[1]); w.w = cvt_pk_bf16(v1[2], v1[3]);
                    *(v4u*)(rowp + bj * HALF) = w; } }
    }
};
struct EpiSwiglu {
    static constexpr bool PERM = true;
    bf16* O;
    __device__ __forceinline__ void operator()(const f32x4 (&acc)[2][2][4][2], const Unit& u, int wr, int wc, int fr, int fq) const {
        const int row0 = u.po * BM + wr * 64 + fr, col0 = u.pn * HALF + wc * 32 + 8 * fq;
#pragma unroll
        for (int ai = 0; ai < 2; ++ai)
#pragma unroll
            for (int m = 0; m < 4; ++m) { bf16* rowp = O + (size_t)(row0 + ai * HALF + m * 16) * DFF + col0;
                const f32x4 g0 = acc[ai][0][m][0], g1 = acc[ai][0][m][1], u0 = acc[ai][1][m][0], u1 = acc[ai][1][m][1];
                v4u w; w.x = cvt_pk_bf16(silu_fast(g0[0]) * u0[0], silu_fast(g0[1]) * u0[1]); w.y = cvt_pk_bf16(silu_fast(g0[2]) * u0[2], silu_fast(g0[3]) * u0[3]);
                w.z = cvt_pk_bf16(silu_fast(g1[0]) * u1[0], silu_fast(g1[1]) * u1[1]); w.w = cvt_pk_bf16(silu_fast(g1[2]) * u1[2], silu_fast(g1[3]) * u1[3]);
                *(v4u*)rowp = w; }
    }
};

template <class Epi, class Sched>
__device__ __forceinline__ void gemm_phase(LAS unsigned char* lds, const int tid, const Gemm g, const Sched& S, const Epi& E) {
    const int wid = __builtin_amdgcn_readfirstlane(tid >> 6), lane = tid & 63, wr = wid >> 2, wc = wid & 3, fr = lane & 15, fq = lane >> 4;
    const int K = g.K, nt = K / BK;
    unsigned voffB[2]; int RA[2]; unsigned cA2[2];
#pragma unroll
    for (int i = 0; i < 2; ++i) { int R, C; stage_rc(tid * 16 + i * 8192, R, C); const int Rb = Epi::PERM ? ((R & ~31) + perm32(R & 31)) : R; RA[i] = R; cA2[i] = (unsigned)C * 2u; voffB[i] = (unsigned)(Rb * K + C) * 2u; }
    unsigned voffG[2][2], voffN[2][2];
#define PG8_ROWS(dst, pm_) do { _Pragma("unroll") for (int hh_ = 0; hh_ < 2; ++hh_) _Pragma("unroll") for (int ii_ = 0; ii_ < 2; ++ii_) { const int pr_ = (pm_) * BM + hh_ * HALF + RA[ii_]; \
        const unsigned gr_ = g.rowsrc ? (unsigned)g.rowsrc[pr_] : (unsigned)pr_; dst[hh_][ii_] = gr_ * (unsigned)(K * 2) + cA2[ii_]; } } while (0)
    const size_t kstep = (size_t)(BK * 2);
    const size_t hstep = (size_t)HALF * K * 2;
    const size_t tstep = 2 * hstep;
    const unsigned ldsw = (unsigned)wid * 1024u;
    const int aoff = lds_byte(wr * 64 + fr, fq * 8), boff = lds_byte(wc * 32 + fr, fq * 8);
#define PG8_SA(b, h) (((b) * 2 + (h)) * HTB)
#define PG8_SB(b, h) ((4 + (b) * 2 + (h)) * HTB)
#define PG8_STAGE(bufoff, gbase, voff) do { _Pragma("unroll") for (int _i = 0; _i < 2; ++_i) \
        __builtin_amdgcn_global_load_lds((const unsigned*)((const char*)(gbase) + (voff)[_i]), (LAS unsigned*)(lds + (bufoff) + ldsw + _i * 8192), 16, 0, 0); } while (0)
#define PG8_STAGEA(bufoff, kbase, vo) do { _Pragma("unroll") for (int _i = 0; _i < 2; ++_i) \
        __builtin_amdgcn_global_load_lds((const unsigned*)((const char*)(kbase) + (vo)[_i]), (LAS unsigned*)(lds + (bufoff) + ldsw + _i * 8192), 16, 0, 0); } while (0)
#define PG8_LDA(dst, b, h) do { _Pragma("unroll") for (int m = 0; m < 4; ++m) _Pragma("unroll") for (int k = 0; k < 2; ++k) dst[m][k] = *(const LAS bf16x8*)(lds + PG8_SA(b, h) + aoff + m * 2048 + k * 1024); } while (0)
#define PG8_LDB(dst, b, h) do { _Pragma("unroll") for (int n = 0; n < 2; ++n) _Pragma("unroll") for (int k = 0; k < 2; ++k) dst[n][k] = *(const LAS bf16x8*)(lds + PG8_SB(b, h) + boff + n * 2048 + k * 1024); } while (0)
#define PG8_MMA(ai, bj, At, Bt) do { __builtin_amdgcn_s_setprio(1); _Pragma("unroll") for (int m = 0; m < 4; ++m) _Pragma("unroll") for (int n = 0; n < 2; ++n) _Pragma("unroll") for (int k = 0; k < 2; ++k) \
        acc[ai][bj][m][n] = __builtin_amdgcn_mfma_f32_16x16x32_bf16(Bt[n][k], At[m][k], acc[ai][bj][m][n], 0, 0, 0); __builtin_amdgcn_s_setprio(0); } while (0)
#define PG8_WAIT_V(n) asm volatile("s_waitcnt vmcnt(" #n ")" ::: "memory")
#define PG8_WAIT_L(n) asm volatile("s_waitcnt lgkmcnt(" #n ")" ::: "memory")
#define PG8_BAR __builtin_amdgcn_s_barrier()
#define PG8_SCHED __builtin_amdgcn_sched_barrier(0)
    Unit cur, nxt; int ui = 0;
    if (!S.next(0, cur)) return;
    f32x4 acc[2][2][4][2];
#pragma unroll
    for (int a = 0; a < 2; ++a)
#pragma unroll
        for (int b = 0; b < 2; ++b)
#pragma unroll
            for (int m = 0; m < 4; ++m)
#pragma unroll
                for (int n = 0; n < 2; ++n) acc[a][b][m][n] = (f32x4){0.f, 0.f, 0.f, 0.f};
    bf16x8 At[4][2], B0[2][2], B1[2][2];
    PG8_ROWS(voffG, cur.pm);
    const char* cA = (const char*)g.A;
    const char* cB = (const char*)g.Bt + (size_t)cur.eb * g.ebytes + (size_t)cur.pn * tstep;
    PG8_STAGE(PG8_SB(0, 0), cB, voffB); PG8_STAGE(PG8_SB(0, 1), cB + hstep, voffB); PG8_STAGEA(PG8_SA(0, 0), cA, voffG[0]); PG8_STAGEA(PG8_SA(0, 1), cA, voffG[1]);
    if (wr == 1) PG8_BAR;
    PG8_WAIT_V(2); PG8_BAR;
    PG8_STAGE(PG8_SB(1, 0), cB + kstep, voffB); PG8_STAGEA(PG8_SA(1, 0), cA + kstep, voffG[0]); PG8_STAGE(PG8_SB(1, 1), cB + hstep + kstep, voffB);
    PG8_WAIT_V(6); PG8_BAR;
    for (;;) {
        const bool has_next = S.next(ui + 1, nxt);
        if (has_next) PG8_ROWS(voffN, nxt.pm); else { voffN[0][0] = voffG[0][0]; voffN[0][1] = voffG[0][1]; voffN[1][0] = voffG[1][0]; voffN[1][1] = voffG[1][1]; }
        const char* nB = has_next ? (const char*)g.Bt + (size_t)nxt.eb * g.ebytes + (size_t)nxt.pn * tstep : cB;
#define PG8_PAIR(a1, a2, b2, a3, b3, v2) do { \
              \
            PG8_LDB(B0, 0, 0); PG8_LDB(B1, 0, 1); PG8_SCHED; PG8_LDA(At, 0, 0); PG8_STAGEA(PG8_SA(1, 1), (a1), voffG[1]); \
            PG8_WAIT_V(8); PG8_WAIT_L(0); PG8_BAR; PG8_MMA(0, 0, At, B0); PG8_MMA(0, 1, At, B1); PG8_BAR; PG8_SCHED; \
              \
            PG8_LDA(At, 0, 1); PG8_STAGE(PG8_SB(0, 0), b2, voffB); PG8_STAGE(PG8_SB(0, 1), (b2) + hstep, voffB); PG8_STAGEA(PG8_SA(0, 0), a2, v2[0]); \
            PG8_WAIT_V(8); PG8_WAIT_L(0); PG8_BAR; PG8_MMA(1, 0, At, B0); PG8_MMA(1, 1, At, B1); PG8_BAR; PG8_SCHED; \
              \
            PG8_LDB(B0, 1, 0); PG8_LDB(B1, 1, 1); PG8_SCHED; PG8_LDA(At, 1, 0); PG8_STAGEA(PG8_SA(0, 1), (a2), v2[1]); \
            PG8_WAIT_V(8); PG8_WAIT_L(0); PG8_BAR; PG8_MMA(0, 0, At, B0); PG8_MMA(0, 1, At, B1); PG8_BAR; PG8_SCHED; \
              \
            PG8_LDA(At, 1, 1); PG8_STAGE(PG8_SB(1, 0), b3, voffB); PG8_STAGE(PG8_SB(1, 1), (b3) + hstep, voffB); PG8_STAGEA(PG8_SA(1, 0), a3, v2[0]); \
            PG8_WAIT_V(8); PG8_WAIT_L(0); PG8_BAR; PG8_MMA(1, 0, At, B0); PG8_MMA(1, 1, At, B1); PG8_BAR; PG8_SCHED; } while (0)
        for (int t = 0; t < nt; t += 2) {
            const bool last = (t == nt - 2);
            const char* a1 = cA + (size_t)(t + 1) * kstep;
            const char* a2 = last ? cA : cA + (size_t)(t + 2) * kstep; const char* b2 = last ? nB : cB + (size_t)(t + 2) * kstep;
            const char* a3 = a2 + kstep; const char* b3 = b2 + kstep;
            unsigned v2[2][2];
#pragma unroll
            for (int hh_ = 0; hh_ < 2; ++hh_) { v2[hh_][0] = last ? voffN[hh_][0] : voffG[hh_][0]; v2[hh_][1] = last ? voffN[hh_][1] : voffG[hh_][1]; }
            PG8_PAIR(a1, a2, b2, a3, b3, v2);
        }
#undef PG8_PAIR
        if (wr == 0) PG8_BAR;
        E(acc, cur, wr, wc, fr, fq);
        if (!has_next) break;
#pragma unroll
        for (int a = 0; a < 2; ++a)
#pragma unroll
            for (int b = 0; b < 2; ++b)
#pragma unroll
                for (int m = 0; m < 4; ++m)
#pragma unroll
                    for (int n = 0; n < 2; ++n) acc[a][b][m][n] = (f32x4){0.f, 0.f, 0.f, 0.f};
        cur = nxt; cB = nB; ++ui; voffG[0][0] = voffN[0][0]; voffG[0][1] = voffN[0][1]; voffG[1][0] = voffN[1][0]; voffG[1][1] = voffN[1][1];
        if (wr == 1) PG8_BAR;
    }
    PG8_WAIT_V(0);
    PG8_BAR;
#undef PG8_SA
#undef PG8_SB
#undef PG8_STAGE
#undef PG8_STAGEA
#undef PG8_ROWS
#undef PG8_LDA
#undef PG8_LDB
#undef PG8_MMA
#undef PG8_WAIT_V
#undef PG8_WAIT_L
#undef PG8_BAR
#undef PG8_SCHED
}
}

constexpr int N_STEPS = 2 + 2 * (7 - USE_GSEQ + 2 * NPASS_DENSE) + 2 * (8 - USE_GSEQ + 2 * NPASS_MOE);
#ifndef REP_A
#define REP_A 1
#define REP_B 1
#endif
#ifndef PROBE_ID
#define PROBE_ID 0
#endif
#ifndef REP_BAR
#define REP_BAR 1
#endif
#ifndef REP_C
#define REP_C 1
#endif
#ifndef REP_L
#define REP_L 1
#endif
#ifndef REP_G
#define REP_G 1
#endif
#ifndef USE_B3
#define USE_B3 1
#endif
#ifndef USE_B2
#define USE_B2 1
#define USE_A2 1
#endif
#ifndef USE_PG8
#define USE_PG8 1
#endif
#ifndef USE_A4
#define USE_A4 1
#endif

__global__ void __launch_bounds__(512, 2) hybrid_fwd(Args args) {
    extern __shared__ __attribute__((aligned(16))) unsigned char lds_raw[];
    Ctx C;
    C.lds = (LAS unsigned char*)lds_raw;
    C.MISC = (volatile LAS unsigned*)(C.lds + MISC_OFF);
    C.tid = threadIdx.x; C.lane = C.tid & 63; C.wave = __builtin_amdgcn_readfirstlane(C.tid >> 6);
    C.G = gridDim.x; C.bid = blockIdx.x; C.hot = 0xffff;
    C.ka = (KArgs*)__builtin_amdgcn_kernarg_segment_ptr();
    C.out = args.out; C.ws = args.ws; C.ctl = (unsigned*)(args.ws + WS_CTL);
    if (C.tid < 32) C.MISC[C.tid] = 0u;
    __syncthreads();
    if (!MK_MULTI) (void)xcd_barrier_post(C.ctl + CW_BAR, C.MISC + 8);
    int step = 0;
    const int wave_s = __builtin_amdgcn_readfirstlane((int)threadIdx.x >> 6);
#define STEP_BEGIN if (step >= C.ka->lo && step < C.ka->hi) { { unsigned m_ = ~0u; asm volatile("" : "+s"(m_)); const int ln_ = (int)__builtin_amdgcn_mbcnt_hi(m_, __builtin_amdgcn_mbcnt_lo(m_, 0u)); \
        int t_ = wave_s * 64 + ln_; asm volatile("" : "+v"(t_)); C.tid = t_; C.lane = t_ & 63; C.wave = wave_s; \
        KArgs* k_ = (KArgs*)__builtin_amdgcn_kernarg_segment_ptr(); asm volatile("" : "+s"(k_)); C.ka = k_; C.ws = k_->ws; C.out = k_->out; C.ctl = (unsigned*)(k_->ws + WS_CTL); C.G = gridDim.x; C.bid = blockIdx.x; }
#define STEP_END } if (!MK_MULTI && step >= C.ka->lo && step + 1 < C.ka->hi) { XcdBarrier b_; b_.bar = (unsigned*)(C.ka->ws + WS_CTL) + CW_BAR; b_.x = xb_xcc_id(); b_.st = C.MISC + 8; xcd_barrier(b_); if (REP_BAR > 1) xcd_barrier(b_); } ++step;
#define WSP(T, off) ((T*)(C.ws + (off)))
#define RELAUNDER { int t_ = C.tid; asm volatile("" : "+v"(t_)); C.tid = t_; C.lane = t_ & 63; C.wave = __builtin_amdgcn_readfirstlane(t_ >> 6); }

    STEP_BEGIN
        ph_mod(C); __syncthreads(); ph_conv(C, 0);
#if REP_C > 1
        __syncthreads(); ph_mod(C); __syncthreads(); ph_conv(C, 0);
#endif
    STEP_END
    STEP_BEGIN
        ph_modulate0(C);
#if PROBE_ID == 8
        RELAUNDER ph_modulate0(C); RELAUNDER ph_modulate0(C); RELAUNDER ph_modulate0(C); RELAUNDER ph_modulate0(C);
#endif
    STEP_END

    for (int l = 0; l < DEPTH; ++l) {
        STEP_BEGIN
#if USE_PG8
            { const pg8::Gemm g{WSP(bf16, WS_H), WSP(bf16, WS_WIN), DM, 0}; pg8::Order S; S.init(256, 11, C.G, C.bid, 0, 0, nullptr);
              pg8::gemm_phase(C.lds, C.tid, g, S, pg8::EpiProj{WSP(bf16, WS_P), WSP(bf16, WS_KFA), WSP(bf16, WS_KFI), WSP(bf16, WS_VF)});
#if PROBE_ID == 5
              RELAUNDER pg8::gemm_phase(C.lds, C.tid, g, S, pg8::EpiProj{WSP(bf16, WS_P), WSP(bf16, WS_KFA), WSP(bf16, WS_KFI), WSP(bf16, WS_VF)});
#endif
            }
#else
            for (int u = C.bid; u < 256 * 11; u += C.G) {
                const int pm = u / 11, pn = u % 11; const GUnit gu{pm * 256, pm * 256, pn, 0};
                gemm_simple_unit<0>(C, WSP(bf16, WS_H), DM, nullptr, WSP(bf16, WS_WIN), DM, gu, EpiStoreS{WSP(bf16, WS_P), PW});
            }
#endif
        STEP_END
        STEP_BEGIN
#pragma unroll 1
#if USE_A4
            for (int rp_ = 0; rp_ < (PROBE_ID == 1 ? 2 : 1); ++rp_) {
#ifdef PROBE_HOT
                C.hot = (PROBE_ID == 1 && rp_ == 0) ? PROBE_HOT : 0xffff;
#endif
#ifdef PROBE_SKIP
#define A4_SKIPM ((PROBE_ID == 1 && rp_ == 0) ? PROBE_SKIP : 0)
#else
#define A4_SKIPM 0
#endif
#define A4_MAP(idx_) const int b = (idx_) & 15, r_ = (idx_) >> 4, j_ = (r_ & 15) + 16 * (r_ >> 5), t0 = 4 * (((r_ >> 4) & 1) ? 1023 - j_ : j_);
                LAS unsigned* img = (LAS unsigned*)C.lds;
#if USE_GSEQ
                const int NGW = C.G >= 128 ? 64 : C.G / 2, NW = C.G - NGW, wid = C.bid - NGW;
                const int nun = (wid >= 0 && wid < 16384) ? (16384 - wid + NW - 1) / NW : 0;
                if (wid < 0) {
#pragma unroll 1
                    for (int sq_ = C.bid; sq_ < 64; sq_ += NGW) { RELAUNDER ph_gla_seq(C, l, sq_); }
                } else
#else
                const int NW = C.G, wid = C.bid;
                const int nun = (C.bid < 16384) ? (16384 - C.bid + C.G - 1) / C.G : 0;
#endif
                if (C.wave < 4) {
                    A4S S;
                    { A4_MAP(nun > 0 ? wid : 0) a4_prefetch(C, S, b, t0); }
#pragma unroll 1
                    for (int k = 0; k < nun; ++k) { RELAUNDER
                        { const int nidx = (k + 1 < nun) ? wid + (k + 1) * NW : wid; const int nb = nidx & 15, nr_ = nidx >> 4, nj_ = (nr_ & 15) + 16 * (nr_ >> 5), nt0 = 4 * (((nr_ >> 4) & 1) ? 1023 - nj_ : nj_);
                          A4_MAP(wid + k * NW) a4_score(C, S, img + (k & 1) * A4_BUF, b, t0, nb, nt0); }
                        __syncthreads(); }
                } else {
#pragma unroll 1
                    for (int k = 0; k < nun; ++k) { __syncthreads(); RELAUNDER A4_MAP(wid + k * NW) const int q = C.wave - 4; if (!(A4_SKIPM & 32)) a4_select(C, img + (k & 1) * A4_BUF + q * A3_QP, b, t0 + q); }
                }
                __syncthreads();
#undef A4_MAP
            }
#else
            for (int rp_ = 0; rp_ < (PROBE_ID == 1 ? 2 : 1); ++rp_)
            for (int idx = C.bid; idx < 8192; idx += C.G) {
                RELAUNDER
                const int b = idx & 15, r = idx >> 4, j = (r & 15) + 16 * (r >> 5), qb = ((r >> 4) & 1) ? 511 - j : j;
                A3Q qa; a3_load_q(C, b, qb * 8, qa);
                ph_dsa_a3_unit(C, b, qb * 8, qa, false, 0, 0);
            }
#endif
#if !USE_GSEQ
#pragma unroll 1
            for (int rp_ = 0; rp_ < (PROBE_ID == 3 ? 2 : 1); ++rp_)
            for (int u = C.bid; u < 4096; u += C.G) { RELAUNDER ph_gla1_unit(C, l, u); }
#endif
        STEP_END
#if !USE_GSEQ
        STEP_BEGIN
            ph_gla2(C);
#if PROBE_ID == 9
            RELAUNDER ph_gla2(C, (size_t)66 * MiB); RELAUNDER ph_gla2(C, (size_t)66 * MiB);
#endif
        STEP_END
#endif
        STEP_BEGIN
#if !USE_GSEQ
#pragma unroll 1
            for (int rp_ = 0; rp_ < (PROBE_ID == 4 ? 2 : 1); ++rp_)
            for (int u = C.bid; u < 4096; u += C.G) { RELAUNDER ph_gla3_unit(C, l, u); }
#endif
#if USE_B2
#pragma unroll 1
            for (int rep = 0; rep < (PROBE_ID == 2 ? 2 : 1); ++rep)
#ifdef PROBE_HOT
            { C.hot = (PROBE_ID == 2 && rep == 0) ? PROBE_HOT : 0xffff;
#else
            {
#endif
            for (int idx = C.bid; idx < 2048; idx += C.G) {
                RELAUNDER
                const int b = idx & 15, r = idx >> 4, j = (r & 15) + 16 * (r >> 5), qb = ((r >> 4) & 1) ? 127 - j : j;
#if USE_B3
                ph_dsa_b3_wave(C, b, qb * 32 + C.wave * 4);
#else
                ph_dsa_b2_wave(C, b, qb * 32 + C.wave * 4);
#endif
            }
            }
#else
            for (int u = C.bid; u < 8192; u += C.G) { RELAUNDER ph_dsa_b_unit(C, u & 15, (u >> 4) * 8); }
#endif
        STEP_END
        STEP_BEGIN
#if USE_PG8
            { const pg8::Gemm g{(const bf16*)C.out, WSP(bf16, WS_WOUT), DM, 0}; pg8::Order S; S.init(256, 4, C.G, C.bid, 0, 0, nullptr);
              pg8::gemm_phase(C.lds, C.tid, g, S, pg8::EpiBf16{WSP(bf16, WS_Y), DM});
#if PROBE_ID == 6
              RELAUNDER pg8::gemm_phase(C.lds, C.tid, g, S, pg8::EpiBf16{WSP(bf16, WS_Y), DM});
#endif
            }
#else
            for (int u = C.bid; u < 256 * 4; u += C.G) {
                const int pm = u >> 2, pn = u & 3; const GUnit gu{pm * 256, pm * 256, pn, 0};
                gemm_simple_unit<0>(C, WSP(bf16, WS_H), DM, nullptr, WSP(bf16, WS_WOUT), DM, gu, EpiStoreS{WSP(bf16, WS_Y), DM});
            }
#endif
        STEP_END
        STEP_BEGIN
            const float* Xin = C.in(I_X);
            if (l == 0) ph_ln<false, 0, 0>(C, Xin, l, 0, 2048, l, 3072, true, 0, 0, false);
            else if (l & 1) ph_ln<true, 0, 1>(C, Xin, l, 0, 2048, l, 3072, true, l >> 1, 0, false);
            else ph_ln<false, 0, 1>(C, Xin, l, 0, 2048, l, 3072, true, l >> 1, 0, false);
        STEP_END
        if (l & 1) {
            STEP_BEGIN
                ph_assign(C, l >> 1);
            STEP_END
        }
        for (int pass = 0; pass < ((l & 1) ? NPASS_MOE : NPASS_DENSE); ++pass) {
            STEP_BEGIN
                const bool moe = (l & 1) != 0;
                MoeTab tb; tb.npanels = 256;
#pragma unroll
                for (int e = 0; e < 8; ++e) tb.pend[e] = 65536;
                if (moe) tb = moe_tab(C, l >> 1);
                const int p_lo = pass * PASS_PANELS, p_hi = moe ? ((pass == NPASS_MOE - 1 || tb.npanels < p_lo + PASS_PANELS) ? tb.npanels : p_lo + PASS_PANELS) : p_lo + PASS_PANELS;
                const int npan = p_hi > p_lo ? p_hi - p_lo : 0;
#if USE_PG8
                LAS unsigned char* pe = C.lds + PE_OFF;
                for (int p = C.tid; p < 528; p += 512) pe[p] = (unsigned char)(moe ? panel_expert(tb, p) : 0);
                __syncthreads();
                { const pg8::Gemm g{WSP(bf16, WS_H), WSP(bf16, WS_WGU), DM, (size_t)5632 * 1024 * 2, moe ? (const int*)WSP(int, WS_ROWTOK) : nullptr}; pg8::Order S; S.init(npan, 22, C.G, C.bid, p_lo, 0, pe);
                  pg8::gemm_phase(C.lds, C.tid, g, S, pg8::EpiSwiglu{WSP(bf16, WS_P)});
#if REP_G > 1
                  RELAUNDER pg8::gemm_phase(C.lds, C.tid, g, S, pg8::EpiSwiglu{WSP(bf16, WS_P)});
#endif
                }
#else
                for (int u = C.bid; u < npan * 22; u += C.G) {
                    const int lp = u / 22, pn = u % 22, gp = p_lo + lp; const int e = moe ? panel_expert(tb, gp) : 0;
                    const GUnit gu{gp * 256, lp * 256, pn, (size_t)e * 5632 * 1024};
                    gemm_simple_unit<1>(C, moe ? WSP(bf16, WS_Y) : WSP(bf16, WS_H), DM, nullptr, WSP(bf16, WS_WGU), DM, gu, EpiSwigluS{WSP(bf16, WS_P)});
                }
#endif
            STEP_END
            STEP_BEGIN
                const bool moe = (l & 1) != 0;
                MoeTab tb; tb.npanels = 256;
#pragma unroll
                for (int e = 0; e < 8; ++e) tb.pend[e] = 65536;
                if (moe) tb = moe_tab(C, l >> 1);
                const int p_lo = pass * PASS_PANELS, p_hi = moe ? ((pass == NPASS_MOE - 1 || tb.npanels < p_lo + PASS_PANELS) ? tb.npanels : p_lo + PASS_PANELS) : p_lo + PASS_PANELS;
                const int npan = p_hi > p_lo ? p_hi - p_lo : 0;
#if USE_PG8
                LAS unsigned char* pe = C.lds + PE_OFF;
                for (int p = C.tid; p < 528; p += 512) pe[p] = (unsigned char)(moe ? panel_expert(tb, p) : 0);
                __syncthreads();
                { const pg8::Gemm g{WSP(bf16, WS_P), WSP(bf16, WS_WDN), DFF, (size_t)1024 * DFF * 2}; pg8::Order S; S.init(npan, 4, C.G, C.bid, p_lo, 1, pe);
                  pg8::gemm_phase(C.lds, C.tid, g, S, pg8::EpiGate{WSP(bf16, WS_Y), moe ? WSP(float, WS_ROWGATE) : nullptr});
#if PROBE_ID == 7
                  RELAUNDER pg8::gemm_phase(C.lds, C.tid, g, S, pg8::EpiGate{WSP(bf16, WS_Y), moe ? WSP(float, WS_ROWGATE) : nullptr});
#endif
                }
#else
                for (int u = C.bid; u < npan * 4; u += C.G) {
                    const int lp = u >> 2, pn = u & 3, gp = p_lo + lp; const int e = moe ? panel_expert(tb, gp) : 0;
                    const GUnit gu{lp * 256, gp * 256, pn, (size_t)e * 1024 * DFF};
                    if (moe) gemm_simple_unit<0>(C, WSP(bf16, WS_P), DFF, nullptr, WSP(bf16, WS_WDN), DFF, gu, EpiGateS{WSP(bf16, WS_Y), WSP(float, WS_ROWGATE)});
                    else gemm_simple_unit<0>(C, WSP(bf16, WS_P), DFF, nullptr, WSP(bf16, WS_WDN), DFF, gu, EpiStoreS{WSP(bf16, WS_Y), DM});
                }
#endif
            STEP_END
        }
        STEP_BEGIN
            const int l2 = l < 3 ? l + 1 : 3;
            if (l & 1) ph_ln<false, 1, 1>(C, nullptr, l, 1, 5120, l2, 0, l < 3, 0, 3072, l == 3); else ph_ln<false, 0, 1>(C, nullptr, l, 1, 5120, l2, 0, l < 3, 0, 3072, l == 3);
            if (l < 3) ph_conv(C, l + 1);
#if REP_C > 1
            if (l < 3) { RELAUNDER ph_conv(C, l + 1); }
#endif
        STEP_END
    }
#undef STEP_BEGIN
#undef STEP_END
#undef WSP
#undef RELAUNDER
}

#ifndef DUMP_HI
#define DUMP_HI 0
#define DUMP_OFF 0
#define DUMP_WORDS 1
#endif
#if DUMP_HI
__global__ void __launch_bounds__(256) copy_half_k(const unsigned* src, unsigned* dst) {
    for (size_t i = (size_t)blockIdx.x * 256 + threadIdx.x; i < (size_t)65536 * 256; i += (size_t)gridDim.x * 256) dst[i] = src[(i >> 8) * 512 + (i & 255)];
}
__global__ void __launch_bounds__(256) dump_k(const unsigned* src, size_t nwords, float* out) {
    const size_t N = (size_t)MTOK * DM;
    for (size_t i = (size_t)blockIdx.x * 256 + threadIdx.x; i < N; i += (size_t)gridDim.x * 256) {
        float v = 0.f;
        for (size_t k = i % nwords; k < nwords; k += N) { const unsigned w = src[k]; v += (float)((w ^ (w >> 13)) & 0xFFFu); }
        out[i] = v;
    }
}
#endif
extern "C" void kernel_launch(void* const* d_in, const int* in_sizes, int n_in, void* d_out, int out_size, void* d_ws, size_t ws_size, hipStream_t stream) {
    static int grid = 0;
    if (grid == 0) {
        if (n_in != 19 || in_sizes[0] != MTOK * DM || out_size != MTOK * DM || ws_size < WS_END) {
            fprintf(stderr, "kernel_launch: unexpected shapes (n_in %d, in0 %d, out %d, ws %zu); nothing launched\n", n_in, n_in > 0 ? in_sizes[0] : -1, out_size, ws_size); grid = -1; return; }
        int dev = 0, cus = 0, per_cu = 0;
        if (hipGetDevice(&dev) != hipSuccess || hipDeviceGetAttribute(&cus, hipDeviceAttributeMultiprocessorCount, dev) != hipSuccess) { grid = -1; return; }
        if (hipFuncSetAttribute((const void*)hybrid_fwd, hipFuncAttributeMaxDynamicSharedMemorySize, LDS_BYTES) != hipSuccess) { fprintf(stderr, "kernel_launch: hipFuncSetAttribute failed\n"); grid = -1; return; }
        if (hipOccupancyMaxActiveBlocksPerMultiprocessor(&per_cu, (const void*)hybrid_fwd, 512, LDS_BYTES) != hipSuccess || per_cu < 1)
            fprintf(stderr, "kernel_launch: note: occupancy query reports %d workgroups per CU\n", per_cu);
        (void)hipGetLastError();
        grid = cus;
    }
    if (grid < 0) return;
    if (hipMemsetAsync((char*)d_ws + WS_CTL, 0, CTL_ZERO_BYTES, stream) != hipSuccess) { fprintf(stderr, "kernel_launch: memset failed\n"); return; }
    Args a{};
    for (int i = 0; i < 19; ++i) a.in[i] = (const float*)d_in[i];
    a.out = (float*)d_out; a.ws = (unsigned char*)d_ws;
#if MK_MULTI
    for (int s = 0; s < N_STEPS; ++s) { a.lo = s; a.hi = s + 1; hipLaunchKernelGGL(hybrid_fwd, dim3(grid), dim3(512), LDS_BYTES, stream, a); }
#else
#ifdef DUMP_SPLIT
    a.lo = 0; a.hi = DUMP_SPLIT;
    hipLaunchKernelGGL(hybrid_fwd, dim3(grid), dim3(512), LDS_BYTES, stream, a);
    (void)hipMemsetAsync((char*)d_ws + WS_CTL, 0, 65536, stream);
    a.lo = DUMP_SPLIT; a.hi = DUMP_HI;
    hipLaunchKernelGGL(hybrid_fwd, dim3(grid), dim3(512), LDS_BYTES, stream, a);
#else
    a.lo = 0; a.hi = DUMP_HI ? DUMP_HI : N_STEPS;
    hipLaunchKernelGGL(hybrid_fwd, dim3(grid), dim3(512), LDS_BYTES, stream, a);
#endif
#ifdef DUMP_OUTCOPY
    hipLaunchKernelGGL(copy_half_k, dim3(8192), dim3(256), 0, stream, (const unsigned*)d_out + (DUMP_OUTCOPY == 2 ? 256 : 0), (unsigned*)((char*)d_ws + (size_t)DUMP_OFF));
#endif
#if DUMP_HI
    hipLaunchKernelGGL(dump_k, dim3(8192), dim3(256), 0, stream, (const unsigned*)((const char*)d_ws + (size_t)DUMP_OFF), (size_t)DUMP_WORDS, (float*)d_out);
#endif
#endif
    const hipError_t le = hipPeekAtLastError();
    if (le != hipSuccess) fprintf(stderr, "kernel_launch: launch failed: %s\n", hipGetErrorName(le));
}
```

```cpp
#include <hip/hip_runtime.h>
#include <cstdio>
#include <cstdint>

#define GAS __attribute__((address_space(1)))
#define LAS __attribute__((address_space(3)))
typedef unsigned short bf16;
typedef unsigned v4u __attribute__((ext_vector_type(4)));
typedef unsigned v2u __attribute__((ext_vector_type(2)));
typedef float f32x4 __attribute__((ext_vector_type(4)));
typedef float f32x2 __attribute__((ext_vector_type(2)));
typedef float f32x16 __attribute__((ext_vector_type(16)));
typedef short bf16x8 __attribute__((ext_vector_type(8)));

#ifndef USE_LIST
#define USE_LIST 0
#endif
#ifndef USE_BCAST
#define USE_BCAST 1
#endif
#ifndef USE_GSEQ
#define USE_GSEQ 1
#endif
#ifndef MK_MULTI
#define MK_MULTI 0
#endif

constexpr int BATCH = 16, SEQ = 4096, DM = 1024, DEPTH = 4, MTOK = BATCH * SEQ;
constexpr int PW = 2816;
constexpr int PROJ_SRC = 2776;
constexpr int C_AQ = 0, C_IQ = 512, C_BQ = 1024, C_BK = 1280, C_BV = 1536, C_BG = 2048, C_AK = 2560, C_AV = 2624, C_IK = 2688, C_IW = 2752, C_BA = 2760;
constexpr int DFF = 2816, NEXP = 8;
constexpr int PASS_PANELS = 256, NPASS_DENSE = 1, NPASS_MOE = 2;
constexpr float DN_ALPHA = 1.681792830507429f;
constexpr float LN_EPS = 1e-5f;
constexpr float LOG2E = 1.4426950408889634f;

constexpr size_t MiB = 1u << 20;
constexpr size_t WS_CTL = 0, CTL_ZERO_BYTES = 1 * MiB;
constexpr size_t WS_MOD = 1 * MiB;
constexpr size_t WS_TOPE = 3 * MiB;
constexpr size_t WS_TOPG = WS_TOPE + MiB / 2;
constexpr size_t WS_TOKSLOT = WS_TOPG + MiB / 2;
constexpr size_t WS_ROWTOK = 5 * MiB;
constexpr size_t WS_ROWGATE = 6 * MiB;
constexpr size_t WS_WIN = 8 * MiB;
constexpr size_t WS_WOUT = 14 * MiB;
constexpr size_t WS_WGU = 16 * MiB;
constexpr size_t WS_WDN = 104 * MiB;
constexpr size_t WS_H = 148 * MiB;
constexpr size_t WS_P = 276 * MiB;
constexpr size_t WS_Y = 640 * MiB;
constexpr size_t WS_SEL = 900 * MiB;
constexpr size_t WS_END = 1024 * MiB;

constexpr int CW_BAR = 4096;
constexpr int CW_QUEUE = 8192;
constexpr int CW_CNT = 10240;
constexpr int CW_FILL = 10752;

constexpr int LDS_BYTES = 147456;
constexpr int PE_OFF = 131072;
constexpr int MISC_OFF = 139264;

__device__ __forceinline__ float bf2f(unsigned v) { return __uint_as_float(v << 16); }
typedef __bf16 bf16x2_t __attribute__((ext_vector_type(2)));
__device__ __forceinline__ unsigned pk2(float lo, float hi) { const f32x2 v = {lo, hi}; return __builtin_bit_cast(unsigned, __builtin_convertvector(v, bf16x2_t)); }
__device__ __forceinline__ unsigned f2bf(float f) { return pk2(f, 0.f) & 0xffffu; }
__device__ __forceinline__ float wave_sum(float v) {
#pragma unroll
    for (int o = 1; o < 64; o <<= 1) v += __shfl_xor(v, o);
    return v;
}
__device__ __forceinline__ float wave_max(float v) {
#pragma unroll
    for (int o = 1; o < 64; o <<= 1) v = fmaxf(v, __shfl_xor(v, o));
    return v;
}
#define DPP_U32(x, ctrl) ((unsigned)__builtin_amdgcn_update_dpp(0, (int)(x), (ctrl), 0xF, 0xF, true))
__device__ __forceinline__ unsigned wave_sum_u32(unsigned x) {
    x += DPP_U32(x, 0xB1); x += DPP_U32(x, 0x4E); x += DPP_U32(x, 0x124); x += DPP_U32(x, 0x128);
#if USE_BCAST
    x += (unsigned)__builtin_amdgcn_update_dpp(0, (int)x, 0x142, 0xA, 0xF, false);
    x += (unsigned)__builtin_amdgcn_update_dpp(0, (int)x, 0x143, 0xC, 0xF, false);
    return (unsigned)__builtin_amdgcn_readlane((int)x, 63);
#else
    return (unsigned)__builtin_amdgcn_readlane((int)x, 0) + (unsigned)__builtin_amdgcn_readlane((int)x, 16) + (unsigned)__builtin_amdgcn_readlane((int)x, 32) + (unsigned)__builtin_amdgcn_readlane((int)x, 48);
#endif
}
__device__ __forceinline__ float dpp_f32_(float x, int) { return x; }
#define DPP_F32(x, ctrl) (__builtin_bit_cast(float, __builtin_amdgcn_update_dpp(0, __builtin_bit_cast(int, (x)), (ctrl), 0xF, 0xF, true)))
__device__ __forceinline__ float wave_sum_f(float x) {
    x += DPP_F32(x, 0xB1); x += DPP_F32(x, 0x4E); x += DPP_F32(x, 0x124); x += DPP_F32(x, 0x128);
    const float r0 = __builtin_bit_cast(float, __builtin_amdgcn_readlane(__builtin_bit_cast(int, x), 0)), r1 = __builtin_bit_cast(float, __builtin_amdgcn_readlane(__builtin_bit_cast(int, x), 16));
    const float r2 = __builtin_bit_cast(float, __builtin_amdgcn_readlane(__builtin_bit_cast(int, x), 32)), r3 = __builtin_bit_cast(float, __builtin_amdgcn_readlane(__builtin_bit_cast(int, x), 48));
    return (r0 + r1) + (r2 + r3);
}
__device__ __forceinline__ unsigned umax_(unsigned a, unsigned b) { return a > b ? a : b; }
__device__ __forceinline__ unsigned umin_(unsigned a, unsigned b) { return a < b ? a : b; }
__device__ __forceinline__ unsigned wave_max_u32(unsigned x) {
    x = umax_(x, DPP_U32(x, 0xB1)); x = umax_(x, DPP_U32(x, 0x4E)); x = umax_(x, DPP_U32(x, 0x124)); x = umax_(x, DPP_U32(x, 0x128));
    return umax_(umax_((unsigned)__builtin_amdgcn_readlane((int)x, 0), (unsigned)__builtin_amdgcn_readlane((int)x, 16)), umax_((unsigned)__builtin_amdgcn_readlane((int)x, 32), (unsigned)__builtin_amdgcn_readlane((int)x, 48)));
}
__device__ __forceinline__ unsigned wave_min_u32(unsigned x) {
    x = umin_(x, DPP_U32(x, 0xB1)); x = umin_(x, DPP_U32(x, 0x4E)); x = umin_(x, DPP_U32(x, 0x124)); x = umin_(x, DPP_U32(x, 0x128));
    return umin_(umin_((unsigned)__builtin_amdgcn_readlane((int)x, 0), (unsigned)__builtin_amdgcn_readlane((int)x, 16)), umin_((unsigned)__builtin_amdgcn_readlane((int)x, 32), (unsigned)__builtin_amdgcn_readlane((int)x, 48)));
}
#define SHX_F(v, o, lane_) (__builtin_bit_cast(float, __builtin_amdgcn_ds_bpermute((((lane_) ^ (o)) << 2), __builtin_bit_cast(int, (float)(v)))))
#define SHUP_I(v, o, lane_) (__builtin_amdgcn_ds_bpermute((((lane_) - (o)) << 2), (int)(v)))
__device__ __forceinline__ int wave_incl_scan_i(int x, int lane) {
    x += __builtin_amdgcn_update_dpp(0, x, 0x111, 0xF, 0xF, true); x += __builtin_amdgcn_update_dpp(0, x, 0x112, 0xF, 0xF, true);
    x += __builtin_amdgcn_update_dpp(0, x, 0x114, 0xF, 0xF, true); x += __builtin_amdgcn_update_dpp(0, x, 0x118, 0xF, 0xF, true);
    const int t0 = __builtin_amdgcn_readlane(x, 15), t1 = __builtin_amdgcn_readlane(x, 31), t2 = __builtin_amdgcn_readlane(x, 47);
    return x + (lane >= 16 ? t0 : 0) + (lane >= 32 ? t1 : 0) + (lane >= 48 ? t2 : 0);
}
__device__ __forceinline__ float silu_f(float v) { return v / (1.f + expf(-v)); }

#define XB_TMO      128
#define XB_XCNT(j)  (256  + 64 * (j))
#define XB_XSUB(j)  (1280 + 64 * (j))
#define XB_XGEN(j)  (2304 + 64 * (j))
#define XB_TOP      3328
#define XB_TOPGEN   3392
#define XCD_BAR_WORDS 3456
#define XB_SPIN_CAP (1u << 21)

__device__ __forceinline__ unsigned xb_ld(unsigned* p)              { return __hip_atomic_load(p, __ATOMIC_RELAXED, __HIP_MEMORY_SCOPE_AGENT); }
__device__ __forceinline__ unsigned xb_add(unsigned* p, unsigned v) { return __hip_atomic_fetch_add(p, v, __ATOMIC_RELAXED, __HIP_MEMORY_SCOPE_AGENT); }
__device__ __forceinline__ unsigned xb_xcc_id() { return (unsigned)__builtin_amdgcn_s_getreg((3 << 11) | 20) & 0xFu; }
#define XB_SPIN(cond, bar) do { unsigned _sp = 0; while (cond) { __builtin_amdgcn_s_sleep(1); \
    if ((++_sp & 255u) == 0u) { if (xb_ld(&(bar)[XB_TMO])) break; if (_sp > XB_SPIN_CAP) { atomicAdd(&(bar)[XB_TMO], 1u); break; } } } } while (0)

struct XcdBarrier {
    unsigned* bar; unsigned x;
    volatile LAS unsigned* st;
};

__device__ __forceinline__ XcdBarrier xcd_barrier_post(unsigned* bar, volatile LAS unsigned* st) {
    XcdBarrier b; b.bar = bar; b.x = xb_xcc_id(); b.st = st;
    if (threadIdx.x == 0) (void)xb_add(&bar[XB_XCNT(b.x)], 1u);
    return b;
}
__device__ __forceinline__ void xcd_barrier_complete(unsigned* bar, unsigned x, unsigned& nloc, unsigned& nx) {
    const unsigned G = gridDim.x * gridDim.y * gridDim.z;
    unsigned sum, cnt, mine, sp = 0u;
    for (;;) {
        sum = 0u; cnt = 0u; mine = 0u;
#pragma unroll
        for (unsigned j = 0; j < 16; ++j) { const unsigned c = xb_ld(&bar[XB_XCNT(j)]); sum += c; cnt += (c > 0u) ? 1u : 0u; mine = (j == x) ? c : mine; }
        if (sum == G) break;
        __builtin_amdgcn_s_sleep(1);
        if ((++sp & 255u) == 0u) { if (xb_ld(&bar[XB_TMO])) break; if (sp > XB_SPIN_CAP) { atomicAdd(&bar[XB_TMO], 1u); break; } }
    }
    nloc = mine > 0u ? mine : 1u; nx = cnt > 0u ? cnt : 1u;
}

__device__ __forceinline__ void xcd_barrier(const XcdBarrier& b) {
    asm volatile("s_waitcnt vmcnt(0)" ::: "memory");
    __syncthreads();
    if (threadIdx.x == 0) {
        unsigned* bar = b.bar;
        __builtin_amdgcn_s_waitcnt(0);
        unsigned nloc = b.st[0], nx = b.st[1];
        if (nloc == 0u) { xcd_barrier_complete(bar, b.x, nloc, nx); b.st[0] = nloc; b.st[1] = nx; }
        const unsigned old = xb_add(&bar[XB_XSUB(b.x)], 1u);
        const unsigned gen = old / nloc;
        if (old + 1u == (gen + 1u) * nloc) {
            __builtin_amdgcn_fence(__ATOMIC_RELEASE, "agent");
            asm volatile("s_waitcnt vmcnt(0)" ::: "memory");
            const unsigned og = xb_add(&bar[XB_TOP], 1u);
            const unsigned tg = og / nx;
            if (og + 1u == (tg + 1u) * nx) xb_add(&bar[XB_TOPGEN], 1u);
            else XB_SPIN(xb_ld(&bar[XB_TOPGEN]) == tg, bar);
            __builtin_amdgcn_fence(__ATOMIC_ACQUIRE, "agent");
            xb_add(&bar[XB_XGEN(b.x)], 1u);
            asm volatile("s_waitcnt vmcnt(0)" ::: "memory");
        } else {
            XB_SPIN(xb_ld(&bar[XB_XGEN(b.x)]) == gen, bar);
            __builtin_amdgcn_fence(__ATOMIC_ACQUIRE, "agent");
            asm volatile("s_waitcnt vmcnt(0)" ::: "memory");
        }
    }
    __syncthreads();
}


struct Args { const float* in[19]; float* out; unsigned char* ws; int lo, hi; };
typedef const Args __attribute__((address_space(4))) KArgs;
struct Ctx {
    LAS unsigned char* lds;
    volatile LAS unsigned* MISC;
    unsigned* ctl;
    int tid, lane, wave, G, bid;
    int hot;
    KArgs* ka;
    float* out; unsigned char* ws;
    __device__ __forceinline__ const float* in(int i) const { return ka->in[i]; }
};
enum { I_X = 0, I_C, I_WIN, I_WA2, I_BA, I_GLAG, I_WOUT, I_WMOD, I_BMOD, I_LNG, I_LNB, I_FG, I_FU, I_FD, I_WR, I_BR, I_MG, I_MU, I_MD };

__device__ __forceinline__ f32x16 mfma32(bf16x8 a, bf16x8 b, f32x16 c) { return __builtin_amdgcn_mfma_f32_32x32x16_bf16(a, b, c, 0, 0, 0); }

__device__ __forceinline__ void ph_mod(Ctx& C) {
    LAS float* sc = (LAS float*)C.lds;
    LAS float* red = (LAS float*)(C.lds + 65536);
    const float* c = C.in(I_C);
    for (int i = C.tid; i < 16 * 1024; i += 512) sc[i] = silu_f(c[i]);
    __syncthreads();
    const float* wmod = C.in(I_WMOD); const float* bmod = C.in(I_BMOD);
    float* MOD = (float*)(C.ws + WS_MOD);
    for (int u = C.bid; u < 4 * 96; u += C.G) {
        const int l = u / 96, cc = u % 96, col = cc * 64 + C.lane;
        float acc[16];
#pragma unroll
        for (int b = 0; b < 16; ++b) acc[b] = 0.f;
        const float* wp = wmod + ((size_t)l * 1024 + C.wave * 128) * 6144 + col;
        const LAS float* sp = sc + C.wave * 128;
#pragma unroll 16
        for (int kk = 0; kk < 128; ++kk) {
            const float w = wp[(size_t)kk * 6144];
#pragma unroll
            for (int b = 0; b < 16; ++b) acc[b] += sp[b * 1024 + kk] * w;
        }
#pragma unroll
        for (int b = 0; b < 16; ++b) red[(C.wave * 16 + b) * 64 + C.lane] = acc[b];
        __syncthreads();
        for (int o = C.tid; o < 1024; o += 512) {
            const int b = o >> 6, ln = o & 63; float s = 0.f;
#pragma unroll
            for (int w = 0; w < 8; ++w) s += red[(w * 16 + b) * 64 + ln];
            const int cl = cc * 64 + ln;
            MOD[((size_t)l * 16 + b) * 6144 + cl] = s + bmod[l * 6144 + cl];
        }
        __syncthreads();
    }
}

__device__ __forceinline__ void conv_item(const float* colp, int ldn, int K, bf16* WT, LAS float* scr, int kb, int nb, int lane) {
    const int k0 = 64 * kb, n0 = 32 * nb;
    float tv[32];
#pragma unroll
    for (int i = 0; i < 32; ++i) { const int kk = 2 * i + (lane >> 5); tv[i] = colp ? colp[(size_t)(k0 + kk) * ldn] : 0.f; }
#pragma unroll
    for (int i = 0; i < 32; ++i) { const int kk = 2 * i + (lane >> 5); scr[kk * 33 + (lane & 31)] = tv[i]; }
    asm volatile("s_waitcnt lgkmcnt(0)" ::: "memory");
    const int c = lane & 7;
#pragma unroll
    for (int j = 0; j < 4; ++j) {
        const int n = (lane >> 3) + 8 * j; const LAS float* s = scr + (8 * c) * 33 + n;
        v4u o; o.x = pk2(s[0 * 33], s[1 * 33]); o.y = pk2(s[2 * 33], s[3 * 33]); o.z = pk2(s[4 * 33], s[5 * 33]); o.w = pk2(s[6 * 33], s[7 * 33]);
        *(v4u*)(WT + (size_t)(n0 + n) * K + k0 + 8 * c) = o;
    }
    asm volatile("s_waitcnt lgkmcnt(0)" ::: "memory");
}
__device__ __forceinline__ int win_src_col(int n) {
    if (n < C_IQ) return n;
    if (n < C_BQ) return 640 + (n - C_IQ);
    if (n < C_AK) return 1224 + (n - C_BQ);
    if (n < C_AV) return 512 + (n - C_AK);
    if (n < C_IK) return 576 + (n - C_AV);
    if (n < C_IW) return 1152 + (n - C_IK);
    if (n < C_BA) return 1216 + (n - C_IW);
    if (n < PROJ_SRC) return 2760 + (n - C_BA);
    return -1;
}
__device__ __forceinline__ void ph_conv(Ctx& C, int l) {
    LAS float* scr = (LAS float*)(C.lds + C.wave * 8448);
    const int gw = C.bid * 8 + C.wave, NGW = C.G * 8;
    const bool moe = (l & 1) != 0; const int j = l >> 1, ne = moe ? NEXP : 1;
    constexpr int I_IN = 16 * 88, I_OUT = 16 * 32, I_GU = 16 * 176, I_DN = 44 * 32;
    const int nitems = I_IN + I_OUT + ne * (I_GU + I_DN);
    bf16* WIN = (bf16*)(C.ws + WS_WIN); bf16* WOUT = (bf16*)(C.ws + WS_WOUT); bf16* WGU = (bf16*)(C.ws + WS_WGU); bf16* WDN = (bf16*)(C.ws + WS_WDN);
    for (int it = gw; it < nitems; it += NGW) {
        int r = it;
        if (r < I_IN) { const int kb = r / 88, nb = r % 88; const int sc_ = win_src_col(nb * 32 + (C.lane & 31));
            const float* W = C.in(I_WIN) + (size_t)l * 1024 * PROJ_SRC;
            conv_item(sc_ >= 0 ? W + sc_ : nullptr, PROJ_SRC, 1024, WIN, scr, kb, nb, C.lane); continue; }
        r -= I_IN;
        if (r < I_OUT) { const int kb = r / 32, nb = r % 32; const float* W = C.in(I_WOUT) + (size_t)l * 1024 * 1024;
            conv_item(W + nb * 32 + (C.lane & 31), 1024, 1024, WOUT, scr, kb, nb, C.lane); continue; }
        r -= I_OUT;
        const int e = r / (I_GU + I_DN); r -= e * (I_GU + I_DN);
        const size_t eoff = (size_t)(j * ne + e) * 1024 * DFF;
        if (r < I_GU) { const int kb = r / 176, nb = r % 176; const int n = nb * 32 + (C.lane & 31), T = n >> 8, jj = n & 255;
            const float* Wg = (moe ? C.in(I_MG) : C.in(I_FG)) + eoff; const float* Wu = (moe ? C.in(I_MU) : C.in(I_FU)) + eoff;
            const float* colp = (jj < 128) ? Wg + T * 128 + jj : Wu + T * 128 + (jj - 128);
            conv_item(colp, DFF, 1024, WGU + (size_t)e * 5632 * 1024, scr, kb, nb, C.lane); continue; }
        r -= I_GU;
        { const int kb = r / 32, nb = r % 32; const float* Wd = (moe ? C.in(I_MD) : C.in(I_FD)) + eoff;
          conv_item(Wd + nb * 32 + (C.lane & 31), 1024, DFF, WDN + (size_t)e * 1024 * DFF, scr, kb, nb, C.lane); }
    }
}

__device__ __forceinline__ void ph_modulate0(Ctx& C) {
    const int gw = C.bid * 8 + C.wave, NGW = C.G * 8;
    const float* MOD = (const float*)(C.ws + WS_MOD); bf16* H = (bf16*)(C.ws + WS_H); const float* x = C.in(I_X);
    for (int row = gw; row < MTOK; row += NGW) {
        const int b = row >> 12; const float* md = MOD + (size_t)b * 6144;
#pragma unroll
        for (int j = 0; j < 4; ++j) {
            const int col = 4 * C.lane + 256 * j;
            const f32x4 v = *(const f32x4*)(x + (size_t)row * DM + col), sh = *(const f32x4*)(md + col), sc = *(const f32x4*)(md + 1024 + col);
            v2u o; o.x = pk2(v.x * (1.f + sc.x) + sh.x, v.y * (1.f + sc.y) + sh.y); o.y = pk2(v.z * (1.f + sc.z) + sh.z, v.w * (1.f + sc.w) + sh.w);
            *(v2u*)(H + (size_t)row * DM + col) = o;
        }
    }
}

struct GUnit { int arow0; int orow0; int pn; size_t boff; };
template <int MODE, class Epi>
__device__ __forceinline__ void gemm_simple_unit(Ctx& C, const bf16* A, int lda, const int* rowmap, const bf16* Bt, int K, const GUnit& u, const Epi& E) {
    const int rs = C.wave & 3, ch = C.wave >> 2, n = C.lane & 31, h = C.lane >> 5;
    const int r0 = u.arow0 + rs * 64 + n;
    const int ra = rowmap ? rowmap[r0] : r0, rb = rowmap ? rowmap[r0 + 32] : r0 + 32;
    const bf16* a0p = A + (size_t)ra * lda + 8 * h; const bf16* a1p = A + (size_t)rb * lda + 8 * h;
#pragma unroll 1
    for (int sp = 0; sp < 2; ++sp) {
        int br0, br1;
        if (MODE == 1) { const int jj = 2 * ch + sp; br0 = u.pn * 256 + 32 * jj; br1 = br0 + 128; }
        else { br0 = u.pn * 256 + 128 * ch + 64 * sp; br1 = br0 + 32; }
        const bf16* b0p = Bt + u.boff + (size_t)(br0 + n) * K + 8 * h; const bf16* b1p = Bt + u.boff + (size_t)(br1 + n) * K + 8 * h;
        f32x16 c00, c01, c10, c11;
#pragma unroll
        for (int i = 0; i < 16; ++i) { c00[i] = 0.f; c01[i] = 0.f; c10[i] = 0.f; c11[i] = 0.f; }
#pragma unroll 4
        for (int k = 0; k < K; k += 16) {
            const bf16x8 a0 = *(const bf16x8*)(a0p + k), a1 = *(const bf16x8*)(a1p + k), b0 = *(const bf16x8*)(b0p + k), b1 = *(const bf16x8*)(b1p + k);
            c00 = mfma32(a0, b0, c00); c01 = mfma32(a0, b1, c01); c10 = mfma32(a1, b0, c10); c11 = mfma32(a1, b1, c11);
        }
        const int orow = u.orow0 + rs * 64 + 4 * h;
        E(c00, c01, orow, br0, br1, n, u);
        E(c10, c11, orow + 32, br0, br1, n, u);
    }
}
struct EpiStoreS {
    bf16* O; int ldc;
    __device__ __forceinline__ void operator()(const f32x16& c0, const f32x16& c1, int orow, int br0, int br1, int n, const GUnit&) const {
#pragma unroll
        for (int r = 0; r < 16; ++r) { const size_t row = (size_t)(orow + (r & 3) + 8 * (r >> 2));
            O[row * ldc + br0 + n] = (bf16)f2bf(c0[r]); O[row * ldc + br1 + n] = (bf16)f2bf(c1[r]); }
    }
};
struct EpiSwigluS {
    bf16* O;
    __device__ __forceinline__ void operator()(const f32x16& c0, const f32x16& c1, int orow, int br0, int br1, int n, const GUnit& u) const {
        const int col = 128 * u.pn + (br0 - 256 * u.pn) + n;
#pragma unroll
        for (int r = 0; r < 16; ++r) { const size_t row = (size_t)(orow + (r & 3) + 8 * (r >> 2));
            O[row * DFF + col] = (bf16)f2bf(silu_f(c0[r]) * c1[r]); }
    }
};
struct EpiGateS {
    bf16* O; const float* gate;
    __device__ __forceinline__ void operator()(const f32x16& c0, const f32x16& c1, int orow, int br0, int br1, int n, const GUnit&) const {
#pragma unroll
        for (int r = 0; r < 16; ++r) { const size_t row = (size_t)(orow + (r & 3) + 8 * (r >> 2)); const float g = gate[row];
            O[row * DM + br0 + n] = (bf16)f2bf(c0[r] * g); O[row * DM + br1 + n] = (bf16)f2bf(c1[r] * g); }
    }
};

__device__ __forceinline__ void ph_gla_unit(Ctx& C, int l, int b, int hh) {
    LAS float* q_s = (LAS float*)C.lds;
    LAS float* k_s = q_s + 4096;
    LAS float* a_s = k_s + 4096;
    LAS float* v_s = a_s + 4096;
    LAS float* o_s = v_s + 8192;
    const bf16* PROJ = (const bf16*)(C.ws + WS_P); bf16* YM = (bf16*)(C.ws + WS_H);
    const float* w_a2 = C.in(I_WA2) + (size_t)l * 16 * 256; const float* b_a = C.in(I_BA) + l * 256; const float* gg = C.in(I_GLAG) + l * 128;
    const int e = C.tid >> 2, dg = C.tid & 3;
    float S[16];
#pragma unroll
    for (int i = 0; i < 16; ++i) S[i] = 0.f;
    for (int c = 0; c < 64; ++c) {
        const size_t row0 = (size_t)b * SEQ + c * 64;
        {
            const int t = C.tid >> 3, d0 = (C.tid & 7) * 8; const bf16* pr = PROJ + (row0 + t) * PW;
            const v4u qv = *(const v4u*)(pr + C_BQ + hh * 64 + d0), kv = *(const v4u*)(pr + C_BK + hh * 64 + d0);
            const v4u ba0 = *(const v4u*)(pr + C_BA), ba1 = *(const v4u*)(pr + C_BA + 8);
            float baf[16];
            baf[0] = bf2f(ba0.x & 0xffffu); baf[1] = bf2f(ba0.x >> 16); baf[2] = bf2f(ba0.y & 0xffffu); baf[3] = bf2f(ba0.y >> 16);
            baf[4] = bf2f(ba0.z & 0xffffu); baf[5] = bf2f(ba0.z >> 16); baf[6] = bf2f(ba0.w & 0xffffu); baf[7] = bf2f(ba0.w >> 16);
            baf[8] = bf2f(ba1.x & 0xffffu); baf[9] = bf2f(ba1.x >> 16); baf[10] = bf2f(ba1.y & 0xffffu); baf[11] = bf2f(ba1.y >> 16);
            baf[12] = bf2f(ba1.z & 0xffffu); baf[13] = bf2f(ba1.z >> 16); baf[14] = bf2f(ba1.w & 0xffffu); baf[15] = bf2f(ba1.w >> 16);
            const unsigned qw[4] = {qv.x, qv.y, qv.z, qv.w}, kw[4] = {kv.x, kv.y, kv.z, kv.w};
#pragma unroll
            for (int i = 0; i < 8; ++i) {
                const int d = d0 + i; float z = b_a[hh * 64 + d];
#pragma unroll
                for (int r = 0; r < 16; ++r) z += baf[r] * w_a2[r * 256 + hh * 64 + d];
                const float ls = fminf(z, 0.f) - log1pf(expf(-fabsf(z)));
                a_s[t * 64 + d] = expf(ls * (1.f / 16.f));
                const unsigned qq = (i & 1) ? (qw[i >> 1] >> 16) : (qw[i >> 1] & 0xffffu), kk = (i & 1) ? (kw[i >> 1] >> 16) : (kw[i >> 1] & 0xffffu);
                q_s[t * 64 + d] = bf2f(qq) * 0.125f; k_s[t * 64 + d] = bf2f(kk);
            }
            const int e0 = (C.tid & 7) * 16;
            const v4u v0 = *(const v4u*)(pr + C_BV + hh * 128 + e0), v1 = *(const v4u*)(pr + C_BV + hh * 128 + e0 + 8);
            const unsigned vw[8] = {v0.x, v0.y, v0.z, v0.w, v1.x, v1.y, v1.z, v1.w};
#pragma unroll
            for (int i = 0; i < 8; ++i) { v_s[t * 128 + e0 + 2 * i] = bf2f(vw[i] & 0xffffu); v_s[t * 128 + e0 + 2 * i + 1] = bf2f(vw[i] >> 16); }
        }
        __syncthreads();
        for (int tt = 0; tt < 64; ++tt) {
            const float vv = v_s[tt * 128 + e]; float po = 0.f;
#pragma unroll
            for (int i = 0; i < 16; ++i) { const int d = 16 * dg + i; S[i] = a_s[tt * 64 + d] * S[i] + k_s[tt * 64 + d] * vv; po += q_s[tt * 64 + d] * S[i]; }
            po += __shfl_xor(po, 1); po += __shfl_xor(po, 2);
            if (dg == 0) o_s[tt * 128 + e] = po;
        }
        __syncthreads();
#pragma unroll 1
        for (int r = 0; r < 8; ++r) {
            const int tt = C.wave * 8 + r; const float o0 = o_s[tt * 128 + C.lane], o1 = o_s[tt * 128 + 64 + C.lane];
            const float ss = wave_sum(o0 * o0 + o1 * o1); const float rstd = rsqrtf(ss * (1.f / 128.f) + LN_EPS);
            const bf16* pr = PROJ + (row0 + tt) * PW + C_BG + hh * 128; const float g0 = bf2f(pr[C.lane]), g1 = bf2f(pr[64 + C.lane]);
            bf16* yo = YM + (row0 + tt) * DM + 512 + hh * 128;
            yo[C.lane] = (bf16)f2bf(o0 * rstd * gg[C.lane] * silu_f(g0)); yo[64 + C.lane] = (bf16)f2bf(o1 * rstd * gg[64 + C.lane] * silu_f(g1));
        }
        __syncthreads();
    }
}

__device__ __forceinline__ unsigned sortable_u32(float f) { const unsigned u = __float_as_uint(f + 0.0f); return (u & 0x80000000u) ? ~u : (u | 0x80000000u); }
__device__ __forceinline__ void ph_dsa_a_unit(Ctx& C, int b, int t0) {
    LAS unsigned* sc = (LAS unsigned*)C.lds;
    LAS unsigned* cnt = (LAS unsigned*)(C.lds + 131072);
    const bf16* PROJ = (const bf16*)(C.ws + WS_P); unsigned* SEL = (unsigned*)(C.ws + WS_SEL);
    const int lane = C.lane, n = lane & 31, h = lane >> 5, tid = C.tid;
    const int nk = t0 + 8, ntile = (nk + 31) >> 5, nscan = ntile * 32;
    if (tid < 48) cnt[tid] = 0u;
    {
        bf16x8 af[2][4]; float wv[2][4][4];
#pragma unroll
        for (int mt = 0; mt < 2; ++mt) {
            const bf16* p = PROJ + (size_t)(b * SEQ + t0 + 4 * mt + (n >> 3)) * PW + C_IQ + (n & 7) * 64 + 8 * h;
#pragma unroll
            for (int ks = 0; ks < 4; ++ks) af[mt][ks] = *(const bf16x8*)(p + ks * 16);
#pragma unroll
            for (int jq = 0; jq < 4; ++jq)
#pragma unroll
                for (int i = 0; i < 4; ++i) wv[mt][jq][i] = bf2f(PROJ[(size_t)(b * SEQ + t0 + 4 * mt + jq) * PW + C_IW + i + 4 * h]) * (0.35355339059327373f * 0.125f);
        }
        for (int tile = C.wave; tile < ntile; tile += 8) {
            const int s = tile * 32 + n; const bf16* kp = PROJ + (size_t)(b * SEQ + s) * PW + C_IK + 8 * h;
            bf16x8 bfr[4];
#pragma unroll
            for (int ks = 0; ks < 4; ++ks) bfr[ks] = *(const bf16x8*)(kp + ks * 16);
#pragma unroll
            for (int mt = 0; mt < 2; ++mt) {
                f32x16 acc;
#pragma unroll
                for (int i = 0; i < 16; ++i) acc[i] = 0.f;
#pragma unroll
                for (int ks = 0; ks < 4; ++ks) acc = mfma32(af[mt][ks], bfr[ks], acc);
#pragma unroll
                for (int jq = 0; jq < 4; ++jq) {
                    float p = 0.f;
#pragma unroll
                    for (int i = 0; i < 4; ++i) p += wv[mt][jq][i] * fmaxf(acc[4 * jq + i], 0.f);
                    p += __shfl_xor(p, 32);
                    const int t = t0 + 4 * mt + jq; const unsigned u = (s <= t) ? sortable_u32(p) : 0u;
                    if (h == mt) sc[(4 * mt + jq) * 4096 + s] = u;
                }
            }
        }
    }
    __syncthreads();
    unsigned u[8][8];
#pragma unroll
    for (int i = 0; i < 8; ++i) {
        const int s = tid + 512 * i; const bool inr = s < nscan; const int sidx = inr ? s : 0;
#pragma unroll
        for (int q = 0; q < 8; ++q) { const unsigned v = sc[q * 4096 + sidx]; u[i][q] = inr ? v : 0u; }
    }
    unsigned T[8], J[8], need[8];
#pragma unroll
    for (int q = 0; q < 8; ++q) { T[q] = 0u; J[q] = 8192u; need[q] = 0u; }
    int buf = 0;
    for (int bit = 31; bit >= 0; --bit) {
        unsigned cq[8];
#pragma unroll
        for (int q = 0; q < 8; ++q) cq[q] = 0u;
#pragma unroll
        for (int i = 0; i < 8; ++i) if (512 * i < nscan) {
#pragma unroll
            for (int q = 0; q < 8; ++q) cq[q] += (unsigned)__popcll(__ballot(u[i][q] >= (T[q] | (1u << bit))));
        }
        unsigned myc = 0u;
#pragma unroll
        for (int q = 0; q < 8; ++q) myc = (lane == q) ? cq[q] : myc;
        if (lane < 8) __hip_atomic_fetch_add(cnt + buf * 16 + lane, myc, __ATOMIC_RELAXED, __HIP_MEMORY_SCOPE_WORKGROUP);
        const int nb = (buf == 2) ? 0 : buf + 1;
        if (tid >= 64 && tid < 80) cnt[nb * 16 + (tid - 64)] = 0u;
        __syncthreads();
#pragma unroll
        for (int q = 0; q < 8; ++q) if (cnt[buf * 16 + q] >= 256u) T[q] |= (1u << bit);
        buf = nb;
    }
#pragma unroll
    for (int q = 0; q < 8; ++q) T[q] = T[q] < 1u ? 1u : T[q];
    bool extra = false;
    {
        unsigned cg[8], ce[8];
#pragma unroll
        for (int q = 0; q < 8; ++q) { cg[q] = 0u; ce[q] = 0u; }
#pragma unroll
        for (int i = 0; i < 8; ++i) if (512 * i < nscan) {
#pragma unroll
            for (int q = 0; q < 8; ++q) { cg[q] += (unsigned)__popcll(__ballot(u[i][q] > T[q])); ce[q] += (unsigned)__popcll(__ballot(u[i][q] >= T[q])); }
        }
        unsigned myc = 0u;
#pragma unroll
        for (int q = 0; q < 8; ++q) { myc = (lane == q) ? cg[q] : myc; myc = (lane == 8 + q) ? ce[q] : myc; }
        if (lane < 16) __hip_atomic_fetch_add(cnt + buf * 16 + lane, myc, __ATOMIC_RELAXED, __HIP_MEMORY_SCOPE_WORKGROUP);
        const int nb = (buf == 2) ? 0 : buf + 1;
        if (tid >= 64 && tid < 80) cnt[nb * 16 + (tid - 64)] = 0u;
        __syncthreads();
#pragma unroll
        for (int q = 0; q < 8; ++q) { const unsigned g = cnt[buf * 16 + q], ge = cnt[buf * 16 + 8 + q]; need[q] = 256u - (g < 256u ? g : 256u); extra = extra || (ge > 256u); }
        buf = nb;
    }
    if (extra) {
#pragma unroll
        for (int q = 0; q < 8; ++q) J[q] = 0u;
        for (int bit = 12; bit >= 0; --bit) {
            unsigned cq[8];
#pragma unroll
            for (int q = 0; q < 8; ++q) cq[q] = 0u;
#pragma unroll
            for (int i = 0; i < 8; ++i) if (512 * i < nscan) {
                const unsigned s = (unsigned)(tid + 512 * i);
#pragma unroll
                for (int q = 0; q < 8; ++q) cq[q] += (unsigned)__popcll(__ballot(u[i][q] == T[q] && s < (J[q] | (1u << bit))));
            }
            unsigned myc = 0u;
#pragma unroll
            for (int q = 0; q < 8; ++q) myc = (lane == q) ? cq[q] : myc;
            if (lane < 8) __hip_atomic_fetch_add(cnt + buf * 16 + lane, myc, __ATOMIC_RELAXED, __HIP_MEMORY_SCOPE_WORKGROUP);
            const int nb = (buf == 2) ? 0 : buf + 1;
            if (tid >= 64 && tid < 80) cnt[nb * 16 + (tid - 64)] = 0u;
            __syncthreads();
#pragma unroll
            for (int q = 0; q < 8; ++q) if (cnt[buf * 16 + q] <= need[q]) J[q] |= (1u << bit);
            buf = nb;
        }
    }
#pragma unroll
    for (int i = 0; i < 8; ++i) if (512 * i < nscan) {
        const unsigned s = (unsigned)(tid + 512 * i); const int tile0 = 2 * C.wave + 16 * i;
#pragma unroll
        for (int q = 0; q < 8; ++q) {
            const unsigned long long bm = __ballot((u[i][q] > T[q]) || (u[i][q] == T[q] && s < J[q]));
            if (lane == 0) { unsigned* w = SEL + (size_t)(b * SEQ + t0 + q) * 128 + tile0;
                if (tile0 < ntile) w[0] = (unsigned)bm; if (tile0 + 1 < ntile) w[1] = (unsigned)(bm >> 32); }
        }
    }
    __syncthreads();
}

__device__ __forceinline__ void ph_dsa_b_unit(Ctx& C, int b, int t0) {
    LAS float* qs = (LAS float*)C.lds + C.wave * 512;
    LAS int* lst = (LAS int*)(C.lds + 16384) + C.wave * 256;
    LAS float* pl = (LAS float*)(C.lds + 16384 + 8192) + C.wave * 2048;
    const bf16* PROJ = (const bf16*)(C.ws + WS_P); const unsigned* SEL = (const unsigned*)(C.ws + WS_SEL); bf16* YM = (bf16*)(C.ws + WS_H);
    const int lane = C.lane, t = t0 + C.wave; const size_t row = (size_t)b * SEQ + t;
    const int ntile = (t >> 5) + 1;
    int base = 0;
#pragma unroll 1
    for (int rd = 0; rd < 2; ++rd) {
        const int wi = rd * 64 + lane; unsigned w = (wi < ntile) ? SEL[row * 128 + wi] : 0u;
        const int c = __popc(w); int incl = c;
#pragma unroll
        for (int o = 1; o < 64; o <<= 1) { const int v = __shfl_up(incl, o); if (lane >= o) incl += v; }
        int pos = base + incl - c;
        while (w) { const int bit = __ffs(w) - 1; w &= w - 1; if (pos < 256) lst[pos] = wi * 32 + bit; ++pos; }
        base += __shfl(incl, 63);
    }
    const int nsel = base < 256 ? base : 256;
    {
        const v4u qv = *(const v4u*)(PROJ + row * PW + C_AQ + lane * 8); const unsigned qw[4] = {qv.x, qv.y, qv.z, qv.w};
#pragma unroll
        for (int i = 0; i < 4; ++i) { qs[lane * 8 + 2 * i] = bf2f(qw[i] & 0xffffu) * (0.125f * LOG2E); qs[lane * 8 + 2 * i + 1] = bf2f(qw[i] >> 16) * (0.125f * LOG2E); }
    }
    asm volatile("s_waitcnt lgkmcnt(0)" ::: "memory");
    float mx[8];
#pragma unroll
    for (int hd = 0; hd < 8; ++hd) mx[hd] = -3.0e38f;
#pragma unroll 1
    for (int i = 0; i < 4; ++i) {
        const int j = lane + 64 * i;
        asm volatile("" ::: "memory");
        if (j < nsel) {
            const int s = lst[j];
            const bf16* kp = PROJ + ((size_t)b * SEQ + s) * PW + C_AK;
            float kr[64];
#pragma unroll
            for (int c8 = 0; c8 < 8; ++c8) { const v4u kv = *(const v4u*)(kp + 8 * c8); const unsigned kw[4] = {kv.x, kv.y, kv.z, kv.w};
#pragma unroll
                for (int x = 0; x < 4; ++x) { kr[8 * c8 + 2 * x] = bf2f(kw[x] & 0xffffu); kr[8 * c8 + 2 * x + 1] = bf2f(kw[x] >> 16); } }
#pragma unroll
            for (int hd = 0; hd < 8; ++hd) {
                float d = 0.f;
#pragma unroll
                for (int x = 0; x < 64; ++x) d += qs[hd * 64 + x] * kr[x];
                const float slope2 = exp2f(-(float)(hd + 1)) * LOG2E;
                const float lgv = d - slope2 * (float)(t - s);
                pl[j * 8 + hd] = lgv; mx[hd] = fmaxf(mx[hd], lgv);
            }
        }
    }
#pragma unroll
    for (int hd = 0; hd < 8; ++hd) mx[hd] = wave_max(mx[hd]);
    asm volatile("s_waitcnt lgkmcnt(0)" ::: "memory");
    float sm[8];
#pragma unroll
    for (int hd = 0; hd < 8; ++hd) sm[hd] = 0.f;
#pragma unroll 1
    for (int i = 0; i < 4; ++i) {
        const int j = lane + 64 * i;
        if (j < nsel) {
#pragma unroll
            for (int hd = 0; hd < 8; ++hd) { const float p = exp2f(pl[j * 8 + hd] - mx[hd]); pl[j * 8 + hd] = p; sm[hd] += p; }
        }
    }
#pragma unroll
    for (int hd = 0; hd < 8; ++hd) sm[hd] = 1.f / wave_sum(sm[hd]);
    asm volatile("s_waitcnt lgkmcnt(0)" ::: "memory");
    float acc[8];
#pragma unroll
    for (int hd = 0; hd < 8; ++hd) acc[hd] = 0.f;
    const bf16* vb = PROJ + (size_t)b * SEQ * PW + C_AV + lane;
#pragma unroll 4
    for (int j = 0; j < nsel; ++j) {
        const int s = lst[j]; const float v = bf2f(vb[(size_t)s * PW]);
        const f32x4 p0 = *(const LAS f32x4*)(pl + j * 8), p1 = *(const LAS f32x4*)(pl + j * 8 + 4);
        acc[0] += p0.x * v; acc[1] += p0.y * v; acc[2] += p0.z * v; acc[3] += p0.w * v; acc[4] += p1.x * v; acc[5] += p1.y * v; acc[6] += p1.z * v; acc[7] += p1.w * v;
    }
#pragma unroll
    for (int hd = 0; hd < 8; ++hd) acc[hd] *= sm[hd];
#pragma unroll
    for (int hd = 0; hd < 8; ++hd) YM[row * DM + hd * 64 + lane] = (bf16)f2bf(acc[hd]);
}

struct LnRaw { f32x4 x[4]; v2u ya[4]; v2u yb[4]; v2u hx[4]; };
template <bool ROUTE, int YMODE, int XMODE>
__device__ __forceinline__ void ph_ln(Ctx& C, const float* Xin, int l, int which, int mod_g, int mod_l2, int mod_sh, bool write_h, int jmoe, int mod_in, bool write_x) {
    const int gw = C.bid * 8 + C.wave, NGW = C.G * 8, lane = C.lane;
    const float* MOD = (const float*)(C.ws + WS_MOD); bf16* H = (bf16*)(C.ws + WS_H); const bf16* Y = (const bf16*)(C.ws + WS_Y);
    const float* lng = C.in(I_LNG) + (size_t)(l * 2 + which) * DM; const float* lnb = C.in(I_LNB) + (size_t)(l * 2 + which) * DM;
    const int* TOKSLOT = (const int*)(C.ws + WS_TOKSLOT);
    const float* wr = C.in(I_WR) + (size_t)jmoe * DM * NEXP; const float* br = C.in(I_BR) + jmoe * NEXP;
    int* TOPE = (int*)(C.ws + WS_TOPE); float* TOPG = (float*)(C.ws + WS_TOPG);
    unsigned ecnt[8];
#pragma unroll
    for (int e = 0; e < 8; ++e) ecnt[e] = 0u;
    LAS float* wrs = (LAS float*)C.lds;
    if (ROUTE) { for (int i = C.tid; i < DM * NEXP / 4; i += 512) ((LAS f32x4*)wrs)[i] = ((const f32x4*)wr)[i]; __syncthreads(); }
    const int RPW = (MTOK + NGW - 1) / NGW;
    const int r0 = gw * RPW, r1 = (r0 + RPW < MTOK) ? r0 + RPW : MTOK;
    if (r0 < MTOK) {
        const int b = r0 >> 12;
        const bool one_batch = ((r1 - 1) >> 12) == b;
        const float* mg = MOD + ((size_t)l * 16 + b) * 6144 + mod_g;
        const float* mi = MOD + ((size_t)l * 16 + b) * 6144 + mod_in;
        const float* ms = MOD + ((size_t)mod_l2 * 16 + b) * 6144 + mod_sh;
        f32x4 gv[4], shi[4], sci[4];
#pragma unroll
        for (int j = 0; j < 4; ++j) { const int col = 4 * lane + 256 * j; gv[j] = *(const f32x4*)(mg + col);
            if (XMODE == 1) { shi[j] = *(const f32x4*)(mi + col); const f32x4 sc_ = *(const f32x4*)(mi + 1024 + col); sci[j].x = 1.f / (sc_.x + 1.f); sci[j].y = 1.f / (sc_.y + 1.f); sci[j].z = 1.f / (sc_.z + 1.f); sci[j].w = 1.f / (sc_.w + 1.f); } }
        f32x4 Av[4], Bv[4];
#pragma unroll
        for (int j = 0; j < 4; ++j) { const int col = 4 * lane + 256 * j; const f32x4 gn = *(const f32x4*)(lng + col), bn = *(const f32x4*)(lnb + col);
            if (write_h) { const f32x4 sh = *(const f32x4*)(ms + col), sc = *(const f32x4*)(ms + 1024 + col); Av[j] = gn * (sc + 1.f); Bv[j] = bn * (sc + 1.f) + sh; } else { Av[j] = gn; Bv[j] = bn; } }
        int sl0 = 0, sl1 = 0;
        if (YMODE == 1 && r0 + lane < r1) { sl0 = TOKSLOT[2 * (r0 + lane)]; sl1 = TOKSLOT[2 * (r0 + lane) + 1]; }
#define LN_LOAD(R, row_) { const int s0_ = (YMODE == 1) ? (((row_) - r0 < 64) ? __builtin_amdgcn_readlane(sl0, (row_) - r0) : TOKSLOT[2 * (row_)]) : 0, s1_ = (YMODE == 1) ? (((row_) - r0 < 64) ? __builtin_amdgcn_readlane(sl1, (row_) - r0) : TOKSLOT[2 * (row_) + 1]) : 0; \
        const bf16* y0_ = (YMODE == 0) ? Y + (size_t)(row_) * DM : Y + (size_t)s0_ * DM; const bf16* y1_ = Y + (size_t)s1_ * DM; \
        _Pragma("unroll") for (int j = 0; j < 4; ++j) { const int col = 4 * lane + 256 * j; \
            if (XMODE == 0) R.x[j] = *(const f32x4*)(Xin + (size_t)(row_) * DM + col); else R.hx[j] = *(const v2u*)(H + (size_t)(row_) * DM + col); \
            R.ya[j] = *(const v2u*)(y0_ + col); if (YMODE == 1) R.yb[j] = *(const v2u*)(y1_ + col); } }
        LnRaw cur, nx1, nx2;
        LN_LOAD(cur, r0)
        if (r0 + 1 < r1) LN_LOAD(nx1, r0 + 1)
        for (int row = r0; row < r1; ++row) {
            if (ROUTE) asm volatile("" ::: "memory");
            if (row + 2 < r1) LN_LOAD(nx2, row + 2)
            if (!one_batch) {
                const int bb = row >> 12; const float* mg2 = MOD + ((size_t)l * 16 + bb) * 6144 + mod_g; const float* mi2 = MOD + ((size_t)l * 16 + bb) * 6144 + mod_in;
#pragma unroll
                for (int j = 0; j < 4; ++j) { const int col = 4 * lane + 256 * j; gv[j] = *(const f32x4*)(mg2 + col);
                    if (XMODE == 1) { shi[j] = *(const f32x4*)(mi2 + col); const f32x4 sc_ = *(const f32x4*)(mi2 + 1024 + col); sci[j].x = 1.f / (sc_.x + 1.f); sci[j].y = 1.f / (sc_.y + 1.f); sci[j].z = 1.f / (sc_.z + 1.f); sci[j].w = 1.f / (sc_.w + 1.f); } }
            }
            if (!one_batch) {
                const float* msr = MOD + ((size_t)mod_l2 * 16 + (row >> 12)) * 6144 + mod_sh;
#pragma unroll
                for (int j = 0; j < 4; ++j) { const int col = 4 * lane + 256 * j; const f32x4 gn = *(const f32x4*)(lng + col), bn = *(const f32x4*)(lnb + col);
                    if (write_h) { const f32x4 sh = *(const f32x4*)(msr + col), sc = *(const f32x4*)(msr + 1024 + col); Av[j] = gn * (sc + 1.f); Bv[j] = bn * (sc + 1.f) + sh; } else { Av[j] = gn; Bv[j] = bn; } }
            }
            f32x4 v[4]; float s = 0.f;
#pragma unroll
            for (int j = 0; j < 4; ++j) {
                const v2u ya = cur.ya[j];
                f32x4 y; y.x = bf2f(ya.x & 0xffffu); y.y = bf2f(ya.x >> 16); y.z = bf2f(ya.y & 0xffffu); y.w = bf2f(ya.y >> 16);
                if (YMODE == 1) { const v2u yb = cur.yb[j]; y.x += bf2f(yb.x & 0xffffu); y.y += bf2f(yb.x >> 16); y.z += bf2f(yb.y & 0xffffu); y.w += bf2f(yb.y >> 16); }
                f32x4 xr;
                if (XMODE == 0) xr = cur.x[j];
                else { const v2u hh_ = cur.hx[j]; f32x4 hf; hf.x = bf2f(hh_.x & 0xffffu); hf.y = bf2f(hh_.x >> 16); hf.z = bf2f(hh_.y & 0xffffu); hf.w = bf2f(hh_.y >> 16);
                       xr = (hf - shi[j]) * sci[j]; }
                v[j] = xr * DN_ALPHA + (gv[j] + 1.f) * y;
                s += (v[j].x + v[j].y) + (v[j].z + v[j].w);
            }
            const float mean = wave_sum_f(s) * (1.f / DM); float s2 = 0.f;
#pragma unroll
            for (int j = 0; j < 4; ++j) { v[j] = v[j] - mean; s2 += (v[j].x * v[j].x + v[j].y * v[j].y) + (v[j].z * v[j].z + v[j].w * v[j].w); }
            const float rstd = rsqrtf(wave_sum_f(s2) * (1.f / DM) + LN_EPS);
            float lgt[8];
#pragma unroll
            for (int e = 0; e < 8; ++e) lgt[e] = 0.f;
#pragma unroll
            for (int j = 0; j < 4; ++j) {
                const int col = 4 * lane + 256 * j;
                const f32x4 hv = v[j] * rstd * Av[j] + Bv[j];
                if (write_x) *(f32x4*)(C.out + (size_t)row * DM + col) = hv;
                if (write_h) {
                    v2u o; o.x = pk2(hv.x, hv.y); o.y = pk2(hv.z, hv.w);
                    *(v2u*)(H + (size_t)row * DM + col) = o;
                    if (ROUTE) {
                        const float hx[4] = {hv.x, hv.y, hv.z, hv.w};
#pragma unroll
                        for (int c = 0; c < 4; ++c) { const f32x4 w0 = *(const LAS f32x4*)(wrs + (col + c) * NEXP), w1 = *(const LAS f32x4*)(wrs + (col + c) * NEXP + 4);
                            lgt[0] += hx[c] * w0.x; lgt[1] += hx[c] * w0.y; lgt[2] += hx[c] * w0.z; lgt[3] += hx[c] * w0.w;
                            lgt[4] += hx[c] * w1.x; lgt[5] += hx[c] * w1.y; lgt[6] += hx[c] * w1.z; lgt[7] += hx[c] * w1.w; }
                    }
                }
            }
            if (ROUTE) {
#pragma unroll
                for (int e = 0; e < 8; ++e) lgt[e] = wave_sum_f(lgt[e]) + br[e];
                int e0 = 0; float v0 = lgt[0];
#pragma unroll
                for (int e = 1; e < 8; ++e) if (lgt[e] > v0) { v0 = lgt[e]; e0 = e; }
                int e1 = -1; float v1 = -3.0e38f;
#pragma unroll
                for (int e = 0; e < 8; ++e) if (e != e0 && lgt[e] > v1) { v1 = lgt[e]; e1 = e; }
                const float g1 = 1.f / (1.f + expf(v0 - v1)), g0 = 1.f - g1;
                if (lane == 0) { TOPE[2 * row] = e0; TOPE[2 * row + 1] = e1; TOPG[2 * row] = g0; TOPG[2 * row + 1] = g1; }
#pragma unroll
                for (int e = 0; e < 8; ++e) ecnt[e] += (e == e0 ? 1u : 0u) + (e == e1 ? 1u : 0u);
            }
            cur = nx1; nx1 = nx2;
        }
#undef LN_LOAD
    }
    if (ROUTE) {
        unsigned mine = 0u;
#pragma unroll
        for (int e = 0; e < 8; ++e) mine = (lane == e) ? ecnt[e] : mine;
        if (lane < 8 && mine) __hip_atomic_fetch_add(C.ctl + CW_CNT + 64 * jmoe + lane, mine, __ATOMIC_RELAXED, __HIP_MEMORY_SCOPE_AGENT);
    }
}

struct MoeTab { int pend[8]; int npanels; };
__device__ __forceinline__ MoeTab moe_tab(Ctx& C, int jmoe) {
    MoeTab t; int acc = 0;
#pragma unroll
    for (int e = 0; e < 8; ++e) { const int c = (int)__hip_atomic_load(C.ctl + CW_CNT + 64 * jmoe + e, __ATOMIC_RELAXED, __HIP_MEMORY_SCOPE_AGENT); acc += (c + 255) & ~255; t.pend[e] = acc; }
    t.npanels = acc >> 8; return t;
}
__device__ __forceinline__ int panel_expert(const MoeTab& t, int p) {
    int e = 0;
#pragma unroll
    for (int k = 0; k < 7; ++k) e += (p * 256 >= t.pend[k]) ? 1 : 0;
    return e;
}
__device__ __forceinline__ void ph_assign(Ctx& C, int jmoe) {
    const int gw = C.bid * 8 + C.wave, NGW = C.G * 8, lane = C.lane;
    const MoeTab tb = moe_tab(C, jmoe);
    const int* TOPE = (const int*)(C.ws + WS_TOPE); const float* TOPG = (const float*)(C.ws + WS_TOPG);
    int* TOKSLOT = (int*)(C.ws + WS_TOKSLOT); int* ROWTOK = (int*)(C.ws + WS_ROWTOK); float* ROWGATE = (float*)(C.ws + WS_ROWGATE);
    const bf16* H = (const bf16*)(C.ws + WS_H); bf16* HS = (bf16*)(C.ws + WS_Y);
    const unsigned long long ltmask = (lane == 0) ? 0ull : (~0ull >> (64 - lane));
    for (int tk0 = gw * 32; tk0 < MTOK; tk0 += NGW * 32) {
        const int tok = tk0 + (lane & 31); const bool act = lane < 32;
        const int e0 = act ? TOPE[2 * tok] : -1, e1 = act ? TOPE[2 * tok + 1] : -1; const float g0 = TOPG[2 * tok], g1 = TOPG[2 * tok + 1];
        int s0 = 0, s1 = 0;
#pragma unroll
        for (int e = 0; e < 8; ++e) {
            const unsigned long long m0 = __ballot(e0 == e), m1 = __ballot(e1 == e); const int n0 = __popcll(m0), n1 = __popcll(m1);
            int basev = 0;
            if (lane == 0 && (n0 + n1) > 0) basev = (int)__hip_atomic_fetch_add(C.ctl + CW_FILL + 64 * jmoe + e, (unsigned)(n0 + n1), __ATOMIC_RELAXED, __HIP_MEMORY_SCOPE_AGENT);
            basev = __builtin_amdgcn_readfirstlane(basev);
            const int pstart = (e == 0) ? 0 : tb.pend[e > 0 ? e - 1 : 0];
            if (e0 == e) s0 = pstart + basev + __popcll(m0 & ltmask);
            if (e1 == e) s1 = pstart + basev + n0 + __popcll(m1 & ltmask);
        }
        if (act) { TOKSLOT[2 * tok] = s0; TOKSLOT[2 * tok + 1] = s1;
            ROWTOK[s0] = tok; ROWGATE[s0] = g0; ROWTOK[s1] = tok; ROWGATE[s1] = g1; }
    }
    for (int idx = gw; idx < 8 * 256; idx += NGW) {
        const int e = idx >> 8, jj = idx & 255;
        const int c = (int)__hip_atomic_load(C.ctl + CW_CNT + 64 * jmoe + e, __ATOMIC_RELAXED, __HIP_MEMORY_SCOPE_AGENT);
        int pstart = 0;
#pragma unroll
        for (int k = 0; k < 7; ++k) if (k < e) pstart = tb.pend[k];
        const int slot = pstart + c + jj;
        if (c + jj < ((c + 255) & ~255)) {
            if (lane == 0) { ROWTOK[slot] = 0; ROWGATE[slot] = 0.f; }
        }
    }
}

__device__ __forceinline__ float silu_fast_(float v) { return v * __builtin_amdgcn_rcpf(1.f + __builtin_amdgcn_exp2f(-v * LOG2E)); }
constexpr size_t WS_GLA_LT = WS_Y;
constexpr size_t WS_GLA_SP = WS_Y + 130 * MiB;
constexpr size_t WS_GLA_EB = WS_Y + 128 * MiB;
constexpr int GLA_PITCH = 72;

struct GlaDecay { float b[8]; float Btot; float qv[8]; float kv[8]; };
__device__ __forceinline__ void gla_decay(Ctx& C, int l, int b, int hh, int c, LAS float* segs, GlaDecay& D, int bas_off = 36864) {
    const bf16* PROJ = (const bf16*)(C.ws + WS_P);
    const float* w_a2 = C.in(I_WA2) + (size_t)l * 16 * 256 + hh * 64 + C.lane; const float bias = C.in(I_BA)[l * 256 + hh * 64 + C.lane];
    float w[16];
#pragma unroll
    for (int r = 0; r < 16; ++r) w[r] = w_a2[r * 256];
    const size_t row0 = (size_t)b * SEQ + c * 64 + 8 * C.wave;
    LAS unsigned* baS = (LAS unsigned*)(C.lds + bas_off) + C.wave * 64;
    baS[C.lane] = *(const unsigned*)(PROJ + (row0 + (C.lane >> 3)) * PW + C_BA + 2 * (C.lane & 7));
    float qraw[8], kraw[8];
#pragma unroll
    for (int i = 0; i < 8; ++i) { const bf16* pr = PROJ + (row0 + i) * PW; qraw[i] = bf2f(pr[C_BQ + hh * 64 + C.lane]); kraw[i] = bf2f(pr[C_BK + hh * 64 + C.lane]); }
    asm volatile("s_waitcnt lgkmcnt(0)" ::: "memory");
    float run = 0.f;
#pragma unroll
    for (int i = 0; i < 8; ++i) {
        const v4u ba0 = *(const LAS v4u*)(baS + 8 * i), ba1 = *(const LAS v4u*)(baS + 8 * i + 4);
        const unsigned bw[8] = {ba0.x, ba0.y, ba0.z, ba0.w, ba1.x, ba1.y, ba1.z, ba1.w};
        float z = bias;
#pragma unroll
        for (int r = 0; r < 8; ++r) { z += bf2f(bw[r] & 0xffffu) * w[2 * r]; z += bf2f(bw[r] >> 16) * w[2 * r + 1]; }
        const float ls = fminf(z, 0.f) - __logf(1.f + __expf(-fabsf(z)));
        run += ls * (1.f / 16.f);
        D.b[i] = run;
        D.qv[i] = qraw[i]; D.kv[i] = kraw[i];
    }
    segs[C.wave * 64 + C.lane] = run;
    __syncthreads();
    float off = 0.f, tot = 0.f;
#pragma unroll
    for (int w8 = 0; w8 < 8; ++w8) { const float sv = segs[w8 * 64 + C.lane]; tot += sv; off += (w8 < C.wave) ? sv : 0.f; }
#pragma unroll
    for (int i = 0; i < 8; ++i) D.b[i] += off;
    D.Btot = tot;
}
__device__ __forceinline__ bf16x8 gla_vt_frag(const bf16* vcol, int ks, int h) {
    unsigned short x[8];
#pragma unroll
    for (int j = 0; j < 8; ++j) x[j] = vcol[(size_t)(16 * ks + 8 * (j >> 2) + 4 * h + (j & 3)) * PW];
    v4u p; p.x = (unsigned)x[0] | ((unsigned)x[1] << 16); p.y = (unsigned)x[2] | ((unsigned)x[3] << 16); p.z = (unsigned)x[4] | ((unsigned)x[5] << 16); p.w = (unsigned)x[6] | ((unsigned)x[7] << 16);
    return __builtin_bit_cast(bf16x8, p);
}

__device__ __forceinline__ void ph_gla1_unit(Ctx& C, int l, int unit) {
    const int c = unit & 63, hh = (unit >> 6) & 3, b = unit >> 8;
    LAS bf16* KDT = (LAS bf16*)C.lds;
    LAS float* segs = (LAS float*)(C.lds + 32768);
    const bf16* PROJ = (const bf16*)(C.ws + WS_P);
    const int mt = C.wave >> 1, nd = C.wave & 1, n = C.lane & 31, h = C.lane >> 5;
    const bf16* vcol = PROJ + ((size_t)b * SEQ + c * 64) * PW + C_BV + hh * 128 + 32 * mt + n;
    bf16x8 vf[4];
#pragma unroll
    for (int ks = 0; ks < 4; ++ks) vf[ks] = gla_vt_frag(vcol, ks, h);
    GlaDecay D; gla_decay(C, l, b, hh, c, segs, D);
    {
        v4u p;
        p.x = pk2(D.kv[0] * __expf(D.Btot - D.b[0]), D.kv[1] * __expf(D.Btot - D.b[1])); p.y = pk2(D.kv[2] * __expf(D.Btot - D.b[2]), D.kv[3] * __expf(D.Btot - D.b[3]));
        p.z = pk2(D.kv[4] * __expf(D.Btot - D.b[4]), D.kv[5] * __expf(D.Btot - D.b[5])); p.w = pk2(D.kv[6] * __expf(D.Btot - D.b[6]), D.kv[7] * __expf(D.Btot - D.b[7]));
        *(LAS v4u*)(KDT + C.lane * GLA_PITCH + 8 * C.wave) = p;
        if (C.wave == 0) ((float*)(C.ws + WS_GLA_EB))[(size_t)unit * 64 + C.lane] = __expf(D.Btot);
    }
    __syncthreads();
    f32x16 acc;
#pragma unroll
    for (int i = 0; i < 16; ++i) acc[i] = 0.f;
#pragma unroll
    for (int ks = 0; ks < 4; ++ks) {
        const LAS bf16* kp = KDT + (32 * nd + n) * GLA_PITCH + 16 * ks + 4 * h;
        const v2u k0 = *(const LAS v2u*)kp, k1 = *(const LAS v2u*)(kp + 8);
        v4u kk; kk.x = k0.x; kk.y = k0.y; kk.z = k1.x; kk.w = k1.y;
        acc = mfma32(vf[ks], __builtin_bit_cast(bf16x8, kk), acc);
    }
    float* LT = (float*)(C.ws + WS_GLA_LT) + (size_t)unit * 8192;
#pragma unroll
    for (int r = 0; r < 16; ++r) LT[(32 * mt + (r & 3) + 8 * (r >> 2) + 4 * h) * 64 + 32 * nd + n] = acc[r];
    __syncthreads();
}

__device__ __forceinline__ void ph_gla2(Ctx& C, size_t probe_off = 0) {
    const f32x4* LT = (const f32x4*)(C.ws + WS_GLA_LT); v2u* SP = (v2u*)(C.ws + WS_GLA_SP + probe_off); const float* EB = (const float*)(C.ws + WS_GLA_EB);
    for (int it = C.bid; it < 64 * 4; it += C.G) {
        const int bh = it >> 2, idx = (it & 3) * 512 + C.tid;
        const f32x4* p = LT + (size_t)bh * 64 * 2048 + idx; v2u* q = SP + (size_t)bh * 64 * 2048 + idx; const float* eb = EB + (size_t)bh * 64 * 64 + ((4 * idx) & 63);
        float S0 = 0.f, S1 = 0.f, S2 = 0.f, S3 = 0.f;
#pragma unroll 16
        for (int c = 0; c < 64; ++c) { const f32x4 lv = p[(size_t)c * 2048]; const f32x4 e = *(const f32x4*)(eb + c * 64);
            v2u o; o.x = pk2(S0, S1); o.y = pk2(S2, S3); q[(size_t)c * 2048] = o;
            S0 = e.x * S0 + lv.x; S1 = e.y * S1 + lv.y; S2 = e.z * S2 + lv.z; S3 = e.w * S3 + lv.w; }
    }
}

__device__ __forceinline__ void ph_gla3_unit(Ctx& C, int l, int unit) {
    const int c = unit & 63, hh = (unit >> 6) & 3, b = unit >> 8;
    LAS bf16* QE = (LAS bf16*)C.lds;
    LAS bf16* KE = QE + 64 * GLA_PITCH;
    LAS float* segs = (LAS float*)(C.lds + 32768);
    LAS float* ssq = (LAS float*)(C.lds + 32768 + 2048);
    const bf16* PROJ = (const bf16*)(C.ws + WS_P); bf16* YM = (bf16*)C.out;
    const int mt = C.wave >> 1, nt = C.wave & 1, n = C.lane & 31, h = C.lane >> 5;
    const size_t row0 = (size_t)b * SEQ + c * 64;
    const bf16* vcol = PROJ + row0 * PW + C_BV + hh * 128 + 32 * mt + n;
    bf16x8 vf[4]; bf16x8 spf[4]; v2u gb[4]; f32x4 gnv[4];
#pragma unroll
    for (int ks = 0; ks < 4; ++ks) vf[ks] = gla_vt_frag(vcol, (ks <= 2 * nt + 1) ? ks : 0, h);
    {
        const bf16* Sp = (const bf16*)(C.ws + WS_GLA_SP) + (size_t)unit * 8192 + (size_t)(32 * mt + n) * 64 + 8 * h;
#pragma unroll
        for (int ks = 0; ks < 4; ++ks) spf[ks] = *(const bf16x8*)(Sp + 16 * ks);
#pragma unroll
        for (int j4 = 0; j4 < 4; ++j4) { gb[j4] = *(const v2u*)(PROJ + (row0 + 32 * nt + n) * PW + C_BG + hh * 128 + 32 * mt + 8 * j4 + 4 * h); gnv[j4] = *(const f32x4*)(C.in(I_GLAG) + l * 128 + 32 * mt + 8 * j4 + 4 * h); }
    }
    GlaDecay D; gla_decay(C, l, b, hh, c, segs, D);
#pragma unroll
    for (int i = 0; i < 8; ++i) {
        QE[(8 * C.wave + i) * GLA_PITCH + C.lane] = (bf16)f2bf(D.qv[i] * 0.125f * __expf(D.b[i]));
        KE[(8 * C.wave + i) * GLA_PITCH + C.lane] = (bf16)f2bf(D.kv[i] * __expf(-D.b[i]));
    }
    __syncthreads();
    bf16x8 qf[4];
#pragma unroll
    for (int ks = 0; ks < 4; ++ks) qf[ks] = *(const LAS bf16x8*)(QE + (32 * nt + n) * GLA_PITCH + 16 * ks + 8 * h);
    f32x16 accO;
#pragma unroll
    for (int i = 0; i < 16; ++i) accO[i] = 0.f;
#pragma unroll
    for (int ms = 0; ms < 2; ++ms) {
        if (ms <= nt) {
            f32x16 aT;
#pragma unroll
            for (int i = 0; i < 16; ++i) aT[i] = 0.f;
#pragma unroll
            for (int ks = 0; ks < 4; ++ks) { const bf16x8 kf = *(const LAS bf16x8*)(KE + (32 * ms + n) * GLA_PITCH + 16 * ks + 8 * h); aT = mfma32(kf, qf[ks], aT); }
            if (ms == nt) {
#pragma unroll
                for (int r = 0; r < 16; ++r) { const int s = (r & 3) + 8 * (r >> 2) + 4 * h; aT[r] = (s <= n) ? aT[r] : 0.f; }
            }
#pragma unroll
            for (int s2 = 0; s2 < 2; ++s2) {
                v4u pa; pa.x = pk2(aT[8 * s2 + 0], aT[8 * s2 + 1]); pa.y = pk2(aT[8 * s2 + 2], aT[8 * s2 + 3]); pa.z = pk2(aT[8 * s2 + 4], aT[8 * s2 + 5]); pa.w = pk2(aT[8 * s2 + 6], aT[8 * s2 + 7]);
                accO = mfma32(vf[2 * ms + s2], __builtin_bit_cast(bf16x8, pa), accO);
            }
        }
    }
    {
#pragma unroll
        for (int ks = 0; ks < 4; ++ks) accO = mfma32(spf[ks], qf[ks], accO);
    }
    float sq = 0.f;
#pragma unroll
    for (int r = 0; r < 16; ++r) sq += accO[r] * accO[r];
    sq += SHX_F(sq, 32, C.lane);
    if (h == 0) ssq[mt * 64 + 32 * nt + n] = sq;
    __syncthreads();
    const float rstd = rsqrtf(((ssq[32 * nt + n] + ssq[64 + 32 * nt + n]) + (ssq[128 + 32 * nt + n] + ssq[192 + 32 * nt + n])) * (1.f / 128.f) + LN_EPS);
    const size_t row = row0 + 32 * nt + n;
#pragma unroll
    for (int j4 = 0; j4 < 4; ++j4) {
        const int e0 = 32 * mt + 8 * j4 + 4 * h;
        const v2u gbv = gb[j4]; const f32x4 gn = gnv[j4];
        const float y0 = accO[4 * j4 + 0] * rstd * gn.x * silu_fast_(bf2f(gbv.x & 0xffffu)), y1 = accO[4 * j4 + 1] * rstd * gn.y * silu_fast_(bf2f(gbv.x >> 16));
        const float y2 = accO[4 * j4 + 2] * rstd * gn.z * silu_fast_(bf2f(gbv.y & 0xffffu)), y3 = accO[4 * j4 + 3] * rstd * gn.w * silu_fast_(bf2f(gbv.y >> 16));
        v2u o; o.x = pk2(y0, y1); o.y = pk2(y2, y3);
        *(v2u*)(YM + row * DM + 512 + hh * 128 + e0) = o;
    }
    __syncthreads();
}

constexpr int GS_QE = 0, GS_KE = 9216, GS_KDT = 18432, GS_SB = 27648, GS_SEGS = 46080, GS_SSQ = 48128, GS_EB = 49152, GS_BAS = 49408;
struct GlaIn { bf16x8 vf[4]; v2u gb[4]; unsigned ba; float q[8], k[8]; };
__device__ __forceinline__ void gla_seq_load(Ctx& C, int b, int hh, int c, GlaIn& I) {
    const bf16* PROJ = (const bf16*)(C.ws + WS_P);
    const int mt = C.wave >> 1, x = C.wave & 1, n = C.lane & 31, h = C.lane >> 5;
    const size_t row0 = (size_t)b * SEQ + c * 64;
    const bf16* vcol = PROJ + row0 * PW + C_BV + hh * 128 + 32 * mt + n;
#pragma unroll
    for (int ks = 0; ks < 4; ++ks) I.vf[ks] = gla_vt_frag(vcol, ks, h);
#pragma unroll
    for (int j4 = 0; j4 < 4; ++j4) I.gb[j4] = *(const v2u*)(PROJ + (row0 + 32 * x + n) * PW + C_BG + hh * 128 + 32 * mt + 8 * j4 + 4 * h);
    const size_t rw = row0 + 8 * C.wave;
    I.ba = *(const unsigned*)(PROJ + (rw + (C.lane >> 3)) * PW + C_BA + 2 * (C.lane & 7));
#pragma unroll
    for (int i = 0; i < 8; ++i) { const bf16* pr = PROJ + (rw + i) * PW; I.q[i] = bf2f(pr[C_BQ + hh * 64 + C.lane]); I.k[i] = bf2f(pr[C_BK + hh * 64 + C.lane]); }
}
__device__ __forceinline__ void ph_gla_seq(Ctx& C, int l, int seq) {
    const int hh = seq & 3, b = seq >> 2;
    LAS bf16* QE = (LAS bf16*)(C.lds + GS_QE); LAS bf16* KE = (LAS bf16*)(C.lds + GS_KE); LAS bf16* KDT = (LAS bf16*)(C.lds + GS_KDT); LAS bf16* SB = (LAS bf16*)(C.lds + GS_SB);
    LAS float* segs = (LAS float*)(C.lds + GS_SEGS); LAS float* ssq = (LAS float*)(C.lds + GS_SSQ); LAS float* ebS = (LAS float*)(C.lds + GS_EB);
    LAS unsigned* baS = (LAS unsigned*)(C.lds + GS_BAS) + C.wave * 64;
    bf16* YM = (bf16*)C.out;
    const int mt = C.wave >> 1, x = C.wave & 1, n = C.lane & 31, h = C.lane >> 5;
    f32x16 st;
#pragma unroll
    for (int i = 0; i < 16; ++i) st[i] = 0.f;
    for (int i = C.tid; i < 128 * GLA_PITCH / 2; i += 512) ((LAS unsigned*)SB)[i] = 0u;
    f32x4 gnv[4];
#pragma unroll
    for (int j4 = 0; j4 < 4; ++j4) gnv[j4] = *(const f32x4*)(C.in(I_GLAG) + l * 128 + 32 * mt + 8 * j4 + 4 * h);
    float w[16];
    { const float* w_a2 = C.in(I_WA2) + (size_t)l * 16 * 256 + hh * 64 + C.lane;
#pragma unroll
      for (int r = 0; r < 16; ++r) w[r] = w_a2[r * 256]; }
    const float bias = C.in(I_BA)[l * 256 + hh * 64 + C.lane];
    GlaIn I; gla_seq_load(C, b, hh, 0, I);
    __syncthreads();
#pragma unroll 1
    for (int c = 0; c < 64; ++c) {
        const size_t row0 = (size_t)b * SEQ + c * 64;
        bf16x8 vf[4]; v2u gb[4]; GlaDecay D;
#pragma unroll
        for (int ks = 0; ks < 4; ++ks) vf[ks] = I.vf[ks];
#pragma unroll
        for (int j4 = 0; j4 < 4; ++j4) gb[j4] = I.gb[j4];
        baS[C.lane] = I.ba;
#pragma unroll
        for (int i = 0; i < 8; ++i) { D.qv[i] = I.q[i]; D.kv[i] = I.k[i]; }
        gla_seq_load(C, b, hh, c < 63 ? c + 1 : 63, I);
        {
            asm volatile("" ::: "memory");
            float run = 0.f;
#pragma unroll
            for (int i = 0; i < 8; ++i) {
                const v4u ba0 = *(const LAS v4u*)(baS + 8 * i), ba1 = *(const LAS v4u*)(baS + 8 * i + 4);
                const unsigned bw[8] = {ba0.x, ba0.y, ba0.z, ba0.w, ba1.x, ba1.y, ba1.z, ba1.w};
                float z = bias;
#pragma unroll
                for (int r = 0; r < 8; ++r) { z += bf2f(bw[r] & 0xffffu) * w[2 * r]; z += bf2f(bw[r] >> 16) * w[2 * r + 1]; }
                const float ls = fminf(z, 0.f) - __logf(1.f + __expf(-fabsf(z)));
                run += ls * (1.f / 16.f);
                D.b[i] = run;
            }
            segs[C.wave * 64 + C.lane] = run;
            __syncthreads();
            float off = 0.f, tot = 0.f;
#pragma unroll
            for (int w8 = 0; w8 < 8; ++w8) { const float sv = segs[w8 * 64 + C.lane]; tot += sv; off += (w8 < C.wave) ? sv : 0.f; }
#pragma unroll
            for (int i = 0; i < 8; ++i) D.b[i] += off;
            D.Btot = tot;
        }
#pragma unroll
        for (int i = 0; i < 8; ++i) {
            QE[(8 * C.wave + i) * GLA_PITCH + C.lane] = (bf16)f2bf(D.qv[i] * 0.125f * __expf(D.b[i]));
            KE[(8 * C.wave + i) * GLA_PITCH + C.lane] = (bf16)f2bf(D.kv[i] * __expf(-D.b[i]));
        }
        {
            v4u p;
            p.x = pk2(D.kv[0] * __expf(D.Btot - D.b[0]), D.kv[1] * __expf(D.Btot - D.b[1])); p.y = pk2(D.kv[2] * __expf(D.Btot - D.b[2]), D.kv[3] * __expf(D.Btot - D.b[3]));
            p.z = pk2(D.kv[4] * __expf(D.Btot - D.b[4]), D.kv[5] * __expf(D.Btot - D.b[5])); p.w = pk2(D.kv[6] * __expf(D.Btot - D.b[6]), D.kv[7] * __expf(D.Btot - D.b[7]));
            *(LAS v4u*)(KDT + C.lane * GLA_PITCH + 8 * C.wave) = p;
            if (C.wave == 0) ebS[C.lane] = __expf(D.Btot);
        }
        __syncthreads();
        bf16x8 qf[4];
#pragma unroll
        for (int ks = 0; ks < 4; ++ks) qf[ks] = *(const LAS bf16x8*)(QE + (32 * x + n) * GLA_PITCH + 16 * ks + 8 * h);
        f32x16 accO;
#pragma unroll
        for (int i = 0; i < 16; ++i) accO[i] = 0.f;
#pragma unroll
        for (int ms = 0; ms < 2; ++ms) {
            if (ms <= x) {
                f32x16 aT;
#pragma unroll
                for (int i = 0; i < 16; ++i) aT[i] = 0.f;
#pragma unroll
                for (int ks = 0; ks < 4; ++ks) { const bf16x8 kf = *(const LAS bf16x8*)(KE + (32 * ms + n) * GLA_PITCH + 16 * ks + 8 * h); aT = mfma32(kf, qf[ks], aT); }
                if (ms == x) {
#pragma unroll
                    for (int r = 0; r < 16; ++r) { const int sx = (r & 3) + 8 * (r >> 2) + 4 * h; aT[r] = (sx <= n) ? aT[r] : 0.f; }
                }
#pragma unroll
                for (int s2 = 0; s2 < 2; ++s2) {
                    v4u pa; pa.x = pk2(aT[8 * s2 + 0], aT[8 * s2 + 1]); pa.y = pk2(aT[8 * s2 + 2], aT[8 * s2 + 3]); pa.z = pk2(aT[8 * s2 + 4], aT[8 * s2 + 5]); pa.w = pk2(aT[8 * s2 + 6], aT[8 * s2 + 7]);
                    accO = mfma32(vf[2 * ms + s2], __builtin_bit_cast(bf16x8, pa), accO);
                }
            }
        }
#pragma unroll
        for (int ks = 0; ks < 4; ++ks) { const bf16x8 spf = *(const LAS bf16x8*)(SB + (32 * mt + n) * GLA_PITCH + 16 * ks + 8 * h); accO = mfma32(spf, qf[ks], accO); }
        {
            f32x16 accL;
#pragma unroll
            for (int i = 0; i < 16; ++i) accL[i] = 0.f;
#pragma unroll
            for (int ks = 0; ks < 4; ++ks) {
                const LAS bf16* kp = KDT + (32 * x + n) * GLA_PITCH + 16 * ks + 4 * h;
                const v2u k0 = *(const LAS v2u*)kp, k1 = *(const LAS v2u*)(kp + 8);
                v4u kk; kk.x = k0.x; kk.y = k0.y; kk.z = k1.x; kk.w = k1.y;
                accL = mfma32(vf[ks], __builtin_bit_cast(bf16x8, kk), accL);
            }
            const float eb = ebS[32 * x + n];
#pragma unroll
            for (int i = 0; i < 16; ++i) st[i] = st[i] * eb + accL[i];
        }
        float sq = 0.f;
#pragma unroll
        for (int r = 0; r < 16; ++r) sq += accO[r] * accO[r];
        sq += SHX_F(sq, 32, C.lane);
        if (h == 0) ssq[mt * 64 + 32 * x + n] = sq;
        __syncthreads();
#pragma unroll
        for (int r = 0; r < 16; ++r) SB[(32 * mt + (r & 3) + 8 * (r >> 2) + 4 * h) * GLA_PITCH + 32 * x + n] = (bf16)f2bf(st[r]);
        const float rstd = rsqrtf(((ssq[32 * x + n] + ssq[64 + 32 * x + n]) + (ssq[128 + 32 * x + n] + ssq[192 + 32 * x + n])) * (1.f / 128.f) + LN_EPS);
        const size_t row = row0 + 32 * x + n;
#pragma unroll
        for (int j4 = 0; j4 < 4; ++j4) {
            const int e0 = 32 * mt + 8 * j4 + 4 * h;
            const v2u gbv = gb[j4]; const f32x4 gn = gnv[j4];
            const float y0 = accO[4 * j4 + 0] * rstd * gn.x * silu_fast_(bf2f(gbv.x & 0xffffu)), y1 = accO[4 * j4 + 1] * rstd * gn.y * silu_fast_(bf2f(gbv.x >> 16));
            const float y2 = accO[4 * j4 + 2] * rstd * gn.z * silu_fast_(bf2f(gbv.y & 0xffffu)), y3 = accO[4 * j4 + 3] * rstd * gn.w * silu_fast_(bf2f(gbv.y >> 16));
            v2u o; o.x = pk2(y0, y1); o.y = pk2(y2, y3);
            *(v2u*)(YM + row * DM + 512 + hh * 128 + e0) = o;
        }
    }
    __syncthreads();
}

#ifndef A3_VPATH
#define A3_VPATH(i) (true)
#endif
#ifndef REP_S
#define REP_S 1
#endif
constexpr size_t WS_KFI = 932 * MiB, WS_KFA = 940 * MiB, WS_VF = 948 * MiB;

__device__ __forceinline__ void ph_dsa_a2_unit(Ctx& C, int b, int t0) {
    LAS unsigned* cnt = (LAS unsigned*)(C.lds + 131072);
    const bf16* PROJ = (const bf16*)(C.ws + WS_P); unsigned* SEL = (unsigned*)(C.ws + WS_SEL); const bf16* KFI = (const bf16*)(C.ws + WS_KFI);
    const int lane = C.lane, n = lane & 31, h = lane >> 5, tid = C.tid, wave = C.wave;
    const int nk = t0 + 8, ntile = (nk + 31) >> 5;
    if (tid < 48) cnt[tid] = 0u;
    unsigned u[16][4];
    {
        bf16x8 af[2][4]; float wv[2][2][8];
        const int jq = 2 * ((n >> 4) & 1) + ((n >> 2) & 1), hd = 4 * ((n >> 3) & 1) + (n & 3);
#pragma unroll
        for (int mt = 0; mt < 2; ++mt) {
            const bf16* p = PROJ + (size_t)(b * SEQ + t0 + 4 * mt + jq) * PW + C_IQ + hd * 64 + 8 * h;
#pragma unroll
            for (int ks = 0; ks < 4; ++ks) af[mt][ks] = *(const bf16x8*)(p + ks * 16);
#pragma unroll
            for (int g = 0; g < 2; ++g) {
                const v4u w4 = *(const v4u*)(PROJ + (size_t)(b * SEQ + t0 + 4 * mt + 2 * g + h) * PW + C_IW); const unsigned ww[4] = {w4.x, w4.y, w4.z, w4.w};
#pragma unroll
                for (int x = 0; x < 4; ++x) { wv[mt][g][2 * x] = bf2f(ww[x] & 0xffffu) * (0.35355339059327373f * 0.125f); wv[mt][g][2 * x + 1] = bf2f(ww[x] >> 16) * (0.35355339059327373f * 0.125f); }
            }
        }
        const bf16* kbase = KFI + (size_t)(b * 128) * 2048 + lane * 8;
#pragma unroll
        for (int i = 0; i < 16; ++i) {
            const int tile = wave + 8 * i;
#pragma unroll
            for (int k = 0; k < 4; ++k) u[i][k] = 0u;
            if (tile < ntile) {
                bf16x8 bcur[4];
#pragma unroll
                for (int ks = 0; ks < 4; ++ks) bcur[ks] = *(const bf16x8*)(kbase + (size_t)tile * 2048 + ks * 512);
                const int s = tile * 32 + n;
#pragma unroll
                for (int mt = 0; mt < 2; ++mt) {
                    f32x16 acc;
#pragma unroll
                    for (int x = 0; x < 16; ++x) acc[x] = 0.f;
#pragma unroll
                    for (int ks = 0; ks < 4; ++ks) acc = mfma32(af[mt][ks], bcur[ks], acc);
#pragma unroll
                    for (int g = 0; g < 2; ++g) {
                        float p = 0.f;
#pragma unroll
                        for (int x = 0; x < 8; ++x) p += wv[mt][g][x] * fmaxf(acc[8 * g + x], 0.f);
                        const int t = t0 + 4 * mt + 2 * g + h;
                        u[i][2 * mt + g] = (s <= t) ? sortable_u32(p) : 0u;
                    }
                }
            }
            __builtin_amdgcn_sched_barrier(0);
        }
    }
    __syncthreads();
    unsigned Tl[4], Jl[4], needl[4];
#pragma unroll
    for (int k = 0; k < 4; ++k) { Tl[k] = 0u; Jl[k] = 8192u; needl[k] = 0u; }
    int buf = 0;
#define DSA_COUNT(PRED) \
        _Pragma("unroll") for (int i = 0; i < 16; ++i) if (wave + 8 * i < ntile) { const unsigned s = (unsigned)((wave + 8 * i) * 32 + n); (void)s; \
            _Pragma("unroll") for (int k = 0; k < 4; ++k) { const unsigned uu = u[i][k]; const unsigned long long bm = __ballot(PRED); cq[2 * k] += (unsigned)__popc((unsigned)bm); cq[2 * k + 1] += (unsigned)__popc((unsigned)(bm >> 32)); } __builtin_amdgcn_sched_barrier(0); }
#define DSA_PUBLISH(NW) { unsigned myc = 0u; \
        _Pragma("unroll") for (int q = 0; q < NW; ++q) myc = (lane == q) ? cq[q] : myc; \
        if (lane < NW) __hip_atomic_fetch_add(cnt + buf * 16 + lane, myc, __ATOMIC_RELAXED, __HIP_MEMORY_SCOPE_WORKGROUP); \
        nb = (buf == 2) ? 0 : buf + 1; if (tid >= 64 && tid < 80) cnt[nb * 16 + (tid - 64)] = 0u; __syncthreads(); }
#pragma unroll 1
    for (int bit = 31; bit >= 0; --bit) {
        unsigned cq[8]; int nb;
#pragma unroll
        for (int q = 0; q < 8; ++q) cq[q] = 0u;
        unsigned cl[4];
#pragma unroll
        for (int k = 0; k < 4; ++k) cl[k] = Tl[k] | (1u << bit);
        DSA_COUNT(uu >= cl[k])
        DSA_PUBLISH(8)
#pragma unroll
        for (int k = 0; k < 4; ++k) if (cnt[buf * 16 + 2 * k + h] >= 256u) Tl[k] = cl[k];
        buf = nb;
    }
#pragma unroll
    for (int k = 0; k < 4; ++k) Tl[k] = Tl[k] < 1u ? 1u : Tl[k];
    bool extra = false;
    {
        unsigned cq[16]; int nb;
#pragma unroll
        for (int q = 0; q < 16; ++q) cq[q] = 0u;
#pragma unroll
        for (int i = 0; i < 16; ++i) if (wave + 8 * i < ntile) {
#pragma unroll
            for (int k = 0; k < 4; ++k) { const unsigned uu = u[i][k];
                const unsigned long long bg = __ballot(uu > Tl[k]), be = __ballot(uu >= Tl[k]);
                cq[2 * k] += (unsigned)__popc((unsigned)bg); cq[2 * k + 1] += (unsigned)__popc((unsigned)(bg >> 32));
                cq[8 + 2 * k] += (unsigned)__popc((unsigned)be); cq[8 + 2 * k + 1] += (unsigned)__popc((unsigned)(be >> 32)); }
            __builtin_amdgcn_sched_barrier(0);
        }
        DSA_PUBLISH(16)
#pragma unroll
        for (int k = 0; k < 4; ++k) { const unsigned g = cnt[buf * 16 + 2 * k + h]; needl[k] = 256u - (g < 256u ? g : 256u); }
#pragma unroll
        for (int q = 0; q < 8; ++q) extra = extra || (cnt[buf * 16 + 8 + q] > 256u);
        buf = nb;
    }
    if (extra) {
#pragma unroll
        for (int k = 0; k < 4; ++k) Jl[k] = 0u;
#pragma unroll 1
        for (int bit = 12; bit >= 0; --bit) {
            unsigned cq[8]; int nb;
#pragma unroll
            for (int q = 0; q < 8; ++q) cq[q] = 0u;
            unsigned jl[4];
#pragma unroll
            for (int k = 0; k < 4; ++k) jl[k] = Jl[k] | (1u << bit);
            DSA_COUNT(uu == Tl[k] && s < jl[k])
            DSA_PUBLISH(8)
#pragma unroll
            for (int k = 0; k < 4; ++k) if (cnt[buf * 16 + 2 * k + h] <= needl[k]) Jl[k] = jl[k];
            buf = nb;
        }
    }
    {
        unsigned wsel[4];
#pragma unroll
        for (int k = 0; k < 4; ++k) wsel[k] = 0u;
#pragma unroll
        for (int i = 0; i < 16; ++i) if (wave + 8 * i < ntile) {
            const unsigned s = (unsigned)((wave + 8 * i) * 32 + n);
#pragma unroll
            for (int k = 0; k < 4; ++k) {
                const unsigned uu = u[i][k];
                const unsigned long long bm = __ballot((uu > Tl[k]) || (uu == Tl[k] && s < Jl[k]));
                const unsigned wd = h ? (unsigned)(bm >> 32) : (unsigned)bm;
                wsel[k] = (n == i) ? wd : wsel[k];
            }
            __builtin_amdgcn_sched_barrier(0);
        }
        const int tile = wave + 8 * n;
        if (n < 16 && tile < ntile) {
#pragma unroll
            for (int k = 0; k < 4; ++k) SEL[(size_t)(b * SEQ + t0 + 2 * k + h) * 128 + tile] = wsel[k];
        }
    }
#undef DSA_COUNT
#undef DSA_PUBLISH
    __syncthreads();
}


constexpr int A3_QP = 64 * 68;
struct A3Q { bf16x8 af[2][4]; v4u wq; };
__device__ __forceinline__ void a3_load_q(Ctx& C, int b, int t0, A3Q& Q) {
    const bf16* PROJ = (const bf16*)(C.ws + WS_P);
    const int n = C.lane & 31, h = C.lane >> 5;
    const int jq = 2 * ((n >> 4) & 1) + ((n >> 2) & 1), hd = 4 * ((n >> 3) & 1) + (n & 3);
#pragma unroll
    for (int mt = 0; mt < 2; ++mt) {
        const bf16* p = PROJ + (size_t)(b * SEQ + t0 + 4 * mt + jq) * PW + C_IQ + hd * 64 + 8 * h;
#pragma unroll
        for (int ks = 0; ks < 4; ++ks) Q.af[mt][ks] = *(const bf16x8*)(p + ks * 16);
    }
    Q.wq = *(const v4u*)(PROJ + (size_t)(b * SEQ + t0 + (n & 7)) * PW + C_IW);
}
__device__ __forceinline__ void ph_dsa_a3_unit(Ctx& C, int b, int t0, A3Q& Q, bool has_next, int nb, int nt0) {
    LAS unsigned* sc = (LAS unsigned*)C.lds;
    const bf16* PROJ = (const bf16*)(C.ws + WS_P); unsigned* SEL = (unsigned*)(C.ws + WS_SEL); const bf16* KFI = (const bf16*)(C.ws + WS_KFI);
    const int lane = C.lane, n = lane & 31, h = lane >> 5, wave = C.wave;
    const int nk = t0 + 8, ntile = (nk + 31) >> 5;
    {
        typedef _Float16 h8_t __attribute__((ext_vector_type(8)));
        typedef _Float16 h2_t __attribute__((ext_vector_type(2)));
        h8_t wf[2][2];
        {
            const unsigned ww[4] = {Q.wq.x, Q.wq.y, Q.wq.z, Q.wq.w}; unsigned wp[4];
#pragma unroll
            for (int x = 0; x < 4; ++x) wp[x] = __builtin_bit_cast(unsigned, __builtin_amdgcn_cvt_pkrtz(bf2f(ww[x] & 0xffffu) * (0.35355339059327373f * 0.125f), bf2f(ww[x] >> 16) * (0.35355339059327373f * 0.125f)));
#pragma unroll
            for (int mt = 0; mt < 2; ++mt)
#pragma unroll
                for (int ks = 0; ks < 2; ++ks) { const bool on = (n < 8) && ((n >> 2) == mt) && ((n & 3) == 2 * ks + h);
                    v4u f; f.x = on ? wp[0] : 0u; f.y = on ? wp[1] : 0u; f.z = on ? wp[2] : 0u; f.w = on ? wp[3] : 0u; wf[mt][ks] = __builtin_bit_cast(h8_t, f); }
        }
        const bf16* kbase = KFI + (size_t)(b * 128) * 2048 + lane * 8;
        bf16x8 kA[4], kB[4];
        { const int ta = wave < ntile ? wave : 0, tb = wave + 8 < ntile ? wave + 8 : ta;
#pragma unroll
          for (int ks = 0; ks < 4; ++ks) { kA[ks] = *(const bf16x8*)(kbase + (size_t)ta * 2048 + ks * 512); kB[ks] = *(const bf16x8*)(kbase + (size_t)tb * 2048 + ks * 512); } }
#define A3_MMA(A0, A1, KF) { const f32x16 z16_ = {0.f, 0.f, 0.f, 0.f, 0.f, 0.f, 0.f, 0.f, 0.f, 0.f, 0.f, 0.f, 0.f, 0.f, 0.f, 0.f}; \
            A0 = mfma32(Q.af[0][0], KF[0], z16_); A1 = mfma32(Q.af[1][0], KF[0], z16_); \
            _Pragma("unroll") for (int ks = 1; ks < 4; ++ks) { A0 = mfma32(Q.af[0][ks], KF[ks], A0); A1 = mfma32(Q.af[1][ks], KF[ks], A1); } }
#define A3_RELU4(A, r0_) ({ v4u f_; const h2_t z2_ = {(_Float16)0.f, (_Float16)0.f}; \
                f_.x = __builtin_bit_cast(unsigned, __builtin_elementwise_max(__builtin_bit_cast(h2_t, __builtin_amdgcn_cvt_pkrtz(A[(r0_)], A[(r0_) + 1])), z2_)); \
                f_.y = __builtin_bit_cast(unsigned, __builtin_elementwise_max(__builtin_bit_cast(h2_t, __builtin_amdgcn_cvt_pkrtz(A[(r0_) + 2], A[(r0_) + 3])), z2_)); \
                f_.z = __builtin_bit_cast(unsigned, __builtin_elementwise_max(__builtin_bit_cast(h2_t, __builtin_amdgcn_cvt_pkrtz(A[(r0_) + 4], A[(r0_) + 5])), z2_)); \
                f_.w = __builtin_bit_cast(unsigned, __builtin_elementwise_max(__builtin_bit_cast(h2_t, __builtin_amdgcn_cvt_pkrtz(A[(r0_) + 6], A[(r0_) + 7])), z2_)); \
                __builtin_bit_cast(h8_t, f_); })
#define A3_EPI(A0, A1, tile_) { const int s = (tile_) * 32 + n; const f32x16 z16e_ = {0.f, 0.f, 0.f, 0.f, 0.f, 0.f, 0.f, 0.f, 0.f, 0.f, 0.f, 0.f, 0.f, 0.f, 0.f, 0.f}; \
            f32x16 P_ = __builtin_amdgcn_mfma_f32_32x32x16_f16(wf[0][0], A3_RELU4(A0, 0), z16e_, 0, 0, 0); P_ = __builtin_amdgcn_mfma_f32_32x32x16_f16(wf[0][1], A3_RELU4(A0, 8), P_, 0, 0, 0); \
            P_ = __builtin_amdgcn_mfma_f32_32x32x16_f16(wf[1][0], A3_RELU4(A1, 0), P_, 0, 0, 0); P_ = __builtin_amdgcn_mfma_f32_32x32x16_f16(wf[1][1], A3_RELU4(A1, 8), P_, 0, 0, 0); \
              \
            _Pragma("unroll") for (int r = 0; r < 4; ++r) { const int q = r + 4 * h; sc[q * A3_QP + (s >> 6) * 68 + (s & 63)] = (s <= t0 + q) ? sortable_u32(P_[r]) : 0u; } }
#define A3_LOADK(KF, tile_) { const int tl_ = ((tile_) < ntile) ? (tile_) : wave; \
            _Pragma("unroll") for (int ks = 0; ks < 4; ++ks) KF[ks] = *(const bf16x8*)(kbase + (size_t)tl_ * 2048 + ks * 512); }
        f32x16 accA0, accA1, accB0, accB1;
        if (wave < ntile) { A3_MMA(accA0, accA1, kA) A3_LOADK(kA, wave + 16) }
#pragma unroll 1
        for (int tile = wave; tile < ntile; tile += 16) {
            if (tile + 8 < ntile) { A3_MMA(accB0, accB1, kB) A3_LOADK(kB, tile + 24) }
            A3_EPI(accA0, accA1, tile)
            if (tile + 8 < ntile) {
                if (tile + 16 < ntile) { A3_MMA(accA0, accA1, kA) A3_LOADK(kA, tile + 32) }
                A3_EPI(accB0, accB1, tile + 8)
            }
        }
#undef A3_LOADK
#undef A3_RELU4
#undef A3_MMA
#undef A3_EPI
    }
    __syncthreads();
    {
        const int q = wave, t = t0 + q;
        const int nval = t + 1 - 64 * lane;
        const unsigned long long vm = nval >= 64 ? ~0ull : (nval > 0 ? ((1ull << nval) - 1ull) : 0ull);
        unsigned long long selm = vm;
        if (t >= 256) {
            unsigned lo[32], hi[32];
            {
                const LAS v4u* gp = (const LAS v4u*)(sc + q * A3_QP + lane * 68);
#pragma unroll
                for (int i = 0; i < 8; ++i) { const v4u a = gp[i], c = gp[8 + i]; lo[4 * i] = a.x; lo[4 * i + 1] = a.y; lo[4 * i + 2] = a.z; lo[4 * i + 3] = a.w; hi[4 * i] = c.x; hi[4 * i + 1] = c.y; hi[4 * i + 2] = c.z; hi[4 * i + 3] = c.w; }
            }
#define A3_TR(X) { \
            _Pragma("unroll") for (int k = 0; k < 32; ++k) if ((k & 16) == 0) { const unsigned a = X[k], c = X[k + 16]; X[k] = __builtin_amdgcn_perm(c, a, 0x05040100u); X[k + 16] = __builtin_amdgcn_perm(c, a, 0x07060302u); } \
            _Pragma("unroll") for (int k = 0; k < 32; ++k) if ((k & 8) == 0) { const unsigned a = X[k], c = X[k + 8]; X[k] = __builtin_amdgcn_perm(c, a, 0x06020400u); X[k + 8] = __builtin_amdgcn_perm(c, a, 0x07030501u); } \
            _Pragma("unroll") for (int st = 2; st < 5; ++st) { const int j = 16 >> st; const unsigned m = st == 2 ? 0x0f0f0f0fu : st == 3 ? 0x33333333u : 0x55555555u; \
                _Pragma("unroll") for (int k = 0; k < 32; ++k) if ((k & j) == 0) { const unsigned a = X[k], c = X[k + j]; X[k] = (a & m) | ((c << j) & ~m); X[k + j] = ((a >> j) & m) | (c & ~m); } } }
            A3_TR(lo) A3_TR(hi)
#undef A3_TR
            unsigned al = (unsigned)vm, ah = (unsigned)(vm >> 32), gl = 0u, gh = 0u, G = 0u;
            bool done = false;
#pragma unroll
            for (int b = 31; b >= 0; --b) {
                if (!done) {
                    const unsigned ol = al & lo[b], oh = ah & hi[b];
                    const unsigned c = G + wave_sum_u32((unsigned)__popc(ol) + (unsigned)__popc(oh));
                    if (c >= 256u) { al = ol; ah = oh; done = (c == 256u); }
                    else { gl |= ol; gh |= oh; G = c; al ^= ol; ah ^= oh; }
                }
            }
            const unsigned ca = (unsigned)__popc(al) + (unsigned)__popc(ah);
            const unsigned tot = wave_sum_u32(ca);
            unsigned long long alive = ((unsigned long long)ah << 32) | al;
            if (G + tot > 256u) {
                int incl = (int)ca;
#pragma unroll
                for (int o = 1; o < 64; o <<= 1) { const int v = SHUP_I(incl, o, lane); if (lane >= o) incl += v; }
                const int before = incl - (int)ca, room = (int)(256u - G) - before;
                int take = room < 0 ? 0 : (room > (int)ca ? (int)ca : room);
                unsigned long long keep = 0ull;
                while (__any(take > 0)) { if (take > 0) { const unsigned long long low = alive & (0ull - alive); keep |= low; alive ^= low; --take; } }
                alive = keep;
            }
            selm = (((unsigned long long)gh << 32) | gl) | alive;
        }
        if (has_next) a3_load_q(C, nb, nt0, Q);
#ifdef SEL_ALL
        *(unsigned long long*)(SEL + (size_t)(b * SEQ + t) * 128 + 2 * lane) = selm;
#else
        if (64 * lane <= t) *(unsigned long long*)(SEL + (size_t)(b * SEQ + t) * 128 + 2 * lane) = selm;
#endif
    }
    __syncthreads();
}

constexpr int A4_BUF = 4 * A3_QP;
#ifdef PROBE_HOT
#define A4_TMASK(x) ((x) & C.hot)
#else
#define A4_TMASK(x) (x)
#endif
constexpr int A4_R = 4;
struct A4S { bf16x8 af[4]; v4u wq; bf16x8 k[A4_R][4]; };
__device__ __forceinline__ int a4_cnt(int t0, int sw) { const int ntile = (t0 + 4 + 31) >> 5; return (t0 + 3 < 256 || sw >= ntile) ? 0 : (ntile - sw + 3) >> 2; }
__device__ __forceinline__ void a4_prefetch(Ctx& C, A4S& S, int b, int t0) {
    const bf16* PROJ = (const bf16*)(C.ws + WS_P); const bf16* KFI = (const bf16*)(C.ws + WS_KFI);
    const int lane = C.lane, n = lane & 31, h = lane >> 5, sw = C.wave;
    const int cnt = a4_cnt(t0, sw);
    {
        const int jq = 2 * ((n >> 4) & 1) + ((n >> 2) & 1), hd = 4 * ((n >> 3) & 1) + (n & 3);
        const bf16* p = PROJ + (size_t)(b * SEQ + t0 + jq) * PW + C_IQ + hd * 64 + 8 * h;
#pragma unroll
        for (int ks = 0; ks < 4; ++ks) S.af[ks] = *(const bf16x8*)(p + ks * 16);
        const int qsel = (n & 1) + 2 * ((n >> 2) & 1);
        S.wq = *(const v4u*)(PROJ + (size_t)(b * SEQ + t0 + qsel) * PW + C_IW);
    }
    const bf16* kbase = KFI + (size_t)(b * 128) * 2048 + lane * 8;
#pragma unroll
    for (int j = 0; j < A4_R; ++j) { const int tl = j < cnt ? sw + 4 * j : 0;
#pragma unroll
        for (int ks = 0; ks < 4; ++ks) S.k[j][ks] = *(const bf16x8*)(kbase + (size_t)A4_TMASK(tl) * 2048 + ks * 512);
    }
}
__device__ __forceinline__ void a4_score(Ctx& C, A4S& S, LAS unsigned* sc, int b, int t0, int nb, int nt0) {
    const bf16* KFI = (const bf16*)(C.ws + WS_KFI); const bf16* PROJ = (const bf16*)(C.ws + WS_P);
    const int lane = C.lane, n = lane & 31, h = lane >> 5, sw = C.wave;
    const int cnt = a4_cnt(t0, sw);
    bf16x8 naf[4]; v4u nwq;
    {
        const int jq = 2 * ((n >> 4) & 1) + ((n >> 2) & 1), hd = 4 * ((n >> 3) & 1) + (n & 3);
        const bf16* p = PROJ + (size_t)(nb * SEQ + nt0 + jq) * PW + C_IQ + hd * 64 + 8 * h;
#pragma unroll
        for (int ks = 0; ks < 4; ++ks) naf[ks] = *(const bf16x8*)(p + ks * 16);
        const int qsel = (n & 1) + 2 * ((n >> 2) & 1);
        nwq = *(const v4u*)(PROJ + (size_t)(nb * SEQ + nt0 + qsel) * PW + C_IW);
    }
    const int ncnt = a4_cnt(nt0, sw);
    const bf16* nkbase = KFI + (size_t)(nb * 128) * 2048 + lane * 8;
    typedef _Float16 h8_t __attribute__((ext_vector_type(8)));
    typedef _Float16 h2_t __attribute__((ext_vector_type(2)));
    h8_t wf[2];
    {
        const unsigned ww[4] = {S.wq.x, S.wq.y, S.wq.z, S.wq.w}; unsigned wp[4];
#pragma unroll
        for (int x = 0; x < 4; ++x) wp[x] = __builtin_bit_cast(unsigned, __builtin_amdgcn_cvt_pkrtz(bf2f(ww[x] & 0xffffu) * (0.35355339059327373f * 0.125f), bf2f(ww[x] >> 16) * (0.35355339059327373f * 0.125f)));
        const bool rowok = (n == 0) || (n == 1) || (n == 4) || (n == 5); const int qrow = (n & 1) + 2 * (n >> 2);
#pragma unroll
        for (int ks = 0; ks < 2; ++ks) { const bool on = rowok && (qrow == 2 * ks + h);
            v4u f; f.x = on ? wp[0] : 0u; f.y = on ? wp[1] : 0u; f.z = on ? wp[2] : 0u; f.w = on ? wp[3] : 0u; wf[ks] = __builtin_bit_cast(h8_t, f); }
    }
    const bf16* kbase = KFI + (size_t)(b * 128) * 2048 + lane * 8;
#define A4_MMA(A, KF) { const f32x16 z16_ = {0.f, 0.f, 0.f, 0.f, 0.f, 0.f, 0.f, 0.f, 0.f, 0.f, 0.f, 0.f, 0.f, 0.f, 0.f, 0.f}; \
        A = mfma32(S.af[0], KF[0], z16_); _Pragma("unroll") for (int ks = 1; ks < 4; ++ks) A = mfma32(S.af[ks], KF[ks], A); }
#define A4_RELU4(A, r0_) ({ v4u f_; const h2_t z2_ = {(_Float16)0.f, (_Float16)0.f}; \
            f_.x = __builtin_bit_cast(unsigned, __builtin_elementwise_max(__builtin_bit_cast(h2_t, __builtin_amdgcn_cvt_pkrtz(A[(r0_)], A[(r0_) + 1])), z2_)); \
            f_.y = __builtin_bit_cast(unsigned, __builtin_elementwise_max(__builtin_bit_cast(h2_t, __builtin_amdgcn_cvt_pkrtz(A[(r0_) + 2], A[(r0_) + 3])), z2_)); \
            f_.z = __builtin_bit_cast(unsigned, __builtin_elementwise_max(__builtin_bit_cast(h2_t, __builtin_amdgcn_cvt_pkrtz(A[(r0_) + 4], A[(r0_) + 5])), z2_)); \
            f_.w = __builtin_bit_cast(unsigned, __builtin_elementwise_max(__builtin_bit_cast(h2_t, __builtin_amdgcn_cvt_pkrtz(A[(r0_) + 6], A[(r0_) + 7])), z2_)); \
            __builtin_bit_cast(h8_t, f_); })
#define A4_EPI(A, i_) { const int s = (sw + 4 * (i_)) * 32 + n; const f32x16 z16e_ = {0.f, 0.f, 0.f, 0.f, 0.f, 0.f, 0.f, 0.f, 0.f, 0.f, 0.f, 0.f, 0.f, 0.f, 0.f, 0.f}; \
        f32x16 P_ = __builtin_amdgcn_mfma_f32_32x32x16_f16(wf[0], A4_RELU4(A, 0), z16e_, 0, 0, 0); P_ = __builtin_amdgcn_mfma_f32_32x32x16_f16(wf[1], A4_RELU4(A, 8), P_, 0, 0, 0); \
          \
          \
        _Pragma("unroll") for (int r = 0; r < 2; ++r) { const int q = 2 * h + r; const unsigned u_ = __float_as_uint(P_[r]); sc[q * A3_QP + (s >> 6) * 68 + (s & 63)] = u_ ^ ((unsigned)((int)u_ >> 31) | 0x80000000u); } }
#define A4_LOADK(KF, i_) { const int il_ = ((i_) < cnt) ? (i_) : 0; _Pragma("unroll") for (int ks = 0; ks < 4; ++ks) KF[ks] = *(const bf16x8*)(kbase + (size_t)A4_TMASK(sw + 4 * il_) * 2048 + ks * 512); }
    f32x16 acc0, acc1;
    int i0 = 0;
#pragma unroll 1
    for (; i0 + 4 < cnt; i0 += 4) {
        A4_MMA(acc0, S.k[0]) A4_LOADK(S.k[0], i0 + 4)
        A4_MMA(acc1, S.k[1]) A4_LOADK(S.k[1], i0 + 5)
        A4_EPI(acc0, i0)
        A4_MMA(acc0, S.k[2]) A4_LOADK(S.k[2], i0 + 6)
        A4_EPI(acc1, i0 + 1)
        A4_MMA(acc1, S.k[3]) A4_LOADK(S.k[3], i0 + 7)
        A4_EPI(acc0, i0 + 2)
        A4_EPI(acc1, i0 + 3)
    }
#define A4_LOADN(KF, j_) { const int tl_ = ((j_) < ncnt) ? sw + 4 * (j_) : 0; _Pragma("unroll") for (int ks = 0; ks < 4; ++ks) KF[ks] = *(const bf16x8*)(nkbase + (size_t)A4_TMASK(tl_) * 2048 + ks * 512); }
    if (i0 < cnt) { A4_MMA(acc0, S.k[0]) }
    A4_LOADN(S.k[0], 0)
    if (i0 + 1 < cnt) { A4_MMA(acc1, S.k[1]) }
    A4_LOADN(S.k[1], 1)
    if (i0 < cnt) A4_EPI(acc0, i0)
    if (i0 + 2 < cnt) { A4_MMA(acc0, S.k[2]) }
    A4_LOADN(S.k[2], 2)
    if (i0 + 1 < cnt) A4_EPI(acc1, i0 + 1)
    if (i0 + 3 < cnt) { A4_MMA(acc1, S.k[3]) }
    A4_LOADN(S.k[3], 3)
    if (i0 + 2 < cnt) A4_EPI(acc0, i0 + 2)
    if (i0 + 3 < cnt) A4_EPI(acc1, i0 + 3)
#undef A4_LOADN
#pragma unroll
    for (int ks = 0; ks < 4; ++ks) S.af[ks] = naf[ks];
    S.wq = nwq;
#undef A4_LOADK
#undef A4_RELU4
#undef A4_MMA
#undef A4_EPI
}
__device__ __forceinline__ void a4_select(Ctx& C, const LAS unsigned* scq, int b, int t) {
    unsigned* SEL = (unsigned*)(C.ws + WS_SEL);
    const int lane = C.lane;
    const int nval = t + 1 - 64 * lane;
    const unsigned long long vm = nval >= 64 ? ~0ull : (nval > 0 ? ((1ull << nval) - 1ull) : 0ull);
    unsigned long long selm = vm;
    if (t >= 256) {
        unsigned lo[32], hi[32];
        {
            const LAS v4u* gp = (const LAS v4u*)(scq + lane * 68);
#pragma unroll
            for (int i = 0; i < 8; ++i) { const v4u a = gp[i], c = gp[8 + i]; lo[4 * i] = a.x; lo[4 * i + 1] = a.y; lo[4 * i + 2] = a.z; lo[4 * i + 3] = a.w; hi[4 * i] = c.x; hi[4 * i + 1] = c.y; hi[4 * i + 2] = c.z; hi[4 * i + 3] = c.w; }
        }
#define A3_TR(X) { \
        _Pragma("unroll") for (int k = 0; k < 32; ++k) if ((k & 16) == 0) { const unsigned a = X[k], c = X[k + 16]; X[k] = __builtin_amdgcn_perm(c, a, 0x05040100u); X[k + 16] = __builtin_amdgcn_perm(c, a, 0x07060302u); } \
        _Pragma("unroll") for (int k = 0; k < 32; ++k) if ((k & 8) == 0) { const unsigned a = X[k], c = X[k + 8]; X[k] = __builtin_amdgcn_perm(c, a, 0x06020400u); X[k + 8] = __builtin_amdgcn_perm(c, a, 0x07030501u); } \
        _Pragma("unroll") for (int st = 2; st < 5; ++st) { const int j = 16 >> st; const unsigned m = st == 2 ? 0x0f0f0f0fu : st == 3 ? 0x33333333u : 0x55555555u; \
            _Pragma("unroll") for (int k = 0; k < 32; ++k) if ((k & j) == 0) { const unsigned a = X[k], c = X[k + j]; X[k] = (a & m) | ((c << j) & ~m); X[k + j] = ((a >> j) & m) | (c & ~m); } } }
        A3_TR(lo) A3_TR(hi)
#undef A3_TR
        unsigned al = (unsigned)vm, ah = (unsigned)(vm >> 32), gl = 0u, gh = 0u, G = 0u;
        bool done = false;
#pragma unroll
        for (int bb = 31; bb >= 1; bb -= 2) {
            if (!done) {
                const unsigned o1l = al & lo[bb], o1h = ah & hi[bb];
                const unsigned o11l = o1l & lo[bb - 1], o11h = o1h & hi[bb - 1];
                const unsigned o01l = (al ^ o1l) & lo[bb - 1], o01h = (ah ^ o1h) & hi[bb - 1];
                unsigned x1 = (unsigned)__popc(o1l) + (unsigned)__popc(o1h), x11 = (unsigned)__popc(o11l) + (unsigned)__popc(o11h), x01 = (unsigned)__popc(o01l) + (unsigned)__popc(o01h);
                x1 += DPP_U32(x1, 0xB1); x11 += DPP_U32(x11, 0xB1); x01 += DPP_U32(x01, 0xB1);
                x1 += DPP_U32(x1, 0x4E); x11 += DPP_U32(x11, 0x4E); x01 += DPP_U32(x01, 0x4E);
                x1 += DPP_U32(x1, 0x124); x11 += DPP_U32(x11, 0x124); x01 += DPP_U32(x01, 0x124);
                x1 += DPP_U32(x1, 0x128); x11 += DPP_U32(x11, 0x128); x01 += DPP_U32(x01, 0x128);
                x1 += (unsigned)__builtin_amdgcn_update_dpp(0, (int)x1, 0x142, 0xA, 0xF, false); x11 += (unsigned)__builtin_amdgcn_update_dpp(0, (int)x11, 0x142, 0xA, 0xF, false); x01 += (unsigned)__builtin_amdgcn_update_dpp(0, (int)x01, 0x142, 0xA, 0xF, false);
                x1 += (unsigned)__builtin_amdgcn_update_dpp(0, (int)x1, 0x143, 0xC, 0xF, false); x11 += (unsigned)__builtin_amdgcn_update_dpp(0, (int)x11, 0x143, 0xC, 0xF, false); x01 += (unsigned)__builtin_amdgcn_update_dpp(0, (int)x01, 0x143, 0xC, 0xF, false);
                const unsigned c1 = G + (unsigned)__builtin_amdgcn_readlane((int)x1, 63), n11 = (unsigned)__builtin_amdgcn_readlane((int)x11, 63), n01 = (unsigned)__builtin_amdgcn_readlane((int)x01, 63);
                if (c1 >= 256u) {
                    al = o1l; ah = o1h;
                    if (c1 == 256u) done = true;
                    else {
                        const unsigned c = G + n11;
                        if (c >= 256u) { al = o11l; ah = o11h; done = (c == 256u); }
                        else { gl |= o11l; gh |= o11h; G = c; al ^= o11l; ah ^= o11h; }
                    }
                } else {
                    gl |= o1l; gh |= o1h; G = c1; al ^= o1l; ah ^= o1h;
                    const unsigned c = G + n01;
                    if (c >= 256u) { al = o01l; ah = o01h; done = (c == 256u); }
                    else { gl |= o01l; gh |= o01h; G = c; al ^= o01l; ah ^= o01h; }
                }
            }
        }
        const unsigned ca = (unsigned)__popc(al) + (unsigned)__popc(ah);
        const unsigned tot = wave_sum_u32(ca);
        unsigned long long alive = ((unsigned long long)ah << 32) | al;
        if (G + tot > 256u) {
            const int incl = wave_incl_scan_i((int)ca, lane);
            const int before = incl - (int)ca, room = (int)(256u - G) - before;
            int take = room < 0 ? 0 : (room > (int)ca ? (int)ca : room);
            unsigned long long keep = 0ull;
            while (__any(take > 0)) { if (take > 0) { const unsigned long long low = alive & (0ull - alive); keep |= low; alive ^= low; --take; } }
            alive = keep;
        }
        selm = (((unsigned long long)gh << 32) | gl) | alive;
    }
#if USE_LIST
    if (t >= 256) {
        LAS unsigned short* lb = (LAS unsigned short*)(C.lds + MISC_OFF + 1024) + (C.wave & 3) * 256;
        unsigned w0 = (unsigned)selm, w1 = (unsigned)(selm >> 32);
        const int c = __popc(w0) + __popc(w1); const int incl = wave_incl_scan_i(c, lane); int pos = incl - c;
        while (w0) { const int bit = __ffs(w0) - 1; w0 &= w0 - 1; if (pos < 256) lb[pos] = (unsigned short)(64 * lane + bit); ++pos; }
        while (w1) { const int bit = __ffs(w1) - 1; w1 &= w1 - 1; if (pos < 256) lb[pos] = (unsigned short)(64 * lane + 32 + bit); ++pos; }
        asm volatile("" ::: "memory");
        const v2u e = *(const LAS v2u*)(lb + 4 * lane);
        *(v2u*)((unsigned short*)SEL + (size_t)(b * SEQ + t) * 256 + 4 * lane) = e;
        asm volatile("" ::: "memory");
    }
#else
    if (64 * lane <= t) *(unsigned long long*)(SEL + (size_t)(b * SEQ + t) * 128 + 2 * lane) = selm;
#endif
}

__device__ __forceinline__ void ph_dsa_b2_wave(Ctx& C, int b, int t4) {
    const bf16* PROJ = (const bf16*)(C.ws + WS_P); const unsigned* SEL = (const unsigned*)(C.ws + WS_SEL); bf16* YM = (bf16*)(C.ws + WS_H);
    const bf16* KFA = (const bf16*)(C.ws + WS_KFA); const bf16* VF = (const bf16*)(C.ws + WS_VF);
    const int lane = C.lane, n = lane & 31, h = lane >> 5, tl = n >> 3, hd = n & 7;
    const int ntile = ((t4 + 3) >> 5) + 1;
    const size_t qrow = (size_t)b * SEQ + t4 + tl;
    bf16x8 qf[5];
    {
        const bf16* qp = PROJ + qrow * PW + C_AQ + hd * 64 + 8 * h;
#pragma unroll
        for (int ks = 0; ks < 4; ++ks) {
            const v4u q4 = *(const v4u*)(qp + 16 * ks); const unsigned qw[4] = {q4.x, q4.y, q4.z, q4.w}; v4u o;
            unsigned ow[4];
#pragma unroll
            for (int x = 0; x < 4; ++x) ow[x] = pk2(bf2f(qw[x] & 0xffffu) * (0.125f * LOG2E), bf2f(qw[x] >> 16) * (0.125f * LOG2E));
            o.x = ow[0]; o.y = ow[1]; o.z = ow[2]; o.w = ow[3]; qf[ks] = __builtin_bit_cast(bf16x8, o);
        }
        const unsigned one = 0x3f80u, sl = f2bf(exp2f(-(float)(hd + 1)));
        v4u e; e.x = (tl == 0 ? one : 0u) | ((tl == 1 ? one : 0u) << 16); e.y = (tl == 2 ? one : 0u) | ((tl == 3 ? one : 0u) << 16); e.z = sl | (sl << 16); e.w = sl;
        if (h) { e.x = 0u; e.y = 0u; e.z = 0u; e.w = 0u; }
        qf[4] = __builtin_bit_cast(bf16x8, e);
    }
    f32x16 O0, O1;
#pragma unroll
    for (int x = 0; x < 16; ++x) { O0[x] = 0.f; O1[x] = 0.f; }
    float m = -3.0e38f, lsum = 0.f;
    const unsigned NEGB = 0xf149u;
    const bf16* kb = KFA + (size_t)(b * 128) * 2048 + lane * 8; const bf16* vb = VF + (size_t)(b * 128) * 2048 + lane * 8;
    const unsigned* selp = SEL + ((size_t)b * SEQ + t4 + (lane & 3)) * 128;
    bf16x8 kc[4], vc[4]; unsigned wc_;
#pragma unroll
    for (int ks = 0; ks < 4; ++ks) { kc[ks] = *(const bf16x8*)(kb + ks * 512); vc[ks] = *(const bf16x8*)(vb + ks * 512); }
    wc_ = selp[0];
    for (int tile = 0; tile < ntile; ++tile) {
        bf16x8 kn[4], vn[4]; unsigned wn = 0u;
        const int tn = (tile + 1 < ntile) ? tile + 1 : tile;
#pragma unroll
        for (int ks = 0; ks < 4; ++ks) { kn[ks] = *(const bf16x8*)(kb + (size_t)tn * 2048 + ks * 512); vn[ks] = *(const bf16x8*)(vb + (size_t)tn * 2048 + ks * 512); }
        wn = selp[tn];
        bf16x8 kx;
        {
            const unsigned w0 = (unsigned)__builtin_amdgcn_readlane((int)wc_, 0), w1 = (unsigned)__builtin_amdgcn_readlane((int)wc_, 1), w2 = (unsigned)__builtin_amdgcn_readlane((int)wc_, 2), w3 = (unsigned)__builtin_amdgcn_readlane((int)wc_, 3);
            const unsigned m0 = ((w0 >> n) & 1u) ? 0u : NEGB, m1 = ((w1 >> n) & 1u) ? 0u : NEGB, m2 = ((w2 >> n) & 1u) ? 0u : NEGB, m3 = ((w3 >> n) & 1u) ? 0u : NEGB;
            const float cs = LOG2E * (float)(tile * 32 + n);
            const unsigned c1 = f2bf(cs); const float r1 = cs - bf2f(c1); const unsigned c2 = f2bf(r1); const float r2 = r1 - bf2f(c2); const unsigned c3 = f2bf(r2);
            v4u e; e.x = m0 | (m1 << 16); e.y = m2 | (m3 << 16); e.z = c1 | (c2 << 16); e.w = c3;
            if (h) { e.x = 0u; e.y = 0u; e.z = 0u; e.w = 0u; }
            kx = __builtin_bit_cast(bf16x8, e);
        }
        f32x16 S;
#pragma unroll
        for (int x = 0; x < 16; ++x) S[x] = 0.f;
#pragma unroll
        for (int ks = 0; ks < 4; ++ks) S = mfma32(kc[ks], qf[ks], S);
        S = mfma32(kx, qf[4], S);
        float mloc = S[0];
#pragma unroll
        for (int x = 1; x < 16; ++x) mloc = fmaxf(mloc, S[x]);
        mloc = fmaxf(mloc, __shfl_xor(mloc, 32));
        const float mnew = fmaxf(m, mloc), alpha = __builtin_amdgcn_exp2f(m - mnew);
        m = mnew;
        float ps = 0.f;
#pragma unroll
        for (int x = 0; x < 16; ++x) { S[x] = __builtin_amdgcn_exp2f(S[x] - mnew); ps += S[x]; }
        lsum = lsum * alpha + ps;
#pragma unroll
        for (int x = 0; x < 16; ++x) { O0[x] *= alpha; O1[x] *= alpha; }
        v4u p0, p1;
        p0.x = pk2(S[0], S[1]); p0.y = pk2(S[2], S[3]); p0.z = pk2(S[4], S[5]); p0.w = pk2(S[6], S[7]);
        p1.x = pk2(S[8], S[9]); p1.y = pk2(S[10], S[11]); p1.z = pk2(S[12], S[13]); p1.w = pk2(S[14], S[15]);
        const bf16x8 pf0 = __builtin_bit_cast(bf16x8, p0), pf1 = __builtin_bit_cast(bf16x8, p1);
        O0 = mfma32(vc[0], pf0, O0); O1 = mfma32(vc[1], pf0, O1);
        O0 = mfma32(vc[2], pf1, O0); O1 = mfma32(vc[3], pf1, O1);
#pragma unroll
        for (int ks = 0; ks < 4; ++ks) { kc[ks] = kn[ks]; vc[ks] = vn[ks]; }
        wc_ = wn;
    }
    const float inv = 1.f / (lsum + __shfl_xor(lsum, 32));
    bf16* yo = YM + qrow * DM + hd * 64 + 4 * h;
#pragma unroll
    for (int j4 = 0; j4 < 4; ++j4) {
        v2u o; o.x = pk2(O0[4 * j4] * inv, O0[4 * j4 + 1] * inv); o.y = pk2(O0[4 * j4 + 2] * inv, O0[4 * j4 + 3] * inv);
        *(v2u*)(yo + 8 * j4) = o;
        v2u o2; o2.x = pk2(O1[4 * j4] * inv, O1[4 * j4 + 1] * inv); o2.y = pk2(O1[4 * j4 + 2] * inv, O1[4 * j4 + 3] * inv);
        *(v2u*)(yo + 32 + 8 * j4) = o2;
    }
}

__device__ __forceinline__ f32x4 mfma16(bf16x8 a, bf16x8 b, f32x4 c) { return __builtin_amdgcn_mfma_f32_16x16x32_bf16(a, b, c, 0, 0, 0); }
constexpr int B3_VS_PITCH = 144;
constexpr int B3_WAVE_LDS = 640 + 32 * B3_VS_PITCH;
#ifdef PROBE_HOT
#define B3_SKIP(bit) ((PROBE_SKIP & (bit)) && C.hot != 0xffff)
#define B3_HOTMASK C.hot
#else
#define B3_SKIP(bit) false
#define B3_HOTMASK 0xffff
#endif
template <bool FULL>
__device__ __forceinline__ void b3_core(Ctx& C, int b, int t, int nsel, const v4u qc0, const v4u qc1, LAS unsigned short* lst, LAS unsigned char* vs) {
    const bf16* PROJ = (const bf16*)(C.ws + WS_P); bf16* YM = (bf16*)C.out;
    const int lane = C.lane, m16 = lane & 15, g = lane >> 4;
    const size_t row = (size_t)b * SEQ + t;
    const int nt16 = FULL ? 16 : (nsel + 15) >> 4, nk32 = FULL ? 8 : (nsel + 31) >> 5;
    const bf16* vbase = PROJ + (size_t)b * SEQ * PW + C_AV + 8 * (lane & 7); const bf16* kbase = PROJ + (size_t)b * SEQ * PW + C_AK + 8 * g;
    v4u vb[3][4];
#pragma unroll
    for (int i = 0; i < 4; ++i) { const int s = (int)lst[8 * i + (lane >> 3)] & B3_HOTMASK; vb[0][i] = *(const v4u*)(vbase + (size_t)s * PW); }
    bf16x8 qf[2];
#pragma unroll
    for (int ks = 0; ks < 2; ++ks) {
        const v4u q4 = ks ? qc1 : qc0; const unsigned qw[4] = {q4.x, q4.y, q4.z, q4.w}; unsigned ow[4];
#pragma unroll
        for (int x = 0; x < 4; ++x) ow[x] = (m16 < 8) ? pk2(bf2f(qw[x] & 0xffffu) * (0.125f * LOG2E), bf2f(qw[x] >> 16) * (0.125f * LOG2E)) : 0u;
        v4u o; o.x = ow[0]; o.y = ow[1]; o.z = ow[2]; o.w = ow[3]; qf[ks] = __builtin_bit_cast(bf16x8, o);
    }
    const float sl2 = exp2f(-(float)((m16 & 7) + 1)) * LOG2E, tf = (float)t;
    f32x4 lg[16];
    bf16x8 a0[2][4], a1[2][4];
#define B3_GATHER(buf, hf_) { _Pragma("unroll") for (int i = 0; i < 4; ++i) { const int sm_k = ((FULL || 4 * (hf_) + i < nt16) ? (int)lst[16 * (4 * (hf_) + i) + m16] : 0) & B3_HOTMASK; \
        const bf16* kp = kbase + (size_t)sm_k * PW; a0[buf][i] = *(const bf16x8*)kp; a1[buf][i] = *(const bf16x8*)(kp + 32); } }
    if (!B3_SKIP(4)) { B3_GATHER(0, 0) B3_GATHER(1, 1) }
#pragma unroll
    for (int kt = 0; kt < 16; ++kt) {
        if (FULL || kt < nt16) {
            const v2u p4 = *(const LAS v2u*)(lst + 16 * kt + 4 * g);
            const float sr[4] = {(float)(p4.x & 0xffffu), (float)(p4.x >> 16), (float)(p4.y & 0xffffu), (float)(p4.y >> 16)};
#pragma unroll
            for (int r = 0; r < 4; ++r) lg[kt][r] = (FULL || 16 * kt + 4 * g + r < nsel) ? sl2 * (sr[r] - tf) : -3.0e38f;
        } else lg[kt] = (f32x4){-3.0e38f, -3.0e38f, -3.0e38f, -3.0e38f};
    }
#pragma unroll
    for (int hf = 0; hf < 4; ++hf) {
        if (!B3_SKIP(2)) {
#pragma unroll
            for (int i = 0; i < 4; ++i) if (FULL || 4 * hf + i < nt16) lg[4 * hf + i] = mfma16(a0[hf & 1][i], qf[0], lg[4 * hf + i]);
#pragma unroll
            for (int i = 0; i < 4; ++i) if (FULL || 4 * hf + i < nt16) lg[4 * hf + i] = mfma16(a1[hf & 1][i], qf[1], lg[4 * hf + i]);
        }
        if (!B3_SKIP(4)) { if (hf == 0) B3_GATHER(0, 2) if (hf == 1) B3_GATHER(1, 3) }
    }
    float mx;
    {
        float m0 = -3.0e38f, m1 = -3.0e38f, m2 = -3.0e38f, m3 = -3.0e38f;
#pragma unroll
        for (int kt = 0; kt < 16; ++kt) { m0 = fmaxf(m0, lg[kt][0]); m1 = fmaxf(m1, lg[kt][1]); m2 = fmaxf(m2, lg[kt][2]); m3 = fmaxf(m3, lg[kt][3]); }
        mx = fmaxf(fmaxf(m0, m1), fmaxf(m2, m3));
    }
#undef B3_GATHER
#pragma unroll
    for (int d = 1; d < 3; ++d) if (FULL || d < nk32) {
#pragma unroll
        for (int i = 0; i < 4; ++i) { const int s = (int)lst[32 * d + 8 * i + (lane >> 3)] & B3_HOTMASK; vb[d][i] = *(const v4u*)(vbase + (size_t)s * PW); }
    }
    mx = fmaxf(mx, SHX_F(mx, 16, lane)); mx = fmaxf(mx, SHX_F(mx, 32, lane));
    float sm_;
    {
        float s0 = 0.f, s1 = 0.f, s2 = 0.f, s3 = 0.f;
#pragma unroll
        for (int kt = 0; kt < 16; ++kt) {
            if (FULL || kt < nt16) {
                const float p0 = __builtin_amdgcn_exp2f(lg[kt][0] - mx), p1 = __builtin_amdgcn_exp2f(lg[kt][1] - mx), p2 = __builtin_amdgcn_exp2f(lg[kt][2] - mx), p3 = __builtin_amdgcn_exp2f(lg[kt][3] - mx);
                lg[kt] = (f32x4){p0, p1, p2, p3}; s0 += p0; s1 += p1; s2 += p2; s3 += p3;
            } else lg[kt] = (f32x4){0.f, 0.f, 0.f, 0.f};
        }
        sm_ = (s0 + s1) + (s2 + s3);
    }
    sm_ += SHX_F(sm_, 16, lane); sm_ += SHX_F(sm_, 32, lane);
    const float inv = 1.f / sm_;
    v4u pbk[8];
#pragma unroll
    for (int kk = 0; kk < 8; ++kk) { pbk[kk].x = pk2(lg[2 * kk][0], lg[2 * kk][1]); pbk[kk].y = pk2(lg[2 * kk][2], lg[2 * kk][3]); pbk[kk].z = pk2(lg[2 * kk + 1][0], lg[2 * kk + 1][1]); pbk[kk].w = pk2(lg[2 * kk + 1][2], lg[2 * kk + 1][3]); }
    f32x4 O[4];
#pragma unroll
    for (int i = 0; i < 4; ++i) O[i] = (f32x4){0.f, 0.f, 0.f, 0.f};
#pragma unroll
    for (int kk = 0; kk < 8; ++kk) if ((FULL || kk < nk32) && !B3_SKIP(1)) {
#pragma unroll
        for (int i = 0; i < 4; ++i) *(LAS v4u*)(vs + (8 * i + (lane >> 3)) * B3_VS_PITCH + (lane & 7) * 16) = vb[kk % 3][i];
        if (kk >= 1 && kk + 2 < 8 && (FULL || kk + 2 < nk32)) {
#pragma unroll
            for (int i = 0; i < 4; ++i) { const int s = (int)lst[32 * (kk + 2) + 8 * i + (lane >> 3)] & B3_HOTMASK; vb[(kk + 2) % 3][i] = *(const v4u*)(vbase + (size_t)s * PW); }
        }
        asm volatile("s_waitcnt lgkmcnt(0)" ::: "memory");
        const bf16x8 pB = __builtin_bit_cast(bf16x8, pbk[kk]);
#pragma unroll
        for (int u = 0; u < 2; ++u) {
            unsigned w[8];
#pragma unroll
            for (int j = 0; j < 8; ++j) { const int sl = (j < 4) ? 4 * g + j : 16 + 4 * g + (j - 4); w[j] = *(const LAS unsigned*)(vs + sl * B3_VS_PITCH + (32 * u + 2 * m16) * 2); }
            v4u ae, ao;
            ae.x = (w[0] & 0xffffu) | (w[1] << 16); ae.y = (w[2] & 0xffffu) | (w[3] << 16); ae.z = (w[4] & 0xffffu) | (w[5] << 16); ae.w = (w[6] & 0xffffu) | (w[7] << 16);
            ao.x = (w[0] >> 16) | (w[1] & 0xffff0000u); ao.y = (w[2] >> 16) | (w[3] & 0xffff0000u); ao.z = (w[4] >> 16) | (w[5] & 0xffff0000u); ao.w = (w[6] >> 16) | (w[7] & 0xffff0000u);
            O[2 * u] = mfma16(__builtin_bit_cast(bf16x8, ae), pB, O[2 * u]); O[2 * u + 1] = mfma16(__builtin_bit_cast(bf16x8, ao), pB, O[2 * u + 1]);
        }
    }
    if (m16 < 8) {
#pragma unroll
        for (int u = 0; u < 2; ++u) {
            v4u o; o.x = pk2(O[2 * u][0] * inv, O[2 * u + 1][0] * inv); o.y = pk2(O[2 * u][1] * inv, O[2 * u + 1][1] * inv); o.z = pk2(O[2 * u][2] * inv, O[2 * u + 1][2] * inv); o.w = pk2(O[2 * u][3] * inv, O[2 * u + 1][3] * inv);
            *(v4u*)(YM + row * DM + m16 * 64 + 32 * u + 8 * g) = o;
        }
    }
}
__device__ __forceinline__ void ph_dsa_b3_wave(Ctx& C, int b, int t4) {
    LAS unsigned short* lst = (LAS unsigned short*)(C.lds + C.wave * B3_WAVE_LDS);
    LAS unsigned char* vs = C.lds + C.wave * B3_WAVE_LDS + 640;
    const bf16* PROJ = (const bf16*)(C.ws + WS_P); const unsigned* SEL = (const unsigned*)(C.ws + WS_SEL);
    const int lane = C.lane, m16 = lane & 15, g = lane >> 4;
#if USE_LIST
    v2u lqn; v4u qn0, qn1;
#define B3_PREFETCH(tq) { const size_t r_ = (size_t)b * SEQ + (tq); \
        lqn = ((tq) >= 256) ? *(const v2u*)((const unsigned short*)SEL + r_ * 256 + 4 * lane) : (v2u){0u, 0u}; \
        const bf16* qp_ = PROJ + r_ * PW + C_AQ + (m16 & 7) * 64 + 8 * g; qn0 = *(const v4u*)qp_; qn1 = *(const v4u*)(qp_ + 32); }
    B3_PREFETCH(t4)
#pragma unroll 1
    for (int qi = 0; qi < 4; ++qi) {
        const int t = t4 + qi;
        v2u lq = lqn;
        const v4u qc0 = qn0, qc1 = qn1;
        if (qi < 3) B3_PREFETCH(t + 1)
        const int nsel = t < 256 ? t + 1 : 256;
        if (t < 256) { const int i0 = 4 * lane; lq.x = (unsigned)(i0 <= t ? i0 : 0) | ((unsigned)(i0 + 1 <= t ? i0 + 1 : 0) << 16); lq.y = (unsigned)(i0 + 2 <= t ? i0 + 2 : 0) | ((unsigned)(i0 + 3 <= t ? i0 + 3 : 0) << 16); }
        *(LAS v2u*)(lst + 4 * lane) = lq;
        if (lane < 16) *(LAS unsigned*)(lst + 256 + 2 * lane) = 0u;
        asm volatile("s_waitcnt lgkmcnt(0)" ::: "memory");
        if (nsel == 256) b3_core<true>(C, b, t, nsel, qc0, qc1, lst, vs); else b3_core<false>(C, b, t, nsel, qc0, qc1, lst, vs);
    }
#undef B3_PREFETCH
#else
    unsigned w0n, w1n; v4u qn0, qn1;
#define B3_PREFETCH(tq) { const size_t r_ = (size_t)b * SEQ + (tq); const int nw_ = ((tq) >> 5) + 1; \
        w0n = (2 * lane < nw_) ? SEL[r_ * 128 + 2 * lane] : 0u; w1n = (2 * lane + 1 < nw_) ? SEL[r_ * 128 + 2 * lane + 1] : 0u; \
        const bf16* qp_ = PROJ + r_ * PW + C_AQ + (m16 & 7) * 64 + 8 * g; qn0 = *(const v4u*)qp_; qn1 = *(const v4u*)(qp_ + 32); }
    B3_PREFETCH(t4)
#pragma unroll 1
    for (int qi = 0; qi < 4; ++qi) {
        const int t = t4 + qi;
        unsigned w0 = w0n, w1 = w1n;
        const v4u qc0 = qn0, qc1 = qn1;
        if (qi < 3) B3_PREFETCH(t + 1)
        int nsel;
        {
            const int c = __popc(w0) + __popc(w1); const int incl = wave_incl_scan_i(c, lane);
            int pos = incl - c; const int tot = __builtin_amdgcn_readlane(incl, 63);
            while (w0) { const int bit = __ffs(w0) - 1; w0 &= w0 - 1; if (pos < 256) lst[pos] = (unsigned short)(64 * lane + bit); ++pos; }
            while (w1) { const int bit = __ffs(w1) - 1; w1 &= w1 - 1; if (pos < 256) lst[pos] = (unsigned short)(64 * lane + 32 + bit); ++pos; }
            nsel = tot < 256 ? tot : 256;
            if (lane < 32 && nsel + lane < 288) lst[nsel + lane] = 0;
        }
        asm volatile("s_waitcnt lgkmcnt(0)" ::: "memory");
        if (nsel == 256) b3_core<true>(C, b, t, nsel, qc0, qc1, lst, vs); else b3_core<false>(C, b, t, nsel, qc0, qc1, lst, vs);
    }
#undef B3_PREFETCH
#endif
}

namespace pg8 {
constexpr int BM = 256, BK = 64, HALF = 128, HTB = HALF * BK * 2, STAGE_BYTES = 8 * HTB, NXCD = 8, WGM = 8;
__host__ __device__ __forceinline__ int lds_byte(int r, int c) { const int st = (r >> 4) * 2 + (c >> 5), rr = r & 15, cc = c & 31, ob = rr * 64 + cc * 2; return st * 1024 + (ob ^ (((ob >> 9) & 1) << 5)); }
__host__ __device__ __forceinline__ void stage_rc(int b, int& R, int& C) { const int st = b / 1024, sb = b % 1024, swz = sb ^ (((sb >> 9) & 1) << 5); R = (st >> 1) * 16 + swz / 64; C = (st & 1) * 32 + (swz % 64) / 2; }
__host__ __device__ __forceinline__ int perm32(int rho) { const int n = rho >> 4, i = rho & 15; return 8 * (i >> 2) + 4 * n + (i & 3); }

struct Unit { int pm, pn, po, eb; };
struct Gemm { const bf16* A; const bf16* Bt; int K; size_t ebytes; const int* rowsrc = nullptr; };

struct Order {
    int nM, nN, nwg, G, c, p_lo, amode; const LAS unsigned char* pe;
    __device__ __forceinline__ void init(int nM_, int nN_, int G_, int c_, int p_lo_, int amode_, const LAS unsigned char* pe_) { nM = nM_; nN = nN_; nwg = nM * nN; G = G_; c = c_; p_lo = p_lo_; amode = amode_; pe = pe_; }
    __device__ __forceinline__ bool next(int i, Unit& u) const {
        const long L = (long)i * G + c; if (L >= nwg) return false;
        int wgid = (int)L; { const int q = nwg / NXCD, r = nwg % NXCD, xcd = wgid % NXCD, off = wgid / NXCD; wgid = (xcd < r ? xcd * (q + 1) : r * (q + 1) + (xcd - r) * q) + off; }
        const int nig = WGM * nN, gid = wgid / nig, fm = gid * WGM, gsz = (nM - fm) < WGM ? (nM - fm) : WGM;
        const int lp = fm + ((wgid % nig) % gsz), gp = p_lo + lp; u.pn = (wgid % nig) / gsz;
        u.pm = amode == 0 ? gp : lp; u.po = amode == 0 ? lp : gp; u.eb = pe ? __builtin_amdgcn_readfirstlane((int)pe[gp]) : 0; return true;
    }
};

__device__ __forceinline__ unsigned cvt_pk_bf16(float lo, float hi) { return pk2(lo, hi); }
__device__ __forceinline__ float silu_fast(float g) { return g * __builtin_amdgcn_rcpf(1.f + __builtin_amdgcn_exp2f(-g * LOG2E)); }

struct EpiBf16 {
    static constexpr bool PERM = true;
    bf16* O; int ldc;
    __device__ __forceinline__ void operator()(const f32x4 (&acc)[2][2][4][2], const Unit& u, int wr, int wc, int fr, int fq) const {
        const int row0 = u.po * BM + wr * 64 + fr, col0 = u.pn * BM + wc * 32 + 8 * fq;
#pragma unroll
        for (int ai = 0; ai < 2; ++ai)
#pragma unroll
            for (int m = 0; m < 4; ++m) { bf16* rowp = O + (size_t)(row0 + ai * HALF + m * 16) * ldc + col0;
#pragma unroll
                for (int bj = 0; bj < 2; ++bj) { const f32x4 v0 = acc[ai][bj][m][0], v1 = acc[ai][bj][m][1];
                    v4u w; w.x = cvt_pk_bf16(v0[0], v0[1]); w.y = cvt_pk_bf16(v0[2], v0[3]); w.z = cvt_pk_bf16(v1[0], v1[1]); w.w = cvt_pk_bf16(v1[2], v1[3]);
                    *(v4u*)(rowp + bj * HALF) = w; } }
    }
};
struct EpiProj {
    static constexpr bool PERM = true;
    bf16* O; bf16* KFA; bf16* KFI; bf16* VF;
    __device__ __forceinline__ void operator()(const f32x4 (&acc)[2][2][4][2], const Unit& u, int wr, int wc, int fr, int fq) const {
        const int row0 = u.po * BM + wr * 64 + fr, col0 = u.pn * BM + wc * 32 + 8 * fq;
#pragma unroll
        for (int ai = 0; ai < 2; ++ai)
#pragma unroll
            for (int m = 0; m < 4; ++m) { const int row = row0 + ai * HALF + m * 16; bf16* rowp = O + (size_t)row * PW + col0;
#pragma unroll
                for (int bj = 0; bj < 2; ++bj) { const f32x4 v0 = acc[ai][bj][m][0], v1 = acc[ai][bj][m][1];
                    v4u w; w.x = cvt_pk_bf16(v0[0], v0[1]); w.y = cvt_pk_bf16(v0[2], v0[3]); w.z = cvt_pk_bf16(v1[0], v1[1]); w.w = cvt_pk_bf16(v1[2], v1[3]);
                    *(v4u*)(rowp + bj * HALF) = w;
                    if (u.pn == 10 && wc < 2 && bj == 1) {
                        const int dc = 4 * wc + fq;
                        bf16* kf = KFI + ((size_t)(row >> 5) * 4 + (dc >> 1)) * 512 + (32 * (dc & 1) + (row & 31)) * 8;
                        *(v4u*)kf = w;
                    } } }
    }
};
struct EpiGate {
    static constexpr bool PERM = true;
    bf16* O; const float* gate;
    __device__ __forceinline__ void operator()(const f32x4 (&acc)[2][2][4][2], const Unit& u, int wr, int wc, int fr, int fq) const {
        const int row0 = u.po * BM + wr * 64 + fr, col0 = u.pn * BM + wc * 32 + 8 * fq;
#pragma unroll
        for (int ai = 0; ai < 2; ++ai)
#pragma unroll
            for (int m = 0; m < 4; ++m) { const int row = row0 + ai * HALF + m * 16; const float g = gate ? gate[row] : 1.f; bf16* rowp = O + (size_t)row * DM + col0;
#pragma unroll
                for (int bj = 0; bj < 2; ++bj) { const f32x4 v0 = acc[ai][bj][m][0] * g, v1 = acc[ai][bj][m][1] * g;
                    v4u w; w.x = cvt_pk_bf16(v0[0], v0[1]); w.y = cvt_pk_bf16(v0[2], v0[3]); w.z = cvt_pk_bf16(v1[0], v1[1]); w.w = cvt_pk_bf16(v1[2], v1[3]);
                    *(v4u*)(rowp + bj * HALF) = w; } }
    }
};
struct EpiSwiglu {
    static constexpr bool PERM = true;
    bf16* O;
    __device__ __forceinline__ void operator()(const f32x4 (&acc)[2][2][4][2], const Unit& u, int wr, int wc, int fr, int fq) const {
        const int row0 = u.po * BM + wr * 64 + fr, col0 = u.pn * HALF + wc * 32 + 8 * fq;
#pragma unroll
        for (int ai = 0; ai < 2; ++ai)
#pragma unroll
            for (int m = 0; m < 4; ++m) { bf16* rowp = O + (size_t)(row0 + ai * HALF + m * 16) * DFF + col0;
                const f32x4 g0 = acc[ai][0][m][0], g1 = acc[ai][0][m][1], u0 = acc[ai][1][m][0], u1 = acc[ai][1][m][1];
                float ge[8] = {g0[0], g0[1], g0[2], g0[3], g1[0], g1[1], g1[2], g1[3]}; const float ue[8] = {u0[0], u0[1], u0[2], u0[3], u1[0], u1[1], u1[2], u1[3]};
                float ee[8];
#pragma unroll
                for (int x = 0; x < 8; ++x) ee[x] = __builtin_amdgcn_exp2f(-ge[x] * LOG2E);
#pragma unroll
                for (int x = 0; x < 8; ++x) ee[x] = __builtin_amdgcn_rcpf(1.f + ee[x]);
#pragma unroll
                for (int x = 0; x < 8; ++x) ge[x] = ge[x] * ee[x] * ue[x];
                v4u w; w.x = pk2(ge[0], ge[1]); w.y = pk2(ge[2], ge[3]); w.z = pk2(ge[4], ge[5]); w.w = pk2(ge[6], ge[7]);
                *(v4u*)rowp = w; }
    }
};

template <class Epi, class Sched>
__device__ __forceinline__ void gemm_phase(LAS unsigned char* lds, const int tid, const Gemm g, const Sched& S, const Epi& E) {
    const int wid = __builtin_amdgcn_readfirstlane(tid >> 6), lane = tid & 63, wr = wid >> 2, wc = wid & 3, fr = lane & 15, fq = lane >> 4;
    const int K = g.K, nt = K / BK;
    unsigned voffB[2]; int RA[2]; unsigned cA2[2];
#pragma unroll
    for (int i = 0; i < 2; ++i) { int R, C; stage_rc(tid * 16 + i * 8192, R, C); const int Rb = Epi::PERM ? ((R & ~31) + perm32(R & 31)) : R; RA[i] = R; cA2[i] = (unsigned)C * 2u; voffB[i] = (unsigned)(Rb * K + C) * 2u; }
    unsigned voffG[2][2], voffN[2][2];
#define PG8_ROWS(dst, pm_) do { _Pragma("unroll") for (int hh_ = 0; hh_ < 2; ++hh_) _Pragma("unroll") for (int ii_ = 0; ii_ < 2; ++ii_) { const int pr_ = (pm_) * BM + hh_ * HALF + RA[ii_]; \
        const unsigned gr_ = g.rowsrc ? (unsigned)g.rowsrc[pr_] : (unsigned)pr_; dst[hh_][ii_] = gr_ * (unsigned)(K * 2) + cA2[ii_]; } } while (0)
    const size_t kstep = (size_t)(BK * 2);
    const size_t hstep = (size_t)HALF * K * 2;
    const size_t tstep = 2 * hstep;
    const unsigned ldsw = (unsigned)wid * 1024u;
    const int aoff = lds_byte(wr * 64 + fr, fq * 8), boff = lds_byte(wc * 32 + fr, fq * 8);
#define PG8_SA(b, h) (((b) * 2 + (h)) * HTB)
#define PG8_SB(b, h) ((4 + (b) * 2 + (h)) * HTB)
#define PG8_STAGE(bufoff, gbase, voff) do { _Pragma("unroll") for (int _i = 0; _i < 2; ++_i) \
        __builtin_amdgcn_global_load_lds((const unsigned*)((const char*)(gbase) + (voff)[_i]), (LAS unsigned*)(lds + (bufoff) + ldsw + _i * 8192), 16, 0, 0); } while (0)
#define PG8_STAGEA(bufoff, kbase, vo) do { _Pragma("unroll") for (int _i = 0; _i < 2; ++_i) \
        __builtin_amdgcn_global_load_lds((const unsigned*)((const char*)(kbase) + (vo)[_i]), (LAS unsigned*)(lds + (bufoff) + ldsw + _i * 8192), 16, 0, 0); } while (0)
#define PG8_LDA(dst, b, h) do { _Pragma("unroll") for (int m = 0; m < 4; ++m) _Pragma("unroll") for (int k = 0; k < 2; ++k) dst[m][k] = *(const LAS bf16x8*)(lds + PG8_SA(b, h) + aoff + m * 2048 + k * 1024); } while (0)
#define PG8_LDB(dst, b, h) do { _Pragma("unroll") for (int n = 0; n < 2; ++n) _Pragma("unroll") for (int k = 0; k < 2; ++k) dst[n][k] = *(const LAS bf16x8*)(lds + PG8_SB(b, h) + boff + n * 2048 + k * 1024); } while (0)
#define PG8_MMA(ai, bj, At, Bt) do { __builtin_amdgcn_s_setprio(1); _Pragma("unroll") for (int m = 0; m < 4; ++m) _Pragma("unroll") for (int n = 0; n < 2; ++n) _Pragma("unroll") for (int k = 0; k < 2; ++k) \
        acc[ai][bj][m][n] = __builtin_amdgcn_mfma_f32_16x16x32_bf16(Bt[n][k], At[m][k], acc[ai][bj][m][n], 0, 0, 0); __builtin_amdgcn_s_setprio(0); } while (0)
#define PG8_WAIT_V(n) asm volatile("s_waitcnt vmcnt(" #n ")" ::: "memory")
#define PG8_WAIT_L(n) asm volatile("s_waitcnt lgkmcnt(" #n ")" ::: "memory")
#define PG8_BAR __builtin_amdgcn_s_barrier()
#define PG8_SCHED __builtin_amdgcn_sched_barrier(0)
    Unit cur, nxt; int ui = 0;
    if (!S.next(0, cur)) return;
    f32x4 acc[2][2][4][2];
#pragma unroll
    for (int a = 0; a < 2; ++a)
#pragma unroll
        for (int b = 0; b < 2; ++b)
#pragma unroll
            for (int m = 0; m < 4; ++m)
#pragma unroll
                for (int n = 0; n < 2; ++n) acc[a][b][m][n] = (f32x4){0.f, 0.f, 0.f, 0.f};
    bf16x8 At[4][2], B0[2][2], B1[2][2];
    PG8_ROWS(voffG, cur.pm);
    const char* cA = (const char*)g.A;
    const char* cB = (const char*)g.Bt + (size_t)cur.eb * g.ebytes + (size_t)cur.pn * tstep;
    PG8_STAGE(PG8_SB(0, 0), cB, voffB); PG8_STAGE(PG8_SB(0, 1), cB + hstep, voffB); PG8_STAGEA(PG8_SA(0, 0), cA, voffG[0]); PG8_STAGEA(PG8_SA(0, 1), cA, voffG[1]);
    if (wr == 1) PG8_BAR;
    PG8_WAIT_V(2); PG8_BAR;
    PG8_STAGE(PG8_SB(1, 0), cB + kstep, voffB); PG8_STAGEA(PG8_SA(1, 0), cA + kstep, voffG[0]); PG8_STAGE(PG8_SB(1, 1), cB + hstep + kstep, voffB);
    PG8_WAIT_V(6); PG8_BAR;
    for (;;) {
        const bool has_next = S.next(ui + 1, nxt);
        if (has_next) PG8_ROWS(voffN, nxt.pm); else { voffN[0][0] = voffG[0][0]; voffN[0][1] = voffG[0][1]; voffN[1][0] = voffG[1][0]; voffN[1][1] = voffG[1][1]; }
        const char* nB = has_next ? (const char*)g.Bt + (size_t)nxt.eb * g.ebytes + (size_t)nxt.pn * tstep : cB;
#define PG8_PAIR(a1, a2, b2, a3, b3, v2) do { \
              \
            PG8_LDB(B0, 0, 0); PG8_LDB(B1, 0, 1); PG8_SCHED; PG8_LDA(At, 0, 0); PG8_STAGEA(PG8_SA(1, 1), (a1), voffG[1]); \
            PG8_WAIT_V(8); PG8_WAIT_L(0); PG8_BAR; PG8_MMA(0, 0, At, B0); PG8_MMA(0, 1, At, B1); PG8_BAR; PG8_SCHED; \
              \
            PG8_LDA(At, 0, 1); PG8_STAGE(PG8_SB(0, 0), b2, voffB); PG8_STAGE(PG8_SB(0, 1), (b2) + hstep, voffB); PG8_STAGEA(PG8_SA(0, 0), a2, v2[0]); \
            PG8_WAIT_V(8); PG8_WAIT_L(0); PG8_BAR; PG8_MMA(1, 0, At, B0); PG8_MMA(1, 1, At, B1); PG8_BAR; PG8_SCHED; \
              \
            PG8_LDB(B0, 1, 0); PG8_LDB(B1, 1, 1); PG8_SCHED; PG8_LDA(At, 1, 0); PG8_STAGEA(PG8_SA(0, 1), (a2), v2[1]); \
            PG8_WAIT_V(8); PG8_WAIT_L(0); PG8_BAR; PG8_MMA(0, 0, At, B0); PG8_MMA(0, 1, At, B1); PG8_BAR; PG8_SCHED; \
              \
            PG8_LDA(At, 1, 1); PG8_STAGE(PG8_SB(1, 0), b3, voffB); PG8_STAGE(PG8_SB(1, 1), (b3) + hstep, voffB); PG8_STAGEA(PG8_SA(1, 0), a3, v2[0]); \
            PG8_WAIT_V(8); PG8_WAIT_L(0); PG8_BAR; PG8_MMA(1, 0, At, B0); PG8_MMA(1, 1, At, B1); PG8_BAR; PG8_SCHED; } while (0)
        for (int t = 0; t < nt; t += 2) {
            const bool last = (t == nt - 2);
            const char* a1 = cA + (size_t)(t + 1) * kstep;
            const char* a2 = last ? cA : cA + (size_t)(t + 2) * kstep; const char* b2 = last ? nB : cB + (size_t)(t + 2) * kstep;
            const char* a3 = a2 + kstep; const char* b3 = b2 + kstep;
            unsigned v2[2][2];
#pragma unroll
            for (int hh_ = 0; hh_ < 2; ++hh_) { v2[hh_][0] = last ? voffN[hh_][0] : voffG[hh_][0]; v2[hh_][1] = last ? voffN[hh_][1] : voffG[hh_][1]; }
            PG8_PAIR(a1, a2, b2, a3, b3, v2);
        }
#undef PG8_PAIR
        if (wr == 0) PG8_BAR;
        E(acc, cur, wr, wc, fr, fq);
        if (!has_next) break;
#pragma unroll
        for (int a = 0; a < 2; ++a)
#pragma unroll
            for (int b = 0; b < 2; ++b)
#pragma unroll
                for (int m = 0; m < 4; ++m)
#pragma unroll
                    for (int n = 0; n < 2; ++n) acc[a][b][m][n] = (f32x4){0.f, 0.f, 0.f, 0.f};
        cur = nxt; cB = nB; ++ui; voffG[0][0] = voffN[0][0]; voffG[0][1] = voffN[0][1]; voffG[1][0] = voffN[1][0]; voffG[1][1] = voffN[1][1];
        if (wr == 1) PG8_BAR;
    }
    PG8_WAIT_V(0);
    PG8_BAR;
#undef PG8_SA
#undef PG8_SB
#undef PG8_STAGE
#undef PG8_STAGEA
#undef PG8_ROWS
#undef PG8_LDA
#undef PG8_LDB
#undef PG8_MMA
#undef PG8_WAIT_V
#undef PG8_WAIT_L
#undef PG8_BAR
#undef PG8_SCHED
}
}

constexpr int N_STEPS = 2 + 2 * (7 - USE_GSEQ + 2 * NPASS_DENSE) + 2 * (8 - USE_GSEQ + 2 * NPASS_MOE);
#ifndef REP_A
#define REP_A 1
#define REP_B 1
#endif
#ifndef PROBE_ID
#define PROBE_ID 0
#endif
#ifndef REP_BAR
#define REP_BAR 1
#endif
#ifndef REP_C
#define REP_C 1
#endif
#ifndef REP_L
#define REP_L 1
#endif
#ifndef REP_G
#define REP_G 1
#endif
#ifndef USE_B3
#define USE_B3 1
#endif
#ifndef USE_B2
#define USE_B2 1
#define USE_A2 1
#endif
#ifndef USE_PG8
#define USE_PG8 1
#endif
#ifndef USE_A4
#define USE_A4 1
#endif

__global__ void __launch_bounds__(512, 2) hybrid_fwd(Args args) {
    extern __shared__ __attribute__((aligned(16))) unsigned char lds_raw[];
    Ctx C;
    C.lds = (LAS unsigned char*)lds_raw;
    C.MISC = (volatile LAS unsigned*)(C.lds + MISC_OFF);
    C.tid = threadIdx.x; C.lane = C.tid & 63; C.wave = __builtin_amdgcn_readfirstlane(C.tid >> 6);
    C.G = gridDim.x; C.bid = blockIdx.x; C.hot = 0xffff;
    C.ka = (KArgs*)__builtin_amdgcn_kernarg_segment_ptr();
    C.out = args.out; C.ws = args.ws; C.ctl = (unsigned*)(args.ws + WS_CTL);
    if (C.tid < 32) C.MISC[C.tid] = 0u;
    __syncthreads();
    if (!MK_MULTI) (void)xcd_barrier_post(C.ctl + CW_BAR, C.MISC + 8);
    int step = 0;
    const int wave_s = __builtin_amdgcn_readfirstlane((int)threadIdx.x >> 6);
#define STEP_BEGIN if (step >= C.ka->lo && step < C.ka->hi) { { unsigned m_ = ~0u; asm volatile("" : "+s"(m_)); const int ln_ = (int)__builtin_amdgcn_mbcnt_hi(m_, __builtin_amdgcn_mbcnt_lo(m_, 0u)); \
        int t_ = wave_s * 64 + ln_; asm volatile("" : "+v"(t_)); C.tid = t_; C.lane = t_ & 63; C.wave = wave_s; \
        KArgs* k_ = (KArgs*)__builtin_amdgcn_kernarg_segment_ptr(); asm volatile("" : "+s"(k_)); C.ka = k_; C.ws = k_->ws; C.out = k_->out; C.ctl = (unsigned*)(k_->ws + WS_CTL); C.G = gridDim.x; C.bid = blockIdx.x; }
#define STEP_END } if (!MK_MULTI && step >= C.ka->lo && step + 1 < C.ka->hi) { XcdBarrier b_; b_.bar = (unsigned*)(C.ka->ws + WS_CTL) + CW_BAR; b_.x = xb_xcc_id(); b_.st = C.MISC + 8; xcd_barrier(b_); if (REP_BAR > 1) xcd_barrier(b_); } ++step;
#define WSP(T, off) ((T*)(C.ws + (off)))
#define RELAUNDER { int t_ = C.tid; asm volatile("" : "+v"(t_)); C.tid = t_; C.lane = t_ & 63; C.wave = __builtin_amdgcn_readfirstlane(t_ >> 6); }

    STEP_BEGIN
        ph_mod(C); __syncthreads(); ph_conv(C, 0);
#if REP_C > 1
        __syncthreads(); ph_mod(C); __syncthreads(); ph_conv(C, 0);
#endif
    STEP_END
    STEP_BEGIN
        ph_modulate0(C);
#if PROBE_ID == 8
        RELAUNDER ph_modulate0(C); RELAUNDER ph_modulate0(C); RELAUNDER ph_modulate0(C); RELAUNDER ph_modulate0(C);
#endif
    STEP_END

    for (int l = 0; l < DEPTH; ++l) {
        STEP_BEGIN
#if USE_PG8
            { const pg8::Gemm g{WSP(bf16, WS_H), WSP(bf16, WS_WIN), DM, 0}; pg8::Order S; S.init(256, 11, C.G, C.bid, 0, 0, nullptr);
              pg8::gemm_phase(C.lds, C.tid, g, S, pg8::EpiProj{WSP(bf16, WS_P), WSP(bf16, WS_KFA), WSP(bf16, WS_KFI), WSP(bf16, WS_VF)});
#if PROBE_ID == 5
              RELAUNDER pg8::gemm_phase(C.lds, C.tid, g, S, pg8::EpiProj{WSP(bf16, WS_P), WSP(bf16, WS_KFA), WSP(bf16, WS_KFI), WSP(bf16, WS_VF)});
#endif
            }
#else
            for (int u = C.bid; u < 256 * 11; u += C.G) {
                const int pm = u / 11, pn = u % 11; const GUnit gu{pm * 256, pm * 256, pn, 0};
                gemm_simple_unit<0>(C, WSP(bf16, WS_H), DM, nullptr, WSP(bf16, WS_WIN), DM, gu, EpiStoreS{WSP(bf16, WS_P), PW});
            }
#endif
        STEP_END
        STEP_BEGIN
#pragma unroll 1
#if USE_A4
            for (int rp_ = 0; rp_ < (PROBE_ID == 1 ? 2 : 1); ++rp_) {
#ifdef PROBE_HOT
                C.hot = (PROBE_ID == 1 && rp_ == 0) ? PROBE_HOT : 0xffff;
#endif
#ifdef PROBE_SKIP
#define A4_SKIPM ((PROBE_ID == 1 && rp_ == 0) ? PROBE_SKIP : 0)
#else
#define A4_SKIPM 0
#endif
#define A4_MAP(idx_) const int b = (idx_) & 15, r_ = (idx_) >> 4, j_ = (r_ & 15) + 16 * (r_ >> 5), t0 = 4 * (((r_ >> 4) & 1) ? 1023 - j_ : j_);
                LAS unsigned* img = (LAS unsigned*)C.lds;
#if USE_GSEQ
                const int NGW = C.G >= 128 ? 64 : C.G / 2, NW = C.G - NGW, wid = C.bid - NGW;
                const int nun = (wid >= 0 && wid < 16384) ? (16384 - wid + NW - 1) / NW : 0;
                if (wid < 0) {
#pragma unroll 1
                    for (int sq_ = C.bid; sq_ < 64; sq_ += NGW) { RELAUNDER ph_gla_seq(C, l, sq_); }
                } else
#else
                const int NW = C.G, wid = C.bid;
                const int nun = (C.bid < 16384) ? (16384 - C.bid + C.G - 1) / C.G : 0;
#endif
                if (C.wave < 4) {
                    A4S S;
                    { A4_MAP(nun > 0 ? wid : 0) a4_prefetch(C, S, b, t0); }
#pragma unroll 1
                    for (int k = 0; k < nun; ++k) { RELAUNDER
                        { const int nidx = (k + 1 < nun) ? wid + (k + 1) * NW : wid; const int nb = nidx & 15, nr_ = nidx >> 4, nj_ = (nr_ & 15) + 16 * (nr_ >> 5), nt0 = 4 * (((nr_ >> 4) & 1) ? 1023 - nj_ : nj_);
                          A4_MAP(wid + k * NW) a4_score(C, S, img + (k & 1) * A4_BUF, b, t0, nb, nt0); }
                        __syncthreads(); }
                } else {
#pragma unroll 1
                    for (int k = 0; k < nun; ++k) { __syncthreads(); RELAUNDER A4_MAP(wid + k * NW) const int q = C.wave - 4; if (!(A4_SKIPM & 32)) a4_select(C, img + (k & 1) * A4_BUF + q * A3_QP, b, t0 + q); }
                }
                __syncthreads();
#undef A4_MAP
            }
#else
            for (int rp_ = 0; rp_ < (PROBE_ID == 1 ? 2 : 1); ++rp_)
            for (int idx = C.bid; idx < 8192; idx += C.G) {
                RELAUNDER
                const int b = idx & 15, r = idx >> 4, j = (r & 15) + 16 * (r >> 5), qb = ((r >> 4) & 1) ? 511 - j : j;
                A3Q qa; a3_load_q(C, b, qb * 8, qa);
                ph_dsa_a3_unit(C, b, qb * 8, qa, false, 0, 0);
            }
#endif
#if !USE_GSEQ
#pragma unroll 1
            for (int rp_ = 0; rp_ < (PROBE_ID == 3 ? 2 : 1); ++rp_)
            for (int u = C.bid; u < 4096; u += C.G) { RELAUNDER ph_gla1_unit(C, l, u); }
#endif
        STEP_END
#if !USE_GSEQ
        STEP_BEGIN
            ph_gla2(C);
#if PROBE_ID == 9
            RELAUNDER ph_gla2(C, (size_t)66 * MiB); RELAUNDER ph_gla2(C, (size_t)66 * MiB);
#endif
        STEP_END
#endif
        STEP_BEGIN
#if !USE_GSEQ
#pragma unroll 1
            for (int rp_ = 0; rp_ < (PROBE_ID == 4 ? 2 : 1); ++rp_)
            for (int u = C.bid; u < 4096; u += C.G) { RELAUNDER ph_gla3_unit(C, l, u); }
#endif
#if USE_B2
#pragma unroll 1
            for (int rep = 0; rep < (PROBE_ID == 2 ? 2 : 1); ++rep)
#ifdef PROBE_HOT
            { C.hot = (PROBE_ID == 2 && rep == 0) ? PROBE_HOT : 0xffff;
#else
            {
#endif
            for (int idx = C.bid; idx < 2048; idx += C.G) {
                RELAUNDER
                const int b = idx & 15, r = idx >> 4, j = (r & 15) + 16 * (r >> 5), qb = ((r >> 4) & 1) ? 127 - j : j;
#if USE_B3
                ph_dsa_b3_wave(C, b, qb * 32 + C.wave * 4);
#else
                ph_dsa_b2_wave(C, b, qb * 32 + C.wave * 4);
#endif
            }
            }
#else
            for (int u = C.bid; u < 8192; u += C.G) { RELAUNDER ph_dsa_b_unit(C, u & 15, (u >> 4) * 8); }
#endif
        STEP_END
        STEP_BEGIN
#if USE_PG8
            { const pg8::Gemm g{(const bf16*)C.out, WSP(bf16, WS_WOUT), DM, 0}; pg8::Order S; S.init(256, 4, C.G, C.bid, 0, 0, nullptr);
              pg8::gemm_phase(C.lds, C.tid, g, S, pg8::EpiBf16{WSP(bf16, WS_Y), DM});
#if PROBE_ID == 6
              RELAUNDER pg8::gemm_phase(C.lds, C.tid, g, S, pg8::EpiBf16{WSP(bf16, WS_Y), DM});
#endif
            }
#else
            for (int u = C.bid; u < 256 * 4; u += C.G) {
                const int pm = u >> 2, pn = u & 3; const GUnit gu{pm * 256, pm * 256, pn, 0};
                gemm_simple_unit<0>(C, WSP(bf16, WS_H), DM, nullptr, WSP(bf16, WS_WOUT), DM, gu, EpiStoreS{WSP(bf16, WS_Y), DM});
            }
#endif
        STEP_END
        STEP_BEGIN
            const float* Xin = C.in(I_X);
            if (l == 0) ph_ln<false, 0, 0>(C, Xin, l, 0, 2048, l, 3072, true, 0, 0, false);
            else if (l & 1) ph_ln<true, 0, 1>(C, Xin, l, 0, 2048, l, 3072, true, l >> 1, 0, false);
            else ph_ln<false, 0, 1>(C, Xin, l, 0, 2048, l, 3072, true, l >> 1, 0, false);
        STEP_END
        if (l & 1) {
            STEP_BEGIN
                ph_assign(C, l >> 1);
            STEP_END
        }
        for (int pass = 0; pass < ((l & 1) ? NPASS_MOE : NPASS_DENSE); ++pass) {
            STEP_BEGIN
                const bool moe = (l & 1) != 0;
                MoeTab tb; tb.npanels = 256;
#pragma unroll
                for (int e = 0; e < 8; ++e) tb.pend[e] = 65536;
                if (moe) tb = moe_tab(C, l >> 1);
                const int p_lo = pass * PASS_PANELS, p_hi = moe ? ((pass == NPASS_MOE - 1 || tb.npanels < p_lo + PASS_PANELS) ? tb.npanels : p_lo + PASS_PANELS) : p_lo + PASS_PANELS;
                const int npan = p_hi > p_lo ? p_hi - p_lo : 0;
#if USE_PG8
                LAS unsigned char* pe = C.lds + PE_OFF;
                for (int p = C.tid; p < 528; p += 512) pe[p] = (unsigned char)(moe ? panel_expert(tb, p) : 0);
                __syncthreads();
                { const pg8::Gemm g{WSP(bf16, WS_H), WSP(bf16, WS_WGU), DM, (size_t)5632 * 1024 * 2, moe ? (const int*)WSP(int, WS_ROWTOK) : nullptr}; pg8::Order S; S.init(npan, 22, C.G, C.bid, p_lo, 0, pe);
                  pg8::gemm_phase(C.lds, C.tid, g, S, pg8::EpiSwiglu{WSP(bf16, WS_P)});
#if REP_G > 1
                  RELAUNDER pg8::gemm_phase(C.lds, C.tid, g, S, pg8::EpiSwiglu{WSP(bf16, WS_P)});
#endif
                }
#else
                for (int u = C.bid; u < npan * 22; u += C.G) {
                    const int lp = u / 22, pn = u % 22, gp = p_lo + lp; const int e = moe ? panel_expert(tb, gp) : 0;
                    const GUnit gu{gp * 256, lp * 256, pn, (size_t)e * 5632 * 1024};
                    gemm_simple_unit<1>(C, moe ? WSP(bf16, WS_Y) : WSP(bf16, WS_H), DM, nullptr, WSP(bf16, WS_WGU), DM, gu, EpiSwigluS{WSP(bf16, WS_P)});
                }
#endif
            STEP_END
            STEP_BEGIN
                const bool moe = (l & 1) != 0;
                MoeTab tb; tb.npanels = 256;
#pragma unroll
                for (int e = 0; e < 8; ++e) tb.pend[e] = 65536;
                if (moe) tb = moe_tab(C, l >> 1);
                const int p_lo = pass * PASS_PANELS, p_hi = moe ? ((pass == NPASS_MOE - 1 || tb.npanels < p_lo + PASS_PANELS) ? tb.npanels : p_lo + PASS_PANELS) : p_lo + PASS_PANELS;
                const int npan = p_hi > p_lo ? p_hi - p_lo : 0;
#if USE_PG8
                LAS unsigned char* pe = C.lds + PE_OFF;
                for (int p = C.tid; p < 528; p += 512) pe[p] = (unsigned char)(moe ? panel_expert(tb, p) : 0);
                __syncthreads();
                { const pg8::Gemm g{WSP(bf16, WS_P), WSP(bf16, WS_WDN), DFF, (size_t)1024 * DFF * 2}; pg8::Order S; S.init(npan, 4, C.G, C.bid, p_lo, 1, pe);
                  pg8::gemm_phase(C.lds, C.tid, g, S, pg8::EpiGate{WSP(bf16, WS_Y), moe ? WSP(float, WS_ROWGATE) : nullptr});
#if PROBE_ID == 7
                  RELAUNDER pg8::gemm_phase(C.lds, C.tid, g, S, pg8::EpiGate{WSP(bf16, WS_Y), moe ? WSP(float, WS_ROWGATE) : nullptr});
#endif
                }
#else
                for (int u = C.bid; u < npan * 4; u += C.G) {
                    const int lp = u >> 2, pn = u & 3, gp = p_lo + lp; const int e = moe ? panel_expert(tb, gp) : 0;
                    const GUnit gu{lp * 256, gp * 256, pn, (size_t)e * 1024 * DFF};
                    if (moe) gemm_simple_unit<0>(C, WSP(bf16, WS_P), DFF, nullptr, WSP(bf16, WS_WDN), DFF, gu, EpiGateS{WSP(bf16, WS_Y), WSP(float, WS_ROWGATE)});
                    else gemm_simple_unit<0>(C, WSP(bf16, WS_P), DFF, nullptr, WSP(bf16, WS_WDN), DFF, gu, EpiStoreS{WSP(bf16, WS_Y), DM});
                }
#endif
            STEP_END
        }
        STEP_BEGIN
            const int l2 = l < 3 ? l + 1 : 3;
            if (l & 1) ph_ln<false, 1, 1>(C, nullptr, l, 1, 5120, l2, 0, l < 3, 0, 3072, l == 3); else ph_ln<false, 0, 1>(C, nullptr, l, 1, 5120, l2, 0, l < 3, 0, 3072, l == 3);
            if (l < 3) ph_conv(C, l + 1);
#if REP_C > 1
            if (l < 3) { RELAUNDER ph_conv(C, l + 1); }
#endif
        STEP_END
    }
#undef STEP_BEGIN
#undef STEP_END
#undef WSP
#undef RELAUNDER
}

#ifndef DUMP_HI
#define DUMP_HI 0
#define DUMP_OFF 0
#define DUMP_WORDS 1
#endif
#if DUMP_HI
__global__ void __launch_bounds__(256) copy_half_k(const unsigned* src, unsigned* dst) {
    for (size_t i = (size_t)blockIdx.x * 256 + threadIdx.x; i < (size_t)65536 * 256; i += (size_t)gridDim.x * 256) dst[i] = src[(i >> 8) * 512 + (i & 255)];
}
__global__ void __launch_bounds__(256) dump_k(const unsigned* src, size_t nwords, float* out) {
    const size_t N = (size_t)MTOK * DM;
    for (size_t i = (size_t)blockIdx.x * 256 + threadIdx.x; i < N; i += (size_t)gridDim.x * 256) {
        float v = 0.f;
        for (size_t k = i % nwords; k < nwords; k += N) { const unsigned w = src[k]; v += (float)((w ^ (w >> 13)) & 0xFFFu); }
        out[i] = v;
    }
}
#endif
extern "C" void kernel_launch(void* const* d_in, const int* in_sizes, int n_in, void* d_out, int out_size, void* d_ws, size_t ws_size, hipStream_t stream) {
    static int grid = 0;
    if (grid == 0) {
        if (n_in != 19 || in_sizes[0] != MTOK * DM || out_size != MTOK * DM || ws_size < WS_END) {
            fprintf(stderr, "kernel_launch: unexpected shapes (n_in %d, in0 %d, out %d, ws %zu); nothing launched\n", n_in, n_in > 0 ? in_sizes[0] : -1, out_size, ws_size); grid = -1; return; }
        int dev = 0, cus = 0, per_cu = 0;
        if (hipGetDevice(&dev) != hipSuccess || hipDeviceGetAttribute(&cus, hipDeviceAttributeMultiprocessorCount, dev) != hipSuccess) { grid = -1; return; }
        if (hipFuncSetAttribute((const void*)hybrid_fwd, hipFuncAttributeMaxDynamicSharedMemorySize, LDS_BYTES) != hipSuccess) { fprintf(stderr, "kernel_launch: hipFuncSetAttribute failed\n"); grid = -1; return; }
        if (hipOccupancyMaxActiveBlocksPerMultiprocessor(&per_cu, (const void*)hybrid_fwd, 512, LDS_BYTES) != hipSuccess || per_cu < 1)
            fprintf(stderr, "kernel_launch: note: occupancy query reports %d workgroups per CU\n", per_cu);
        (void)hipGetLastError();
        grid = cus;
    }
    if (grid < 0) return;
    if (hipMemsetAsync((char*)d_ws + WS_CTL, 0, CTL_ZERO_BYTES, stream) != hipSuccess) { fprintf(stderr, "kernel_launch: memset failed\n"); return; }
    Args a{};
    for (int i = 0; i < 19; ++i) a.in[i] = (const float*)d_in[i];
    a.out = (float*)d_out; a.ws = (unsigned char*)d_ws;
#if MK_MULTI
    for (int s = 0; s < N_STEPS; ++s) { a.lo = s; a.hi = s + 1; hipLaunchKernelGGL(hybrid_fwd, dim3(grid), dim3(512), LDS_BYTES, stream, a); }
#else
#ifdef DUMP_SPLIT
    a.lo = 0; a.hi = DUMP_SPLIT;
    hipLaunchKernelGGL(hybrid_fwd, dim3(grid), dim3(512), LDS_BYTES, stream, a);
    (void)hipMemsetAsync((char*)d_ws + WS_CTL, 0, 65536, stream);
    a.lo = DUMP_SPLIT; a.hi = DUMP_HI;
    hipLaunchKernelGGL(hybrid_fwd, dim3(grid), dim3(512), LDS_BYTES, stream, a);
#else
    a.lo = 0; a.hi = DUMP_HI ? DUMP_HI : N_STEPS;
    hipLaunchKernelGGL(hybrid_fwd, dim3(grid), dim3(512), LDS_BYTES, stream, a);
#endif
#ifdef DUMP_OUTCOPY
    hipLaunchKernelGGL(copy_half_k, dim3(8192), dim3(256), 0, stream, (const unsigned*)d_out + (DUMP_OUTCOPY == 2 ? 256 : 0), (unsigned*)((char*)d_ws + (size_t)DUMP_OFF));
#endif
#if DUMP_HI
    hipLaunchKernelGGL(dump_k, dim3(8192), dim3(256), 0, stream, (const unsigned*)((const char*)d_ws + (size_t)DUMP_OFF), (size_t)DUMP_WORDS, (float*)d_out);
#endif
#endif
    const hipError_t le = hipPeekAtLastError();
    if (le != hipSuccess) fprintf(stderr, "kernel_launch: launch failed: %s\n", hipGetErrorName(le));
}
```

```cpp
#include <hip/hip_runtime.h>
#include <cstdio>
#include <cstdint>

#define GAS __attribute__((address_space(1)))
#define LAS __attribute__((address_space(3)))
typedef unsigned short bf16;
typedef unsigned v4u __attribute__((ext_vector_type(4)));
typedef unsigned v2u __attribute__((ext_vector_type(2)));
typedef float f32x4 __attribute__((ext_vector_type(4)));
typedef float f32x2 __attribute__((ext_vector_type(2)));
typedef float f32x16 __attribute__((ext_vector_type(16)));
typedef short bf16x8 __attribute__((ext_vector_type(8)));

#ifndef USE_LIST
#define USE_LIST 0
#endif
#ifndef USE_BCAST
#define USE_BCAST 1
#endif
#ifndef USE_GSEQ
#define USE_GSEQ 1
#endif
#ifndef MK_MULTI
#define MK_MULTI 0
#endif

constexpr int BATCH = 16, SEQ = 4096, DM = 1024, DEPTH = 4, MTOK = BATCH * SEQ;
constexpr int PW = 2816;
constexpr int PROJ_SRC = 2776;
constexpr int C_AQ = 0, C_IQ = 512, C_BQ = 1024, C_BK = 1280, C_BV = 1536, C_BG = 2048, C_AK = 2560, C_AV = 2624, C_IK = 2688, C_IW = 2752, C_BA = 2760;
constexpr int DFF = 2816, NEXP = 8;
constexpr int PASS_PANELS = 256, NPASS_DENSE = 1, NPASS_MOE = 2;
constexpr float DN_ALPHA = 1.681792830507429f;
constexpr float LN_EPS = 1e-5f;
constexpr float LOG2E = 1.4426950408889634f;

constexpr size_t MiB = 1u << 20;
constexpr size_t WS_CTL = 0, CTL_ZERO_BYTES = 1 * MiB;
constexpr size_t WS_MOD = 1 * MiB;
constexpr size_t WS_TOPE = 3 * MiB;
constexpr size_t WS_TOPG = WS_TOPE + MiB / 2;
constexpr size_t WS_TOKSLOT = WS_TOPG + MiB / 2;
constexpr size_t WS_ROWTOK = 5 * MiB;
constexpr size_t WS_ROWGATE = 6 * MiB;
constexpr size_t WS_WIN = 8 * MiB;
constexpr size_t WS_WOUT = 14 * MiB;
constexpr size_t WS_WGU = 16 * MiB;
constexpr size_t WS_WDN = 104 * MiB;
constexpr size_t WS_H = 148 * MiB;
constexpr size_t WS_P = 276 * MiB;
constexpr size_t WS_Y = 640 * MiB;
constexpr size_t WS_SEL = 900 * MiB;
constexpr size_t WS_END = 1024 * MiB;

constexpr int CW_BAR = 4096;
constexpr int CW_QUEUE = 8192;
constexpr int CW_CNT = 10240;
constexpr int CW_FILL = 10752;

constexpr int LDS_BYTES = 147456;
constexpr int PE_OFF = 131072;
constexpr int MISC_OFF = 139264;

__device__ __forceinline__ float bf2f(unsigned v) { return __uint_as_float(v << 16); }
typedef __bf16 bf16x2_t __attribute__((ext_vector_type(2)));
__device__ __forceinline__ unsigned pk2(float lo, float hi) { const f32x2 v = {lo, hi}; return __builtin_bit_cast(unsigned, __builtin_convertvector(v, bf16x2_t)); }
__device__ __forceinline__ unsigned f2bf(float f) { return pk2(f, 0.f) & 0xffffu; }
__device__ __forceinline__ float wave_sum(float v) {
#pragma unroll
    for (int o = 1; o < 64; o <<= 1) v += __shfl_xor(v, o);
    return v;
}
__device__ __forceinline__ float wave_max(float v) {
#pragma unroll
    for (int o = 1; o < 64; o <<= 1) v = fmaxf(v, __shfl_xor(v, o));
    return v;
}
#define DPP_U32(x, ctrl) ((unsigned)__builtin_amdgcn_update_dpp(0, (int)(x), (ctrl), 0xF, 0xF, true))
__device__ __forceinline__ unsigned wave_sum_u32(unsigned x) {
    x += DPP_U32(x, 0xB1); x += DPP_U32(x, 0x4E); x += DPP_U32(x, 0x124); x += DPP_U32(x, 0x128);
#if USE_BCAST
    x += (unsigned)__builtin_amdgcn_update_dpp(0, (int)x, 0x142, 0xA, 0xF, false);
    x += (unsigned)__builtin_amdgcn_update_dpp(0, (int)x, 0x143, 0xC, 0xF, false);
    return (unsigned)__builtin_amdgcn_readlane((int)x, 63);
#else
    return (unsigned)__builtin_amdgcn_readlane((int)x, 0) + (unsigned)__builtin_amdgcn_readlane((int)x, 16) + (unsigned)__builtin_amdgcn_readlane((int)x, 32) + (unsigned)__builtin_amdgcn_readlane((int)x, 48);
#endif
}
__device__ __forceinline__ float dpp_f32_(float x, int) { return x; }
#define DPP_F32(x, ctrl) (__builtin_bit_cast(float, __builtin_amdgcn_update_dpp(0, __builtin_bit_cast(int, (x)), (ctrl), 0xF, 0xF, true)))
__device__ __forceinline__ float wave_sum_f(float x) {
    x += DPP_F32(x, 0xB1); x += DPP_F32(x, 0x4E); x += DPP_F32(x, 0x124); x += DPP_F32(x, 0x128);
    const float r0 = __builtin_bit_cast(float, __builtin_amdgcn_readlane(__builtin_bit_cast(int, x), 0)), r1 = __builtin_bit_cast(float, __builtin_amdgcn_readlane(__builtin_bit_cast(int, x), 16));
    const float r2 = __builtin_bit_cast(float, __builtin_amdgcn_readlane(__builtin_bit_cast(int, x), 32)), r3 = __builtin_bit_cast(float, __builtin_amdgcn_readlane(__builtin_bit_cast(int, x), 48));
    return (r0 + r1) + (r2 + r3);
}
__device__ __forceinline__ unsigned umax_(unsigned a, unsigned b) { return a > b ? a : b; }
__device__ __forceinline__ unsigned umin_(unsigned a, unsigned b) { return a < b ? a : b; }
__device__ __forceinline__ unsigned wave_max_u32(unsigned x) {
    x = umax_(x, DPP_U32(x, 0xB1)); x = umax_(x, DPP_U32(x, 0x4E)); x = umax_(x, DPP_U32(x, 0x124)); x = umax_(x, DPP_U32(x, 0x128));
    return umax_(umax_((unsigned)__builtin_amdgcn_readlane((int)x, 0), (unsigned)__builtin_amdgcn_readlane((int)x, 16)), umax_((unsigned)__builtin_amdgcn_readlane((int)x, 32), (unsigned)__builtin_amdgcn_readlane((int)x, 48)));
}
__device__ __forceinline__ unsigned wave_min_u32(unsigned x) {
    x = umin_(x, DPP_U32(x, 0xB1)); x = umin_(x, DPP_U32(x, 0x4E)); x = umin_(x, DPP_U32(x, 0x124)); x = umin_(x, DPP_U32(x, 0x128));
    return umin_(umin_((unsigned)__builtin_amdgcn_readlane((int)x, 0), (unsigned)__builtin_amdgcn_readlane((int)x, 16)), umin_((unsigned)__builtin_amdgcn_readlane((int)x, 32), (unsigned)__builtin_amdgcn_readlane((int)x, 48)));
}
#define SHX_F(v, o, lane_) (__builtin_bit_cast(float, __builtin_amdgcn_ds_bpermute((((lane_) ^ (o)) << 2), __builtin_bit_cast(int, (float)(v)))))
#define SHUP_I(v, o, lane_) (__builtin_amdgcn_ds_bpermute((((lane_) - (o)) << 2), (int)(v)))
__device__ __forceinline__ int wave_incl_scan_i(int x, int lane) {
    x += __builtin_amdgcn_update_dpp(0, x, 0x111, 0xF, 0xF, true); x += __builtin_amdgcn_update_dpp(0, x, 0x112, 0xF, 0xF, true);
    x += __builtin_amdgcn_update_dpp(0, x, 0x114, 0xF, 0xF, true); x += __builtin_amdgcn_update_dpp(0, x, 0x118, 0xF, 0xF, true);
    const int t0 = __builtin_amdgcn_readlane(x, 15), t1 = __builtin_amdgcn_readlane(x, 31), t2 = __builtin_amdgcn_readlane(x, 47);
    return x + (lane >= 16 ? t0 : 0) + (lane >= 32 ? t1 : 0) + (lane >= 48 ? t2 : 0);
}
__device__ __forceinline__ float silu_f(float v) { return v / (1.f + expf(-v)); }

#define XB_TMO      128
#define XB_XCNT(j)  (256  + 64 * (j))
#define XB_XSUB(j)  (1280 + 64 * (j))
#define XB_XGEN(j)  (2304 + 64 * (j))
#define XB_TOP      3328
#define XB_TOPGEN   3392
#define XCD_BAR_WORDS 3456
#define XB_SPIN_CAP (1u << 21)

__device__ __forceinline__ unsigned xb_ld(unsigned* p)              { return __hip_atomic_load(p, __ATOMIC_RELAXED, __HIP_MEMORY_SCOPE_AGENT); }
__device__ __forceinline__ unsigned xb_add(unsigned* p, unsigned v) { return __hip_atomic_fetch_add(p, v, __ATOMIC_RELAXED, __HIP_MEMORY_SCOPE_AGENT); }
__device__ __forceinline__ unsigned xb_xcc_id() { return (unsigned)__builtin_amdgcn_s_getreg((3 << 11) | 20) & 0xFu; }
#define XB_SPIN(cond, bar) do { unsigned _sp = 0; while (cond) { __builtin_amdgcn_s_sleep(1); \
    if ((++_sp & 255u) == 0u) { if (xb_ld(&(bar)[XB_TMO])) break; if (_sp > XB_SPIN_CAP) { atomicAdd(&(bar)[XB_TMO], 1u); break; } } } } while (0)

struct XcdBarrier {
    unsigned* bar; unsigned x;
    volatile LAS unsigned* st;
};

__device__ __forceinline__ XcdBarrier xcd_barrier_post(unsigned* bar, volatile LAS unsigned* st) {
    XcdBarrier b; b.bar = bar; b.x = xb_xcc_id(); b.st = st;
    if (threadIdx.x == 0) (void)xb_add(&bar[XB_XCNT(b.x)], 1u);
    return b;
}
__device__ __forceinline__ void xcd_barrier_complete(unsigned* bar, unsigned x, unsigned& nloc, unsigned& nx) {
    const unsigned G = gridDim.x * gridDim.y * gridDim.z;
    unsigned sum, cnt, mine, sp = 0u;
    for (;;) {
        sum = 0u; cnt = 0u; mine = 0u;
#pragma unroll
        for (unsigned j = 0; j < 16; ++j) { const unsigned c = xb_ld(&bar[XB_XCNT(j)]); sum += c; cnt += (c > 0u) ? 1u : 0u; mine = (j == x) ? c : mine; }
        if (sum == G) break;
        __builtin_amdgcn_s_sleep(1);
        if ((++sp & 255u) == 0u) { if (xb_ld(&bar[XB_TMO])) break; if (sp > XB_SPIN_CAP) { atomicAdd(&bar[XB_TMO], 1u); break; } }
    }
    nloc = mine > 0u ? mine : 1u; nx = cnt > 0u ? cnt : 1u;
}

__device__ __forceinline__ void xcd_barrier(const XcdBarrier& b) {
    asm volatile("s_waitcnt vmcnt(0)" ::: "memory");
    __syncthreads();
    if (threadIdx.x == 0) {
        unsigned* bar = b.bar;
        __builtin_amdgcn_s_waitcnt(0);
        unsigned nloc = b.st[0], nx = b.st[1];
        if (nloc == 0u) { xcd_barrier_complete(bar, b.x, nloc, nx); b.st[0] = nloc; b.st[1] = nx; }
        const unsigned old = xb_add(&bar[XB_XSUB(b.x)], 1u);
        const unsigned gen = old / nloc;
        if (old + 1u == (gen + 1u) * nloc) {
            __builtin_amdgcn_fence(__ATOMIC_RELEASE, "agent");
            asm volatile("s_waitcnt vmcnt(0)" ::: "memory");
            const unsigned og = xb_add(&bar[XB_TOP], 1u);
            const unsigned tg = og / nx;
            if (og + 1u == (tg + 1u) * nx) xb_add(&bar[XB_TOPGEN], 1u);
            else XB_SPIN(xb_ld(&bar[XB_TOPGEN]) == tg, bar);
            __builtin_amdgcn_fence(__ATOMIC_ACQUIRE, "agent");
            xb_add(&bar[XB_XGEN(b.x)], 1u);
            asm volatile("s_waitcnt vmcnt(0)" ::: "memory");
        } else {
            XB_SPIN(xb_ld(&bar[XB_XGEN(b.x)]) == gen, bar);
            __builtin_amdgcn_fence(__ATOMIC_ACQUIRE, "agent");
            asm volatile("s_waitcnt vmcnt(0)" ::: "memory");
        }
    }
    __syncthreads();
}


struct Args { const float* in[19]; float* out; unsigned char* ws; int lo, hi; };
typedef const Args __attribute__((address_space(4))) KArgs;
struct Ctx {
    LAS unsigned char* lds;
    volatile LAS unsigned* MISC;
    unsigned* ctl;
    int tid, lane, wave, G, bid;
    int hot;
    KArgs* ka;
    float* out; unsigned char* ws;
    __device__ __forceinline__ const float* in(int i) const { return ka->in[i]; }
};
enum { I_X = 0, I_C, I_WIN, I_WA2, I_BA, I_GLAG, I_WOUT, I_WMOD, I_BMOD, I_LNG, I_LNB, I_FG, I_FU, I_FD, I_WR, I_BR, I_MG, I_MU, I_MD };

__device__ __forceinline__ f32x16 mfma32(bf16x8 a, bf16x8 b, f32x16 c) { return __builtin_amdgcn_mfma_f32_32x32x16_bf16(a, b, c, 0, 0, 0); }

__device__ __forceinline__ void ph_mod(Ctx& C) {
    LAS float* sc = (LAS float*)C.lds;
    LAS float* red = (LAS float*)(C.lds + 65536);
    const float* c = C.in(I_C);
    for (int i = C.tid; i < 16 * 1024; i += 512) sc[i] = silu_f(c[i]);
    __syncthreads();
    const float* wmod = C.in(I_WMOD); const float* bmod = C.in(I_BMOD);
    float* MOD = (float*)(C.ws + WS_MOD);
    for (int u = C.bid; u < 4 * 96; u += C.G) {
        const int l = u / 96, cc = u % 96, col = cc * 64 + C.lane;
        float acc[16];
#pragma unroll
        for (int b = 0; b < 16; ++b) acc[b] = 0.f;
        const float* wp = wmod + ((size_t)l * 1024 + C.wave * 128) * 6144 + col;
        const LAS float* sp = sc + C.wave * 128;
#pragma unroll 32
        for (int kk = 0; kk < 128; ++kk) {
            const float w = wp[(size_t)kk * 6144];
#pragma unroll
            for (int b = 0; b < 16; ++b) acc[b] += sp[b * 1024 + kk] * w;
        }
#pragma unroll
        for (int b = 0; b < 16; ++b) red[(C.wave * 16 + b) * 64 + C.lane] = acc[b];
        __syncthreads();
        for (int o = C.tid; o < 1024; o += 512) {
            const int b = o >> 6, ln = o & 63; float s = 0.f;
#pragma unroll
            for (int w = 0; w < 8; ++w) s += red[(w * 16 + b) * 64 + ln];
            const int cl = cc * 64 + ln;
            MOD[((size_t)l * 16 + b) * 6144 + cl] = s + bmod[l * 6144 + cl];
        }
        __syncthreads();
    }
}

__device__ __forceinline__ void conv_item(const float* colp, int ldn, int K, bf16* WT, LAS float* scr, int kb, int nb, int lane) {
    const int k0 = 64 * kb, n0 = 32 * nb;
    float tv[32];
#pragma unroll
    for (int i = 0; i < 32; ++i) { const int kk = 2 * i + (lane >> 5); tv[i] = colp ? colp[(size_t)(k0 + kk) * ldn] : 0.f; }
#pragma unroll
    for (int i = 0; i < 32; ++i) { const int kk = 2 * i + (lane >> 5); scr[kk * 33 + (lane & 31)] = tv[i]; }
    asm volatile("s_waitcnt lgkmcnt(0)" ::: "memory");
    const int c = lane & 7;
#pragma unroll
    for (int j = 0; j < 4; ++j) {
        const int n = (lane >> 3) + 8 * j; const LAS float* s = scr + (8 * c) * 33 + n;
        v4u o; o.x = pk2(s[0 * 33], s[1 * 33]); o.y = pk2(s[2 * 33], s[3 * 33]); o.z = pk2(s[4 * 33], s[5 * 33]); o.w = pk2(s[6 * 33], s[7 * 33]);
        *(v4u*)(WT + (size_t)(n0 + n) * K + k0 + 8 * c) = o;
    }
    asm volatile("s_waitcnt lgkmcnt(0)" ::: "memory");
}
__device__ __forceinline__ int win_src_col(int n) {
    if (n < C_IQ) return n;
    if (n < C_BQ) return 640 + (n - C_IQ);
    if (n < C_AK) return 1224 + (n - C_BQ);
    if (n < C_AV) return 512 + (n - C_AK);
    if (n < C_IK) return 576 + (n - C_AV);
    if (n < C_IW) return 1152 + (n - C_IK);
    if (n < C_BA) return 1216 + (n - C_IW);
    if (n < PROJ_SRC) return 2760 + (n - C_BA);
    return -1;
}
__device__ __forceinline__ void ph_conv(Ctx& C, int l) {
    LAS float* scr = (LAS float*)(C.lds + C.wave * 8448);
    const int gw = C.bid * 8 + C.wave, NGW = C.G * 8;
    const bool moe = (l & 1) != 0; const int j = l >> 1, ne = moe ? NEXP : 1;
    constexpr int I_IN = 16 * 88, I_OUT = 16 * 32, I_GU = 16 * 176, I_DN = 44 * 32;
    const int nitems = I_IN + I_OUT + ne * (I_GU + I_DN);
    bf16* WIN = (bf16*)(C.ws + WS_WIN); bf16* WOUT = (bf16*)(C.ws + WS_WOUT); bf16* WGU = (bf16*)(C.ws + WS_WGU); bf16* WDN = (bf16*)(C.ws + WS_WDN);
    for (int it = gw; it < nitems; it += NGW) {
        int r = it;
        if (r < I_IN) { const int kb = r / 88, nb = r % 88; const int sc_ = win_src_col(nb * 32 + (C.lane & 31));
            const float* W = C.in(I_WIN) + (size_t)l * 1024 * PROJ_SRC;
            conv_item(sc_ >= 0 ? W + sc_ : nullptr, PROJ_SRC, 1024, WIN, scr, kb, nb, C.lane); continue; }
        r -= I_IN;
        if (r < I_OUT) { const int kb = r / 32, nb = r % 32; const float* W = C.in(I_WOUT) + (size_t)l * 1024 * 1024;
            conv_item(W + nb * 32 + (C.lane & 31), 1024, 1024, WOUT, scr, kb, nb, C.lane); continue; }
        r -= I_OUT;
        const int e = r / (I_GU + I_DN); r -= e * (I_GU + I_DN);
        const size_t eoff = (size_t)(j * ne + e) * 1024 * DFF;
        if (r < I_GU) { const int kb = r / 176, nb = r % 176; const int n = nb * 32 + (C.lane & 31), T = n >> 8, jj = n & 255;
            const float* Wg = (moe ? C.in(I_MG) : C.in(I_FG)) + eoff; const float* Wu = (moe ? C.in(I_MU) : C.in(I_FU)) + eoff;
            const float* colp = (jj < 128) ? Wg + T * 128 + jj : Wu + T * 128 + (jj - 128);
            conv_item(colp, DFF, 1024, WGU + (size_t)e * 5632 * 1024, scr, kb, nb, C.lane); continue; }
        r -= I_GU;
        { const int kb = r / 32, nb = r % 32; const float* Wd = (moe ? C.in(I_MD) : C.in(I_FD)) + eoff;
          conv_item(Wd + nb * 32 + (C.lane & 31), 1024, DFF, WDN + (size_t)e * 1024 * DFF, scr, kb, nb, C.lane); }
    }
}

__device__ __forceinline__ void ph_modulate0(Ctx& C) {
    const int gw = C.bid * 8 + C.wave, NGW = C.G * 8;
    const float* MOD = (const float*)(C.ws + WS_MOD); bf16* H = (bf16*)(C.ws + WS_H); const float* x = C.in(I_X);
    for (int row = gw; row < MTOK; row += NGW) {
        const int b = row >> 12; const float* md = MOD + (size_t)b * 6144;
#pragma unroll
        for (int j = 0; j < 4; ++j) {
            const int col = 4 * C.lane + 256 * j;
            const f32x4 v = *(const f32x4*)(x + (size_t)row * DM + col), sh = *(const f32x4*)(md + col), sc = *(const f32x4*)(md + 1024 + col);
            v2u o; o.x = pk2(v.x * (1.f + sc.x) + sh.x, v.y * (1.f + sc.y) + sh.y); o.y = pk2(v.z * (1.f + sc.z) + sh.z, v.w * (1.f + sc.w) + sh.w);
            *(v2u*)(H + (size_t)row * DM + col) = o;
        }
    }
}

struct GUnit { int arow0; int orow0; int pn; size_t boff; };
template <int MODE, class Epi>
__device__ __forceinline__ void gemm_simple_unit(Ctx& C, const bf16* A, int lda, const int* rowmap, const bf16* Bt, int K, const GUnit& u, const Epi& E) {
    const int rs = C.wave & 3, ch = C.wave >> 2, n = C.lane & 31, h = C.lane >> 5;
    const int r0 = u.arow0 + rs * 64 + n;
    const int ra = rowmap ? rowmap[r0] : r0, rb = rowmap ? rowmap[r0 + 32] : r0 + 32;
    const bf16* a0p = A + (size_t)ra * lda + 8 * h; const bf16* a1p = A + (size_t)rb * lda + 8 * h;
#pragma unroll 1
    for (int sp = 0; sp < 2; ++sp) {
        int br0, br1;
        if (MODE == 1) { const int jj = 2 * ch + sp; br0 = u.pn * 256 + 32 * jj; br1 = br0 + 128; }
        else { br0 = u.pn * 256 + 128 * ch + 64 * sp; br1 = br0 + 32; }
        const bf16* b0p = Bt + u.boff + (size_t)(br0 + n) * K + 8 * h; const bf16* b1p = Bt + u.boff + (size_t)(br1 + n) * K + 8 * h;
        f32x16 c00, c01, c10, c11;
#pragma unroll
        for (int i = 0; i < 16; ++i) { c00[i] = 0.f; c01[i] = 0.f; c10[i] = 0.f; c11[i] = 0.f; }
#pragma unroll 4
        for (int k = 0; k < K; k += 16) {
            const bf16x8 a0 = *(const bf16x8*)(a0p + k), a1 = *(const bf16x8*)(a1p + k), b0 = *(const bf16x8*)(b0p + k), b1 = *(const bf16x8*)(b1p + k);
            c00 = mfma32(a0, b0, c00); c01 = mfma32(a0, b1, c01); c10 = mfma32(a1, b0, c10); c11 = mfma32(a1, b1, c11);
        }
        const int orow = u.orow0 + rs * 64 + 4 * h;
        E(c00, c01, orow, br0, br1, n, u);
        E(c10, c11, orow + 32, br0, br1, n, u);
    }
}
struct EpiStoreS {
    bf16* O; int ldc;
    __device__ __forceinline__ void operator()(const f32x16& c0, const f32x16& c1, int orow, int br0, int br1, int n, const GUnit&) const {
#pragma unroll
        for (int r = 0; r < 16; ++r) { const size_t row = (size_t)(orow + (r & 3) + 8 * (r >> 2));
            O[row * ldc + br0 + n] = (bf16)f2bf(c0[r]); O[row * ldc + br1 + n] = (bf16)f2bf(c1[r]); }
    }
};
struct EpiSwigluS {
    bf16* O;
    __device__ __forceinline__ void operator()(const f32x16& c0, const f32x16& c1, int orow, int br0, int br1, int n, const GUnit& u) const {
        const int col = 128 * u.pn + (br0 - 256 * u.pn) + n;
#pragma unroll
        for (int r = 0; r < 16; ++r) { const size_t row = (size_t)(orow + (r & 3) + 8 * (r >> 2));
            O[row * DFF + col] = (bf16)f2bf(silu_f(c0[r]) * c1[r]); }
    }
};
struct EpiGateS {
    bf16* O; const float* gate;
    __device__ __forceinline__ void operator()(const f32x16& c0, const f32x16& c1, int orow, int br0, int br1, int n, const GUnit&) const {
#pragma unroll
        for (int r = 0; r < 16; ++r) { const size_t row = (size_t)(orow + (r & 3) + 8 * (r >> 2)); const float g = gate[row];
            O[row * DM + br0 + n] = (bf16)f2bf(c0[r] * g); O[row * DM + br1 + n] = (bf16)f2bf(c1[r] * g); }
    }
};

__device__ __forceinline__ void ph_gla_unit(Ctx& C, int l, int b, int hh) {
    LAS float* q_s = (LAS float*)C.lds;
    LAS float* k_s = q_s + 4096;
    LAS float* a_s = k_s + 4096;
    LAS float* v_s = a_s + 4096;
    LAS float* o_s = v_s + 8192;
    const bf16* PROJ = (const bf16*)(C.ws + WS_P); bf16* YM = (bf16*)(C.ws + WS_H);
    const float* w_a2 = C.in(I_WA2) + (size_t)l * 16 * 256; const float* b_a = C.in(I_BA) + l * 256; const float* gg = C.in(I_GLAG) + l * 128;
    const int e = C.tid >> 2, dg = C.tid & 3;
    float S[16];
#pragma unroll
    for (int i = 0; i < 16; ++i) S[i] = 0.f;
    for (int c = 0; c < 64; ++c) {
        const size_t row0 = (size_t)b * SEQ + c * 64;
        {
            const int t = C.tid >> 3, d0 = (C.tid & 7) * 8; const bf16* pr = PROJ + (row0 + t) * PW;
            const v4u qv = *(const v4u*)(pr + C_BQ + hh * 64 + d0), kv = *(const v4u*)(pr + C_BK + hh * 64 + d0);
            const v4u ba0 = *(const v4u*)(pr + C_BA), ba1 = *(const v4u*)(pr + C_BA + 8);
            float baf[16];
            baf[0] = bf2f(ba0.x & 0xffffu); baf[1] = bf2f(ba0.x >> 16); baf[2] = bf2f(ba0.y & 0xffffu); baf[3] = bf2f(ba0.y >> 16);
            baf[4] = bf2f(ba0.z & 0xffffu); baf[5] = bf2f(ba0.z >> 16); baf[6] = bf2f(ba0.w & 0xffffu); baf[7] = bf2f(ba0.w >> 16);
            baf[8] = bf2f(ba1.x & 0xffffu); baf[9] = bf2f(ba1.x >> 16); baf[10] = bf2f(ba1.y & 0xffffu); baf[11] = bf2f(ba1.y >> 16);
            baf[12] = bf2f(ba1.z & 0xffffu); baf[13] = bf2f(ba1.z >> 16); baf[14] = bf2f(ba1.w & 0xffffu); baf[15] = bf2f(ba1.w >> 16);
            const unsigned qw[4] = {qv.x, qv.y, qv.z, qv.w}, kw[4] = {kv.x, kv.y, kv.z, kv.w};
#pragma unroll
            for (int i = 0; i < 8; ++i) {
                const int d = d0 + i; float z = b_a[hh * 64 + d];
#pragma unroll
                for (int r = 0; r < 16; ++r) z += baf[r] * w_a2[r * 256 + hh * 64 + d];
                const float ls = fminf(z, 0.f) - log1pf(expf(-fabsf(z)));
                a_s[t * 64 + d] = expf(ls * (1.f / 16.f));
                const unsigned qq = (i & 1) ? (qw[i >> 1] >> 16) : (qw[i >> 1] & 0xffffu), kk = (i & 1) ? (kw[i >> 1] >> 16) : (kw[i >> 1] & 0xffffu);
                q_s[t * 64 + d] = bf2f(qq) * 0.125f; k_s[t * 64 + d] = bf2f(kk);
            }
            const int e0 = (C.tid & 7) * 16;
            const v4u v0 = *(const v4u*)(pr + C_BV + hh * 128 + e0), v1 = *(const v4u*)(pr + C_BV + hh * 128 + e0 + 8);
            const unsigned vw[8] = {v0.x, v0.y, v0.z, v0.w, v1.x, v1.y, v1.z, v1.w};
#pragma unroll
            for (int i = 0; i < 8; ++i) { v_s[t * 128 + e0 + 2 * i] = bf2f(vw[i] & 0xffffu); v_s[t * 128 + e0 + 2 * i + 1] = bf2f(vw[i] >> 16); }
        }
        __syncthreads();
        for (int tt = 0; tt < 64; ++tt) {
            const float vv = v_s[tt * 128 + e]; float po = 0.f;
#pragma unroll
            for (int i = 0; i < 16; ++i) { const int d = 16 * dg + i; S[i] = a_s[tt * 64 + d] * S[i] + k_s[tt * 64 + d] * vv; po += q_s[tt * 64 + d] * S[i]; }
            po += __shfl_xor(po, 1); po += __shfl_xor(po, 2);
            if (dg == 0) o_s[tt * 128 + e] = po;
        }
        __syncthreads();
#pragma unroll 1
        for (int r = 0; r < 8; ++r) {
            const int tt = C.wave * 8 + r; const float o0 = o_s[tt * 128 + C.lane], o1 = o_s[tt * 128 + 64 + C.lane];
            const float ss = wave_sum(o0 * o0 + o1 * o1); const float rstd = rsqrtf(ss * (1.f / 128.f) + LN_EPS);
            const bf16* pr = PROJ + (row0 + tt) * PW + C_BG + hh * 128; const float g0 = bf2f(pr[C.lane]), g1 = bf2f(pr[64 + C.lane]);
            bf16* yo = YM + (row0 + tt) * DM + 512 + hh * 128;
            yo[C.lane] = (bf16)f2bf(o0 * rstd * gg[C.lane] * silu_f(g0)); yo[64 + C.lane] = (bf16)f2bf(o1 * rstd * gg[64 + C.lane] * silu_f(g1));
        }
        __syncthreads();
    }
}

__device__ __forceinline__ unsigned sortable_u32(float f) { const unsigned u = __float_as_uint(f + 0.0f); return (u & 0x80000000u) ? ~u : (u | 0x80000000u); }
__device__ __forceinline__ void ph_dsa_a_unit(Ctx& C, int b, int t0) {
    LAS unsigned* sc = (LAS unsigned*)C.lds;
    LAS unsigned* cnt = (LAS unsigned*)(C.lds + 131072);
    const bf16* PROJ = (const bf16*)(C.ws + WS_P); unsigned* SEL = (unsigned*)(C.ws + WS_SEL);
    const int lane = C.lane, n = lane & 31, h = lane >> 5, tid = C.tid;
    const int nk = t0 + 8, ntile = (nk + 31) >> 5, nscan = ntile * 32;
    if (tid < 48) cnt[tid] = 0u;
    {
        bf16x8 af[2][4]; float wv[2][4][4];
#pragma unroll
        for (int mt = 0; mt < 2; ++mt) {
            const bf16* p = PROJ + (size_t)(b * SEQ + t0 + 4 * mt + (n >> 3)) * PW + C_IQ + (n & 7) * 64 + 8 * h;
#pragma unroll
            for (int ks = 0; ks < 4; ++ks) af[mt][ks] = *(const bf16x8*)(p + ks * 16);
#pragma unroll
            for (int jq = 0; jq < 4; ++jq)
#pragma unroll
                for (int i = 0; i < 4; ++i) wv[mt][jq][i] = bf2f(PROJ[(size_t)(b * SEQ + t0 + 4 * mt + jq) * PW + C_IW + i + 4 * h]) * (0.35355339059327373f * 0.125f);
        }
        for (int tile = C.wave; tile < ntile; tile += 8) {
            const int s = tile * 32 + n; const bf16* kp = PROJ + (size_t)(b * SEQ + s) * PW + C_IK + 8 * h;
            bf16x8 bfr[4];
#pragma unroll
            for (int ks = 0; ks < 4; ++ks) bfr[ks] = *(const bf16x8*)(kp + ks * 16);
#pragma unroll
            for (int mt = 0; mt < 2; ++mt) {
                f32x16 acc;
#pragma unroll
                for (int i = 0; i < 16; ++i) acc[i] = 0.f;
#pragma unroll
                for (int ks = 0; ks < 4; ++ks) acc = mfma32(af[mt][ks], bfr[ks], acc);
#pragma unroll
                for (int jq = 0; jq < 4; ++jq) {
                    float p = 0.f;
#pragma unroll
                    for (int i = 0; i < 4; ++i) p += wv[mt][jq][i] * fmaxf(acc[4 * jq + i], 0.f);
                    p += __shfl_xor(p, 32);
                    const int t = t0 + 4 * mt + jq; const unsigned u = (s <= t) ? sortable_u32(p) : 0u;
                    if (h == mt) sc[(4 * mt + jq) * 4096 + s] = u;
                }
            }
        }
    }
    __syncthreads();
    unsigned u[8][8];
#pragma unroll
    for (int i = 0; i < 8; ++i) {
        const int s = tid + 512 * i; const bool inr = s < nscan; const int sidx = inr ? s : 0;
#pragma unroll
        for (int q = 0; q < 8; ++q) { const unsigned v = sc[q * 4096 + sidx]; u[i][q] = inr ? v : 0u; }
    }
    unsigned T[8], J[8], need[8];
#pragma unroll
    for (int q = 0; q < 8; ++q) { T[q] = 0u; J[q] = 8192u; need[q] = 0u; }
    int buf = 0;
    for (int bit = 31; bit >= 0; --bit) {
        unsigned cq[8];
#pragma unroll
        for (int q = 0; q < 8; ++q) cq[q] = 0u;
#pragma unroll
        for (int i = 0; i < 8; ++i) if (512 * i < nscan) {
#pragma unroll
            for (int q = 0; q < 8; ++q) cq[q] += (unsigned)__popcll(__ballot(u[i][q] >= (T[q] | (1u << bit))));
        }
        unsigned myc = 0u;
#pragma unroll
        for (int q = 0; q < 8; ++q) myc = (lane == q) ? cq[q] : myc;
        if (lane < 8) __hip_atomic_fetch_add(cnt + buf * 16 + lane, myc, __ATOMIC_RELAXED, __HIP_MEMORY_SCOPE_WORKGROUP);
        const int nb = (buf == 2) ? 0 : buf + 1;
        if (tid >= 64 && tid < 80) cnt[nb * 16 + (tid - 64)] = 0u;
        __syncthreads();
#pragma unroll
        for (int q = 0; q < 8; ++q) if (cnt[buf * 16 + q] >= 256u) T[q] |= (1u << bit);
        buf = nb;
    }
#pragma unroll
    for (int q = 0; q < 8; ++q) T[q] = T[q] < 1u ? 1u : T[q];
    bool extra = false;
    {
        unsigned cg[8], ce[8];
#pragma unroll
        for (int q = 0; q < 8; ++q) { cg[q] = 0u; ce[q] = 0u; }
#pragma unroll
        for (int i = 0; i < 8; ++i) if (512 * i < nscan) {
#pragma unroll
            for (int q = 0; q < 8; ++q) { cg[q] += (unsigned)__popcll(__ballot(u[i][q] > T[q])); ce[q] += (unsigned)__popcll(__ballot(u[i][q] >= T[q])); }
        }
        unsigned myc = 0u;
#pragma unroll
        for (int q = 0; q < 8; ++q) { myc = (lane == q) ? cg[q] : myc; myc = (lane == 8 + q) ? ce[q] : myc; }
        if (lane < 16) __hip_atomic_fetch_add(cnt + buf * 16 + lane, myc, __ATOMIC_RELAXED, __HIP_MEMORY_SCOPE_WORKGROUP);
        const int nb = (buf == 2) ? 0 : buf + 1;
        if (tid >= 64 && tid < 80) cnt[nb * 16 + (tid - 64)] = 0u;
        __syncthreads();
#pragma unroll
        for (int q = 0; q < 8; ++q) { const unsigned g = cnt[buf * 16 + q], ge = cnt[buf * 16 + 8 + q]; need[q] = 256u - (g < 256u ? g : 256u); extra = extra || (ge > 256u); }
        buf = nb;
    }
    if (extra) {
#pragma unroll
        for (int q = 0; q < 8; ++q) J[q] = 0u;
        for (int bit = 12; bit >= 0; --bit) {
            unsigned cq[8];
#pragma unroll
            for (int q = 0; q < 8; ++q) cq[q] = 0u;
#pragma unroll
            for (int i = 0; i < 8; ++i) if (512 * i < nscan) {
                const unsigned s = (unsigned)(tid + 512 * i);
#pragma unroll
                for (int q = 0; q < 8; ++q) cq[q] += (unsigned)__popcll(__ballot(u[i][q] == T[q] && s < (J[q] | (1u << bit))));
            }
            unsigned myc = 0u;
#pragma unroll
            for (int q = 0; q < 8; ++q) myc = (lane == q) ? cq[q] : myc;
            if (lane < 8) __hip_atomic_fetch_add(cnt + buf * 16 + lane, myc, __ATOMIC_RELAXED, __HIP_MEMORY_SCOPE_WORKGROUP);
            const int nb = (buf == 2) ? 0 : buf + 1;
            if (tid >= 64 && tid < 80) cnt[nb * 16 + (tid - 64)] = 0u;
            __syncthreads();
#pragma unroll
            for (int q = 0; q < 8; ++q) if (cnt[buf * 16 + q] <= need[q]) J[q] |= (1u << bit);
            buf = nb;
        }
    }
#pragma unroll
    for (int i = 0; i < 8; ++i) if (512 * i < nscan) {
        const unsigned s = (unsigned)(tid + 512 * i); const int tile0 = 2 * C.wave + 16 * i;
#pragma unroll
        for (int q = 0; q < 8; ++q) {
            const unsigned long long bm = __ballot((u[i][q] > T[q]) || (u[i][q] == T[q] && s < J[q]));
            if (lane == 0) { unsigned* w = SEL + (size_t)(b * SEQ + t0 + q) * 128 + tile0;
                if (tile0 < ntile) w[0] = (unsigned)bm; if (tile0 + 1 < ntile) w[1] = (unsigned)(bm >> 32); }
        }
    }
    __syncthreads();
}

__device__ __forceinline__ void ph_dsa_b_unit(Ctx& C, int b, int t0) {
    LAS float* qs = (LAS float*)C.lds + C.wave * 512;
    LAS int* lst = (LAS int*)(C.lds + 16384) + C.wave * 256;
    LAS float* pl = (LAS float*)(C.lds + 16384 + 8192) + C.wave * 2048;
    const bf16* PROJ = (const bf16*)(C.ws + WS_P); const unsigned* SEL = (const unsigned*)(C.ws + WS_SEL); bf16* YM = (bf16*)(C.ws + WS_H);
    const int lane = C.lane, t = t0 + C.wave; const size_t row = (size_t)b * SEQ + t;
    const int ntile = (t >> 5) + 1;
    int base = 0;
#pragma unroll 1
    for (int rd = 0; rd < 2; ++rd) {
        const int wi = rd * 64 + lane; unsigned w = (wi < ntile) ? SEL[row * 128 + wi] : 0u;
        const int c = __popc(w); int incl = c;
#pragma unroll
        for (int o = 1; o < 64; o <<= 1) { const int v = __shfl_up(incl, o); if (lane >= o) incl += v; }
        int pos = base + incl - c;
        while (w) { const int bit = __ffs(w) - 1; w &= w - 1; if (pos < 256) lst[pos] = wi * 32 + bit; ++pos; }
        base += __shfl(incl, 63);
    }
    const int nsel = base < 256 ? base : 256;
    {
        const v4u qv = *(const v4u*)(PROJ + row * PW + C_AQ + lane * 8); const unsigned qw[4] = {qv.x, qv.y, qv.z, qv.w};
#pragma unroll
        for (int i = 0; i < 4; ++i) { qs[lane * 8 + 2 * i] = bf2f(qw[i] & 0xffffu) * (0.125f * LOG2E); qs[lane * 8 + 2 * i + 1] = bf2f(qw[i] >> 16) * (0.125f * LOG2E); }
    }
    asm volatile("s_waitcnt lgkmcnt(0)" ::: "memory");
    float mx[8];
#pragma unroll
    for (int hd = 0; hd < 8; ++hd) mx[hd] = -3.0e38f;
#pragma unroll 1
    for (int i = 0; i < 4; ++i) {
        const int j = lane + 64 * i;
        asm volatile("" ::: "memory");
        if (j < nsel) {
            const int s = lst[j];
            const bf16* kp = PROJ + ((size_t)b * SEQ + s) * PW + C_AK;
            float kr[64];
#pragma unroll
            for (int c8 = 0; c8 < 8; ++c8) { const v4u kv = *(const v4u*)(kp + 8 * c8); const unsigned kw[4] = {kv.x, kv.y, kv.z, kv.w};
#pragma unroll
                for (int x = 0; x < 4; ++x) { kr[8 * c8 + 2 * x] = bf2f(kw[x] & 0xffffu); kr[8 * c8 + 2 * x + 1] = bf2f(kw[x] >> 16); } }
#pragma unroll
            for (int hd = 0; hd < 8; ++hd) {
                float d = 0.f;
#pragma unroll
                for (int x = 0; x < 64; ++x) d += qs[hd * 64 + x] * kr[x];
                const float slope2 = exp2f(-(float)(hd + 1)) * LOG2E;
                const float lgv = d - slope2 * (float)(t - s);
                pl[j * 8 + hd] = lgv; mx[hd] = fmaxf(mx[hd], lgv);
            }
        }
    }
#pragma unroll
    for (int hd = 0; hd < 8; ++hd) mx[hd] = wave_max(mx[hd]);
    asm volatile("s_waitcnt lgkmcnt(0)" ::: "memory");
    float sm[8];
#pragma unroll
    for (int hd = 0; hd < 8; ++hd) sm[hd] = 0.f;
#pragma unroll 1
    for (int i = 0; i < 4; ++i) {
        const int j = lane + 64 * i;
        if (j < nsel) {
#pragma unroll
            for (int hd = 0; hd < 8; ++hd) { const float p = exp2f(pl[j * 8 + hd] - mx[hd]); pl[j * 8 + hd] = p; sm[hd] += p; }
        }
    }
#pragma unroll
    for (int hd = 0; hd < 8; ++hd) sm[hd] = 1.f / wave_sum(sm[hd]);
    asm volatile("s_waitcnt lgkmcnt(0)" ::: "memory");
    float acc[8];
#pragma unroll
    for (int hd = 0; hd < 8; ++hd) acc[hd] = 0.f;
    const bf16* vb = PROJ + (size_t)b * SEQ * PW + C_AV + lane;
#pragma unroll 4
    for (int j = 0; j < nsel; ++j) {
        const int s = lst[j]; const float v = bf2f(vb[(size_t)s * PW]);
        const f32x4 p0 = *(const LAS f32x4*)(pl + j * 8), p1 = *(const LAS f32x4*)(pl + j * 8 + 4);
        acc[0] += p0.x * v; acc[1] += p0.y * v; acc[2] += p0.z * v; acc[3] += p0.w * v; acc[4] += p1.x * v; acc[5] += p1.y * v; acc[6] += p1.z * v; acc[7] += p1.w * v;
    }
#pragma unroll
    for (int hd = 0; hd < 8; ++hd) acc[hd] *= sm[hd];
#pragma unroll
    for (int hd = 0; hd < 8; ++hd) YM[row * DM + hd * 64 + lane] = (bf16)f2bf(acc[hd]);
}

struct LnRaw { f32x4 x[4]; v2u ya[4]; v2u yb[4]; v2u hx[4]; };
template <bool ROUTE, int YMODE, int XMODE>
__device__ __forceinline__ void ph_ln(Ctx& C, const float* Xin, int l, int which, int mod_g, int mod_l2, int mod_sh, bool write_h, int jmoe, int mod_in, bool write_x) {
    const int gw = C.bid * 8 + C.wave, NGW = C.G * 8, lane = C.lane;
    const float* MOD = (const float*)(C.ws + WS_MOD); bf16* H = (bf16*)(C.ws + WS_H); const bf16* Y = (const bf16*)(C.ws + WS_Y);
    const float* lng = C.in(I_LNG) + (size_t)(l * 2 + which) * DM; const float* lnb = C.in(I_LNB) + (size_t)(l * 2 + which) * DM;
    const int* TOKSLOT = (const int*)(C.ws + WS_TOKSLOT);
    const float* wr = C.in(I_WR) + (size_t)jmoe * DM * NEXP; const float* br = C.in(I_BR) + jmoe * NEXP;
    int* TOPE = (int*)(C.ws + WS_TOPE); float* TOPG = (float*)(C.ws + WS_TOPG);
    unsigned ecnt[8];
#pragma unroll
    for (int e = 0; e < 8; ++e) ecnt[e] = 0u;
    LAS float* wrs = (LAS float*)C.lds;
    if (ROUTE) { for (int i = C.tid; i < DM * NEXP / 4; i += 512) { const int colw = i >> 1, hf = i & 1, L = (colw & 255) >> 2, jw = colw >> 8, cw = colw & 3;
                     ((LAS f32x4*)wrs)[((jw * 4 + cw) * 2 + hf) * 64 + L] = ((const f32x4*)wr)[i]; } __syncthreads(); }
    const int RPW = (MTOK + NGW - 1) / NGW;
    const int r0 = gw * RPW, r1 = (r0 + RPW < MTOK) ? r0 + RPW : MTOK;
    if (r0 < MTOK) {
        const int b = r0 >> 12;
        const bool one_batch = ((r1 - 1) >> 12) == b;
        const float* mg = MOD + ((size_t)l * 16 + b) * 6144 + mod_g;
        const float* mi = MOD + ((size_t)l * 16 + b) * 6144 + mod_in;
        const float* ms = MOD + ((size_t)mod_l2 * 16 + b) * 6144 + mod_sh;
        f32x4 gv[4], shi[4], sci[4];
#pragma unroll
        for (int j = 0; j < 4; ++j) { const int col = 4 * lane + 256 * j; gv[j] = *(const f32x4*)(mg + col);
            if (XMODE == 1) { shi[j] = *(const f32x4*)(mi + col); const f32x4 sc_ = *(const f32x4*)(mi + 1024 + col); sci[j].x = 1.f / (sc_.x + 1.f); sci[j].y = 1.f / (sc_.y + 1.f); sci[j].z = 1.f / (sc_.z + 1.f); sci[j].w = 1.f / (sc_.w + 1.f); } }
        f32x4 Av[4], Bv[4];
#pragma unroll
        for (int j = 0; j < 4; ++j) { const int col = 4 * lane + 256 * j; const f32x4 gn = *(const f32x4*)(lng + col), bn = *(const f32x4*)(lnb + col);
            if (write_h) { const f32x4 sh = *(const f32x4*)(ms + col), sc = *(const f32x4*)(ms + 1024 + col); Av[j] = gn * (sc + 1.f); Bv[j] = bn * (sc + 1.f) + sh; } else { Av[j] = gn; Bv[j] = bn; } }
        int sl0 = 0, sl1 = 0;
        if (YMODE == 1 && r0 + lane < r1) { sl0 = TOKSLOT[2 * (r0 + lane)]; sl1 = TOKSLOT[2 * (r0 + lane) + 1]; }
#define LN_LOAD(R, row_) { const int s0_ = (YMODE == 1) ? (((row_) - r0 < 64) ? __builtin_amdgcn_readlane(sl0, (row_) - r0) : TOKSLOT[2 * (row_)]) : 0, s1_ = (YMODE == 1) ? (((row_) - r0 < 64) ? __builtin_amdgcn_readlane(sl1, (row_) - r0) : TOKSLOT[2 * (row_) + 1]) : 0; \
        const bf16* y0_ = (YMODE == 0) ? Y + (size_t)(row_) * DM : Y + (size_t)s0_ * DM; const bf16* y1_ = Y + (size_t)s1_ * DM; \
        _Pragma("unroll") for (int j = 0; j < 4; ++j) { const int col = 4 * lane + 256 * j; \
            if (XMODE == 0) R.x[j] = *(const f32x4*)(Xin + (size_t)(row_) * DM + col); else R.hx[j] = *(const v2u*)(H + (size_t)(row_) * DM + col); \
            R.ya[j] = *(const v2u*)(y0_ + col); if (YMODE == 1) R.yb[j] = *(const v2u*)(y1_ + col); } }
        LnRaw cur, nx1, nx2;
        LN_LOAD(cur, r0)
        if (r0 + 1 < r1) LN_LOAD(nx1, r0 + 1)
        for (int row = r0; row < r1; ++row) {
            if (ROUTE) asm volatile("" ::: "memory");
            if (row + 2 < r1) LN_LOAD(nx2, row + 2)
            if (!one_batch) {
                const int bb = row >> 12; const float* mg2 = MOD + ((size_t)l * 16 + bb) * 6144 + mod_g; const float* mi2 = MOD + ((size_t)l * 16 + bb) * 6144 + mod_in;
#pragma unroll
                for (int j = 0; j < 4; ++j) { const int col = 4 * lane + 256 * j; gv[j] = *(const f32x4*)(mg2 + col);
                    if (XMODE == 1) { shi[j] = *(const f32x4*)(mi2 + col); const f32x4 sc_ = *(const f32x4*)(mi2 + 1024 + col); sci[j].x = 1.f / (sc_.x + 1.f); sci[j].y = 1.f / (sc_.y + 1.f); sci[j].z = 1.f / (sc_.z + 1.f); sci[j].w = 1.f / (sc_.w + 1.f); } }
            }
            if (!one_batch) {
                const float* msr = MOD + ((size_t)mod_l2 * 16 + (row >> 12)) * 6144 + mod_sh;
#pragma unroll
                for (int j = 0; j < 4; ++j) { const int col = 4 * lane + 256 * j; const f32x4 gn = *(const f32x4*)(lng + col), bn = *(const f32x4*)(lnb + col);
                    if (write_h) { const f32x4 sh = *(const f32x4*)(msr + col), sc = *(const f32x4*)(msr + 1024 + col); Av[j] = gn * (sc + 1.f); Bv[j] = bn * (sc + 1.f) + sh; } else { Av[j] = gn; Bv[j] = bn; } }
            }
            f32x4 v[4]; float s = 0.f;
#pragma unroll
            for (int j = 0; j < 4; ++j) {
                const v2u ya = cur.ya[j];
                f32x4 y; y.x = bf2f(ya.x & 0xffffu); y.y = bf2f(ya.x >> 16); y.z = bf2f(ya.y & 0xffffu); y.w = bf2f(ya.y >> 16);
                if (YMODE == 1) { const v2u yb = cur.yb[j]; y.x += bf2f(yb.x & 0xffffu); y.y += bf2f(yb.x >> 16); y.z += bf2f(yb.y & 0xffffu); y.w += bf2f(yb.y >> 16); }
                f32x4 xr;
                if (XMODE == 0) xr = cur.x[j];
                else { const v2u hh_ = cur.hx[j]; f32x4 hf; hf.x = bf2f(hh_.x & 0xffffu); hf.y = bf2f(hh_.x >> 16); hf.z = bf2f(hh_.y & 0xffffu); hf.w = bf2f(hh_.y >> 16);
                       xr = (hf - shi[j]) * sci[j]; }
                v[j] = xr * DN_ALPHA + (gv[j] + 1.f) * y;
                s += (v[j].x + v[j].y) + (v[j].z + v[j].w);
            }
            const float mean = wave_sum_f(s) * (1.f / DM); float s2 = 0.f;
#pragma unroll
            for (int j = 0; j < 4; ++j) { v[j] = v[j] - mean; s2 += (v[j].x * v[j].x + v[j].y * v[j].y) + (v[j].z * v[j].z + v[j].w * v[j].w); }
            const float rstd = rsqrtf(wave_sum_f(s2) * (1.f / DM) + LN_EPS);
            float lgt[8];
#pragma unroll
            for (int e = 0; e < 8; ++e) lgt[e] = 0.f;
#pragma unroll
            for (int j = 0; j < 4; ++j) {
                const int col = 4 * lane + 256 * j;
                const f32x4 hv = v[j] * rstd * Av[j] + Bv[j];
                if (write_x) *(f32x4*)(C.out + (size_t)row * DM + col) = hv;
                if (write_h) {
                    v2u o; o.x = pk2(hv.x, hv.y); o.y = pk2(hv.z, hv.w);
                    *(v2u*)(H + (size_t)row * DM + col) = o;
                    if (ROUTE) {
                        const float hx[4] = {hv.x, hv.y, hv.z, hv.w};
#pragma unroll
                        for (int c = 0; c < 4; ++c) { const f32x4 w0 = ((const LAS f32x4*)wrs)[((j * 4 + c) * 2 + 0) * 64 + lane], w1 = ((const LAS f32x4*)wrs)[((j * 4 + c) * 2 + 1) * 64 + lane];
                            lgt[0] += hx[c] * w0.x; lgt[1] += hx[c] * w0.y; lgt[2] += hx[c] * w0.z; lgt[3] += hx[c] * w0.w;
                            lgt[4] += hx[c] * w1.x; lgt[5] += hx[c] * w1.y; lgt[6] += hx[c] * w1.z; lgt[7] += hx[c] * w1.w; }
                    }
                }
            }
            if (ROUTE) {
#pragma unroll
                for (int e = 0; e < 8; ++e) lgt[e] = wave_sum_f(lgt[e]) + br[e];
                int e0 = 0; float v0 = lgt[0];
#pragma unroll
                for (int e = 1; e < 8; ++e) if (lgt[e] > v0) { v0 = lgt[e]; e0 = e; }
                int e1 = -1; float v1 = -3.0e38f;
#pragma unroll
                for (int e = 0; e < 8; ++e) if (e != e0 && lgt[e] > v1) { v1 = lgt[e]; e1 = e; }
                const float g1 = 1.f / (1.f + expf(v0 - v1)), g0 = 1.f - g1;
                if (lane == 0) { TOPE[2 * row] = e0; TOPE[2 * row + 1] = e1; TOPG[2 * row] = g0; TOPG[2 * row + 1] = g1; }
#pragma unroll
                for (int e = 0; e < 8; ++e) ecnt[e] += (e == e0 ? 1u : 0u) + (e == e1 ? 1u : 0u);
            }
            cur = nx1; nx1 = nx2;
        }
#undef LN_LOAD
    }
    if (ROUTE) {
        unsigned mine = 0u;
#pragma unroll
        for (int e = 0; e < 8; ++e) mine = (lane == e) ? ecnt[e] : mine;
        if (lane < 8 && mine) __hip_atomic_fetch_add(C.ctl + CW_CNT + 64 * jmoe + lane, mine, __ATOMIC_RELAXED, __HIP_MEMORY_SCOPE_AGENT);
    }
}

struct MoeTab { int pend[8]; int npanels; };
__device__ __forceinline__ MoeTab moe_tab(Ctx& C, int jmoe) {
    MoeTab t; int acc = 0;
#pragma unroll
    for (int e = 0; e < 8; ++e) { const int c = (int)__hip_atomic_load(C.ctl + CW_CNT + 64 * jmoe + e, __ATOMIC_RELAXED, __HIP_MEMORY_SCOPE_AGENT); acc += (c + 255) & ~255; t.pend[e] = acc; }
    t.npanels = acc >> 8; return t;
}
__device__ __forceinline__ int panel_expert(const MoeTab& t, int p) {
    int e = 0;
#pragma unroll
    for (int k = 0; k < 7; ++k) e += (p * 256 >= t.pend[k]) ? 1 : 0;
    return e;
}
__device__ __forceinline__ void ph_assign(Ctx& C, int jmoe) {
    const int gw = C.bid * 8 + C.wave, NGW = C.G * 8, lane = C.lane;
    const MoeTab tb = moe_tab(C, jmoe);
    const int* TOPE = (const int*)(C.ws + WS_TOPE); const float* TOPG = (const float*)(C.ws + WS_TOPG);
    int* TOKSLOT = (int*)(C.ws + WS_TOKSLOT); int* ROWTOK = (int*)(C.ws + WS_ROWTOK); float* ROWGATE = (float*)(C.ws + WS_ROWGATE);
    const bf16* H = (const bf16*)(C.ws + WS_H); bf16* HS = (bf16*)(C.ws + WS_Y);
    const unsigned long long ltmask = (lane == 0) ? 0ull : (~0ull >> (64 - lane));
    for (int tk0 = gw * 32; tk0 < MTOK; tk0 += NGW * 32) {
        const int tok = tk0 + (lane & 31); const bool act = lane < 32;
        const int e0 = act ? TOPE[2 * tok] : -1, e1 = act ? TOPE[2 * tok + 1] : -1; const float g0 = TOPG[2 * tok], g1 = TOPG[2 * tok + 1];
        int s0 = 0, s1 = 0;
#pragma unroll
        for (int e = 0; e < 8; ++e) {
            const unsigned long long m0 = __ballot(e0 == e), m1 = __ballot(e1 == e); const int n0 = __popcll(m0), n1 = __popcll(m1);
            int basev = 0;
            if (lane == 0 && (n0 + n1) > 0) basev = (int)__hip_atomic_fetch_add(C.ctl + CW_FILL + 64 * jmoe + e, (unsigned)(n0 + n1), __ATOMIC_RELAXED, __HIP_MEMORY_SCOPE_AGENT);
            basev = __builtin_amdgcn_readfirstlane(basev);
            const int pstart = (e == 0) ? 0 : tb.pend[e > 0 ? e - 1 : 0];
            if (e0 == e) s0 = pstart + basev + __popcll(m0 & ltmask);
            if (e1 == e) s1 = pstart + basev + n0 + __popcll(m1 & ltmask);
        }
        if (act) { TOKSLOT[2 * tok] = s0; TOKSLOT[2 * tok + 1] = s1;
            ROWTOK[s0] = tok; ROWGATE[s0] = g0; ROWTOK[s1] = tok; ROWGATE[s1] = g1; }
    }
    for (int idx = gw; idx < 8 * 256; idx += NGW) {
        const int e = idx >> 8, jj = idx & 255;
        const int c = (int)__hip_atomic_load(C.ctl + CW_CNT + 64 * jmoe + e, __ATOMIC_RELAXED, __HIP_MEMORY_SCOPE_AGENT);
        int pstart = 0;
#pragma unroll
        for (int k = 0; k < 7; ++k) if (k < e) pstart = tb.pend[k];
        const int slot = pstart + c + jj;
        if (c + jj < ((c + 255) & ~255)) {
            if (lane == 0) { ROWTOK[slot] = 0; ROWGATE[slot] = 0.f; }
        }
    }
}

__device__ __forceinline__ float silu_fast_(float v) { return v * __builtin_amdgcn_rcpf(1.f + __builtin_amdgcn_exp2f(-v * LOG2E)); }
constexpr size_t WS_GLA_LT = WS_Y;
constexpr size_t WS_GLA_SP = WS_Y + 130 * MiB;
constexpr size_t WS_GLA_EB = WS_Y + 128 * MiB;
constexpr int GLA_PITCH = 72;

struct GlaDecay { float b[8]; float Btot; float qv[8]; float kv[8]; };
__device__ __forceinline__ void gla_decay(Ctx& C, int l, int b, int hh, int c, LAS float* segs, GlaDecay& D, int bas_off = 36864) {
    const bf16* PROJ = (const bf16*)(C.ws + WS_P);
    const float* w_a2 = C.in(I_WA2) + (size_t)l * 16 * 256 + hh * 64 + C.lane; const float bias = C.in(I_BA)[l * 256 + hh * 64 + C.lane];
    float w[16];
#pragma unroll
    for (int r = 0; r < 16; ++r) w[r] = w_a2[r * 256];
    const size_t row0 = (size_t)b * SEQ + c * 64 + 8 * C.wave;
    LAS unsigned* baS = (LAS unsigned*)(C.lds + bas_off) + C.wave * 64;
    baS[C.lane] = *(const unsigned*)(PROJ + (row0 + (C.lane >> 3)) * PW + C_BA + 2 * (C.lane & 7));
    float qraw[8], kraw[8];
#pragma unroll
    for (int i = 0; i < 8; ++i) { const bf16* pr = PROJ + (row0 + i) * PW; qraw[i] = bf2f(pr[C_BQ + hh * 64 + C.lane]); kraw[i] = bf2f(pr[C_BK + hh * 64 + C.lane]); }
    asm volatile("s_waitcnt lgkmcnt(0)" ::: "memory");
    float run = 0.f;
#pragma unroll
    for (int i = 0; i < 8; ++i) {
        const v4u ba0 = *(const LAS v4u*)(baS + 8 * i), ba1 = *(const LAS v4u*)(baS + 8 * i + 4);
        const unsigned bw[8] = {ba0.x, ba0.y, ba0.z, ba0.w, ba1.x, ba1.y, ba1.z, ba1.w};
        float z = bias;
#pragma unroll
        for (int r = 0; r < 8; ++r) { z += bf2f(bw[r] & 0xffffu) * w[2 * r]; z += bf2f(bw[r] >> 16) * w[2 * r + 1]; }
        const float ls = fminf(z, 0.f) - __logf(1.f + __expf(-fabsf(z)));
        run += ls * (1.f / 16.f);
        D.b[i] = run;
        D.qv[i] = qraw[i]; D.kv[i] = kraw[i];
    }
    segs[C.wave * 64 + C.lane] = run;
    __syncthreads();
    float off = 0.f, tot = 0.f;
#pragma unroll
    for (int w8 = 0; w8 < 8; ++w8) { const float sv = segs[w8 * 64 + C.lane]; tot += sv; off += (w8 < C.wave) ? sv : 0.f; }
#pragma unroll
    for (int i = 0; i < 8; ++i) D.b[i] += off;
    D.Btot = tot;
}
__device__ __forceinline__ bf16x8 gla_vt_frag(const bf16* vcol, int ks, int h) {
    unsigned short x[8];
#pragma unroll
    for (int j = 0; j < 8; ++j) x[j] = vcol[(size_t)(16 * ks + 8 * (j >> 2) + 4 * h + (j & 3)) * PW];
    v4u p; p.x = (unsigned)x[0] | ((unsigned)x[1] << 16); p.y = (unsigned)x[2] | ((unsigned)x[3] << 16); p.z = (unsigned)x[4] | ((unsigned)x[5] << 16); p.w = (unsigned)x[6] | ((unsigned)x[7] << 16);
    return __builtin_bit_cast(bf16x8, p);
}

__device__ __forceinline__ void ph_gla1_unit(Ctx& C, int l, int unit) {
    const int c = unit & 63, hh = (unit >> 6) & 3, b = unit >> 8;
    LAS bf16* KDT = (LAS bf16*)C.lds;
    LAS float* segs = (LAS float*)(C.lds + 32768);
    const bf16* PROJ = (const bf16*)(C.ws + WS_P);
    const int mt = C.wave >> 1, nd = C.wave & 1, n = C.lane & 31, h = C.lane >> 5;
    const bf16* vcol = PROJ + ((size_t)b * SEQ + c * 64) * PW + C_BV + hh * 128 + 32 * mt + n;
    bf16x8 vf[4];
#pragma unroll
    for (int ks = 0; ks < 4; ++ks) vf[ks] = gla_vt_frag(vcol, ks, h);
    GlaDecay D; gla_decay(C, l, b, hh, c, segs, D);
    {
        v4u p;
        p.x = pk2(D.kv[0] * __expf(D.Btot - D.b[0]), D.kv[1] * __expf(D.Btot - D.b[1])); p.y = pk2(D.kv[2] * __expf(D.Btot - D.b[2]), D.kv[3] * __expf(D.Btot - D.b[3]));
        p.z = pk2(D.kv[4] * __expf(D.Btot - D.b[4]), D.kv[5] * __expf(D.Btot - D.b[5])); p.w = pk2(D.kv[6] * __expf(D.Btot - D.b[6]), D.kv[7] * __expf(D.Btot - D.b[7]));
        *(LAS v4u*)(KDT + C.lane * GLA_PITCH + 8 * C.wave) = p;
        if (C.wave == 0) ((float*)(C.ws + WS_GLA_EB))[(size_t)unit * 64 + C.lane] = __expf(D.Btot);
    }
    __syncthreads();
    f32x16 acc;
#pragma unroll
    for (int i = 0; i < 16; ++i) acc[i] = 0.f;
#pragma unroll
    for (int ks = 0; ks < 4; ++ks) {
        const LAS bf16* kp = KDT + (32 * nd + n) * GLA_PITCH + 16 * ks + 4 * h;
        const v2u k0 = *(const LAS v2u*)kp, k1 = *(const LAS v2u*)(kp + 8);
        v4u kk; kk.x = k0.x; kk.y = k0.y; kk.z = k1.x; kk.w = k1.y;
        acc = mfma32(vf[ks], __builtin_bit_cast(bf16x8, kk), acc);
    }
    float* LT = (float*)(C.ws + WS_GLA_LT) + (size_t)unit * 8192;
#pragma unroll
    for (int r = 0; r < 16; ++r) LT[(32 * mt + (r & 3) + 8 * (r >> 2) + 4 * h) * 64 + 32 * nd + n] = acc[r];
    __syncthreads();
}

__device__ __forceinline__ void ph_gla2(Ctx& C, size_t probe_off = 0) {
    const f32x4* LT = (const f32x4*)(C.ws + WS_GLA_LT); v2u* SP = (v2u*)(C.ws + WS_GLA_SP + probe_off); const float* EB = (const float*)(C.ws + WS_GLA_EB);
    for (int it = C.bid; it < 64 * 4; it += C.G) {
        const int bh = it >> 2, idx = (it & 3) * 512 + C.tid;
        const f32x4* p = LT + (size_t)bh * 64 * 2048 + idx; v2u* q = SP + (size_t)bh * 64 * 2048 + idx; const float* eb = EB + (size_t)bh * 64 * 64 + ((4 * idx) & 63);
        float S0 = 0.f, S1 = 0.f, S2 = 0.f, S3 = 0.f;
#pragma unroll 16
        for (int c = 0; c < 64; ++c) { const f32x4 lv = p[(size_t)c * 2048]; const f32x4 e = *(const f32x4*)(eb + c * 64);
            v2u o; o.x = pk2(S0, S1); o.y = pk2(S2, S3); q[(size_t)c * 2048] = o;
            S0 = e.x * S0 + lv.x; S1 = e.y * S1 + lv.y; S2 = e.z * S2 + lv.z; S3 = e.w * S3 + lv.w; }
    }
}

__device__ __forceinline__ void ph_gla3_unit(Ctx& C, int l, int unit) {
    const int c = unit & 63, hh = (unit >> 6) & 3, b = unit >> 8;
    LAS bf16* QE = (LAS bf16*)C.lds;
    LAS bf16* KE = QE + 64 * GLA_PITCH;
    LAS float* segs = (LAS float*)(C.lds + 32768);
    LAS float* ssq = (LAS float*)(C.lds + 32768 + 2048);
    const bf16* PROJ = (const bf16*)(C.ws + WS_P); bf16* YM = (bf16*)C.out;
    const int mt = C.wave >> 1, nt = C.wave & 1, n = C.lane & 31, h = C.lane >> 5;
    const size_t row0 = (size_t)b * SEQ + c * 64;
    const bf16* vcol = PROJ + row0 * PW + C_BV + hh * 128 + 32 * mt + n;
    bf16x8 vf[4]; bf16x8 spf[4]; v2u gb[4]; f32x4 gnv[4];
#pragma unroll
    for (int ks = 0; ks < 4; ++ks) vf[ks] = gla_vt_frag(vcol, (ks <= 2 * nt + 1) ? ks : 0, h);
    {
        const bf16* Sp = (const bf16*)(C.ws + WS_GLA_SP) + (size_t)unit * 8192 + (size_t)(32 * mt + n) * 64 + 8 * h;
#pragma unroll
        for (int ks = 0; ks < 4; ++ks) spf[ks] = *(const bf16x8*)(Sp + 16 * ks);
#pragma unroll
        for (int j4 = 0; j4 < 4; ++j4) { gb[j4] = *(const v2u*)(PROJ + (row0 + 32 * nt + n) * PW + C_BG + hh * 128 + 32 * mt + 8 * j4 + 4 * h); gnv[j4] = *(const f32x4*)(C.in(I_GLAG) + l * 128 + 32 * mt + 8 * j4 + 4 * h); }
    }
    GlaDecay D; gla_decay(C, l, b, hh, c, segs, D);
#pragma unroll
    for (int i = 0; i < 8; ++i) {
        QE[(8 * C.wave + i) * GLA_PITCH + C.lane] = (bf16)f2bf(D.qv[i] * 0.125f * __expf(D.b[i]));
        KE[(8 * C.wave + i) * GLA_PITCH + C.lane] = (bf16)f2bf(D.kv[i] * __expf(-D.b[i]));
    }
    __syncthreads();
    bf16x8 qf[4];
#pragma unroll
    for (int ks = 0; ks < 4; ++ks) qf[ks] = *(const LAS bf16x8*)(QE + (32 * nt + n) * GLA_PITCH + 16 * ks + 8 * h);
    f32x16 accO;
#pragma unroll
    for (int i = 0; i < 16; ++i) accO[i] = 0.f;
#pragma unroll
    for (int ms = 0; ms < 2; ++ms) {
        if (ms <= nt) {
            f32x16 aT;
#pragma unroll
            for (int i = 0; i < 16; ++i) aT[i] = 0.f;
#pragma unroll
            for (int ks = 0; ks < 4; ++ks) { const bf16x8 kf = *(const LAS bf16x8*)(KE + (32 * ms + n) * GLA_PITCH + 16 * ks + 8 * h); aT = mfma32(kf, qf[ks], aT); }
            if (ms == nt) {
#pragma unroll
                for (int r = 0; r < 16; ++r) { const int s = (r & 3) + 8 * (r >> 2) + 4 * h; aT[r] = (s <= n) ? aT[r] : 0.f; }
            }
#pragma unroll
            for (int s2 = 0; s2 < 2; ++s2) {
                v4u pa; pa.x = pk2(aT[8 * s2 + 0], aT[8 * s2 + 1]); pa.y = pk2(aT[8 * s2 + 2], aT[8 * s2 + 3]); pa.z = pk2(aT[8 * s2 + 4], aT[8 * s2 + 5]); pa.w = pk2(aT[8 * s2 + 6], aT[8 * s2 + 7]);
                accO = mfma32(vf[2 * ms + s2], __builtin_bit_cast(bf16x8, pa), accO);
            }
        }
    }
    {
#pragma unroll
        for (int ks = 0; ks < 4; ++ks) accO = mfma32(spf[ks], qf[ks], accO);
    }
    float sq = 0.f;
#pragma unroll
    for (int r = 0; r < 16; ++r) sq += accO[r] * accO[r];
    sq += SHX_F(sq, 32, C.lane);
    if (h == 0) ssq[mt * 64 + 32 * nt + n] = sq;
    __syncthreads();
    const float rstd = rsqrtf(((ssq[32 * nt + n] + ssq[64 + 32 * nt + n]) + (ssq[128 + 32 * nt + n] + ssq[192 + 32 * nt + n])) * (1.f / 128.f) + LN_EPS);
    const size_t row = row0 + 32 * nt + n;
#pragma unroll
    for (int j4 = 0; j4 < 4; ++j4) {
        const int e0 = 32 * mt + 8 * j4 + 4 * h;
        const v2u gbv = gb[j4]; const f32x4 gn = gnv[j4];
        const float y0 = accO[4 * j4 + 0] * rstd * gn.x * silu_fast_(bf2f(gbv.x & 0xffffu)), y1 = accO[4 * j4 + 1] * rstd * gn.y * silu_fast_(bf2f(gbv.x >> 16));
        const float y2 = accO[4 * j4 + 2] * rstd * gn.z * silu_fast_(bf2f(gbv.y & 0xffffu)), y3 = accO[4 * j4 + 3] * rstd * gn.w * silu_fast_(bf2f(gbv.y >> 16));
        v2u o; o.x = pk2(y0, y1); o.y = pk2(y2, y3);
        *(v2u*)(YM + row * DM + 512 + hh * 128 + e0) = o;
    }
    __syncthreads();
}

constexpr int GS_QE = 0, GS_KE = 9216, GS_KDT = 18432, GS_SB = 27648, GS_SEGS = 46080, GS_SSQ = 48128, GS_EB = 49152, GS_BAS = 49408;
struct GlaIn { v4u v[2]; v4u qr, kr; v2u gb[4]; unsigned ba; };
constexpr int GS_VS = 51456, GS_VP = 272;
constexpr int GS_QK = GS_VS + 64 * GS_VP;
__device__ __forceinline__ void gla_seq_load(Ctx& C, int b, int hh, int c, GlaIn& I) {
    const bf16* PROJ = (const bf16*)(C.ws + WS_P);
    const int mt = C.wave >> 1, x = C.wave & 1, n = C.lane & 31, h = C.lane >> 5;
    const size_t row0 = (size_t)b * SEQ + c * 64;
#pragma unroll
    for (int i = 0; i < 2; ++i) I.v[i] = *(const v4u*)(PROJ + (row0 + 8 * C.wave + 4 * i + (C.lane >> 4)) * PW + C_BV + hh * 128 + 8 * (C.lane & 15));
#pragma unroll
    for (int j4 = 0; j4 < 4; ++j4) I.gb[j4] = *(const v2u*)(PROJ + (row0 + 32 * x + n) * PW + C_BG + hh * 128 + 32 * mt + 8 * j4 + 4 * h);
    const size_t rw = row0 + 8 * C.wave;
    I.ba = *(const unsigned*)(PROJ + (rw + (C.lane >> 3)) * PW + C_BA + 2 * (C.lane & 7));
    I.qr = *(const v4u*)(PROJ + (rw + (C.lane >> 3)) * PW + C_BQ + hh * 64 + 8 * (C.lane & 7));
    I.kr = *(const v4u*)(PROJ + (rw + (C.lane >> 3)) * PW + C_BK + hh * 64 + 8 * (C.lane & 7));
}
__device__ __forceinline__ void ph_gla_seq(Ctx& C, int l, int seq) {
    const int hh = seq & 3, b = seq >> 2;
    LAS bf16* QE = (LAS bf16*)(C.lds + GS_QE); LAS bf16* KE = (LAS bf16*)(C.lds + GS_KE); LAS bf16* KDT = (LAS bf16*)(C.lds + GS_KDT); LAS bf16* SB = (LAS bf16*)(C.lds + GS_SB);
    LAS float* segs = (LAS float*)(C.lds + GS_SEGS); LAS float* ssq = (LAS float*)(C.lds + GS_SSQ); LAS float* ebS = (LAS float*)(C.lds + GS_EB);
    LAS unsigned* baS = (LAS unsigned*)(C.lds + GS_BAS) + C.wave * 64;
    bf16* YM = (bf16*)C.out;
    const int mt = C.wave >> 1, x = C.wave & 1, n = C.lane & 31, h = C.lane >> 5;
    f32x16 st;
#pragma unroll
    for (int i = 0; i < 16; ++i) st[i] = 0.f;
    for (int i = C.tid; i < 128 * GLA_PITCH / 2; i += 512) ((LAS unsigned*)SB)[i] = 0u;
    f32x4 gnv[4];
#pragma unroll
    for (int j4 = 0; j4 < 4; ++j4) gnv[j4] = *(const f32x4*)(C.in(I_GLAG) + l * 128 + 32 * mt + 8 * j4 + 4 * h);
    float w[16];
    { const float* w_a2 = C.in(I_WA2) + (size_t)l * 16 * 256 + hh * 64 + C.lane;
#pragma unroll
      for (int r = 0; r < 16; ++r) w[r] = w_a2[r * 256]; }
    const float bias = C.in(I_BA)[l * 256 + hh * 64 + C.lane];
    GlaIn I; gla_seq_load(C, b, hh, 0, I);
    __syncthreads();
#pragma unroll 1
    for (int c = 0; c < 64; ++c) {
        const size_t row0 = (size_t)b * SEQ + c * 64;
        bf16x8 vf[4]; v2u gb[4]; GlaDecay D;
#pragma unroll
        for (int j4 = 0; j4 < 4; ++j4) gb[j4] = I.gb[j4];
        baS[C.lane] = I.ba;
        {
            LAS unsigned char* VS = C.lds + GS_VS; LAS unsigned char* QK = C.lds + GS_QK + C.wave * 2304;
#pragma unroll
            for (int i = 0; i < 2; ++i) *(LAS v4u*)(VS + (8 * C.wave + 4 * i + (C.lane >> 4)) * GS_VP + 16 * (C.lane & 15)) = I.v[i];
            *(LAS v4u*)(QK + (C.lane >> 3) * 144 + 16 * (C.lane & 7)) = I.qr;
            *(LAS v4u*)(QK + 1152 + (C.lane >> 3) * 144 + 16 * (C.lane & 7)) = I.kr;
            asm volatile("" ::: "memory");
#pragma unroll
            for (int i = 0; i < 8; ++i) { D.qv[i] = bf2f(*(const LAS unsigned short*)(QK + i * 144 + 2 * C.lane)); D.kv[i] = bf2f(*(const LAS unsigned short*)(QK + 1152 + i * 144 + 2 * C.lane)); }
        }
        gla_seq_load(C, b, hh, c < 63 ? c + 1 : 63, I);
        {
            asm volatile("" ::: "memory");
            float run = 0.f;
#pragma unroll
            for (int i = 0; i < 8; ++i) {
                const v4u ba0 = *(const LAS v4u*)(baS + 8 * i), ba1 = *(const LAS v4u*)(baS + 8 * i + 4);
                const unsigned bw[8] = {ba0.x, ba0.y, ba0.z, ba0.w, ba1.x, ba1.y, ba1.z, ba1.w};
                float z = bias;
#pragma unroll
                for (int r = 0; r < 8; ++r) { z += bf2f(bw[r] & 0xffffu) * w[2 * r]; z += bf2f(bw[r] >> 16) * w[2 * r + 1]; }
                const float ls = fminf(z, 0.f) - __logf(1.f + __expf(-fabsf(z)));
                run += ls * (1.f / 16.f);
                D.b[i] = run;
            }
            segs[C.wave * 64 + C.lane] = run;
            __syncthreads();
            float off = 0.f, tot = 0.f;
#pragma unroll
            for (int w8 = 0; w8 < 8; ++w8) { const float sv = segs[w8 * 64 + C.lane]; tot += sv; off += (w8 < C.wave) ? sv : 0.f; }
#pragma unroll
            for (int i = 0; i < 8; ++i) D.b[i] += off;
            D.Btot = tot;
        }
#pragma unroll
        for (int i = 0; i < 8; ++i) {
            QE[(8 * C.wave + i) * GLA_PITCH + C.lane] = (bf16)f2bf(D.qv[i] * 0.125f * __expf(D.b[i]));
            KE[(8 * C.wave + i) * GLA_PITCH + C.lane] = (bf16)f2bf(D.kv[i] * __expf(-D.b[i]));
        }
        {
            v4u p;
            p.x = pk2(D.kv[0] * __expf(D.Btot - D.b[0]), D.kv[1] * __expf(D.Btot - D.b[1])); p.y = pk2(D.kv[2] * __expf(D.Btot - D.b[2]), D.kv[3] * __expf(D.Btot - D.b[3]));
            p.z = pk2(D.kv[4] * __expf(D.Btot - D.b[4]), D.kv[5] * __expf(D.Btot - D.b[5])); p.w = pk2(D.kv[6] * __expf(D.Btot - D.b[6]), D.kv[7] * __expf(D.Btot - D.b[7]));
            *(LAS v4u*)(KDT + C.lane * GLA_PITCH + 8 * C.wave) = p;
            if (C.wave == 0) ebS[C.lane] = __expf(D.Btot);
        }
        __syncthreads();
        {
            const LAS unsigned char* vcol = C.lds + GS_VS + 2 * (32 * mt + n);
#pragma unroll
            for (int ks = 0; ks < 4; ++ks) {
                unsigned short xv[8];
#pragma unroll
                for (int j = 0; j < 8; ++j) xv[j] = *(const LAS unsigned short*)(vcol + (16 * ks + 8 * (j >> 2) + 4 * h + (j & 3)) * GS_VP);
                v4u p; p.x = (unsigned)xv[0] | ((unsigned)xv[1] << 16); p.y = (unsigned)xv[2] | ((unsigned)xv[3] << 16); p.z = (unsigned)xv[4] | ((unsigned)xv[5] << 16); p.w = (unsigned)xv[6] | ((unsigned)xv[7] << 16);
                vf[ks] = __builtin_bit_cast(bf16x8, p);
            }
        }
        bf16x8 qf[4];
#pragma unroll
        for (int ks = 0; ks < 4; ++ks) qf[ks] = *(const LAS bf16x8*)(QE + (32 * x + n) * GLA_PITCH + 16 * ks + 8 * h);
        f32x16 accO;
#pragma unroll
        for (int i = 0; i < 16; ++i) accO[i] = 0.f;
#pragma unroll
        for (int ms = 0; ms < 2; ++ms) {
            if (ms <= x) {
                f32x16 aT;
#pragma unroll
                for (int i = 0; i < 16; ++i) aT[i] = 0.f;
#pragma unroll
                for (int ks = 0; ks < 4; ++ks) { const bf16x8 kf = *(const LAS bf16x8*)(KE + (32 * ms + n) * GLA_PITCH + 16 * ks + 8 * h); aT = mfma32(kf, qf[ks], aT); }
                if (ms == x) {
#pragma unroll
                    for (int r = 0; r < 16; ++r) { const int sx = (r & 3) + 8 * (r >> 2) + 4 * h; aT[r] = (sx <= n) ? aT[r] : 0.f; }
                }
#pragma unroll
                for (int s2 = 0; s2 < 2; ++s2) {
                    v4u pa; pa.x = pk2(aT[8 * s2 + 0], aT[8 * s2 + 1]); pa.y = pk2(aT[8 * s2 + 2], aT[8 * s2 + 3]); pa.z = pk2(aT[8 * s2 + 4], aT[8 * s2 + 5]); pa.w = pk2(aT[8 * s2 + 6], aT[8 * s2 + 7]);
                    accO = mfma32(vf[2 * ms + s2], __builtin_bit_cast(bf16x8, pa), accO);
                }
            }
        }
#pragma unroll
        for (int ks = 0; ks < 4; ++ks) { const bf16x8 spf = *(const LAS bf16x8*)(SB + (32 * mt + n) * GLA_PITCH + 16 * ks + 8 * h); accO = mfma32(spf, qf[ks], accO); }
        {
            f32x16 accL;
#pragma unroll
            for (int i = 0; i < 16; ++i) accL[i] = 0.f;
#pragma unroll
            for (int ks = 0; ks < 4; ++ks) {
                const LAS bf16* kp = KDT + (32 * x + n) * GLA_PITCH + 16 * ks + 4 * h;
                const v2u k0 = *(const LAS v2u*)kp, k1 = *(const LAS v2u*)(kp + 8);
                v4u kk; kk.x = k0.x; kk.y = k0.y; kk.z = k1.x; kk.w = k1.y;
                accL = mfma32(vf[ks], __builtin_bit_cast(bf16x8, kk), accL);
            }
            const float eb = ebS[32 * x + n];
#pragma unroll
            for (int i = 0; i < 16; ++i) st[i] = st[i] * eb + accL[i];
        }
        float sq = 0.f;
#pragma unroll
        for (int r = 0; r < 16; ++r) sq += accO[r] * accO[r];
        sq += SHX_F(sq, 32, C.lane);
        if (h == 0) ssq[mt * 64 + 32 * x + n] = sq;
        __syncthreads();
#pragma unroll
        for (int r = 0; r < 16; ++r) SB[(32 * mt + (r & 3) + 8 * (r >> 2) + 4 * h) * GLA_PITCH + 32 * x + n] = (bf16)f2bf(st[r]);
        const float rstd = rsqrtf(((ssq[32 * x + n] + ssq[64 + 32 * x + n]) + (ssq[128 + 32 * x + n] + ssq[192 + 32 * x + n])) * (1.f / 128.f) + LN_EPS);
        const size_t row = row0 + 32 * x + n;
#pragma unroll
        for (int j4 = 0; j4 < 4; ++j4) {
            const int e0 = 32 * mt + 8 * j4 + 4 * h;
            const v2u gbv = gb[j4]; const f32x4 gn = gnv[j4];
            const float y0 = accO[4 * j4 + 0] * rstd * gn.x * silu_fast_(bf2f(gbv.x & 0xffffu)), y1 = accO[4 * j4 + 1] * rstd * gn.y * silu_fast_(bf2f(gbv.x >> 16));
            const float y2 = accO[4 * j4 + 2] * rstd * gn.z * silu_fast_(bf2f(gbv.y & 0xffffu)), y3 = accO[4 * j4 + 3] * rstd * gn.w * silu_fast_(bf2f(gbv.y >> 16));
            v2u o; o.x = pk2(y0, y1); o.y = pk2(y2, y3);
            *(v2u*)(YM + row * DM + 512 + hh * 128 + e0) = o;
        }
    }
    __syncthreads();
}

#ifndef A3_VPATH
#define A3_VPATH(i) (true)
#endif
#ifndef REP_S
#define REP_S 1
#endif
constexpr size_t WS_KFI = 932 * MiB, WS_KFA = 940 * MiB, WS_VF = 948 * MiB;

__device__ __forceinline__ void ph_dsa_a2_unit(Ctx& C, int b, int t0) {
    LAS unsigned* cnt = (LAS unsigned*)(C.lds + 131072);
    const bf16* PROJ = (const bf16*)(C.ws + WS_P); unsigned* SEL = (unsigned*)(C.ws + WS_SEL); const bf16* KFI = (const bf16*)(C.ws + WS_KFI);
    const int lane = C.lane, n = lane & 31, h = lane >> 5, tid = C.tid, wave = C.wave;
    const int nk = t0 + 8, ntile = (nk + 31) >> 5;
    if (tid < 48) cnt[tid] = 0u;
    unsigned u[16][4];
    {
        bf16x8 af[2][4]; float wv[2][2][8];
        const int jq = 2 * ((n >> 4) & 1) + ((n >> 2) & 1), hd = 4 * ((n >> 3) & 1) + (n & 3);
#pragma unroll
        for (int mt = 0; mt < 2; ++mt) {
            const bf16* p = PROJ + (size_t)(b * SEQ + t0 + 4 * mt + jq) * PW + C_IQ + hd * 64 + 8 * h;
#pragma unroll
            for (int ks = 0; ks < 4; ++ks) af[mt][ks] = *(const bf16x8*)(p + ks * 16);
#pragma unroll
            for (int g = 0; g < 2; ++g) {
                const v4u w4 = *(const v4u*)(PROJ + (size_t)(b * SEQ + t0 + 4 * mt + 2 * g + h) * PW + C_IW); const unsigned ww[4] = {w4.x, w4.y, w4.z, w4.w};
#pragma unroll
                for (int x = 0; x < 4; ++x) { wv[mt][g][2 * x] = bf2f(ww[x] & 0xffffu) * (0.35355339059327373f * 0.125f); wv[mt][g][2 * x + 1] = bf2f(ww[x] >> 16) * (0.35355339059327373f * 0.125f); }
            }
        }
        const bf16* kbase = KFI + (size_t)(b * 128) * 2048 + lane * 8;
#pragma unroll
        for (int i = 0; i < 16; ++i) {
            const int tile = wave + 8 * i;
#pragma unroll
            for (int k = 0; k < 4; ++k) u[i][k] = 0u;
            if (tile < ntile) {
                bf16x8 bcur[4];
#pragma unroll
                for (int ks = 0; ks < 4; ++ks) bcur[ks] = *(const bf16x8*)(kbase + (size_t)tile * 2048 + ks * 512);
                const int s = tile * 32 + n;
#pragma unroll
                for (int mt = 0; mt < 2; ++mt) {
                    f32x16 acc;
#pragma unroll
                    for (int x = 0; x < 16; ++x) acc[x] = 0.f;
#pragma unroll
                    for (int ks = 0; ks < 4; ++ks) acc = mfma32(af[mt][ks], bcur[ks], acc);
#pragma unroll
                    for (int g = 0; g < 2; ++g) {
                        float p = 0.f;
#pragma unroll
                        for (int x = 0; x < 8; ++x) p += wv[mt][g][x] * fmaxf(acc[8 * g + x], 0.f);
                        const int t = t0 + 4 * mt + 2 * g + h;
                        u[i][2 * mt + g] = (s <= t) ? sortable_u32(p) : 0u;
                    }
                }
            }
            __builtin_amdgcn_sched_barrier(0);
        }
    }
    __syncthreads();
    unsigned Tl[4], Jl[4], needl[4];
#pragma unroll
    for (int k = 0; k < 4; ++k) { Tl[k] = 0u; Jl[k] = 8192u; needl[k] = 0u; }
    int buf = 0;
#define DSA_COUNT(PRED) \
        _Pragma("unroll") for (int i = 0; i < 16; ++i) if (wave + 8 * i < ntile) { const unsigned s = (unsigned)((wave + 8 * i) * 32 + n); (void)s; \
            _Pragma("unroll") for (int k = 0; k < 4; ++k) { const unsigned uu = u[i][k]; const unsigned long long bm = __ballot(PRED); cq[2 * k] += (unsigned)__popc((unsigned)bm); cq[2 * k + 1] += (unsigned)__popc((unsigned)(bm >> 32)); } __builtin_amdgcn_sched_barrier(0); }
#define DSA_PUBLISH(NW) { unsigned myc = 0u; \
        _Pragma("unroll") for (int q = 0; q < NW; ++q) myc = (lane == q) ? cq[q] : myc; \
        if (lane < NW) __hip_atomic_fetch_add(cnt + buf * 16 + lane, myc, __ATOMIC_RELAXED, __HIP_MEMORY_SCOPE_WORKGROUP); \
        nb = (buf == 2) ? 0 : buf + 1; if (tid >= 64 && tid < 80) cnt[nb * 16 + (tid - 64)] = 0u; __syncthreads(); }
#pragma unroll 1
    for (int bit = 31; bit >= 0; --bit) {
        unsigned cq[8]; int nb;
#pragma unroll
        for (int q = 0; q < 8; ++q) cq[q] = 0u;
        unsigned cl[4];
#pragma unroll
        for (int k = 0; k < 4; ++k) cl[k] = Tl[k] | (1u << bit);
        DSA_COUNT(uu >= cl[k])
        DSA_PUBLISH(8)
#pragma unroll
        for (int k = 0; k < 4; ++k) if (cnt[buf * 16 + 2 * k + h] >= 256u) Tl[k] = cl[k];
        buf = nb;
    }
#pragma unroll
    for (int k = 0; k < 4; ++k) Tl[k] = Tl[k] < 1u ? 1u : Tl[k];
    bool extra = false;
    {
        unsigned cq[16]; int nb;
#pragma unroll
        for (int q = 0; q < 16; ++q) cq[q] = 0u;
#pragma unroll
        for (int i = 0; i < 16; ++i) if (wave + 8 * i < ntile) {
#pragma unroll
            for (int k = 0; k < 4; ++k) { const unsigned uu = u[i][k];
                const unsigned long long bg = __ballot(uu > Tl[k]), be = __ballot(uu >= Tl[k]);
                cq[2 * k] += (unsigned)__popc((unsigned)bg); cq[2 * k + 1] += (unsigned)__popc((unsigned)(bg >> 32));
                cq[8 + 2 * k] += (unsigned)__popc((unsigned)be); cq[8 + 2 * k + 1] += (unsigned)__popc((unsigned)(be >> 32)); }
            __builtin_amdgcn_sched_barrier(0);
        }
        DSA_PUBLISH(16)
#pragma unroll
        for (int k = 0; k < 4; ++k) { const unsigned g = cnt[buf * 16 + 2 * k + h]; needl[k] = 256u - (g < 256u ? g : 256u); }
#pragma unroll
        for (int q = 0; q < 8; ++q) extra = extra || (cnt[buf * 16 + 8 + q] > 256u);
        buf = nb;
    }
    if (extra) {
#pragma unroll
        for (int k = 0; k < 4; ++k) Jl[k] = 0u;
#pragma unroll 1
        for (int bit = 12; bit >= 0; --bit) {
            unsigned cq[8]; int nb;
#pragma unroll
            for (int q = 0; q < 8; ++q) cq[q] = 0u;
            unsigned jl[4];
#pragma unroll
            for (int k = 0; k < 4; ++k) jl[k] = Jl[k] | (1u << bit);
            DSA_COUNT(uu == Tl[k] && s < jl[k])
            DSA_PUBLISH(8)
#pragma unroll
            for (int k = 0; k < 4; ++k) if (cnt[buf * 16 + 2 * k + h] <= needl[k]) Jl[k] = jl[k];
            buf = nb;
        }
    }
    {
        unsigned wsel[4];
#pragma unroll
        for (int k = 0; k < 4; ++k) wsel[k] = 0u;
#pragma unroll
        for (int i = 0; i < 16; ++i) if (wave + 8 * i < ntile) {
            const unsigned s = (unsigned)((wave + 8 * i) * 32 + n);
#pragma unroll
            for (int k = 0; k < 4; ++k) {
                const unsigned uu = u[i][k];
                const unsigned long long bm = __ballot((uu > Tl[k]) || (uu == Tl[k] && s < Jl[k]));
                const unsigned wd = h ? (unsigned)(bm >> 32) : (unsigned)bm;
                wsel[k] = (n == i) ? wd : wsel[k];
            }
            __builtin_amdgcn_sched_barrier(0);
        }
        const int tile = wave + 8 * n;
        if (n < 16 && tile < ntile) {
#pragma unroll
            for (int k = 0; k < 4; ++k) SEL[(size_t)(b * SEQ + t0 + 2 * k + h) * 128 + tile] = wsel[k];
        }
    }
#undef DSA_COUNT
#undef DSA_PUBLISH
    __syncthreads();
}


constexpr int A3_QP = 64 * 68;
struct A3Q { bf16x8 af[2][4]; v4u wq; };
__device__ __forceinline__ void a3_load_q(Ctx& C, int b, int t0, A3Q& Q) {
    const bf16* PROJ = (const bf16*)(C.ws + WS_P);
    const int n = C.lane & 31, h = C.lane >> 5;
    const int jq = 2 * ((n >> 4) & 1) + ((n >> 2) & 1), hd = 4 * ((n >> 3) & 1) + (n & 3);
#pragma unroll
    for (int mt = 0; mt < 2; ++mt) {
        const bf16* p = PROJ + (size_t)(b * SEQ + t0 + 4 * mt + jq) * PW + C_IQ + hd * 64 + 8 * h;
#pragma unroll
        for (int ks = 0; ks < 4; ++ks) Q.af[mt][ks] = *(const bf16x8*)(p + ks * 16);
    }
    Q.wq = *(const v4u*)(PROJ + (size_t)(b * SEQ + t0 + (n & 7)) * PW + C_IW);
}
__device__ __forceinline__ void ph_dsa_a3_unit(Ctx& C, int b, int t0, A3Q& Q, bool has_next, int nb, int nt0) {
    LAS unsigned* sc = (LAS unsigned*)C.lds;
    const bf16* PROJ = (const bf16*)(C.ws + WS_P); unsigned* SEL = (unsigned*)(C.ws + WS_SEL); const bf16* KFI = (const bf16*)(C.ws + WS_KFI);
    const int lane = C.lane, n = lane & 31, h = lane >> 5, wave = C.wave;
    const int nk = t0 + 8, ntile = (nk + 31) >> 5;
    {
        typedef _Float16 h8_t __attribute__((ext_vector_type(8)));
        typedef _Float16 h2_t __attribute__((ext_vector_type(2)));
        h8_t wf[2][2];
        {
            const unsigned ww[4] = {Q.wq.x, Q.wq.y, Q.wq.z, Q.wq.w}; unsigned wp[4];
#pragma unroll
            for (int x = 0; x < 4; ++x) wp[x] = __builtin_bit_cast(unsigned, __builtin_amdgcn_cvt_pkrtz(bf2f(ww[x] & 0xffffu) * (0.35355339059327373f * 0.125f), bf2f(ww[x] >> 16) * (0.35355339059327373f * 0.125f)));
#pragma unroll
            for (int mt = 0; mt < 2; ++mt)
#pragma unroll
                for (int ks = 0; ks < 2; ++ks) { const bool on = (n < 8) && ((n >> 2) == mt) && ((n & 3) == 2 * ks + h);
                    v4u f; f.x = on ? wp[0] : 0u; f.y = on ? wp[1] : 0u; f.z = on ? wp[2] : 0u; f.w = on ? wp[3] : 0u; wf[mt][ks] = __builtin_bit_cast(h8_t, f); }
        }
        const bf16* kbase = KFI + (size_t)(b * 128) * 2048 + lane * 8;
        bf16x8 kA[4], kB[4];
        { const int ta = wave < ntile ? wave : 0, tb = wave + 8 < ntile ? wave + 8 : ta;
#pragma unroll
          for (int ks = 0; ks < 4; ++ks) { kA[ks] = *(const bf16x8*)(kbase + (size_t)ta * 2048 + ks * 512); kB[ks] = *(const bf16x8*)(kbase + (size_t)tb * 2048 + ks * 512); } }
#define A3_MMA(A0, A1, KF) { const f32x16 z16_ = {0.f, 0.f, 0.f, 0.f, 0.f, 0.f, 0.f, 0.f, 0.f, 0.f, 0.f, 0.f, 0.f, 0.f, 0.f, 0.f}; \
            A0 = mfma32(Q.af[0][0], KF[0], z16_); A1 = mfma32(Q.af[1][0], KF[0], z16_); \
            _Pragma("unroll") for (int ks = 1; ks < 4; ++ks) { A0 = mfma32(Q.af[0][ks], KF[ks], A0); A1 = mfma32(Q.af[1][ks], KF[ks], A1); } }
#define A3_RELU4(A, r0_) ({ v4u f_; const h2_t z2_ = {(_Float16)0.f, (_Float16)0.f}; \
                f_.x = __builtin_bit_cast(unsigned, __builtin_elementwise_max(__builtin_bit_cast(h2_t, __builtin_amdgcn_cvt_pkrtz(A[(r0_)], A[(r0_) + 1])), z2_)); \
                f_.y = __builtin_bit_cast(unsigned, __builtin_elementwise_max(__builtin_bit_cast(h2_t, __builtin_amdgcn_cvt_pkrtz(A[(r0_) + 2], A[(r0_) + 3])), z2_)); \
                f_.z = __builtin_bit_cast(unsigned, __builtin_elementwise_max(__builtin_bit_cast(h2_t, __builtin_amdgcn_cvt_pkrtz(A[(r0_) + 4], A[(r0_) + 5])), z2_)); \
                f_.w = __builtin_bit_cast(unsigned, __builtin_elementwise_max(__builtin_bit_cast(h2_t, __builtin_amdgcn_cvt_pkrtz(A[(r0_) + 6], A[(r0_) + 7])), z2_)); \
                __builtin_bit_cast(h8_t, f_); })
#define A3_EPI(A0, A1, tile_) { const int s = (tile_) * 32 + n; const f32x16 z16e_ = {0.f, 0.f, 0.f, 0.f, 0.f, 0.f, 0.f, 0.f, 0.f, 0.f, 0.f, 0.f, 0.f, 0.f, 0.f, 0.f}; \
            f32x16 P_ = __builtin_amdgcn_mfma_f32_32x32x16_f16(wf[0][0], A3_RELU4(A0, 0), z16e_, 0, 0, 0); P_ = __builtin_amdgcn_mfma_f32_32x32x16_f16(wf[0][1], A3_RELU4(A0, 8), P_, 0, 0, 0); \
            P_ = __builtin_amdgcn_mfma_f32_32x32x16_f16(wf[1][0], A3_RELU4(A1, 0), P_, 0, 0, 0); P_ = __builtin_amdgcn_mfma_f32_32x32x16_f16(wf[1][1], A3_RELU4(A1, 8), P_, 0, 0, 0); \
              \
            _Pragma("unroll") for (int r = 0; r < 4; ++r) { const int q = r + 4 * h; sc[q * A3_QP + (s >> 6) * 68 + (s & 63)] = (s <= t0 + q) ? sortable_u32(P_[r]) : 0u; } }
#define A3_LOADK(KF, tile_) { const int tl_ = ((tile_) < ntile) ? (tile_) : wave; \
            _Pragma("unroll") for (int ks = 0; ks < 4; ++ks) KF[ks] = *(const bf16x8*)(kbase + (size_t)tl_ * 2048 + ks * 512); }
        f32x16 accA0, accA1, accB0, accB1;
        if (wave < ntile) { A3_MMA(accA0, accA1, kA) A3_LOADK(kA, wave + 16) }
#pragma unroll 1
        for (int tile = wave; tile < ntile; tile += 16) {
            if (tile + 8 < ntile) { A3_MMA(accB0, accB1, kB) A3_LOADK(kB, tile + 24) }
            A3_EPI(accA0, accA1, tile)
            if (tile + 8 < ntile) {
                if (tile + 16 < ntile) { A3_MMA(accA0, accA1, kA) A3_LOADK(kA, tile + 32) }
                A3_EPI(accB0, accB1, tile + 8)
            }
        }
#undef A3_LOADK
#undef A3_RELU4
#undef A3_MMA
#undef A3_EPI
    }
    __syncthreads();
    {
        const int q = wave, t = t0 + q;
        const int nval = t + 1 - 64 * lane;
        const unsigned long long vm = nval >= 64 ? ~0ull : (nval > 0 ? ((1ull << nval) - 1ull) : 0ull);
        unsigned long long selm = vm;
        if (t >= 256) {
            unsigned lo[32], hi[32];
            {
                const LAS v4u* gp = (const LAS v4u*)(sc + q * A3_QP + lane * 68);
#pragma unroll
                for (int i = 0; i < 8; ++i) { const v4u a = gp[i], c = gp[8 + i]; lo[4 * i] = a.x; lo[4 * i + 1] = a.y; lo[4 * i + 2] = a.z; lo[4 * i + 3] = a.w; hi[4 * i] = c.x; hi[4 * i + 1] = c.y; hi[4 * i + 2] = c.z; hi[4 * i + 3] = c.w; }
            }
#define A3_TR(X) { \
            _Pragma("unroll") for (int k = 0; k < 32; ++k) if ((k & 16) == 0) { const unsigned a = X[k], c = X[k + 16]; X[k] = __builtin_amdgcn_perm(c, a, 0x05040100u); X[k + 16] = __builtin_amdgcn_perm(c, a, 0x07060302u); } \
            _Pragma("unroll") for (int k = 0; k < 32; ++k) if ((k & 8) == 0) { const unsigned a = X[k], c = X[k + 8]; X[k] = __builtin_amdgcn_perm(c, a, 0x06020400u); X[k + 8] = __builtin_amdgcn_perm(c, a, 0x07030501u); } \
            _Pragma("unroll") for (int st = 2; st < 5; ++st) { const int j = 16 >> st; const unsigned m = st == 2 ? 0x0f0f0f0fu : st == 3 ? 0x33333333u : 0x55555555u; \
                _Pragma("unroll") for (int k = 0; k < 32; ++k) if ((k & j) == 0) { const unsigned a = X[k], c = X[k + j]; X[k] = (a & m) | ((c << j) & ~m); X[k + j] = ((a >> j) & m) | (c & ~m); } } }
            A3_TR(lo) A3_TR(hi)
#undef A3_TR
            unsigned al = (unsigned)vm, ah = (unsigned)(vm >> 32), gl = 0u, gh = 0u, G = 0u;
            bool done = false;
#pragma unroll
            for (int b = 31; b >= 0; --b) {
                if (!done) {
                    const unsigned ol = al & lo[b], oh = ah & hi[b];
                    const unsigned c = G + wave_sum_u32((unsigned)__popc(ol) + (unsigned)__popc(oh));
                    if (c >= 256u) { al = ol; ah = oh; done = (c == 256u); }
                    else { gl |= ol; gh |= oh; G = c; al ^= ol; ah ^= oh; }
                }
            }
            const unsigned ca = (unsigned)__popc(al) + (unsigned)__popc(ah);
            const unsigned tot = wave_sum_u32(ca);
            unsigned long long alive = ((unsigned long long)ah << 32) | al;
            if (G + tot > 256u) {
                int incl = (int)ca;
#pragma unroll
                for (int o = 1; o < 64; o <<= 1) { const int v = SHUP_I(incl, o, lane); if (lane >= o) incl += v; }
                const int before = incl - (int)ca, room = (int)(256u - G) - before;
                int take = room < 0 ? 0 : (room > (int)ca ? (int)ca : room);
                unsigned long long keep = 0ull;
                while (__any(take > 0)) { if (take > 0) { const unsigned long long low = alive & (0ull - alive); keep |= low; alive ^= low; --take; } }
                alive = keep;
            }
            selm = (((unsigned long long)gh << 32) | gl) | alive;
        }
        if (has_next) a3_load_q(C, nb, nt0, Q);
#ifdef SEL_ALL
        *(unsigned long long*)(SEL + (size_t)(b * SEQ + t) * 128 + 2 * lane) = selm;
#else
        if (64 * lane <= t) *(unsigned long long*)(SEL + (size_t)(b * SEQ + t) * 128 + 2 * lane) = selm;
#endif
    }
    __syncthreads();
}

constexpr int A4_BUF = 4 * A3_QP;
#ifdef PROBE_HOT
#define A4_TMASK(x) ((x) & C.hot)
#else
#define A4_TMASK(x) (x)
#endif
constexpr int A4_R = 4;
struct A4S { bf16x8 af[4]; v4u wq; bf16x8 k[A4_R][4]; };
__device__ __forceinline__ int a4_cnt(int t0, int sw) { const int ntile = (t0 + 4 + 31) >> 5; return (t0 + 3 < 256 || sw >= ntile) ? 0 : (ntile - sw + 3) >> 2; }
__device__ __forceinline__ void a4_prefetch(Ctx& C, A4S& S, int b, int t0) {
    const bf16* PROJ = (const bf16*)(C.ws + WS_P); const bf16* KFI = (const bf16*)(C.ws + WS_KFI);
    const int lane = C.lane, n = lane & 31, h = lane >> 5, sw = C.wave;
    const int cnt = a4_cnt(t0, sw);
    {
        const int jq = 2 * ((n >> 4) & 1) + ((n >> 2) & 1), hd = 4 * ((n >> 3) & 1) + (n & 3);
        const bf16* p = PROJ + (size_t)(b * SEQ + t0 + jq) * PW + C_IQ + hd * 64 + 8 * h;
#pragma unroll
        for (int ks = 0; ks < 4; ++ks) S.af[ks] = *(const bf16x8*)(p + ks * 16);
        const int qsel = (n & 1) + 2 * ((n >> 2) & 1);
        S.wq = *(const v4u*)(PROJ + (size_t)(b * SEQ + t0 + qsel) * PW + C_IW);
    }
    const bf16* kbase = KFI + (size_t)(b * 128) * 2048 + lane * 8;
#pragma unroll
    for (int j = 0; j < A4_R; ++j) { const int tl = j < cnt ? sw + 4 * j : 0;
#pragma unroll
        for (int ks = 0; ks < 4; ++ks) S.k[j][ks] = *(const bf16x8*)(kbase + (size_t)A4_TMASK(tl) * 2048 + ks * 512);
    }
}
__device__ __forceinline__ void a4_score(Ctx& C, A4S& S, LAS unsigned* sc, int b, int t0, int nb, int nt0) {
    const bf16* KFI = (const bf16*)(C.ws + WS_KFI); const bf16* PROJ = (const bf16*)(C.ws + WS_P);
    const int lane = C.lane, n = lane & 31, h = lane >> 5, sw = C.wave;
    const int cnt = a4_cnt(t0, sw);
    bf16x8 naf[4]; v4u nwq;
    {
        const int jq = 2 * ((n >> 4) & 1) + ((n >> 2) & 1), hd = 4 * ((n >> 3) & 1) + (n & 3);
        const bf16* p = PROJ + (size_t)(nb * SEQ + nt0 + jq) * PW + C_IQ + hd * 64 + 8 * h;
#pragma unroll
        for (int ks = 0; ks < 4; ++ks) naf[ks] = *(const bf16x8*)(p + ks * 16);
        const int qsel = (n & 1) + 2 * ((n >> 2) & 1);
        nwq = *(const v4u*)(PROJ + (size_t)(nb * SEQ + nt0 + qsel) * PW + C_IW);
    }
    const int ncnt = a4_cnt(nt0, sw);
    const bf16* nkbase = KFI + (size_t)(nb * 128) * 2048 + lane * 8;
    typedef _Float16 h8_t __attribute__((ext_vector_type(8)));
    typedef _Float16 h2_t __attribute__((ext_vector_type(2)));
    h8_t wf[2];
    {
        const unsigned ww[4] = {S.wq.x, S.wq.y, S.wq.z, S.wq.w}; unsigned wp[4];
#pragma unroll
        for (int x = 0; x < 4; ++x) wp[x] = __builtin_bit_cast(unsigned, __builtin_amdgcn_cvt_pkrtz(bf2f(ww[x] & 0xffffu) * (0.35355339059327373f * 0.125f), bf2f(ww[x] >> 16) * (0.35355339059327373f * 0.125f)));
        const bool rowok = (n == 0) || (n == 1) || (n == 4) || (n == 5); const int qrow = (n & 1) + 2 * (n >> 2);
#pragma unroll
        for (int ks = 0; ks < 2; ++ks) { const bool on = rowok && (qrow == 2 * ks + h);
            v4u f; f.x = on ? wp[0] : 0u; f.y = on ? wp[1] : 0u; f.z = on ? wp[2] : 0u; f.w = on ? wp[3] : 0u; wf[ks] = __builtin_bit_cast(h8_t, f); }
    }
    const bf16* kbase = KFI + (size_t)(b * 128) * 2048 + lane * 8;
#define A4_MMA(A, KF) { const f32x16 z16_ = {0.f, 0.f, 0.f, 0.f, 0.f, 0.f, 0.f, 0.f, 0.f, 0.f, 0.f, 0.f, 0.f, 0.f, 0.f, 0.f}; \
        A = mfma32(S.af[0], KF[0], z16_); _Pragma("unroll") for (int ks = 1; ks < 4; ++ks) A = mfma32(S.af[ks], KF[ks], A); }
#define A4_RELU4(A, r0_) ({ v4u f_; const h2_t z2_ = {(_Float16)0.f, (_Float16)0.f}; \
            f_.x = __builtin_bit_cast(unsigned, __builtin_elementwise_max(__builtin_bit_cast(h2_t, __builtin_amdgcn_cvt_pkrtz(A[(r0_)], A[(r0_) + 1])), z2_)); \
            f_.y = __builtin_bit_cast(unsigned, __builtin_elementwise_max(__builtin_bit_cast(h2_t, __builtin_amdgcn_cvt_pkrtz(A[(r0_) + 2], A[(r0_) + 3])), z2_)); \
            f_.z = __builtin_bit_cast(unsigned, __builtin_elementwise_max(__builtin_bit_cast(h2_t, __builtin_amdgcn_cvt_pkrtz(A[(r0_) + 4], A[(r0_) + 5])), z2_)); \
            f_.w = __builtin_bit_cast(unsigned, __builtin_elementwise_max(__builtin_bit_cast(h2_t, __builtin_amdgcn_cvt_pkrtz(A[(r0_) + 6], A[(r0_) + 7])), z2_)); \
            __builtin_bit_cast(h8_t, f_); })
#define A4_EPI(A, i_) { const int s = (sw + 4 * (i_)) * 32 + n; const f32x16 z16e_ = {0.f, 0.f, 0.f, 0.f, 0.f, 0.f, 0.f, 0.f, 0.f, 0.f, 0.f, 0.f, 0.f, 0.f, 0.f, 0.f}; \
        f32x16 P_ = __builtin_amdgcn_mfma_f32_32x32x16_f16(wf[0], A4_RELU4(A, 0), z16e_, 0, 0, 0); P_ = __builtin_amdgcn_mfma_f32_32x32x16_f16(wf[1], A4_RELU4(A, 8), P_, 0, 0, 0); \
          \
          \
        _Pragma("unroll") for (int r = 0; r < 2; ++r) { const int q = 2 * h + r; const unsigned u_ = __float_as_uint(P_[r]); sc[q * A3_QP + (s >> 6) * 68 + (s & 63)] = u_ ^ ((unsigned)((int)u_ >> 31) | 0x80000000u); } }
#define A4_LOADK(KF, i_) { const int il_ = ((i_) < cnt) ? (i_) : 0; _Pragma("unroll") for (int ks = 0; ks < 4; ++ks) KF[ks] = *(const bf16x8*)(kbase + (size_t)A4_TMASK(sw + 4 * il_) * 2048 + ks * 512); }
    f32x16 acc0, acc1;
    int i0 = 0;
#pragma unroll 1
    for (; i0 + 4 < cnt; i0 += 4) {
        A4_MMA(acc0, S.k[0]) A4_LOADK(S.k[0], i0 + 4)
        A4_MMA(acc1, S.k[1]) A4_LOADK(S.k[1], i0 + 5)
        A4_EPI(acc0, i0)
        A4_MMA(acc0, S.k[2]) A4_LOADK(S.k[2], i0 + 6)
        A4_EPI(acc1, i0 + 1)
        A4_MMA(acc1, S.k[3]) A4_LOADK(S.k[3], i0 + 7)
        A4_EPI(acc0, i0 + 2)
        A4_EPI(acc1, i0 + 3)
    }
#define A4_LOADN(KF, j_) { const int tl_ = ((j_) < ncnt) ? sw + 4 * (j_) : 0; _Pragma("unroll") for (int ks = 0; ks < 4; ++ks) KF[ks] = *(const bf16x8*)(nkbase + (size_t)A4_TMASK(tl_) * 2048 + ks * 512); }
    if (i0 < cnt) { A4_MMA(acc0, S.k[0]) }
    A4_LOADN(S.k[0], 0)
    if (i0 + 1 < cnt) { A4_MMA(acc1, S.k[1]) }
    A4_LOADN(S.k[1], 1)
    if (i0 < cnt) A4_EPI(acc0, i0)
    if (i0 + 2 < cnt) { A4_MMA(acc0, S.k[2]) }
    A4_LOADN(S.k[2], 2)
    if (i0 + 1 < cnt) A4_EPI(acc1, i0 + 1)
    if (i0 + 3 < cnt) { A4_MMA(acc1, S.k[3]) }
    A4_LOADN(S.k[3], 3)
    if (i0 + 2 < cnt) A4_EPI(acc0, i0 + 2)
    if (i0 + 3 < cnt) A4_EPI(acc1, i0 + 3)
#undef A4_LOADN
#pragma unroll
    for (int ks = 0; ks < 4; ++ks) S.af[ks] = naf[ks];
    S.wq = nwq;
#undef A4_LOADK
#undef A4_RELU4
#undef A4_MMA
#undef A4_EPI
}
__device__ __forceinline__ void a4_select(Ctx& C, const LAS unsigned* scq, int b, int t) {
    unsigned* SEL = (unsigned*)(C.ws + WS_SEL);
    const int lane = C.lane;
    const int nval = t + 1 - 64 * lane;
    const unsigned long long vm = nval >= 64 ? ~0ull : (nval > 0 ? ((1ull << nval) - 1ull) : 0ull);
    unsigned long long selm = vm;
    if (t >= 256) {
        unsigned lo[32], hi[32];
        {
            const LAS v4u* gp = (const LAS v4u*)(scq + lane * 68);
#pragma unroll
            for (int i = 0; i < 8; ++i) { const v4u a = gp[i], c = gp[8 + i]; lo[4 * i] = a.x; lo[4 * i + 1] = a.y; lo[4 * i + 2] = a.z; lo[4 * i + 3] = a.w; hi[4 * i] = c.x; hi[4 * i + 1] = c.y; hi[4 * i + 2] = c.z; hi[4 * i + 3] = c.w; }
        }
#define A3_TR(X) { \
        _Pragma("unroll") for (int k = 0; k < 32; ++k) if ((k & 16) == 0) { const unsigned a = X[k], c = X[k + 16]; X[k] = __builtin_amdgcn_perm(c, a, 0x05040100u); X[k + 16] = __builtin_amdgcn_perm(c, a, 0x07060302u); } \
        _Pragma("unroll") for (int k = 0; k < 32; ++k) if ((k & 8) == 0) { const unsigned a = X[k], c = X[k + 8]; X[k] = __builtin_amdgcn_perm(c, a, 0x06020400u); X[k + 8] = __builtin_amdgcn_perm(c, a, 0x07030501u); } \
        _Pragma("unroll") for (int st = 2; st < 5; ++st) { const int j = 16 >> st; const unsigned m = st == 2 ? 0x0f0f0f0fu : st == 3 ? 0x33333333u : 0x55555555u; \
            _Pragma("unroll") for (int k = 0; k < 32; ++k) if ((k & j) == 0) { const unsigned a = X[k], c = X[k + j]; X[k] = (a & m) | ((c << j) & ~m); X[k + j] = ((a >> j) & m) | (c & ~m); } } }
        A3_TR(lo) A3_TR(hi)
#undef A3_TR
        unsigned al = (unsigned)vm, ah = (unsigned)(vm >> 32), gl = 0u, gh = 0u, G = 0u;
        bool done = false;
#pragma unroll
        for (int bb = 31; bb >= 1; bb -= 2) {
            if (!done) {
                const unsigned o1l = al & lo[bb], o1h = ah & hi[bb];
                const unsigned o11l = o1l & lo[bb - 1], o11h = o1h & hi[bb - 1];
                const unsigned o01l = (al ^ o1l) & lo[bb - 1], o01h = (ah ^ o1h) & hi[bb - 1];
                unsigned x1 = (unsigned)__popc(o1l) + (unsigned)__popc(o1h), x11 = (unsigned)__popc(o11l) + (unsigned)__popc(o11h), x01 = (unsigned)__popc(o01l) + (unsigned)__popc(o01h);
                x1 += DPP_U32(x1, 0xB1); x11 += DPP_U32(x11, 0xB1); x01 += DPP_U32(x01, 0xB1);
                x1 += DPP_U32(x1, 0x4E); x11 += DPP_U32(x11, 0x4E); x01 += DPP_U32(x01, 0x4E);
                x1 += DPP_U32(x1, 0x124); x11 += DPP_U32(x11, 0x124); x01 += DPP_U32(x01, 0x124);
                x1 += DPP_U32(x1, 0x128); x11 += DPP_U32(x11, 0x128); x01 += DPP_U32(x01, 0x128);
                x1 += (unsigned)__builtin_amdgcn_update_dpp(0, (int)x1, 0x142, 0xA, 0xF, false); x11 += (unsigned)__builtin_amdgcn_update_dpp(0, (int)x11, 0x142, 0xA, 0xF, false); x01 += (unsigned)__builtin_amdgcn_update_dpp(0, (int)x01, 0x142, 0xA, 0xF, false);
                x1 += (unsigned)__builtin_amdgcn_update_dpp(0, (int)x1, 0x143, 0xC, 0xF, false); x11 += (unsigned)__builtin_amdgcn_update_dpp(0, (int)x11, 0x143, 0xC, 0xF, false); x01 += (unsigned)__builtin_amdgcn_update_dpp(0, (int)x01, 0x143, 0xC, 0xF, false);
                const unsigned c1 = G + (unsigned)__builtin_amdgcn_readlane((int)x1, 63), n11 = (unsigned)__builtin_amdgcn_readlane((int)x11, 63), n01 = (unsigned)__builtin_amdgcn_readlane((int)x01, 63);
                if (c1 >= 256u) {
                    al = o1l; ah = o1h;
                    if (c1 == 256u) done = true;
                    else {
                        const unsigned c = G + n11;
                        if (c >= 256u) { al = o11l; ah = o11h; done = (c == 256u); }
                        else { gl |= o11l; gh |= o11h; G = c; al ^= o11l; ah ^= o11h; }
                    }
                } else {
                    gl |= o1l; gh |= o1h; G = c1; al ^= o1l; ah ^= o1h;
                    const unsigned c = G + n01;
                    if (c >= 256u) { al = o01l; ah = o01h; done = (c == 256u); }
                    else { gl |= o01l; gh |= o01h; G = c; al ^= o01l; ah ^= o01h; }
                }
            }
        }
        const unsigned ca = (unsigned)__popc(al) + (unsigned)__popc(ah);
        const unsigned tot = wave_sum_u32(ca);
        unsigned long long alive = ((unsigned long long)ah << 32) | al;
        if (G + tot > 256u) {
            const int incl = wave_incl_scan_i((int)ca, lane);
            const int before = incl - (int)ca, room = (int)(256u - G) - before;
            int take = room < 0 ? 0 : (room > (int)ca ? (int)ca : room);
            unsigned long long keep = 0ull;
            while (__any(take > 0)) { if (take > 0) { const unsigned long long low = alive & (0ull - alive); keep |= low; alive ^= low; --take; } }
            alive = keep;
        }
        selm = (((unsigned long long)gh << 32) | gl) | alive;
    }
#if USE_LIST
    if (t >= 256) {
        LAS unsigned short* lb = (LAS unsigned short*)(C.lds + MISC_OFF + 1024) + (C.wave & 3) * 256;
        unsigned w0 = (unsigned)selm, w1 = (unsigned)(selm >> 32);
        const int c = __popc(w0) + __popc(w1); const int incl = wave_incl_scan_i(c, lane); int pos = incl - c;
        while (w0) { const int bit = __ffs(w0) - 1; w0 &= w0 - 1; if (pos < 256) lb[pos] = (unsigned short)(64 * lane + bit); ++pos; }
        while (w1) { const int bit = __ffs(w1) - 1; w1 &= w1 - 1; if (pos < 256) lb[pos] = (unsigned short)(64 * lane + 32 + bit); ++pos; }
        asm volatile("" ::: "memory");
        const v2u e = *(const LAS v2u*)(lb + 4 * lane);
        *(v2u*)((unsigned short*)SEL + (size_t)(b * SEQ + t) * 256 + 4 * lane) = e;
        asm volatile("" ::: "memory");
    }
#else
    if (64 * lane <= t) *(unsigned long long*)(SEL + (size_t)(b * SEQ + t) * 128 + 2 * lane) = selm;
#endif
}

__device__ __forceinline__ void ph_dsa_b2_wave(Ctx& C, int b, int t4) {
    const bf16* PROJ = (const bf16*)(C.ws + WS_P); const unsigned* SEL = (const unsigned*)(C.ws + WS_SEL); bf16* YM = (bf16*)(C.ws + WS_H);
    const bf16* KFA = (const bf16*)(C.ws + WS_KFA); const bf16* VF = (const bf16*)(C.ws + WS_VF);
    const int lane = C.lane, n = lane & 31, h = lane >> 5, tl = n >> 3, hd = n & 7;
    const int ntile = ((t4 + 3) >> 5) + 1;
    const size_t qrow = (size_t)b * SEQ + t4 + tl;
    bf16x8 qf[5];
    {
        const bf16* qp = PROJ + qrow * PW + C_AQ + hd * 64 + 8 * h;
#pragma unroll
        for (int ks = 0; ks < 4; ++ks) {
            const v4u q4 = *(const v4u*)(qp + 16 * ks); const unsigned qw[4] = {q4.x, q4.y, q4.z, q4.w}; v4u o;
            unsigned ow[4];
#pragma unroll
            for (int x = 0; x < 4; ++x) ow[x] = pk2(bf2f(qw[x] & 0xffffu) * (0.125f * LOG2E), bf2f(qw[x] >> 16) * (0.125f * LOG2E));
            o.x = ow[0]; o.y = ow[1]; o.z = ow[2]; o.w = ow[3]; qf[ks] = __builtin_bit_cast(bf16x8, o);
        }
        const unsigned one = 0x3f80u, sl = f2bf(exp2f(-(float)(hd + 1)));
        v4u e; e.x = (tl == 0 ? one : 0u) | ((tl == 1 ? one : 0u) << 16); e.y = (tl == 2 ? one : 0u) | ((tl == 3 ? one : 0u) << 16); e.z = sl | (sl << 16); e.w = sl;
        if (h) { e.x = 0u; e.y = 0u; e.z = 0u; e.w = 0u; }
        qf[4] = __builtin_bit_cast(bf16x8, e);
    }
    f32x16 O0, O1;
#pragma unroll
    for (int x = 0; x < 16; ++x) { O0[x] = 0.f; O1[x] = 0.f; }
    float m = -3.0e38f, lsum = 0.f;
    const unsigned NEGB = 0xf149u;
    const bf16* kb = KFA + (size_t)(b * 128) * 2048 + lane * 8; const bf16* vb = VF + (size_t)(b * 128) * 2048 + lane * 8;
    const unsigned* selp = SEL + ((size_t)b * SEQ + t4 + (lane & 3)) * 128;
    bf16x8 kc[4], vc[4]; unsigned wc_;
#pragma unroll
    for (int ks = 0; ks < 4; ++ks) { kc[ks] = *(const bf16x8*)(kb + ks * 512); vc[ks] = *(const bf16x8*)(vb + ks * 512); }
    wc_ = selp[0];
    for (int tile = 0; tile < ntile; ++tile) {
        bf16x8 kn[4], vn[4]; unsigned wn = 0u;
        const int tn = (tile + 1 < ntile) ? tile + 1 : tile;
#pragma unroll
        for (int ks = 0; ks < 4; ++ks) { kn[ks] = *(const bf16x8*)(kb + (size_t)tn * 2048 + ks * 512); vn[ks] = *(const bf16x8*)(vb + (size_t)tn * 2048 + ks * 512); }
        wn = selp[tn];
        bf16x8 kx;
        {
            const unsigned w0 = (unsigned)__builtin_amdgcn_readlane((int)wc_, 0), w1 = (unsigned)__builtin_amdgcn_readlane((int)wc_, 1), w2 = (unsigned)__builtin_amdgcn_readlane((int)wc_, 2), w3 = (unsigned)__builtin_amdgcn_readlane((int)wc_, 3);
            const unsigned m0 = ((w0 >> n) & 1u) ? 0u : NEGB, m1 = ((w1 >> n) & 1u) ? 0u : NEGB, m2 = ((w2 >> n) & 1u) ? 0u : NEGB, m3 = ((w3 >> n) & 1u) ? 0u : NEGB;
            const float cs = LOG2E * (float)(tile * 32 + n);
            const unsigned c1 = f2bf(cs); const float r1 = cs - bf2f(c1); const unsigned c2 = f2bf(r1); const float r2 = r1 - bf2f(c2); const unsigned c3 = f2bf(r2);
            v4u e; e.x = m0 | (m1 << 16); e.y = m2 | (m3 << 16); e.z = c1 | (c2 << 16); e.w = c3;
            if (h) { e.x = 0u; e.y = 0u; e.z = 0u; e.w = 0u; }
            kx = __builtin_bit_cast(bf16x8, e);
        }
        f32x16 S;
#pragma unroll
        for (int x = 0; x < 16; ++x) S[x] = 0.f;
#pragma unroll
        for (int ks = 0; ks < 4; ++ks) S = mfma32(kc[ks], qf[ks], S);
        S = mfma32(kx, qf[4], S);
        float mloc = S[0];
#pragma unroll
        for (int x = 1; x < 16; ++x) mloc = fmaxf(mloc, S[x]);
        mloc = fmaxf(mloc, __shfl_xor(mloc, 32));
        const float mnew = fmaxf(m, mloc), alpha = __builtin_amdgcn_exp2f(m - mnew);
        m = mnew;
        float ps = 0.f;
#pragma unroll
        for (int x = 0; x < 16; ++x) { S[x] = __builtin_amdgcn_exp2f(S[x] - mnew); ps += S[x]; }
        lsum = lsum * alpha + ps;
#pragma unroll
        for (int x = 0; x < 16; ++x) { O0[x] *= alpha; O1[x] *= alpha; }
        v4u p0, p1;
        p0.x = pk2(S[0], S[1]); p0.y = pk2(S[2], S[3]); p0.z = pk2(S[4], S[5]); p0.w = pk2(S[6], S[7]);
        p1.x = pk2(S[8], S[9]); p1.y = pk2(S[10], S[11]); p1.z = pk2(S[12], S[13]); p1.w = pk2(S[14], S[15]);
        const bf16x8 pf0 = __builtin_bit_cast(bf16x8, p0), pf1 = __builtin_bit_cast(bf16x8, p1);
        O0 = mfma32(vc[0], pf0, O0); O1 = mfma32(vc[1], pf0, O1);
        O0 = mfma32(vc[2], pf1, O0); O1 = mfma32(vc[3], pf1, O1);
#pragma unroll
        for (int ks = 0; ks < 4; ++ks) { kc[ks] = kn[ks]; vc[ks] = vn[ks]; }
        wc_ = wn;
    }
    const float inv = 1.f / (lsum + __shfl_xor(lsum, 32));
    bf16* yo = YM + qrow * DM + hd * 64 + 4 * h;
#pragma unroll
    for (int j4 = 0; j4 < 4; ++j4) {
        v2u o; o.x = pk2(O0[4 * j4] * inv, O0[4 * j4 + 1] * inv); o.y = pk2(O0[4 * j4 + 2] * inv, O0[4 * j4 + 3] * inv);
        *(v2u*)(yo + 8 * j4) = o;
        v2u o2; o2.x = pk2(O1[4 * j4] * inv, O1[4 * j4 + 1] * inv); o2.y = pk2(O1[4 * j4 + 2] * inv, O1[4 * j4 + 3] * inv);
        *(v2u*)(yo + 32 + 8 * j4) = o2;
    }
}

__device__ __forceinline__ f32x4 mfma16(bf16x8 a, bf16x8 b, f32x4 c) { return __builtin_amdgcn_mfma_f32_16x16x32_bf16(a, b, c, 0, 0, 0); }
constexpr int B3_VS_PITCH = 144;
constexpr int B3_WAVE_LDS = 640 + 3 * 32 * B3_VS_PITCH;
#ifdef PROBE_HOT
#define B3_SKIP(bit) ((PROBE_SKIP & (bit)) && C.hot != 0xffff)
#define B3_HOTMASK C.hot
#else
#define B3_SKIP(bit) false
#define B3_HOTMASK 0xffff
#endif
template <bool FULL>
__device__ __forceinline__ void b3_core(Ctx& C, int b, int t, int nsel, const v4u qc0, const v4u qc1, LAS unsigned short* lst, LAS unsigned char* vs) {
    const bf16* PROJ = (const bf16*)(C.ws + WS_P); bf16* YM = (bf16*)C.out;
    const int lane = C.lane, m16 = lane & 15, g = lane >> 4;
    const size_t row = (size_t)b * SEQ + t;
    const int nt16 = FULL ? 16 : (nsel + 15) >> 4, nk32 = FULL ? 8 : (nsel + 31) >> 5;
    const bf16* vbase = PROJ + (size_t)b * SEQ * PW + C_AV + 8 * (lane & 7);
    v4u vb[3][4];
#pragma unroll
    for (int i = 0; i < 4; ++i) { const int s = (int)lst[8 * i + (lane >> 3)] & B3_HOTMASK; vb[0][i] = *(const v4u*)(vbase + (size_t)s * PW); }
    bf16x8 qf[2];
#pragma unroll
    for (int ks = 0; ks < 2; ++ks) {
        const v4u q4 = ks ? qc1 : qc0; const unsigned qw[4] = {q4.x, q4.y, q4.z, q4.w}; unsigned ow[4];
#pragma unroll
        for (int x = 0; x < 4; ++x) ow[x] = (m16 < 8) ? pk2(bf2f(qw[x] & 0xffffu) * (0.125f * LOG2E), bf2f(qw[x] >> 16) * (0.125f * LOG2E)) : 0u;
        v4u o; o.x = ow[0]; o.y = ow[1]; o.z = ow[2]; o.w = ow[3]; qf[ks] = __builtin_bit_cast(bf16x8, o);
    }
    const float sl2 = exp2f(-(float)((m16 & 7) + 1)) * LOG2E, tf = (float)t;
    f32x4 lg[16];
#pragma unroll
    for (int kt = 0; kt < 16; ++kt) {
        if (FULL || kt < nt16) {
            const v2u p4 = *(const LAS v2u*)(lst + 16 * kt + 4 * g);
            const float sr[4] = {(float)(p4.x & 0xffffu), (float)(p4.x >> 16), (float)(p4.y & 0xffffu), (float)(p4.y >> 16)};
#pragma unroll
            for (int r = 0; r < 4; ++r) lg[kt][r] = (FULL || 16 * kt + 4 * g + r < nsel) ? sl2 * (sr[r] - tf) : -3.0e38f;
        } else lg[kt] = (f32x4){-3.0e38f, -3.0e38f, -3.0e38f, -3.0e38f};
    }
    {
        const bf16* kbase = PROJ + (size_t)b * SEQ * PW + C_AK + 8 * (lane & 7);
        LAS unsigned char* ksb = vs + 32 * B3_VS_PITCH;
        v4u kr[3][4];
#define B3_KLOAD(dst, kq_) { _Pragma("unroll") for (int i = 0; i < 4; ++i) { const int s = (int)lst[32 * (kq_) + 8 * i + (lane >> 3)] & B3_HOTMASK; dst[i] = *(const v4u*)(kbase + (size_t)s * PW); } }
        if (!B3_SKIP(4)) { B3_KLOAD(kr[0], 0) if (FULL || 1 < nk32) B3_KLOAD(kr[1], 1) }
#pragma unroll
        for (int kq = 0; kq < 8; ++kq) if (FULL || kq < nk32) {
            if (!B3_SKIP(4)) { if (kq + 2 < 8 && (FULL || kq + 2 < nk32)) B3_KLOAD(kr[(kq + 2) % 3], kq + 2) }
            LAS unsigned char* kim = ksb + (kq & 1) * (32 * B3_VS_PITCH);
#pragma unroll
            for (int i = 0; i < 4; ++i) *(LAS v4u*)(kim + (8 * i + (lane >> 3)) * B3_VS_PITCH + (lane & 7) * 16) = kr[kq % 3][i];
            asm volatile("" ::: "memory");
            if (!B3_SKIP(2)) {
#pragma unroll
                for (int tt = 0; tt < 2; ++tt) { const int kt = 2 * kq + tt;
                    if (FULL || kt < nt16) {
                        const LAS unsigned char* rp = kim + (16 * tt + m16) * B3_VS_PITCH + 16 * g;
                        const bf16x8 a0 = *(const LAS bf16x8*)rp, a1 = *(const LAS bf16x8*)(rp + 64);
                        lg[kt] = mfma16(a0, qf[0], lg[kt]); lg[kt] = mfma16(a1, qf[1], lg[kt]);
                    } }
            }
            asm volatile("" ::: "memory");
        }
#undef B3_KLOAD
    }
    float mx;
    {
        float m0 = -3.0e38f, m1 = -3.0e38f, m2 = -3.0e38f, m3 = -3.0e38f;
#pragma unroll
        for (int kt = 0; kt < 16; ++kt) { m0 = fmaxf(m0, lg[kt][0]); m1 = fmaxf(m1, lg[kt][1]); m2 = fmaxf(m2, lg[kt][2]); m3 = fmaxf(m3, lg[kt][3]); }
        mx = fmaxf(fmaxf(m0, m1), fmaxf(m2, m3));
    }
#pragma unroll
    for (int d = 1; d < 3; ++d) if (FULL || d < nk32) {
#pragma unroll
        for (int i = 0; i < 4; ++i) { const int s = (int)lst[32 * d + 8 * i + (lane >> 3)] & B3_HOTMASK; vb[d][i] = *(const v4u*)(vbase + (size_t)s * PW); }
    }
    mx = fmaxf(mx, SHX_F(mx, 16, lane)); mx = fmaxf(mx, SHX_F(mx, 32, lane));
    float sm_;
    {
        float s0 = 0.f, s1 = 0.f, s2 = 0.f, s3 = 0.f;
#pragma unroll
        for (int kt = 0; kt < 16; ++kt) {
            if (FULL || kt < nt16) {
                const float p0 = __builtin_amdgcn_exp2f(lg[kt][0] - mx), p1 = __builtin_amdgcn_exp2f(lg[kt][1] - mx), p2 = __builtin_amdgcn_exp2f(lg[kt][2] - mx), p3 = __builtin_amdgcn_exp2f(lg[kt][3] - mx);
                lg[kt] = (f32x4){p0, p1, p2, p3}; s0 += p0; s1 += p1; s2 += p2; s3 += p3;
            } else lg[kt] = (f32x4){0.f, 0.f, 0.f, 0.f};
        }
        sm_ = (s0 + s1) + (s2 + s3);
    }
    sm_ += SHX_F(sm_, 16, lane); sm_ += SHX_F(sm_, 32, lane);
    const float inv = 1.f / sm_;
    v4u pbk[8];
#pragma unroll
    for (int kk = 0; kk < 8; ++kk) { pbk[kk].x = pk2(lg[2 * kk][0], lg[2 * kk][1]); pbk[kk].y = pk2(lg[2 * kk][2], lg[2 * kk][3]); pbk[kk].z = pk2(lg[2 * kk + 1][0], lg[2 * kk + 1][1]); pbk[kk].w = pk2(lg[2 * kk + 1][2], lg[2 * kk + 1][3]); }
    f32x4 O[4];
#pragma unroll
    for (int i = 0; i < 4; ++i) O[i] = (f32x4){0.f, 0.f, 0.f, 0.f};
#pragma unroll
    for (int kk = 0; kk < 8; ++kk) if ((FULL || kk < nk32) && !B3_SKIP(1)) {
#pragma unroll
        for (int i = 0; i < 4; ++i) *(LAS v4u*)(vs + (8 * i + (lane >> 3)) * B3_VS_PITCH + (lane & 7) * 16) = vb[kk % 3][i];
        if (kk >= 1 && kk + 2 < 8 && (FULL || kk + 2 < nk32)) {
#pragma unroll
            for (int i = 0; i < 4; ++i) { const int s = (int)lst[32 * (kk + 2) + 8 * i + (lane >> 3)] & B3_HOTMASK; vb[(kk + 2) % 3][i] = *(const v4u*)(vbase + (size_t)s * PW); }
        }
        asm volatile("s_waitcnt lgkmcnt(0)" ::: "memory");
        const bf16x8 pB = __builtin_bit_cast(bf16x8, pbk[kk]);
#pragma unroll
        for (int u = 0; u < 2; ++u) {
            unsigned w[8];
#pragma unroll
            for (int j = 0; j < 8; ++j) { const int sl = (j < 4) ? 4 * g + j : 16 + 4 * g + (j - 4); w[j] = *(const LAS unsigned*)(vs + sl * B3_VS_PITCH + (32 * u + 2 * m16) * 2); }
            v4u ae, ao;
            ae.x = (w[0] & 0xffffu) | (w[1] << 16); ae.y = (w[2] & 0xffffu) | (w[3] << 16); ae.z = (w[4] & 0xffffu) | (w[5] << 16); ae.w = (w[6] & 0xffffu) | (w[7] << 16);
            ao.x = (w[0] >> 16) | (w[1] & 0xffff0000u); ao.y = (w[2] >> 16) | (w[3] & 0xffff0000u); ao.z = (w[4] >> 16) | (w[5] & 0xffff0000u); ao.w = (w[6] >> 16) | (w[7] & 0xffff0000u);
            O[2 * u] = mfma16(__builtin_bit_cast(bf16x8, ae), pB, O[2 * u]); O[2 * u + 1] = mfma16(__builtin_bit_cast(bf16x8, ao), pB, O[2 * u + 1]);
        }
    }
    if (m16 < 8) {
#pragma unroll
        for (int u = 0; u < 2; ++u) {
            v4u o; o.x = pk2(O[2 * u][0] * inv, O[2 * u + 1][0] * inv); o.y = pk2(O[2 * u][1] * inv, O[2 * u + 1][1] * inv); o.z = pk2(O[2 * u][2] * inv, O[2 * u + 1][2] * inv); o.w = pk2(O[2 * u][3] * inv, O[2 * u + 1][3] * inv);
            *(v4u*)(YM + row * DM + m16 * 64 + 32 * u + 8 * g) = o;
        }
    }
}
__device__ __forceinline__ void ph_dsa_b3_wave(Ctx& C, int b, int t4) {
    LAS unsigned short* lst = (LAS unsigned short*)(C.lds + C.wave * B3_WAVE_LDS);
    LAS unsigned char* vs = C.lds + C.wave * B3_WAVE_LDS + 640;
    const bf16* PROJ = (const bf16*)(C.ws + WS_P); const unsigned* SEL = (const unsigned*)(C.ws + WS_SEL);
    const int lane = C.lane, m16 = lane & 15, g = lane >> 4;
#if USE_LIST
    v2u lqn; v4u qn0, qn1;
#define B3_PREFETCH(tq) { const size_t r_ = (size_t)b * SEQ + (tq); \
        lqn = ((tq) >= 256) ? *(const v2u*)((const unsigned short*)SEL + r_ * 256 + 4 * lane) : (v2u){0u, 0u}; \
        const bf16* qp_ = PROJ + r_ * PW + C_AQ + (m16 & 7) * 64 + 8 * g; qn0 = *(const v4u*)qp_; qn1 = *(const v4u*)(qp_ + 32); }
    B3_PREFETCH(t4)
#pragma unroll 1
    for (int qi = 0; qi < 4; ++qi) {
        const int t = t4 + qi;
        v2u lq = lqn;
        const v4u qc0 = qn0, qc1 = qn1;
        if (qi < 3) B3_PREFETCH(t + 1)
        const int nsel = t < 256 ? t + 1 : 256;
        if (t < 256) { const int i0 = 4 * lane; lq.x = (unsigned)(i0 <= t ? i0 : 0) | ((unsigned)(i0 + 1 <= t ? i0 + 1 : 0) << 16); lq.y = (unsigned)(i0 + 2 <= t ? i0 + 2 : 0) | ((unsigned)(i0 + 3 <= t ? i0 + 3 : 0) << 16); }
        *(LAS v2u*)(lst + 4 * lane) = lq;
        if (lane < 16) *(LAS unsigned*)(lst + 256 + 2 * lane) = 0u;
        asm volatile("s_waitcnt lgkmcnt(0)" ::: "memory");
        if (nsel == 256) b3_core<true>(C, b, t, nsel, qc0, qc1, lst, vs); else b3_core<false>(C, b, t, nsel, qc0, qc1, lst, vs);
    }
#undef B3_PREFETCH
#else
    unsigned w0n, w1n; v4u qn0, qn1;
#define B3_PREFETCH(tq) { const size_t r_ = (size_t)b * SEQ + (tq); const int nw_ = ((tq) >> 5) + 1; \
        w0n = (2 * lane < nw_) ? SEL[r_ * 128 + 2 * lane] : 0u; w1n = (2 * lane + 1 < nw_) ? SEL[r_ * 128 + 2 * lane + 1] : 0u; \
        const bf16* qp_ = PROJ + r_ * PW + C_AQ + (m16 & 7) * 64 + 8 * g; qn0 = *(const v4u*)qp_; qn1 = *(const v4u*)(qp_ + 32); }
    B3_PREFETCH(t4)
#pragma unroll 1
    for (int qi = 0; qi < 4; ++qi) {
        const int t = t4 + qi;
        unsigned w0 = w0n, w1 = w1n;
        const v4u qc0 = qn0, qc1 = qn1;
        if (qi < 3) B3_PREFETCH(t + 1)
        int nsel;
        {
            const int c = __popc(w0) + __popc(w1); const int incl = wave_incl_scan_i(c, lane);
            int pos = incl - c; const int tot = __builtin_amdgcn_readlane(incl, 63);
            while (w0) { const int bit = __ffs(w0) - 1; w0 &= w0 - 1; if (pos < 256) lst[pos] = (unsigned short)(64 * lane + bit); ++pos; }
            while (w1) { const int bit = __ffs(w1) - 1; w1 &= w1 - 1; if (pos < 256) lst[pos] = (unsigned short)(64 * lane + 32 + bit); ++pos; }
            nsel = tot < 256 ? tot : 256;
            if (lane < 32 && nsel + lane < 288) lst[nsel + lane] = 0;
        }
        asm volatile("s_waitcnt lgkmcnt(0)" ::: "memory");
        if (nsel == 256) b3_core<true>(C, b, t, nsel, qc0, qc1, lst, vs); else b3_core<false>(C, b, t, nsel, qc0, qc1, lst, vs);
    }
#undef B3_PREFETCH
#endif
}

namespace pg8 {
constexpr int BM = 256, BK = 64, HALF = 128, HTB = HALF * BK * 2, STAGE_BYTES = 8 * HTB, NXCD = 8, WGM = 8;
__host__ __device__ __forceinline__ int lds_byte(int r, int c) { const int st = (r >> 4) * 2 + (c >> 5), rr = r & 15, cc = c & 31, ob = rr * 64 + cc * 2; return st * 1024 + (ob ^ (((ob >> 9) & 1) << 5)); }
__host__ __device__ __forceinline__ void stage_rc(int b, int& R, int& C) { const int st = b / 1024, sb = b % 1024, swz = sb ^ (((sb >> 9) & 1) << 5); R = (st >> 1) * 16 + swz / 64; C = (st & 1) * 32 + (swz % 64) / 2; }
__host__ __device__ __forceinline__ int perm32(int rho) { const int n = rho >> 4, i = rho & 15; return 8 * (i >> 2) + 4 * n + (i & 3); }

struct Unit { int pm, pn, po, eb; };
struct Gemm { const bf16* A; const bf16* Bt; int K; size_t ebytes; const int* rowsrc = nullptr; };

struct Order {
    int nM, nN, nwg, G, c, p_lo, amode, wgm = WGM; const LAS unsigned char* pe;
    __device__ __forceinline__ void init(int nM_, int nN_, int G_, int c_, int p_lo_, int amode_, const LAS unsigned char* pe_) { nM = nM_; nN = nN_; nwg = nM * nN; G = G_; c = c_; p_lo = p_lo_; amode = amode_; pe = pe_; }
    __device__ __forceinline__ bool next(int i, Unit& u) const {
        const long L = (long)i * G + c; if (L >= nwg) return false;
        int wgid = (int)L; { const int q = nwg / NXCD, r = nwg % NXCD, xcd = wgid % NXCD, off = wgid / NXCD; wgid = (xcd < r ? xcd * (q + 1) : r * (q + 1) + (xcd - r) * q) + off; }
        const int nig = wgm * nN, gid = wgid / nig, fm = gid * wgm, gsz = (nM - fm) < wgm ? (nM - fm) : wgm;
        const int lp = fm + ((wgid % nig) % gsz), gp = p_lo + lp; u.pn = (wgid % nig) / gsz;
        u.pm = amode == 0 ? gp : lp; u.po = amode == 0 ? lp : gp; u.eb = pe ? __builtin_amdgcn_readfirstlane((int)pe[gp]) : 0; return true;
    }
};

__device__ __forceinline__ unsigned cvt_pk_bf16(float lo, float hi) { return pk2(lo, hi); }
__device__ __forceinline__ float silu_fast(float g) { return g * __builtin_amdgcn_rcpf(1.f + __builtin_amdgcn_exp2f(-g * LOG2E)); }

struct EpiBf16 {
    static constexpr bool PERM = true;
    bf16* O; int ldc;
    __device__ __forceinline__ void operator()(const f32x4 (&acc)[2][2][4][2], const Unit& u, int wr, int wc, int fr, int fq) const {
        const int row0 = u.po * BM + wr * 64 + fr, col0 = u.pn * BM + wc * 32 + 8 * fq;
#pragma unroll
        for (int ai = 0; ai < 2; ++ai)
#pragma unroll
            for (int m = 0; m < 4; ++m) { bf16* rowp = O + (size_t)(row0 + ai * HALF + m * 16) * ldc + col0;
#pragma unroll
                for (int bj = 0; bj < 2; ++bj) { const f32x4 v0 = acc[ai][bj][m][0], v1 = acc[ai][bj][m][1];
                    v4u w; w.x = cvt_pk_bf16(v0[0], v0[1]); w.y = cvt_pk_bf16(v0[2], v0[3]); w.z = cvt_pk_bf16(v1[0], v1[1]); w.w = cvt_pk_bf16(v1[2], v1[3]);
                    *(v4u*)(rowp + bj * HALF) = w; } }
    }
};
struct EpiProj {
    static constexpr bool PERM = true;
    bf16* O; bf16* KFA; bf16* KFI; bf16* VF;
    __device__ __forceinline__ void operator()(const f32x4 (&acc)[2][2][4][2], const Unit& u, int wr, int wc, int fr, int fq) const {
        const int row0 = u.po * BM + wr * 64 + fr, col0 = u.pn * BM + wc * 32 + 8 * fq;
#pragma unroll
        for (int ai = 0; ai < 2; ++ai)
#pragma unroll
            for (int m = 0; m < 4; ++m) { const int row = row0 + ai * HALF + m * 16; bf16* rowp = O + (size_t)row * PW + col0;
#pragma unroll
                for (int bj = 0; bj < 2; ++bj) { const f32x4 v0 = acc[ai][bj][m][0], v1 = acc[ai][bj][m][1];
                    v4u w; w.x = cvt_pk_bf16(v0[0], v0[1]); w.y = cvt_pk_bf16(v0[2], v0[3]); w.z = cvt_pk_bf16(v1[0], v1[1]); w.w = cvt_pk_bf16(v1[2], v1[3]);
                    *(v4u*)(rowp + bj * HALF) = w;
                    if (u.pn == 10 && wc < 2 && bj == 1) {
                        const int dc = 4 * wc + fq;
                        bf16* kf = KFI + ((size_t)(row >> 5) * 4 + (dc >> 1)) * 512 + (32 * (dc & 1) + (row & 31)) * 8;
                        *(v4u*)kf = w;
                    } } }
    }
};
struct EpiGate {
    static constexpr bool PERM = true;
    bf16* O; const float* gate;
    __device__ __forceinline__ void operator()(const f32x4 (&acc)[2][2][4][2], const Unit& u, int wr, int wc, int fr, int fq) const {
        const int row0 = u.po * BM + wr * 64 + fr, col0 = u.pn * BM + wc * 32 + 8 * fq;
#pragma unroll
        for (int ai = 0; ai < 2; ++ai)
#pragma unroll
            for (int m = 0; m < 4; ++m) { const int row = row0 + ai * HALF + m * 16; const float g = gate ? gate[row] : 1.f; bf16* rowp = O + (size_t)row * DM + col0;
#pragma unroll
                for (int bj = 0; bj < 2; ++bj) { const f32x4 v0 = acc[ai][bj][m][0] * g, v1 = acc[ai][bj][m][1] * g;
                    v4u w; w.x = cvt_pk_bf16(v0[0], v0[1]); w.y = cvt_pk_bf16(v0[2], v0[3]); w.z = cvt_pk_bf16(v1[0], v1[1]); w.w = cvt_pk_bf16(v1[2], v1[3]);
                    *(v4u*)(rowp + bj * HALF) = w; } }
    }
};
struct EpiSwiglu {
    static constexpr bool PERM = true;
    bf16* O;
    __device__ __forceinline__ void operator()(const f32x4 (&acc)[2][2][4][2], const Unit& u, int wr, int wc, int fr, int fq) const {
        const int row0 = u.po * BM + wr * 64 + fr, col0 = u.pn * HALF + wc * 32 + 8 * fq;
#pragma unroll
        for (int ai = 0; ai < 2; ++ai)
#pragma unroll
            for (int m = 0; m < 4; ++m) { bf16* rowp = O + (size_t)(row0 + ai * HALF + m * 16) * DFF + col0;
                const f32x4 g0 = acc[ai][0][m][0], g1 = acc[ai][0][m][1], u0 = acc[ai][1][m][0], u1 = acc[ai][1][m][1];
                float ge[8] = {g0[0], g0[1], g0[2], g0[3], g1[0], g1[1], g1[2], g1[3]}; const float ue[8] = {u0[0], u0[1], u0[2], u0[3], u1[0], u1[1], u1[2], u1[3]};
                float ee[8];
#pragma unroll
                for (int x = 0; x < 8; ++x) ee[x] = __builtin_amdgcn_exp2f(-ge[x] * LOG2E);
#pragma unroll
                for (int x = 0; x < 8; ++x) ee[x] = __builtin_amdgcn_rcpf(1.f + ee[x]);
#pragma unroll
                for (int x = 0; x < 8; ++x) ge[x] = ge[x] * ee[x] * ue[x];
                v4u w; w.x = pk2(ge[0], ge[1]); w.y = pk2(ge[2], ge[3]); w.z = pk2(ge[4], ge[5]); w.w = pk2(ge[6], ge[7]);
                *(v4u*)rowp = w; }
    }
};

template <class Epi, class Sched>
__device__ __forceinline__ void gemm_phase(LAS unsigned char* lds, const int tid, const Gemm g, const Sched& S, const Epi& E) {
    const int wid = __builtin_amdgcn_readfirstlane(tid >> 6), lane = tid & 63, wr = wid >> 2, wc = wid & 3, fr = lane & 15, fq = lane >> 4;
    const int K = g.K, nt = K / BK;
    unsigned voffB[2]; int RA[2]; unsigned cA2[2];
#pragma unroll
    for (int i = 0; i < 2; ++i) { int R, C; stage_rc(tid * 16 + i * 8192, R, C); const int Rb = Epi::PERM ? ((R & ~31) + perm32(R & 31)) : R; RA[i] = R; cA2[i] = (unsigned)C * 2u; voffB[i] = (unsigned)(Rb * K + C) * 2u; }
    unsigned voffG[2][2], voffN[2][2];
#define PG8_ROWS(dst, pm_) do { _Pragma("unroll") for (int hh_ = 0; hh_ < 2; ++hh_) _Pragma("unroll") for (int ii_ = 0; ii_ < 2; ++ii_) { const int pr_ = (pm_) * BM + hh_ * HALF + RA[ii_]; \
        const unsigned gr_ = g.rowsrc ? (unsigned)g.rowsrc[pr_] : (unsigned)pr_; dst[hh_][ii_] = gr_ * (unsigned)(K * 2) + cA2[ii_]; } } while (0)
    const size_t kstep = (size_t)(BK * 2);
    const size_t hstep = (size_t)HALF * K * 2;
    const size_t tstep = 2 * hstep;
    const unsigned ldsw = (unsigned)wid * 1024u;
    const int aoff = lds_byte(wr * 64 + fr, fq * 8), boff = lds_byte(wc * 32 + fr, fq * 8);
#define PG8_SA(b, h) (((b) * 2 + (h)) * HTB)
#define PG8_SB(b, h) ((4 + (b) * 2 + (h)) * HTB)
#define PG8_STAGE(bufoff, gbase, voff) do { _Pragma("unroll") for (int _i = 0; _i < 2; ++_i) \
        __builtin_amdgcn_global_load_lds((const unsigned*)((const char*)(gbase) + (voff)[_i]), (LAS unsigned*)(lds + (bufoff) + ldsw + _i * 8192), 16, 0, 0); } while (0)
#define PG8_STAGEA(bufoff, kbase, vo) do { _Pragma("unroll") for (int _i = 0; _i < 2; ++_i) \
        __builtin_amdgcn_global_load_lds((const unsigned*)((const char*)(kbase) + (vo)[_i]), (LAS unsigned*)(lds + (bufoff) + ldsw + _i * 8192), 16, 0, 0); } while (0)
#define PG8_LDA(dst, b, h) do { _Pragma("unroll") for (int m = 0; m < 4; ++m) _Pragma("unroll") for (int k = 0; k < 2; ++k) dst[m][k] = *(const LAS bf16x8*)(lds + PG8_SA(b, h) + aoff + m * 2048 + k * 1024); } while (0)
#define PG8_LDB(dst, b, h) do { _Pragma("unroll") for (int n = 0; n < 2; ++n) _Pragma("unroll") for (int k = 0; k < 2; ++k) dst[n][k] = *(const LAS bf16x8*)(lds + PG8_SB(b, h) + boff + n * 2048 + k * 1024); } while (0)
#define PG8_MMA(ai, bj, At, Bt) do { __builtin_amdgcn_s_setprio(1); _Pragma("unroll") for (int m = 0; m < 4; ++m) _Pragma("unroll") for (int n = 0; n < 2; ++n) _Pragma("unroll") for (int k = 0; k < 2; ++k) \
        acc[ai][bj][m][n] = __builtin_amdgcn_mfma_f32_16x16x32_bf16(Bt[n][k], At[m][k], acc[ai][bj][m][n], 0, 0, 0); __builtin_amdgcn_s_setprio(0); } while (0)
#define PG8_WAIT_V(n) asm volatile("s_waitcnt vmcnt(" #n ")" ::: "memory")
#define PG8_WAIT_L(n) asm volatile("s_waitcnt lgkmcnt(" #n ")" ::: "memory")
#define PG8_BAR __builtin_amdgcn_s_barrier()
#define PG8_SCHED __builtin_amdgcn_sched_barrier(0)
    Unit cur, nxt; int ui = 0;
    if (!S.next(0, cur)) return;
    f32x4 acc[2][2][4][2];
#pragma unroll
    for (int a = 0; a < 2; ++a)
#pragma unroll
        for (int b = 0; b < 2; ++b)
#pragma unroll
            for (int m = 0; m < 4; ++m)
#pragma unroll
                for (int n = 0; n < 2; ++n) acc[a][b][m][n] = (f32x4){0.f, 0.f, 0.f, 0.f};
    bf16x8 At[4][2], B0[2][2], B1[2][2];
    PG8_ROWS(voffG, cur.pm);
    const char* cA = (const char*)g.A;
    const char* cB = (const char*)g.Bt + (size_t)cur.eb * g.ebytes + (size_t)cur.pn * tstep;
    PG8_STAGE(PG8_SB(0, 0), cB, voffB); PG8_STAGE(PG8_SB(0, 1), cB + hstep, voffB); PG8_STAGEA(PG8_SA(0, 0), cA, voffG[0]); PG8_STAGEA(PG8_SA(0, 1), cA, voffG[1]);
    if (wr == 1) PG8_BAR;
    PG8_WAIT_V(2); PG8_BAR;
    PG8_STAGE(PG8_SB(1, 0), cB + kstep, voffB); PG8_STAGEA(PG8_SA(1, 0), cA + kstep, voffG[0]); PG8_STAGE(PG8_SB(1, 1), cB + hstep + kstep, voffB);
    PG8_WAIT_V(6); PG8_BAR;
    for (;;) {
        const bool has_next = S.next(ui + 1, nxt);
        if (has_next) PG8_ROWS(voffN, nxt.pm); else { voffN[0][0] = voffG[0][0]; voffN[0][1] = voffG[0][1]; voffN[1][0] = voffG[1][0]; voffN[1][1] = voffG[1][1]; }
        const char* nB = has_next ? (const char*)g.Bt + (size_t)nxt.eb * g.ebytes + (size_t)nxt.pn * tstep : cB;
#define PG8_PAIR(a1, a2, b2, a3, b3, v2) do { \
              \
            PG8_LDB(B0, 0, 0); PG8_LDB(B1, 0, 1); PG8_SCHED; PG8_LDA(At, 0, 0); PG8_STAGEA(PG8_SA(1, 1), (a1), voffG[1]); \
            PG8_WAIT_V(8); PG8_WAIT_L(0); PG8_BAR; PG8_MMA(0, 0, At, B0); PG8_MMA(0, 1, At, B1); PG8_BAR; PG8_SCHED; \
              \
            PG8_LDA(At, 0, 1); PG8_STAGE(PG8_SB(0, 0), b2, voffB); PG8_STAGE(PG8_SB(0, 1), (b2) + hstep, voffB); PG8_STAGEA(PG8_SA(0, 0), a2, v2[0]); \
            PG8_WAIT_V(8); PG8_WAIT_L(0); PG8_BAR; PG8_MMA(1, 0, At, B0); PG8_MMA(1, 1, At, B1); PG8_BAR; PG8_SCHED; \
              \
            PG8_LDB(B0, 1, 0); PG8_LDB(B1, 1, 1); PG8_SCHED; PG8_LDA(At, 1, 0); PG8_STAGEA(PG8_SA(0, 1), (a2), v2[1]); \
            PG8_WAIT_V(8); PG8_WAIT_L(0); PG8_BAR; PG8_MMA(0, 0, At, B0); PG8_MMA(0, 1, At, B1); PG8_BAR; PG8_SCHED; \
              \
            PG8_LDA(At, 1, 1); PG8_STAGE(PG8_SB(1, 0), b3, voffB); PG8_STAGE(PG8_SB(1, 1), (b3) + hstep, voffB); PG8_STAGEA(PG8_SA(1, 0), a3, v2[0]); \
            PG8_WAIT_V(8); PG8_WAIT_L(0); PG8_BAR; PG8_MMA(1, 0, At, B0); PG8_MMA(1, 1, At, B1); PG8_BAR; PG8_SCHED; } while (0)
        for (int t = 0; t < nt; t += 2) {
            const bool last = (t == nt - 2);
            const char* a1 = cA + (size_t)(t + 1) * kstep;
            const char* a2 = last ? cA : cA + (size_t)(t + 2) * kstep; const char* b2 = last ? nB : cB + (size_t)(t + 2) * kstep;
            const char* a3 = a2 + kstep; const char* b3 = b2 + kstep;
            unsigned v2[2][2];
#pragma unroll
            for (int hh_ = 0; hh_ < 2; ++hh_) { v2[hh_][0] = last ? voffN[hh_][0] : voffG[hh_][0]; v2[hh_][1] = last ? voffN[hh_][1] : voffG[hh_][1]; }
            PG8_PAIR(a1, a2, b2, a3, b3, v2);
        }
#undef PG8_PAIR
        if (wr == 0) PG8_BAR;
        E(acc, cur, wr, wc, fr, fq);
        if (!has_next) break;
#pragma unroll
        for (int a = 0; a < 2; ++a)
#pragma unroll
            for (int b = 0; b < 2; ++b)
#pragma unroll
                for (int m = 0; m < 4; ++m)
#pragma unroll
                    for (int n = 0; n < 2; ++n) acc[a][b][m][n] = (f32x4){0.f, 0.f, 0.f, 0.f};
        cur = nxt; cB = nB; ++ui; voffG[0][0] = voffN[0][0]; voffG[0][1] = voffN[0][1]; voffG[1][0] = voffN[1][0]; voffG[1][1] = voffN[1][1];
        if (wr == 1) PG8_BAR;
    }
    PG8_WAIT_V(0);
    PG8_BAR;
#undef PG8_SA
#undef PG8_SB
#undef PG8_STAGE
#undef PG8_STAGEA
#undef PG8_ROWS
#undef PG8_LDA
#undef PG8_LDB
#undef PG8_MMA
#undef PG8_WAIT_V
#undef PG8_WAIT_L
#undef PG8_BAR
#undef PG8_SCHED
}
}

constexpr int N_STEPS = 2 + 2 * (7 - USE_GSEQ + 2 * NPASS_DENSE) + 2 * (8 - USE_GSEQ + 2 * NPASS_MOE);
#ifndef REP_A
#define REP_A 1
#define REP_B 1
#endif
#ifndef PROBE_ID
#define PROBE_ID 0
#endif
#ifndef REP_BAR
#define REP_BAR 1
#endif
#ifndef REP_C
#define REP_C 1
#endif
#ifndef REP_L
#define REP_L 1
#endif
#ifndef REP_G
#define REP_G 1
#endif
#ifndef USE_B3
#define USE_B3 1
#endif
#ifndef USE_B2
#define USE_B2 1
#define USE_A2 1
#endif
#ifndef USE_PG8
#define USE_PG8 1
#endif
#ifndef GLA_A4_SHARE
#define GLA_A4_SHARE 4
#endif
#ifndef A4_SCORE_PRIO
#define A4_SCORE_PRIO 2
#endif
#ifndef WGM_IN
#define WGM_IN 4
#define WGM_OUT 8
#define WGM_F1 4
#define WGM_F2 4
#endif
#ifndef USE_A4
#define USE_A4 1
#endif

__global__ void __launch_bounds__(512, 2) hybrid_fwd(Args args) {
    extern __shared__ __attribute__((aligned(16))) unsigned char lds_raw[];
    Ctx C;
    C.lds = (LAS unsigned char*)lds_raw;
    C.MISC = (volatile LAS unsigned*)(C.lds + MISC_OFF);
    C.tid = threadIdx.x; C.lane = C.tid & 63; C.wave = __builtin_amdgcn_readfirstlane(C.tid >> 6);
    C.G = gridDim.x; C.bid = blockIdx.x; C.hot = 0xffff;
    C.ka = (KArgs*)__builtin_amdgcn_kernarg_segment_ptr();
    C.out = args.out; C.ws = args.ws; C.ctl = (unsigned*)(args.ws + WS_CTL);
    if (C.tid < 32) C.MISC[C.tid] = 0u;
    __syncthreads();
    if (!MK_MULTI) (void)xcd_barrier_post(C.ctl + CW_BAR, C.MISC + 8);
    int step = 0;
    const int wave_s = __builtin_amdgcn_readfirstlane((int)threadIdx.x >> 6);
#define STEP_BEGIN if (step >= C.ka->lo && step < C.ka->hi) { { unsigned m_ = ~0u; asm volatile("" : "+s"(m_)); const int ln_ = (int)__builtin_amdgcn_mbcnt_hi(m_, __builtin_amdgcn_mbcnt_lo(m_, 0u)); \
        int t_ = wave_s * 64 + ln_; asm volatile("" : "+v"(t_)); C.tid = t_; C.lane = t_ & 63; C.wave = wave_s; \
        KArgs* k_ = (KArgs*)__builtin_amdgcn_kernarg_segment_ptr(); asm volatile("" : "+s"(k_)); C.ka = k_; C.ws = k_->ws; C.out = k_->out; C.ctl = (unsigned*)(k_->ws + WS_CTL); C.G = gridDim.x; C.bid = blockIdx.x; }
#define STEP_END } if (!MK_MULTI && step >= C.ka->lo && step + 1 < C.ka->hi) { XcdBarrier b_; b_.bar = (unsigned*)(C.ka->ws + WS_CTL) + CW_BAR; b_.x = xb_xcc_id(); b_.st = C.MISC + 8; xcd_barrier(b_); if (REP_BAR > 1) xcd_barrier(b_); } ++step;
#define WSP(T, off) ((T*)(C.ws + (off)))
#define RELAUNDER { int t_ = C.tid; asm volatile("" : "+v"(t_)); C.tid = t_; C.lane = t_ & 63; C.wave = __builtin_amdgcn_readfirstlane(t_ >> 6); }

    STEP_BEGIN
        ph_mod(C); __syncthreads(); ph_conv(C, 0);
#if REP_C > 1
        __syncthreads(); ph_mod(C); __syncthreads(); ph_conv(C, 0);
#endif
    STEP_END
    STEP_BEGIN
        ph_modulate0(C);
#if PROBE_ID == 8
        RELAUNDER ph_modulate0(C); RELAUNDER ph_modulate0(C); RELAUNDER ph_modulate0(C); RELAUNDER ph_modulate0(C);
#endif
    STEP_END

    for (int l = 0; l < DEPTH; ++l) {
        STEP_BEGIN
#if USE_PG8
            { const pg8::Gemm g{WSP(bf16, WS_H), WSP(bf16, WS_WIN), DM, 0}; pg8::Order S; S.init(256, 11, C.G, C.bid, 0, 0, nullptr); S.wgm = WGM_IN;
              pg8::gemm_phase(C.lds, C.tid, g, S, pg8::EpiProj{WSP(bf16, WS_P), WSP(bf16, WS_KFA), WSP(bf16, WS_KFI), WSP(bf16, WS_VF)});
#if PROBE_ID == 5
              RELAUNDER pg8::gemm_phase(C.lds, C.tid, g, S, pg8::EpiProj{WSP(bf16, WS_P), WSP(bf16, WS_KFA), WSP(bf16, WS_KFI), WSP(bf16, WS_VF)});
#endif
            }
#else
            for (int u = C.bid; u < 256 * 11; u += C.G) {
                const int pm = u / 11, pn = u % 11; const GUnit gu{pm * 256, pm * 256, pn, 0};
                gemm_simple_unit<0>(C, WSP(bf16, WS_H), DM, nullptr, WSP(bf16, WS_WIN), DM, gu, EpiStoreS{WSP(bf16, WS_P), PW});
            }
#endif
        STEP_END
        STEP_BEGIN
#pragma unroll 1
#if USE_A4
            for (int rp_ = 0; rp_ < (PROBE_ID == 1 ? 2 : 1); ++rp_) {
#ifdef PROBE_HOT
                C.hot = (PROBE_ID == 1 && rp_ == 0) ? PROBE_HOT : 0xffff;
#endif
#ifdef PROBE_SKIP
#define A4_SKIPM ((PROBE_ID == 1 && rp_ == 0) ? PROBE_SKIP : 0)
#else
#define A4_SKIPM 0
#endif
#define A4_MAP(idx_) const int b = (idx_) & 15, r_ = (idx_) >> 4, j_ = (r_ & 15) + 16 * (r_ >> 5), t0 = 4 * (((r_ >> 4) & 1) ? 1023 - j_ : j_);
                LAS unsigned* img = (LAS unsigned*)C.lds;
#if USE_GSEQ
                const int NGW = C.G >= 128 ? 64 : C.G / 2, ufull = 16384 - NGW * GLA_A4_SHARE;
                const bool glawg = C.bid < NGW;
                const int NW = glawg ? NGW : C.G - NGW, wid = glawg ? ufull + C.bid : C.bid - NGW, ulim = glawg ? 16384 : ufull;
                const int nun = (wid < ulim) ? (ulim - wid + NW - 1) / NW : 0;
                if (glawg) {
#pragma unroll 1
                    for (int sq_ = C.bid; sq_ < 64; sq_ += NGW) { RELAUNDER ph_gla_seq(C, l, sq_); }
                }
#else
                const int NW = C.G, wid = C.bid;
                const int nun = (C.bid < 16384) ? (16384 - C.bid + C.G - 1) / C.G : 0;
#endif
                if (C.wave < 4) {
                    __builtin_amdgcn_s_setprio(A4_SCORE_PRIO);
                    A4S S;
                    { A4_MAP(nun > 0 ? wid : 0) a4_prefetch(C, S, b, t0); }
#pragma unroll 1
                    for (int k = 0; k < nun; ++k) { RELAUNDER
                        { const int nidx = (k + 1 < nun) ? wid + (k + 1) * NW : wid; const int nb = nidx & 15, nr_ = nidx >> 4, nj_ = (nr_ & 15) + 16 * (nr_ >> 5), nt0 = 4 * (((nr_ >> 4) & 1) ? 1023 - nj_ : nj_);
                          A4_MAP(wid + k * NW) a4_score(C, S, img + (k & 1) * A4_BUF, b, t0, nb, nt0); }
                        __syncthreads(); }
                    __builtin_amdgcn_s_setprio(0);
                } else {
#pragma unroll 1
                    for (int k = 0; k < nun; ++k) { __syncthreads(); RELAUNDER A4_MAP(wid + k * NW) const int q = C.wave - 4; if (!(A4_SKIPM & 32)) a4_select(C, img + (k & 1) * A4_BUF + q * A3_QP, b, t0 + q); }
                }
                __syncthreads();
#undef A4_MAP
            }
#else
            for (int rp_ = 0; rp_ < (PROBE_ID == 1 ? 2 : 1); ++rp_)
            for (int idx = C.bid; idx < 8192; idx += C.G) {
                RELAUNDER
                const int b = idx & 15, r = idx >> 4, j = (r & 15) + 16 * (r >> 5), qb = ((r >> 4) & 1) ? 511 - j : j;
                A3Q qa; a3_load_q(C, b, qb * 8, qa);
                ph_dsa_a3_unit(C, b, qb * 8, qa, false, 0, 0);
            }
#endif
#if !USE_GSEQ
#pragma unroll 1
            for (int rp_ = 0; rp_ < (PROBE_ID == 3 ? 2 : 1); ++rp_)
            for (int u = C.bid; u < 4096; u += C.G) { RELAUNDER ph_gla1_unit(C, l, u); }
#endif
        STEP_END
#if !USE_GSEQ
        STEP_BEGIN
            ph_gla2(C);
#if PROBE_ID == 9
            RELAUNDER ph_gla2(C, (size_t)66 * MiB); RELAUNDER ph_gla2(C, (size_t)66 * MiB);
#endif
        STEP_END
#endif
        STEP_BEGIN
#if !USE_GSEQ
#pragma unroll 1
            for (int rp_ = 0; rp_ < (PROBE_ID == 4 ? 2 : 1); ++rp_)
            for (int u = C.bid; u < 4096; u += C.G) { RELAUNDER ph_gla3_unit(C, l, u); }
#endif
#if USE_B2
#pragma unroll 1
            for (int rep = 0; rep < (PROBE_ID == 2 ? 2 : 1); ++rep)
#ifdef PROBE_HOT
            { C.hot = (PROBE_ID == 2 && rep == 0) ? PROBE_HOT : 0xffff;
#else
            {
#endif
            for (int idx = C.bid; idx < 2048; idx += C.G) {
                RELAUNDER
                const int b = idx & 15, r = idx >> 4, j = (r & 15) + 16 * (r >> 5), qb = ((r >> 4) & 1) ? 127 - j : j;
#if USE_B3
                ph_dsa_b3_wave(C, b, qb * 32 + C.wave * 4);
#else
                ph_dsa_b2_wave(C, b, qb * 32 + C.wave * 4);
#endif
            }
            }
#else
            for (int u = C.bid; u < 8192; u += C.G) { RELAUNDER ph_dsa_b_unit(C, u & 15, (u >> 4) * 8); }
#endif
        STEP_END
        STEP_BEGIN
#if USE_PG8
            { const pg8::Gemm g{(const bf16*)C.out, WSP(bf16, WS_WOUT), DM, 0}; pg8::Order S; S.init(256, 4, C.G, C.bid, 0, 0, nullptr); S.wgm = WGM_OUT;
              pg8::gemm_phase(C.lds, C.tid, g, S, pg8::EpiBf16{WSP(bf16, WS_Y), DM});
#if PROBE_ID == 6
              RELAUNDER pg8::gemm_phase(C.lds, C.tid, g, S, pg8::EpiBf16{WSP(bf16, WS_Y), DM});
#endif
            }
#else
            for (int u = C.bid; u < 256 * 4; u += C.G) {
                const int pm = u >> 2, pn = u & 3; const GUnit gu{pm * 256, pm * 256, pn, 0};
                gemm_simple_unit<0>(C, WSP(bf16, WS_H), DM, nullptr, WSP(bf16, WS_WOUT), DM, gu, EpiStoreS{WSP(bf16, WS_Y), DM});
            }
#endif
        STEP_END
        STEP_BEGIN
            const float* Xin = C.in(I_X);
            if (l == 0) ph_ln<false, 0, 0>(C, Xin, l, 0, 2048, l, 3072, true, 0, 0, false);
            else if (l & 1) ph_ln<true, 0, 1>(C, Xin, l, 0, 2048, l, 3072, true, l >> 1, 0, false);
            else ph_ln<false, 0, 1>(C, Xin, l, 0, 2048, l, 3072, true, l >> 1, 0, false);
        STEP_END
        if (l & 1) {
            STEP_BEGIN
                ph_assign(C, l >> 1);
            STEP_END
        }
        for (int pass = 0; pass < ((l & 1) ? NPASS_MOE : NPASS_DENSE); ++pass) {
            STEP_BEGIN
                const bool moe = (l & 1) != 0;
                MoeTab tb; tb.npanels = 256;
#pragma unroll
                for (int e = 0; e < 8; ++e) tb.pend[e] = 65536;
                if (moe) tb = moe_tab(C, l >> 1);
                const int p_lo = pass * PASS_PANELS, p_hi = moe ? ((pass == NPASS_MOE - 1 || tb.npanels < p_lo + PASS_PANELS) ? tb.npanels : p_lo + PASS_PANELS) : p_lo + PASS_PANELS;
                const int npan = p_hi > p_lo ? p_hi - p_lo : 0;
#if USE_PG8
                LAS unsigned char* pe = C.lds + PE_OFF;
                for (int p = C.tid; p < 528; p += 512) pe[p] = (unsigned char)(moe ? panel_expert(tb, p) : 0);
                __syncthreads();
                { const pg8::Gemm g{WSP(bf16, WS_H), WSP(bf16, WS_WGU), DM, (size_t)5632 * 1024 * 2, moe ? (const int*)WSP(int, WS_ROWTOK) : nullptr}; pg8::Order S; S.init(npan, 22, C.G, C.bid, p_lo, 0, pe); S.wgm = WGM_F1;
                  pg8::gemm_phase(C.lds, C.tid, g, S, pg8::EpiSwiglu{WSP(bf16, WS_P)});
#if REP_G > 1
                  RELAUNDER pg8::gemm_phase(C.lds, C.tid, g, S, pg8::EpiSwiglu{WSP(bf16, WS_P)});
#endif
                }
#else
                for (int u = C.bid; u < npan * 22; u += C.G) {
                    const int lp = u / 22, pn = u % 22, gp = p_lo + lp; const int e = moe ? panel_expert(tb, gp) : 0;
                    const GUnit gu{gp * 256, lp * 256, pn, (size_t)e * 5632 * 1024};
                    gemm_simple_unit<1>(C, moe ? WSP(bf16, WS_Y) : WSP(bf16, WS_H), DM, nullptr, WSP(bf16, WS_WGU), DM, gu, EpiSwigluS{WSP(bf16, WS_P)});
                }
#endif
            STEP_END
            STEP_BEGIN
                const bool moe = (l & 1) != 0;
                MoeTab tb; tb.npanels = 256;
#pragma unroll
                for (int e = 0; e < 8; ++e) tb.pend[e] = 65536;
                if (moe) tb = moe_tab(C, l >> 1);
                const int p_lo = pass * PASS_PANELS, p_hi = moe ? ((pass == NPASS_MOE - 1 || tb.npanels < p_lo + PASS_PANELS) ? tb.npanels : p_lo + PASS_PANELS) : p_lo + PASS_PANELS;
                const int npan = p_hi > p_lo ? p_hi - p_lo : 0;
#if USE_PG8
                LAS unsigned char* pe = C.lds + PE_OFF;
                for (int p = C.tid; p < 528; p += 512) pe[p] = (unsigned char)(moe ? panel_expert(tb, p) : 0);
                __syncthreads();
                { const pg8::Gemm g{WSP(bf16, WS_P), WSP(bf16, WS_WDN), DFF, (size_t)1024 * DFF * 2}; pg8::Order S; S.init(npan, 4, C.G, C.bid, p_lo, 1, pe); S.wgm = WGM_F2;
                  pg8::gemm_phase(C.lds, C.tid, g, S, pg8::EpiGate{WSP(bf16, WS_Y), moe ? WSP(float, WS_ROWGATE) : nullptr});
#if PROBE_ID == 7
                  RELAUNDER pg8::gemm_phase(C.lds, C.tid, g, S, pg8::EpiGate{WSP(bf16, WS_Y), moe ? WSP(float, WS_ROWGATE) : nullptr});
#endif
                }
#else
                for (int u = C.bid; u < npan * 4; u += C.G) {
                    const int lp = u >> 2, pn = u & 3, gp = p_lo + lp; const int e = moe ? panel_expert(tb, gp) : 0;
                    const GUnit gu{lp * 256, gp * 256, pn, (size_t)e * 1024 * DFF};
                    if (moe) gemm_simple_unit<0>(C, WSP(bf16, WS_P), DFF, nullptr, WSP(bf16, WS_WDN), DFF, gu, EpiGateS{WSP(bf16, WS_Y), WSP(float, WS_ROWGATE)});
                    else gemm_simple_unit<0>(C, WSP(bf16, WS_P), DFF, nullptr, WSP(bf16, WS_WDN), DFF, gu, EpiStoreS{WSP(bf16, WS_Y), DM});
                }
#endif
            STEP_END
        }
        STEP_BEGIN
            const int l2 = l < 3 ? l + 1 : 3;
            if (l & 1) ph_ln<false, 1, 1>(C, nullptr, l, 1, 5120, l2, 0, l < 3, 0, 3072, l == 3); else ph_ln<false, 0, 1>(C, nullptr, l, 1, 5120, l2, 0, l < 3, 0, 3072, l == 3);
            if (l < 3) ph_conv(C, l + 1);
#if REP_C > 1
            if (l < 3) { RELAUNDER ph_conv(C, l + 1); }
#endif
        STEP_END
    }
#undef STEP_BEGIN
#undef STEP_END
#undef WSP
#undef RELAUNDER
}

#ifndef DUMP_HI
#define DUMP_HI 0
#define DUMP_OFF 0
#define DUMP_WORDS 1
#endif
#if DUMP_HI
__global__ void __launch_bounds__(256) copy_half_k(const unsigned* src, unsigned* dst) {
    for (size_t i = (size_t)blockIdx.x * 256 + threadIdx.x; i < (size_t)65536 * 256; i += (size_t)gridDim.x * 256) dst[i] = src[(i >> 8) * 512 + (i & 255)];
}
__global__ void __launch_bounds__(256) dump_k(const unsigned* src, size_t nwords, float* out) {
    const size_t N = (size_t)MTOK * DM;
    for (size_t i = (size_t)blockIdx.x * 256 + threadIdx.x; i < N; i += (size_t)gridDim.x * 256) {
        float v = 0.f;
        for (size_t k = i % nwords; k < nwords; k += N) { const unsigned w = src[k]; v += (float)((w ^ (w >> 13)) & 0xFFFu); }
        out[i] = v;
    }
}
#endif
extern "C" void kernel_launch(void* const* d_in, const int* in_sizes, int n_in, void* d_out, int out_size, void* d_ws, size_t ws_size, hipStream_t stream) {
    static int grid = 0;
    if (grid == 0) {
        if (n_in != 19 || in_sizes[0] != MTOK * DM || out_size != MTOK * DM || ws_size < WS_END) {
            fprintf(stderr, "kernel_launch: unexpected shapes (n_in %d, in0 %d, out %d, ws %zu); nothing launched\n", n_in, n_in > 0 ? in_sizes[0] : -1, out_size, ws_size); grid = -1; return; }
        int dev = 0, cus = 0, per_cu = 0;
        if (hipGetDevice(&dev) != hipSuccess || hipDeviceGetAttribute(&cus, hipDeviceAttributeMultiprocessorCount, dev) != hipSuccess) { grid = -1; return; }
        if (hipFuncSetAttribute((const void*)hybrid_fwd, hipFuncAttributeMaxDynamicSharedMemorySize, LDS_BYTES) != hipSuccess) { fprintf(stderr, "kernel_launch: hipFuncSetAttribute failed\n"); grid = -1; return; }
        if (hipOccupancyMaxActiveBlocksPerMultiprocessor(&per_cu, (const void*)hybrid_fwd, 512, LDS_BYTES) != hipSuccess || per_cu < 1)
            fprintf(stderr, "kernel_launch: note: occupancy query reports %d workgroups per CU\n", per_cu);
        (void)hipGetLastError();
        grid = cus;
    }
    if (grid < 0) return;
    if (hipMemsetAsync((char*)d_ws + WS_CTL, 0, CTL_ZERO_BYTES, stream) != hipSuccess) { fprintf(stderr, "kernel_launch: memset failed\n"); return; }
    Args a{};
    for (int i = 0; i < 19; ++i) a.in[i] = (const float*)d_in[i];
    a.out = (float*)d_out; a.ws = (unsigned char*)d_ws;
#if MK_MULTI
    for (int s = 0; s < N_STEPS; ++s) { a.lo = s; a.hi = s + 1; hipLaunchKernelGGL(hybrid_fwd, dim3(grid), dim3(512), LDS_BYTES, stream, a); }
#else
#ifdef DUMP_SPLIT
    a.lo = 0; a.hi = DUMP_SPLIT;
    hipLaunchKernelGGL(hybrid_fwd, dim3(grid), dim3(512), LDS_BYTES, stream, a);
    (void)hipMemsetAsync((char*)d_ws + WS_CTL, 0, 65536, stream);
    a.lo = DUMP_SPLIT; a.hi = DUMP_HI;
    hipLaunchKernelGGL(hybrid_fwd, dim3(grid), dim3(512), LDS_BYTES, stream, a);
#else
    a.lo = 0; a.hi = DUMP_HI ? DUMP_HI : N_STEPS;
    hipLaunchKernelGGL(hybrid_fwd, dim3(grid), dim3(512), LDS_BYTES, stream, a);
#endif
#ifdef DUMP_OUTCOPY
    hipLaunchKernelGGL(copy_half_k, dim3(8192), dim3(256), 0, stream, (const unsigned*)d_out + (DUMP_OUTCOPY == 2 ? 256 : 0), (unsigned*)((char*)d_ws + (size_t)DUMP_OFF));
#endif
#if DUMP_HI
    hipLaunchKernelGGL(dump_k, dim3(8192), dim3(256), 0, stream, (const unsigned*)((const char*)d_ws + (size_t)DUMP_OFF), (size_t)DUMP_WORDS, (float*)d_out);
#endif
#endif
    const hipError_t le = hipPeekAtLastError();
    if (le != hipSuccess) fprintf(stderr, "kernel_launch: launch failed: %s\n", hipGetErrorName(le));
}
```
